# Optimizing an MI355X kernel written in HIP

```python
import math
import jax, jax.numpy as jnp
from jax import lax
import numpy as np

D_MODEL = 2048
BATCH = 1
SEQ = 16384
DEPTH = 1

D_MIX = D_MODEL
A_HEADS = 4
A_HEAD_DIM = 128
A_VDIM = 2 * A_HEAD_DIM
A_WIDTH = A_HEADS * A_VDIM
Q_BLOCK = 128
M_HEADS = 4
M_QK_DIM = 128
M_VDIM = 256
M_WIDTH = M_HEADS * M_VDIM
M_CHUNK = 128
CONV_K = 4
GATE_CAP = 15.0
D_FF = 256 * ((8 * D_MODEL // 3 + 255) // 256)
EPS = 1e-6

SPLIT_SIZES = [
    A_HEADS * 2 * A_HEAD_DIM,
    A_HEADS * 2 * A_HEAD_DIM,
    A_WIDTH,
    M_HEADS * M_QK_DIM,
    M_HEADS * M_QK_DIM,
    M_WIDTH,
    M_WIDTH,
    M_HEADS,
    M_HEADS,
]
N_IN = sum(SPLIT_SIZES)

kernel_name = 'hymba_style_diffattn_mlstm_macaron'


def rmsnorm(x, g):
    x32 = x.astype(jnp.float32)
    y = x32 * lax.rsqrt(jnp.mean(x32 * x32, axis=-1, keepdims=True) + EPS)
    return (y * g.astype(jnp.float32)).astype(x.dtype)


def swiglu(h, w_gate, w_up, w_down):
    return (jax.nn.silu(h @ w_gate) * (h @ w_up)) @ w_down


def diff_attention(q, k, v, lam, head_gain, lam_init):
    B, S = q.shape[0], q.shape[1]
    nb = S // Q_BLOCK
    q = q * (A_HEAD_DIM ** -0.5)
    qb = q.reshape(B, nb, Q_BLOCK, A_HEADS, 2, A_HEAD_DIM).transpose(1, 0, 2, 3, 4, 5)
    kpos = jnp.arange(S)

    def block(args):
        qi, i = args
        s = jnp.einsum('bqhcd,bkhcd->bhcqk', qi, k).astype(jnp.float32)
        qpos = i * Q_BLOCK + jnp.arange(Q_BLOCK)
        mask = kpos[None, :] <= qpos[:, None]
        a = jax.nn.softmax(jnp.where(mask, s, -jnp.inf), axis=-1)
        w = a[:, :, 0] - lam * a[:, :, 1]
        return jnp.einsum('bhqk,bkhe->bqhe', w.astype(v.dtype), v)

    o = lax.map(block, (qb, jnp.arange(nb)))
    o = o.transpose(1, 0, 2, 3, 4).reshape(B, S, A_HEADS, A_VDIM)
    o = rmsnorm(o, head_gain) * (1.0 - lam_init)
    return o.reshape(B, S, A_WIDTH)


def causal_dwconv(x, w, b):
    y = lax.conv_general_dilated(
        x, w.astype(x.dtype), window_strides=(1,), padding=[(CONV_K - 1, 0)],
        dimension_numbers=('NWC', 'WIO', 'NWC'), feature_group_count=x.shape[-1])
    return y + b.astype(x.dtype)


def mlstm_chunkwise(q, k, v, i_pre, f_pre):
    B, S = q.shape[0], q.shape[1]
    nc = S // M_CHUNK
    L = M_CHUNK
    q = q.astype(jnp.float32) * (M_QK_DIM ** -0.5)
    k = k.astype(jnp.float32)
    v = v.astype(jnp.float32)

    def to_chunks(t):
        return t.reshape(B, nc, L, M_HEADS, t.shape[-1]).transpose(1, 0, 3, 2, 4)

    def gate_chunks(t):
        return t.reshape(B, nc, L, M_HEADS).transpose(1, 0, 3, 2)

    log_f = jax.nn.log_sigmoid(f_pre)
    xs = (to_chunks(q), to_chunks(k), to_chunks(v), gate_chunks(i_pre), gate_chunks(log_f))
    tri = jnp.tril(jnp.ones((L, L), dtype=bool))

    def step(carry, inp):
        C, n, m = carry
        qc, kc, vc, ig, lf = inp
        b = jnp.cumsum(lf, axis=-1)
        d_log = b[..., :, None] - b[..., None, :] + ig[..., None, :]
        d_log = jnp.where(tri, d_log, -jnp.inf)
        inter = b + m[..., None]
        m_t = jnp.maximum(inter, jnp.max(d_log, axis=-1))
        s_w = jnp.einsum('bhtd,bhsd->bhts', qc, kc) * jnp.exp(d_log - m_t[..., None])
        g = jnp.exp(inter - m_t)
        num = g[..., None] * jnp.einsum('bhtd,bhde->bhte', qc, C) + jnp.einsum('bhts,bhse->bhte', s_w, vc)
        den = g * jnp.einsum('bhtd,bhd->bht', qc, n) + jnp.sum(s_w, axis=-1)
        den = jnp.maximum(jnp.abs(den), jnp.exp(-m_t))
        h = num / den[..., None]
        b_last = b[..., -1]
        w_log = b_last[..., None] - b + ig
        m_new = jnp.maximum(b_last + m, jnp.max(w_log, axis=-1))
        ws = jnp.exp(w_log - m_new[..., None])
        g_state = jnp.exp(b_last + m - m_new)
        C_new = g_state[..., None, None] * C + jnp.einsum('bhs,bhsd,bhse->bhde', ws, kc, vc)
        n_new = g_state[..., None] * n + jnp.einsum('bhs,bhsd->bhd', ws, kc)
        return (C_new, n_new, m_new), h

    init = (jnp.zeros((B, M_HEADS, M_QK_DIM, M_VDIM), jnp.float32),
            jnp.zeros((B, M_HEADS, M_QK_DIM), jnp.float32),
            jnp.zeros((B, M_HEADS), jnp.float32))
    _, h = lax.scan(step, init, xs)
    return h.transpose(1, 0, 3, 2, 4).reshape(B, S, M_HEADS, M_VDIM)


def setup_inputs(seed: int = 0) -> dict:
    key = jax.random.key(seed)
    ks = jax.random.split(key, 24)
    f32 = jnp.float32

    def nrm(k, shape, scale):
        return jax.random.normal(k, shape, f32) * scale

    def gain(k, shape):
        return 1.0 + 0.02 * jax.random.normal(k, shape, f32)

    f_bias = jnp.linspace(3.0, 6.0, M_HEADS, dtype=f32)[None, :] + nrm(ks[13], (DEPTH, M_HEADS), 0.1)
    return {
        'x': nrm(ks[0], (BATCH, SEQ, D_MODEL), 1.0),
        'ffn1_norm': gain(ks[1], (DEPTH, D_MODEL)),
        'ffn1_w_gate': nrm(ks[2], (DEPTH, D_MODEL, D_FF), D_MODEL ** -0.5),
        'ffn1_w_up': nrm(ks[3], (DEPTH, D_MODEL, D_FF), D_MODEL ** -0.5),
        'ffn1_w_down': nrm(ks[4], (DEPTH, D_FF, D_MODEL), D_FF ** -0.5),
        'mix_norm': gain(ks[5], (DEPTH, D_MODEL)),
        'w_in': nrm(ks[6], (DEPTH, D_MODEL, N_IN), D_MODEL ** -0.5),
        'lam_q1': nrm(ks[7], (DEPTH, A_HEAD_DIM), 0.1),
        'lam_k1': nrm(ks[8], (DEPTH, A_HEAD_DIM), 0.1),
        'lam_q2': nrm(ks[9], (DEPTH, A_HEAD_DIM), 0.1),
        'lam_k2': nrm(ks[10], (DEPTH, A_HEAD_DIM), 0.1),
        'attn_head_norm': gain(ks[11], (DEPTH, A_HEADS, A_VDIM)),
        'conv_w': nrm(ks[12], (DEPTH, CONV_K, 1, 2 * M_HEADS * M_QK_DIM), CONV_K ** -0.5),
        'conv_b': nrm(ks[14], (DEPTH, 2 * M_HEADS * M_QK_DIM), 0.01),
        'b_igate': nrm(ks[15], (DEPTH, M_HEADS), 0.1),
        'b_fgate': f_bias,
        'mlstm_head_norm': gain(ks[16], (DEPTH, M_HEADS, M_VDIM)),
        'w_out': nrm(ks[17], (DEPTH, D_MIX, D_MODEL), D_MIX ** -0.5),
        'ffn2_norm': gain(ks[18], (DEPTH, D_MODEL)),
        'ffn2_w_gate': nrm(ks[19], (DEPTH, D_MODEL, D_FF), D_MODEL ** -0.5),
        'ffn2_w_up': nrm(ks[20], (DEPTH, D_MODEL, D_FF), D_MODEL ** -0.5),
        'ffn2_w_down': nrm(ks[21], (DEPTH, D_FF, D_MODEL), D_FF ** -0.5),
        'final_norm': gain(ks[22], (D_MODEL,)),
    }


def reference(x, ffn1_norm, ffn1_w_gate, ffn1_w_up, ffn1_w_down, mix_norm, w_in,
              lam_q1, lam_k1, lam_q2, lam_k2, attn_head_norm, conv_w, conv_b,
              b_igate, b_fgate, mlstm_head_norm, w_out, ffn2_norm, ffn2_w_gate,
              ffn2_w_up, ffn2_w_down, final_norm):
    B, S, _ = x.shape
    split_idx = list(np.cumsum(SPLIT_SIZES)[:-1])
    for l in range(DEPTH):
        x = x + 0.5 * swiglu(rmsnorm(x, ffn1_norm[l]), ffn1_w_gate[l], ffn1_w_up[l], ffn1_w_down[l])

        h = rmsnorm(x, mix_norm[l])
        a_q, a_k, a_v, m_q, m_k, m_v, m_o, m_i, m_f = jnp.split(h @ w_in[l], split_idx, axis=-1)

        lam_init = 0.8 - 0.6 * math.exp(-0.3 * l)
        lam = (jnp.exp(jnp.sum(lam_q1[l].astype(jnp.float32) * lam_k1[l].astype(jnp.float32)))
               - jnp.exp(jnp.sum(lam_q2[l].astype(jnp.float32) * lam_k2[l].astype(jnp.float32)))
               + lam_init)
        y_a = diff_attention(
            a_q.reshape(B, S, A_HEADS, 2, A_HEAD_DIM),
            a_k.reshape(B, S, A_HEADS, 2, A_HEAD_DIM),
            a_v.reshape(B, S, A_HEADS, A_VDIM),
            lam, attn_head_norm[l], lam_init)

        qk = jax.nn.silu(causal_dwconv(jnp.concatenate([m_q, m_k], axis=-1), conv_w[l], conv_b[l]))
        mq, mk = jnp.split(qk, 2, axis=-1)
        i_pre = m_i.astype(jnp.float32) + b_igate[l].astype(jnp.float32)
        f_pre = m_f.astype(jnp.float32) + b_fgate[l].astype(jnp.float32)
        i_pre = GATE_CAP * jnp.tanh(i_pre / GATE_CAP)
        f_pre = GATE_CAP * jnp.tanh(f_pre / GATE_CAP)
        hm = mlstm_chunkwise(
            mq.reshape(B, S, M_HEADS, M_QK_DIM),
            mk.reshape(B, S, M_HEADS, M_QK_DIM),
            m_v.reshape(B, S, M_HEADS, M_VDIM),
            i_pre, f_pre)
        hm = rmsnorm(hm, mlstm_head_norm[l]).reshape(B, S, M_WIDTH).astype(x.dtype)
        y_b = hm * jax.nn.sigmoid(m_o)

        x = x + jnp.concatenate([y_a, y_b], axis=-1) @ w_out[l]

        x = x + 0.5 * swiglu(rmsnorm(x, ffn2_norm[l]), ffn2_w_gate[l], ffn2_w_up[l], ffn2_w_down[l])
    return rmsnorm(x, final_norm)
```

```cpp
#include <hip/hip_runtime.h>
#include <hip/hip_bf16.h>
#include <hip/hip_cooperative_groups.h>
#include <cstdio>
#include <cstdint>
namespace cg = cooperative_groups;

#ifndef MK_SPLIT
#define MK_SPLIT 0
#endif

namespace pg8 {
#define PG8_LAS __attribute__((address_space(3)))
typedef unsigned short bf16_t;
typedef short bf16x8 __attribute__((ext_vector_type(8)));
typedef float f32x4 __attribute__((ext_vector_type(4)));
typedef unsigned u32x4 __attribute__((ext_vector_type(4)));
constexpr int BM = 256, BK = 64, HALF = 128, HTB = HALF * BK * 2  , STAGE_BYTES = 8 * HTB, NXCD = 8, WGM = 8;

__host__ __device__ __forceinline__ int lds_byte(int r, int c) { const int st = (r >> 4) * 2 + (c >> 5), rr = r & 15, cc = c & 31, ob = rr * 64 + cc * 2; return st * 1024 + (ob ^ (((ob >> 9) & 1) << 5)); }
__host__ __device__ __forceinline__ void stage_rc(int b, int& R, int& C) { const int st = b / 1024, sb = b % 1024, swz = sb ^ (((sb >> 9) & 1) << 5); R = (st >> 1) * 16 + swz / 64; C = (st & 1) * 32 + (swz % 64) / 2; }
__host__ __device__ __forceinline__ int perm32(int rho) { const int n = rho >> 4, i = rho & 15; return 8 * (i >> 2) + 4 * n + (i & 3); }

struct Unit { int pm, pn; };
struct Gemm { const bf16_t* A; const bf16_t* Bt; int M, N, K; };

struct StaticOrder {
    int nM, nN, nwg, G, c;
    __host__ __device__ void init(int M, int N, int G_, int c_) { nM = M / BM; nN = N / BM; nwg = nM * nN; G = G_; c = c_; }
    __host__ __device__ bool next(int i, Unit& u) const {
        const long L = (long)i * G + c; if (L >= nwg) return false;
        int wgid = (int)L; { const int q = nwg / NXCD, r = nwg % NXCD, xcd = wgid % NXCD, off = wgid / NXCD; wgid = (xcd < r ? xcd * (q + 1) : r * (q + 1) + (xcd - r) * q) + off; }
        const int nig = WGM * nN, gid = wgid / nig, fm = gid * WGM, gsz = (nM - fm) < WGM ? (nM - fm) : WGM;
        u.pm = fm + ((wgid % nig) % gsz); u.pn = (wgid % nig) / gsz; return true;
    }
    __device__ __forceinline__ void a_ready(const Unit&) const {}
    __device__ __forceinline__ void done(const Unit&) const {}
};

__device__ __forceinline__ unsigned cvt_pk_bf16(float lo, float hi) { unsigned r; asm volatile("v_cvt_pk_bf16_f32 %0, %1, %2" : "=v"(r) : "v"(lo), "v"(hi)); return r; }

constexpr float RMS_EPS = 1e-6f;
__device__ __forceinline__ float silu_f(float x) { return x * __builtin_amdgcn_rcpf(1.0f + __builtin_amdgcn_exp2f(-1.4426950408889634f * x)); }
struct EpiSwiGLU {
    static constexpr bool PERM = true, AFTER_DRAIN = false;
    bf16_t* O; int ldo; const float* rowss; float inv_n;
    __device__ __forceinline__ void operator()(const f32x4 (&acc)[2][2][4][2], const Unit& u, int wr, int wc, int fr, int fq) const {
        const int row0 = u.pm * BM + wr * 64 + fr, col0 = u.pn * HALF + wc * 32 + 8 * fq;
#pragma unroll
        for (int ai = 0; ai < 2; ++ai)
#pragma unroll
            for (int m = 0; m < 4; ++m) {
                const int r = row0 + ai * HALF + m * 16;
                const float rs = rowss ? __builtin_amdgcn_rsqf(rowss[r] * inv_n + RMS_EPS) : 1.0f;
                const f32x4 g0 = acc[ai][0][m][0] * rs, g1 = acc[ai][0][m][1] * rs, u0 = acc[ai][1][m][0] * rs, u1 = acc[ai][1][m][1] * rs;
                u32x4 w;
                w.x = cvt_pk_bf16(silu_f(g0[0]) * u0[0], silu_f(g0[1]) * u0[1]); w.y = cvt_pk_bf16(silu_f(g0[2]) * u0[2], silu_f(g0[3]) * u0[3]);
                w.z = cvt_pk_bf16(silu_f(g1[0]) * u1[0], silu_f(g1[1]) * u1[1]); w.w = cvt_pk_bf16(silu_f(g1[2]) * u1[2], silu_f(g1[3]) * u1[3]);
                *(u32x4*)(O + (size_t)r * ldo + col0) = w;
            }
    }
};
struct EpiResid {
    static constexpr bool PERM = false, AFTER_DRAIN = false;
    const float* resid; float* out; bf16_t* xb; float* rowss; float alpha; int ld;
    __device__ __forceinline__ void operator()(const f32x4 (&acc)[2][2][4][2], const Unit& u, int wr, int wc, int fr, int fq) const {
        typedef unsigned u32x2v __attribute__((ext_vector_type(2)));
        const int row0 = u.pm * BM + wr * 64 + fr, col0 = u.pn * BM + wc * 32 + 4 * fq;
#pragma unroll
        for (int ai = 0; ai < 2; ++ai)
#pragma unroll
            for (int m = 0; m < 4; ++m) {
                const int r = row0 + ai * HALF + m * 16; float ss = 0.f;
#pragma unroll
                for (int bj = 0; bj < 2; ++bj)
#pragma unroll
                    for (int n = 0; n < 2; ++n) {
                        const size_t off = (size_t)r * ld + col0 + bj * HALF + n * 16;
                        const f32x4 b = *(const f32x4*)(resid + off); const f32x4 o = b + acc[ai][bj][m][n] * alpha;
                        *(f32x4*)(out + off) = o; ss += (o[0] * o[0] + o[1] * o[1]) + (o[2] * o[2] + o[3] * o[3]);
                        if (xb) { u32x2v w; w.x = cvt_pk_bf16(o[0], o[1]); w.y = cvt_pk_bf16(o[2], o[3]); *(u32x2v*)(xb + off) = w; }
                    }
                if (rowss) { ss += __shfl_xor(ss, 16); ss += __shfl_xor(ss, 32); if (fq == 0) atomicAdd(rowss + r, ss); }
            }
    }
};
struct EpiProj {
    static constexpr bool PERM = true, AFTER_DRAIN = false;
    bf16_t* O; const float* rowss; float inv_n;
    __device__ __forceinline__ void operator()(const f32x4 (&acc)[2][2][4][2], const Unit& u, int wr, int wc, int fr, int fq) const {
        const int row0 = u.pm * BM + wr * 64 + fr;
        {
            const bool dense = u.pn < 12;
            const size_t rstride = dense ? 128 : 3072;
            bf16_t* base = dense ? O + (size_t)(2 * u.pn) * ((size_t)16384 * 128) + wc * 32 + 8 * fq : O + (size_t)24 * 16384 * 128 + (u.pn - 12) * BM + wc * 32 + 8 * fq;
            const size_t bjstep = dense ? (size_t)16384 * 128 : 128;
#pragma unroll
            for (int ai = 0; ai < 2; ++ai)
#pragma unroll
                for (int m = 0; m < 4; ++m) {
                    const int r = row0 + ai * HALF + m * 16; const float rs = __builtin_amdgcn_rsqf(rowss[r] * inv_n + RMS_EPS);
#pragma unroll
                    for (int bj = 0; bj < 2; ++bj) { const f32x4 v0 = acc[ai][bj][m][0] * rs, v1 = acc[ai][bj][m][1] * rs; u32x4 w;
                        w.x = cvt_pk_bf16(v0[0], v0[1]); w.y = cvt_pk_bf16(v0[2], v0[3]); w.z = cvt_pk_bf16(v1[0], v1[1]); w.w = cvt_pk_bf16(v1[2], v1[3]);
                        *(u32x4*)(base + (size_t)r * rstride + bj * bjstep) = w; }
                }
        }
    }
};
template <class Epi, class Sched, bool ALIGN_EPI = false, bool SP2 = false>
__device__ __forceinline__ void gemm_phase(PG8_LAS unsigned char* lds, const Gemm g, const Sched& S, const Epi& E, const int mk_wave) {
    const int lane = (int)(__builtin_amdgcn_mbcnt_hi(~0u, __builtin_amdgcn_mbcnt_lo(~0u, 0u)) & 63u), wid = mk_wave & 7, tid = wid * 64 + lane, wr = wid >> 2, wc = wid & 3, fr = lane & 15, fq = lane >> 4;
    const int K = g.K, nt = K / BK;
    unsigned voffA[2], voffB[2];
#pragma unroll
    for (int i = 0; i < 2; ++i) { int R, C; stage_rc(tid * 16 + i * 8192, R, C); const int Rb = Epi::PERM ? ((R & ~31) + perm32(R & 31)) : R;
        voffA[i] = (unsigned)(R * K + C) * 2u; voffB[i] = (unsigned)(Rb * K + C) * 2u; }
    const size_t kstep = (size_t)(BK * 2);
    const size_t hstep = (size_t)HALF * K * 2;
    const size_t tstep = 2 * hstep;
    const unsigned ldsw = (unsigned)wid * 1024u;
    const int aoff = lds_byte(wr * 64 + fr, fq * 8), boff = lds_byte(wc * 32 + fr, fq * 8);
#define PG8_SA(b, h) (((b) * 2 + (h)) * HTB)
#define PG8_SB(b, h) ((4 + (b) * 2 + (h)) * HTB)
#define PG8_STAGE(bufoff, gbase, voff) do { _Pragma("unroll") for (int _i = 0; _i < 2; ++_i) \
        __builtin_amdgcn_global_load_lds((const unsigned*)((const char*)(gbase) + (voff)[_i]), (PG8_LAS unsigned*)(lds + (bufoff) + ldsw + _i * 8192), 16, 0, 0); } while (0)
#define PG8_LDA(dst, b, h) do { _Pragma("unroll") for (int m = 0; m < 4; ++m) _Pragma("unroll") for (int k = 0; k < 2; ++k) dst[m][k] = *(const PG8_LAS bf16x8*)(lds + PG8_SA(b, h) + aoff + m * 2048 + k * 1024); } while (0)
#define PG8_LDB(dst, b, h) do { _Pragma("unroll") for (int n = 0; n < 2; ++n) _Pragma("unroll") for (int k = 0; k < 2; ++k) dst[n][k] = *(const PG8_LAS bf16x8*)(lds + PG8_SB(b, h) + boff + n * 2048 + k * 1024); } while (0)
#define PG8_MMA(ai, bj, At, Bt) do { __builtin_amdgcn_s_setprio(1); _Pragma("unroll") for (int m = 0; m < 4; ++m) _Pragma("unroll") for (int n = 0; n < 2; ++n) _Pragma("unroll") for (int k = 0; k < 2; ++k) \
        acc[ai][bj][m][n] = __builtin_amdgcn_mfma_f32_16x16x32_bf16(Bt[n][k], At[m][k], acc[ai][bj][m][n], 0, 0, 0); __builtin_amdgcn_s_setprio(0); } while (0)
#define PG8_WAIT_V(n) asm volatile("s_waitcnt vmcnt(" #n ")" ::: "memory")
#define PG8_WAIT_L(n) asm volatile("s_waitcnt lgkmcnt(" #n ")" ::: "memory")
#define PG8_BAR __builtin_amdgcn_s_barrier()
#define PG8_SCHED __builtin_amdgcn_sched_barrier(0)
    Unit cur, nxt; int ui = 0;
    if (!S.next(0, cur)) return;
    f32x4 acc[2][2][4][2];
#pragma unroll
    for (int a = 0; a < 2; ++a)
#pragma unroll
        for (int b = 0; b < 2; ++b)
#pragma unroll
            for (int m = 0; m < 4; ++m)
#pragma unroll
                for (int n = 0; n < 2; ++n) acc[a][b][m][n] = (f32x4){0.f, 0.f, 0.f, 0.f};
    bf16x8 At[4][2], B0[2][2], B1[2][2];
    const char* cA = (const char*)g.A + (size_t)cur.pm * tstep; const char* cB = (const char*)g.Bt + (size_t)cur.pn * tstep;
    S.a_ready(cur);
    if constexpr (SP2) {
        PG8_STAGE(PG8_SB(0, 0), cB, voffB); PG8_STAGE(PG8_SB(0, 1), cB + hstep, voffB); PG8_STAGE(PG8_SA(0, 0), cA, voffA); PG8_STAGE(PG8_SA(0, 1), cA + hstep, voffA);
        if (wr == 1) PG8_BAR;
        PG8_WAIT_V(2); PG8_BAR;
        PG8_STAGE(PG8_SB(1, 0), cB + kstep, voffB); PG8_STAGE(PG8_SA(1, 0), cA + kstep, voffA); PG8_STAGE(PG8_SB(1, 1), cB + hstep + kstep, voffB);
        PG8_WAIT_V(6); PG8_BAR;
    } else {
        PG8_STAGE(PG8_SB(0, 0), cB, voffB); PG8_STAGE(PG8_SA(0, 0), cA, voffA); PG8_STAGE(PG8_SB(0, 1), cB + hstep, voffB); PG8_STAGE(PG8_SA(0, 1), cA + hstep, voffA);
        if (wr == 1) PG8_BAR;
        PG8_WAIT_V(4); PG8_BAR;
        PG8_STAGE(PG8_SB(1, 0), cB + kstep, voffB); PG8_STAGE(PG8_SA(1, 0), cA + kstep, voffA); PG8_STAGE(PG8_SB(1, 1), cB + hstep + kstep, voffB);
        PG8_WAIT_V(6); PG8_BAR;
    }
    for (;;) {
        const bool has_next = S.next(ui + 1, nxt);
        const char* nA = has_next ? (const char*)g.A + (size_t)nxt.pm * tstep : cA; const char* nB = has_next ? (const char*)g.Bt + (size_t)nxt.pn * tstep : cB;
        for (int t = 0; t < nt; t += 2) {
            const bool last = (t == nt - 2);
            const char* a1 = cA + (size_t)(t + 1) * kstep;
            const char* a2 = last ? nA : cA + (size_t)(t + 2) * kstep; const char* b2 = last ? nB : cB + (size_t)(t + 2) * kstep;
            const char* a3 = a2 + kstep; const char* b3 = b2 + kstep;
            if (last && has_next) S.a_ready(nxt);
            if constexpr (SP2) {
            PG8_LDB(B0, 0, 0); PG8_LDB(B1, 0, 1); PG8_SCHED; PG8_LDA(At, 0, 0); PG8_STAGE(PG8_SA(1, 1), a1 + hstep, voffA);
            PG8_WAIT_V(8); PG8_WAIT_L(0); PG8_BAR; PG8_MMA(0, 0, At, B0); PG8_MMA(0, 1, At, B1); PG8_BAR; PG8_SCHED;
            PG8_LDA(At, 0, 1); PG8_STAGE(PG8_SB(0, 0), b2, voffB); PG8_STAGE(PG8_SB(0, 1), b2 + hstep, voffB); PG8_STAGE(PG8_SA(0, 0), a2, voffA);
            PG8_WAIT_V(8); PG8_WAIT_L(0); PG8_BAR; PG8_MMA(1, 0, At, B0); PG8_MMA(1, 1, At, B1); PG8_BAR; PG8_SCHED;
            PG8_LDB(B0, 1, 0); PG8_LDB(B1, 1, 1); PG8_SCHED; PG8_LDA(At, 1, 0); PG8_STAGE(PG8_SA(0, 1), a2 + hstep, voffA);
            PG8_WAIT_V(8); PG8_WAIT_L(0); PG8_BAR; PG8_MMA(0, 0, At, B0); PG8_MMA(0, 1, At, B1); PG8_BAR; PG8_SCHED;
            PG8_LDA(At, 1, 1); PG8_STAGE(PG8_SB(1, 0), b3, voffB); PG8_STAGE(PG8_SB(1, 1), b3 + hstep, voffB); PG8_STAGE(PG8_SA(1, 0), a3, voffA);
            PG8_WAIT_V(8); PG8_WAIT_L(0); PG8_BAR; PG8_MMA(1, 0, At, B0); PG8_MMA(1, 1, At, B1); PG8_BAR; PG8_SCHED;
            } else {
            PG8_LDB(B0, 0, 0); PG8_SCHED; PG8_LDA(At, 0, 0); PG8_STAGE(PG8_SA(1, 1), a1 + hstep, voffA);
            PG8_WAIT_L(8); PG8_BAR; PG8_WAIT_L(0); PG8_MMA(0, 0, At, B0); PG8_BAR; PG8_SCHED;
            PG8_LDB(B1, 0, 1); PG8_STAGE(PG8_SB(0, 0), b2, voffB);
            PG8_BAR; PG8_WAIT_L(0); PG8_MMA(0, 1, At, B1); PG8_BAR;
            PG8_LDA(At, 0, 1); PG8_STAGE(PG8_SA(0, 0), a2, voffA);
            PG8_BAR; PG8_WAIT_L(0); PG8_MMA(1, 0, At, B0); PG8_BAR; PG8_SCHED;
            PG8_STAGE(PG8_SB(0, 1), b2 + hstep, voffB);
            PG8_WAIT_V(6); PG8_BAR; PG8_MMA(1, 1, At, B1); PG8_BAR;
            PG8_LDB(B0, 1, 0); PG8_SCHED; PG8_LDA(At, 1, 0); PG8_STAGE(PG8_SA(0, 1), a2 + hstep, voffA);
            PG8_WAIT_L(8); PG8_BAR; PG8_WAIT_L(0); PG8_MMA(0, 0, At, B0); PG8_BAR; PG8_SCHED;
            PG8_LDB(B1, 1, 1); PG8_STAGE(PG8_SB(1, 0), b3, voffB);
            PG8_BAR; PG8_WAIT_L(0); PG8_MMA(0, 1, At, B1); PG8_BAR;
            PG8_LDA(At, 1, 1); PG8_STAGE(PG8_SA(1, 0), a3, voffA);
            PG8_BAR; PG8_WAIT_L(0); PG8_MMA(1, 0, At, B0); PG8_BAR; PG8_SCHED;
            PG8_STAGE(PG8_SB(1, 1), b3 + hstep, voffB);
            PG8_WAIT_V(6); PG8_BAR; PG8_MMA(1, 1, At, B1); PG8_BAR;
            }
        }
        if constexpr (ALIGN_EPI) { if (wr == 0) PG8_BAR; }
        if constexpr (!Epi::AFTER_DRAIN) { E(acc, cur, wr, wc, fr, fq); S.done(cur); }
        if (!has_next) break;
#pragma unroll
        for (int a = 0; a < 2; ++a)
#pragma unroll
            for (int b = 0; b < 2; ++b)
#pragma unroll
                for (int m = 0; m < 4; ++m)
#pragma unroll
                    for (int n = 0; n < 2; ++n) acc[a][b][m][n] = (f32x4){0.f, 0.f, 0.f, 0.f};
        cur = nxt; cA = nA; cB = nB; ++ui;
        if constexpr (ALIGN_EPI) { if (wr == 1) PG8_BAR; }
    }
    PG8_WAIT_V(0);
    if constexpr (!ALIGN_EPI) { if (wr == 0) PG8_BAR; }
    PG8_BAR;
    if constexpr (Epi::AFTER_DRAIN) { E.fused(acc, cur, wr, wc, fr, fq, lds, wid, lane); S.done(cur); }
#undef PG8_SA
#undef PG8_SB
#undef PG8_STAGE
#undef PG8_LDA
#undef PG8_LDB
#undef PG8_MMA
#undef PG8_WAIT_V
#undef PG8_WAIT_L
#undef PG8_BAR
#undef PG8_SCHED
}
}

namespace att {
constexpr int D = 128; constexpr float THR = 8.f; constexpr bool WSKIP = false; constexpr int LDP = 128, LDO = 2048;
constexpr float SCALE = 0.08838834764831845f;
constexpr int NW = 8, QBLK = 32, KVBLK = 64, QB = NW * QBLK;
constexpr int SHM_V = KVBLK * D * 2, SHM_K = KVBLK * D * 2;
constexpr int LDS_BYTES = 2 * SHM_V + 2 * SHM_K + NW * 64 * 4;

using bf16 = __hip_bfloat16;
typedef short bf16x8 __attribute__((ext_vector_type(8)));
typedef short s16x4 __attribute__((ext_vector_type(4)));
typedef float f32x16 __attribute__((ext_vector_type(16)));
typedef float f32x4 __attribute__((ext_vector_type(4)));
typedef unsigned u32x4 __attribute__((ext_vector_type(4)));
template <class A, class Bt> struct same_t { static constexpr bool v = false; };
template <class A> struct same_t<A, A> { static constexpr bool v = true; };

#define KSWZ(row, colB) ((row) * 256 + ((colB) ^ (((row) & 7) << 4)))
#define SBAR() __builtin_amdgcn_sched_barrier(0)
__device__ __forceinline__ int v_st(int k, int c) { const int kk = (k & ~0xC) | ((k & 4) << 1) | ((k & 8) >> 1); return ((kk >> 3) * 4 + (c >> 5)) * 512 + ((kk & 7) * 32 + (c & 31)) * 2; }
__device__ __forceinline__ int v_rd_base(int lane) { return ((lane & 3) << 3) | (((lane >> 2) & 3) << 6) | (((lane >> 4) & 1) << 5) | (((lane >> 5) & 1) << 8); }
constexpr int v_rd_off(int d0, int ks, int half) { return d0 * 512 + ks * 4096 + half * 2048; }
__device__ __forceinline__ int crow(int r, int hi) { return (r & 3) + 8 * (r >> 2) + 4 * hi; }
__device__ __forceinline__ unsigned cvtpk(float lo, float hi) {
    unsigned r; asm volatile("v_cvt_pk_bf16_f32 %0, %1, %2" : "=v"(r) : "v"(lo), "v"(hi)); return r;
}
__device__ __forceinline__ bf16x8 pack8(f32x4 a, f32x4 b) {
    u32x4 w = {cvtpk(a[0], a[1]), cvtpk(a[2], a[3]), cvtpk(b[0], b[1]), cvtpk(b[2], b[3])};
    return *reinterpret_cast<bf16x8*>(&w);
}
template <class T> __device__ __forceinline__ bf16x8 load8(const T* p) {
    if constexpr (same_t<T, float>::v) { return pack8(*(const f32x4*)p, *(const f32x4*)(p + 4)); }
    else { return *reinterpret_cast<const bf16x8*>(p); }
}
__device__ __forceinline__ void mask_tile(f32x16& p0, f32x16& p1, int dq, unsigned W) {
    const float NEG = -__builtin_inff();
#pragma unroll
    for (int r = 0; r < 16; ++r) {
        const int c = (r & 3) + 8 * (r >> 2);
        if ((unsigned)(dq - c) >= W) p0[r] = NEG;
        if ((unsigned)(dq - c - 32) >= W) p1[r] = NEG;
    }
}
__device__ __forceinline__ void partialSM(f32x16& p0, f32x16& p1, float& m_reg, float& mn, float& alpha) {
    float pmax = p0[0]; for (int r = 1; r < 16; ++r) pmax = fmaxf(pmax, p0[r]); for (int r = 0; r < 16; ++r) pmax = fmaxf(pmax, p1[r]);
    { auto rr = __builtin_amdgcn_permlane32_swap(__float_as_uint(pmax), __float_as_uint(pmax), false, false);
      pmax = fmaxf(__uint_as_float(rr[0]), __uint_as_float(rr[1])); }
    constexpr float C2 = 1.4426950408889634f * SCALE;
    if (__builtin_expect(__all((pmax - m_reg) * SCALE <= THR), 1)) { mn = m_reg; alpha = 1.f; }
    else { mn = fmaxf(m_reg, pmax); alpha = __builtin_amdgcn_exp2f((m_reg - mn) * C2); m_reg = mn; }
    const float mnL = -mn * C2;
    for (int r = 0; r < 16; ++r) p0[r] = fmaf(p0[r], C2, mnL); for (int r = 0; r < 16; ++r) p1[r] = fmaf(p1[r], C2, mnL);
    for (int r = 0; r < 16; ++r) p0[r] = __builtin_amdgcn_exp2f(p0[r]);
}
__device__ __forceinline__ void finishSM(f32x16& p0, f32x16& p1, float alpha, float& l_reg, bf16x8& pa0, bf16x8& pa1, bf16x8& pa2, bf16x8& pa3) {
    for (int r = 0; r < 16; ++r) p1[r] = __builtin_amdgcn_exp2f(p1[r]);
    float ps = 0; for (int r = 0; r < 16; ++r) ps += p0[r]; for (int r = 0; r < 16; ++r) ps += p1[r];
    { auto rr = __builtin_amdgcn_permlane32_swap(__float_as_uint(ps), __float_as_uint(ps), false, false);
      ps = __uint_as_float(rr[0]) + __uint_as_float(rr[1]); }
    l_reg = l_reg * alpha + ps;
#define PK4(P, B_, OUT) do { unsigned a0 = cvtpk(P[B_+0], P[B_+1]), a1 = cvtpk(P[B_+2], P[B_+3]);                          \
        unsigned b0 = cvtpk(P[B_+4], P[B_+5]), b1 = cvtpk(P[B_+6], P[B_+7]);                                             \
        auto r0 = __builtin_amdgcn_permlane32_swap(a0, b0, false, false); auto r1 = __builtin_amdgcn_permlane32_swap(a1, b1, false, false); \
        u32x4 w = {r0[0], r1[0], r0[1], r1[1]}; OUT = *reinterpret_cast<bf16x8*>(&w); } while (0)
    PK4(p0, 0, pa0); PK4(p0, 8, pa1); PK4(p1, 0, pa2); PK4(p1, 8, pa3);
#undef PK4
}
template <int KB, bool SK>
__device__ __forceinline__ void qkt(f32x16& p0, f32x16& p1, const char* K_lds, int r32, int hi, const bf16x8* qr, bool act) {
    if (SK && !act) { const float NEG = -__builtin_inff();
#pragma unroll
        for (int r = 0; r < 16; ++r) { p0[r] = NEG; p1[r] = NEG; } return; }
    p0 = f32x16{}; p1 = f32x16{};
    const char* kb[4];
#pragma unroll
    for (int dd = 0; dd < 4; ++dd) kb[dd] = K_lds + KB * SHM_K + KSWZ(r32, (dd * 16 + hi * 8) * 2);
#pragma unroll
    for (int d0 = 0; d0 < 8; ++d0) { const char* a = kb[d0 & 3] + (d0 >> 2) * 128;
        bf16x8 b0 = *reinterpret_cast<const bf16x8*>(a);
        bf16x8 b1 = *reinterpret_cast<const bf16x8*>(a + 32 * 256);
        p0 = __builtin_amdgcn_mfma_f32_32x32x16_bf16(b0, qr[d0], p0, 0, 0, 0);
        p1 = __builtin_amdgcn_mfma_f32_32x32x16_bf16(b1, qr[d0], p1, 0, 0, 0); }
}
template <int VB, bool SK>
__device__ __forceinline__ void pv_tile(f32x16* o, int vb0, bf16x8 pa0, bf16x8 pa1, bf16x8 pa2, bf16x8 pa3, bool act) {
    if (SK && !act) return;
#define TRRD(dst, off) asm volatile("ds_read_b64_tr_b16 %0, %1 offset:%2" : "=&v"(dst) : "v"(vb0), "i"(off) : "memory")
#define PV_D0(d0) do { s16x4 l0, l1, l2, l3, h0, h1, h2, h3; constexpr int b_ = VB * SHM_V + v_rd_off(d0, 0, 0);     \
        TRRD(l0, b_); TRRD(h0, b_ + 2048); TRRD(l1, b_ + 4096); TRRD(h1, b_ + 6144); TRRD(l2, b_ + 8192); TRRD(h2, b_ + 10240); TRRD(l3, b_ + 12288); TRRD(h3, b_ + 14336); \
        asm volatile("s_waitcnt lgkmcnt(0)" ::: "memory"); SBAR();                 \
        o[d0] = __builtin_amdgcn_mfma_f32_32x32x16_bf16(pa0, (bf16x8){l0[0], l0[1], l0[2], l0[3], h0[0], h0[1], h0[2], h0[3]}, o[d0], 0, 0, 0);   \
        o[d0] = __builtin_amdgcn_mfma_f32_32x32x16_bf16(pa1, (bf16x8){l1[0], l1[1], l1[2], l1[3], h1[0], h1[1], h1[2], h1[3]}, o[d0], 0, 0, 0);   \
        o[d0] = __builtin_amdgcn_mfma_f32_32x32x16_bf16(pa2, (bf16x8){l2[0], l2[1], l2[2], l2[3], h2[0], h2[1], h2[2], h2[3]}, o[d0], 0, 0, 0);   \
        o[d0] = __builtin_amdgcn_mfma_f32_32x32x16_bf16(pa3, (bf16x8){l3[0], l3[1], l3[2], l3[3], h3[0], h3[1], h3[2], h3[3]}, o[d0], 0, 0, 0); } while (0)
    PV_D0(0); PV_D0(1); PV_D0(2); PV_D0(3);
#undef PV_D0
#undef TRRD
}

template <class TIn, class TOut> struct BlockRef { const TIn* Q; const TIn* K; const TIn* V; TOut* O; int P0; };
template <class TIn> struct Seam {
    bf16x8 qr[8];
    bf16x8 st_v0, st_v1, st_k0, st_k1; f32x4 sf0, sf1, sf2, sf3;
    f32x4 tq[16];
};
__device__ __forceinline__ int swa_jlo(int P0, int W) { const int lowk = P0 - W + 1; return lowk > 0 ? lowk / KVBLK : 0; }
#define ROW(p, k0, rr) ((p) + (size_t)((k0) + (rr)) * LDP + sc)
#define VMW() asm volatile("s_waitcnt vmcnt(0)" ::: "memory")
#define VMWN(n) asm volatile("s_waitcnt vmcnt(%0)" :: "i"(n) : "memory")
#define SLOAD_H(Kp, Vp, k0) do { S.st_v0 = load8<TIn>(ROW(Vp, k0, sr)); S.st_v1 = load8<TIn>(ROW(Vp, k0, 32 + sr));              \
                         S.st_k0 = load8<TIn>(ROW(Kp, k0, sr)); S.st_k1 = load8<TIn>(ROW(Kp, k0, 32 + sr)); } while (0)
#define SWRITE_HK(bf) do { *(bf16x8*)(K_lds + (bf) * SHM_K + kws) = S.st_k0; *(bf16x8*)(K_lds + (bf) * SHM_K + kws + 32 * 256) = S.st_k1; } while (0)
#define SWRITE_HV(bf) do { *(bf16x8*)(V_lds + (bf) * SHM_V + vst0) = S.st_v0; *(bf16x8*)(V_lds + (bf) * SHM_V + vst1) = S.st_v1; } while (0)
#define SWRITE_H(bf) do { SWRITE_HV(bf); SWRITE_HK(bf); } while (0)
#define SLOAD_F(p, k0) do { S.sf0 = *(const f32x4*)ROW(p, k0, sr); S.sf1 = *(const f32x4*)(ROW(p, k0, sr) + 4);                \
                            S.sf2 = *(const f32x4*)ROW(p, k0, 32 + sr); S.sf3 = *(const f32x4*)(ROW(p, k0, 32 + sr) + 4); } while (0)
#define SWRITE_KF(bf) do { *(bf16x8*)(K_lds + (bf) * SHM_K + kws) = pack8(S.sf0, S.sf1); *(bf16x8*)(K_lds + (bf) * SHM_K + kws + 32 * 256) = pack8(S.sf2, S.sf3); } while (0)
#define SWRITE_VF(bf) do { *(bf16x8*)(V_lds + (bf) * SHM_V + vst0) = pack8(S.sf0, S.sf1); *(bf16x8*)(V_lds + (bf) * SHM_V + vst1) = pack8(S.sf2, S.sf3); } while (0)
template <class TIn, class TOut>
__device__ __forceinline__ void causal_swa_prime(const BlockRef<TIn, TOut>& cur, int W, char* lds, Seam<TIn>& S, const int mk_wave) {
    constexpr bool F32 = same_t<TIn, float>::v;
    const int lane = (int)(__builtin_amdgcn_mbcnt_hi(~0u, __builtin_amdgcn_mbcnt_lo(~0u, 0u)) & 63u), wid = mk_wave & 7, tid = wid * 64 + lane, r32 = lane & 31, hi = lane >> 5;
    const int sr = tid >> 4, sc = (tid & 15) * 8, kws = KSWZ(sr, sc * 2); char* K_lds = lds + 2 * SHM_V;
    const int kb0 = swa_jlo(cur.P0, W) * KVBLK;
    for (int d0 = 0; d0 < 8; ++d0) S.qr[d0] = load8<TIn>(cur.Q + (size_t)(wid * QBLK + r32) * LDP + d0 * 16 + hi * 8);
    if constexpr (F32) { SLOAD_F((const float*)cur.K, kb0); VMW(); SWRITE_KF(0); SBAR(); SLOAD_F((const float*)cur.V, kb0); }
    else { SLOAD_H(cur.K, cur.V, kb0); VMW(); SWRITE_HK(0); }
    __syncthreads();
}
template <class TIn, class TOut>
__device__ __forceinline__ void causal_swa_block(const BlockRef<TIn, TOut>& cur, const BlockRef<TIn, TOut>& nxt, int skv, int W, char* lds, Seam<TIn>& S, const int mk_wave) {
    constexpr bool F32 = same_t<TIn, float>::v;
    const int lane = (int)(__builtin_amdgcn_mbcnt_hi(~0u, __builtin_amdgcn_mbcnt_lo(~0u, 0u)) & 63u), wid = mk_wave & 7, tid = wid * 64 + lane, r32 = lane & 31, hi = lane >> 5;
    const int j_lo = swa_jlo(cur.P0, W);
    int j_hi = (cur.P0 + QB - 1) / KVBLK + 1; if (j_hi > skv / KVBLK) j_hi = skv / KVBLK;
    const int NT = j_hi - j_lo;
    const int kbn = swa_jlo(nxt.P0, W) * KVBLK;
    const int qlo = cur.P0 + wid * QBLK, qm = qlo + r32 - 4 * hi;
    char* V_lds = lds; char* K_lds = lds + 2 * SHM_V;
    float* ws = (float*)(lds + 2 * SHM_V + 2 * SHM_K) + wid * 64; float* li_l = ws, * al_l = ws + 32;
    float m_reg = -1e30f, l_reg = 0; f32x16 o[4] = {};
    const int sr = tid >> 4, sc = (tid & 15) * 8, vst0 = v_st(sr, sc), vst1 = v_st(32 + sr, sc), kws = KSWZ(sr, sc * 2);
    const int vb0 = (int)(uintptr_t)V_lds + v_rd_base(lane);
    const TIn* Kh = cur.K; const TIn* Vh = cur.V;
#define RESC(a) do { if (__any((a) < 1.f)) { if (hi == 0) al_l[r32] = (a); asm volatile("s_waitcnt lgkmcnt(0)" ::: "memory");              \
                     for (int d_ = 0; d_ < 4; ++d_) for (int r = 0; r < 16; ++r) o[d_][r] *= al_l[crow(r, hi)]; } } while (0)
#define KBASE(t) ((j_lo + (t)) * KVBLK)
#define ACT(t) (KBASE(t) <= qlo + QBLK - 1 && KBASE(t) + KVBLK - 1 >= qlo - W + 1)
#define MASKT(P0_, P1_, t) do { const int kb_ = KBASE(t); if ((!SK || ACT(t)) && (kb_ + KVBLK - 1 > qlo || kb_ <= qlo + QBLK - 1 - W)) mask_tile(P0_, P1_, qm - kb_, (unsigned)W); } while (0)
    constexpr int NQL = F32 ? 16 : 8;
    constexpr bool SK = WSKIP && !F32;
#define SEAM_K0() do { VMWN(NQL); if constexpr (F32) { SWRITE_KF(0); SBAR(); SLOAD_F((const float*)nxt.V, kbn); } else { SWRITE_HK(0); } SBAR(); } while (0)
    f32x16 pA0, pA1, pB0, pB1; float mnA, mnB, alA, alB; bf16x8 pa0, pa1, pa2, pa3;
    if constexpr (F32) { VMW(); SWRITE_VF(0); SBAR(); } else { SWRITE_HV(0); SBAR(); }
    if (NT > 1) { if constexpr (F32) SLOAD_F((const float*)Kh, KBASE(1)); else SLOAD_H(Kh, Vh, KBASE(1)); }
    SBAR(); qkt<0, SK>(pA0, pA1, K_lds, r32, hi, S.qr, ACT(0));
    if constexpr (F32) { if (NT > 1) { VMW(); SWRITE_KF(1); SBAR(); SLOAD_F((const float*)Vh, KBASE(1)); } }
    MASKT(pA0, pA1, 0); partialSM(pA0, pA1, m_reg, mnA, alA);
    if (NT > 1) { VMW(); if constexpr (F32) { SWRITE_VF(1); SBAR(); if (NT > 2) SLOAD_F((const float*)Kh, KBASE(2)); } else SWRITE_H(1); }
    __syncthreads();
#define HALF_STEP(PX0, PX1, mnX, alX, PY0, PY1, alY, t, KB, VB, SB) do {                                                      \
        SBAR(); qkt<KB, SK>(PX0, PX1, K_lds, r32, hi, S.qr, ACT(t));                                             \
        finishSM(PY0, PY1, alY, l_reg, pa0, pa1, pa2, pa3); SBAR();                                                           \
        if ((t) + 1 < NT) { if constexpr (F32) { VMW(); SWRITE_KF(SB); SBAR(); SLOAD_F((const float*)Vh, KBASE((t) + 1)); }  \
                            else { SLOAD_H(Kh, Vh, KBASE((t) + 1)); } SBAR(); }                                               \
        pv_tile<VB, SK>(o, vb0, pa0, pa1, pa2, pa3, ACT((t) - 1)); MASKT(PX0, PX1, (t)); partialSM(PX0, PX1, m_reg, mnX, alX);                                        \
        __syncthreads();                                                                                                      \
        if ((t) + 1 < NT) { VMW(); if constexpr (F32) { SWRITE_VF(SB); SBAR(); if ((t) + 2 < NT) SLOAD_F((const float*)Kh, KBASE((t) + 2)); } \
                            else { SWRITE_H(SB); } }                                                                          \
        RESC(alX); __syncthreads(); } while (0)
    for (int t = 1; t + 1 < NT; t += 2) {
        HALF_STEP(pB0, pB1, mnB, alB, pA0, pA1, alA, t, 1, 0, 0);
        HALF_STEP(pA0, pA1, mnA, alA, pB0, pB1, alB, t + 1, 0, 1, 1);
    }
    const bool even = (NT & 1) == 0;
    if (even) { SBAR(); qkt<1, SK>(pB0, pB1, K_lds, r32, hi, S.qr, ACT(NT - 1)); SBAR(); }
#define QROW(e) (nxt.Q + (size_t)(wid * QBLK + r32) * LDP + ((e) >> 1) * 16 + hi * 8 + ((e) & 1) * 4)
    if constexpr (F32) { SLOAD_F((const float*)nxt.K, kbn); SBAR();
#pragma unroll
        for (int e = 0; e < 8; ++e) S.tq[e] = *(const f32x4*)QROW(e); }
    else { SLOAD_H(nxt.K, nxt.V, kbn); SBAR();
#pragma unroll
        for (int d0 = 0; d0 < 8; ++d0) S.qr[d0] = load8<TIn>(nxt.Q + (size_t)(wid * QBLK + r32) * LDP + d0 * 16 + hi * 8); }
    SBAR();
    finishSM(pA0, pA1, alA, l_reg, pa0, pa1, pa2, pa3); SBAR();
    if constexpr (F32) {
#pragma unroll
        for (int e = 8; e < 16; ++e) S.tq[e] = *(const f32x4*)QROW(e); SBAR(); }
#undef QROW
    pv_tile<0, SK>(o, vb0, pa0, pa1, pa2, pa3, ACT(even ? NT - 2 : NT - 1));
    if (even) { MASKT(pB0, pB1, NT - 1); partialSM(pB0, pB1, m_reg, mnB, alB); __syncthreads(); RESC(alB);
        finishSM(pB0, pB1, alB, l_reg, pa0, pa1, pa2, pa3); SBAR(); pv_tile<1, SK>(o, vb0, pa0, pa1, pa2, pa3, ACT(NT - 1)); }
    SBAR(); SEAM_K0();
    if (hi == 0) li_l[r32] = l_reg; asm volatile("s_waitcnt lgkmcnt(0)" ::: "memory");
    float rli[16];
#pragma unroll
    for (int r = 0; r < 16; ++r) rli[r] = __builtin_amdgcn_rcpf(li_l[crow(r, hi)]);
    TOut* Ow = cur.O + (size_t)(wid * QBLK) * LDO;
#pragma unroll
    for (int r = 0; r < 16; ++r) { const int orow = crow(r, hi);
#pragma unroll
        for (int d0 = 0; d0 < 4; ++d0) { const float v = o[d0][r] * rli[r];
            if constexpr (same_t<TOut, float>::v) { Ow[(size_t)orow * LDO + d0 * 32 + r32] = v; }
            else { const float vn = __shfl_xor(v, 1);
                   if ((r32 & 1) == 0) *(unsigned*)(Ow + (size_t)orow * LDO + d0 * 32 + r32) = cvtpk(v, vn); } } }
    if constexpr (F32) {
#pragma unroll
        for (int d0 = 0; d0 < 8; ++d0) S.qr[d0] = pack8(S.tq[2 * d0], S.tq[2 * d0 + 1]); }
    __syncthreads();
#undef RESC
#undef KBASE
#undef ACT
#undef MASKT
#undef SEAM_K0
#undef HALF_STEP
}
#undef ROW
#undef VMW
#undef VMWN
#undef SLOAD_H
#undef SWRITE_HK
#undef SWRITE_HV
#undef SWRITE_H
#undef SLOAD_F
#undef SWRITE_KF
#undef SWRITE_VF

constexpr int A2_V = 0;
constexpr int A2_K = 4 * SHM_V;
constexpr int A2_X = A2_K + 2 * SHM_K;
constexpr int A2_XS = 4096 + 512;
constexpr int A2_LDS = A2_X + 4 * A2_XS;
struct A2Ref { const bf16* Q; const bf16* K; const bf16* V0; const bf16* V1; bf16* O; int P0; };

__device__ __forceinline__ void attn2_block(const A2Ref& c, char* lds, const int mk_wave) {
    const int lane = (int)(__builtin_amdgcn_mbcnt_hi(~0u, __builtin_amdgcn_mbcnt_lo(~0u, 0u)) & 63u), wid = mk_wave & 7, tid = wid * 64 + lane, r32 = lane & 31, hi = lane >> 5, rg = wid & 3, vh = wid >> 2;
    char* V_lds = lds + A2_V; char* K_lds = lds + A2_K; char* X = lds + A2_X + rg * A2_XS;
    float* XA = (float*)(X + 4096); float* XM = XA + 32; float* XL = XA + 64;
    const int NT = (c.P0 + 127) / 64 + 1;
    const int qlo = c.P0 + rg * 32, qm = qlo + r32 - 4 * hi;
    const int sr = tid >> 4, sc = (tid & 15) * 8, vst0 = v_st(sr, sc), vst1 = v_st(32 + sr, sc), kws = KSWZ(sr, sc * 2);
    const int vb0 = (int)(uintptr_t)V_lds + vh * SHM_V + v_rd_base(lane);
    bf16x8 qr[8];
#pragma unroll
    for (int d0 = 0; d0 < 8; ++d0) qr[d0] = load8<bf16>(c.Q + (size_t)(rg * 32 + r32) * 128 + d0 * 16 + hi * 8);
    float m_reg = -1e30f, l_reg = 0.f; f32x16 o[4] = {};
    bf16x8 sk0, sk1, sa0, sa1, sb0, sb1;
#define A2_LOAD(kb) do { const size_t ro_ = (size_t)((kb) + sr) * 128 + sc; sk0 = load8<bf16>(c.K + ro_); sk1 = load8<bf16>(c.K + ro_ + 32 * 128); \
        sa0 = load8<bf16>(c.V0 + ro_); sa1 = load8<bf16>(c.V0 + ro_ + 32 * 128); sb0 = load8<bf16>(c.V1 + ro_); sb1 = load8<bf16>(c.V1 + ro_ + 32 * 128); } while (0)
#define A2_WRITE(buf) do { *(bf16x8*)(K_lds + (buf) * SHM_K + kws) = sk0; *(bf16x8*)(K_lds + (buf) * SHM_K + kws + 32 * 256) = sk1; \
        *(bf16x8*)(V_lds + (buf) * 2 * SHM_V + vst0) = sa0; *(bf16x8*)(V_lds + (buf) * 2 * SHM_V + vst1) = sa1; \
        *(bf16x8*)(V_lds + (buf) * 2 * SHM_V + SHM_V + vst0) = sb0; *(bf16x8*)(V_lds + (buf) * 2 * SHM_V + SHM_V + vst1) = sb1; } while (0)
#define A2_VMW() asm volatile("s_waitcnt vmcnt(0)" ::: "memory")
#define A2_STEP(t, B) do { const bool more_ = (t) + 1 < NT; if (more_) A2_LOAD(((t) + 1) * 64); \
        bf16x8 pa0, pa1, pa2, pa3; \
        if (vh == (B)) { f32x16 p0, p1; float mn, alpha; \
            qkt<(B), false>(p0, p1, K_lds, r32, hi, qr, true); \
            if (64 * (t) + 63 > qlo) mask_tile(p0, p1, qm - 64 * (t), 16384u); \
            partialSM(p0, p1, m_reg, mn, alpha); finishSM(p0, p1, alpha, l_reg, pa0, pa1, pa2, pa3); \
            *(bf16x8*)(X + lane * 16) = pa0; *(bf16x8*)(X + 1024 + lane * 16) = pa1; *(bf16x8*)(X + 2048 + lane * 16) = pa2; *(bf16x8*)(X + 3072 + lane * 16) = pa3; \
            if (hi == 0) { XA[r32] = alpha; XM[r32] = m_reg; XL[r32] = l_reg; } } \
        __syncthreads(); \
        if (vh != (B)) { pa0 = *(const bf16x8*)(X + lane * 16); pa1 = *(const bf16x8*)(X + 1024 + lane * 16); pa2 = *(const bf16x8*)(X + 2048 + lane * 16); pa3 = *(const bf16x8*)(X + 3072 + lane * 16); \
            m_reg = XM[r32]; l_reg = XL[r32]; } \
        { const float a_ = XA[r32]; if (__any(a_ < 1.f)) { \
            _Pragma("unroll") for (int d_ = 0; d_ < 4; ++d_) _Pragma("unroll") for (int r = 0; r < 16; ++r) o[d_][r] *= XA[crow(r, hi)]; } } \
        pv_tile<2 * (B), false>(o, vb0, pa0, pa1, pa2, pa3, true); \
        if (more_) { A2_VMW(); A2_WRITE((B) ^ 1); } \
        __syncthreads(); } while (0)
    A2_LOAD(0); A2_VMW(); A2_WRITE(0); __syncthreads();
    for (int t = 0; t < NT; t += 2) { A2_STEP(t, 0); A2_STEP(t + 1, 1); }
    float rli[16];
#pragma unroll
    for (int r = 0; r < 16; ++r) rli[r] = __builtin_amdgcn_rcpf(XL[crow(r, hi)]);
    bf16* Ow = c.O + (size_t)(rg * 32) * LDO + vh * 128;
#pragma unroll
    for (int r = 0; r < 16; ++r) { const int orow = crow(r, hi);
#pragma unroll
        for (int d0 = 0; d0 < 4; ++d0) { const float v = o[d0][r] * rli[r]; const float vn = __shfl_xor(v, 1);
            if ((r32 & 1) == 0) *(unsigned*)(Ow + (size_t)orow * LDO + d0 * 32 + r32) = cvtpk(v, vn); } }
    __syncthreads();
#undef A2_LOAD
#undef A2_WRITE
#undef A2_VMW
#undef A2_STEP
}

constexpr int A3_XS = 4096 + 2 * 384;
constexpr int A3_LDS = A2_X + 4 * A3_XS;
__device__ __forceinline__ void attn3_block(const A2Ref& c, char* lds, const int mk_wave) {
    int lane_ = (int)(__builtin_amdgcn_mbcnt_hi(~0u, __builtin_amdgcn_mbcnt_lo(~0u, 0u)) & 63u); asm volatile("" : "+v"(lane_));
    const int lane = lane_ & 63, wid = mk_wave & 7, tid = wid * 64 + lane, r32 = lane & 31, hi = lane >> 5, rg = wid & 3, vh = wid >> 2;
    char* V_lds = lds + A2_V; char* K_lds = lds + A2_K; char* X = lds + A2_X + rg * A3_XS;
    float* XS = (float*)(X + 4096);
    const int NT = (c.P0 + 127) / 64 + 1;
    const int qlo = c.P0 + rg * 32, qm = qlo + r32 - 4 * hi;
    const int sr = tid >> 4, sc = (tid & 15) * 8, vst0 = v_st(sr, sc), vst1 = v_st(32 + sr, sc), kws = KSWZ(sr, sc * 2);
    const int vb0 = (int)(uintptr_t)V_lds + vh * SHM_V + v_rd_base(lane);
    bf16x8 qr[8];
#pragma unroll
    for (int d0 = 0; d0 < 8; ++d0) qr[d0] = load8<bf16>(c.Q + (size_t)(rg * 32 + r32) * 128 + d0 * 16 + hi * 8);
    float m_reg = -1e30f, l_reg = 0.f; f32x16 o[4] = {};
    bf16x8 sk0, sk1, sa0, sa1, sb0, sb1, pa0, pa1, pa2, pa3;
    const unsigned so = (unsigned)(sr * 128 + sc) * 2u;
#define A3_G(base, kb, rows) (*(const bf16x8*)((const char*)((base) + (size_t)((kb) + (rows)) * 128) + so))
#define A3_LOADK(kb) do { sk0 = A3_G(c.K, kb, 0); sk1 = A3_G(c.K, kb, 32); } while (0)
#define A3_LOADV(kb) do { sa0 = A3_G(c.V0, kb, 0); sa1 = A3_G(c.V0, kb, 32); sb0 = A3_G(c.V1, kb, 0); sb1 = A3_G(c.V1, kb, 32); } while (0)
#define A3_WRITEK(buf) do { *(bf16x8*)(K_lds + (buf) * SHM_K + kws) = sk0; *(bf16x8*)(K_lds + (buf) * SHM_K + kws + 32 * 256) = sk1; } while (0)
#define A3_WRITEV(buf) do { *(bf16x8*)(V_lds + (buf) * 2 * SHM_V + vst0) = sa0; *(bf16x8*)(V_lds + (buf) * 2 * SHM_V + vst1) = sa1; \
        *(bf16x8*)(V_lds + (buf) * 2 * SHM_V + SHM_V + vst0) = sb0; *(bf16x8*)(V_lds + (buf) * 2 * SHM_V + SHM_V + vst1) = sb1; } while (0)
#define A3_VMW() asm volatile("s_waitcnt vmcnt(0)" ::: "memory")
#define A3_SOFTMAX_PUBLISH(T, PS) do { float mn_, alpha_; \
        if (64 * (T) + 63 > qlo) mask_tile(p0, p1, qm - 64 * (T), 16384u); \
        partialSM(p0, p1, m_reg, mn_, alpha_); finishSM(p0, p1, alpha_, l_reg, pa0, pa1, pa2, pa3); \
        *(bf16x8*)(X + lane * 16) = pa0; *(bf16x8*)(X + 1024 + lane * 16) = pa1; *(bf16x8*)(X + 2048 + lane * 16) = pa2; *(bf16x8*)(X + 3072 + lane * 16) = pa3; \
        if (hi == 0) { XS[(PS) * 96 + r32] = alpha_; XS[(PS) * 96 + 32 + r32] = m_reg; XS[(PS) * 96 + 64 + r32] = l_reg; } } while (0)
    A3_LOADK(0); A3_LOADV(0); A3_VMW(); A3_WRITEK(0); A3_WRITEV(0); A3_LOADK(64); A3_VMW(); A3_WRITEK(1);
    __syncthreads();
    if (vh == 0) { f32x16 p0, p1; qkt<0, false>(p0, p1, K_lds, r32, hi, qr, true); A3_SOFTMAX_PUBLISH(0, 0); }
    __syncthreads();
#define A3_STEP(t, B) do { const bool more1_ = (t) + 1 < NT, more2_ = (t) + 2 < NT; \
        f32x16 p0, p1; \
        if (vh != (B) && more1_) { qkt<(B) ^ 1, false>(p0, p1, K_lds, r32, hi, qr, true); } \
        SBAR(); \
        if (more2_) A3_LOADK(((t) + 2) * 64); if (more1_) A3_LOADV(((t) + 1) * 64); \
        if (vh != (B)) { pa0 = *(const bf16x8*)(X + lane * 16); pa1 = *(const bf16x8*)(X + 1024 + lane * 16); pa2 = *(const bf16x8*)(X + 2048 + lane * 16); pa3 = *(const bf16x8*)(X + 3072 + lane * 16); \
            m_reg = XS[(B) * 96 + 32 + r32]; l_reg = XS[(B) * 96 + 64 + r32]; } \
        { const float a_ = XS[(B) * 96 + r32]; if (__any(a_ < 1.f)) { \
            _Pragma("unroll") for (int d_ = 0; d_ < 4; ++d_) _Pragma("unroll") for (int r = 0; r < 16; ++r) o[d_][r] *= XS[(B) * 96 + crow(r, hi)]; } } \
        pv_tile<2 * (B), false>(o, vb0, pa0, pa1, pa2, pa3, true); \
        SBAR(); \
        if (vh != (B) && more1_) A3_SOFTMAX_PUBLISH((t) + 1, (B) ^ 1); \
        if (more1_) { A3_VMW(); if (more2_) A3_WRITEK(B); A3_WRITEV((B) ^ 1); } \
        __syncthreads(); } while (0)
    for (int t = 0; t < NT; t += 2) { A3_STEP(t, 0); A3_STEP(t + 1, 1); }
    float rli[16];
#pragma unroll
    for (int r = 0; r < 16; ++r) rli[r] = __builtin_amdgcn_rcpf(XS[96 + 64 + crow(r, hi)]);
    bf16* Ow = c.O + (size_t)(rg * 32) * LDO + vh * 128;
#pragma unroll
    for (int r = 0; r < 16; ++r) { const int orow = crow(r, hi);
#pragma unroll
        for (int d0 = 0; d0 < 4; ++d0) { const float v = o[d0][r] * rli[r]; const float vn = __shfl_xor(v, 1);
            if ((r32 & 1) == 0) *(unsigned*)(Ow + (size_t)orow * LDO + d0 * 32 + r32) = cvtpk(v, vn); } }
    __syncthreads();
#undef A3_G
#undef A3_LOADK
#undef A3_LOADV
#undef A3_WRITEK
#undef A3_WRITEV
#undef A3_VMW
#undef A3_SOFTMAX_PUBLISH
#undef A3_STEP
}

}

constexpr int S_ = 16384, DM = 2048, FF = 5632, NIN = 6152, NINP = 6144, PLD = 3072;
constexpr int NWAVES = 8, NTHR = 512;
constexpr int C_MQ = 0, C_MK = 512, C_MV = 1024, C_MO = 2048;
constexpr size_t MiB = 1u << 20, KiB = 1u << 10;
constexpr size_t WS_ROWSS1 = 0, WS_ROWSS2 = 64 * KiB, WS_SC = 192 * KiB  , WS_DN = 256 * KiB, WS_GATES = 512 * KiB;
constexpr size_t WS_BAR = 128 * KiB;
constexpr size_t WS_WGU = 1 * MiB, WS_WD = 45 * MiB, WS_WIN = 67 * MiB, WS_WOUT = 92 * MiB;
constexpr size_t WS_XN = 100 * MiB;
constexpr size_t WS_BIG = 164 * MiB;
constexpr size_t WS_Y = 356 * MiB;
constexpr size_t WS_CT = 420 * MiB;
constexpr size_t WS_QC = 452 * MiB, WS_KC = 468 * MiB;
constexpr size_t WS_NST = 484 * MiB;
constexpr size_t WS_GW = 484 * MiB + 512 * KiB;
constexpr size_t WS_END = 485 * MiB;
constexpr int LDS_BYTES = 147456;

#define LAS __attribute__((address_space(3)))
typedef unsigned short bfu;
typedef unsigned v4u __attribute__((ext_vector_type(4)));
typedef unsigned v2u __attribute__((ext_vector_type(2)));
typedef float f32x4 __attribute__((ext_vector_type(4)));
typedef short bf16x8 __attribute__((ext_vector_type(8)));
#define MFMA16(a, b, c) __builtin_amdgcn_mfma_f32_16x16x32_bf16(a, b, c, 0, 0, 0)
#define LDS_WAIT() asm volatile("s_waitcnt lgkmcnt(0)" ::: "memory")
__device__ __forceinline__ unsigned f2bf(float f) { unsigned u = __builtin_bit_cast(unsigned, f); return (u + 0x7fffu + ((u >> 16) & 1u)) >> 16; }
__device__ __forceinline__ unsigned pk2(float lo, float hi) { return f2bf(lo) | (f2bf(hi) << 16); }
__device__ __forceinline__ float bf2f(unsigned b) { return __builtin_bit_cast(float, b << 16); }
__device__ __forceinline__ int mk_lane() { return (int)(__builtin_amdgcn_mbcnt_hi(~0u, __builtin_amdgcn_mbcnt_lo(~0u, 0u)) & 63u); }
__device__ __forceinline__ float wave_sum(float v) {
#pragma unroll
    for (int o = 1; o < 64; o <<= 1) v += __shfl_xor(v, o);
    return v;
}
__device__ __forceinline__ float silu(float x) { return x / (1.0f + __expf(-x)); }

__device__ __forceinline__ void cvt_item(const float* __restrict__ W, int ldw, int ncols, const float* __restrict__ gain, bfu* WT, int K, int dst_row0, int k0, int n0, LAS float* scr, int lane) {
    const int nq = (lane & 15) * 4, kr = lane >> 4, n = n0 + nq;
#pragma unroll 8
    for (int i = 0; i < 16; ++i) { const int kk = 4 * i + kr; f32x4 v = (f32x4){0.f, 0.f, 0.f, 0.f};
        if (n < ncols) v = *(const f32x4*)(W + (size_t)(k0 + kk) * ldw + n);
        if (gain) v = v * gain[k0 + kk];
        LAS float* d = scr + kk * 65 + nq; d[0] = v[0]; d[1] = v[1]; d[2] = v[2]; d[3] = v[3]; }
    LDS_WAIT(); asm volatile("" ::: "memory");
    const int c = lane & 7;
#pragma unroll
    for (int j = 0; j < 8; ++j) { const int nn = (lane >> 3) + 8 * j; const LAS float* s = scr + (8 * c) * 65 + nn;
        v4u o; o.x = pk2(s[0 * 65], s[1 * 65]); o.y = pk2(s[2 * 65], s[3 * 65]); o.z = pk2(s[4 * 65], s[5 * 65]); o.w = pk2(s[6 * 65], s[7 * 65]);
        *(v4u*)(WT + (size_t)(dst_row0 + nn) * K + k0 + 8 * c) = o; }
    LDS_WAIT(); asm volatile("" ::: "memory");
}
__device__ __forceinline__ void cvt_ffn_item(int it, const float* wg, const float* wu, const float* wd, const float* gain, bfu* Wgu, bfu* Wd, LAS float* scr, int lane) {
    if (it < 2 * 2816) { const int up = it >= 2816; const int r = up ? it - 2816 : it; const int kb = r / 88, nb = r % 88, n0 = nb * 64;
        cvt_item(up ? wu : wg, FF, FF, gain, Wgu, DM, 256 * (n0 >> 7) + (n0 & 127) + (up ? 128 : 0), kb * 64, n0, scr, lane); }
    else { const int r = it - 2 * 2816; const int kb = r / 32, nb = r % 32; cvt_item(wd, DM, DM, nullptr, Wd, FF, nb * 64, kb * 64, nb * 64, scr, lane); }
}

constexpr int GWP = 4112;
__device__ __forceinline__ void gates_rows(LAS unsigned char* lds, const bfu* __restrict__ XB, const float* __restrict__ rowss, const float* __restrict__ b_i, const float* __restrict__ b_f, float* GATES, int rb, int wave, int lane) {
    const int fr = lane & 15, fq = lane >> 4, rg = wave & 3, kh = wave >> 2;
    const LAS unsigned char* wl = lds + 16384;
    const bfu* xp = XB + (size_t)(rb * 64 + rg * 16 + fr) * DM + kh * 1024 + 8 * fq;
    f32x4 acc = (f32x4){0.f, 0.f, 0.f, 0.f};
    for (int k0 = 0; k0 < 32; k0 += 16) {
        bf16x8 xa[16];
#pragma unroll
        for (int ks = 0; ks < 16; ++ks) xa[ks] = *(const bf16x8*)(xp + (k0 + ks) * 32);
#pragma unroll
        for (int ks = 0; ks < 16; ++ks) { const bf16x8 wb = *(const LAS bf16x8*)(wl + fr * GWP + (kh * 1024 + (k0 + ks) * 32 + 8 * fq) * 2); acc = MFMA16(xa[ks], wb, acc); }
    }
    LAS f32x4* red = (LAS f32x4*)lds;
    if (kh == 1) red[rg * 64 + lane] = acc;
    __syncthreads();
    if (kh == 0 && fr < 8) {
        const f32x4 o = red[rg * 64 + lane]; const float bias = fr < 4 ? b_i[fr] : b_f[fr - 4];
#pragma unroll
        for (int j = 0; j < 4; ++j) { const int row = rb * 64 + rg * 16 + 4 * fq + j;
            const float pre = (acc[j] + o[j]) / sqrtf(rowss[row] * (1.0f / DM) + 1e-6f) + bias; const float capped = 15.0f * tanhf(pre * (1.0f / 15.0f));
            GATES[(size_t)row * 8 + fr] = fr < 4 ? capped : -log1pf(expf(-capped)); }
    }
    __syncthreads();
}

#define XB_TMO      128
#define XB_XCNT(j)  (256  + 64 * (j))
#define XB_XSUB(j)  (1280 + 64 * (j))
#define XB_XGEN(j)  (2304 + 64 * (j))
#define XB_TOP      3328
#define XB_TOPGEN   3392
#define XCD_BAR_WORDS 3456
#define XB_SPIN_CAP (1u << 18)
__device__ __forceinline__ unsigned xb_ld(unsigned* p)              { return __hip_atomic_load(p, __ATOMIC_RELAXED, __HIP_MEMORY_SCOPE_AGENT); }
__device__ __forceinline__ unsigned xb_add(unsigned* p, unsigned v) { return __hip_atomic_fetch_add(p, v, __ATOMIC_RELAXED, __HIP_MEMORY_SCOPE_AGENT); }
__device__ __forceinline__ unsigned xb_xcc_id() { return (unsigned)__builtin_amdgcn_s_getreg((3 << 11) | 20) & 0xFu; }
#define XB_SPIN(cond, bar) do { unsigned _sp = 0; while (cond) { __builtin_amdgcn_s_sleep(1); \
    if ((++_sp & 255u) == 0u) { if (xb_ld(&(bar)[XB_TMO])) break; if (_sp > XB_SPIN_CAP) { atomicAdd(&(bar)[XB_TMO], 1u); break; } } } } while (0)
__device__ __forceinline__ void xcd_barrier_complete(unsigned* bar, unsigned x, unsigned& nloc, unsigned& nx) {
    const unsigned G = gridDim.x * gridDim.y * gridDim.z;
    unsigned sum, cnt, mine, sp = 0u;
    for (;;) {
        sum = 0u; cnt = 0u; mine = 0u;
#pragma unroll
        for (unsigned j = 0; j < 16; ++j) { const unsigned c = xb_ld(&bar[XB_XCNT(j)]); sum += c; cnt += (c > 0u) ? 1u : 0u; mine = (j == x) ? c : mine; }
        if (sum == G) break;
        __builtin_amdgcn_s_sleep(1);
        if ((++sp & 255u) == 0u) { if (xb_ld(&bar[XB_TMO])) break; if (sp > XB_SPIN_CAP) { atomicAdd(&bar[XB_TMO], 1u); break; } }
    }
    nloc = mine > 0u ? mine : 1u; nx = cnt > 0u ? cnt : 1u;
}
__device__ __forceinline__ void xcd_barrier(unsigned* bar, volatile LAS unsigned* st, const bool first) {
    asm volatile("s_waitcnt vmcnt(0)" ::: "memory");
    __syncthreads();
    if (first) {
        const unsigned x = xb_xcc_id();
        __builtin_amdgcn_s_waitcnt(0);
        unsigned nloc = st[0], nx = st[1];
        if (nloc == 0u) { xcd_barrier_complete(bar, x, nloc, nx); st[0] = nloc; st[1] = nx; }
        const unsigned old = xb_add(&bar[XB_XSUB(x)], 1u);
        const unsigned gen = old / nloc;
        if (old + 1u == (gen + 1u) * nloc) {
            __builtin_amdgcn_fence(__ATOMIC_RELEASE, "agent");
            asm volatile("s_waitcnt vmcnt(0)" ::: "memory");
            const unsigned og = xb_add(&bar[XB_TOP], 1u);
            const unsigned tg = og / nx;
            if (og + 1u == (tg + 1u) * nx) xb_add(&bar[XB_TOPGEN], 1u);
            else XB_SPIN(xb_ld(&bar[XB_TOPGEN]) == tg, bar);
            __builtin_amdgcn_fence(__ATOMIC_ACQUIRE, "agent");
            xb_add(&bar[XB_XGEN(x)], 1u);
            asm volatile("s_waitcnt vmcnt(0)" ::: "memory");
        } else {
            XB_SPIN(xb_ld(&bar[XB_XGEN(x)]) == gen, bar);
            __builtin_amdgcn_fence(__ATOMIC_ACQUIRE, "agent");
            asm volatile("s_waitcnt vmcnt(0)" ::: "memory");
        }
    }
    __syncthreads();
}

struct Args { const float* in[23]; float* out; unsigned char* ws; int ph_lo, ph_hi; };
constexpr int NPH = 12;

constexpr int MP = 272;

__device__ __forceinline__ void mlstm_stage_a(LAS unsigned char* lds, const bfu* __restrict__ PROJ, const float* __restrict__ GATES, const float* __restrict__ conv_w, const float* __restrict__ conv_b,
                                              bfu* QC, bfu* KC, float* DELTA, float* DN, float* SC, int item, const int mk_wave) {
    int lane = mk_lane(); asm volatile("" : "+v"(lane));
    const int wid = mk_wave & 7, tid = wid * 64 + lane, fr = lane & 15, fq = lane >> 4;
    const int h = item & 3, row0 = (item >> 2) * 128;
    LAS float* fa = (LAS float*)lds; LAS unsigned char* KT = lds + 4096; LAS unsigned char* VT = KT + 128 * MP;
    if (tid < 128) { fa[tid] = GATES[(size_t)(row0 + tid) * 8 + 4 + h]; fa[128 + tid] = GATES[(size_t)(row0 + tid) * 8 + h]; }
    __syncthreads();
    if (tid < 128) { float b = 0.f; for (int s = 0; s <= tid; ++s) b += fa[s]; fa[256 + tid] = fa[128 + tid] - b; if (tid == 127) fa[385] = b; }
    __syncthreads();
    if (wid == 0) { float a = fmaxf(fa[256 + lane], fa[320 + lane]);
#pragma unroll
        for (int o = 1; o < 64; o <<= 1) a = fmaxf(a, __shfl_xor(a, o));
        if (lane == 0) fa[384] = a; }
    __syncthreads();
    const float amax = fa[384], blast = fa[385];
    if (tid < 128) fa[tid] = __expf(fa[256 + tid] - amax);
    if (tid == 0) { SC[item] = blast + amax; SC[512 + item] = blast; }
    __syncthreads();
    for (int task = tid; task < 4096; task += NTHR) {
        const int isk = task >> 11, t2 = task & 2047, d = t2 & 127, s0 = (t2 >> 7) * 8, ch = isk * 512 + h * 128 + d;
        const float w0 = conv_w[ch], w1 = conv_w[1024 + ch], w2 = conv_w[2048 + ch], w3 = conv_w[3072 + ch], bias = conv_b[ch];
        float x[11];
#pragma unroll
        for (int i = 0; i < 11; ++i) { const int r = row0 + s0 - 3 + i; x[i] = r >= 0 ? bf2f(PROJ[(size_t)r * PLD + C_MQ + ch]) : 0.f; }
        float y[8];
#pragma unroll
        for (int i = 0; i < 8; ++i) y[i] = silu(bias + w0 * x[i] + w1 * x[i + 1] + w2 * x[i + 2] + w3 * x[i + 3]);
        if (!isk) {
#pragma unroll
            for (int i = 0; i < 8; ++i) QC[(size_t)(row0 + s0 + i) * 512 + h * 128 + d] = (bfu)f2bf(y[i] * 0.08838834764831845f);
        } else {
#pragma unroll
            for (int i = 0; i < 8; ++i) { KC[(size_t)(row0 + s0 + i) * 512 + h * 128 + d] = (bfu)f2bf(y[i]); y[i] *= fa[s0 + i]; }
            v4u o; o.x = pk2(y[0], y[1]); o.y = pk2(y[2], y[3]); o.z = pk2(y[4], y[5]); o.w = pk2(y[6], y[7]);
            *(LAS v4u*)(KT + d * MP + s0 * 2) = o;
        }
    }
    for (int task = tid; task < 4096; task += NTHR) {
        const int sidx = task & 127, e0 = (task >> 7) * 8;
        const v4u v = *(const v4u*)(PROJ + (size_t)(row0 + sidx) * PLD + C_MV + h * 256 + e0);
        LAS unsigned short* d = (LAS unsigned short*)(VT + e0 * MP + sidx * 2);
        d[0 * (MP / 2)] = (unsigned short)(v.x & 0xffffu); d[1 * (MP / 2)] = (unsigned short)(v.x >> 16); d[2 * (MP / 2)] = (unsigned short)(v.y & 0xffffu); d[3 * (MP / 2)] = (unsigned short)(v.y >> 16);
        d[4 * (MP / 2)] = (unsigned short)(v.z & 0xffffu); d[5 * (MP / 2)] = (unsigned short)(v.z >> 16); d[6 * (MP / 2)] = (unsigned short)(v.w & 0xffffu); d[7 * (MP / 2)] = (unsigned short)(v.w >> 16);
    }
    __syncthreads();
    f32x4 acc[2][8];
#pragma unroll
    for (int mt = 0; mt < 2; ++mt)
#pragma unroll
        for (int nt = 0; nt < 8; ++nt) acc[mt][nt] = (f32x4){0.f, 0.f, 0.f, 0.f};
#pragma unroll
    for (int ks = 0; ks < 4; ++ks) {
        bf16x8 a[2];
#pragma unroll
        for (int mt = 0; mt < 2; ++mt) a[mt] = *(const LAS bf16x8*)(VT + (32 * wid + 16 * mt + fr) * MP + (32 * ks + 8 * fq) * 2);
#pragma unroll
        for (int nt = 0; nt < 8; ++nt) { const bf16x8 b = *(const LAS bf16x8*)(KT + (16 * nt + fr) * MP + (32 * ks + 8 * fq) * 2);
            acc[0][nt] = MFMA16(a[0], b, acc[0][nt]); acc[1][nt] = MFMA16(a[1], b, acc[1][nt]); }
    }
    float* dst = DELTA + (size_t)item * 32768;
#pragma unroll
    for (int mt = 0; mt < 2; ++mt)
#pragma unroll
        for (int nt = 0; nt < 8; ++nt)
#pragma unroll
            for (int j = 0; j < 4; ++j) dst[(32 * wid + 16 * mt + 4 * fq + j) * 128 + 16 * nt + fr] = acc[mt][nt][j];
    if (tid < 128) { float s = 0.f; for (int i = 0; i < 128; ++i) s += bf2f(*(const LAS unsigned short*)(KT + tid * MP + i * 2)); DN[(size_t)item * 128 + tid] = s; }
    __syncthreads();
}

__device__ __forceinline__ void mlstm_scan(const float* __restrict__ DELTA, const float* __restrict__ DN, const float* __restrict__ SC, float* MPREV, bfu* __restrict__ CT, float* __restrict__ NST, int gtid, int nthreads) {
    for (int idx = gtid; idx < 4 * 32768 + 512; idx += nthreads) {
        const bool main_ = idx < 4 * 32768;
        const int h = main_ ? (idx >> 15) : ((idx - 4 * 32768) >> 7), rem = main_ ? (idx & 32767) : ((idx - 4 * 32768) & 127);
        const float* src = main_ ? DELTA + (size_t)h * 32768 + rem : DN + h * 128 + rem; const size_t sstride = main_ ? 4 * 32768 : 512;
        float m = 0.f, C = 0.f;
        for (int c0 = 0; c0 < 128; c0 += 8) {
            float d8[8];
#pragma unroll
            for (int i = 0; i < 8; ++i) d8[i] = src[(size_t)(c0 + i) * sstride];
#pragma unroll
            for (int i = 0; i < 8; ++i) { const int item = (c0 + i) * 4 + h;
                if (main_) { CT[(size_t)item * 32768 + rem] = (bfu)f2bf(C); if (rem == 0) MPREV[item] = m; } else NST[(size_t)item * 128 + rem] = C;
                const float mloc = SC[item], bl = SC[512 + item], mn = fmaxf(bl + m, mloc);
                C = __expf(bl + m - mn) * C + __expf(mloc - mn) * d8[i]; m = mn; }
        }
    }
}

__device__ __forceinline__ void mlstm_stage_c(LAS unsigned char* lds, const bfu* __restrict__ PROJ, const float* __restrict__ GATES, const bfu* __restrict__ QC, const bfu* __restrict__ KC,
                                              const bfu* __restrict__ CT, const float* __restrict__ NST, const float* __restrict__ MPREV, const float* __restrict__ hgain, bfu* Y, int item, const int mk_wave) {
    int lane = mk_lane(); asm volatile("" : "+v"(lane));
    const int wid = mk_wave & 7, tid = wid * 64 + lane, fr = lane & 15, fq = lane >> 4;
    const int h = item & 3, row0 = (item >> 2) * 128;
    LAS float* fa = (LAS float*)lds;
    LAS unsigned char* Qs = lds + 4096; LAS unsigned char* Ks = Qs + 128 * MP; LAS unsigned char* BUF = Ks + 128 * MP;
    if (tid < 128) { fa[768 + tid] = GATES[(size_t)(row0 + tid) * 8 + 4 + h]; fa[896 + tid] = GATES[(size_t)(row0 + tid) * 8 + h]; fa[640 + tid] = NST[(size_t)item * 128 + tid]; }
    __syncthreads();
    float bt_ = 0.f;
    if (tid < 128) { for (int s = 0; s <= tid; ++s) bt_ += fa[768 + s]; fa[tid] = fa[896 + tid] - bt_; }
    __syncthreads();
    if (tid < 128) { const float mp = MPREV[item]; float pm = -3.0e38f; for (int s = 0; s <= tid; ++s) pm = fmaxf(pm, fa[s]);
        const float M = fmaxf(mp, pm); fa[128 + tid] = M; fa[256 + tid] = __expf(mp - M); fa[384 + tid] = __expf(-(bt_ + M)); }
    for (int t = tid; t < 2048; t += NTHR) { const int r = t >> 4, c = t & 15;
        *(LAS v4u*)(Qs + r * MP + c * 16) = *(const v4u*)(QC + (size_t)(row0 + r) * 512 + h * 128 + c * 8);
        *(LAS v4u*)(Ks + r * MP + c * 16) = *(const v4u*)(KC + (size_t)(row0 + r) * 512 + h * 128 + c * 8); }
    for (int t = tid; t < 4096; t += NTHR) { const int r = t >> 4, c = t & 15; *(LAS v4u*)(BUF + r * MP + c * 16) = *(const v4u*)(CT + (size_t)item * 32768 + r * 128 + c * 8); }
    __syncthreads();
    {
        const int t = 16 * wid + fr; float s = 0.f;
#pragma unroll
        for (int i = 0; i < 32; ++i) s += bf2f(*(const LAS unsigned short*)(Qs + t * MP + (32 * fq + i) * 2)) * fa[640 + 32 * fq + i];
        s += __shfl_xor(s, 16); s += __shfl_xor(s, 32); if (fq == 0) fa[512 + t] = s;
    }
    f32x4 sa[8];
#pragma unroll
    for (int nt = 0; nt < 8; ++nt) sa[nt] = (f32x4){0.f, 0.f, 0.f, 0.f};
    bf16x8 qa[4];
#pragma unroll
    for (int ks = 0; ks < 4; ++ks) qa[ks] = *(const LAS bf16x8*)(Qs + (16 * wid + fr) * MP + (32 * ks + 8 * fq) * 2);
#pragma unroll
    for (int nt = 0; nt < 8; ++nt) if (nt <= wid) {
#pragma unroll
        for (int ks = 0; ks < 4; ++ks) { const bf16x8 b = *(const LAS bf16x8*)(Ks + (16 * nt + fr) * MP + (32 * ks + 8 * fq) * 2); sa[nt] = MFMA16(qa[ks], b, sa[nt]); } }
    float Mt[4], rsum[4];
#pragma unroll
    for (int j = 0; j < 4; ++j) { Mt[j] = fa[128 + 16 * wid + 4 * fq + j]; rsum[j] = 0.f; }
#pragma unroll
    for (int nt = 0; nt < 8; ++nt) { const int s = 16 * nt + fr; const float as = fa[s];
#pragma unroll
        for (int j = 0; j < 4; ++j) { const int t = 16 * wid + 4 * fq + j; const float p = (s <= t) ? sa[nt][j] * __expf(as - Mt[j]) : 0.f; sa[nt][j] = p; rsum[j] += p; } }
#pragma unroll
    for (int j = 0; j < 4; ++j) { float v = rsum[j]; v += __shfl_xor(v, 1); v += __shfl_xor(v, 2); v += __shfl_xor(v, 4); v += __shfl_xor(v, 8); rsum[j] = v; }
    f32x4 num[16];
#pragma unroll
    for (int nt = 0; nt < 16; ++nt) num[nt] = (f32x4){0.f, 0.f, 0.f, 0.f};
#pragma unroll
    for (int ks = 0; ks < 4; ++ks)
#pragma unroll
        for (int nt = 0; nt < 16; ++nt) { const bf16x8 b = *(const LAS bf16x8*)(BUF + (16 * nt + fr) * MP + (32 * ks + 8 * fq) * 2); num[nt] = MFMA16(qa[ks], b, num[nt]); if ((nt & 3) == 3) __builtin_amdgcn_sched_barrier(0); }
    float g4[4], den[4];
#pragma unroll
    for (int j = 0; j < 4; ++j) { const int t = 16 * wid + 4 * fq + j; g4[j] = fa[256 + t]; den[j] = fmaxf(fabsf(g4[j] * fa[512 + t] + rsum[j]), fa[384 + t]); }
#pragma unroll
    for (int nt = 0; nt < 16; ++nt)
#pragma unroll
        for (int j = 0; j < 4; ++j) num[nt][j] *= g4[j];
    __syncthreads();
#pragma unroll
    for (int nt = 0; nt < 8; ++nt)
#pragma unroll
        for (int j = 0; j < 4; ++j) *(LAS unsigned short*)(Ks + (16 * wid + 4 * fq + j) * MP + (16 * nt + fr) * 2) = (unsigned short)f2bf(sa[nt][j]);
    for (int task = tid; task < 4096; task += NTHR) {
        const int sidx = task & 127, e0 = (task >> 7) * 8;
        const v4u v = *(const v4u*)(PROJ + (size_t)(row0 + sidx) * PLD + C_MV + h * 256 + e0);
        LAS unsigned short* d = (LAS unsigned short*)(BUF + e0 * MP + sidx * 2);
        d[0 * (MP / 2)] = (unsigned short)(v.x & 0xffffu); d[1 * (MP / 2)] = (unsigned short)(v.x >> 16); d[2 * (MP / 2)] = (unsigned short)(v.y & 0xffffu); d[3 * (MP / 2)] = (unsigned short)(v.y >> 16);
        d[4 * (MP / 2)] = (unsigned short)(v.z & 0xffffu); d[5 * (MP / 2)] = (unsigned short)(v.z >> 16); d[6 * (MP / 2)] = (unsigned short)(v.w & 0xffffu); d[7 * (MP / 2)] = (unsigned short)(v.w >> 16);
    }
    __syncthreads();
#pragma unroll
    for (int ks = 0; ks < 4; ++ks) { const bf16x8 pa = *(const LAS bf16x8*)(Ks + (16 * wid + fr) * MP + (32 * ks + 8 * fq) * 2);
#pragma unroll
        for (int nt = 0; nt < 16; ++nt) { const bf16x8 b = *(const LAS bf16x8*)(BUF + (16 * nt + fr) * MP + (32 * ks + 8 * fq) * 2); num[nt] = MFMA16(pa, b, num[nt]); if ((nt & 3) == 3) __builtin_amdgcn_sched_barrier(0); } }
    float ssq[4];
#pragma unroll
    for (int j = 0; j < 4; ++j) { const float rd = 1.0f / den[j]; float s = 0.f;
#pragma unroll
        for (int nt = 0; nt < 16; ++nt) { const float v = num[nt][j] * rd; num[nt][j] = v; s += v * v; }
        s += __shfl_xor(s, 1); s += __shfl_xor(s, 2); s += __shfl_xor(s, 4); s += __shfl_xor(s, 8); ssq[j] = 1.0f / sqrtf(s * (1.0f / 256.0f) + 1e-6f); }
    __syncthreads();
    LAS float* HS = (LAS float*)(lds + 4096);
#pragma unroll
    for (int nt = 0; nt < 16; ++nt)
#pragma unroll
        for (int j = 0; j < 4; ++j) HS[(16 * wid + 4 * fq + j) * 260 + 16 * nt + fr] = num[nt][j] * ssq[j];
    __syncthreads();
    for (int task = tid; task < 4096; task += NTHR) {
        const int r = task >> 5, c8 = (task & 31) * 8; const size_t row = (size_t)(row0 + r);
        const f32x4 h0 = *(const LAS f32x4*)(HS + r * 260 + c8), h1 = *(const LAS f32x4*)(HS + r * 260 + c8 + 4);
        const f32x4 g0 = *(const f32x4*)(hgain + h * 256 + c8), g1 = *(const f32x4*)(hgain + h * 256 + c8 + 4);
        const v4u mo = *(const v4u*)(PROJ + row * PLD + C_MO + h * 256 + c8);
        v4u o;
        o.x = pk2(h0[0] * g0[0] / (1.0f + __expf(-bf2f(mo.x & 0xffffu))), h0[1] * g0[1] / (1.0f + __expf(-bf2f(mo.x >> 16))));
        o.y = pk2(h0[2] * g0[2] / (1.0f + __expf(-bf2f(mo.y & 0xffffu))), h0[3] * g0[3] / (1.0f + __expf(-bf2f(mo.y >> 16))));
        o.z = pk2(h1[0] * g1[0] / (1.0f + __expf(-bf2f(mo.z & 0xffffu))), h1[1] * g1[1] / (1.0f + __expf(-bf2f(mo.z >> 16))));
        o.w = pk2(h1[2] * g1[2] / (1.0f + __expf(-bf2f(mo.w & 0xffffu))), h1[3] * g1[3] / (1.0f + __expf(-bf2f(mo.w >> 16))));
        *(v4u*)(Y + row * DM + 1024 + h * 256 + c8) = o;
    }
    __syncthreads();
}

__device__ __forceinline__ att::BlockRef<att::bf16, att::bf16> att_ref(int i, int pass, const bfu* PROJ, bfu* OATT) {
    int ph, x;
    if (gridDim.x == 256) { ph = ((i >> 8) & 1) * 8 + (blockIdx.x & 7); x = blockIdx.x >> 3; }
    else { ph = (i >> 5) & 15; x = i & 31; }
    const int qb = pass ? 63 - x : x, h = ph >> 2, c = (ph >> 1) & 1, vh = ph & 1;
    att::BlockRef<att::bf16, att::bf16> r;
    constexpr size_t MSZ = (size_t)16384 * 128;
    r.Q = (const att::bf16*)(PROJ + (size_t)(2 * h + c) * MSZ + (size_t)qb * 256 * 128);
    r.K = (const att::bf16*)(PROJ + (size_t)(8 + 2 * h + c) * MSZ);
    r.V = (const att::bf16*)(PROJ + (size_t)(16 + 2 * h + vh) * MSZ);
    r.O = (att::bf16*)(OATT + (size_t)qb * 256 * 2048 + h * 512 + c * 256 + vh * 128);
    r.P0 = qb * 256;
    return r;
}
__device__ __forceinline__ void attn_phase(char* lds, const bfu* PROJ, bfu* OATT, const int TOTAL, const int mk_wave) {
    using namespace att;
    int i = blockIdx.x; if (i >= TOTAL) return;
    int pass = 0;
    BlockRef<bf16, bf16> cur = att_ref(i, 0, PROJ, OATT);
    Seam<bf16> S;
    causal_swa_prime<bf16, bf16>(cur, S_, lds, S, mk_wave);
    for (;;) {
        const bool more_pass = pass == 0, more_item = i + (int)gridDim.x < TOTAL, last = !more_pass && !more_item;
        int in_ = i, passn = pass + 1;
        if (!more_pass) { passn = 0; in_ = more_item ? i + (int)gridDim.x : i; }
        const BlockRef<bf16, bf16> nxt = last ? cur : att_ref(in_, passn, PROJ, OATT);
        causal_swa_block<bf16, bf16>(cur, nxt, S_, S_, lds, S, mk_wave);
        if (last) break;
        cur = nxt; i = in_; pass = passn;
    }
}

#ifndef ATTN2
#define ATTN2 2
#endif
__device__ __forceinline__ att::A2Ref att2_ref(int i, int pass, const bfu* PROJ, bfu* OATT) {
    int hc, x;
    if (gridDim.x == 256) { hc = blockIdx.x & 7; x = ((i >> 8) & 1) * 32 + (blockIdx.x >> 3); }
    else { hc = (i >> 6) & 7; x = i & 63; }
    const int qb = pass ? 127 - x : x, h = hc >> 1, c = hc & 1;
    constexpr size_t MSZ = (size_t)16384 * 128;
    att::A2Ref r;
    r.Q = (const att::bf16*)(PROJ + (size_t)(2 * h + c) * MSZ + (size_t)qb * 128 * 128);
    r.K = (const att::bf16*)(PROJ + (size_t)(8 + 2 * h + c) * MSZ);
    r.V0 = (const att::bf16*)(PROJ + (size_t)(16 + 2 * h) * MSZ); r.V1 = (const att::bf16*)(PROJ + (size_t)(16 + 2 * h + 1) * MSZ);
    r.O = (att::bf16*)(OATT + (size_t)qb * 128 * 2048 + h * 512 + c * 256);
    r.P0 = qb * 128;
    return r;
}
__device__ __forceinline__ void attn2_phase(char* lds, const bfu* PROJ, bfu* OATT, const int TOTAL, const int mk_wave) {
    for (int i = blockIdx.x; i < TOTAL; i += gridDim.x)
        for (int pass = 0; pass < 2; ++pass) { const att::A2Ref r = att2_ref(i, pass, PROJ, OATT); if (ATTN2 == 2) att::attn3_block(r, lds, mk_wave); else att::attn2_block(r, lds, mk_wave); }
}

__global__ void __launch_bounds__(NTHR, 2) mega_fwd(Args args) {
    extern __shared__ __attribute__((aligned(16))) unsigned char lds_raw[];
    LAS unsigned char* lds = (LAS unsigned char*)lds_raw;
    const int wave = __builtin_amdgcn_readfirstlane((int)threadIdx.x >> 6);
    const int G = gridDim.x, gw = blockIdx.x * NWAVES + wave, NGW = G * NWAVES;
#define AS4 __attribute__((address_space(4)))
#define PH_BEGIN int koff_ = 0; asm volatile("" : "+s"(koff_)); const AS4 char* kp_ = (const AS4 char*)__builtin_amdgcn_kernarg_segment_ptr() + koff_; \
    unsigned char* ws = *(unsigned char* const AS4*)(kp_ + 192); float* out = *(float* const AS4*)(kp_ + 184); (void)out; (void)ws; const int lane = mk_lane(), tid = wave * 64 + lane; (void)tid; (void)lane;
#define KIN(i) (*(const float* const AS4*)(kp_ + 8 * (i)))
#define Wgu ((bfu*)(ws + WS_WGU))
#define Wd ((bfu*)(ws + WS_WD))
#define Win ((bfu*)(ws + WS_WIN))
#define Wout ((bfu*)(ws + WS_WOUT))
#define XN ((bfu*)(ws + WS_XN))
#define BIG ((bfu*)(ws + WS_BIG))
#define Y ((bfu*)(ws + WS_Y))
#define CT ((bfu*)(ws + WS_CT))
#define QC ((bfu*)(ws + WS_QC))
#define KC ((bfu*)(ws + WS_KC))
#define NST ((float*)(ws + WS_NST))
#define rowss1 ((float*)(ws + WS_ROWSS1))
#define rowss2 ((float*)(ws + WS_ROWSS2))
#define SC ((float*)(ws + WS_SC))
#define DN ((float*)(ws + WS_DN))
#define GATES ((float*)(ws + WS_GATES))
#define DELTA ((float*)(ws + WS_XN))
#define OATT ((bfu*)(ws + WS_XN))
#define PROJM (BIG + (size_t)24 * 16384 * 128)
    const int lo = args.ph_lo, hi = args.ph_hi;
    if (hi - lo > 1) {
        if (wave == 0 && mk_lane() == 0) { volatile LAS unsigned* st = (volatile LAS unsigned*)(lds + LDS_BYTES - 64); st[0] = 0u; st[1] = 0u;
            (void)xb_add(&((unsigned*)(args.ws + WS_BAR))[XB_XCNT(xb_xcc_id())], 1u); }
        __syncthreads();
    }
#ifndef PHMASK
#define PHMASK 0xfff
#endif
#define IN(k) (((PHMASK >> (k)) & 1) && lo <= (k) && (k) < hi)
#ifndef PROBE_MASK
#define PROBE_MASK 0
#endif
#define NREP(k) (((PROBE_MASK >> (k)) & 1) ? 2 : 1)
#define STAGGER_DELAY(N) do { const int sn_ = (int)((blockIdx.x >> 3) & 3) * (N); for (int sd_ = 0; sd_ < sn_; ++sd_) __builtin_amdgcn_s_sleep(85); } while (0)
#define SYNC(k) do { if (IN(k) && IN((k) + 1)) { if (lo < 0) cg::this_grid().sync();     \
        { int kb_ = 0; asm volatile("" : "+s"(kb_)); unsigned char* wsb_ = *(unsigned char* const AS4*)((const AS4 char*)__builtin_amdgcn_kernarg_segment_ptr() + kb_ + 192); \
               xcd_barrier((unsigned*)(wsb_ + WS_BAR), (volatile LAS unsigned*)(lds + LDS_BYTES - 64), wave == 0 && mk_lane() == 0); \
               if ((PROBE_MASK >> 14) & 1) xcd_barrier((unsigned*)(wsb_ + WS_BAR), (volatile LAS unsigned*)(lds + LDS_BYTES - 64), wave == 0 && mk_lane() == 0); } } } while (0)

    if (IN(0)) for (int rep_ = 0; rep_ < NREP(0); ++rep_) { PH_BEGIN
        const float* x = KIN(0);
        LAS float* scr = (LAS float*)(lds + wave * 16640);
        constexpr int I_FFN = 3 * 2816, I_IN = 32 * 96, I_OUT = 32 * 32;
        for (int it = gw; it < I_FFN + I_IN + I_OUT; it += NGW) {
            if (it < I_FFN) cvt_ffn_item(it, KIN(2), KIN(3), KIN(4), KIN(1), Wgu, Wd, scr, lane);
            else if (it < I_FFN + I_IN) { const int r = it - I_FFN, kb = r / 96, nb = r % 96; cvt_item(KIN(6), NIN, NIN, KIN(5), Win, DM, nb * 64, kb * 64, nb * 64, scr, lane); }
            else { const int r = it - I_FFN - I_IN, kb = r / 32, nb = r % 32; cvt_item(KIN(17), DM, DM, nullptr, Wout, DM, nb * 64, kb * 64, nb * 64, scr, lane); }
        }
        for (int m = gw; m < S_; m += NGW) {
            const f32x4* xr = (const f32x4*)(x + (size_t)m * DM) + lane; f32x4 v[8]; float s = 0.f;
#pragma unroll
            for (int j = 0; j < 8; ++j) { v[j] = xr[64 * j]; s += (v[j][0] * v[j][0] + v[j][1] * v[j][1]) + (v[j][2] * v[j][2] + v[j][3] * v[j][3]); }
            const float rs = 1.0f / sqrtf(wave_sum(s) * (1.0f / DM) + 1e-6f);
            v2u* o8 = (v2u*)(XN + (size_t)m * DM) + lane;
#pragma unroll
            for (int j = 0; j < 8; ++j) { v2u w; w.x = pk2(v[j][0] * rs, v[j][1] * rs); w.y = pk2(v[j][2] * rs, v[j][3] * rs); o8[64 * j] = w; }
        }
        for (int i = blockIdx.x * NTHR + tid; i < 2 * S_; i += G * NTHR) rowss1[i] = 0.f;
        for (int k = blockIdx.x * NTHR + tid; k < DM + 8; k += G * NTHR) {
            unsigned char* gwp = ws + WS_GW; f32x4 w0 = (f32x4){0.f, 0.f, 0.f, 0.f}, w1 = w0;
            if (k < DM) { const float gk = KIN(5)[k]; w0 = *(const f32x4*)(KIN(6) + (size_t)k * NIN + 6144) * gk; w1 = *(const f32x4*)(KIN(6) + (size_t)k * NIN + 6148) * gk; }
#pragma unroll
            for (int j = 0; j < 4; ++j) { *(unsigned short*)(gwp + j * GWP + k * 2) = (unsigned short)f2bf(w0[j]); *(unsigned short*)(gwp + (4 + j) * GWP + k * 2) = (unsigned short)f2bf(w1[j]);
                *(unsigned short*)(gwp + (8 + j) * GWP + k * 2) = 0; *(unsigned short*)(gwp + (12 + j) * GWP + k * 2) = 0; }
        }
    }
    SYNC(0);
    if (IN(1)) { PH_BEGIN
        pg8::Gemm g{XN, Wgu, S_, 2 * FF, DM}; pg8::StaticOrder So; So.init(S_, 2 * FF, G, (int)blockIdx.x);
        pg8::EpiSwiGLU E{BIG, FF, nullptr, 0.f};
        STAGGER_DELAY(1); for (int rep_ = 0; rep_ < NREP(1); ++rep_) pg8::gemm_phase<pg8::EpiSwiGLU, pg8::StaticOrder, true, true>(lds, g, So, E, wave);
    }
    SYNC(1);
    if (IN(2)) { PH_BEGIN
        pg8::Gemm g{BIG, Wd, S_, DM, FF}; pg8::StaticOrder So; So.init(S_, DM, G, (int)blockIdx.x);
        pg8::EpiResid E{KIN(0), out, XN, rowss1, 0.5f, DM};
        STAGGER_DELAY(3); pg8::gemm_phase<pg8::EpiResid, pg8::StaticOrder, true, true>(lds, g, So, E, wave);
    }
    SYNC(2);
    if (IN(3)) { PH_BEGIN
        pg8::Gemm g{XN, Win, S_, NINP, DM}; pg8::StaticOrder So; So.init(S_, NINP, G, (int)blockIdx.x);
        pg8::EpiProj E{BIG, rowss1, 1.0f / DM};
        STAGGER_DELAY(1); for (int rep_ = 0; rep_ < NREP(3); ++rep_) pg8::gemm_phase<pg8::EpiProj, pg8::StaticOrder, true, true>(lds, g, So, E, wave);
        {
            const v4u* src = (const v4u*)(ws + WS_GW);
            for (int i = tid; i < 16 * GWP / 16; i += NTHR) *(LAS v4u*)(lds + 16384 + i * 16) = src[i];
            __syncthreads();
        }
        for (int rep_ = 0; rep_ < NREP(13); ++rep_) for (int rb = blockIdx.x; rb < S_ / 64; rb += G) gates_rows(lds, XN, rowss1, KIN(14), KIN(15), GATES, rb, wave, lane);
    }
    SYNC(3);
    if (IN(4)) { PH_BEGIN for (int item = blockIdx.x; item < 512 * NREP(4); item += G) mlstm_stage_a(lds, PROJM, GATES, KIN(12), KIN(13), QC, KC, DELTA, DN, SC, item & 511, wave); }
    SYNC(4);
    if (IN(5)) { PH_BEGIN for (int rep_ = 0; rep_ < NREP(5); ++rep_) mlstm_scan(DELTA, DN, SC, SC + 1024, CT, NST, blockIdx.x * NTHR + tid, G * NTHR); }
    SYNC(5);
    if (IN(6)) { PH_BEGIN
#ifndef NO_ATTN
#if ATTN2
        attn2_phase((char*)lds_raw, BIG, OATT, 512 * NREP(6), wave);
#else
        attn_phase((char*)lds_raw, BIG, OATT, 512 * NREP(6), wave);
#endif
#endif
        __syncthreads();
#ifndef NO_STAGEC
        for (int rep_ = 0; rep_ < NREP(12); ++rep_) for (int item = blockIdx.x; item < 512; item += G) mlstm_stage_c(lds, PROJM, GATES, QC, KC, CT, NST, SC + 1024, KIN(16), Y, item, wave);
#endif
    }
    SYNC(6);
    if (IN(7)) for (int rep_ = 0; rep_ < NREP(7); ++rep_) { PH_BEGIN
        const float l1 = wave_sum(KIN(7)[lane] * KIN(8)[lane] + KIN(7)[lane + 64] * KIN(8)[lane + 64]);
        const float l2 = wave_sum(KIN(9)[lane] * KIN(10)[lane] + KIN(9)[lane + 64] * KIN(10)[lane + 64]);
        const float lam = expf(l1) - expf(l2) + 0.2f;
        const float* hg = KIN(11);
        for (int m = gw; m < S_; m += NGW) {
#pragma unroll
            for (int h = 0; h < 4; ++h) {
                const v2u a = *((const v2u*)(OATT + (size_t)m * 2048 + h * 512) + lane), b = *((const v2u*)(OATT + (size_t)m * 2048 + h * 512 + 256) + lane);
                float y0 = bf2f(a.x & 0xffffu) - lam * bf2f(b.x & 0xffffu), y1 = bf2f(a.x >> 16) - lam * bf2f(b.x >> 16), y2 = bf2f(a.y & 0xffffu) - lam * bf2f(b.y & 0xffffu), y3 = bf2f(a.y >> 16) - lam * bf2f(b.y >> 16);
                const float rs = 0.8f / sqrtf(wave_sum((y0 * y0 + y1 * y1) + (y2 * y2 + y3 * y3)) * (1.0f / 256.0f) + 1e-6f);
                const f32x4 gn = *((const f32x4*)(hg + h * 256) + lane);
                v2u w; w.x = pk2(y0 * rs * gn[0], y1 * rs * gn[1]); w.y = pk2(y2 * rs * gn[2], y3 * rs * gn[3]);
                *((v2u*)(Y + (size_t)m * DM + h * 256) + lane) = w;
            }
        }
        LAS float* scr = (LAS float*)(lds + wave * 16640);
        for (int it = gw; it < 3 * 2816; it += NGW) cvt_ffn_item(it, KIN(19), KIN(20), KIN(21), KIN(18), Wgu, Wd, scr, lane);
    }
    SYNC(7);
    if (IN(8)) { PH_BEGIN
        pg8::Gemm g{Y, Wout, S_, DM, DM}; pg8::StaticOrder So; So.init(S_, DM, G, (int)blockIdx.x);
        pg8::EpiResid E{out, out, XN, rowss2, 1.0f, DM};
        STAGGER_DELAY(3); pg8::gemm_phase<pg8::EpiResid, pg8::StaticOrder, true, true>(lds, g, So, E, wave);
    }
    SYNC(8);
    if (IN(9)) { PH_BEGIN
        pg8::Gemm g{XN, Wgu, S_, 2 * FF, DM}; pg8::StaticOrder So; So.init(S_, 2 * FF, G, (int)blockIdx.x);
        pg8::EpiSwiGLU E{BIG, FF, rowss2, 1.0f / DM};
        STAGGER_DELAY(1); pg8::gemm_phase<pg8::EpiSwiGLU, pg8::StaticOrder, true, true>(lds, g, So, E, wave);
    }
    SYNC(9);
    if (IN(10)) { PH_BEGIN
        pg8::Gemm g{BIG, Wd, S_, DM, FF}; pg8::StaticOrder So; So.init(S_, DM, G, (int)blockIdx.x);
        pg8::EpiResid E{out, out, nullptr, nullptr, 0.5f, DM};
        STAGGER_DELAY(3); pg8::gemm_phase<pg8::EpiResid, pg8::StaticOrder, true, true>(lds, g, So, E, wave);
    }
    SYNC(10);
    if (IN(11)) { PH_BEGIN
        const float* fg = KIN(22);
        for (int m = gw; m < S_; m += NGW) {
            f32x4* xr = (f32x4*)(out + (size_t)m * DM) + lane; f32x4 v[8]; float s = 0.f;
#pragma unroll
            for (int j = 0; j < 8; ++j) { v[j] = xr[64 * j]; s += (v[j][0] * v[j][0] + v[j][1] * v[j][1]) + (v[j][2] * v[j][2] + v[j][3] * v[j][3]); }
            const float rs = 1.0f / sqrtf(wave_sum(s) * (1.0f / DM) + 1e-6f);
#pragma unroll
            for (int j = 0; j < 8; ++j) { const f32x4 gn = *((const f32x4*)fg + 64 * j + lane); xr[64 * j] = v[j] * rs * gn; }
        }
    }
#undef IN
#undef SYNC
}

extern "C" void kernel_launch(void* const* d_in, const int* in_sizes, int n_in, void* d_out, int out_size, void* d_ws, size_t ws_size, hipStream_t stream) {
    static int grid = 0;
    if (grid == 0) {
        if (n_in != 23 || in_sizes[0] != S_ * DM || out_size != S_ * DM || ws_size < WS_END) { fprintf(stderr, "kernel_launch: unexpected shapes (n_in %d, in0 %d, out %d, ws %zu)\n", n_in, n_in > 0 ? in_sizes[0] : -1, out_size, ws_size); grid = -1; return; }
        int dev = 0, cus = 0, per_cu = 0;
        (void)hipGetDevice(&dev); (void)hipDeviceGetAttribute(&cus, hipDeviceAttributeMultiprocessorCount, dev);
        if (hipFuncSetAttribute((const void*)mega_fwd, hipFuncAttributeMaxDynamicSharedMemorySize, LDS_BYTES) != hipSuccess) { fprintf(stderr, "kernel_launch: hipFuncSetAttribute failed\n"); grid = -1; return; }
        if (hipOccupancyMaxActiveBlocksPerMultiprocessor(&per_cu, (const void*)mega_fwd, NTHR, LDS_BYTES) != hipSuccess || per_cu < 1) per_cu = 1;
        grid = cus * per_cu;
        fprintf(stderr, "kernel_launch: grid %d (%d CUs x %d)\n", grid, cus, per_cu);
    }
    if (grid < 0) return;
    Args a{};
    for (int i = 0; i < 23; ++i) a.in[i] = (const float*)d_in[i];
    a.out = (float*)d_out; a.ws = (unsigned char*)d_ws;
#if MK_SPLIT
    for (int p = 0; p < NPH; ++p) { a.ph_lo = p; a.ph_hi = p + 1; hipLaunchKernelGGL(mega_fwd, dim3(grid), dim3(NTHR), LDS_BYTES, stream, a); }
#else
    a.ph_lo = 0; a.ph_hi = NPH;
    (void)hipMemsetAsync((char*)d_ws + WS_BAR, 0, XCD_BAR_WORDS * 4, stream);
    void* kargs[] = {&a};
    hipError_t e = hipLaunchCooperativeKernel((const void*)mega_fwd, dim3(grid), dim3(NTHR), kargs, LDS_BYTES, stream);
    if (e != hipSuccess) fprintf(stderr, "kernel_launch: cooperative launch failed: %s (grid %d)\n", hipGetErrorString(e), grid);
#endif
}
```

```cpp
#include <hip/hip_runtime.h>
#include <hip/hip_bf16.h>
#include <hip/hip_cooperative_groups.h>
#include <cstdio>
#include <cstdint>
namespace cg = cooperative_groups;

#ifndef MK_SPLIT
#define MK_SPLIT 0
#endif

namespace pg8 {
#define PG8_LAS __attribute__((address_space(3)))
typedef unsigned short bf16_t;
typedef short bf16x8 __attribute__((ext_vector_type(8)));
typedef float f32x4 __attribute__((ext_vector_type(4)));
typedef unsigned u32x4 __attribute__((ext_vector_type(4)));
constexpr int BM = 256, BK = 64, HALF = 128, HTB = HALF * BK * 2  , STAGE_BYTES = 8 * HTB, NXCD = 8, WGM = 8;

__host__ __device__ __forceinline__ int lds_byte(int r, int c) { const int st = (r >> 4) * 2 + (c >> 5), rr = r & 15, cc = c & 31, ob = rr * 64 + cc * 2; return st * 1024 + (ob ^ (((ob >> 9) & 1) << 5)); }
__host__ __device__ __forceinline__ void stage_rc(int b, int& R, int& C) { const int st = b / 1024, sb = b % 1024, swz = sb ^ (((sb >> 9) & 1) << 5); R = (st >> 1) * 16 + swz / 64; C = (st & 1) * 32 + (swz % 64) / 2; }
__host__ __device__ __forceinline__ int perm32(int rho) { const int n = rho >> 4, i = rho & 15; return 8 * (i >> 2) + 4 * n + (i & 3); }

struct Unit { int pm, pn; };
struct Gemm { const bf16_t* A; const bf16_t* Bt; int M, N, K; };

struct StaticOrder {
    int nM, nN, nwg, G, c;
    __host__ __device__ void init(int M, int N, int G_, int c_) { nM = M / BM; nN = N / BM; nwg = nM * nN; G = G_; c = c_; }
    __host__ __device__ bool next(int i, Unit& u) const {
        const long L = (long)i * G + c; if (L >= nwg) return false;
        int wgid = (int)L; { const int q = nwg / NXCD, r = nwg % NXCD, xcd = wgid % NXCD, off = wgid / NXCD; wgid = (xcd < r ? xcd * (q + 1) : r * (q + 1) + (xcd - r) * q) + off; }
        const int nig = WGM * nN, gid = wgid / nig, fm = gid * WGM, gsz = (nM - fm) < WGM ? (nM - fm) : WGM;
        u.pm = fm + ((wgid % nig) % gsz); u.pn = (wgid % nig) / gsz; return true;
    }
    __device__ __forceinline__ void a_ready(const Unit&) const {}
    __device__ __forceinline__ void done(const Unit&) const {}
};

__device__ __forceinline__ unsigned cvt_pk_bf16(float lo, float hi) { unsigned r; asm volatile("v_cvt_pk_bf16_f32 %0, %1, %2" : "=v"(r) : "v"(lo), "v"(hi)); return r; }

constexpr float RMS_EPS = 1e-6f;
__device__ __forceinline__ float silu_f(float x) { return x * __builtin_amdgcn_rcpf(1.0f + __builtin_amdgcn_exp2f(-1.4426950408889634f * x)); }
struct EpiSwiGLU {
    static constexpr bool PERM = true, AFTER_DRAIN = false;
    bf16_t* O; int ldo; const float* rowss; float inv_n;
    __device__ __forceinline__ void operator()(const f32x4 (&acc)[2][2][4][2], const Unit& u, int wr, int wc, int fr, int fq) const {
        const int row0 = u.pm * BM + wr * 64 + fr, col0 = u.pn * HALF + wc * 32 + 8 * fq;
#pragma unroll
        for (int ai = 0; ai < 2; ++ai)
#pragma unroll
            for (int m = 0; m < 4; ++m) {
                const int r = row0 + ai * HALF + m * 16;
                const float rs = rowss ? __builtin_amdgcn_rsqf(rowss[r] * inv_n + RMS_EPS) : 1.0f;
                const f32x4 g0 = acc[ai][0][m][0] * rs, g1 = acc[ai][0][m][1] * rs, u0 = acc[ai][1][m][0] * rs, u1 = acc[ai][1][m][1] * rs;
                u32x4 w;
                w.x = cvt_pk_bf16(silu_f(g0[0]) * u0[0], silu_f(g0[1]) * u0[1]); w.y = cvt_pk_bf16(silu_f(g0[2]) * u0[2], silu_f(g0[3]) * u0[3]);
                w.z = cvt_pk_bf16(silu_f(g1[0]) * u1[0], silu_f(g1[1]) * u1[1]); w.w = cvt_pk_bf16(silu_f(g1[2]) * u1[2], silu_f(g1[3]) * u1[3]);
                *(u32x4*)(O + (size_t)r * ldo + col0) = w;
            }
    }
};
struct EpiResid {
    static constexpr bool PERM = false, AFTER_DRAIN = false;
    const float* resid; float* out; bf16_t* xb; float* rowss; float alpha; int ld;
    __device__ __forceinline__ void operator()(const f32x4 (&acc)[2][2][4][2], const Unit& u, int wr, int wc, int fr, int fq) const {
        typedef unsigned u32x2v __attribute__((ext_vector_type(2)));
        const int row0 = u.pm * BM + wr * 64 + fr, col0 = u.pn * BM + wc * 32 + 4 * fq;
#pragma unroll
        for (int ai = 0; ai < 2; ++ai)
#pragma unroll
            for (int m = 0; m < 4; ++m) {
                const int r = row0 + ai * HALF + m * 16; float ss = 0.f;
#pragma unroll
                for (int bj = 0; bj < 2; ++bj)
#pragma unroll
                    for (int n = 0; n < 2; ++n) {
                        const size_t off = (size_t)r * ld + col0 + bj * HALF + n * 16;
                        const f32x4 b = *(const f32x4*)(resid + off); const f32x4 o = b + acc[ai][bj][m][n] * alpha;
                        *(f32x4*)(out + off) = o; ss += (o[0] * o[0] + o[1] * o[1]) + (o[2] * o[2] + o[3] * o[3]);
                        if (xb) { u32x2v w; w.x = cvt_pk_bf16(o[0], o[1]); w.y = cvt_pk_bf16(o[2], o[3]); *(u32x2v*)(xb + off) = w; }
                    }
                if (rowss) { ss += __shfl_xor(ss, 16); ss += __shfl_xor(ss, 32); if (fq == 0) atomicAdd(rowss + r, ss); }
            }
    }
};
struct EpiProj {
    static constexpr bool PERM = true, AFTER_DRAIN = false;
    bf16_t* O; const float* rowss; float inv_n;
    __device__ __forceinline__ void operator()(const f32x4 (&acc)[2][2][4][2], const Unit& u, int wr, int wc, int fr, int fq) const {
        const int row0 = u.pm * BM + wr * 64 + fr;
        {
            const bool dense = u.pn < 12;
            const size_t rstride = dense ? 128 : 3072;
            bf16_t* base = dense ? O + (size_t)(2 * u.pn) * ((size_t)16384 * 128) + wc * 32 + 8 * fq : O + (size_t)24 * 16384 * 128 + (u.pn - 12) * BM + wc * 32 + 8 * fq;
            const size_t bjstep = dense ? (size_t)16384 * 128 : 128;
#pragma unroll
            for (int ai = 0; ai < 2; ++ai)
#pragma unroll
                for (int m = 0; m < 4; ++m) {
                    const int r = row0 + ai * HALF + m * 16; const float rs = __builtin_amdgcn_rsqf(rowss[r] * inv_n + RMS_EPS);
#pragma unroll
                    for (int bj = 0; bj < 2; ++bj) { const f32x4 v0 = acc[ai][bj][m][0] * rs, v1 = acc[ai][bj][m][1] * rs; u32x4 w;
                        w.x = cvt_pk_bf16(v0[0], v0[1]); w.y = cvt_pk_bf16(v0[2], v0[3]); w.z = cvt_pk_bf16(v1[0], v1[1]); w.w = cvt_pk_bf16(v1[2], v1[3]);
                        *(u32x4*)(base + (size_t)r * rstride + bj * bjstep) = w; }
                }
        }
    }
};
template <class Epi, class Sched, bool ALIGN_EPI = false, bool SP2 = false>
__device__ __forceinline__ void gemm_phase(PG8_LAS unsigned char* lds, const Gemm g, const Sched& S, const Epi& E, const int mk_wave) {
    const int lane = (int)(__builtin_amdgcn_mbcnt_hi(~0u, __builtin_amdgcn_mbcnt_lo(~0u, 0u)) & 63u), wid = mk_wave & 7, tid = wid * 64 + lane, wr = wid >> 2, wc = wid & 3, fr = lane & 15, fq = lane >> 4;
    const int K = g.K, nt = K / BK;
    unsigned voffA[2], voffB[2];
#pragma unroll
    for (int i = 0; i < 2; ++i) { int R, C; stage_rc(tid * 16 + i * 8192, R, C); const int Rb = Epi::PERM ? ((R & ~31) + perm32(R & 31)) : R;
        voffA[i] = (unsigned)(R * K + C) * 2u; voffB[i] = (unsigned)(Rb * K + C) * 2u; }
    const size_t kstep = (size_t)(BK * 2);
    const size_t hstep = (size_t)HALF * K * 2;
    const size_t tstep = 2 * hstep;
    const unsigned ldsw = (unsigned)wid * 1024u;
    const int aoff = lds_byte(wr * 64 + fr, fq * 8), boff = lds_byte(wc * 32 + fr, fq * 8);
#define PG8_SA(b, h) (((b) * 2 + (h)) * HTB)
#define PG8_SB(b, h) ((4 + (b) * 2 + (h)) * HTB)
#define PG8_STAGE(bufoff, gbase, voff) do { _Pragma("unroll") for (int _i = 0; _i < 2; ++_i) \
        __builtin_amdgcn_global_load_lds((const unsigned*)((const char*)(gbase) + (voff)[_i]), (PG8_LAS unsigned*)(lds + (bufoff) + ldsw + _i * 8192), 16, 0, 0); } while (0)
#define PG8_LDA(dst, b, h) do { _Pragma("unroll") for (int m = 0; m < 4; ++m) _Pragma("unroll") for (int k = 0; k < 2; ++k) dst[m][k] = *(const PG8_LAS bf16x8*)(lds + PG8_SA(b, h) + aoff + m * 2048 + k * 1024); } while (0)
#define PG8_LDB(dst, b, h) do { _Pragma("unroll") for (int n = 0; n < 2; ++n) _Pragma("unroll") for (int k = 0; k < 2; ++k) dst[n][k] = *(const PG8_LAS bf16x8*)(lds + PG8_SB(b, h) + boff + n * 2048 + k * 1024); } while (0)
#define PG8_MMA(ai, bj, At, Bt) do { __builtin_amdgcn_s_setprio(1); _Pragma("unroll") for (int m = 0; m < 4; ++m) _Pragma("unroll") for (int n = 0; n < 2; ++n) _Pragma("unroll") for (int k = 0; k < 2; ++k) \
        acc[ai][bj][m][n] = __builtin_amdgcn_mfma_f32_16x16x32_bf16(Bt[n][k], At[m][k], acc[ai][bj][m][n], 0, 0, 0); __builtin_amdgcn_s_setprio(0); } while (0)
#define PG8_WAIT_V(n) asm volatile("s_waitcnt vmcnt(" #n ")" ::: "memory")
#define PG8_WAIT_L(n) asm volatile("s_waitcnt lgkmcnt(" #n ")" ::: "memory")
#define PG8_BAR __builtin_amdgcn_s_barrier()
#define PG8_SCHED __builtin_amdgcn_sched_barrier(0)
    Unit cur, nxt; int ui = 0;
    if (!S.next(0, cur)) return;
    f32x4 acc[2][2][4][2];
#pragma unroll
    for (int a = 0; a < 2; ++a)
#pragma unroll
        for (int b = 0; b < 2; ++b)
#pragma unroll
            for (int m = 0; m < 4; ++m)
#pragma unroll
                for (int n = 0; n < 2; ++n) acc[a][b][m][n] = (f32x4){0.f, 0.f, 0.f, 0.f};
    bf16x8 At[4][2], B0[2][2], B1[2][2];
    const char* cA = (const char*)g.A + (size_t)cur.pm * tstep; const char* cB = (const char*)g.Bt + (size_t)cur.pn * tstep;
    S.a_ready(cur);
    if constexpr (SP2) {
        PG8_STAGE(PG8_SB(0, 0), cB, voffB); PG8_STAGE(PG8_SB(0, 1), cB + hstep, voffB); PG8_STAGE(PG8_SA(0, 0), cA, voffA); PG8_STAGE(PG8_SA(0, 1), cA + hstep, voffA);
        if (wr == 1) PG8_BAR;
        PG8_WAIT_V(2); PG8_BAR;
        PG8_STAGE(PG8_SB(1, 0), cB + kstep, voffB); PG8_STAGE(PG8_SA(1, 0), cA + kstep, voffA); PG8_STAGE(PG8_SB(1, 1), cB + hstep + kstep, voffB);
        PG8_WAIT_V(6); PG8_BAR;
    } else {
        PG8_STAGE(PG8_SB(0, 0), cB, voffB); PG8_STAGE(PG8_SA(0, 0), cA, voffA); PG8_STAGE(PG8_SB(0, 1), cB + hstep, voffB); PG8_STAGE(PG8_SA(0, 1), cA + hstep, voffA);
        if (wr == 1) PG8_BAR;
        PG8_WAIT_V(4); PG8_BAR;
        PG8_STAGE(PG8_SB(1, 0), cB + kstep, voffB); PG8_STAGE(PG8_SA(1, 0), cA + kstep, voffA); PG8_STAGE(PG8_SB(1, 1), cB + hstep + kstep, voffB);
        PG8_WAIT_V(6); PG8_BAR;
    }
    for (;;) {
        const bool has_next = S.next(ui + 1, nxt);
        const char* nA = has_next ? (const char*)g.A + (size_t)nxt.pm * tstep : cA; const char* nB = has_next ? (const char*)g.Bt + (size_t)nxt.pn * tstep : cB;
        for (int t = 0; t < nt; t += 2) {
            const bool last = (t == nt - 2);
            const char* a1 = cA + (size_t)(t + 1) * kstep;
            const char* a2 = last ? nA : cA + (size_t)(t + 2) * kstep; const char* b2 = last ? nB : cB + (size_t)(t + 2) * kstep;
            const char* a3 = a2 + kstep; const char* b3 = b2 + kstep;
            if (last && has_next) S.a_ready(nxt);
            if constexpr (SP2) {
            PG8_LDB(B0, 0, 0); PG8_LDB(B1, 0, 1); PG8_SCHED; PG8_LDA(At, 0, 0); PG8_STAGE(PG8_SA(1, 1), a1 + hstep, voffA);
            PG8_WAIT_V(8); PG8_WAIT_L(0); PG8_BAR; PG8_MMA(0, 0, At, B0); PG8_MMA(0, 1, At, B1); PG8_BAR; PG8_SCHED;
            PG8_LDA(At, 0, 1); PG8_STAGE(PG8_SB(0, 0), b2, voffB); PG8_STAGE(PG8_SB(0, 1), b2 + hstep, voffB); PG8_STAGE(PG8_SA(0, 0), a2, voffA);
            PG8_WAIT_V(8); PG8_WAIT_L(0); PG8_BAR; PG8_MMA(1, 0, At, B0); PG8_MMA(1, 1, At, B1); PG8_BAR; PG8_SCHED;
            PG8_LDB(B0, 1, 0); PG8_LDB(B1, 1, 1); PG8_SCHED; PG8_LDA(At, 1, 0); PG8_STAGE(PG8_SA(0, 1), a2 + hstep, voffA);
            PG8_WAIT_V(8); PG8_WAIT_L(0); PG8_BAR; PG8_MMA(0, 0, At, B0); PG8_MMA(0, 1, At, B1); PG8_BAR; PG8_SCHED;
            PG8_LDA(At, 1, 1); PG8_STAGE(PG8_SB(1, 0), b3, voffB); PG8_STAGE(PG8_SB(1, 1), b3 + hstep, voffB); PG8_STAGE(PG8_SA(1, 0), a3, voffA);
            PG8_WAIT_V(8); PG8_WAIT_L(0); PG8_BAR; PG8_MMA(1, 0, At, B0); PG8_MMA(1, 1, At, B1); PG8_BAR; PG8_SCHED;
            } else {
            PG8_LDB(B0, 0, 0); PG8_SCHED; PG8_LDA(At, 0, 0); PG8_STAGE(PG8_SA(1, 1), a1 + hstep, voffA);
            PG8_WAIT_L(8); PG8_BAR; PG8_WAIT_L(0); PG8_MMA(0, 0, At, B0); PG8_BAR; PG8_SCHED;
            PG8_LDB(B1, 0, 1); PG8_STAGE(PG8_SB(0, 0), b2, voffB);
            PG8_BAR; PG8_WAIT_L(0); PG8_MMA(0, 1, At, B1); PG8_BAR;
            PG8_LDA(At, 0, 1); PG8_STAGE(PG8_SA(0, 0), a2, voffA);
            PG8_BAR; PG8_WAIT_L(0); PG8_MMA(1, 0, At, B0); PG8_BAR; PG8_SCHED;
            PG8_STAGE(PG8_SB(0, 1), b2 + hstep, voffB);
            PG8_WAIT_V(6); PG8_BAR; PG8_MMA(1, 1, At, B1); PG8_BAR;
            PG8_LDB(B0, 1, 0); PG8_SCHED; PG8_LDA(At, 1, 0); PG8_STAGE(PG8_SA(0, 1), a2 + hstep, voffA);
            PG8_WAIT_L(8); PG8_BAR; PG8_WAIT_L(0); PG8_MMA(0, 0, At, B0); PG8_BAR; PG8_SCHED;
            PG8_LDB(B1, 1, 1); PG8_STAGE(PG8_SB(1, 0), b3, voffB);
            PG8_BAR; PG8_WAIT_L(0); PG8_MMA(0, 1, At, B1); PG8_BAR;
            PG8_LDA(At, 1, 1); PG8_STAGE(PG8_SA(1, 0), a3, voffA);
            PG8_BAR; PG8_WAIT_L(0); PG8_MMA(1, 0, At, B0); PG8_BAR; PG8_SCHED;
            PG8_STAGE(PG8_SB(1, 1), b3 + hstep, voffB);
            PG8_WAIT_V(6); PG8_BAR; PG8_MMA(1, 1, At, B1); PG8_BAR;
            }
        }
        if constexpr (ALIGN_EPI) { if (wr == 0) PG8_BAR; }
        if constexpr (!Epi::AFTER_DRAIN) { E(acc, cur, wr, wc, fr, fq); S.done(cur); }
        if (!has_next) break;
#pragma unroll
        for (int a = 0; a < 2; ++a)
#pragma unroll
            for (int b = 0; b < 2; ++b)
#pragma unroll
                for (int m = 0; m < 4; ++m)
#pragma unroll
                    for (int n = 0; n < 2; ++n) acc[a][b][m][n] = (f32x4){0.f, 0.f, 0.f, 0.f};
        cur = nxt; cA = nA; cB = nB; ++ui;
        if constexpr (ALIGN_EPI) { if (wr == 1) PG8_BAR; }
    }
    PG8_WAIT_V(0);
    if constexpr (!ALIGN_EPI) { if (wr == 0) PG8_BAR; }
    PG8_BAR;
    if constexpr (Epi::AFTER_DRAIN) { E.fused(acc, cur, wr, wc, fr, fq, lds, wid, lane); S.done(cur); }
#undef PG8_SA
#undef PG8_SB
#undef PG8_STAGE
#undef PG8_LDA
#undef PG8_LDB
#undef PG8_MMA
#undef PG8_WAIT_V
#undef PG8_WAIT_L
#undef PG8_BAR
#undef PG8_SCHED
}
}

namespace att {
constexpr int D = 128; constexpr float THR = 8.f; constexpr bool WSKIP = false; constexpr int LDP = 128, LDO = 2048;
constexpr float SCALE = 0.08838834764831845f;
constexpr int NW = 8, QBLK = 32, KVBLK = 64, QB = NW * QBLK;
constexpr int SHM_V = KVBLK * D * 2, SHM_K = KVBLK * D * 2;
constexpr int LDS_BYTES = 2 * SHM_V + 2 * SHM_K + NW * 64 * 4;

using bf16 = __hip_bfloat16;
typedef short bf16x8 __attribute__((ext_vector_type(8)));
typedef short s16x4 __attribute__((ext_vector_type(4)));
typedef float f32x16 __attribute__((ext_vector_type(16)));
typedef float f32x4 __attribute__((ext_vector_type(4)));
typedef unsigned u32x4 __attribute__((ext_vector_type(4)));
template <class A, class Bt> struct same_t { static constexpr bool v = false; };
template <class A> struct same_t<A, A> { static constexpr bool v = true; };

#define KSWZ(row, colB) ((row) * 256 + ((colB) ^ (((row) & 7) << 4)))
#define SBAR() __builtin_amdgcn_sched_barrier(0)
__device__ __forceinline__ int v_st(int k, int c) { const int kk = (k & ~0xC) | ((k & 4) << 1) | ((k & 8) >> 1); return ((kk >> 3) * 4 + (c >> 5)) * 512 + ((kk & 7) * 32 + (c & 31)) * 2; }
__device__ __forceinline__ int v_rd_base(int lane) { return ((lane & 3) << 3) | (((lane >> 2) & 3) << 6) | (((lane >> 4) & 1) << 5) | (((lane >> 5) & 1) << 8); }
constexpr int v_rd_off(int d0, int ks, int half) { return d0 * 512 + ks * 4096 + half * 2048; }
__device__ __forceinline__ int crow(int r, int hi) { return (r & 3) + 8 * (r >> 2) + 4 * hi; }
__device__ __forceinline__ unsigned cvtpk(float lo, float hi) {
    unsigned r; asm volatile("v_cvt_pk_bf16_f32 %0, %1, %2" : "=v"(r) : "v"(lo), "v"(hi)); return r;
}
__device__ __forceinline__ bf16x8 pack8(f32x4 a, f32x4 b) {
    u32x4 w = {cvtpk(a[0], a[1]), cvtpk(a[2], a[3]), cvtpk(b[0], b[1]), cvtpk(b[2], b[3])};
    return *reinterpret_cast<bf16x8*>(&w);
}
template <class T> __device__ __forceinline__ bf16x8 load8(const T* p) {
    if constexpr (same_t<T, float>::v) { return pack8(*(const f32x4*)p, *(const f32x4*)(p + 4)); }
    else { return *reinterpret_cast<const bf16x8*>(p); }
}
__device__ __forceinline__ void mask_tile(f32x16& p0, f32x16& p1, int dq, unsigned W) {
    const float NEG = -__builtin_inff();
#pragma unroll
    for (int r = 0; r < 16; ++r) {
        const int c = (r & 3) + 8 * (r >> 2);
        if ((unsigned)(dq - c) >= W) p0[r] = NEG;
        if ((unsigned)(dq - c - 32) >= W) p1[r] = NEG;
    }
}
__device__ __forceinline__ void partialSM(f32x16& p0, f32x16& p1, float& m_reg, float& mn, float& alpha) {
    float pmax = p0[0]; for (int r = 1; r < 16; ++r) pmax = fmaxf(pmax, p0[r]); for (int r = 0; r < 16; ++r) pmax = fmaxf(pmax, p1[r]);
    { auto rr = __builtin_amdgcn_permlane32_swap(__float_as_uint(pmax), __float_as_uint(pmax), false, false);
      pmax = fmaxf(__uint_as_float(rr[0]), __uint_as_float(rr[1])); }
    constexpr float C2 = 1.4426950408889634f * SCALE;
    if (__builtin_expect(__all((pmax - m_reg) * SCALE <= THR), 1)) { mn = m_reg; alpha = 1.f; }
    else { mn = fmaxf(m_reg, pmax); alpha = __builtin_amdgcn_exp2f((m_reg - mn) * C2); m_reg = mn; }
    const float mnL = -mn * C2;
    for (int r = 0; r < 16; ++r) p0[r] = fmaf(p0[r], C2, mnL); for (int r = 0; r < 16; ++r) p1[r] = fmaf(p1[r], C2, mnL);
    for (int r = 0; r < 16; ++r) p0[r] = __builtin_amdgcn_exp2f(p0[r]);
}
__device__ __forceinline__ void finishSM(f32x16& p0, f32x16& p1, float alpha, float& l_reg, bf16x8& pa0, bf16x8& pa1, bf16x8& pa2, bf16x8& pa3) {
    for (int r = 0; r < 16; ++r) p1[r] = __builtin_amdgcn_exp2f(p1[r]);
    float ps = 0; for (int r = 0; r < 16; ++r) ps += p0[r]; for (int r = 0; r < 16; ++r) ps += p1[r];
    { auto rr = __builtin_amdgcn_permlane32_swap(__float_as_uint(ps), __float_as_uint(ps), false, false);
      ps = __uint_as_float(rr[0]) + __uint_as_float(rr[1]); }
    l_reg = l_reg * alpha + ps;
#define PK4(P, B_, OUT) do { unsigned a0 = cvtpk(P[B_+0], P[B_+1]), a1 = cvtpk(P[B_+2], P[B_+3]);                          \
        unsigned b0 = cvtpk(P[B_+4], P[B_+5]), b1 = cvtpk(P[B_+6], P[B_+7]);                                             \
        auto r0 = __builtin_amdgcn_permlane32_swap(a0, b0, false, false); auto r1 = __builtin_amdgcn_permlane32_swap(a1, b1, false, false); \
        u32x4 w = {r0[0], r1[0], r0[1], r1[1]}; OUT = *reinterpret_cast<bf16x8*>(&w); } while (0)
    PK4(p0, 0, pa0); PK4(p0, 8, pa1); PK4(p1, 0, pa2); PK4(p1, 8, pa3);
#undef PK4
}
template <int KB, bool SK>
__device__ __forceinline__ void qkt(f32x16& p0, f32x16& p1, const char* K_lds, int r32, int hi, const bf16x8* qr, bool act) {
    if (SK && !act) { const float NEG = -__builtin_inff();
#pragma unroll
        for (int r = 0; r < 16; ++r) { p0[r] = NEG; p1[r] = NEG; } return; }
    p0 = f32x16{}; p1 = f32x16{};
    const char* kb[4];
#pragma unroll
    for (int dd = 0; dd < 4; ++dd) kb[dd] = K_lds + KB * SHM_K + KSWZ(r32, (dd * 16 + hi * 8) * 2);
#pragma unroll
    for (int d0 = 0; d0 < 8; ++d0) { const char* a = kb[d0 & 3] + (d0 >> 2) * 128;
        bf16x8 b0 = *reinterpret_cast<const bf16x8*>(a);
        bf16x8 b1 = *reinterpret_cast<const bf16x8*>(a + 32 * 256);
        p0 = __builtin_amdgcn_mfma_f32_32x32x16_bf16(b0, qr[d0], p0, 0, 0, 0);
        p1 = __builtin_amdgcn_mfma_f32_32x32x16_bf16(b1, qr[d0], p1, 0, 0, 0); }
}
template <int VB, bool SK>
__device__ __forceinline__ void pv_tile(f32x16* o, int vb0, bf16x8 pa0, bf16x8 pa1, bf16x8 pa2, bf16x8 pa3, bool act) {
    if (SK && !act) return;
#define TRRD(dst, off) asm volatile("ds_read_b64_tr_b16 %0, %1 offset:%2" : "=&v"(dst) : "v"(vb0), "i"(off) : "memory")
#define PV_D0(d0) do { s16x4 l0, l1, l2, l3, h0, h1, h2, h3; constexpr int b_ = VB * SHM_V + v_rd_off(d0, 0, 0);     \
        TRRD(l0, b_); TRRD(h0, b_ + 2048); TRRD(l1, b_ + 4096); TRRD(h1, b_ + 6144); TRRD(l2, b_ + 8192); TRRD(h2, b_ + 10240); TRRD(l3, b_ + 12288); TRRD(h3, b_ + 14336); \
        asm volatile("s_waitcnt lgkmcnt(0)" ::: "memory"); SBAR();                 \
        o[d0] = __builtin_amdgcn_mfma_f32_32x32x16_bf16(pa0, (bf16x8){l0[0], l0[1], l0[2], l0[3], h0[0], h0[1], h0[2], h0[3]}, o[d0], 0, 0, 0);   \
        o[d0] = __builtin_amdgcn_mfma_f32_32x32x16_bf16(pa1, (bf16x8){l1[0], l1[1], l1[2], l1[3], h1[0], h1[1], h1[2], h1[3]}, o[d0], 0, 0, 0);   \
        o[d0] = __builtin_amdgcn_mfma_f32_32x32x16_bf16(pa2, (bf16x8){l2[0], l2[1], l2[2], l2[3], h2[0], h2[1], h2[2], h2[3]}, o[d0], 0, 0, 0);   \
        o[d0] = __builtin_amdgcn_mfma_f32_32x32x16_bf16(pa3, (bf16x8){l3[0], l3[1], l3[2], l3[3], h3[0], h3[1], h3[2], h3[3]}, o[d0], 0, 0, 0); } while (0)
    PV_D0(0); PV_D0(1); PV_D0(2); PV_D0(3);
#undef PV_D0
#undef TRRD
}

template <class TIn, class TOut> struct BlockRef { const TIn* Q; const TIn* K; const TIn* V; TOut* O; int P0; };
template <class TIn> struct Seam {
    bf16x8 qr[8];
    bf16x8 st_v0, st_v1, st_k0, st_k1; f32x4 sf0, sf1, sf2, sf3;
    f32x4 tq[16];
};
__device__ __forceinline__ int swa_jlo(int P0, int W) { const int lowk = P0 - W + 1; return lowk > 0 ? lowk / KVBLK : 0; }
#define ROW(p, k0, rr) ((p) + (size_t)((k0) + (rr)) * LDP + sc)
#define VMW() asm volatile("s_waitcnt vmcnt(0)" ::: "memory")
#define VMWN(n) asm volatile("s_waitcnt vmcnt(%0)" :: "i"(n) : "memory")
#define SLOAD_H(Kp, Vp, k0) do { S.st_v0 = load8<TIn>(ROW(Vp, k0, sr)); S.st_v1 = load8<TIn>(ROW(Vp, k0, 32 + sr));              \
                         S.st_k0 = load8<TIn>(ROW(Kp, k0, sr)); S.st_k1 = load8<TIn>(ROW(Kp, k0, 32 + sr)); } while (0)
#define SWRITE_HK(bf) do { *(bf16x8*)(K_lds + (bf) * SHM_K + kws) = S.st_k0; *(bf16x8*)(K_lds + (bf) * SHM_K + kws + 32 * 256) = S.st_k1; } while (0)
#define SWRITE_HV(bf) do { *(bf16x8*)(V_lds + (bf) * SHM_V + vst0) = S.st_v0; *(bf16x8*)(V_lds + (bf) * SHM_V + vst1) = S.st_v1; } while (0)
#define SWRITE_H(bf) do { SWRITE_HV(bf); SWRITE_HK(bf); } while (0)
#define SLOAD_F(p, k0) do { S.sf0 = *(const f32x4*)ROW(p, k0, sr); S.sf1 = *(const f32x4*)(ROW(p, k0, sr) + 4);                \
                            S.sf2 = *(const f32x4*)ROW(p, k0, 32 + sr); S.sf3 = *(const f32x4*)(ROW(p, k0, 32 + sr) + 4); } while (0)
#define SWRITE_KF(bf) do { *(bf16x8*)(K_lds + (bf) * SHM_K + kws) = pack8(S.sf0, S.sf1); *(bf16x8*)(K_lds + (bf) * SHM_K + kws + 32 * 256) = pack8(S.sf2, S.sf3); } while (0)
#define SWRITE_VF(bf) do { *(bf16x8*)(V_lds + (bf) * SHM_V + vst0) = pack8(S.sf0, S.sf1); *(bf16x8*)(V_lds + (bf) * SHM_V + vst1) = pack8(S.sf2, S.sf3); } while (0)
template <class TIn, class TOut>
__device__ __forceinline__ void causal_swa_prime(const BlockRef<TIn, TOut>& cur, int W, char* lds, Seam<TIn>& S, const int mk_wave) {
    constexpr bool F32 = same_t<TIn, float>::v;
    const int lane = (int)(__builtin_amdgcn_mbcnt_hi(~0u, __builtin_amdgcn_mbcnt_lo(~0u, 0u)) & 63u), wid = mk_wave & 7, tid = wid * 64 + lane, r32 = lane & 31, hi = lane >> 5;
    const int sr = tid >> 4, sc = (tid & 15) * 8, kws = KSWZ(sr, sc * 2); char* K_lds = lds + 2 * SHM_V;
    const int kb0 = swa_jlo(cur.P0, W) * KVBLK;
    for (int d0 = 0; d0 < 8; ++d0) S.qr[d0] = load8<TIn>(cur.Q + (size_t)(wid * QBLK + r32) * LDP + d0 * 16 + hi * 8);
    if constexpr (F32) { SLOAD_F((const float*)cur.K, kb0); VMW(); SWRITE_KF(0); SBAR(); SLOAD_F((const float*)cur.V, kb0); }
    else { SLOAD_H(cur.K, cur.V, kb0); VMW(); SWRITE_HK(0); }
    __syncthreads();
}
template <class TIn, class TOut>
__device__ __forceinline__ void causal_swa_block(const BlockRef<TIn, TOut>& cur, const BlockRef<TIn, TOut>& nxt, int skv, int W, char* lds, Seam<TIn>& S, const int mk_wave) {
    constexpr bool F32 = same_t<TIn, float>::v;
    const int lane = (int)(__builtin_amdgcn_mbcnt_hi(~0u, __builtin_amdgcn_mbcnt_lo(~0u, 0u)) & 63u), wid = mk_wave & 7, tid = wid * 64 + lane, r32 = lane & 31, hi = lane >> 5;
    const int j_lo = swa_jlo(cur.P0, W);
    int j_hi = (cur.P0 + QB - 1) / KVBLK + 1; if (j_hi > skv / KVBLK) j_hi = skv / KVBLK;
    const int NT = j_hi - j_lo;
    const int kbn = swa_jlo(nxt.P0, W) * KVBLK;
    const int qlo = cur.P0 + wid * QBLK, qm = qlo + r32 - 4 * hi;
    char* V_lds = lds; char* K_lds = lds + 2 * SHM_V;
    float* ws = (float*)(lds + 2 * SHM_V + 2 * SHM_K) + wid * 64; float* li_l = ws, * al_l = ws + 32;
    float m_reg = -1e30f, l_reg = 0; f32x16 o[4] = {};
    const int sr = tid >> 4, sc = (tid & 15) * 8, vst0 = v_st(sr, sc), vst1 = v_st(32 + sr, sc), kws = KSWZ(sr, sc * 2);
    const int vb0 = (int)(uintptr_t)V_lds + v_rd_base(lane);
    const TIn* Kh = cur.K; const TIn* Vh = cur.V;
#define RESC(a) do { if (__any((a) < 1.f)) { if (hi == 0) al_l[r32] = (a); asm volatile("s_waitcnt lgkmcnt(0)" ::: "memory");              \
                     for (int d_ = 0; d_ < 4; ++d_) for (int r = 0; r < 16; ++r) o[d_][r] *= al_l[crow(r, hi)]; } } while (0)
#define KBASE(t) ((j_lo + (t)) * KVBLK)
#define ACT(t) (KBASE(t) <= qlo + QBLK - 1 && KBASE(t) + KVBLK - 1 >= qlo - W + 1)
#define MASKT(P0_, P1_, t) do { const int kb_ = KBASE(t); if ((!SK || ACT(t)) && (kb_ + KVBLK - 1 > qlo || kb_ <= qlo + QBLK - 1 - W)) mask_tile(P0_, P1_, qm - kb_, (unsigned)W); } while (0)
    constexpr int NQL = F32 ? 16 : 8;
    constexpr bool SK = WSKIP && !F32;
#define SEAM_K0() do { VMWN(NQL); if constexpr (F32) { SWRITE_KF(0); SBAR(); SLOAD_F((const float*)nxt.V, kbn); } else { SWRITE_HK(0); } SBAR(); } while (0)
    f32x16 pA0, pA1, pB0, pB1; float mnA, mnB, alA, alB; bf16x8 pa0, pa1, pa2, pa3;
    if constexpr (F32) { VMW(); SWRITE_VF(0); SBAR(); } else { SWRITE_HV(0); SBAR(); }
    if (NT > 1) { if constexpr (F32) SLOAD_F((const float*)Kh, KBASE(1)); else SLOAD_H(Kh, Vh, KBASE(1)); }
    SBAR(); qkt<0, SK>(pA0, pA1, K_lds, r32, hi, S.qr, ACT(0));
    if constexpr (F32) { if (NT > 1) { VMW(); SWRITE_KF(1); SBAR(); SLOAD_F((const float*)Vh, KBASE(1)); } }
    MASKT(pA0, pA1, 0); partialSM(pA0, pA1, m_reg, mnA, alA);
    if (NT > 1) { VMW(); if constexpr (F32) { SWRITE_VF(1); SBAR(); if (NT > 2) SLOAD_F((const float*)Kh, KBASE(2)); } else SWRITE_H(1); }
    __syncthreads();
#define HALF_STEP(PX0, PX1, mnX, alX, PY0, PY1, alY, t, KB, VB, SB) do {                                                      \
        SBAR(); qkt<KB, SK>(PX0, PX1, K_lds, r32, hi, S.qr, ACT(t));                                             \
        finishSM(PY0, PY1, alY, l_reg, pa0, pa1, pa2, pa3); SBAR();                                                           \
        if ((t) + 1 < NT) { if constexpr (F32) { VMW(); SWRITE_KF(SB); SBAR(); SLOAD_F((const float*)Vh, KBASE((t) + 1)); }  \
                            else { SLOAD_H(Kh, Vh, KBASE((t) + 1)); } SBAR(); }                                               \
        pv_tile<VB, SK>(o, vb0, pa0, pa1, pa2, pa3, ACT((t) - 1)); MASKT(PX0, PX1, (t)); partialSM(PX0, PX1, m_reg, mnX, alX);                                        \
        __syncthreads();                                                                                                      \
        if ((t) + 1 < NT) { VMW(); if constexpr (F32) { SWRITE_VF(SB); SBAR(); if ((t) + 2 < NT) SLOAD_F((const float*)Kh, KBASE((t) + 2)); } \
                            else { SWRITE_H(SB); } }                                                                          \
        RESC(alX); __syncthreads(); } while (0)
    for (int t = 1; t + 1 < NT; t += 2) {
        HALF_STEP(pB0, pB1, mnB, alB, pA0, pA1, alA, t, 1, 0, 0);
        HALF_STEP(pA0, pA1, mnA, alA, pB0, pB1, alB, t + 1, 0, 1, 1);
    }
    const bool even = (NT & 1) == 0;
    if (even) { SBAR(); qkt<1, SK>(pB0, pB1, K_lds, r32, hi, S.qr, ACT(NT - 1)); SBAR(); }
#define QROW(e) (nxt.Q + (size_t)(wid * QBLK + r32) * LDP + ((e) >> 1) * 16 + hi * 8 + ((e) & 1) * 4)
    if constexpr (F32) { SLOAD_F((const float*)nxt.K, kbn); SBAR();
#pragma unroll
        for (int e = 0; e < 8; ++e) S.tq[e] = *(const f32x4*)QROW(e); }
    else { SLOAD_H(nxt.K, nxt.V, kbn); SBAR();
#pragma unroll
        for (int d0 = 0; d0 < 8; ++d0) S.qr[d0] = load8<TIn>(nxt.Q + (size_t)(wid * QBLK + r32) * LDP + d0 * 16 + hi * 8); }
    SBAR();
    finishSM(pA0, pA1, alA, l_reg, pa0, pa1, pa2, pa3); SBAR();
    if constexpr (F32) {
#pragma unroll
        for (int e = 8; e < 16; ++e) S.tq[e] = *(const f32x4*)QROW(e); SBAR(); }
#undef QROW
    pv_tile<0, SK>(o, vb0, pa0, pa1, pa2, pa3, ACT(even ? NT - 2 : NT - 1));
    if (even) { MASKT(pB0, pB1, NT - 1); partialSM(pB0, pB1, m_reg, mnB, alB); __syncthreads(); RESC(alB);
        finishSM(pB0, pB1, alB, l_reg, pa0, pa1, pa2, pa3); SBAR(); pv_tile<1, SK>(o, vb0, pa0, pa1, pa2, pa3, ACT(NT - 1)); }
    SBAR(); SEAM_K0();
    if (hi == 0) li_l[r32] = l_reg; asm volatile("s_waitcnt lgkmcnt(0)" ::: "memory");
    float rli[16];
#pragma unroll
    for (int r = 0; r < 16; ++r) rli[r] = __builtin_amdgcn_rcpf(li_l[crow(r, hi)]);
    TOut* Ow = cur.O + (size_t)(wid * QBLK) * LDO;
#pragma unroll
    for (int r = 0; r < 16; ++r) { const int orow = crow(r, hi);
#pragma unroll
        for (int d0 = 0; d0 < 4; ++d0) { const float v = o[d0][r] * rli[r];
            if constexpr (same_t<TOut, float>::v) { Ow[(size_t)orow * LDO + d0 * 32 + r32] = v; }
            else { const float vn = __shfl_xor(v, 1);
                   if ((r32 & 1) == 0) *(unsigned*)(Ow + (size_t)orow * LDO + d0 * 32 + r32) = cvtpk(v, vn); } } }
    if constexpr (F32) {
#pragma unroll
        for (int d0 = 0; d0 < 8; ++d0) S.qr[d0] = pack8(S.tq[2 * d0], S.tq[2 * d0 + 1]); }
    __syncthreads();
#undef RESC
#undef KBASE
#undef ACT
#undef MASKT
#undef SEAM_K0
#undef HALF_STEP
}
#undef ROW
#undef VMW
#undef VMWN
#undef SLOAD_H
#undef SWRITE_HK
#undef SWRITE_HV
#undef SWRITE_H
#undef SLOAD_F
#undef SWRITE_KF
#undef SWRITE_VF

constexpr int A2_V = 0;
constexpr int A2_K = 4 * SHM_V;
constexpr int A2_X = A2_K + 2 * SHM_K;
constexpr int A2_XS = 4096 + 512;
constexpr int A2_LDS = A2_X + 4 * A2_XS;
struct A2Ref { const bf16* Q; const bf16* K; const bf16* V0; const bf16* V1; bf16* O; int P0; };

__device__ __forceinline__ void attn2_block(const A2Ref& c, char* lds, const int mk_wave) {
    const int lane = (int)(__builtin_amdgcn_mbcnt_hi(~0u, __builtin_amdgcn_mbcnt_lo(~0u, 0u)) & 63u), wid = mk_wave & 7, tid = wid * 64 + lane, r32 = lane & 31, hi = lane >> 5, rg = wid & 3, vh = wid >> 2;
    char* V_lds = lds + A2_V; char* K_lds = lds + A2_K; char* X = lds + A2_X + rg * A2_XS;
    float* XA = (float*)(X + 4096); float* XM = XA + 32; float* XL = XA + 64;
    const int NT = (c.P0 + 127) / 64 + 1;
    const int qlo = c.P0 + rg * 32, qm = qlo + r32 - 4 * hi;
    const int sr = tid >> 4, sc = (tid & 15) * 8, vst0 = v_st(sr, sc), vst1 = v_st(32 + sr, sc), kws = KSWZ(sr, sc * 2);
    const int vb0 = (int)(uintptr_t)V_lds + vh * SHM_V + v_rd_base(lane);
    bf16x8 qr[8];
#pragma unroll
    for (int d0 = 0; d0 < 8; ++d0) qr[d0] = load8<bf16>(c.Q + (size_t)(rg * 32 + r32) * 128 + d0 * 16 + hi * 8);
    float m_reg = -1e30f, l_reg = 0.f; f32x16 o[4] = {};
    bf16x8 sk0, sk1, sa0, sa1, sb0, sb1;
#define A2_LOAD(kb) do { const size_t ro_ = (size_t)((kb) + sr) * 128 + sc; sk0 = load8<bf16>(c.K + ro_); sk1 = load8<bf16>(c.K + ro_ + 32 * 128); \
        sa0 = load8<bf16>(c.V0 + ro_); sa1 = load8<bf16>(c.V0 + ro_ + 32 * 128); sb0 = load8<bf16>(c.V1 + ro_); sb1 = load8<bf16>(c.V1 + ro_ + 32 * 128); } while (0)
#define A2_WRITE(buf) do { *(bf16x8*)(K_lds + (buf) * SHM_K + kws) = sk0; *(bf16x8*)(K_lds + (buf) * SHM_K + kws + 32 * 256) = sk1; \
        *(bf16x8*)(V_lds + (buf) * 2 * SHM_V + vst0) = sa0; *(bf16x8*)(V_lds + (buf) * 2 * SHM_V + vst1) = sa1; \
        *(bf16x8*)(V_lds + (buf) * 2 * SHM_V + SHM_V + vst0) = sb0; *(bf16x8*)(V_lds + (buf) * 2 * SHM_V + SHM_V + vst1) = sb1; } while (0)
#define A2_VMW() asm volatile("s_waitcnt vmcnt(0)" ::: "memory")
#define A2_STEP(t, B) do { const bool more_ = (t) + 1 < NT; if (more_) A2_LOAD(((t) + 1) * 64); \
        bf16x8 pa0, pa1, pa2, pa3; \
        if (vh == (B)) { f32x16 p0, p1; float mn, alpha; \
            qkt<(B), false>(p0, p1, K_lds, r32, hi, qr, true); \
            if (64 * (t) + 63 > qlo) mask_tile(p0, p1, qm - 64 * (t), 16384u); \
            partialSM(p0, p1, m_reg, mn, alpha); finishSM(p0, p1, alpha, l_reg, pa0, pa1, pa2, pa3); \
            *(bf16x8*)(X + lane * 16) = pa0; *(bf16x8*)(X + 1024 + lane * 16) = pa1; *(bf16x8*)(X + 2048 + lane * 16) = pa2; *(bf16x8*)(X + 3072 + lane * 16) = pa3; \
            if (hi == 0) { XA[r32] = alpha; XM[r32] = m_reg; XL[r32] = l_reg; } } \
        __syncthreads(); \
        if (vh != (B)) { pa0 = *(const bf16x8*)(X + lane * 16); pa1 = *(const bf16x8*)(X + 1024 + lane * 16); pa2 = *(const bf16x8*)(X + 2048 + lane * 16); pa3 = *(const bf16x8*)(X + 3072 + lane * 16); \
            m_reg = XM[r32]; l_reg = XL[r32]; } \
        { const float a_ = XA[r32]; if (__any(a_ < 1.f)) { \
            _Pragma("unroll") for (int d_ = 0; d_ < 4; ++d_) _Pragma("unroll") for (int r = 0; r < 16; ++r) o[d_][r] *= XA[crow(r, hi)]; } } \
        pv_tile<2 * (B), false>(o, vb0, pa0, pa1, pa2, pa3, true); \
        if (more_) { A2_VMW(); A2_WRITE((B) ^ 1); } \
        __syncthreads(); } while (0)
    A2_LOAD(0); A2_VMW(); A2_WRITE(0); __syncthreads();
    for (int t = 0; t < NT; t += 2) { A2_STEP(t, 0); A2_STEP(t + 1, 1); }
    float rli[16];
#pragma unroll
    for (int r = 0; r < 16; ++r) rli[r] = __builtin_amdgcn_rcpf(XL[crow(r, hi)]);
    bf16* Ow = c.O + (size_t)(rg * 32) * LDO + vh * 128;
#pragma unroll
    for (int r = 0; r < 16; ++r) { const int orow = crow(r, hi);
#pragma unroll
        for (int d0 = 0; d0 < 4; ++d0) { const float v = o[d0][r] * rli[r]; const float vn = __shfl_xor(v, 1);
            if ((r32 & 1) == 0) *(unsigned*)(Ow + (size_t)orow * LDO + d0 * 32 + r32) = cvtpk(v, vn); } }
    __syncthreads();
#undef A2_LOAD
#undef A2_WRITE
#undef A2_VMW
#undef A2_STEP
}

constexpr int A3_XS = 4096 + 2 * 384;
constexpr int A3_LDS = A2_X + 4 * A3_XS;
__device__ __forceinline__ void attn3_block(const A2Ref& c, char* lds, const int mk_wave) {
    int lane_ = (int)(__builtin_amdgcn_mbcnt_hi(~0u, __builtin_amdgcn_mbcnt_lo(~0u, 0u)) & 63u); asm volatile("" : "+v"(lane_));
    const int lane = lane_ & 63, wid = mk_wave & 7, tid = wid * 64 + lane, r32 = lane & 31, hi = lane >> 5, rg = wid & 3, vh = wid >> 2;
    char* V_lds = lds + A2_V; char* K_lds = lds + A2_K; char* X = lds + A2_X + rg * A3_XS;
    float* XS = (float*)(X + 4096);
    const int NT = (c.P0 + 127) / 64 + 1;
    const int qlo = c.P0 + rg * 32, qm = qlo + r32 - 4 * hi;
    const int sr = tid >> 4, sc = (tid & 15) * 8, vst0 = v_st(sr, sc), vst1 = v_st(32 + sr, sc), kws = KSWZ(sr, sc * 2);
    const int vb0 = (int)(uintptr_t)V_lds + vh * SHM_V + v_rd_base(lane);
    bf16x8 qr[8];
#pragma unroll
    for (int d0 = 0; d0 < 8; ++d0) qr[d0] = load8<bf16>(c.Q + (size_t)(rg * 32 + r32) * 128 + d0 * 16 + hi * 8);
    float m_reg = -1e30f, l_reg = 0.f; f32x16 o[4] = {};
    bf16x8 sk0, sk1, sa0, sa1, sb0, sb1, pa0, pa1, pa2, pa3;
    const unsigned so = (unsigned)(sr * 128 + sc) * 2u;
#define A3_G(base, kb, rows) (*(const bf16x8*)((const char*)((base) + (size_t)((kb) + (rows)) * 128) + so))
#define A3_LOADK(kb) do { sk0 = A3_G(c.K, kb, 0); sk1 = A3_G(c.K, kb, 32); } while (0)
#define A3_LOADV(kb) do { sa0 = A3_G(c.V0, kb, 0); sa1 = A3_G(c.V0, kb, 32); sb0 = A3_G(c.V1, kb, 0); sb1 = A3_G(c.V1, kb, 32); } while (0)
#define A3_WRITEK(buf) do { *(bf16x8*)(K_lds + (buf) * SHM_K + kws) = sk0; *(bf16x8*)(K_lds + (buf) * SHM_K + kws + 32 * 256) = sk1; } while (0)
#define A3_WRITEV(buf) do { *(bf16x8*)(V_lds + (buf) * 2 * SHM_V + vst0) = sa0; *(bf16x8*)(V_lds + (buf) * 2 * SHM_V + vst1) = sa1; \
        *(bf16x8*)(V_lds + (buf) * 2 * SHM_V + SHM_V + vst0) = sb0; *(bf16x8*)(V_lds + (buf) * 2 * SHM_V + SHM_V + vst1) = sb1; } while (0)
#define A3_VMW() asm volatile("s_waitcnt vmcnt(0)" ::: "memory")
#define A3_SOFTMAX_PUBLISH(T, PS) do { float mn_, alpha_; \
        if (64 * (T) + 63 > qlo) mask_tile(p0, p1, qm - 64 * (T), 16384u); \
        partialSM(p0, p1, m_reg, mn_, alpha_); finishSM(p0, p1, alpha_, l_reg, pa0, pa1, pa2, pa3); \
        *(bf16x8*)(X + lane * 16) = pa0; *(bf16x8*)(X + 1024 + lane * 16) = pa1; *(bf16x8*)(X + 2048 + lane * 16) = pa2; *(bf16x8*)(X + 3072 + lane * 16) = pa3; \
        if (hi == 0) { XS[(PS) * 96 + r32] = alpha_; XS[(PS) * 96 + 32 + r32] = m_reg; XS[(PS) * 96 + 64 + r32] = l_reg; } } while (0)
    A3_LOADK(0); A3_LOADV(0); A3_VMW(); A3_WRITEK(0); A3_WRITEV(0); A3_LOADK(64); A3_VMW(); A3_WRITEK(1);
    __syncthreads();
    if (vh == 0) { f32x16 p0, p1; qkt<0, false>(p0, p1, K_lds, r32, hi, qr, true); A3_SOFTMAX_PUBLISH(0, 0); }
    __syncthreads();
#define A3_STEP(t, B) do { const bool more1_ = (t) + 1 < NT, more2_ = (t) + 2 < NT; \
        f32x16 p0, p1; \
        if (vh != (B) && more1_) { qkt<(B) ^ 1, false>(p0, p1, K_lds, r32, hi, qr, true); } \
        SBAR(); \
        if (more2_) A3_LOADK(((t) + 2) * 64); if (more1_) A3_LOADV(((t) + 1) * 64); \
        if (vh != (B)) { pa0 = *(const bf16x8*)(X + lane * 16); pa1 = *(const bf16x8*)(X + 1024 + lane * 16); pa2 = *(const bf16x8*)(X + 2048 + lane * 16); pa3 = *(const bf16x8*)(X + 3072 + lane * 16); \
            m_reg = XS[(B) * 96 + 32 + r32]; l_reg = XS[(B) * 96 + 64 + r32]; } \
        { const float a_ = XS[(B) * 96 + r32]; if (__any(a_ < 1.f)) { \
            _Pragma("unroll") for (int d_ = 0; d_ < 4; ++d_) _Pragma("unroll") for (int r = 0; r < 16; ++r) o[d_][r] *= XS[(B) * 96 + crow(r, hi)]; } } \
        pv_tile<2 * (B), false>(o, vb0, pa0, pa1, pa2, pa3, true); \
        SBAR(); \
        if (vh != (B) && more1_) A3_SOFTMAX_PUBLISH((t) + 1, (B) ^ 1); \
        if (more1_) { A3_VMW(); if (more2_) A3_WRITEK(B); A3_WRITEV((B) ^ 1); } \
        __syncthreads(); } while (0)
    for (int t = 0; t < NT; t += 2) { A3_STEP(t, 0); A3_STEP(t + 1, 1); }
    float rli[16];
#pragma unroll
    for (int r = 0; r < 16; ++r) rli[r] = __builtin_amdgcn_rcpf(XS[96 + 64 + crow(r, hi)]);
    bf16* Ow = c.O + (size_t)(rg * 32) * LDO + vh * 128;
#pragma unroll
    for (int r = 0; r < 16; ++r) { const int orow = crow(r, hi);
#pragma unroll
        for (int d0 = 0; d0 < 4; ++d0) { const float v = o[d0][r] * rli[r]; const float vn = __shfl_xor(v, 1);
            if ((r32 & 1) == 0) *(unsigned*)(Ow + (size_t)orow * LDO + d0 * 32 + r32) = cvtpk(v, vn); } }
    __syncthreads();
#undef A3_G
#undef A3_LOADK
#undef A3_LOADV
#undef A3_WRITEK
#undef A3_WRITEV
#undef A3_VMW
#undef A3_SOFTMAX_PUBLISH
#undef A3_STEP
}

}

constexpr int S_ = 16384, DM = 2048, FF = 5632, NIN = 6152, NINP = 6144, PLD = 3072;
constexpr int NWAVES = 8, NTHR = 512;
constexpr int C_MQ = 0, C_MK = 512, C_MV = 1024, C_MO = 2048;
constexpr size_t MiB = 1u << 20, KiB = 1u << 10;
constexpr size_t WS_ROWSS1 = 0, WS_ROWSS2 = 64 * KiB, WS_SC = 192 * KiB  , WS_DN = 256 * KiB, WS_GATES = 512 * KiB;
constexpr size_t WS_BAR = 128 * KiB;
constexpr size_t WS_WGU = 1 * MiB, WS_WD = 45 * MiB, WS_WIN = 67 * MiB, WS_WOUT = 92 * MiB;
constexpr size_t WS_XN = 100 * MiB;
constexpr size_t WS_BIG = 164 * MiB;
constexpr size_t WS_Y = 356 * MiB;
constexpr size_t WS_CT = 420 * MiB;
constexpr size_t WS_QC = 452 * MiB, WS_KC = 468 * MiB;
constexpr size_t WS_NST = 484 * MiB;
constexpr size_t WS_GW = 484 * MiB + 512 * KiB;
constexpr size_t WS_END = 485 * MiB;
constexpr int LDS_BYTES = 147456;

#define LAS __attribute__((address_space(3)))
typedef unsigned short bfu;
typedef unsigned v4u __attribute__((ext_vector_type(4)));
typedef unsigned v2u __attribute__((ext_vector_type(2)));
typedef float f32x4 __attribute__((ext_vector_type(4)));
typedef short bf16x8 __attribute__((ext_vector_type(8)));
#define MFMA16(a, b, c) __builtin_amdgcn_mfma_f32_16x16x32_bf16(a, b, c, 0, 0, 0)
#define LDS_WAIT() asm volatile("s_waitcnt lgkmcnt(0)" ::: "memory")
__device__ __forceinline__ unsigned f2bf(float f) { unsigned u = __builtin_bit_cast(unsigned, f); return (u + 0x7fffu + ((u >> 16) & 1u)) >> 16; }
__device__ __forceinline__ unsigned pk2(float lo, float hi) { return f2bf(lo) | (f2bf(hi) << 16); }
__device__ __forceinline__ float bf2f(unsigned b) { return __builtin_bit_cast(float, b << 16); }
__device__ __forceinline__ int mk_lane() { return (int)(__builtin_amdgcn_mbcnt_hi(~0u, __builtin_amdgcn_mbcnt_lo(~0u, 0u)) & 63u); }
__device__ __forceinline__ float wave_sum(float v) {
#pragma unroll
    for (int o = 1; o < 64; o <<= 1) v += __shfl_xor(v, o);
    return v;
}
__device__ __forceinline__ float silu(float x) { return x / (1.0f + __expf(-x)); }

__device__ __forceinline__ void cvt_item(const float* __restrict__ W, int ldw, int ncols, const float* __restrict__ gain, bfu* WT, int K, int dst_row0, int k0, int n0, LAS float* scr, int lane) {
    const int nq = (lane & 15) * 4, kr = lane >> 4, n = n0 + nq;
#pragma unroll 8
    for (int i = 0; i < 16; ++i) { const int kk = 4 * i + kr; f32x4 v = (f32x4){0.f, 0.f, 0.f, 0.f};
        if (n < ncols) v = *(const f32x4*)(W + (size_t)(k0 + kk) * ldw + n);
        if (gain) v = v * gain[k0 + kk];
        LAS float* d = scr + kk * 65 + nq; d[0] = v[0]; d[1] = v[1]; d[2] = v[2]; d[3] = v[3]; }
    LDS_WAIT(); asm volatile("" ::: "memory");
    const int c = lane & 7;
#pragma unroll
    for (int j = 0; j < 8; ++j) { const int nn = (lane >> 3) + 8 * j; const LAS float* s = scr + (8 * c) * 65 + nn;
        v4u o; o.x = pk2(s[0 * 65], s[1 * 65]); o.y = pk2(s[2 * 65], s[3 * 65]); o.z = pk2(s[4 * 65], s[5 * 65]); o.w = pk2(s[6 * 65], s[7 * 65]);
        *(v4u*)(WT + (size_t)(dst_row0 + nn) * K + k0 + 8 * c) = o; }
    LDS_WAIT(); asm volatile("" ::: "memory");
}
__device__ __forceinline__ void cvt_ffn_item(int it, const float* wg, const float* wu, const float* wd, const float* gain, bfu* Wgu, bfu* Wd, LAS float* scr, int lane) {
    if (it < 2 * 2816) { const int up = it >= 2816; const int r = up ? it - 2816 : it; const int kb = r / 88, nb = r % 88, n0 = nb * 64;
        cvt_item(up ? wu : wg, FF, FF, gain, Wgu, DM, 256 * (n0 >> 7) + (n0 & 127) + (up ? 128 : 0), kb * 64, n0, scr, lane); }
    else { const int r = it - 2 * 2816; const int kb = r / 32, nb = r % 32; cvt_item(wd, DM, DM, nullptr, Wd, FF, nb * 64, kb * 64, nb * 64, scr, lane); }
}

constexpr int GWP = 4112;
__device__ __forceinline__ void gates_rows(LAS unsigned char* lds, const bfu* __restrict__ XB, const float* __restrict__ rowss, const float* __restrict__ b_i, const float* __restrict__ b_f, float* GATES, int rb, int wave, int lane) {
    const int fr = lane & 15, fq = lane >> 4, rg = wave & 3, kh = wave >> 2;
    const LAS unsigned char* wl = lds + 16384;
    const bfu* xp = XB + (size_t)(rb * 64 + rg * 16 + fr) * DM + kh * 1024 + 8 * fq;
    f32x4 acc = (f32x4){0.f, 0.f, 0.f, 0.f};
    for (int k0 = 0; k0 < 32; k0 += 16) {
        bf16x8 xa[16];
#pragma unroll
        for (int ks = 0; ks < 16; ++ks) xa[ks] = *(const bf16x8*)(xp + (k0 + ks) * 32);
#pragma unroll
        for (int ks = 0; ks < 16; ++ks) { const bf16x8 wb = *(const LAS bf16x8*)(wl + fr * GWP + (kh * 1024 + (k0 + ks) * 32 + 8 * fq) * 2); acc = MFMA16(xa[ks], wb, acc); }
    }
    LAS f32x4* red = (LAS f32x4*)lds;
    if (kh == 1) red[rg * 64 + lane] = acc;
    __syncthreads();
    if (kh == 0 && fr < 8) {
        const f32x4 o = red[rg * 64 + lane]; const float bias = fr < 4 ? b_i[fr] : b_f[fr - 4];
#pragma unroll
        for (int j = 0; j < 4; ++j) { const int row = rb * 64 + rg * 16 + 4 * fq + j;
            const float pre = (acc[j] + o[j]) / sqrtf(rowss[row] * (1.0f / DM) + 1e-6f) + bias; const float capped = 15.0f * tanhf(pre * (1.0f / 15.0f));
            GATES[(size_t)row * 8 + fr] = fr < 4 ? capped : -log1pf(expf(-capped)); }
    }
    __syncthreads();
}

#define XB_TMO      128
#define XB_XCNT(j)  (256  + 64 * (j))
#define XB_XSUB(j)  (1280 + 64 * (j))
#define XB_XGEN(j)  (2304 + 64 * (j))
#define XB_TOP      3328
#define XB_TOPGEN   3392
#define XCD_BAR_WORDS 3456
#define XB_SPIN_CAP (1u << 18)
__device__ __forceinline__ unsigned xb_ld(unsigned* p)              { return __hip_atomic_load(p, __ATOMIC_RELAXED, __HIP_MEMORY_SCOPE_AGENT); }
__device__ __forceinline__ unsigned xb_add(unsigned* p, unsigned v) { return __hip_atomic_fetch_add(p, v, __ATOMIC_RELAXED, __HIP_MEMORY_SCOPE_AGENT); }
__device__ __forceinline__ unsigned xb_xcc_id() { return (unsigned)__builtin_amdgcn_s_getreg((3 << 11) | 20) & 0xFu; }
#define XB_SPIN(cond, bar) do { unsigned _sp = 0; while (cond) { __builtin_amdgcn_s_sleep(1); \
    if ((++_sp & 255u) == 0u) { if (xb_ld(&(bar)[XB_TMO])) break; if (_sp > XB_SPIN_CAP) { atomicAdd(&(bar)[XB_TMO], 1u); break; } } } } while (0)
__device__ __forceinline__ void xcd_barrier_complete(unsigned* bar, unsigned x, unsigned& nloc, unsigned& nx) {
    const unsigned G = gridDim.x * gridDim.y * gridDim.z;
    unsigned sum, cnt, mine, sp = 0u;
    for (;;) {
        sum = 0u; cnt = 0u; mine = 0u;
#pragma unroll
        for (unsigned j = 0; j < 16; ++j) { const unsigned c = xb_ld(&bar[XB_XCNT(j)]); sum += c; cnt += (c > 0u) ? 1u : 0u; mine = (j == x) ? c : mine; }
        if (sum == G) break;
        __builtin_amdgcn_s_sleep(1);
        if ((++sp & 255u) == 0u) { if (xb_ld(&bar[XB_TMO])) break; if (sp > XB_SPIN_CAP) { atomicAdd(&bar[XB_TMO], 1u); break; } }
    }
    nloc = mine > 0u ? mine : 1u; nx = cnt > 0u ? cnt : 1u;
}
__device__ __forceinline__ void xcd_barrier(unsigned* bar, volatile LAS unsigned* st, const bool first) {
    asm volatile("s_waitcnt vmcnt(0)" ::: "memory");
    __syncthreads();
    if (first) {
        const unsigned x = xb_xcc_id();
        __builtin_amdgcn_s_waitcnt(0);
        unsigned nloc = st[0], nx = st[1];
        if (nloc == 0u) { xcd_barrier_complete(bar, x, nloc, nx); st[0] = nloc; st[1] = nx; }
        const unsigned old = xb_add(&bar[XB_XSUB(x)], 1u);
        const unsigned gen = old / nloc;
        if (old + 1u == (gen + 1u) * nloc) {
            __builtin_amdgcn_fence(__ATOMIC_RELEASE, "agent");
            asm volatile("s_waitcnt vmcnt(0)" ::: "memory");
            const unsigned og = xb_add(&bar[XB_TOP], 1u);
            const unsigned tg = og / nx;
            if (og + 1u == (tg + 1u) * nx) xb_add(&bar[XB_TOPGEN], 1u);
            else XB_SPIN(xb_ld(&bar[XB_TOPGEN]) == tg, bar);
            __builtin_amdgcn_fence(__ATOMIC_ACQUIRE, "agent");
            xb_add(&bar[XB_XGEN(x)], 1u);
            asm volatile("s_waitcnt vmcnt(0)" ::: "memory");
        } else {
            XB_SPIN(xb_ld(&bar[XB_XGEN(x)]) == gen, bar);
            __builtin_amdgcn_fence(__ATOMIC_ACQUIRE, "agent");
            asm volatile("s_waitcnt vmcnt(0)" ::: "memory");
        }
    }
    __syncthreads();
}

struct Args { const float* in[23]; float* out; unsigned char* ws; int ph_lo, ph_hi; };
constexpr int NPH = 12;

constexpr int MP = 272;

__device__ __forceinline__ void mlstm_stage_a(LAS unsigned char* lds, const bfu* __restrict__ PROJ, const float* __restrict__ GATES, const float* __restrict__ conv_w, const float* __restrict__ conv_b,
                                              bfu* QC, bfu* KC, float* DELTA, float* DN, float* SC, int item, const int mk_wave) {
    int lane = mk_lane(); asm volatile("" : "+v"(lane));
    const int wid = mk_wave & 7, tid = wid * 64 + lane, fr = lane & 15, fq = lane >> 4;
    const int h = item & 3, row0 = (item >> 2) * 128;
    LAS float* fa = (LAS float*)lds; LAS unsigned char* KT = lds + 4096; LAS unsigned char* VT = KT + 128 * MP;
    if (tid < 128) { fa[tid] = GATES[(size_t)(row0 + tid) * 8 + 4 + h]; fa[128 + tid] = GATES[(size_t)(row0 + tid) * 8 + h]; }
    __syncthreads();
    if (tid < 128) { float b = 0.f; for (int s = 0; s <= tid; ++s) b += fa[s]; fa[256 + tid] = fa[128 + tid] - b; if (tid == 127) fa[385] = b; }
    __syncthreads();
    if (wid == 0) { float a = fmaxf(fa[256 + lane], fa[320 + lane]);
#pragma unroll
        for (int o = 1; o < 64; o <<= 1) a = fmaxf(a, __shfl_xor(a, o));
        if (lane == 0) fa[384] = a; }
    __syncthreads();
    const float amax = fa[384], blast = fa[385];
    if (tid < 128) fa[tid] = __expf(fa[256 + tid] - amax);
    if (tid == 0) { SC[item] = blast + amax; SC[512 + item] = blast; }
    __syncthreads();
    for (int task = tid; task < 4096; task += NTHR) {
        const int isk = task >> 11, t2 = task & 2047, d = t2 & 127, s0 = (t2 >> 7) * 8, ch = isk * 512 + h * 128 + d;
        const float w0 = conv_w[ch], w1 = conv_w[1024 + ch], w2 = conv_w[2048 + ch], w3 = conv_w[3072 + ch], bias = conv_b[ch];
        float x[11];
#pragma unroll
        for (int i = 0; i < 11; ++i) { const int r = row0 + s0 - 3 + i; x[i] = r >= 0 ? bf2f(PROJ[(size_t)r * PLD + C_MQ + ch]) : 0.f; }
        float y[8];
#pragma unroll
        for (int i = 0; i < 8; ++i) y[i] = silu(bias + w0 * x[i] + w1 * x[i + 1] + w2 * x[i + 2] + w3 * x[i + 3]);
        if (!isk) {
#pragma unroll
            for (int i = 0; i < 8; ++i) QC[(size_t)(row0 + s0 + i) * 512 + h * 128 + d] = (bfu)f2bf(y[i] * 0.08838834764831845f);
        } else {
#pragma unroll
            for (int i = 0; i < 8; ++i) { KC[(size_t)(row0 + s0 + i) * 512 + h * 128 + d] = (bfu)f2bf(y[i]); y[i] *= fa[s0 + i]; }
            v4u o; o.x = pk2(y[0], y[1]); o.y = pk2(y[2], y[3]); o.z = pk2(y[4], y[5]); o.w = pk2(y[6], y[7]);
            *(LAS v4u*)(KT + d * MP + s0 * 2) = o;
        }
    }
    for (int task = tid; task < 4096; task += NTHR) {
        const int sidx = task & 127, e0 = (task >> 7) * 8;
        const v4u v = *(const v4u*)(PROJ + (size_t)(row0 + sidx) * PLD + C_MV + h * 256 + e0);
        LAS unsigned short* d = (LAS unsigned short*)(VT + e0 * MP + sidx * 2);
        d[0 * (MP / 2)] = (unsigned short)(v.x & 0xffffu); d[1 * (MP / 2)] = (unsigned short)(v.x >> 16); d[2 * (MP / 2)] = (unsigned short)(v.y & 0xffffu); d[3 * (MP / 2)] = (unsigned short)(v.y >> 16);
        d[4 * (MP / 2)] = (unsigned short)(v.z & 0xffffu); d[5 * (MP / 2)] = (unsigned short)(v.z >> 16); d[6 * (MP / 2)] = (unsigned short)(v.w & 0xffffu); d[7 * (MP / 2)] = (unsigned short)(v.w >> 16);
    }
    __syncthreads();
    f32x4 acc[2][8];
#pragma unroll
    for (int mt = 0; mt < 2; ++mt)
#pragma unroll
        for (int nt = 0; nt < 8; ++nt) acc[mt][nt] = (f32x4){0.f, 0.f, 0.f, 0.f};
#pragma unroll
    for (int ks = 0; ks < 4; ++ks) {
        bf16x8 a[2];
#pragma unroll
        for (int mt = 0; mt < 2; ++mt) a[mt] = *(const LAS bf16x8*)(VT + (32 * wid + 16 * mt + fr) * MP + (32 * ks + 8 * fq) * 2);
#pragma unroll
        for (int nt = 0; nt < 8; ++nt) { const bf16x8 b = *(const LAS bf16x8*)(KT + (16 * nt + fr) * MP + (32 * ks + 8 * fq) * 2);
            acc[0][nt] = MFMA16(a[0], b, acc[0][nt]); acc[1][nt] = MFMA16(a[1], b, acc[1][nt]); }
    }
    float* dst = DELTA + (size_t)item * 32768;
#pragma unroll
    for (int mt = 0; mt < 2; ++mt)
#pragma unroll
        for (int nt = 0; nt < 8; ++nt)
#pragma unroll
            for (int j = 0; j < 4; ++j) dst[(32 * wid + 16 * mt + 4 * fq + j) * 128 + 16 * nt + fr] = acc[mt][nt][j];
    if (tid < 128) { float s = 0.f; for (int i = 0; i < 128; ++i) s += bf2f(*(const LAS unsigned short*)(KT + tid * MP + i * 2)); DN[(size_t)item * 128 + tid] = s; }
    __syncthreads();
}

__device__ __forceinline__ void mlstm_scan(LAS unsigned char* lds, const float* __restrict__ DELTA, const float* __restrict__ DN, const float* __restrict__ SC, float* MPREV, bfu* __restrict__ CT, float* __restrict__ NST,
                                           int tid, int gtid, int nthreads) {
    LAS float* fdec = (LAS float*)lds; LAS float* fin = fdec + 512; LAS float* mpv = fdec + 1024;
    if (tid < 4) { float m = 0.f;
        for (int c = 0; c < 128; ++c) { const int item = c * 4 + tid; const float mloc = SC[item], bl = SC[512 + item], mn = fmaxf(bl + m, mloc);
            mpv[tid * 128 + c] = m; fdec[tid * 128 + c] = __expf(bl + m - mn); fin[tid * 128 + c] = __expf(mloc - mn); m = mn; } }
    __syncthreads();
    for (int idx = gtid; idx < 4 * 32768 + 512; idx += nthreads) {
        const bool main_ = idx < 4 * 32768;
        const int h = main_ ? (idx >> 15) : ((idx - 4 * 32768) >> 7), rem = main_ ? (idx & 32767) : ((idx - 4 * 32768) & 127);
        const float* src = main_ ? DELTA + (size_t)h * 32768 + rem : DN + h * 128 + rem; const size_t sstride = main_ ? 4 * 32768 : 512;
        float C = 0.f; float d8[8], e8[8];
#pragma unroll
        for (int i = 0; i < 8; ++i) d8[i] = src[(size_t)i * sstride];
        for (int c0 = 0; c0 < 128; c0 += 8) {
            if (c0 + 8 < 128) {
#pragma unroll
                for (int i = 0; i < 8; ++i) e8[i] = src[(size_t)(c0 + 8 + i) * sstride];
            }
#pragma unroll
            for (int i = 0; i < 8; ++i) { const int c = c0 + i, item = c * 4 + h;
                if (main_) { CT[(size_t)item * 32768 + rem] = (bfu)f2bf(C); if (rem == 0) MPREV[item] = mpv[h * 128 + c]; } else NST[(size_t)item * 128 + rem] = C;
                C = fdec[h * 128 + c] * C + fin[h * 128 + c] * d8[i]; }
#pragma unroll
            for (int i = 0; i < 8; ++i) d8[i] = e8[i];
        }
    }
    __syncthreads();
}

__device__ __forceinline__ void mlstm_stage_c(LAS unsigned char* lds, const bfu* __restrict__ PROJ, const float* __restrict__ GATES, const bfu* __restrict__ QC, const bfu* __restrict__ KC,
                                              const bfu* __restrict__ CT, const float* __restrict__ NST, const float* __restrict__ MPREV, const float* __restrict__ hgain, bfu* Y, int item, const int mk_wave) {
    int lane = mk_lane(); asm volatile("" : "+v"(lane));
    const int wid = mk_wave & 7, tid = wid * 64 + lane, fr = lane & 15, fq = lane >> 4;
    const int h = item & 3, row0 = (item >> 2) * 128;
    LAS float* fa = (LAS float*)lds;
    LAS unsigned char* Qs = lds + 4096; LAS unsigned char* Ks = Qs + 128 * MP; LAS unsigned char* BUF = Ks + 128 * MP;
    if (tid < 128) { fa[768 + tid] = GATES[(size_t)(row0 + tid) * 8 + 4 + h]; fa[896 + tid] = GATES[(size_t)(row0 + tid) * 8 + h]; fa[640 + tid] = NST[(size_t)item * 128 + tid]; }
    __syncthreads();
    float bt_ = 0.f;
    if (tid < 128) { for (int s = 0; s <= tid; ++s) bt_ += fa[768 + s]; fa[tid] = fa[896 + tid] - bt_; }
    __syncthreads();
    if (tid < 128) { const float mp = MPREV[item]; float pm = -3.0e38f; for (int s = 0; s <= tid; ++s) pm = fmaxf(pm, fa[s]);
        const float M = fmaxf(mp, pm); fa[128 + tid] = M; fa[256 + tid] = __expf(mp - M); fa[384 + tid] = __expf(-(bt_ + M)); }
    for (int t = tid; t < 2048; t += NTHR) { const int r = t >> 4, c = t & 15;
        *(LAS v4u*)(Qs + r * MP + c * 16) = *(const v4u*)(QC + (size_t)(row0 + r) * 512 + h * 128 + c * 8);
        *(LAS v4u*)(Ks + r * MP + c * 16) = *(const v4u*)(KC + (size_t)(row0 + r) * 512 + h * 128 + c * 8); }
    for (int t = tid; t < 4096; t += NTHR) { const int r = t >> 4, c = t & 15; *(LAS v4u*)(BUF + r * MP + c * 16) = *(const v4u*)(CT + (size_t)item * 32768 + r * 128 + c * 8); }
    __syncthreads();
    {
        const int t = 16 * wid + fr; float s = 0.f;
#pragma unroll
        for (int i = 0; i < 32; ++i) s += bf2f(*(const LAS unsigned short*)(Qs + t * MP + (32 * fq + i) * 2)) * fa[640 + 32 * fq + i];
        s += __shfl_xor(s, 16); s += __shfl_xor(s, 32); if (fq == 0) fa[512 + t] = s;
    }
    f32x4 sa[8];
#pragma unroll
    for (int nt = 0; nt < 8; ++nt) sa[nt] = (f32x4){0.f, 0.f, 0.f, 0.f};
    bf16x8 qa[4];
#pragma unroll
    for (int ks = 0; ks < 4; ++ks) qa[ks] = *(const LAS bf16x8*)(Qs + (16 * wid + fr) * MP + (32 * ks + 8 * fq) * 2);
#pragma unroll
    for (int nt = 0; nt < 8; ++nt) if (nt <= wid) {
#pragma unroll
        for (int ks = 0; ks < 4; ++ks) { const bf16x8 b = *(const LAS bf16x8*)(Ks + (16 * nt + fr) * MP + (32 * ks + 8 * fq) * 2); sa[nt] = MFMA16(qa[ks], b, sa[nt]); } }
    float Mt[4], rsum[4];
#pragma unroll
    for (int j = 0; j < 4; ++j) { Mt[j] = fa[128 + 16 * wid + 4 * fq + j]; rsum[j] = 0.f; }
#pragma unroll
    for (int nt = 0; nt < 8; ++nt) { const int s = 16 * nt + fr; const float as = fa[s];
#pragma unroll
        for (int j = 0; j < 4; ++j) { const int t = 16 * wid + 4 * fq + j; const float p = (s <= t) ? sa[nt][j] * __expf(as - Mt[j]) : 0.f; sa[nt][j] = p; rsum[j] += p; } }
#pragma unroll
    for (int j = 0; j < 4; ++j) { float v = rsum[j]; v += __shfl_xor(v, 1); v += __shfl_xor(v, 2); v += __shfl_xor(v, 4); v += __shfl_xor(v, 8); rsum[j] = v; }
    f32x4 num[16];
#pragma unroll
    for (int nt = 0; nt < 16; ++nt) num[nt] = (f32x4){0.f, 0.f, 0.f, 0.f};
#pragma unroll
    for (int ks = 0; ks < 4; ++ks)
#pragma unroll
        for (int nt = 0; nt < 16; ++nt) { const bf16x8 b = *(const LAS bf16x8*)(BUF + (16 * nt + fr) * MP + (32 * ks + 8 * fq) * 2); num[nt] = MFMA16(qa[ks], b, num[nt]); if ((nt & 3) == 3) __builtin_amdgcn_sched_barrier(0); }
    float g4[4], den[4];
#pragma unroll
    for (int j = 0; j < 4; ++j) { const int t = 16 * wid + 4 * fq + j; g4[j] = fa[256 + t]; den[j] = fmaxf(fabsf(g4[j] * fa[512 + t] + rsum[j]), fa[384 + t]); }
#pragma unroll
    for (int nt = 0; nt < 16; ++nt)
#pragma unroll
        for (int j = 0; j < 4; ++j) num[nt][j] *= g4[j];
    __syncthreads();
#pragma unroll
    for (int nt = 0; nt < 8; ++nt)
#pragma unroll
        for (int j = 0; j < 4; ++j) *(LAS unsigned short*)(Ks + (16 * wid + 4 * fq + j) * MP + (16 * nt + fr) * 2) = (unsigned short)f2bf(sa[nt][j]);
    for (int task = tid; task < 4096; task += NTHR) {
        const int sidx = task & 127, e0 = (task >> 7) * 8;
        const v4u v = *(const v4u*)(PROJ + (size_t)(row0 + sidx) * PLD + C_MV + h * 256 + e0);
        LAS unsigned short* d = (LAS unsigned short*)(BUF + e0 * MP + sidx * 2);
        d[0 * (MP / 2)] = (unsigned short)(v.x & 0xffffu); d[1 * (MP / 2)] = (unsigned short)(v.x >> 16); d[2 * (MP / 2)] = (unsigned short)(v.y & 0xffffu); d[3 * (MP / 2)] = (unsigned short)(v.y >> 16);
        d[4 * (MP / 2)] = (unsigned short)(v.z & 0xffffu); d[5 * (MP / 2)] = (unsigned short)(v.z >> 16); d[6 * (MP / 2)] = (unsigned short)(v.w & 0xffffu); d[7 * (MP / 2)] = (unsigned short)(v.w >> 16);
    }
    __syncthreads();
#pragma unroll
    for (int ks = 0; ks < 4; ++ks) { const bf16x8 pa = *(const LAS bf16x8*)(Ks + (16 * wid + fr) * MP + (32 * ks + 8 * fq) * 2);
#pragma unroll
        for (int nt = 0; nt < 16; ++nt) { const bf16x8 b = *(const LAS bf16x8*)(BUF + (16 * nt + fr) * MP + (32 * ks + 8 * fq) * 2); num[nt] = MFMA16(pa, b, num[nt]); if ((nt & 3) == 3) __builtin_amdgcn_sched_barrier(0); } }
    float ssq[4];
#pragma unroll
    for (int j = 0; j < 4; ++j) { const float rd = 1.0f / den[j]; float s = 0.f;
#pragma unroll
        for (int nt = 0; nt < 16; ++nt) { const float v = num[nt][j] * rd; num[nt][j] = v; s += v * v; }
        s += __shfl_xor(s, 1); s += __shfl_xor(s, 2); s += __shfl_xor(s, 4); s += __shfl_xor(s, 8); ssq[j] = 1.0f / sqrtf(s * (1.0f / 256.0f) + 1e-6f); }
    __syncthreads();
    LAS float* HS = (LAS float*)(lds + 4096);
#pragma unroll
    for (int nt = 0; nt < 16; ++nt)
#pragma unroll
        for (int j = 0; j < 4; ++j) HS[(16 * wid + 4 * fq + j) * 260 + 16 * nt + fr] = num[nt][j] * ssq[j];
    __syncthreads();
    for (int task = tid; task < 4096; task += NTHR) {
        const int r = task >> 5, c8 = (task & 31) * 8; const size_t row = (size_t)(row0 + r);
        const f32x4 h0 = *(const LAS f32x4*)(HS + r * 260 + c8), h1 = *(const LAS f32x4*)(HS + r * 260 + c8 + 4);
        const f32x4 g0 = *(const f32x4*)(hgain + h * 256 + c8), g1 = *(const f32x4*)(hgain + h * 256 + c8 + 4);
        const v4u mo = *(const v4u*)(PROJ + row * PLD + C_MO + h * 256 + c8);
        v4u o;
        o.x = pk2(h0[0] * g0[0] / (1.0f + __expf(-bf2f(mo.x & 0xffffu))), h0[1] * g0[1] / (1.0f + __expf(-bf2f(mo.x >> 16))));
        o.y = pk2(h0[2] * g0[2] / (1.0f + __expf(-bf2f(mo.y & 0xffffu))), h0[3] * g0[3] / (1.0f + __expf(-bf2f(mo.y >> 16))));
        o.z = pk2(h1[0] * g1[0] / (1.0f + __expf(-bf2f(mo.z & 0xffffu))), h1[1] * g1[1] / (1.0f + __expf(-bf2f(mo.z >> 16))));
        o.w = pk2(h1[2] * g1[2] / (1.0f + __expf(-bf2f(mo.w & 0xffffu))), h1[3] * g1[3] / (1.0f + __expf(-bf2f(mo.w >> 16))));
        *(v4u*)(Y + row * DM + 1024 + h * 256 + c8) = o;
    }
    __syncthreads();
}

__device__ __forceinline__ att::BlockRef<att::bf16, att::bf16> att_ref(int i, int pass, const bfu* PROJ, bfu* OATT) {
    int ph, x;
    if (gridDim.x == 256) { ph = ((i >> 8) & 1) * 8 + (blockIdx.x & 7); x = blockIdx.x >> 3; }
    else { ph = (i >> 5) & 15; x = i & 31; }
    const int qb = pass ? 63 - x : x, h = ph >> 2, c = (ph >> 1) & 1, vh = ph & 1;
    att::BlockRef<att::bf16, att::bf16> r;
    constexpr size_t MSZ = (size_t)16384 * 128;
    r.Q = (const att::bf16*)(PROJ + (size_t)(2 * h + c) * MSZ + (size_t)qb * 256 * 128);
    r.K = (const att::bf16*)(PROJ + (size_t)(8 + 2 * h + c) * MSZ);
    r.V = (const att::bf16*)(PROJ + (size_t)(16 + 2 * h + vh) * MSZ);
    r.O = (att::bf16*)(OATT + (size_t)qb * 256 * 2048 + h * 512 + c * 256 + vh * 128);
    r.P0 = qb * 256;
    return r;
}
__device__ __forceinline__ void attn_phase(char* lds, const bfu* PROJ, bfu* OATT, const int TOTAL, const int mk_wave) {
    using namespace att;
    int i = blockIdx.x; if (i >= TOTAL) return;
    int pass = 0;
    BlockRef<bf16, bf16> cur = att_ref(i, 0, PROJ, OATT);
    Seam<bf16> S;
    causal_swa_prime<bf16, bf16>(cur, S_, lds, S, mk_wave);
    for (;;) {
        const bool more_pass = pass == 0, more_item = i + (int)gridDim.x < TOTAL, last = !more_pass && !more_item;
        int in_ = i, passn = pass + 1;
        if (!more_pass) { passn = 0; in_ = more_item ? i + (int)gridDim.x : i; }
        const BlockRef<bf16, bf16> nxt = last ? cur : att_ref(in_, passn, PROJ, OATT);
        causal_swa_block<bf16, bf16>(cur, nxt, S_, S_, lds, S, mk_wave);
        if (last) break;
        cur = nxt; i = in_; pass = passn;
    }
}

#ifndef ATTN2
#define ATTN2 2
#endif
__device__ __forceinline__ att::A2Ref att2_ref(int i, int pass, const bfu* PROJ, bfu* OATT) {
    int hc, x;
    if (gridDim.x == 256) { hc = blockIdx.x & 7; x = ((i >> 8) & 1) * 32 + (blockIdx.x >> 3); }
    else { hc = (i >> 6) & 7; x = i & 63; }
    const int qb = pass ? 127 - x : x, h = hc >> 1, c = hc & 1;
    constexpr size_t MSZ = (size_t)16384 * 128;
    att::A2Ref r;
    r.Q = (const att::bf16*)(PROJ + (size_t)(2 * h + c) * MSZ + (size_t)qb * 128 * 128);
    r.K = (const att::bf16*)(PROJ + (size_t)(8 + 2 * h + c) * MSZ);
    r.V0 = (const att::bf16*)(PROJ + (size_t)(16 + 2 * h) * MSZ); r.V1 = (const att::bf16*)(PROJ + (size_t)(16 + 2 * h + 1) * MSZ);
    r.O = (att::bf16*)(OATT + (size_t)qb * 128 * 2048 + h * 512 + c * 256);
    r.P0 = qb * 128;
    return r;
}
__device__ __forceinline__ void attn2_phase(char* lds, const bfu* PROJ, bfu* OATT, const int TOTAL, const int mk_wave) {
    for (int i = blockIdx.x; i < TOTAL; i += gridDim.x)
        for (int pass = 0; pass < 2; ++pass) { const att::A2Ref r = att2_ref(i, pass, PROJ, OATT); if (ATTN2 == 2) att::attn3_block(r, lds, mk_wave); else att::attn2_block(r, lds, mk_wave); }
}

__global__ void __launch_bounds__(NTHR, 2) mega_fwd(Args args) {
    extern __shared__ __attribute__((aligned(16))) unsigned char lds_raw[];
    LAS unsigned char* lds = (LAS unsigned char*)lds_raw;
    const int wave = __builtin_amdgcn_readfirstlane((int)threadIdx.x >> 6);
    const int G = gridDim.x, gw = blockIdx.x * NWAVES + wave, NGW = G * NWAVES;
#define AS4 __attribute__((address_space(4)))
#define PH_BEGIN int koff_ = 0; asm volatile("" : "+s"(koff_)); const AS4 char* kp_ = (const AS4 char*)__builtin_amdgcn_kernarg_segment_ptr() + koff_; \
    unsigned char* ws = *(unsigned char* const AS4*)(kp_ + 192); float* out = *(float* const AS4*)(kp_ + 184); (void)out; (void)ws; const int lane = mk_lane(), tid = wave * 64 + lane; (void)tid; (void)lane;
#define KIN(i) (*(const float* const AS4*)(kp_ + 8 * (i)))
#define Wgu ((bfu*)(ws + WS_WGU))
#define Wd ((bfu*)(ws + WS_WD))
#define Win ((bfu*)(ws + WS_WIN))
#define Wout ((bfu*)(ws + WS_WOUT))
#define XN ((bfu*)(ws + WS_XN))
#define BIG ((bfu*)(ws + WS_BIG))
#define Y ((bfu*)(ws + WS_Y))
#define CT ((bfu*)(ws + WS_CT))
#define QC ((bfu*)(ws + WS_QC))
#define KC ((bfu*)(ws + WS_KC))
#define NST ((float*)(ws + WS_NST))
#define rowss1 ((float*)(ws + WS_ROWSS1))
#define rowss2 ((float*)(ws + WS_ROWSS2))
#define SC ((float*)(ws + WS_SC))
#define DN ((float*)(ws + WS_DN))
#define GATES ((float*)(ws + WS_GATES))
#define DELTA ((float*)(ws + WS_XN))
#define OATT ((bfu*)(ws + WS_XN))
#define PROJM (BIG + (size_t)24 * 16384 * 128)
    const int lo = args.ph_lo, hi = args.ph_hi;
    if (hi - lo > 1) {
        if (wave == 0 && mk_lane() == 0) { volatile LAS unsigned* st = (volatile LAS unsigned*)(lds + LDS_BYTES - 64); st[0] = 0u; st[1] = 0u;
            (void)xb_add(&((unsigned*)(args.ws + WS_BAR))[XB_XCNT(xb_xcc_id())], 1u); }
        __syncthreads();
    }
#ifndef PHMASK
#define PHMASK 0xfff
#endif
#define IN(k) (((PHMASK >> (k)) & 1) && lo <= (k) && (k) < hi)
#ifndef PROBE_MASK
#define PROBE_MASK 0
#endif
#define NREP(k) (((PROBE_MASK >> (k)) & 1) ? 2 : 1)
#define STAGGER_DELAY(N) do { const int sn_ = (int)((blockIdx.x >> 3) & 3) * (N); for (int sd_ = 0; sd_ < sn_; ++sd_) __builtin_amdgcn_s_sleep(85); } while (0)
#define SYNC(k) do { if (IN(k) && IN((k) + 1)) { if (lo < 0) cg::this_grid().sync();     \
        { int kb_ = 0; asm volatile("" : "+s"(kb_)); unsigned char* wsb_ = *(unsigned char* const AS4*)((const AS4 char*)__builtin_amdgcn_kernarg_segment_ptr() + kb_ + 192); \
               xcd_barrier((unsigned*)(wsb_ + WS_BAR), (volatile LAS unsigned*)(lds + LDS_BYTES - 64), wave == 0 && mk_lane() == 0); \
               if ((PROBE_MASK >> 14) & 1) xcd_barrier((unsigned*)(wsb_ + WS_BAR), (volatile LAS unsigned*)(lds + LDS_BYTES - 64), wave == 0 && mk_lane() == 0); } } } while (0)

    if (IN(0)) for (int rep_ = 0; rep_ < NREP(0); ++rep_) { PH_BEGIN
        const float* x = KIN(0);
        LAS float* scr = (LAS float*)(lds + wave * 16640);
        constexpr int I_FFN = 3 * 2816, I_IN = 32 * 96, I_OUT = 32 * 32;
        for (int it = gw; it < I_FFN + I_IN + I_OUT; it += NGW) {
            if (it < I_FFN) cvt_ffn_item(it, KIN(2), KIN(3), KIN(4), KIN(1), Wgu, Wd, scr, lane);
            else if (it < I_FFN + I_IN) { const int r = it - I_FFN, kb = r / 96, nb = r % 96; cvt_item(KIN(6), NIN, NIN, KIN(5), Win, DM, nb * 64, kb * 64, nb * 64, scr, lane); }
            else { const int r = it - I_FFN - I_IN, kb = r / 32, nb = r % 32; cvt_item(KIN(17), DM, DM, nullptr, Wout, DM, nb * 64, kb * 64, nb * 64, scr, lane); }
        }
        for (int m = gw; m < S_; m += NGW) {
            const f32x4* xr = (const f32x4*)(x + (size_t)m * DM) + lane; f32x4 v[8]; float s = 0.f;
#pragma unroll
            for (int j = 0; j < 8; ++j) { v[j] = xr[64 * j]; s += (v[j][0] * v[j][0] + v[j][1] * v[j][1]) + (v[j][2] * v[j][2] + v[j][3] * v[j][3]); }
            const float rs = 1.0f / sqrtf(wave_sum(s) * (1.0f / DM) + 1e-6f);
            v2u* o8 = (v2u*)(XN + (size_t)m * DM) + lane;
#pragma unroll
            for (int j = 0; j < 8; ++j) { v2u w; w.x = pk2(v[j][0] * rs, v[j][1] * rs); w.y = pk2(v[j][2] * rs, v[j][3] * rs); o8[64 * j] = w; }
        }
        for (int i = blockIdx.x * NTHR + tid; i < 2 * S_; i += G * NTHR) rowss1[i] = 0.f;
        for (int k = blockIdx.x * NTHR + tid; k < DM + 8; k += G * NTHR) {
            unsigned char* gwp = ws + WS_GW; f32x4 w0 = (f32x4){0.f, 0.f, 0.f, 0.f}, w1 = w0;
            if (k < DM) { const float gk = KIN(5)[k]; w0 = *(const f32x4*)(KIN(6) + (size_t)k * NIN + 6144) * gk; w1 = *(const f32x4*)(KIN(6) + (size_t)k * NIN + 6148) * gk; }
#pragma unroll
            for (int j = 0; j < 4; ++j) { *(unsigned short*)(gwp + j * GWP + k * 2) = (unsigned short)f2bf(w0[j]); *(unsigned short*)(gwp + (4 + j) * GWP + k * 2) = (unsigned short)f2bf(w1[j]);
                *(unsigned short*)(gwp + (8 + j) * GWP + k * 2) = 0; *(unsigned short*)(gwp + (12 + j) * GWP + k * 2) = 0; }
        }
    }
    SYNC(0);
    if (IN(1)) { PH_BEGIN
        pg8::Gemm g{XN, Wgu, S_, 2 * FF, DM}; pg8::StaticOrder So; So.init(S_, 2 * FF, G, (int)blockIdx.x);
        pg8::EpiSwiGLU E{BIG, FF, nullptr, 0.f};
        STAGGER_DELAY(1); for (int rep_ = 0; rep_ < NREP(1); ++rep_) pg8::gemm_phase<pg8::EpiSwiGLU, pg8::StaticOrder, true, true>(lds, g, So, E, wave);
    }
    SYNC(1);
    if (IN(2)) { PH_BEGIN
        pg8::Gemm g{BIG, Wd, S_, DM, FF}; pg8::StaticOrder So; So.init(S_, DM, G, (int)blockIdx.x);
        pg8::EpiResid E{KIN(0), out, XN, rowss1, 0.5f, DM};
        STAGGER_DELAY(3); pg8::gemm_phase<pg8::EpiResid, pg8::StaticOrder, true, true>(lds, g, So, E, wave);
    }
    SYNC(2);
    if (IN(3)) { PH_BEGIN
        pg8::Gemm g{XN, Win, S_, NINP, DM}; pg8::StaticOrder So; So.init(S_, NINP, G, (int)blockIdx.x);
        pg8::EpiProj E{BIG, rowss1, 1.0f / DM};
        STAGGER_DELAY(1); for (int rep_ = 0; rep_ < NREP(3); ++rep_) pg8::gemm_phase<pg8::EpiProj, pg8::StaticOrder, true, true>(lds, g, So, E, wave);
        {
            const v4u* src = (const v4u*)(ws + WS_GW);
            for (int i = tid; i < 16 * GWP / 16; i += NTHR) *(LAS v4u*)(lds + 16384 + i * 16) = src[i];
            __syncthreads();
        }
        for (int rep_ = 0; rep_ < NREP(13); ++rep_) for (int rb = blockIdx.x; rb < S_ / 64; rb += G) gates_rows(lds, XN, rowss1, KIN(14), KIN(15), GATES, rb, wave, lane);
    }
    SYNC(3);
    if (IN(4)) { PH_BEGIN for (int item = blockIdx.x; item < 512 * NREP(4); item += G) mlstm_stage_a(lds, PROJM, GATES, KIN(12), KIN(13), QC, KC, DELTA, DN, SC, item & 511, wave); }
    SYNC(4);
    if (IN(5)) { PH_BEGIN for (int rep_ = 0; rep_ < NREP(5); ++rep_) mlstm_scan(lds, DELTA, DN, SC, SC + 1024, CT, NST, tid, blockIdx.x * NTHR + tid, G * NTHR); }
    SYNC(5);
    if (IN(6)) { PH_BEGIN
#ifndef NO_ATTN
#if ATTN2
        attn2_phase((char*)lds_raw, BIG, OATT, 512 * NREP(6), wave);
#else
        attn_phase((char*)lds_raw, BIG, OATT, 512 * NREP(6), wave);
#endif
#endif
        __syncthreads();
#ifndef NO_STAGEC
        for (int rep_ = 0; rep_ < NREP(12); ++rep_) for (int item = blockIdx.x; item < 512; item += G) mlstm_stage_c(lds, PROJM, GATES, QC, KC, CT, NST, SC + 1024, KIN(16), Y, item, wave);
#endif
    }
    SYNC(6);
    if (IN(7)) for (int rep_ = 0; rep_ < NREP(7); ++rep_) { PH_BEGIN
        const float l1 = wave_sum(KIN(7)[lane] * KIN(8)[lane] + KIN(7)[lane + 64] * KIN(8)[lane + 64]);
        const float l2 = wave_sum(KIN(9)[lane] * KIN(10)[lane] + KIN(9)[lane + 64] * KIN(10)[lane + 64]);
        const float lam = expf(l1) - expf(l2) + 0.2f;
        const float* hg = KIN(11);
        for (int m = gw; m < S_; m += NGW) {
#pragma unroll
            for (int h = 0; h < 4; ++h) {
                const v2u a = *((const v2u*)(OATT + (size_t)m * 2048 + h * 512) + lane), b = *((const v2u*)(OATT + (size_t)m * 2048 + h * 512 + 256) + lane);
                float y0 = bf2f(a.x & 0xffffu) - lam * bf2f(b.x & 0xffffu), y1 = bf2f(a.x >> 16) - lam * bf2f(b.x >> 16), y2 = bf2f(a.y & 0xffffu) - lam * bf2f(b.y & 0xffffu), y3 = bf2f(a.y >> 16) - lam * bf2f(b.y >> 16);
                const float rs = 0.8f / sqrtf(wave_sum((y0 * y0 + y1 * y1) + (y2 * y2 + y3 * y3)) * (1.0f / 256.0f) + 1e-6f);
                const f32x4 gn = *((const f32x4*)(hg + h * 256) + lane);
                v2u w; w.x = pk2(y0 * rs * gn[0], y1 * rs * gn[1]); w.y = pk2(y2 * rs * gn[2], y3 * rs * gn[3]);
                *((v2u*)(Y + (size_t)m * DM + h * 256) + lane) = w;
            }
        }
        LAS float* scr = (LAS float*)(lds + wave * 16640);
        for (int it = gw; it < 3 * 2816; it += NGW) cvt_ffn_item(it, KIN(19), KIN(20), KIN(21), KIN(18), Wgu, Wd, scr, lane);
    }
    SYNC(7);
    if (IN(8)) { PH_BEGIN
        pg8::Gemm g{Y, Wout, S_, DM, DM}; pg8::StaticOrder So; So.init(S_, DM, G, (int)blockIdx.x);
        pg8::EpiResid E{out, out, XN, rowss2, 1.0f, DM};
        STAGGER_DELAY(3); pg8::gemm_phase<pg8::EpiResid, pg8::StaticOrder, true, true>(lds, g, So, E, wave);
    }
    SYNC(8);
    if (IN(9)) { PH_BEGIN
        pg8::Gemm g{XN, Wgu, S_, 2 * FF, DM}; pg8::StaticOrder So; So.init(S_, 2 * FF, G, (int)blockIdx.x);
        pg8::EpiSwiGLU E{BIG, FF, rowss2, 1.0f / DM};
        STAGGER_DELAY(1); pg8::gemm_phase<pg8::EpiSwiGLU, pg8::StaticOrder, true, true>(lds, g, So, E, wave);
    }
    SYNC(9);
    if (IN(10)) { PH_BEGIN
        pg8::Gemm g{BIG, Wd, S_, DM, FF}; pg8::StaticOrder So; So.init(S_, DM, G, (int)blockIdx.x);
        pg8::EpiResid E{out, out, nullptr, nullptr, 0.5f, DM};
        STAGGER_DELAY(3); pg8::gemm_phase<pg8::EpiResid, pg8::StaticOrder, true, true>(lds, g, So, E, wave);
    }
    SYNC(10);
    if (IN(11)) { PH_BEGIN
        const float* fg = KIN(22);
        for (int m = gw; m < S_; m += NGW) {
            f32x4* xr = (f32x4*)(out + (size_t)m * DM) + lane; f32x4 v[8]; float s = 0.f;
#pragma unroll
            for (int j = 0; j < 8; ++j) { v[j] = xr[64 * j]; s += (v[j][0] * v[j][0] + v[j][1] * v[j][1]) + (v[j][2] * v[j][2] + v[j][3] * v[j][3]); }
            const float rs = 1.0f / sqrtf(wave_sum(s) * (1.0f / DM) + 1e-6f);
#pragma unroll
            for (int j = 0; j < 8; ++j) { const f32x4 gn = *((const f32x4*)fg + 64 * j + lane); xr[64 * j] = v[j] * rs * gn; }
        }
    }
#undef IN
#undef SYNC
}

extern "C" void kernel_launch(void* const* d_in, const int* in_sizes, int n_in, void* d_out, int out_size, void* d_ws, size_t ws_size, hipStream_t stream) {
    static int grid = 0;
    if (grid == 0) {
        if (n_in != 23 || in_sizes[0] != S_ * DM || out_size != S_ * DM || ws_size < WS_END) { fprintf(stderr, "kernel_launch: unexpected shapes (n_in %d, in0 %d, out %d, ws %zu)\n", n_in, n_in > 0 ? in_sizes[0] : -1, out_size, ws_size); grid = -1; return; }
        int dev = 0, cus = 0, per_cu = 0;
        (void)hipGetDevice(&dev); (void)hipDeviceGetAttribute(&cus, hipDeviceAttributeMultiprocessorCount, dev);
        if (hipFuncSetAttribute((const void*)mega_fwd, hipFuncAttributeMaxDynamicSharedMemorySize, LDS_BYTES) != hipSuccess) { fprintf(stderr, "kernel_launch: hipFuncSetAttribute failed\n"); grid = -1; return; }
        if (hipOccupancyMaxActiveBlocksPerMultiprocessor(&per_cu, (const void*)mega_fwd, NTHR, LDS_BYTES) != hipSuccess || per_cu < 1) per_cu = 1;
        grid = cus * per_cu;
        fprintf(stderr, "kernel_launch: grid %d (%d CUs x %d)\n", grid, cus, per_cu);
    }
    if (grid < 0) return;
    Args a{};
    for (int i = 0; i < 23; ++i) a.in[i] = (const float*)d_in[i];
    a.out = (float*)d_out; a.ws = (unsigned char*)d_ws;
#if MK_SPLIT
    for (int p = 0; p < NPH; ++p) { a.ph_lo = p; a.ph_hi = p + 1; hipLaunchKernelGGL(mega_fwd, dim3(grid), dim3(NTHR), LDS_BYTES, stream, a); }
#else
    a.ph_lo = 0; a.ph_hi = NPH;
    (void)hipMemsetAsync((char*)d_ws + WS_BAR, 0, XCD_BAR_WORDS * 4, stream);
    void* kargs[] = {&a};
    hipError_t e = hipLaunchCooperativeKernel((const void*)mega_fwd, dim3(grid), dim3(NTHR), kargs, LDS_BYTES, stream);
    if (e != hipSuccess) fprintf(stderr, "kernel_launch: cooperative launch failed: %s (grid %d)\n", hipGetErrorString(e), grid);
#endif
}
```

```cpp
#include <hip/hip_runtime.h>
#include <hip/hip_bf16.h>
#include <hip/hip_cooperative_groups.h>
#include <cstdio>
#include <cstdint>
namespace cg = cooperative_groups;

#ifndef MK_SPLIT
#define MK_SPLIT 0
#endif

namespace pg8 {
#define PG8_LAS __attribute__((address_space(3)))
typedef unsigned short bf16_t;
typedef short bf16x8 __attribute__((ext_vector_type(8)));
typedef float f32x4 __attribute__((ext_vector_type(4)));
typedef unsigned u32x4 __attribute__((ext_vector_type(4)));
constexpr int BM = 256, BK = 64, HALF = 128, HTB = HALF * BK * 2  , STAGE_BYTES = 8 * HTB, NXCD = 8, WGM = 8;

__host__ __device__ __forceinline__ int lds_byte(int r, int c) { const int st = (r >> 4) * 2 + (c >> 5), rr = r & 15, cc = c & 31, ob = rr * 64 + cc * 2; return st * 1024 + (ob ^ (((ob >> 9) & 1) << 5)); }
__host__ __device__ __forceinline__ void stage_rc(int b, int& R, int& C) { const int st = b / 1024, sb = b % 1024, swz = sb ^ (((sb >> 9) & 1) << 5); R = (st >> 1) * 16 + swz / 64; C = (st & 1) * 32 + (swz % 64) / 2; }
__host__ __device__ __forceinline__ int perm32(int rho) { const int n = rho >> 4, i = rho & 15; return 8 * (i >> 2) + 4 * n + (i & 3); }

struct Unit { int pm, pn; };
struct Gemm { const bf16_t* A; const bf16_t* Bt; int M, N, K; };

struct StaticOrder {
    int nM, nN, nwg, G, c;
    __host__ __device__ void init(int M, int N, int G_, int c_) { nM = M / BM; nN = N / BM; nwg = nM * nN; G = G_; c = c_; }
    __host__ __device__ bool next(int i, Unit& u) const {
        const long L = (long)i * G + c; if (L >= nwg) return false;
        int wgid = (int)L; { const int q = nwg / NXCD, r = nwg % NXCD, xcd = wgid % NXCD, off = wgid / NXCD; wgid = (xcd < r ? xcd * (q + 1) : r * (q + 1) + (xcd - r) * q) + off; }
        const int nig = WGM * nN, gid = wgid / nig, fm = gid * WGM, gsz = (nM - fm) < WGM ? (nM - fm) : WGM;
        u.pm = fm + ((wgid % nig) % gsz); u.pn = (wgid % nig) / gsz; return true;
    }
    __device__ __forceinline__ void a_ready(const Unit&) const {}
    __device__ __forceinline__ void done(const Unit&) const {}
};

__device__ __forceinline__ unsigned cvt_pk_bf16(float lo, float hi) { unsigned r; asm volatile("v_cvt_pk_bf16_f32 %0, %1, %2" : "=v"(r) : "v"(lo), "v"(hi)); return r; }

constexpr float RMS_EPS = 1e-6f;
__device__ __forceinline__ float silu_f(float x) { return x * __builtin_amdgcn_rcpf(1.0f + __builtin_amdgcn_exp2f(-1.4426950408889634f * x)); }
struct EpiSwiGLU {
    static constexpr bool PERM = true, AFTER_DRAIN = false;
    bf16_t* O; int ldo; const float* rowss; float inv_n;
    __device__ __forceinline__ void operator()(const f32x4 (&acc)[2][2][4][2], const Unit& u, int wr, int wc, int fr, int fq) const {
        const int row0 = u.pm * BM + wr * 64 + fr, col0 = u.pn * HALF + wc * 32 + 8 * fq;
#pragma unroll
        for (int ai = 0; ai < 2; ++ai)
#pragma unroll
            for (int m = 0; m < 4; ++m) {
                const int r = row0 + ai * HALF + m * 16;
                const float rs = rowss ? __builtin_amdgcn_rsqf(rowss[r] * inv_n + RMS_EPS) : 1.0f;
                const f32x4 g0 = acc[ai][0][m][0] * rs, g1 = acc[ai][0][m][1] * rs, u0 = acc[ai][1][m][0] * rs, u1 = acc[ai][1][m][1] * rs;
                u32x4 w;
                w.x = cvt_pk_bf16(silu_f(g0[0]) * u0[0], silu_f(g0[1]) * u0[1]); w.y = cvt_pk_bf16(silu_f(g0[2]) * u0[2], silu_f(g0[3]) * u0[3]);
                w.z = cvt_pk_bf16(silu_f(g1[0]) * u1[0], silu_f(g1[1]) * u1[1]); w.w = cvt_pk_bf16(silu_f(g1[2]) * u1[2], silu_f(g1[3]) * u1[3]);
                *(u32x4*)(O + (size_t)r * ldo + col0) = w;
            }
    }
};
struct EpiResid {
    static constexpr bool PERM = false, AFTER_DRAIN = false;
    const float* resid; float* out; bf16_t* xb; float* rowss; float alpha; int ld;
    __device__ __forceinline__ void operator()(const f32x4 (&acc)[2][2][4][2], const Unit& u, int wr, int wc, int fr, int fq) const {
        typedef unsigned u32x2v __attribute__((ext_vector_type(2)));
        const int row0 = u.pm * BM + wr * 64 + fr, col0 = u.pn * BM + wc * 32 + 4 * fq;
#pragma unroll
        for (int ai = 0; ai < 2; ++ai)
#pragma unroll
            for (int m = 0; m < 4; ++m) {
                const int r = row0 + ai * HALF + m * 16; float ss = 0.f;
#pragma unroll
                for (int bj = 0; bj < 2; ++bj)
#pragma unroll
                    for (int n = 0; n < 2; ++n) {
                        const size_t off = (size_t)r * ld + col0 + bj * HALF + n * 16;
                        const f32x4 b = *(const f32x4*)(resid + off); const f32x4 o = b + acc[ai][bj][m][n] * alpha;
                        *(f32x4*)(out + off) = o; ss += (o[0] * o[0] + o[1] * o[1]) + (o[2] * o[2] + o[3] * o[3]);
                        if (xb) { u32x2v w; w.x = cvt_pk_bf16(o[0], o[1]); w.y = cvt_pk_bf16(o[2], o[3]); *(u32x2v*)(xb + off) = w; }
                    }
                if (rowss) { ss += __shfl_xor(ss, 16); ss += __shfl_xor(ss, 32); if (fq == 0) atomicAdd(rowss + r, ss); }
            }
    }
};
struct EpiProj {
    static constexpr bool PERM = true, AFTER_DRAIN = false;
    bf16_t* O; const float* rowss; float inv_n;
    __device__ __forceinline__ void operator()(const f32x4 (&acc)[2][2][4][2], const Unit& u, int wr, int wc, int fr, int fq) const {
        const int row0 = u.pm * BM + wr * 64 + fr;
        {
            const bool dense = u.pn < 12;
            const size_t rstride = dense ? 128 : 3072;
            bf16_t* base = dense ? O + (size_t)(2 * u.pn) * ((size_t)16384 * 128) + wc * 32 + 8 * fq : O + (size_t)24 * 16384 * 128 + (u.pn - 12) * BM + wc * 32 + 8 * fq;
            const size_t bjstep = dense ? (size_t)16384 * 128 : 128;
#pragma unroll
            for (int ai = 0; ai < 2; ++ai)
#pragma unroll
                for (int m = 0; m < 4; ++m) {
                    const int r = row0 + ai * HALF + m * 16; const float rs = __builtin_amdgcn_rsqf(rowss[r] * inv_n + RMS_EPS);
#pragma unroll
                    for (int bj = 0; bj < 2; ++bj) { const f32x4 v0 = acc[ai][bj][m][0] * rs, v1 = acc[ai][bj][m][1] * rs; u32x4 w;
                        w.x = cvt_pk_bf16(v0[0], v0[1]); w.y = cvt_pk_bf16(v0[2], v0[3]); w.z = cvt_pk_bf16(v1[0], v1[1]); w.w = cvt_pk_bf16(v1[2], v1[3]);
                        *(u32x4*)(base + (size_t)r * rstride + bj * bjstep) = w; }
                }
        }
    }
};
template <class Epi, class Sched, bool ALIGN_EPI = false, bool SP2 = false>
__device__ __forceinline__ void gemm_phase(PG8_LAS unsigned char* lds, const Gemm g, const Sched& S, const Epi& E, const int mk_wave) {
    const int lane = (int)(__builtin_amdgcn_mbcnt_hi(~0u, __builtin_amdgcn_mbcnt_lo(~0u, 0u)) & 63u), wid = mk_wave & 7, tid = wid * 64 + lane, wr = wid >> 2, wc = wid & 3, fr = lane & 15, fq = lane >> 4;
    const int K = g.K, nt = K / BK;
    unsigned voffA[2], voffB[2];
#pragma unroll
    for (int i = 0; i < 2; ++i) { int R, C; stage_rc(tid * 16 + i * 8192, R, C); const int Rb = Epi::PERM ? ((R & ~31) + perm32(R & 31)) : R;
        voffA[i] = (unsigned)(R * K + C) * 2u; voffB[i] = (unsigned)(Rb * K + C) * 2u; }
    const size_t kstep = (size_t)(BK * 2);
    const size_t hstep = (size_t)HALF * K * 2;
    const size_t tstep = 2 * hstep;
    const unsigned ldsw = (unsigned)wid * 1024u;
    const int aoff = lds_byte(wr * 64 + fr, fq * 8), boff = lds_byte(wc * 32 + fr, fq * 8);
#define PG8_SA(b, h) (((b) * 2 + (h)) * HTB)
#define PG8_SB(b, h) ((4 + (b) * 2 + (h)) * HTB)
#define PG8_STAGE(bufoff, gbase, voff) do { _Pragma("unroll") for (int _i = 0; _i < 2; ++_i) \
        __builtin_amdgcn_global_load_lds((const unsigned*)((const char*)(gbase) + (voff)[_i]), (PG8_LAS unsigned*)(lds + (bufoff) + ldsw + _i * 8192), 16, 0, 0); } while (0)
#define PG8_LDA(dst, b, h) do { _Pragma("unroll") for (int m = 0; m < 4; ++m) _Pragma("unroll") for (int k = 0; k < 2; ++k) dst[m][k] = *(const PG8_LAS bf16x8*)(lds + PG8_SA(b, h) + aoff + m * 2048 + k * 1024); } while (0)
#define PG8_LDB(dst, b, h) do { _Pragma("unroll") for (int n = 0; n < 2; ++n) _Pragma("unroll") for (int k = 0; k < 2; ++k) dst[n][k] = *(const PG8_LAS bf16x8*)(lds + PG8_SB(b, h) + boff + n * 2048 + k * 1024); } while (0)
#define PG8_MMA(ai, bj, At, Bt) do { __builtin_amdgcn_s_setprio(1); _Pragma("unroll") for (int m = 0; m < 4; ++m) _Pragma("unroll") for (int n = 0; n < 2; ++n) _Pragma("unroll") for (int k = 0; k < 2; ++k) \
        acc[ai][bj][m][n] = __builtin_amdgcn_mfma_f32_16x16x32_bf16(Bt[n][k], At[m][k], acc[ai][bj][m][n], 0, 0, 0); __builtin_amdgcn_s_setprio(0); } while (0)
#define PG8_WAIT_V(n) asm volatile("s_waitcnt vmcnt(" #n ")" ::: "memory")
#define PG8_WAIT_L(n) asm volatile("s_waitcnt lgkmcnt(" #n ")" ::: "memory")
#define PG8_BAR __builtin_amdgcn_s_barrier()
#define PG8_SCHED __builtin_amdgcn_sched_barrier(0)
    Unit cur, nxt; int ui = 0;
    if (!S.next(0, cur)) return;
    f32x4 acc[2][2][4][2];
#pragma unroll
    for (int a = 0; a < 2; ++a)
#pragma unroll
        for (int b = 0; b < 2; ++b)
#pragma unroll
            for (int m = 0; m < 4; ++m)
#pragma unroll
                for (int n = 0; n < 2; ++n) acc[a][b][m][n] = (f32x4){0.f, 0.f, 0.f, 0.f};
    bf16x8 At[4][2], B0[2][2], B1[2][2];
    const char* cA = (const char*)g.A + (size_t)cur.pm * tstep; const char* cB = (const char*)g.Bt + (size_t)cur.pn * tstep;
    S.a_ready(cur);
    if constexpr (SP2) {
        PG8_STAGE(PG8_SB(0, 0), cB, voffB); PG8_STAGE(PG8_SB(0, 1), cB + hstep, voffB); PG8_STAGE(PG8_SA(0, 0), cA, voffA); PG8_STAGE(PG8_SA(0, 1), cA + hstep, voffA);
        if (wr == 1) PG8_BAR;
        PG8_WAIT_V(2); PG8_BAR;
        PG8_STAGE(PG8_SB(1, 0), cB + kstep, voffB); PG8_STAGE(PG8_SA(1, 0), cA + kstep, voffA); PG8_STAGE(PG8_SB(1, 1), cB + hstep + kstep, voffB);
        PG8_WAIT_V(6); PG8_BAR;
    } else {
        PG8_STAGE(PG8_SB(0, 0), cB, voffB); PG8_STAGE(PG8_SA(0, 0), cA, voffA); PG8_STAGE(PG8_SB(0, 1), cB + hstep, voffB); PG8_STAGE(PG8_SA(0, 1), cA + hstep, voffA);
        if (wr == 1) PG8_BAR;
        PG8_WAIT_V(4); PG8_BAR;
        PG8_STAGE(PG8_SB(1, 0), cB + kstep, voffB); PG8_STAGE(PG8_SA(1, 0), cA + kstep, voffA); PG8_STAGE(PG8_SB(1, 1), cB + hstep + kstep, voffB);
        PG8_WAIT_V(6); PG8_BAR;
    }
    for (;;) {
        const bool has_next = S.next(ui + 1, nxt);
        const char* nA = has_next ? (const char*)g.A + (size_t)nxt.pm * tstep : cA; const char* nB = has_next ? (const char*)g.Bt + (size_t)nxt.pn * tstep : cB;
        for (int t = 0; t < nt; t += 2) {
            const bool last = (t == nt - 2);
            const char* a1 = cA + (size_t)(t + 1) * kstep;
            const char* a2 = last ? nA : cA + (size_t)(t + 2) * kstep; const char* b2 = last ? nB : cB + (size_t)(t + 2) * kstep;
            const char* a3 = a2 + kstep; const char* b3 = b2 + kstep;
            if (last && has_next) S.a_ready(nxt);
            if constexpr (SP2) {
            PG8_LDB(B0, 0, 0); PG8_LDB(B1, 0, 1); PG8_SCHED; PG8_LDA(At, 0, 0); PG8_STAGE(PG8_SA(1, 1), a1 + hstep, voffA);
            PG8_WAIT_V(8); PG8_WAIT_L(0); PG8_BAR; PG8_MMA(0, 0, At, B0); PG8_MMA(0, 1, At, B1); PG8_BAR; PG8_SCHED;
            PG8_LDA(At, 0, 1); PG8_STAGE(PG8_SB(0, 0), b2, voffB); PG8_STAGE(PG8_SB(0, 1), b2 + hstep, voffB); PG8_STAGE(PG8_SA(0, 0), a2, voffA);
            PG8_WAIT_V(8); PG8_WAIT_L(0); PG8_BAR; PG8_MMA(1, 0, At, B0); PG8_MMA(1, 1, At, B1); PG8_BAR; PG8_SCHED;
            PG8_LDB(B0, 1, 0); PG8_LDB(B1, 1, 1); PG8_SCHED; PG8_LDA(At, 1, 0); PG8_STAGE(PG8_SA(0, 1), a2 + hstep, voffA);
            PG8_WAIT_V(8); PG8_WAIT_L(0); PG8_BAR; PG8_MMA(0, 0, At, B0); PG8_MMA(0, 1, At, B1); PG8_BAR; PG8_SCHED;
            PG8_LDA(At, 1, 1); PG8_STAGE(PG8_SB(1, 0), b3, voffB); PG8_STAGE(PG8_SB(1, 1), b3 + hstep, voffB); PG8_STAGE(PG8_SA(1, 0), a3, voffA);
            PG8_WAIT_V(8); PG8_WAIT_L(0); PG8_BAR; PG8_MMA(1, 0, At, B0); PG8_MMA(1, 1, At, B1); PG8_BAR; PG8_SCHED;
            } else {
            PG8_LDB(B0, 0, 0); PG8_SCHED; PG8_LDA(At, 0, 0); PG8_STAGE(PG8_SA(1, 1), a1 + hstep, voffA);
            PG8_WAIT_L(8); PG8_BAR; PG8_WAIT_L(0); PG8_MMA(0, 0, At, B0); PG8_BAR; PG8_SCHED;
            PG8_LDB(B1, 0, 1); PG8_STAGE(PG8_SB(0, 0), b2, voffB);
            PG8_BAR; PG8_WAIT_L(0); PG8_MMA(0, 1, At, B1); PG8_BAR;
            PG8_LDA(At, 0, 1); PG8_STAGE(PG8_SA(0, 0), a2, voffA);
            PG8_BAR; PG8_WAIT_L(0); PG8_MMA(1, 0, At, B0); PG8_BAR; PG8_SCHED;
            PG8_STAGE(PG8_SB(0, 1), b2 + hstep, voffB);
            PG8_WAIT_V(6); PG8_BAR; PG8_MMA(1, 1, At, B1); PG8_BAR;
            PG8_LDB(B0, 1, 0); PG8_SCHED; PG8_LDA(At, 1, 0); PG8_STAGE(PG8_SA(0, 1), a2 + hstep, voffA);
            PG8_WAIT_L(8); PG8_BAR; PG8_WAIT_L(0); PG8_MMA(0, 0, At, B0); PG8_BAR; PG8_SCHED;
            PG8_LDB(B1, 1, 1); PG8_STAGE(PG8_SB(1, 0), b3, voffB);
            PG8_BAR; PG8_WAIT_L(0); PG8_MMA(0, 1, At, B1); PG8_BAR;
            PG8_LDA(At, 1, 1); PG8_STAGE(PG8_SA(1, 0), a3, voffA);
            PG8_BAR; PG8_WAIT_L(0); PG8_MMA(1, 0, At, B0); PG8_BAR; PG8_SCHED;
            PG8_STAGE(PG8_SB(1, 1), b3 + hstep, voffB);
            PG8_WAIT_V(6); PG8_BAR; PG8_MMA(1, 1, At, B1); PG8_BAR;
            }
        }
        if constexpr (ALIGN_EPI) { if (wr == 0) PG8_BAR; }
        if constexpr (!Epi::AFTER_DRAIN) { E(acc, cur, wr, wc, fr, fq); S.done(cur); }
        if (!has_next) break;
#pragma unroll
        for (int a = 0; a < 2; ++a)
#pragma unroll
            for (int b = 0; b < 2; ++b)
#pragma unroll
                for (int m = 0; m < 4; ++m)
#pragma unroll
                    for (int n = 0; n < 2; ++n) acc[a][b][m][n] = (f32x4){0.f, 0.f, 0.f, 0.f};
        cur = nxt; cA = nA; cB = nB; ++ui;
        if constexpr (ALIGN_EPI) { if (wr == 1) PG8_BAR; }
    }
    PG8_WAIT_V(0);
    if constexpr (!ALIGN_EPI) { if (wr == 0) PG8_BAR; }
    PG8_BAR;
    if constexpr (Epi::AFTER_DRAIN) { E.fused(acc, cur, wr, wc, fr, fq, lds, wid, lane); S.done(cur); }
#undef PG8_SA
#undef PG8_SB
#undef PG8_STAGE
#undef PG8_LDA
#undef PG8_LDB
#undef PG8_MMA
#undef PG8_WAIT_V
#undef PG8_WAIT_L
#undef PG8_BAR
#undef PG8_SCHED
}
}

namespace att {
constexpr int D = 128; constexpr float THR = 8.f; constexpr bool WSKIP = false; constexpr int LDP = 128, LDO = 2048;
constexpr float SCALE = 0.08838834764831845f;
constexpr int NW = 8, QBLK = 32, KVBLK = 64, QB = NW * QBLK;
constexpr int SHM_V = KVBLK * D * 2, SHM_K = KVBLK * D * 2;
constexpr int LDS_BYTES = 2 * SHM_V + 2 * SHM_K + NW * 64 * 4;

using bf16 = __hip_bfloat16;
typedef short bf16x8 __attribute__((ext_vector_type(8)));
typedef short s16x4 __attribute__((ext_vector_type(4)));
typedef float f32x16 __attribute__((ext_vector_type(16)));
typedef float f32x4 __attribute__((ext_vector_type(4)));
typedef unsigned u32x4 __attribute__((ext_vector_type(4)));
template <class A, class Bt> struct same_t { static constexpr bool v = false; };
template <class A> struct same_t<A, A> { static constexpr bool v = true; };

#define KSWZ(row, colB) ((row) * 256 + ((colB) ^ (((row) & 7) << 4)))
#define SBAR() __builtin_amdgcn_sched_barrier(0)
__device__ __forceinline__ int v_st(int k, int c) { const int kk = (k & ~0xC) | ((k & 4) << 1) | ((k & 8) >> 1); return ((kk >> 3) * 4 + (c >> 5)) * 512 + ((kk & 7) * 32 + (c & 31)) * 2; }
__device__ __forceinline__ int v_rd_base(int lane) { return ((lane & 3) << 3) | (((lane >> 2) & 3) << 6) | (((lane >> 4) & 1) << 5) | (((lane >> 5) & 1) << 8); }
constexpr int v_rd_off(int d0, int ks, int half) { return d0 * 512 + ks * 4096 + half * 2048; }
__device__ __forceinline__ int crow(int r, int hi) { return (r & 3) + 8 * (r >> 2) + 4 * hi; }
__device__ __forceinline__ unsigned cvtpk(float lo, float hi) {
    unsigned r; asm volatile("v_cvt_pk_bf16_f32 %0, %1, %2" : "=v"(r) : "v"(lo), "v"(hi)); return r;
}
__device__ __forceinline__ bf16x8 pack8(f32x4 a, f32x4 b) {
    u32x4 w = {cvtpk(a[0], a[1]), cvtpk(a[2], a[3]), cvtpk(b[0], b[1]), cvtpk(b[2], b[3])};
    return *reinterpret_cast<bf16x8*>(&w);
}
template <class T> __device__ __forceinline__ bf16x8 load8(const T* p) {
    if constexpr (same_t<T, float>::v) { return pack8(*(const f32x4*)p, *(const f32x4*)(p + 4)); }
    else { return *reinterpret_cast<const bf16x8*>(p); }
}
__device__ __forceinline__ void mask_tile(f32x16& p0, f32x16& p1, int dq, unsigned W) {
    const float NEG = -__builtin_inff();
#pragma unroll
    for (int r = 0; r < 16; ++r) {
        const int c = (r & 3) + 8 * (r >> 2);
        if ((unsigned)(dq - c) >= W) p0[r] = NEG;
        if ((unsigned)(dq - c - 32) >= W) p1[r] = NEG;
    }
}
__device__ __forceinline__ void partialSM(f32x16& p0, f32x16& p1, float& m_reg, float& mn, float& alpha) {
    float pmax = p0[0]; for (int r = 1; r < 16; ++r) pmax = fmaxf(pmax, p0[r]); for (int r = 0; r < 16; ++r) pmax = fmaxf(pmax, p1[r]);
    { auto rr = __builtin_amdgcn_permlane32_swap(__float_as_uint(pmax), __float_as_uint(pmax), false, false);
      pmax = fmaxf(__uint_as_float(rr[0]), __uint_as_float(rr[1])); }
    constexpr float C2 = 1.4426950408889634f * SCALE;
    if (__builtin_expect(__all((pmax - m_reg) * SCALE <= THR), 1)) { mn = m_reg; alpha = 1.f; }
    else { mn = fmaxf(m_reg, pmax); alpha = __builtin_amdgcn_exp2f((m_reg - mn) * C2); m_reg = mn; }
    const float mnL = -mn * C2;
    for (int r = 0; r < 16; ++r) p0[r] = fmaf(p0[r], C2, mnL); for (int r = 0; r < 16; ++r) p1[r] = fmaf(p1[r], C2, mnL);
    for (int r = 0; r < 16; ++r) p0[r] = __builtin_amdgcn_exp2f(p0[r]);
}
__device__ __forceinline__ void finishSM(f32x16& p0, f32x16& p1, float alpha, float& l_reg, bf16x8& pa0, bf16x8& pa1, bf16x8& pa2, bf16x8& pa3) {
    for (int r = 0; r < 16; ++r) p1[r] = __builtin_amdgcn_exp2f(p1[r]);
    float ps = 0; for (int r = 0; r < 16; ++r) ps += p0[r]; for (int r = 0; r < 16; ++r) ps += p1[r];
    { auto rr = __builtin_amdgcn_permlane32_swap(__float_as_uint(ps), __float_as_uint(ps), false, false);
      ps = __uint_as_float(rr[0]) + __uint_as_float(rr[1]); }
    l_reg = l_reg * alpha + ps;
#define PK4(P, B_, OUT) do { unsigned a0 = cvtpk(P[B_+0], P[B_+1]), a1 = cvtpk(P[B_+2], P[B_+3]);                          \
        unsigned b0 = cvtpk(P[B_+4], P[B_+5]), b1 = cvtpk(P[B_+6], P[B_+7]);                                             \
        auto r0 = __builtin_amdgcn_permlane32_swap(a0, b0, false, false); auto r1 = __builtin_amdgcn_permlane32_swap(a1, b1, false, false); \
        u32x4 w = {r0[0], r1[0], r0[1], r1[1]}; OUT = *reinterpret_cast<bf16x8*>(&w); } while (0)
    PK4(p0, 0, pa0); PK4(p0, 8, pa1); PK4(p1, 0, pa2); PK4(p1, 8, pa3);
#undef PK4
}
template <int KB, bool SK>
__device__ __forceinline__ void qkt(f32x16& p0, f32x16& p1, const char* K_lds, int r32, int hi, const bf16x8* qr, bool act) {
    if (SK && !act) { const float NEG = -__builtin_inff();
#pragma unroll
        for (int r = 0; r < 16; ++r) { p0[r] = NEG; p1[r] = NEG; } return; }
    p0 = f32x16{}; p1 = f32x16{};
    const char* kb[4];
#pragma unroll
    for (int dd = 0; dd < 4; ++dd) kb[dd] = K_lds + KB * SHM_K + KSWZ(r32, (dd * 16 + hi * 8) * 2);
#pragma unroll
    for (int d0 = 0; d0 < 8; ++d0) { const char* a = kb[d0 & 3] + (d0 >> 2) * 128;
        bf16x8 b0 = *reinterpret_cast<const bf16x8*>(a);
        bf16x8 b1 = *reinterpret_cast<const bf16x8*>(a + 32 * 256);
        p0 = __builtin_amdgcn_mfma_f32_32x32x16_bf16(b0, qr[d0], p0, 0, 0, 0);
        p1 = __builtin_amdgcn_mfma_f32_32x32x16_bf16(b1, qr[d0], p1, 0, 0, 0); }
}
template <int VB, bool SK>
__device__ __forceinline__ void pv_tile(f32x16* o, int vb0, bf16x8 pa0, bf16x8 pa1, bf16x8 pa2, bf16x8 pa3, bool act) {
    if (SK && !act) return;
#define TRRD(dst, off) asm volatile("ds_read_b64_tr_b16 %0, %1 offset:%2" : "=&v"(dst) : "v"(vb0), "i"(off) : "memory")
#define PV_D0(d0) do { s16x4 l0, l1, l2, l3, h0, h1, h2, h3; constexpr int b_ = VB * SHM_V + v_rd_off(d0, 0, 0);     \
        TRRD(l0, b_); TRRD(h0, b_ + 2048); TRRD(l1, b_ + 4096); TRRD(h1, b_ + 6144); TRRD(l2, b_ + 8192); TRRD(h2, b_ + 10240); TRRD(l3, b_ + 12288); TRRD(h3, b_ + 14336); \
        asm volatile("s_waitcnt lgkmcnt(0)" ::: "memory"); SBAR();                 \
        o[d0] = __builtin_amdgcn_mfma_f32_32x32x16_bf16(pa0, (bf16x8){l0[0], l0[1], l0[2], l0[3], h0[0], h0[1], h0[2], h0[3]}, o[d0], 0, 0, 0);   \
        o[d0] = __builtin_amdgcn_mfma_f32_32x32x16_bf16(pa1, (bf16x8){l1[0], l1[1], l1[2], l1[3], h1[0], h1[1], h1[2], h1[3]}, o[d0], 0, 0, 0);   \
        o[d0] = __builtin_amdgcn_mfma_f32_32x32x16_bf16(pa2, (bf16x8){l2[0], l2[1], l2[2], l2[3], h2[0], h2[1], h2[2], h2[3]}, o[d0], 0, 0, 0);   \
        o[d0] = __builtin_amdgcn_mfma_f32_32x32x16_bf16(pa3, (bf16x8){l3[0], l3[1], l3[2], l3[3], h3[0], h3[1], h3[2], h3[3]}, o[d0], 0, 0, 0); } while (0)
    PV_D0(0); PV_D0(1); PV_D0(2); PV_D0(3);
#undef PV_D0
#undef TRRD
}

template <class TIn, class TOut> struct BlockRef { const TIn* Q; const TIn* K; const TIn* V; TOut* O; int P0; };
template <class TIn> struct Seam {
    bf16x8 qr[8];
    bf16x8 st_v0, st_v1, st_k0, st_k1; f32x4 sf0, sf1, sf2, sf3;
    f32x4 tq[16];
};
__device__ __forceinline__ int swa_jlo(int P0, int W) { const int lowk = P0 - W + 1; return lowk > 0 ? lowk / KVBLK : 0; }
#define ROW(p, k0, rr) ((p) + (size_t)((k0) + (rr)) * LDP + sc)
#define VMW() asm volatile("s_waitcnt vmcnt(0)" ::: "memory")
#define VMWN(n) asm volatile("s_waitcnt vmcnt(%0)" :: "i"(n) : "memory")
#define SLOAD_H(Kp, Vp, k0) do { S.st_v0 = load8<TIn>(ROW(Vp, k0, sr)); S.st_v1 = load8<TIn>(ROW(Vp, k0, 32 + sr));              \
                         S.st_k0 = load8<TIn>(ROW(Kp, k0, sr)); S.st_k1 = load8<TIn>(ROW(Kp, k0, 32 + sr)); } while (0)
#define SWRITE_HK(bf) do { *(bf16x8*)(K_lds + (bf) * SHM_K + kws) = S.st_k0; *(bf16x8*)(K_lds + (bf) * SHM_K + kws + 32 * 256) = S.st_k1; } while (0)
#define SWRITE_HV(bf) do { *(bf16x8*)(V_lds + (bf) * SHM_V + vst0) = S.st_v0; *(bf16x8*)(V_lds + (bf) * SHM_V + vst1) = S.st_v1; } while (0)
#define SWRITE_H(bf) do { SWRITE_HV(bf); SWRITE_HK(bf); } while (0)
#define SLOAD_F(p, k0) do { S.sf0 = *(const f32x4*)ROW(p, k0, sr); S.sf1 = *(const f32x4*)(ROW(p, k0, sr) + 4);                \
                            S.sf2 = *(const f32x4*)ROW(p, k0, 32 + sr); S.sf3 = *(const f32x4*)(ROW(p, k0, 32 + sr) + 4); } while (0)
#define SWRITE_KF(bf) do { *(bf16x8*)(K_lds + (bf) * SHM_K + kws) = pack8(S.sf0, S.sf1); *(bf16x8*)(K_lds + (bf) * SHM_K + kws + 32 * 256) = pack8(S.sf2, S.sf3); } while (0)
#define SWRITE_VF(bf) do { *(bf16x8*)(V_lds + (bf) * SHM_V + vst0) = pack8(S.sf0, S.sf1); *(bf16x8*)(V_lds + (bf) * SHM_V + vst1) = pack8(S.sf2, S.sf3); } while (0)
template <class TIn, class TOut>
__device__ __forceinline__ void causal_swa_prime(const BlockRef<TIn, TOut>& cur, int W, char* lds, Seam<TIn>& S, const int mk_wave) {
    constexpr bool F32 = same_t<TIn, float>::v;
    const int lane = (int)(__builtin_amdgcn_mbcnt_hi(~0u, __builtin_amdgcn_mbcnt_lo(~0u, 0u)) & 63u), wid = mk_wave & 7, tid = wid * 64 + lane, r32 = lane & 31, hi = lane >> 5;
    const int sr = tid >> 4, sc = (tid & 15) * 8, kws = KSWZ(sr, sc * 2); char* K_lds = lds + 2 * SHM_V;
    const int kb0 = swa_jlo(cur.P0, W) * KVBLK;
    for (int d0 = 0; d0 < 8; ++d0) S.qr[d0] = load8<TIn>(cur.Q + (size_t)(wid * QBLK + r32) * LDP + d0 * 16 + hi * 8);
    if constexpr (F32) { SLOAD_F((const float*)cur.K, kb0); VMW(); SWRITE_KF(0); SBAR(); SLOAD_F((const float*)cur.V, kb0); }
    else { SLOAD_H(cur.K, cur.V, kb0); VMW(); SWRITE_HK(0); }
    __syncthreads();
}
template <class TIn, class TOut>
__device__ __forceinline__ void causal_swa_block(const BlockRef<TIn, TOut>& cur, const BlockRef<TIn, TOut>& nxt, int skv, int W, char* lds, Seam<TIn>& S, const int mk_wave) {
    constexpr bool F32 = same_t<TIn, float>::v;
    const int lane = (int)(__builtin_amdgcn_mbcnt_hi(~0u, __builtin_amdgcn_mbcnt_lo(~0u, 0u)) & 63u), wid = mk_wave & 7, tid = wid * 64 + lane, r32 = lane & 31, hi = lane >> 5;
    const int j_lo = swa_jlo(cur.P0, W);
    int j_hi = (cur.P0 + QB - 1) / KVBLK + 1; if (j_hi > skv / KVBLK) j_hi = skv / KVBLK;
    const int NT = j_hi - j_lo;
    const int kbn = swa_jlo(nxt.P0, W) * KVBLK;
    const int qlo = cur.P0 + wid * QBLK, qm = qlo + r32 - 4 * hi;
    char* V_lds = lds; char* K_lds = lds + 2 * SHM_V;
    float* ws = (float*)(lds + 2 * SHM_V + 2 * SHM_K) + wid * 64; float* li_l = ws, * al_l = ws + 32;
    float m_reg = -1e30f, l_reg = 0; f32x16 o[4] = {};
    const int sr = tid >> 4, sc = (tid & 15) * 8, vst0 = v_st(sr, sc), vst1 = v_st(32 + sr, sc), kws = KSWZ(sr, sc * 2);
    const int vb0 = (int)(uintptr_t)V_lds + v_rd_base(lane);
    const TIn* Kh = cur.K; const TIn* Vh = cur.V;
#define RESC(a) do { if (__any((a) < 1.f)) { if (hi == 0) al_l[r32] = (a); asm volatile("s_waitcnt lgkmcnt(0)" ::: "memory");              \
                     for (int d_ = 0; d_ < 4; ++d_) for (int r = 0; r < 16; ++r) o[d_][r] *= al_l[crow(r, hi)]; } } while (0)
#define KBASE(t) ((j_lo + (t)) * KVBLK)
#define ACT(t) (KBASE(t) <= qlo + QBLK - 1 && KBASE(t) + KVBLK - 1 >= qlo - W + 1)
#define MASKT(P0_, P1_, t) do { const int kb_ = KBASE(t); if ((!SK || ACT(t)) && (kb_ + KVBLK - 1 > qlo || kb_ <= qlo + QBLK - 1 - W)) mask_tile(P0_, P1_, qm - kb_, (unsigned)W); } while (0)
    constexpr int NQL = F32 ? 16 : 8;
    constexpr bool SK = WSKIP && !F32;
#define SEAM_K0() do { VMWN(NQL); if constexpr (F32) { SWRITE_KF(0); SBAR(); SLOAD_F((const float*)nxt.V, kbn); } else { SWRITE_HK(0); } SBAR(); } while (0)
    f32x16 pA0, pA1, pB0, pB1; float mnA, mnB, alA, alB; bf16x8 pa0, pa1, pa2, pa3;
    if constexpr (F32) { VMW(); SWRITE_VF(0); SBAR(); } else { SWRITE_HV(0); SBAR(); }
    if (NT > 1) { if constexpr (F32) SLOAD_F((const float*)Kh, KBASE(1)); else SLOAD_H(Kh, Vh, KBASE(1)); }
    SBAR(); qkt<0, SK>(pA0, pA1, K_lds, r32, hi, S.qr, ACT(0));
    if constexpr (F32) { if (NT > 1) { VMW(); SWRITE_KF(1); SBAR(); SLOAD_F((const float*)Vh, KBASE(1)); } }
    MASKT(pA0, pA1, 0); partialSM(pA0, pA1, m_reg, mnA, alA);
    if (NT > 1) { VMW(); if constexpr (F32) { SWRITE_VF(1); SBAR(); if (NT > 2) SLOAD_F((const float*)Kh, KBASE(2)); } else SWRITE_H(1); }
    __syncthreads();
#define HALF_STEP(PX0, PX1, mnX, alX, PY0, PY1, alY, t, KB, VB, SB) do {                                                      \
        SBAR(); qkt<KB, SK>(PX0, PX1, K_lds, r32, hi, S.qr, ACT(t));                                             \
        finishSM(PY0, PY1, alY, l_reg, pa0, pa1, pa2, pa3); SBAR();                                                           \
        if ((t) + 1 < NT) { if constexpr (F32) { VMW(); SWRITE_KF(SB); SBAR(); SLOAD_F((const float*)Vh, KBASE((t) + 1)); }  \
                            else { SLOAD_H(Kh, Vh, KBASE((t) + 1)); } SBAR(); }                                               \
        pv_tile<VB, SK>(o, vb0, pa0, pa1, pa2, pa3, ACT((t) - 1)); MASKT(PX0, PX1, (t)); partialSM(PX0, PX1, m_reg, mnX, alX);                                        \
        __syncthreads();                                                                                                      \
        if ((t) + 1 < NT) { VMW(); if constexpr (F32) { SWRITE_VF(SB); SBAR(); if ((t) + 2 < NT) SLOAD_F((const float*)Kh, KBASE((t) + 2)); } \
                            else { SWRITE_H(SB); } }                                                                          \
        RESC(alX); __syncthreads(); } while (0)
    for (int t = 1; t + 1 < NT; t += 2) {
        HALF_STEP(pB0, pB1, mnB, alB, pA0, pA1, alA, t, 1, 0, 0);
        HALF_STEP(pA0, pA1, mnA, alA, pB0, pB1, alB, t + 1, 0, 1, 1);
    }
    const bool even = (NT & 1) == 0;
    if (even) { SBAR(); qkt<1, SK>(pB0, pB1, K_lds, r32, hi, S.qr, ACT(NT - 1)); SBAR(); }
#define QROW(e) (nxt.Q + (size_t)(wid * QBLK + r32) * LDP + ((e) >> 1) * 16 + hi * 8 + ((e) & 1) * 4)
    if constexpr (F32) { SLOAD_F((const float*)nxt.K, kbn); SBAR();
#pragma unroll
        for (int e = 0; e < 8; ++e) S.tq[e] = *(const f32x4*)QROW(e); }
    else { SLOAD_H(nxt.K, nxt.V, kbn); SBAR();
#pragma unroll
        for (int d0 = 0; d0 < 8; ++d0) S.qr[d0] = load8<TIn>(nxt.Q + (size_t)(wid * QBLK + r32) * LDP + d0 * 16 + hi * 8); }
    SBAR();
    finishSM(pA0, pA1, alA, l_reg, pa0, pa1, pa2, pa3); SBAR();
    if constexpr (F32) {
#pragma unroll
        for (int e = 8; e < 16; ++e) S.tq[e] = *(const f32x4*)QROW(e); SBAR(); }
#undef QROW
    pv_tile<0, SK>(o, vb0, pa0, pa1, pa2, pa3, ACT(even ? NT - 2 : NT - 1));
    if (even) { MASKT(pB0, pB1, NT - 1); partialSM(pB0, pB1, m_reg, mnB, alB); __syncthreads(); RESC(alB);
        finishSM(pB0, pB1, alB, l_reg, pa0, pa1, pa2, pa3); SBAR(); pv_tile<1, SK>(o, vb0, pa0, pa1, pa2, pa3, ACT(NT - 1)); }
    SBAR(); SEAM_K0();
    if (hi == 0) li_l[r32] = l_reg; asm volatile("s_waitcnt lgkmcnt(0)" ::: "memory");
    float rli[16];
#pragma unroll
    for (int r = 0; r < 16; ++r) rli[r] = __builtin_amdgcn_rcpf(li_l[crow(r, hi)]);
    TOut* Ow = cur.O + (size_t)(wid * QBLK) * LDO;
#pragma unroll
    for (int r = 0; r < 16; ++r) { const int orow = crow(r, hi);
#pragma unroll
        for (int d0 = 0; d0 < 4; ++d0) { const float v = o[d0][r] * rli[r];
            if constexpr (same_t<TOut, float>::v) { Ow[(size_t)orow * LDO + d0 * 32 + r32] = v; }
            else { const float vn = __shfl_xor(v, 1);
                   if ((r32 & 1) == 0) *(unsigned*)(Ow + (size_t)orow * LDO + d0 * 32 + r32) = cvtpk(v, vn); } } }
    if constexpr (F32) {
#pragma unroll
        for (int d0 = 0; d0 < 8; ++d0) S.qr[d0] = pack8(S.tq[2 * d0], S.tq[2 * d0 + 1]); }
    __syncthreads();
#undef RESC
#undef KBASE
#undef ACT
#undef MASKT
#undef SEAM_K0
#undef HALF_STEP
}
#undef ROW
#undef VMW
#undef VMWN
#undef SLOAD_H
#undef SWRITE_HK
#undef SWRITE_HV
#undef SWRITE_H
#undef SLOAD_F
#undef SWRITE_KF
#undef SWRITE_VF

constexpr int A2_V = 0;
constexpr int A2_K = 4 * SHM_V;
constexpr int A2_X = A2_K + 2 * SHM_K;
constexpr int A2_XS = 4096 + 512;
constexpr int A2_LDS = A2_X + 4 * A2_XS;
struct A2Ref { const bf16* Q; const bf16* K; const bf16* V0; const bf16* V1; bf16* O; int P0; };

__device__ __forceinline__ void attn2_block(const A2Ref& c, char* lds, const int mk_wave) {
    const int lane = (int)(__builtin_amdgcn_mbcnt_hi(~0u, __builtin_amdgcn_mbcnt_lo(~0u, 0u)) & 63u), wid = mk_wave & 7, tid = wid * 64 + lane, r32 = lane & 31, hi = lane >> 5, rg = wid & 3, vh = wid >> 2;
    char* V_lds = lds + A2_V; char* K_lds = lds + A2_K; char* X = lds + A2_X + rg * A2_XS;
    float* XA = (float*)(X + 4096); float* XM = XA + 32; float* XL = XA + 64;
    const int NT = (c.P0 + 127) / 64 + 1;
    const int qlo = c.P0 + rg * 32, qm = qlo + r32 - 4 * hi;
    const int sr = tid >> 4, sc = (tid & 15) * 8, vst0 = v_st(sr, sc), vst1 = v_st(32 + sr, sc), kws = KSWZ(sr, sc * 2);
    const int vb0 = (int)(uintptr_t)V_lds + vh * SHM_V + v_rd_base(lane);
    bf16x8 qr[8];
#pragma unroll
    for (int d0 = 0; d0 < 8; ++d0) qr[d0] = load8<bf16>(c.Q + (size_t)(rg * 32 + r32) * 128 + d0 * 16 + hi * 8);
    float m_reg = -1e30f, l_reg = 0.f; f32x16 o[4] = {};
    bf16x8 sk0, sk1, sa0, sa1, sb0, sb1;
#define A2_LOAD(kb) do { const size_t ro_ = (size_t)((kb) + sr) * 128 + sc; sk0 = load8<bf16>(c.K + ro_); sk1 = load8<bf16>(c.K + ro_ + 32 * 128); \
        sa0 = load8<bf16>(c.V0 + ro_); sa1 = load8<bf16>(c.V0 + ro_ + 32 * 128); sb0 = load8<bf16>(c.V1 + ro_); sb1 = load8<bf16>(c.V1 + ro_ + 32 * 128); } while (0)
#define A2_WRITE(buf) do { *(bf16x8*)(K_lds + (buf) * SHM_K + kws) = sk0; *(bf16x8*)(K_lds + (buf) * SHM_K + kws + 32 * 256) = sk1; \
        *(bf16x8*)(V_lds + (buf) * 2 * SHM_V + vst0) = sa0; *(bf16x8*)(V_lds + (buf) * 2 * SHM_V + vst1) = sa1; \
        *(bf16x8*)(V_lds + (buf) * 2 * SHM_V + SHM_V + vst0) = sb0; *(bf16x8*)(V_lds + (buf) * 2 * SHM_V + SHM_V + vst1) = sb1; } while (0)
#define A2_VMW() asm volatile("s_waitcnt vmcnt(0)" ::: "memory")
#define A2_STEP(t, B) do { const bool more_ = (t) + 1 < NT; if (more_) A2_LOAD(((t) + 1) * 64); \
        bf16x8 pa0, pa1, pa2, pa3; \
        if (vh == (B)) { f32x16 p0, p1; float mn, alpha; \
            qkt<(B), false>(p0, p1, K_lds, r32, hi, qr, true); \
            if (64 * (t) + 63 > qlo) mask_tile(p0, p1, qm - 64 * (t), 16384u); \
            partialSM(p0, p1, m_reg, mn, alpha); finishSM(p0, p1, alpha, l_reg, pa0, pa1, pa2, pa3); \
            *(bf16x8*)(X + lane * 16) = pa0; *(bf16x8*)(X + 1024 + lane * 16) = pa1; *(bf16x8*)(X + 2048 + lane * 16) = pa2; *(bf16x8*)(X + 3072 + lane * 16) = pa3; \
            if (hi == 0) { XA[r32] = alpha; XM[r32] = m_reg; XL[r32] = l_reg; } } \
        __syncthreads(); \
        if (vh != (B)) { pa0 = *(const bf16x8*)(X + lane * 16); pa1 = *(const bf16x8*)(X + 1024 + lane * 16); pa2 = *(const bf16x8*)(X + 2048 + lane * 16); pa3 = *(const bf16x8*)(X + 3072 + lane * 16); \
            m_reg = XM[r32]; l_reg = XL[r32]; } \
        { const float a_ = XA[r32]; if (__any(a_ < 1.f)) { \
            _Pragma("unroll") for (int d_ = 0; d_ < 4; ++d_) _Pragma("unroll") for (int r = 0; r < 16; ++r) o[d_][r] *= XA[crow(r, hi)]; } } \
        pv_tile<2 * (B), false>(o, vb0, pa0, pa1, pa2, pa3, true); \
        if (more_) { A2_VMW(); A2_WRITE((B) ^ 1); } \
        __syncthreads(); } while (0)
    A2_LOAD(0); A2_VMW(); A2_WRITE(0); __syncthreads();
    for (int t = 0; t < NT; t += 2) { A2_STEP(t, 0); A2_STEP(t + 1, 1); }
    float rli[16];
#pragma unroll
    for (int r = 0; r < 16; ++r) rli[r] = __builtin_amdgcn_rcpf(XL[crow(r, hi)]);
    bf16* Ow = c.O + (size_t)(rg * 32) * LDO + vh * 128;
#pragma unroll
    for (int r = 0; r < 16; ++r) { const int orow = crow(r, hi);
#pragma unroll
        for (int d0 = 0; d0 < 4; ++d0) { const float v = o[d0][r] * rli[r]; const float vn = __shfl_xor(v, 1);
            if ((r32 & 1) == 0) *(unsigned*)(Ow + (size_t)orow * LDO + d0 * 32 + r32) = cvtpk(v, vn); } }
    __syncthreads();
#undef A2_LOAD
#undef A2_WRITE
#undef A2_VMW
#undef A2_STEP
}

constexpr int A3_XS = 4096 + 2 * 384;
constexpr int A3_LDS = A2_X + 4 * A3_XS;
__device__ __forceinline__ void attn3_block(const A2Ref& c, char* lds, const int mk_wave) {
    int lane_ = (int)(__builtin_amdgcn_mbcnt_hi(~0u, __builtin_amdgcn_mbcnt_lo(~0u, 0u)) & 63u); asm volatile("" : "+v"(lane_));
    const int lane = lane_ & 63, wid = mk_wave & 7, tid = wid * 64 + lane, r32 = lane & 31, hi = lane >> 5, rg = wid & 3, vh = wid >> 2;
    char* V_lds = lds + A2_V; char* K_lds = lds + A2_K; char* X = lds + A2_X + rg * A3_XS;
    float* XS = (float*)(X + 4096);
    const int NT = (c.P0 + 127) / 64 + 1;
    const int qlo = c.P0 + rg * 32, qm = qlo + r32 - 4 * hi;
    const int sr = tid >> 4, sc = (tid & 15) * 8, vst0 = v_st(sr, sc), vst1 = v_st(32 + sr, sc), kws = KSWZ(sr, sc * 2);
    const int vb0 = (int)(uintptr_t)V_lds + vh * SHM_V + v_rd_base(lane);
    bf16x8 qr[8];
#pragma unroll
    for (int d0 = 0; d0 < 8; ++d0) qr[d0] = load8<bf16>(c.Q + (size_t)(rg * 32 + r32) * 128 + d0 * 16 + hi * 8);
    float m_reg = -1e30f, l_reg = 0.f; f32x16 o[4] = {};
    bf16x8 sk0, sk1, sa0, sa1, sb0, sb1, pa0, pa1, pa2, pa3;
    const unsigned so = (unsigned)(sr * 128 + sc) * 2u;
#define A3_G(base, kb, rows) (*(const bf16x8*)((const char*)((base) + (size_t)((kb) + (rows)) * 128) + so))
#define A3_LOADK(kb) do { sk0 = A3_G(c.K, kb, 0); sk1 = A3_G(c.K, kb, 32); } while (0)
#define A3_LOADV(kb) do { sa0 = A3_G(c.V0, kb, 0); sa1 = A3_G(c.V0, kb, 32); sb0 = A3_G(c.V1, kb, 0); sb1 = A3_G(c.V1, kb, 32); } while (0)
#define A3_WRITEK(buf) do { *(bf16x8*)(K_lds + (buf) * SHM_K + kws) = sk0; *(bf16x8*)(K_lds + (buf) * SHM_K + kws + 32 * 256) = sk1; } while (0)
#define A3_WRITEV(buf) do { *(bf16x8*)(V_lds + (buf) * 2 * SHM_V + vst0) = sa0; *(bf16x8*)(V_lds + (buf) * 2 * SHM_V + vst1) = sa1; \
        *(bf16x8*)(V_lds + (buf) * 2 * SHM_V + SHM_V + vst0) = sb0; *(bf16x8*)(V_lds + (buf) * 2 * SHM_V + SHM_V + vst1) = sb1; } while (0)
#define A3_VMW() asm volatile("s_waitcnt vmcnt(0)" ::: "memory")
#define A3_SOFTMAX_PUBLISH(T, PS) do { float mn_, alpha_; \
        if (64 * (T) + 63 > qlo) mask_tile(p0, p1, qm - 64 * (T), 16384u); \
        partialSM(p0, p1, m_reg, mn_, alpha_); finishSM(p0, p1, alpha_, l_reg, pa0, pa1, pa2, pa3); \
        *(bf16x8*)(X + lane * 16) = pa0; *(bf16x8*)(X + 1024 + lane * 16) = pa1; *(bf16x8*)(X + 2048 + lane * 16) = pa2; *(bf16x8*)(X + 3072 + lane * 16) = pa3; \
        if (hi == 0) { XS[(PS) * 96 + r32] = alpha_; XS[(PS) * 96 + 32 + r32] = m_reg; XS[(PS) * 96 + 64 + r32] = l_reg; } } while (0)
    A3_LOADK(0); A3_LOADV(0); A3_VMW(); A3_WRITEK(0); A3_WRITEV(0); A3_LOADK(64); A3_VMW(); A3_WRITEK(1);
    __syncthreads();
    if (vh == 0) { f32x16 p0, p1; qkt<0, false>(p0, p1, K_lds, r32, hi, qr, true); A3_SOFTMAX_PUBLISH(0, 0); }
    __syncthreads();
#define A3_STEP(t, B) do { const bool more1_ = (t) + 1 < NT, more2_ = (t) + 2 < NT; \
        f32x16 p0, p1; \
        if (vh != (B) && more1_) { qkt<(B) ^ 1, false>(p0, p1, K_lds, r32, hi, qr, true); } \
        SBAR(); \
        if (more2_) A3_LOADK(((t) + 2) * 64); if (more1_) A3_LOADV(((t) + 1) * 64); \
        if (vh != (B)) { pa0 = *(const bf16x8*)(X + lane * 16); pa1 = *(const bf16x8*)(X + 1024 + lane * 16); pa2 = *(const bf16x8*)(X + 2048 + lane * 16); pa3 = *(const bf16x8*)(X + 3072 + lane * 16); \
            m_reg = XS[(B) * 96 + 32 + r32]; l_reg = XS[(B) * 96 + 64 + r32]; } \
        { const float a_ = XS[(B) * 96 + r32]; if (__any(a_ < 1.f)) { \
            _Pragma("unroll") for (int d_ = 0; d_ < 4; ++d_) _Pragma("unroll") for (int r = 0; r < 16; ++r) o[d_][r] *= XS[(B) * 96 + crow(r, hi)]; } } \
        pv_tile<2 * (B), false>(o, vb0, pa0, pa1, pa2, pa3, true); \
        SBAR(); \
        if (vh != (B) && more1_) A3_SOFTMAX_PUBLISH((t) + 1, (B) ^ 1); \
        if (more1_) { A3_VMW(); if (more2_) A3_WRITEK(B); A3_WRITEV((B) ^ 1); } \
        __syncthreads(); } while (0)
    for (int t = 0; t < NT; t += 2) { A3_STEP(t, 0); A3_STEP(t + 1, 1); }
    float rli[16];
#pragma unroll
    for (int r = 0; r < 16; ++r) rli[r] = __builtin_amdgcn_rcpf(XS[96 + 64 + crow(r, hi)]);
    bf16* Ow = c.O + (size_t)(rg * 32) * LDO + vh * 128;
#pragma unroll
    for (int r = 0; r < 16; ++r) { const int orow = crow(r, hi);
#pragma unroll
        for (int d0 = 0; d0 < 4; ++d0) { const float v = o[d0][r] * rli[r]; const float vn = __shfl_xor(v, 1);
            if ((r32 & 1) == 0) *(unsigned*)(Ow + (size_t)orow * LDO + d0 * 32 + r32) = cvtpk(v, vn); } }
    __syncthreads();
#undef A3_G
#undef A3_LOADK
#undef A3_LOADV
#undef A3_WRITEK
#undef A3_WRITEV
#undef A3_VMW
#undef A3_SOFTMAX_PUBLISH
#undef A3_STEP
}

constexpr int A4_XS = 4096 + 512;
constexpr int A4_AL = A2_X + 4 * A4_XS;
constexpr int A4_LDS = A4_AL + 8 * 128;
__device__ __forceinline__ void attn4_block(const A2Ref& c, char* lds, const int mk_wave) {
    int lane_ = (int)(__builtin_amdgcn_mbcnt_hi(~0u, __builtin_amdgcn_mbcnt_lo(~0u, 0u)) & 63u); asm volatile("" : "+v"(lane_));
    const int lane = lane_ & 63, wid = mk_wave & 7, tid = wid * 64 + lane, r32 = lane & 31, hi = lane >> 5, rg = wid & 3, vh = wid >> 2;
    char* V_lds = lds + A2_V; char* K_lds = lds + A2_K; char* X = lds + A2_X + rg * A4_XS;
    float* XM = (float*)(X + 4096); float* XL = XM + 64; float* AL = (float*)(lds + A4_AL + wid * 128);
    const int NT = (c.P0 + 127) / 64 + 1;
    const int qlo = c.P0 + rg * 32, qm = qlo + r32 - 4 * hi;
    const int sr = tid >> 4, sc = (tid & 15) * 8, vst0 = v_st(sr, sc), vst1 = v_st(32 + sr, sc), kws = KSWZ(sr, sc * 2);
    const unsigned so = (unsigned)(sr * 128 + sc) * 2u;
    const int vb0 = (int)(uintptr_t)V_lds + vh * SHM_V + v_rd_base(lane);
    bf16x8 qr[8];
#pragma unroll
    for (int d0 = 0; d0 < 8; ++d0) qr[d0] = load8<bf16>(c.Q + (size_t)(rg * 32 + r32) * 128 + d0 * 16 + hi * 8);
    float m_reg = -1e30f, l_reg = 0.f; f32x16 o[4] = {};
    bf16x8 sk0, sk1, sa0, sa1, sb0, sb1;
    constexpr float C2 = 1.4426950408889634f * SCALE;
#define A4_G(base, kb, rows) (*(const bf16x8*)((const char*)((base) + (size_t)((kb) + (rows)) * 128) + so))
#define A4_LOAD(kb) do { sk0 = A4_G(c.K, kb, 0); sk1 = A4_G(c.K, kb, 32); sa0 = A4_G(c.V0, kb, 0); sa1 = A4_G(c.V0, kb, 32); sb0 = A4_G(c.V1, kb, 0); sb1 = A4_G(c.V1, kb, 32); } while (0)
#define A4_WRITE(buf) do { *(bf16x8*)(K_lds + (buf) * SHM_K + kws) = sk0; *(bf16x8*)(K_lds + (buf) * SHM_K + kws + 32 * 256) = sk1; \
        *(bf16x8*)(V_lds + (buf) * 2 * SHM_V + vst0) = sa0; *(bf16x8*)(V_lds + (buf) * 2 * SHM_V + vst1) = sa1; \
        *(bf16x8*)(V_lds + (buf) * 2 * SHM_V + SHM_V + vst0) = sb0; *(bf16x8*)(V_lds + (buf) * 2 * SHM_V + SHM_V + vst1) = sb1; } while (0)
#define A4_VMW() asm volatile("s_waitcnt vmcnt(0)" ::: "memory")
#define A4_PK(P, B_, OUT) do { unsigned a0_ = cvtpk(P[B_+0], P[B_+1]), a1_ = cvtpk(P[B_+2], P[B_+3]), b0_ = cvtpk(P[B_+4], P[B_+5]), b1_ = cvtpk(P[B_+6], P[B_+7]); \
        auto r0_ = __builtin_amdgcn_permlane32_swap(a0_, b0_, false, false); auto r1_ = __builtin_amdgcn_permlane32_swap(a1_, b1_, false, false); \
        u32x4 w_ = {r0_[0], r1_[0], r0_[1], r1_[1]}; OUT = *reinterpret_cast<bf16x8*>(&w_); } while (0)
    A4_LOAD(0); A4_VMW(); A4_WRITE(0); A4_LOAD(64);
    __syncthreads();
#define A4_STEP(t, B) do { \
        f32x16 p = f32x16{}; \
        { const char* kb_[4]; \
          _Pragma("unroll") for (int dd = 0; dd < 4; ++dd) kb_[dd] = K_lds + (B) * SHM_K + vh * (32 * 256) + KSWZ(r32, (dd * 16 + hi * 8) * 2); \
          _Pragma("unroll") for (int d0 = 0; d0 < 8; ++d0) { const bf16x8 b_ = *reinterpret_cast<const bf16x8*>(kb_[d0 & 3] + (d0 >> 2) * 128); p = __builtin_amdgcn_mfma_f32_32x32x16_bf16(b_, qr[d0], p, 0, 0, 0); } } \
        if (64 * (t) + 32 * vh + 31 > qlo) { const int dq_ = qm - 64 * (t) - 32 * vh; \
            _Pragma("unroll") for (int r = 0; r < 16; ++r) { const int cc_ = (r & 3) + 8 * (r >> 2); if ((unsigned)(dq_ - cc_) >= 16384u) p[r] = -__builtin_inff(); } } \
        float pmax_ = p[0]; \
        _Pragma("unroll") for (int r = 1; r < 16; ++r) pmax_ = fmaxf(pmax_, p[r]); \
        { auto rr_ = __builtin_amdgcn_permlane32_swap(__float_as_uint(pmax_), __float_as_uint(pmax_), false, false); pmax_ = fmaxf(__uint_as_float(rr_[0]), __uint_as_float(rr_[1])); } \
        if (hi == 0) XM[vh * 32 + r32] = pmax_; \
        __syncthreads(); \
        if ((t) + 1 < NT) { A4_VMW(); A4_WRITE((B) ^ 1); if ((t) + 2 < NT) A4_LOAD(((t) + 2) * 64); } \
        pmax_ = fmaxf(pmax_, XM[(vh ^ 1) * 32 + r32]); \
        float mn_, alpha_; \
        if (__builtin_expect(__all((pmax_ - m_reg) * SCALE <= THR), 1)) { mn_ = m_reg; alpha_ = 1.f; } \
        else { mn_ = fmaxf(m_reg, pmax_); alpha_ = __builtin_amdgcn_exp2f((m_reg - mn_) * C2); m_reg = mn_; } \
        { const float mnL_ = -mn_ * C2; float ps_ = 0.f; \
          _Pragma("unroll") for (int r = 0; r < 16; ++r) { p[r] = __builtin_amdgcn_exp2f(fmaf(p[r], C2, mnL_)); ps_ += p[r]; } \
          auto rr_ = __builtin_amdgcn_permlane32_swap(__float_as_uint(ps_), __float_as_uint(ps_), false, false); ps_ = __uint_as_float(rr_[0]) + __uint_as_float(rr_[1]); \
          l_reg = l_reg * alpha_ + ps_; } \
        bf16x8 pa0, pa1, pa2, pa3, pm0_, pm1_; \
        A4_PK(p, 0, pm0_); A4_PK(p, 8, pm1_); \
        *(bf16x8*)(X + vh * 2048 + lane * 16) = pm0_; *(bf16x8*)(X + vh * 2048 + 1024 + lane * 16) = pm1_; \
        if (hi == 0) AL[r32] = alpha_; \
        __syncthreads(); \
        { const bf16x8 po0_ = *(const bf16x8*)(X + (vh ^ 1) * 2048 + lane * 16), po1_ = *(const bf16x8*)(X + (vh ^ 1) * 2048 + 1024 + lane * 16); \
          if (vh == 0) { pa0 = pm0_; pa1 = pm1_; pa2 = po0_; pa3 = po1_; } else { pa0 = po0_; pa1 = po1_; pa2 = pm0_; pa3 = pm1_; } } \
        if (__any(alpha_ < 1.f)) { \
            _Pragma("unroll") for (int d_ = 0; d_ < 4; ++d_) _Pragma("unroll") for (int r = 0; r < 16; ++r) o[d_][r] *= AL[crow(r, hi)]; } \
        pv_tile<2 * (B), false>(o, vb0, pa0, pa1, pa2, pa3, true); \
    } while (0)
    for (int t = 0; t < NT; t += 2) { A4_STEP(t, 0); A4_STEP(t + 1, 1); }
    if (hi == 0) XL[vh * 32 + r32] = l_reg;
    __syncthreads();
    float rli[16];
#pragma unroll
    for (int r = 0; r < 16; ++r) rli[r] = __builtin_amdgcn_rcpf(XL[crow(r, hi)] + XL[32 + crow(r, hi)]);
    bf16* Ow = c.O + (size_t)(rg * 32) * LDO + vh * 128;
#pragma unroll
    for (int r = 0; r < 16; ++r) { const int orow = crow(r, hi);
#pragma unroll
        for (int d0 = 0; d0 < 4; ++d0) { const float v = o[d0][r] * rli[r]; const float vn = __shfl_xor(v, 1);
            if ((r32 & 1) == 0) *(unsigned*)(Ow + (size_t)orow * LDO + d0 * 32 + r32) = cvtpk(v, vn); } }
    __syncthreads();
#undef A4_G
#undef A4_LOAD
#undef A4_WRITE
#undef A4_VMW
#undef A4_PK
#undef A4_STEP
}

}

constexpr int S_ = 16384, DM = 2048, FF = 5632, NIN = 6152, NINP = 6144, PLD = 3072;
constexpr int NWAVES = 8, NTHR = 512;
constexpr int C_MQ = 0, C_MK = 512, C_MV = 1024, C_MO = 2048;
constexpr size_t MiB = 1u << 20, KiB = 1u << 10;
constexpr size_t WS_ROWSS1 = 0, WS_ROWSS2 = 64 * KiB, WS_SC = 192 * KiB  , WS_DN = 256 * KiB, WS_GATES = 512 * KiB;
constexpr size_t WS_BAR = 128 * KiB;
constexpr size_t WS_WGU = 1 * MiB, WS_WD = 45 * MiB, WS_WIN = 67 * MiB, WS_WOUT = 92 * MiB;
constexpr size_t WS_XN = 100 * MiB;
constexpr size_t WS_BIG = 164 * MiB;
constexpr size_t WS_Y = 356 * MiB;
constexpr size_t WS_CT = 420 * MiB;
constexpr size_t WS_QC = 452 * MiB, WS_KC = 468 * MiB;
constexpr size_t WS_NST = 484 * MiB;
constexpr size_t WS_GW = 484 * MiB + 512 * KiB;
constexpr size_t WS_END = 485 * MiB;
constexpr int LDS_BYTES = 147456;

#define LAS __attribute__((address_space(3)))
typedef unsigned short bfu;
typedef unsigned v4u __attribute__((ext_vector_type(4)));
typedef unsigned v2u __attribute__((ext_vector_type(2)));
typedef float f32x4 __attribute__((ext_vector_type(4)));
typedef short bf16x8 __attribute__((ext_vector_type(8)));
#define MFMA16(a, b, c) __builtin_amdgcn_mfma_f32_16x16x32_bf16(a, b, c, 0, 0, 0)
#define LDS_WAIT() asm volatile("s_waitcnt lgkmcnt(0)" ::: "memory")
__device__ __forceinline__ unsigned f2bf(float f) { unsigned u = __builtin_bit_cast(unsigned, f); return (u + 0x7fffu + ((u >> 16) & 1u)) >> 16; }
__device__ __forceinline__ unsigned pk2(float lo, float hi) { return f2bf(lo) | (f2bf(hi) << 16); }
__device__ __forceinline__ float bf2f(unsigned b) { return __builtin_bit_cast(float, b << 16); }
__device__ __forceinline__ int mk_lane() { return (int)(__builtin_amdgcn_mbcnt_hi(~0u, __builtin_amdgcn_mbcnt_lo(~0u, 0u)) & 63u); }
__device__ __forceinline__ float wave_sum(float v) {
#pragma unroll
    for (int o = 1; o < 64; o <<= 1) v += __shfl_xor(v, o);
    return v;
}
__device__ __forceinline__ float silu(float x) { return x / (1.0f + __expf(-x)); }

__device__ __forceinline__ void cvt_item(const float* __restrict__ W, int ldw, int ncols, const float* __restrict__ gain, bfu* WT, int K, int dst_row0, int k0, int n0, LAS float* scr, int lane) {
    const int nq = (lane & 15) * 4, kr = lane >> 4, n = n0 + nq;
#pragma unroll 8
    for (int i = 0; i < 16; ++i) { const int kk = 4 * i + kr; f32x4 v = (f32x4){0.f, 0.f, 0.f, 0.f};
        if (n < ncols) v = *(const f32x4*)(W + (size_t)(k0 + kk) * ldw + n);
        if (gain) v = v * gain[k0 + kk];
        LAS float* d = scr + kk * 65 + nq; d[0] = v[0]; d[1] = v[1]; d[2] = v[2]; d[3] = v[3]; }
    LDS_WAIT(); asm volatile("" ::: "memory");
    const int c = lane & 7;
#pragma unroll
    for (int j = 0; j < 8; ++j) { const int nn = (lane >> 3) + 8 * j; const LAS float* s = scr + (8 * c) * 65 + nn;
        v4u o; o.x = pk2(s[0 * 65], s[1 * 65]); o.y = pk2(s[2 * 65], s[3 * 65]); o.z = pk2(s[4 * 65], s[5 * 65]); o.w = pk2(s[6 * 65], s[7 * 65]);
        *(v4u*)(WT + (size_t)(dst_row0 + nn) * K + k0 + 8 * c) = o; }
    LDS_WAIT(); asm volatile("" ::: "memory");
}
__device__ __forceinline__ void cvt_ffn_item(int it, const float* wg, const float* wu, const float* wd, const float* gain, bfu* Wgu, bfu* Wd, LAS float* scr, int lane) {
    if (it < 2 * 2816) { const int up = it >= 2816; const int r = up ? it - 2816 : it; const int kb = r / 88, nb = r % 88, n0 = nb * 64;
        cvt_item(up ? wu : wg, FF, FF, gain, Wgu, DM, 256 * (n0 >> 7) + (n0 & 127) + (up ? 128 : 0), kb * 64, n0, scr, lane); }
    else { const int r = it - 2 * 2816; const int kb = r / 32, nb = r % 32; cvt_item(wd, DM, DM, nullptr, Wd, FF, nb * 64, kb * 64, nb * 64, scr, lane); }
}

constexpr int GWP = 4112;
__device__ __forceinline__ void gates_rows(LAS unsigned char* lds, const bfu* __restrict__ XB, const float* __restrict__ rowss, const float* __restrict__ b_i, const float* __restrict__ b_f, float* GATES, int rb, int wave, int lane) {
    const int fr = lane & 15, fq = lane >> 4, rg = wave & 3, kh = wave >> 2;
    const LAS unsigned char* wl = lds + 16384;
    const bfu* xp = XB + (size_t)(rb * 64 + rg * 16 + fr) * DM + kh * 1024 + 8 * fq;
    f32x4 acc = (f32x4){0.f, 0.f, 0.f, 0.f};
    for (int k0 = 0; k0 < 32; k0 += 16) {
        bf16x8 xa[16];
#pragma unroll
        for (int ks = 0; ks < 16; ++ks) xa[ks] = *(const bf16x8*)(xp + (k0 + ks) * 32);
#pragma unroll
        for (int ks = 0; ks < 16; ++ks) { const bf16x8 wb = *(const LAS bf16x8*)(wl + fr * GWP + (kh * 1024 + (k0 + ks) * 32 + 8 * fq) * 2); acc = MFMA16(xa[ks], wb, acc); }
    }
    LAS f32x4* red = (LAS f32x4*)lds;
    if (kh == 1) red[rg * 64 + lane] = acc;
    __syncthreads();
    if (kh == 0 && fr < 8) {
        const f32x4 o = red[rg * 64 + lane]; const float bias = fr < 4 ? b_i[fr] : b_f[fr - 4];
#pragma unroll
        for (int j = 0; j < 4; ++j) { const int row = rb * 64 + rg * 16 + 4 * fq + j;
            const float pre = (acc[j] + o[j]) / sqrtf(rowss[row] * (1.0f / DM) + 1e-6f) + bias; const float capped = 15.0f * tanhf(pre * (1.0f / 15.0f));
            GATES[(size_t)row * 8 + fr] = fr < 4 ? capped : -log1pf(expf(-capped)); }
    }
    __syncthreads();
}

#define XB_TMO      128
#define XB_XCNT(j)  (256  + 64 * (j))
#define XB_XSUB(j)  (1280 + 64 * (j))
#define XB_XGEN(j)  (2304 + 64 * (j))
#define XB_TOP      3328
#define XB_TOPGEN   3392
#define XCD_BAR_WORDS 3456
#define XB_SPIN_CAP (1u << 18)
__device__ __forceinline__ unsigned xb_ld(unsigned* p)              { return __hip_atomic_load(p, __ATOMIC_RELAXED, __HIP_MEMORY_SCOPE_AGENT); }
__device__ __forceinline__ unsigned xb_add(unsigned* p, unsigned v) { return __hip_atomic_fetch_add(p, v, __ATOMIC_RELAXED, __HIP_MEMORY_SCOPE_AGENT); }
__device__ __forceinline__ unsigned xb_xcc_id() { return (unsigned)__builtin_amdgcn_s_getreg((3 << 11) | 20) & 0xFu; }
#define XB_SPIN(cond, bar) do { unsigned _sp = 0; while (cond) { __builtin_amdgcn_s_sleep(1); \
    if ((++_sp & 255u) == 0u) { if (xb_ld(&(bar)[XB_TMO])) break; if (_sp > XB_SPIN_CAP) { atomicAdd(&(bar)[XB_TMO], 1u); break; } } } } while (0)
__device__ __forceinline__ void xcd_barrier_complete(unsigned* bar, unsigned x, unsigned& nloc, unsigned& nx) {
    const unsigned G = gridDim.x * gridDim.y * gridDim.z;
    unsigned sum, cnt, mine, sp = 0u;
    for (;;) {
        sum = 0u; cnt = 0u; mine = 0u;
#pragma unroll
        for (unsigned j = 0; j < 16; ++j) { const unsigned c = xb_ld(&bar[XB_XCNT(j)]); sum += c; cnt += (c > 0u) ? 1u : 0u; mine = (j == x) ? c : mine; }
        if (sum == G) break;
        __builtin_amdgcn_s_sleep(1);
        if ((++sp & 255u) == 0u) { if (xb_ld(&bar[XB_TMO])) break; if (sp > XB_SPIN_CAP) { atomicAdd(&bar[XB_TMO], 1u); break; } }
    }
    nloc = mine > 0u ? mine : 1u; nx = cnt > 0u ? cnt : 1u;
}
__device__ __forceinline__ void xcd_barrier(unsigned* bar, volatile LAS unsigned* st, const bool first) {
    asm volatile("s_waitcnt vmcnt(0)" ::: "memory");
    __syncthreads();
    if (first) {
        const unsigned x = xb_xcc_id();
        __builtin_amdgcn_s_waitcnt(0);
        unsigned nloc = st[0], nx = st[1];
        if (nloc == 0u) { xcd_barrier_complete(bar, x, nloc, nx); st[0] = nloc; st[1] = nx; }
        const unsigned old = xb_add(&bar[XB_XSUB(x)], 1u);
        const unsigned gen = old / nloc;
        if (old + 1u == (gen + 1u) * nloc) {
            __builtin_amdgcn_fence(__ATOMIC_RELEASE, "agent");
            asm volatile("s_waitcnt vmcnt(0)" ::: "memory");
            const unsigned og = xb_add(&bar[XB_TOP], 1u);
            const unsigned tg = og / nx;
            if (og + 1u == (tg + 1u) * nx) xb_add(&bar[XB_TOPGEN], 1u);
            else XB_SPIN(xb_ld(&bar[XB_TOPGEN]) == tg, bar);
            __builtin_amdgcn_fence(__ATOMIC_ACQUIRE, "agent");
            xb_add(&bar[XB_XGEN(x)], 1u);
            asm volatile("s_waitcnt vmcnt(0)" ::: "memory");
        } else {
            XB_SPIN(xb_ld(&bar[XB_XGEN(x)]) == gen, bar);
            __builtin_amdgcn_fence(__ATOMIC_ACQUIRE, "agent");
            asm volatile("s_waitcnt vmcnt(0)" ::: "memory");
        }
    }
    __syncthreads();
}

struct Args { const float* in[23]; float* out; unsigned char* ws; int ph_lo, ph_hi; };
constexpr int NPH = 12;

constexpr int MP = 272;

__device__ __forceinline__ void mlstm_stage_a(LAS unsigned char* lds, const bfu* __restrict__ PROJ, const float* __restrict__ GATES, const float* __restrict__ conv_w, const float* __restrict__ conv_b,
                                              bfu* QC, bfu* KC, float* DELTA, float* DN, float* SC, int item, const int mk_wave) {
    int lane = mk_lane(); asm volatile("" : "+v"(lane));
    const int wid = mk_wave & 7, tid = wid * 64 + lane, fr = lane & 15, fq = lane >> 4;
    const int h = item & 3, row0 = (item >> 2) * 128;
    LAS float* fa = (LAS float*)lds; LAS unsigned char* KT = lds + 4096; LAS unsigned char* VT = KT + 128 * MP;
    if (tid < 128) { fa[tid] = GATES[(size_t)(row0 + tid) * 8 + 4 + h]; fa[128 + tid] = GATES[(size_t)(row0 + tid) * 8 + h]; }
    __syncthreads();
    if (tid < 128) { float b = 0.f; for (int s = 0; s <= tid; ++s) b += fa[s]; fa[256 + tid] = fa[128 + tid] - b; if (tid == 127) fa[385] = b; }
    __syncthreads();
    if (wid == 0) { float a = fmaxf(fa[256 + lane], fa[320 + lane]);
#pragma unroll
        for (int o = 1; o < 64; o <<= 1) a = fmaxf(a, __shfl_xor(a, o));
        if (lane == 0) fa[384] = a; }
    __syncthreads();
    const float amax = fa[384], blast = fa[385];
    if (tid < 128) fa[tid] = __expf(fa[256 + tid] - amax);
    if (tid == 0) { SC[item] = blast + amax; SC[512 + item] = blast; }
    __syncthreads();
    for (int task = tid; task < 4096; task += NTHR) {
        const int isk = task >> 11, t2 = task & 2047, d = t2 & 127, s0 = (t2 >> 7) * 8, ch = isk * 512 + h * 128 + d;
        const float w0 = conv_w[ch], w1 = conv_w[1024 + ch], w2 = conv_w[2048 + ch], w3 = conv_w[3072 + ch], bias = conv_b[ch];
        float x[11];
#pragma unroll
        for (int i = 0; i < 11; ++i) { const int r = row0 + s0 - 3 + i; x[i] = r >= 0 ? bf2f(PROJ[(size_t)r * PLD + C_MQ + ch]) : 0.f; }
        float y[8];
#pragma unroll
        for (int i = 0; i < 8; ++i) y[i] = silu(bias + w0 * x[i] + w1 * x[i + 1] + w2 * x[i + 2] + w3 * x[i + 3]);
        if (!isk) {
#pragma unroll
            for (int i = 0; i < 8; ++i) QC[(size_t)(row0 + s0 + i) * 512 + h * 128 + d] = (bfu)f2bf(y[i] * 0.08838834764831845f);
        } else {
#pragma unroll
            for (int i = 0; i < 8; ++i) { KC[(size_t)(row0 + s0 + i) * 512 + h * 128 + d] = (bfu)f2bf(y[i]); y[i] *= fa[s0 + i]; }
            v4u o; o.x = pk2(y[0], y[1]); o.y = pk2(y[2], y[3]); o.z = pk2(y[4], y[5]); o.w = pk2(y[6], y[7]);
            *(LAS v4u*)(KT + d * MP + s0 * 2) = o;
        }
    }
    for (int task = tid; task < 4096; task += NTHR) {
        const int sidx = task & 127, e0 = (task >> 7) * 8;
        const v4u v = *(const v4u*)(PROJ + (size_t)(row0 + sidx) * PLD + C_MV + h * 256 + e0);
        LAS unsigned short* d = (LAS unsigned short*)(VT + e0 * MP + sidx * 2);
        d[0 * (MP / 2)] = (unsigned short)(v.x & 0xffffu); d[1 * (MP / 2)] = (unsigned short)(v.x >> 16); d[2 * (MP / 2)] = (unsigned short)(v.y & 0xffffu); d[3 * (MP / 2)] = (unsigned short)(v.y >> 16);
        d[4 * (MP / 2)] = (unsigned short)(v.z & 0xffffu); d[5 * (MP / 2)] = (unsigned short)(v.z >> 16); d[6 * (MP / 2)] = (unsigned short)(v.w & 0xffffu); d[7 * (MP / 2)] = (unsigned short)(v.w >> 16);
    }
    __syncthreads();
    f32x4 acc[2][8];
#pragma unroll
    for (int mt = 0; mt < 2; ++mt)
#pragma unroll
        for (int nt = 0; nt < 8; ++nt) acc[mt][nt] = (f32x4){0.f, 0.f, 0.f, 0.f};
#pragma unroll
    for (int ks = 0; ks < 4; ++ks) {
        bf16x8 a[2];
#pragma unroll
        for (int mt = 0; mt < 2; ++mt) a[mt] = *(const LAS bf16x8*)(VT + (32 * wid + 16 * mt + fr) * MP + (32 * ks + 8 * fq) * 2);
#pragma unroll
        for (int nt = 0; nt < 8; ++nt) { const bf16x8 b = *(const LAS bf16x8*)(KT + (16 * nt + fr) * MP + (32 * ks + 8 * fq) * 2);
            acc[0][nt] = MFMA16(a[0], b, acc[0][nt]); acc[1][nt] = MFMA16(a[1], b, acc[1][nt]); }
    }
    float* dst = DELTA + (size_t)item * 32768;
#pragma unroll
    for (int mt = 0; mt < 2; ++mt)
#pragma unroll
        for (int nt = 0; nt < 8; ++nt)
#pragma unroll
            for (int j = 0; j < 4; ++j) dst[(32 * wid + 16 * mt + 4 * fq + j) * 128 + 16 * nt + fr] = acc[mt][nt][j];
    if (tid < 128) { float s = 0.f; for (int i = 0; i < 128; ++i) s += bf2f(*(const LAS unsigned short*)(KT + tid * MP + i * 2)); DN[(size_t)item * 128 + tid] = s; }
    __syncthreads();
}

__device__ __forceinline__ void mlstm_scan(LAS unsigned char* lds, const float* __restrict__ DELTA, const float* __restrict__ DN, const float* __restrict__ SC, float* MPREV, bfu* __restrict__ CT, float* __restrict__ NST,
                                           int tid, int gtid, int nthreads) {
    LAS float* fdec = (LAS float*)lds; LAS float* fin = fdec + 512; LAS float* mpv = fdec + 1024;
    if (tid < 4) { float m = 0.f;
        for (int c = 0; c < 128; ++c) { const int item = c * 4 + tid; const float mloc = SC[item], bl = SC[512 + item], mn = fmaxf(bl + m, mloc);
            mpv[tid * 128 + c] = m; fdec[tid * 128 + c] = __expf(bl + m - mn); fin[tid * 128 + c] = __expf(mloc - mn); m = mn; } }
    __syncthreads();
    for (int idx = gtid; idx < 4 * 32768 + 512; idx += nthreads) {
        const bool main_ = idx < 4 * 32768;
        const int h = main_ ? (idx >> 15) : ((idx - 4 * 32768) >> 7), rem = main_ ? (idx & 32767) : ((idx - 4 * 32768) & 127);
        const float* src = main_ ? DELTA + (size_t)h * 32768 + rem : DN + h * 128 + rem; const size_t sstride = main_ ? 4 * 32768 : 512;
        float C = 0.f; float d8[8], e8[8];
#pragma unroll
        for (int i = 0; i < 8; ++i) d8[i] = src[(size_t)i * sstride];
        for (int c0 = 0; c0 < 128; c0 += 8) {
            if (c0 + 8 < 128) {
#pragma unroll
                for (int i = 0; i < 8; ++i) e8[i] = src[(size_t)(c0 + 8 + i) * sstride];
            }
#pragma unroll
            for (int i = 0; i < 8; ++i) { const int c = c0 + i, item = c * 4 + h;
                if (main_) { CT[(size_t)item * 32768 + rem] = (bfu)f2bf(C); if (rem == 0) MPREV[item] = mpv[h * 128 + c]; } else NST[(size_t)item * 128 + rem] = C;
                C = fdec[h * 128 + c] * C + fin[h * 128 + c] * d8[i]; }
#pragma unroll
            for (int i = 0; i < 8; ++i) d8[i] = e8[i];
        }
    }
    __syncthreads();
}

__device__ __forceinline__ void mlstm_stage_c(LAS unsigned char* lds, const bfu* __restrict__ PROJ, const float* __restrict__ GATES, const bfu* __restrict__ QC, const bfu* __restrict__ KC,
                                              const bfu* __restrict__ CT, const float* __restrict__ NST, const float* __restrict__ MPREV, const float* __restrict__ hgain, bfu* Y, int item, const int mk_wave) {
    int lane = mk_lane(); asm volatile("" : "+v"(lane));
    const int wid = mk_wave & 7, tid = wid * 64 + lane, fr = lane & 15, fq = lane >> 4;
    const int h = item & 3, row0 = (item >> 2) * 128;
    LAS float* fa = (LAS float*)lds;
    LAS unsigned char* Qs = lds + 4096; LAS unsigned char* Ks = Qs + 128 * MP; LAS unsigned char* BUF = Ks + 128 * MP;
    if (tid < 128) { fa[768 + tid] = GATES[(size_t)(row0 + tid) * 8 + 4 + h]; fa[896 + tid] = GATES[(size_t)(row0 + tid) * 8 + h]; fa[640 + tid] = NST[(size_t)item * 128 + tid]; }
    __syncthreads();
    float bt_ = 0.f;
    if (tid < 128) { for (int s = 0; s <= tid; ++s) bt_ += fa[768 + s]; fa[tid] = fa[896 + tid] - bt_; }
    __syncthreads();
    if (tid < 128) { const float mp = MPREV[item]; float pm = -3.0e38f; for (int s = 0; s <= tid; ++s) pm = fmaxf(pm, fa[s]);
        const float M = fmaxf(mp, pm); fa[128 + tid] = M; fa[256 + tid] = __expf(mp - M); fa[384 + tid] = __expf(-(bt_ + M)); }
    for (int t = tid; t < 2048; t += NTHR) { const int r = t >> 4, c = t & 15;
        *(LAS v4u*)(Qs + r * MP + c * 16) = *(const v4u*)(QC + (size_t)(row0 + r) * 512 + h * 128 + c * 8);
        *(LAS v4u*)(Ks + r * MP + c * 16) = *(const v4u*)(KC + (size_t)(row0 + r) * 512 + h * 128 + c * 8); }
    for (int t = tid; t < 4096; t += NTHR) { const int r = t >> 4, c = t & 15; *(LAS v4u*)(BUF + r * MP + c * 16) = *(const v4u*)(CT + (size_t)item * 32768 + r * 128 + c * 8); }
    __syncthreads();
    {
        const int t = 16 * wid + fr; float s = 0.f;
#pragma unroll
        for (int i = 0; i < 32; ++i) s += bf2f(*(const LAS unsigned short*)(Qs + t * MP + (32 * fq + i) * 2)) * fa[640 + 32 * fq + i];
        s += __shfl_xor(s, 16); s += __shfl_xor(s, 32); if (fq == 0) fa[512 + t] = s;
    }
    f32x4 sa[8];
#pragma unroll
    for (int nt = 0; nt < 8; ++nt) sa[nt] = (f32x4){0.f, 0.f, 0.f, 0.f};
    bf16x8 qa[4];
#pragma unroll
    for (int ks = 0; ks < 4; ++ks) qa[ks] = *(const LAS bf16x8*)(Qs + (16 * wid + fr) * MP + (32 * ks + 8 * fq) * 2);
#pragma unroll
    for (int nt = 0; nt < 8; ++nt) if (nt <= wid) {
#pragma unroll
        for (int ks = 0; ks < 4; ++ks) { const bf16x8 b = *(const LAS bf16x8*)(Ks + (16 * nt + fr) * MP + (32 * ks + 8 * fq) * 2); sa[nt] = MFMA16(qa[ks], b, sa[nt]); } }
    float Mt[4], rsum[4];
#pragma unroll
    for (int j = 0; j < 4; ++j) { Mt[j] = fa[128 + 16 * wid + 4 * fq + j]; rsum[j] = 0.f; }
#pragma unroll
    for (int nt = 0; nt < 8; ++nt) { const int s = 16 * nt + fr; const float as = fa[s];
#pragma unroll
        for (int j = 0; j < 4; ++j) { const int t = 16 * wid + 4 * fq + j; const float p = (s <= t) ? sa[nt][j] * __expf(as - Mt[j]) : 0.f; sa[nt][j] = p; rsum[j] += p; } }
#pragma unroll
    for (int j = 0; j < 4; ++j) { float v = rsum[j]; v += __shfl_xor(v, 1); v += __shfl_xor(v, 2); v += __shfl_xor(v, 4); v += __shfl_xor(v, 8); rsum[j] = v; }
    f32x4 num[16];
#pragma unroll
    for (int nt = 0; nt < 16; ++nt) num[nt] = (f32x4){0.f, 0.f, 0.f, 0.f};
#pragma unroll
    for (int ks = 0; ks < 4; ++ks)
#pragma unroll
        for (int nt = 0; nt < 16; ++nt) { const bf16x8 b = *(const LAS bf16x8*)(BUF + (16 * nt + fr) * MP + (32 * ks + 8 * fq) * 2); num[nt] = MFMA16(qa[ks], b, num[nt]); if ((nt & 3) == 3) __builtin_amdgcn_sched_barrier(0); }
    float g4[4], den[4];
#pragma unroll
    for (int j = 0; j < 4; ++j) { const int t = 16 * wid + 4 * fq + j; g4[j] = fa[256 + t]; den[j] = fmaxf(fabsf(g4[j] * fa[512 + t] + rsum[j]), fa[384 + t]); }
#pragma unroll
    for (int nt = 0; nt < 16; ++nt)
#pragma unroll
        for (int j = 0; j < 4; ++j) num[nt][j] *= g4[j];
    __syncthreads();
#pragma unroll
    for (int nt = 0; nt < 8; ++nt)
#pragma unroll
        for (int j = 0; j < 4; ++j) *(LAS unsigned short*)(Ks + (16 * wid + 4 * fq + j) * MP + (16 * nt + fr) * 2) = (unsigned short)f2bf(sa[nt][j]);
    for (int task = tid; task < 4096; task += NTHR) {
        const int sidx = task & 127, e0 = (task >> 7) * 8;
        const v4u v = *(const v4u*)(PROJ + (size_t)(row0 + sidx) * PLD + C_MV + h * 256 + e0);
        LAS unsigned short* d = (LAS unsigned short*)(BUF + e0 * MP + sidx * 2);
        d[0 * (MP / 2)] = (unsigned short)(v.x & 0xffffu); d[1 * (MP / 2)] = (unsigned short)(v.x >> 16); d[2 * (MP / 2)] = (unsigned short)(v.y & 0xffffu); d[3 * (MP / 2)] = (unsigned short)(v.y >> 16);
        d[4 * (MP / 2)] = (unsigned short)(v.z & 0xffffu); d[5 * (MP / 2)] = (unsigned short)(v.z >> 16); d[6 * (MP / 2)] = (unsigned short)(v.w & 0xffffu); d[7 * (MP / 2)] = (unsigned short)(v.w >> 16);
    }
    __syncthreads();
#pragma unroll
    for (int ks = 0; ks < 4; ++ks) { const bf16x8 pa = *(const LAS bf16x8*)(Ks + (16 * wid + fr) * MP + (32 * ks + 8 * fq) * 2);
#pragma unroll
        for (int nt = 0; nt < 16; ++nt) { const bf16x8 b = *(const LAS bf16x8*)(BUF + (16 * nt + fr) * MP + (32 * ks + 8 * fq) * 2); num[nt] = MFMA16(pa, b, num[nt]); if ((nt & 3) == 3) __builtin_amdgcn_sched_barrier(0); } }
    float ssq[4];
#pragma unroll
    for (int j = 0; j < 4; ++j) { const float rd = 1.0f / den[j]; float s = 0.f;
#pragma unroll
        for (int nt = 0; nt < 16; ++nt) { const float v = num[nt][j] * rd; num[nt][j] = v; s += v * v; }
        s += __shfl_xor(s, 1); s += __shfl_xor(s, 2); s += __shfl_xor(s, 4); s += __shfl_xor(s, 8); ssq[j] = 1.0f / sqrtf(s * (1.0f / 256.0f) + 1e-6f); }
    __syncthreads();
    LAS float* HS = (LAS float*)(lds + 4096);
#pragma unroll
    for (int nt = 0; nt < 16; ++nt)
#pragma unroll
        for (int j = 0; j < 4; ++j) HS[(16 * wid + 4 * fq + j) * 260 + 16 * nt + fr] = num[nt][j] * ssq[j];
    __syncthreads();
    for (int task = tid; task < 4096; task += NTHR) {
        const int r = task >> 5, c8 = (task & 31) * 8; const size_t row = (size_t)(row0 + r);
        const f32x4 h0 = *(const LAS f32x4*)(HS + r * 260 + c8), h1 = *(const LAS f32x4*)(HS + r * 260 + c8 + 4);
        const f32x4 g0 = *(const f32x4*)(hgain + h * 256 + c8), g1 = *(const f32x4*)(hgain + h * 256 + c8 + 4);
        const v4u mo = *(const v4u*)(PROJ + row * PLD + C_MO + h * 256 + c8);
        v4u o;
        o.x = pk2(h0[0] * g0[0] / (1.0f + __expf(-bf2f(mo.x & 0xffffu))), h0[1] * g0[1] / (1.0f + __expf(-bf2f(mo.x >> 16))));
        o.y = pk2(h0[2] * g0[2] / (1.0f + __expf(-bf2f(mo.y & 0xffffu))), h0[3] * g0[3] / (1.0f + __expf(-bf2f(mo.y >> 16))));
        o.z = pk2(h1[0] * g1[0] / (1.0f + __expf(-bf2f(mo.z & 0xffffu))), h1[1] * g1[1] / (1.0f + __expf(-bf2f(mo.z >> 16))));
        o.w = pk2(h1[2] * g1[2] / (1.0f + __expf(-bf2f(mo.w & 0xffffu))), h1[3] * g1[3] / (1.0f + __expf(-bf2f(mo.w >> 16))));
        *(v4u*)(Y + row * DM + 1024 + h * 256 + c8) = o;
    }
    __syncthreads();
}

__device__ __forceinline__ att::BlockRef<att::bf16, att::bf16> att_ref(int i, int pass, const bfu* PROJ, bfu* OATT) {
    int ph, x;
    if (gridDim.x == 256) { ph = ((i >> 8) & 1) * 8 + (blockIdx.x & 7); x = blockIdx.x >> 3; }
    else { ph = (i >> 5) & 15; x = i & 31; }
    const int qb = pass ? 63 - x : x, h = ph >> 2, c = (ph >> 1) & 1, vh = ph & 1;
    att::BlockRef<att::bf16, att::bf16> r;
    constexpr size_t MSZ = (size_t)16384 * 128;
    r.Q = (const att::bf16*)(PROJ + (size_t)(2 * h + c) * MSZ + (size_t)qb * 256 * 128);
    r.K = (const att::bf16*)(PROJ + (size_t)(8 + 2 * h + c) * MSZ);
    r.V = (const att::bf16*)(PROJ + (size_t)(16 + 2 * h + vh) * MSZ);
    r.O = (att::bf16*)(OATT + (size_t)qb * 256 * 2048 + h * 512 + c * 256 + vh * 128);
    r.P0 = qb * 256;
    return r;
}
__device__ __forceinline__ void attn_phase(char* lds, const bfu* PROJ, bfu* OATT, const int TOTAL, const int mk_wave) {
    using namespace att;
    int i = blockIdx.x; if (i >= TOTAL) return;
    int pass = 0;
    BlockRef<bf16, bf16> cur = att_ref(i, 0, PROJ, OATT);
    Seam<bf16> S;
    causal_swa_prime<bf16, bf16>(cur, S_, lds, S, mk_wave);
    for (;;) {
        const bool more_pass = pass == 0, more_item = i + (int)gridDim.x < TOTAL, last = !more_pass && !more_item;
        int in_ = i, passn = pass + 1;
        if (!more_pass) { passn = 0; in_ = more_item ? i + (int)gridDim.x : i; }
        const BlockRef<bf16, bf16> nxt = last ? cur : att_ref(in_, passn, PROJ, OATT);
        causal_swa_block<bf16, bf16>(cur, nxt, S_, S_, lds, S, mk_wave);
        if (last) break;
        cur = nxt; i = in_; pass = passn;
    }
}

#ifndef ATTN2
#define ATTN2 3
#endif
__device__ __forceinline__ att::A2Ref att2_ref(int i, int pass, const bfu* PROJ, bfu* OATT) {
    int hc, x;
    if (gridDim.x == 256) { hc = blockIdx.x & 7; x = ((i >> 8) & 1) * 32 + (blockIdx.x >> 3); }
    else { hc = (i >> 6) & 7; x = i & 63; }
    const int qb = pass ? 127 - x : x, h = hc >> 1, c = hc & 1;
    constexpr size_t MSZ = (size_t)16384 * 128;
    att::A2Ref r;
    r.Q = (const att::bf16*)(PROJ + (size_t)(2 * h + c) * MSZ + (size_t)qb * 128 * 128);
    r.K = (const att::bf16*)(PROJ + (size_t)(8 + 2 * h + c) * MSZ);
    r.V0 = (const att::bf16*)(PROJ + (size_t)(16 + 2 * h) * MSZ); r.V1 = (const att::bf16*)(PROJ + (size_t)(16 + 2 * h + 1) * MSZ);
    r.O = (att::bf16*)(OATT + (size_t)qb * 128 * 2048 + h * 512 + c * 256);
    r.P0 = qb * 128;
    return r;
}
__device__ __forceinline__ void attn2_phase(char* lds, const bfu* PROJ, bfu* OATT, const int TOTAL, const int mk_wave) {
    for (int i = blockIdx.x; i < TOTAL; i += gridDim.x)
        for (int pass = 0; pass < 2; ++pass) { const att::A2Ref r = att2_ref(i, pass, PROJ, OATT); if (ATTN2 == 3) att::attn4_block(r, lds, mk_wave); else if (ATTN2 == 2) att::attn3_block(r, lds, mk_wave); else att::attn2_block(r, lds, mk_wave); }
}

__global__ void __launch_bounds__(NTHR, 2) mega_fwd(Args args) {
    extern __shared__ __attribute__((aligned(16))) unsigned char lds_raw[];
    LAS unsigned char* lds = (LAS unsigned char*)lds_raw;
    const int wave = __builtin_amdgcn_readfirstlane((int)threadIdx.x >> 6);
    const int G = gridDim.x, gw = blockIdx.x * NWAVES + wave, NGW = G * NWAVES;
#define AS4 __attribute__((address_space(4)))
#define PH_BEGIN int koff_ = 0; asm volatile("" : "+s"(koff_)); const AS4 char* kp_ = (const AS4 char*)__builtin_amdgcn_kernarg_segment_ptr() + koff_; \
    unsigned char* ws = *(unsigned char* const AS4*)(kp_ + 192); float* out = *(float* const AS4*)(kp_ + 184); (void)out; (void)ws; const int lane = mk_lane(), tid = wave * 64 + lane; (void)tid; (void)lane;
#define KIN(i) (*(const float* const AS4*)(kp_ + 8 * (i)))
#define Wgu ((bfu*)(ws + WS_WGU))
#define Wd ((bfu*)(ws + WS_WD))
#define Win ((bfu*)(ws + WS_WIN))
#define Wout ((bfu*)(ws + WS_WOUT))
#define XN ((bfu*)(ws + WS_XN))
#define BIG ((bfu*)(ws + WS_BIG))
#define Y ((bfu*)(ws + WS_Y))
#define CT ((bfu*)(ws + WS_CT))
#define QC ((bfu*)(ws + WS_QC))
#define KC ((bfu*)(ws + WS_KC))
#define NST ((float*)(ws + WS_NST))
#define rowss1 ((float*)(ws + WS_ROWSS1))
#define rowss2 ((float*)(ws + WS_ROWSS2))
#define SC ((float*)(ws + WS_SC))
#define DN ((float*)(ws + WS_DN))
#define GATES ((float*)(ws + WS_GATES))
#define DELTA ((float*)(ws + WS_XN))
#define OATT ((bfu*)(ws + WS_XN))
#define PROJM (BIG + (size_t)24 * 16384 * 128)
    const int lo = args.ph_lo, hi = args.ph_hi;
    if (hi - lo > 1) {
        if (wave == 0 && mk_lane() == 0) { volatile LAS unsigned* st = (volatile LAS unsigned*)(lds + LDS_BYTES - 64); st[0] = 0u; st[1] = 0u;
            (void)xb_add(&((unsigned*)(args.ws + WS_BAR))[XB_XCNT(xb_xcc_id())], 1u); }
        __syncthreads();
    }
#ifndef PHMASK
#define PHMASK 0xfff
#endif
#define IN(k) (((PHMASK >> (k)) & 1) && lo <= (k) && (k) < hi)
#ifndef PROBE_MASK
#define PROBE_MASK 0
#endif
#define NREP(k) (((PROBE_MASK >> (k)) & 1) ? 2 : 1)
#define STAGGER_DELAY(N) do { const int sn_ = (int)((blockIdx.x >> 3) & 3) * (N); for (int sd_ = 0; sd_ < sn_; ++sd_) __builtin_amdgcn_s_sleep(85); } while (0)
#define SYNC(k) do { if (IN(k) && IN((k) + 1)) { if (lo < 0) cg::this_grid().sync();     \
        { int kb_ = 0; asm volatile("" : "+s"(kb_)); unsigned char* wsb_ = *(unsigned char* const AS4*)((const AS4 char*)__builtin_amdgcn_kernarg_segment_ptr() + kb_ + 192); \
               xcd_barrier((unsigned*)(wsb_ + WS_BAR), (volatile LAS unsigned*)(lds + LDS_BYTES - 64), wave == 0 && mk_lane() == 0); \
               if ((PROBE_MASK >> 14) & 1) xcd_barrier((unsigned*)(wsb_ + WS_BAR), (volatile LAS unsigned*)(lds + LDS_BYTES - 64), wave == 0 && mk_lane() == 0); } } } while (0)

    if (IN(0)) for (int rep_ = 0; rep_ < NREP(0); ++rep_) { PH_BEGIN
        const float* x = KIN(0);
        LAS float* scr = (LAS float*)(lds + wave * 16640);
        constexpr int I_FFN = 3 * 2816, I_IN = 32 * 96, I_OUT = 32 * 32;
        for (int it = gw; it < I_FFN + I_IN + I_OUT; it += NGW) {
            if (it < I_FFN) cvt_ffn_item(it, KIN(2), KIN(3), KIN(4), KIN(1), Wgu, Wd, scr, lane);
            else if (it < I_FFN + I_IN) { const int r = it - I_FFN, kb = r / 96, nb = r % 96; cvt_item(KIN(6), NIN, NIN, KIN(5), Win, DM, nb * 64, kb * 64, nb * 64, scr, lane); }
            else { const int r = it - I_FFN - I_IN, kb = r / 32, nb = r % 32; cvt_item(KIN(17), DM, DM, nullptr, Wout, DM, nb * 64, kb * 64, nb * 64, scr, lane); }
        }
        for (int m = gw; m < S_; m += NGW) {
            const f32x4* xr = (const f32x4*)(x + (size_t)m * DM) + lane; f32x4 v[8]; float s = 0.f;
#pragma unroll
            for (int j = 0; j < 8; ++j) { v[j] = xr[64 * j]; s += (v[j][0] * v[j][0] + v[j][1] * v[j][1]) + (v[j][2] * v[j][2] + v[j][3] * v[j][3]); }
            const float rs = 1.0f / sqrtf(wave_sum(s) * (1.0f / DM) + 1e-6f);
            v2u* o8 = (v2u*)(XN + (size_t)m * DM) + lane;
#pragma unroll
            for (int j = 0; j < 8; ++j) { v2u w; w.x = pk2(v[j][0] * rs, v[j][1] * rs); w.y = pk2(v[j][2] * rs, v[j][3] * rs); o8[64 * j] = w; }
        }
        for (int i = blockIdx.x * NTHR + tid; i < 2 * S_; i += G * NTHR) rowss1[i] = 0.f;
        for (int k = blockIdx.x * NTHR + tid; k < DM + 8; k += G * NTHR) {
            unsigned char* gwp = ws + WS_GW; f32x4 w0 = (f32x4){0.f, 0.f, 0.f, 0.f}, w1 = w0;
            if (k < DM) { const float gk = KIN(5)[k]; w0 = *(const f32x4*)(KIN(6) + (size_t)k * NIN + 6144) * gk; w1 = *(const f32x4*)(KIN(6) + (size_t)k * NIN + 6148) * gk; }
#pragma unroll
            for (int j = 0; j < 4; ++j) { *(unsigned short*)(gwp + j * GWP + k * 2) = (unsigned short)f2bf(w0[j]); *(unsigned short*)(gwp + (4 + j) * GWP + k * 2) = (unsigned short)f2bf(w1[j]);
                *(unsigned short*)(gwp + (8 + j) * GWP + k * 2) = 0; *(unsigned short*)(gwp + (12 + j) * GWP + k * 2) = 0; }
        }
    }
    SYNC(0);
    if (IN(1)) { PH_BEGIN
        pg8::Gemm g{XN, Wgu, S_, 2 * FF, DM}; pg8::StaticOrder So; So.init(S_, 2 * FF, G, (int)blockIdx.x);
        pg8::EpiSwiGLU E{BIG, FF, nullptr, 0.f};
        STAGGER_DELAY(1); for (int rep_ = 0; rep_ < NREP(1); ++rep_) pg8::gemm_phase<pg8::EpiSwiGLU, pg8::StaticOrder, true, true>(lds, g, So, E, wave);
    }
    SYNC(1);
    if (IN(2)) { PH_BEGIN
        pg8::Gemm g{BIG, Wd, S_, DM, FF}; pg8::StaticOrder So; So.init(S_, DM, G, (int)blockIdx.x);
        pg8::EpiResid E{KIN(0), out, XN, rowss1, 0.5f, DM};
        STAGGER_DELAY(3); pg8::gemm_phase<pg8::EpiResid, pg8::StaticOrder, true, true>(lds, g, So, E, wave);
    }
    SYNC(2);
    if (IN(3)) { PH_BEGIN
        pg8::Gemm g{XN, Win, S_, NINP, DM}; pg8::StaticOrder So; So.init(S_, NINP, G, (int)blockIdx.x);
        pg8::EpiProj E{BIG, rowss1, 1.0f / DM};
        STAGGER_DELAY(1); for (int rep_ = 0; rep_ < NREP(3); ++rep_) pg8::gemm_phase<pg8::EpiProj, pg8::StaticOrder, true, true>(lds, g, So, E, wave);
        {
            const v4u* src = (const v4u*)(ws + WS_GW);
            for (int i = tid; i < 16 * GWP / 16; i += NTHR) *(LAS v4u*)(lds + 16384 + i * 16) = src[i];
            __syncthreads();
        }
        for (int rep_ = 0; rep_ < NREP(13); ++rep_) for (int rb = blockIdx.x; rb < S_ / 64; rb += G) gates_rows(lds, XN, rowss1, KIN(14), KIN(15), GATES, rb, wave, lane);
    }
    SYNC(3);
    if (IN(4)) { PH_BEGIN for (int item = blockIdx.x; item < 512 * NREP(4); item += G) mlstm_stage_a(lds, PROJM, GATES, KIN(12), KIN(13), QC, KC, DELTA, DN, SC, item & 511, wave); }
    SYNC(4);
    if (IN(5)) { PH_BEGIN for (int rep_ = 0; rep_ < NREP(5); ++rep_) mlstm_scan(lds, DELTA, DN, SC, SC + 1024, CT, NST, tid, blockIdx.x * NTHR + tid, G * NTHR); }
    SYNC(5);
    if (IN(6)) { PH_BEGIN
#ifndef NO_ATTN
#if ATTN2
        attn2_phase((char*)lds_raw, BIG, OATT, 512 * NREP(6), wave);
#else
        attn_phase((char*)lds_raw, BIG, OATT, 512 * NREP(6), wave);
#endif
#endif
        __syncthreads();
#ifndef NO_STAGEC
        for (int rep_ = 0; rep_ < NREP(12); ++rep_) for (int item = blockIdx.x; item < 512; item += G) mlstm_stage_c(lds, PROJM, GATES, QC, KC, CT, NST, SC + 1024, KIN(16), Y, item, wave);
#endif
    }
    SYNC(6);
    if (IN(7)) for (int rep_ = 0; rep_ < NREP(7); ++rep_) { PH_BEGIN
        const float l1 = wave_sum(KIN(7)[lane] * KIN(8)[lane] + KIN(7)[lane + 64] * KIN(8)[lane + 64]);
        const float l2 = wave_sum(KIN(9)[lane] * KIN(10)[lane] + KIN(9)[lane + 64] * KIN(10)[lane + 64]);
        const float lam = expf(l1) - expf(l2) + 0.2f;
        const float* hg = KIN(11);
        for (int m = gw; m < S_; m += NGW) {
#pragma unroll
            for (int h = 0; h < 4; ++h) {
                const v2u a = *((const v2u*)(OATT + (size_t)m * 2048 + h * 512) + lane), b = *((const v2u*)(OATT + (size_t)m * 2048 + h * 512 + 256) + lane);
                float y0 = bf2f(a.x & 0xffffu) - lam * bf2f(b.x & 0xffffu), y1 = bf2f(a.x >> 16) - lam * bf2f(b.x >> 16), y2 = bf2f(a.y & 0xffffu) - lam * bf2f(b.y & 0xffffu), y3 = bf2f(a.y >> 16) - lam * bf2f(b.y >> 16);
                const float rs = 0.8f / sqrtf(wave_sum((y0 * y0 + y1 * y1) + (y2 * y2 + y3 * y3)) * (1.0f / 256.0f) + 1e-6f);
                const f32x4 gn = *((const f32x4*)(hg + h * 256) + lane);
                v2u w; w.x = pk2(y0 * rs * gn[0], y1 * rs * gn[1]); w.y = pk2(y2 * rs * gn[2], y3 * rs * gn[3]);
                *((v2u*)(Y + (size_t)m * DM + h * 256) + lane) = w;
            }
        }
        LAS float* scr = (LAS float*)(lds + wave * 16640);
        for (int it = gw; it < 3 * 2816; it += NGW) cvt_ffn_item(it, KIN(19), KIN(20), KIN(21), KIN(18), Wgu, Wd, scr, lane);
    }
    SYNC(7);
    if (IN(8)) { PH_BEGIN
        pg8::Gemm g{Y, Wout, S_, DM, DM}; pg8::StaticOrder So; So.init(S_, DM, G, (int)blockIdx.x);
        pg8::EpiResid E{out, out, XN, rowss2, 1.0f, DM};
        STAGGER_DELAY(3); pg8::gemm_phase<pg8::EpiResid, pg8::StaticOrder, true, true>(lds, g, So, E, wave);
    }
    SYNC(8);
    if (IN(9)) { PH_BEGIN
        pg8::Gemm g{XN, Wgu, S_, 2 * FF, DM}; pg8::StaticOrder So; So.init(S_, 2 * FF, G, (int)blockIdx.x);
        pg8::EpiSwiGLU E{BIG, FF, rowss2, 1.0f / DM};
        STAGGER_DELAY(1); pg8::gemm_phase<pg8::EpiSwiGLU, pg8::StaticOrder, true, true>(lds, g, So, E, wave);
    }
    SYNC(9);
    if (IN(10)) { PH_BEGIN
        pg8::Gemm g{BIG, Wd, S_, DM, FF}; pg8::StaticOrder So; So.init(S_, DM, G, (int)blockIdx.x);
        pg8::EpiResid E{out, out, nullptr, nullptr, 0.5f, DM};
        STAGGER_DELAY(3); pg8::gemm_phase<pg8::EpiResid, pg8::StaticOrder, true, true>(lds, g, So, E, wave);
    }
    SYNC(10);
    if (IN(11)) { PH_BEGIN
        const float* fg = KIN(22);
        for (int m = gw; m < S_; m += NGW) {
            f32x4* xr = (f32x4*)(out + (size_t)m * DM) + lane; f32x4 v[8]; float s = 0.f;
#pragma unroll
            for (int j = 0; j < 8; ++j) { v[j] = xr[64 * j]; s += (v[j][0] * v[j][0] + v[j][1] * v[j][1]) + (v[j][2] * v[j][2] + v[j][3] * v[j][3]); }
            const float rs = 1.0f / sqrtf(wave_sum(s) * (1.0f / DM) + 1e-6f);
#pragma unroll
            for (int j = 0; j < 8; ++j) { const f32x4 gn = *((const f32x4*)fg + 64 * j + lane); xr[64 * j] = v[j] * rs * gn; }
        }
    }
#undef IN
#undef SYNC
}

extern "C" void kernel_launch(void* const* d_in, const int* in_sizes, int n_in, void* d_out, int out_size, void* d_ws, size_t ws_size, hipStream_t stream) {
    static int grid = 0;
    if (grid == 0) {
        if (n_in != 23 || in_sizes[0] != S_ * DM || out_size != S_ * DM || ws_size < WS_END) { fprintf(stderr, "kernel_launch: unexpected shapes (n_in %d, in0 %d, out %d, ws %zu)\n", n_in, n_in > 0 ? in_sizes[0] : -1, out_size, ws_size); grid = -1; return; }
        int dev = 0, cus = 0, per_cu = 0;
        (void)hipGetDevice(&dev); (void)hipDeviceGetAttribute(&cus, hipDeviceAttributeMultiprocessorCount, dev);
        if (hipFuncSetAttribute((const void*)mega_fwd, hipFuncAttributeMaxDynamicSharedMemorySize, LDS_BYTES) != hipSuccess) { fprintf(stderr, "kernel_launch: hipFuncSetAttribute failed\n"); grid = -1; return; }
        if (hipOccupancyMaxActiveBlocksPerMultiprocessor(&per_cu, (const void*)mega_fwd, NTHR, LDS_BYTES) != hipSuccess || per_cu < 1) per_cu = 1;
        grid = cus * per_cu;
        fprintf(stderr, "kernel_launch: grid %d (%d CUs x %d)\n", grid, cus, per_cu);
    }
    if (grid < 0) return;
    Args a{};
    for (int i = 0; i < 23; ++i) a.in[i] = (const float*)d_in[i];
    a.out = (float*)d_out; a.ws = (unsigned char*)d_ws;
#if MK_SPLIT
    for (int p = 0; p < NPH; ++p) { a.ph_lo = p; a.ph_hi = p + 1; hipLaunchKernelGGL(mega_fwd, dim3(grid), dim3(NTHR), LDS_BYTES, stream, a); }
#else
    a.ph_lo = 0; a.ph_hi = NPH;
    (void)hipMemsetAsync((char*)d_ws + WS_BAR, 0, XCD_BAR_WORDS * 4, stream);
    void* kargs[] = {&a};
    hipError_t e = hipLaunchCooperativeKernel((const void*)mega_fwd, dim3(grid), dim3(NTHR), kargs, LDS_BYTES, stream);
    if (e != hipSuccess) fprintf(stderr, "kernel_launch: cooperative launch failed: %s (grid %d)\n", hipGetErrorString(e), grid);
#endif
}
```

```cpp
#include <hip/hip_runtime.h>
#include <hip/hip_bf16.h>
#include <hip/hip_cooperative_groups.h>
#include <cstdio>
#include <cstdint>
namespace cg = cooperative_groups;

#ifndef MK_SPLIT
#define MK_SPLIT 0
#endif

namespace pg8 {
#define PG8_LAS __attribute__((address_space(3)))
typedef unsigned short bf16_t;
typedef short bf16x8 __attribute__((ext_vector_type(8)));
typedef float f32x4 __attribute__((ext_vector_type(4)));
typedef unsigned u32x4 __attribute__((ext_vector_type(4)));
constexpr int BM = 256, BK = 64, HALF = 128, HTB = HALF * BK * 2  , STAGE_BYTES = 8 * HTB, NXCD = 8, WGM = 8;

__host__ __device__ __forceinline__ int lds_byte(int r, int c) { const int st = (r >> 4) * 2 + (c >> 5), rr = r & 15, cc = c & 31, ob = rr * 64 + cc * 2; return st * 1024 + (ob ^ (((ob >> 9) & 1) << 5)); }
__host__ __device__ __forceinline__ void stage_rc(int b, int& R, int& C) { const int st = b / 1024, sb = b % 1024, swz = sb ^ (((sb >> 9) & 1) << 5); R = (st >> 1) * 16 + swz / 64; C = (st & 1) * 32 + (swz % 64) / 2; }
__host__ __device__ __forceinline__ int perm32(int rho) { const int n = rho >> 4, i = rho & 15; return 8 * (i >> 2) + 4 * n + (i & 3); }

struct Unit { int pm, pn; };
struct Gemm { const bf16_t* A; const bf16_t* Bt; int M, N, K; };

struct StaticOrder {
    int nM, nN, nwg, G, c;
    __host__ __device__ void init(int M, int N, int G_, int c_) { nM = M / BM; nN = N / BM; nwg = nM * nN; G = G_; c = c_; }
    __host__ __device__ bool next(int i, Unit& u) const {
        const long L = (long)i * G + c; if (L >= nwg) return false;
        int wgid = (int)L; { const int q = nwg / NXCD, r = nwg % NXCD, xcd = wgid % NXCD, off = wgid / NXCD; wgid = (xcd < r ? xcd * (q + 1) : r * (q + 1) + (xcd - r) * q) + off; }
        const int nig = WGM * nN, gid = wgid / nig, fm = gid * WGM, gsz = (nM - fm) < WGM ? (nM - fm) : WGM;
        u.pm = fm + ((wgid % nig) % gsz); u.pn = (wgid % nig) / gsz; return true;
    }
    __device__ __forceinline__ void a_ready(const Unit&) const {}
    __device__ __forceinline__ void done(const Unit&) const {}
};

__device__ __forceinline__ unsigned cvt_pk_bf16(float lo, float hi) { unsigned r; asm volatile("v_cvt_pk_bf16_f32 %0, %1, %2" : "=v"(r) : "v"(lo), "v"(hi)); return r; }

constexpr float RMS_EPS = 1e-6f;
__device__ __forceinline__ float silu_f(float x) { return x * __builtin_amdgcn_rcpf(1.0f + __builtin_amdgcn_exp2f(-1.4426950408889634f * x)); }
struct EpiSwiGLU {
    static constexpr bool PERM = true, AFTER_DRAIN = false;
    bf16_t* O; int ldo; const float* rowss; float inv_n;
    __device__ __forceinline__ void operator()(const f32x4 (&acc)[2][2][4][2], const Unit& u, int wr, int wc, int fr, int fq) const {
        const int row0 = u.pm * BM + wr * 64 + fr, col0 = u.pn * HALF + wc * 32 + 8 * fq;
#pragma unroll
        for (int ai = 0; ai < 2; ++ai)
#pragma unroll
            for (int m = 0; m < 4; ++m) {
                const int r = row0 + ai * HALF + m * 16;
                const float rs = rowss ? __builtin_amdgcn_rsqf(rowss[r] * inv_n + RMS_EPS) : 1.0f;
                const f32x4 g0 = acc[ai][0][m][0] * rs, g1 = acc[ai][0][m][1] * rs, u0 = acc[ai][1][m][0] * rs, u1 = acc[ai][1][m][1] * rs;
                u32x4 w;
                w.x = cvt_pk_bf16(silu_f(g0[0]) * u0[0], silu_f(g0[1]) * u0[1]); w.y = cvt_pk_bf16(silu_f(g0[2]) * u0[2], silu_f(g0[3]) * u0[3]);
                w.z = cvt_pk_bf16(silu_f(g1[0]) * u1[0], silu_f(g1[1]) * u1[1]); w.w = cvt_pk_bf16(silu_f(g1[2]) * u1[2], silu_f(g1[3]) * u1[3]);
                *(u32x4*)(O + (size_t)r * ldo + col0) = w;
            }
    }
};
struct EpiResid {
    static constexpr bool PERM = false, AFTER_DRAIN = false;
    const float* resid; float* out; bf16_t* xb; float* rowss; float alpha; int ld;
    __device__ __forceinline__ void operator()(const f32x4 (&acc)[2][2][4][2], const Unit& u, int wr, int wc, int fr, int fq) const {
        typedef unsigned u32x2v __attribute__((ext_vector_type(2)));
        const int row0 = u.pm * BM + wr * 64 + fr, col0 = u.pn * BM + wc * 32 + 4 * fq;
#pragma unroll
        for (int ai = 0; ai < 2; ++ai)
#pragma unroll
            for (int m = 0; m < 4; ++m) {
                const int r = row0 + ai * HALF + m * 16; float ss = 0.f;
#pragma unroll
                for (int bj = 0; bj < 2; ++bj)
#pragma unroll
                    for (int n = 0; n < 2; ++n) {
                        const size_t off = (size_t)r * ld + col0 + bj * HALF + n * 16;
                        const f32x4 b = *(const f32x4*)(resid + off); const f32x4 o = b + acc[ai][bj][m][n] * alpha;
                        *(f32x4*)(out + off) = o; ss += (o[0] * o[0] + o[1] * o[1]) + (o[2] * o[2] + o[3] * o[3]);
                        if (xb) { u32x2v w; w.x = cvt_pk_bf16(o[0], o[1]); w.y = cvt_pk_bf16(o[2], o[3]); *(u32x2v*)(xb + off) = w; }
                    }
                if (rowss) { ss += __shfl_xor(ss, 16); ss += __shfl_xor(ss, 32); if (fq == 0) atomicAdd(rowss + r, ss); }
            }
    }
};
struct EpiProj {
    static constexpr bool PERM = true, AFTER_DRAIN = false;
    bf16_t* O; const float* rowss; float inv_n;
    __device__ __forceinline__ void operator()(const f32x4 (&acc)[2][2][4][2], const Unit& u, int wr, int wc, int fr, int fq) const {
        const int row0 = u.pm * BM + wr * 64 + fr;
        {
            const bool dense = u.pn < 12;
            const size_t rstride = dense ? 128 : 3072;
            bf16_t* base = dense ? O + (size_t)(2 * u.pn) * ((size_t)16384 * 128) + wc * 32 + 8 * fq : O + (size_t)24 * 16384 * 128 + (u.pn - 12) * BM + wc * 32 + 8 * fq;
            const size_t bjstep = dense ? (size_t)16384 * 128 : 128;
#pragma unroll
            for (int ai = 0; ai < 2; ++ai)
#pragma unroll
                for (int m = 0; m < 4; ++m) {
                    const int r = row0 + ai * HALF + m * 16; const float rs = __builtin_amdgcn_rsqf(rowss[r] * inv_n + RMS_EPS);
#pragma unroll
                    for (int bj = 0; bj < 2; ++bj) { const f32x4 v0 = acc[ai][bj][m][0] * rs, v1 = acc[ai][bj][m][1] * rs; u32x4 w;
                        w.x = cvt_pk_bf16(v0[0], v0[1]); w.y = cvt_pk_bf16(v0[2], v0[3]); w.z = cvt_pk_bf16(v1[0], v1[1]); w.w = cvt_pk_bf16(v1[2], v1[3]);
                        *(u32x4*)(base + (size_t)r * rstride + bj * bjstep) = w; }
                }
        }
    }
};
template <class Epi, class Sched, bool ALIGN_EPI = false, bool SP2 = false>
__device__ __forceinline__ void gemm_phase(PG8_LAS unsigned char* lds, const Gemm g, const Sched& S, const Epi& E, const int mk_wave) {
    const int lane = (int)(__builtin_amdgcn_mbcnt_hi(~0u, __builtin_amdgcn_mbcnt_lo(~0u, 0u)) & 63u), wid = mk_wave & 7, tid = wid * 64 + lane, wr = wid >> 2, wc = wid & 3, fr = lane & 15, fq = lane >> 4;
    const int K = g.K, nt = K / BK;
    unsigned voffA[2], voffB[2];
#pragma unroll
    for (int i = 0; i < 2; ++i) { int R, C; stage_rc(tid * 16 + i * 8192, R, C); const int Rb = Epi::PERM ? ((R & ~31) + perm32(R & 31)) : R;
        voffA[i] = (unsigned)(R * K + C) * 2u; voffB[i] = (unsigned)(Rb * K + C) * 2u; }
    const size_t kstep = (size_t)(BK * 2);
    const size_t hstep = (size_t)HALF * K * 2;
    const size_t tstep = 2 * hstep;
    const unsigned ldsw = (unsigned)wid * 1024u;
    const int aoff = lds_byte(wr * 64 + fr, fq * 8), boff = lds_byte(wc * 32 + fr, fq * 8);
#define PG8_SA(b, h) (((b) * 2 + (h)) * HTB)
#define PG8_SB(b, h) ((4 + (b) * 2 + (h)) * HTB)
#define PG8_STAGE(bufoff, gbase, voff) do { _Pragma("unroll") for (int _i = 0; _i < 2; ++_i) \
        __builtin_amdgcn_global_load_lds((const unsigned*)((const char*)(gbase) + (voff)[_i]), (PG8_LAS unsigned*)(lds + (bufoff) + ldsw + _i * 8192), 16, 0, 0); } while (0)
#define PG8_LDA(dst, b, h) do { _Pragma("unroll") for (int m = 0; m < 4; ++m) _Pragma("unroll") for (int k = 0; k < 2; ++k) dst[m][k] = *(const PG8_LAS bf16x8*)(lds + PG8_SA(b, h) + aoff + m * 2048 + k * 1024); } while (0)
#define PG8_LDB(dst, b, h) do { _Pragma("unroll") for (int n = 0; n < 2; ++n) _Pragma("unroll") for (int k = 0; k < 2; ++k) dst[n][k] = *(const PG8_LAS bf16x8*)(lds + PG8_SB(b, h) + boff + n * 2048 + k * 1024); } while (0)
#define PG8_MMA(ai, bj, At, Bt) do { __builtin_amdgcn_s_setprio(1); _Pragma("unroll") for (int m = 0; m < 4; ++m) _Pragma("unroll") for (int n = 0; n < 2; ++n) _Pragma("unroll") for (int k = 0; k < 2; ++k) \
        acc[ai][bj][m][n] = __builtin_amdgcn_mfma_f32_16x16x32_bf16(Bt[n][k], At[m][k], acc[ai][bj][m][n], 0, 0, 0); __builtin_amdgcn_s_setprio(0); } while (0)
#define PG8_WAIT_V(n) asm volatile("s_waitcnt vmcnt(" #n ")" ::: "memory")
#define PG8_WAIT_L(n) asm volatile("s_waitcnt lgkmcnt(" #n ")" ::: "memory")
#define PG8_BAR __builtin_amdgcn_s_barrier()
#define PG8_SCHED __builtin_amdgcn_sched_barrier(0)
    Unit cur, nxt; int ui = 0;
    if (!S.next(0, cur)) return;
    f32x4 acc[2][2][4][2];
#pragma unroll
    for (int a = 0; a < 2; ++a)
#pragma unroll
        for (int b = 0; b < 2; ++b)
#pragma unroll
            for (int m = 0; m < 4; ++m)
#pragma unroll
                for (int n = 0; n < 2; ++n) acc[a][b][m][n] = (f32x4){0.f, 0.f, 0.f, 0.f};
    bf16x8 At[4][2], B0[2][2], B1[2][2];
    const char* cA = (const char*)g.A + (size_t)cur.pm * tstep; const char* cB = (const char*)g.Bt + (size_t)cur.pn * tstep;
    S.a_ready(cur);
    if constexpr (SP2) {
        PG8_STAGE(PG8_SB(0, 0), cB, voffB); PG8_STAGE(PG8_SB(0, 1), cB + hstep, voffB); PG8_STAGE(PG8_SA(0, 0), cA, voffA); PG8_STAGE(PG8_SA(0, 1), cA + hstep, voffA);
        if (wr == 1) PG8_BAR;
        PG8_WAIT_V(2); PG8_BAR;
        PG8_STAGE(PG8_SB(1, 0), cB + kstep, voffB); PG8_STAGE(PG8_SA(1, 0), cA + kstep, voffA); PG8_STAGE(PG8_SB(1, 1), cB + hstep + kstep, voffB);
        PG8_WAIT_V(6); PG8_BAR;
    } else {
        PG8_STAGE(PG8_SB(0, 0), cB, voffB); PG8_STAGE(PG8_SA(0, 0), cA, voffA); PG8_STAGE(PG8_SB(0, 1), cB + hstep, voffB); PG8_STAGE(PG8_SA(0, 1), cA + hstep, voffA);
        if (wr == 1) PG8_BAR;
        PG8_WAIT_V(4); PG8_BAR;
        PG8_STAGE(PG8_SB(1, 0), cB + kstep, voffB); PG8_STAGE(PG8_SA(1, 0), cA + kstep, voffA); PG8_STAGE(PG8_SB(1, 1), cB + hstep + kstep, voffB);
        PG8_WAIT_V(6); PG8_BAR;
    }
    for (;;) {
        const bool has_next = S.next(ui + 1, nxt);
        const char* nA = has_next ? (const char*)g.A + (size_t)nxt.pm * tstep : cA; const char* nB = has_next ? (const char*)g.Bt + (size_t)nxt.pn * tstep : cB;
        for (int t = 0; t < nt; t += 2) {
            const bool last = (t == nt - 2);
            const char* a1 = cA + (size_t)(t + 1) * kstep;
            const char* a2 = last ? nA : cA + (size_t)(t + 2) * kstep; const char* b2 = last ? nB : cB + (size_t)(t + 2) * kstep;
            const char* a3 = a2 + kstep; const char* b3 = b2 + kstep;
            if (last && has_next) S.a_ready(nxt);
            if constexpr (SP2) {
            PG8_LDB(B0, 0, 0); PG8_LDB(B1, 0, 1); PG8_SCHED; PG8_LDA(At, 0, 0); PG8_STAGE(PG8_SA(1, 1), a1 + hstep, voffA);
            PG8_WAIT_V(8); PG8_WAIT_L(0); PG8_BAR; PG8_MMA(0, 0, At, B0); PG8_MMA(0, 1, At, B1); PG8_BAR; PG8_SCHED;
            PG8_LDA(At, 0, 1); PG8_STAGE(PG8_SB(0, 0), b2, voffB); PG8_STAGE(PG8_SB(0, 1), b2 + hstep, voffB); PG8_STAGE(PG8_SA(0, 0), a2, voffA);
            PG8_WAIT_V(8); PG8_WAIT_L(0); PG8_BAR; PG8_MMA(1, 0, At, B0); PG8_MMA(1, 1, At, B1); PG8_BAR; PG8_SCHED;
            PG8_LDB(B0, 1, 0); PG8_LDB(B1, 1, 1); PG8_SCHED; PG8_LDA(At, 1, 0); PG8_STAGE(PG8_SA(0, 1), a2 + hstep, voffA);
            PG8_WAIT_V(8); PG8_WAIT_L(0); PG8_BAR; PG8_MMA(0, 0, At, B0); PG8_MMA(0, 1, At, B1); PG8_BAR; PG8_SCHED;
            PG8_LDA(At, 1, 1); PG8_STAGE(PG8_SB(1, 0), b3, voffB); PG8_STAGE(PG8_SB(1, 1), b3 + hstep, voffB); PG8_STAGE(PG8_SA(1, 0), a3, voffA);
            PG8_WAIT_V(8); PG8_WAIT_L(0); PG8_BAR; PG8_MMA(1, 0, At, B0); PG8_MMA(1, 1, At, B1); PG8_BAR; PG8_SCHED;
            } else {
            PG8_LDB(B0, 0, 0); PG8_SCHED; PG8_LDA(At, 0, 0); PG8_STAGE(PG8_SA(1, 1), a1 + hstep, voffA);
            PG8_WAIT_L(8); PG8_BAR; PG8_WAIT_L(0); PG8_MMA(0, 0, At, B0); PG8_BAR; PG8_SCHED;
            PG8_LDB(B1, 0, 1); PG8_STAGE(PG8_SB(0, 0), b2, voffB);
            PG8_BAR; PG8_WAIT_L(0); PG8_MMA(0, 1, At, B1); PG8_BAR;
            PG8_LDA(At, 0, 1); PG8_STAGE(PG8_SA(0, 0), a2, voffA);
            PG8_BAR; PG8_WAIT_L(0); PG8_MMA(1, 0, At, B0); PG8_BAR; PG8_SCHED;
            PG8_STAGE(PG8_SB(0, 1), b2 + hstep, voffB);
            PG8_WAIT_V(6); PG8_BAR; PG8_MMA(1, 1, At, B1); PG8_BAR;
            PG8_LDB(B0, 1, 0); PG8_SCHED; PG8_LDA(At, 1, 0); PG8_STAGE(PG8_SA(0, 1), a2 + hstep, voffA);
            PG8_WAIT_L(8); PG8_BAR; PG8_WAIT_L(0); PG8_MMA(0, 0, At, B0); PG8_BAR; PG8_SCHED;
            PG8_LDB(B1, 1, 1); PG8_STAGE(PG8_SB(1, 0), b3, voffB);
            PG8_BAR; PG8_WAIT_L(0); PG8_MMA(0, 1, At, B1); PG8_BAR;
            PG8_LDA(At, 1, 1); PG8_STAGE(PG8_SA(1, 0), a3, voffA);
            PG8_BAR; PG8_WAIT_L(0); PG8_MMA(1, 0, At, B0); PG8_BAR; PG8_SCHED;
            PG8_STAGE(PG8_SB(1, 1), b3 + hstep, voffB);
            PG8_WAIT_V(6); PG8_BAR; PG8_MMA(1, 1, At, B1); PG8_BAR;
            }
        }
        if constexpr (ALIGN_EPI) { if (wr == 0) PG8_BAR; }
        if constexpr (!Epi::AFTER_DRAIN) { E(acc, cur, wr, wc, fr, fq); S.done(cur); }
        if (!has_next) break;
#pragma unroll
        for (int a = 0; a < 2; ++a)
#pragma unroll
            for (int b = 0; b < 2; ++b)
#pragma unroll
                for (int m = 0; m < 4; ++m)
#pragma unroll
                    for (int n = 0; n < 2; ++n) acc[a][b][m][n] = (f32x4){0.f, 0.f, 0.f, 0.f};
        cur = nxt; cA = nA; cB = nB; ++ui;
        if constexpr (ALIGN_EPI) { if (wr == 1) PG8_BAR; }
    }
    PG8_WAIT_V(0);
    if constexpr (!ALIGN_EPI) { if (wr == 0) PG8_BAR; }
    PG8_BAR;
    if constexpr (Epi::AFTER_DRAIN) { E.fused(acc, cur, wr, wc, fr, fq, lds, wid, lane); S.done(cur); }
#undef PG8_SA
#undef PG8_SB
#undef PG8_STAGE
#undef PG8_LDA
#undef PG8_LDB
#undef PG8_MMA
#undef PG8_WAIT_V
#undef PG8_WAIT_L
#undef PG8_BAR
#undef PG8_SCHED
}
}

namespace att {
constexpr int D = 128; constexpr float THR = 8.f; constexpr bool WSKIP = false; constexpr int LDP = 128, LDO = 2048;
constexpr float SCALE = 0.08838834764831845f;
constexpr int NW = 8, QBLK = 32, KVBLK = 64, QB = NW * QBLK;
constexpr int SHM_V = KVBLK * D * 2, SHM_K = KVBLK * D * 2;
constexpr int LDS_BYTES = 2 * SHM_V + 2 * SHM_K + NW * 64 * 4;

using bf16 = __hip_bfloat16;
typedef short bf16x8 __attribute__((ext_vector_type(8)));
typedef short s16x4 __attribute__((ext_vector_type(4)));
typedef float f32x16 __attribute__((ext_vector_type(16)));
typedef float f32x4 __attribute__((ext_vector_type(4)));
typedef unsigned u32x4 __attribute__((ext_vector_type(4)));
template <class A, class Bt> struct same_t { static constexpr bool v = false; };
template <class A> struct same_t<A, A> { static constexpr bool v = true; };

#define KSWZ(row, colB) ((row) * 256 + ((colB) ^ (((row) & 7) << 4)))
#define SBAR() __builtin_amdgcn_sched_barrier(0)
__device__ __forceinline__ int v_st(int k, int c) { const int kk = (k & ~0xC) | ((k & 4) << 1) | ((k & 8) >> 1); return ((kk >> 3) * 4 + (c >> 5)) * 512 + ((kk & 7) * 32 + (c & 31)) * 2; }
__device__ __forceinline__ int v_rd_base(int lane) { return ((lane & 3) << 3) | (((lane >> 2) & 3) << 6) | (((lane >> 4) & 1) << 5) | (((lane >> 5) & 1) << 8); }
constexpr int v_rd_off(int d0, int ks, int half) { return d0 * 512 + ks * 4096 + half * 2048; }
__device__ __forceinline__ int crow(int r, int hi) { return (r & 3) + 8 * (r >> 2) + 4 * hi; }
__device__ __forceinline__ unsigned cvtpk(float lo, float hi) {
    unsigned r; asm volatile("v_cvt_pk_bf16_f32 %0, %1, %2" : "=v"(r) : "v"(lo), "v"(hi)); return r;
}
__device__ __forceinline__ bf16x8 pack8(f32x4 a, f32x4 b) {
    u32x4 w = {cvtpk(a[0], a[1]), cvtpk(a[2], a[3]), cvtpk(b[0], b[1]), cvtpk(b[2], b[3])};
    return *reinterpret_cast<bf16x8*>(&w);
}
template <class T> __device__ __forceinline__ bf16x8 load8(const T* p) {
    if constexpr (same_t<T, float>::v) { return pack8(*(const f32x4*)p, *(const f32x4*)(p + 4)); }
    else { return *reinterpret_cast<const bf16x8*>(p); }
}
__device__ __forceinline__ void mask_tile(f32x16& p0, f32x16& p1, int dq, unsigned W) {
    const float NEG = -__builtin_inff();
#pragma unroll
    for (int r = 0; r < 16; ++r) {
        const int c = (r & 3) + 8 * (r >> 2);
        if ((unsigned)(dq - c) >= W) p0[r] = NEG;
        if ((unsigned)(dq - c - 32) >= W) p1[r] = NEG;
    }
}
__device__ __forceinline__ void partialSM(f32x16& p0, f32x16& p1, float& m_reg, float& mn, float& alpha) {
    float pmax = p0[0]; for (int r = 1; r < 16; ++r) pmax = fmaxf(pmax, p0[r]); for (int r = 0; r < 16; ++r) pmax = fmaxf(pmax, p1[r]);
    { auto rr = __builtin_amdgcn_permlane32_swap(__float_as_uint(pmax), __float_as_uint(pmax), false, false);
      pmax = fmaxf(__uint_as_float(rr[0]), __uint_as_float(rr[1])); }
    constexpr float C2 = 1.4426950408889634f * SCALE;
    if (__builtin_expect(__all((pmax - m_reg) * SCALE <= THR), 1)) { mn = m_reg; alpha = 1.f; }
    else { mn = fmaxf(m_reg, pmax); alpha = __builtin_amdgcn_exp2f((m_reg - mn) * C2); m_reg = mn; }
    const float mnL = -mn * C2;
    for (int r = 0; r < 16; ++r) p0[r] = fmaf(p0[r], C2, mnL); for (int r = 0; r < 16; ++r) p1[r] = fmaf(p1[r], C2, mnL);
    for (int r = 0; r < 16; ++r) p0[r] = __builtin_amdgcn_exp2f(p0[r]);
}
__device__ __forceinline__ void finishSM(f32x16& p0, f32x16& p1, float alpha, float& l_reg, bf16x8& pa0, bf16x8& pa1, bf16x8& pa2, bf16x8& pa3) {
    for (int r = 0; r < 16; ++r) p1[r] = __builtin_amdgcn_exp2f(p1[r]);
    float ps = 0; for (int r = 0; r < 16; ++r) ps += p0[r]; for (int r = 0; r < 16; ++r) ps += p1[r];
    { auto rr = __builtin_amdgcn_permlane32_swap(__float_as_uint(ps), __float_as_uint(ps), false, false);
      ps = __uint_as_float(rr[0]) + __uint_as_float(rr[1]); }
    l_reg = l_reg * alpha + ps;
#define PK4(P, B_, OUT) do { unsigned a0 = cvtpk(P[B_+0], P[B_+1]), a1 = cvtpk(P[B_+2], P[B_+3]);                          \
        unsigned b0 = cvtpk(P[B_+4], P[B_+5]), b1 = cvtpk(P[B_+6], P[B_+7]);                                             \
        auto r0 = __builtin_amdgcn_permlane32_swap(a0, b0, false, false); auto r1 = __builtin_amdgcn_permlane32_swap(a1, b1, false, false); \
        u32x4 w = {r0[0], r1[0], r0[1], r1[1]}; OUT = *reinterpret_cast<bf16x8*>(&w); } while (0)
    PK4(p0, 0, pa0); PK4(p0, 8, pa1); PK4(p1, 0, pa2); PK4(p1, 8, pa3);
#undef PK4
}
template <int KB, bool SK>
__device__ __forceinline__ void qkt(f32x16& p0, f32x16& p1, const char* K_lds, int r32, int hi, const bf16x8* qr, bool act) {
    if (SK && !act) { const float NEG = -__builtin_inff();
#pragma unroll
        for (int r = 0; r < 16; ++r) { p0[r] = NEG; p1[r] = NEG; } return; }
    p0 = f32x16{}; p1 = f32x16{};
    const char* kb[4];
#pragma unroll
    for (int dd = 0; dd < 4; ++dd) kb[dd] = K_lds + KB * SHM_K + KSWZ(r32, (dd * 16 + hi * 8) * 2);
#pragma unroll
    for (int d0 = 0; d0 < 8; ++d0) { const char* a = kb[d0 & 3] + (d0 >> 2) * 128;
        bf16x8 b0 = *reinterpret_cast<const bf16x8*>(a);
        bf16x8 b1 = *reinterpret_cast<const bf16x8*>(a + 32 * 256);
        p0 = __builtin_amdgcn_mfma_f32_32x32x16_bf16(b0, qr[d0], p0, 0, 0, 0);
        p1 = __builtin_amdgcn_mfma_f32_32x32x16_bf16(b1, qr[d0], p1, 0, 0, 0); }
}
template <int VB, bool SK>
__device__ __forceinline__ void pv_tile(f32x16* o, int vb0, bf16x8 pa0, bf16x8 pa1, bf16x8 pa2, bf16x8 pa3, bool act) {
    if (SK && !act) return;
#define TRRD(dst, off) asm volatile("ds_read_b64_tr_b16 %0, %1 offset:%2" : "=&v"(dst) : "v"(vb0), "i"(off) : "memory")
#define PV_D0(d0) do { s16x4 l0, l1, l2, l3, h0, h1, h2, h3; constexpr int b_ = VB * SHM_V + v_rd_off(d0, 0, 0);     \
        TRRD(l0, b_); TRRD(h0, b_ + 2048); TRRD(l1, b_ + 4096); TRRD(h1, b_ + 6144); TRRD(l2, b_ + 8192); TRRD(h2, b_ + 10240); TRRD(l3, b_ + 12288); TRRD(h3, b_ + 14336); \
        asm volatile("s_waitcnt lgkmcnt(0)" ::: "memory"); SBAR();                 \
        o[d0] = __builtin_amdgcn_mfma_f32_32x32x16_bf16(pa0, (bf16x8){l0[0], l0[1], l0[2], l0[3], h0[0], h0[1], h0[2], h0[3]}, o[d0], 0, 0, 0);   \
        o[d0] = __builtin_amdgcn_mfma_f32_32x32x16_bf16(pa1, (bf16x8){l1[0], l1[1], l1[2], l1[3], h1[0], h1[1], h1[2], h1[3]}, o[d0], 0, 0, 0);   \
        o[d0] = __builtin_amdgcn_mfma_f32_32x32x16_bf16(pa2, (bf16x8){l2[0], l2[1], l2[2], l2[3], h2[0], h2[1], h2[2], h2[3]}, o[d0], 0, 0, 0);   \
        o[d0] = __builtin_amdgcn_mfma_f32_32x32x16_bf16(pa3, (bf16x8){l3[0], l3[1], l3[2], l3[3], h3[0], h3[1], h3[2], h3[3]}, o[d0], 0, 0, 0); } while (0)
    PV_D0(0); PV_D0(1); PV_D0(2); PV_D0(3);
#undef PV_D0
#undef TRRD
}

template <class TIn, class TOut> struct BlockRef { const TIn* Q; const TIn* K; const TIn* V; TOut* O; int P0; };
template <class TIn> struct Seam {
    bf16x8 qr[8];
    bf16x8 st_v0, st_v1, st_k0, st_k1; f32x4 sf0, sf1, sf2, sf3;
    f32x4 tq[16];
};
__device__ __forceinline__ int swa_jlo(int P0, int W) { const int lowk = P0 - W + 1; return lowk > 0 ? lowk / KVBLK : 0; }
#define ROW(p, k0, rr) ((p) + (size_t)((k0) + (rr)) * LDP + sc)
#define VMW() asm volatile("s_waitcnt vmcnt(0)" ::: "memory")
#define VMWN(n) asm volatile("s_waitcnt vmcnt(%0)" :: "i"(n) : "memory")
#define SLOAD_H(Kp, Vp, k0) do { S.st_v0 = load8<TIn>(ROW(Vp, k0, sr)); S.st_v1 = load8<TIn>(ROW(Vp, k0, 32 + sr));              \
                         S.st_k0 = load8<TIn>(ROW(Kp, k0, sr)); S.st_k1 = load8<TIn>(ROW(Kp, k0, 32 + sr)); } while (0)
#define SWRITE_HK(bf) do { *(bf16x8*)(K_lds + (bf) * SHM_K + kws) = S.st_k0; *(bf16x8*)(K_lds + (bf) * SHM_K + kws + 32 * 256) = S.st_k1; } while (0)
#define SWRITE_HV(bf) do { *(bf16x8*)(V_lds + (bf) * SHM_V + vst0) = S.st_v0; *(bf16x8*)(V_lds + (bf) * SHM_V + vst1) = S.st_v1; } while (0)
#define SWRITE_H(bf) do { SWRITE_HV(bf); SWRITE_HK(bf); } while (0)
#define SLOAD_F(p, k0) do { S.sf0 = *(const f32x4*)ROW(p, k0, sr); S.sf1 = *(const f32x4*)(ROW(p, k0, sr) + 4);                \
                            S.sf2 = *(const f32x4*)ROW(p, k0, 32 + sr); S.sf3 = *(const f32x4*)(ROW(p, k0, 32 + sr) + 4); } while (0)
#define SWRITE_KF(bf) do { *(bf16x8*)(K_lds + (bf) * SHM_K + kws) = pack8(S.sf0, S.sf1); *(bf16x8*)(K_lds + (bf) * SHM_K + kws + 32 * 256) = pack8(S.sf2, S.sf3); } while (0)
#define SWRITE_VF(bf) do { *(bf16x8*)(V_lds + (bf) * SHM_V + vst0) = pack8(S.sf0, S.sf1); *(bf16x8*)(V_lds + (bf) * SHM_V + vst1) = pack8(S.sf2, S.sf3); } while (0)
template <class TIn, class TOut>
__device__ __forceinline__ void causal_swa_prime(const BlockRef<TIn, TOut>& cur, int W, char* lds, Seam<TIn>& S, const int mk_wave) {
    constexpr bool F32 = same_t<TIn, float>::v;
    const int lane = (int)(__builtin_amdgcn_mbcnt_hi(~0u, __builtin_amdgcn_mbcnt_lo(~0u, 0u)) & 63u), wid = mk_wave & 7, tid = wid * 64 + lane, r32 = lane & 31, hi = lane >> 5;
    const int sr = tid >> 4, sc = (tid & 15) * 8, kws = KSWZ(sr, sc * 2); char* K_lds = lds + 2 * SHM_V;
    const int kb0 = swa_jlo(cur.P0, W) * KVBLK;
    for (int d0 = 0; d0 < 8; ++d0) S.qr[d0] = load8<TIn>(cur.Q + (size_t)(wid * QBLK + r32) * LDP + d0 * 16 + hi * 8);
    if constexpr (F32) { SLOAD_F((const float*)cur.K, kb0); VMW(); SWRITE_KF(0); SBAR(); SLOAD_F((const float*)cur.V, kb0); }
    else { SLOAD_H(cur.K, cur.V, kb0); VMW(); SWRITE_HK(0); }
    __syncthreads();
}
template <class TIn, class TOut>
__device__ __forceinline__ void causal_swa_block(const BlockRef<TIn, TOut>& cur, const BlockRef<TIn, TOut>& nxt, int skv, int W, char* lds, Seam<TIn>& S, const int mk_wave) {
    constexpr bool F32 = same_t<TIn, float>::v;
    const int lane = (int)(__builtin_amdgcn_mbcnt_hi(~0u, __builtin_amdgcn_mbcnt_lo(~0u, 0u)) & 63u), wid = mk_wave & 7, tid = wid * 64 + lane, r32 = lane & 31, hi = lane >> 5;
    const int j_lo = swa_jlo(cur.P0, W);
    int j_hi = (cur.P0 + QB - 1) / KVBLK + 1; if (j_hi > skv / KVBLK) j_hi = skv / KVBLK;
    const int NT = j_hi - j_lo;
    const int kbn = swa_jlo(nxt.P0, W) * KVBLK;
    const int qlo = cur.P0 + wid * QBLK, qm = qlo + r32 - 4 * hi;
    char* V_lds = lds; char* K_lds = lds + 2 * SHM_V;
    float* ws = (float*)(lds + 2 * SHM_V + 2 * SHM_K) + wid * 64; float* li_l = ws, * al_l = ws + 32;
    float m_reg = -1e30f, l_reg = 0; f32x16 o[4] = {};
    const int sr = tid >> 4, sc = (tid & 15) * 8, vst0 = v_st(sr, sc), vst1 = v_st(32 + sr, sc), kws = KSWZ(sr, sc * 2);
    const int vb0 = (int)(uintptr_t)V_lds + v_rd_base(lane);
    const TIn* Kh = cur.K; const TIn* Vh = cur.V;
#define RESC(a) do { if (__any((a) < 1.f)) { if (hi == 0) al_l[r32] = (a); asm volatile("s_waitcnt lgkmcnt(0)" ::: "memory");              \
                     for (int d_ = 0; d_ < 4; ++d_) for (int r = 0; r < 16; ++r) o[d_][r] *= al_l[crow(r, hi)]; } } while (0)
#define KBASE(t) ((j_lo + (t)) * KVBLK)
#define ACT(t) (KBASE(t) <= qlo + QBLK - 1 && KBASE(t) + KVBLK - 1 >= qlo - W + 1)
#define MASKT(P0_, P1_, t) do { const int kb_ = KBASE(t); if ((!SK || ACT(t)) && (kb_ + KVBLK - 1 > qlo || kb_ <= qlo + QBLK - 1 - W)) mask_tile(P0_, P1_, qm - kb_, (unsigned)W); } while (0)
    constexpr int NQL = F32 ? 16 : 8;
    constexpr bool SK = WSKIP && !F32;
#define SEAM_K0() do { VMWN(NQL); if constexpr (F32) { SWRITE_KF(0); SBAR(); SLOAD_F((const float*)nxt.V, kbn); } else { SWRITE_HK(0); } SBAR(); } while (0)
    f32x16 pA0, pA1, pB0, pB1; float mnA, mnB, alA, alB; bf16x8 pa0, pa1, pa2, pa3;
    if constexpr (F32) { VMW(); SWRITE_VF(0); SBAR(); } else { SWRITE_HV(0); SBAR(); }
    if (NT > 1) { if constexpr (F32) SLOAD_F((const float*)Kh, KBASE(1)); else SLOAD_H(Kh, Vh, KBASE(1)); }
    SBAR(); qkt<0, SK>(pA0, pA1, K_lds, r32, hi, S.qr, ACT(0));
    if constexpr (F32) { if (NT > 1) { VMW(); SWRITE_KF(1); SBAR(); SLOAD_F((const float*)Vh, KBASE(1)); } }
    MASKT(pA0, pA1, 0); partialSM(pA0, pA1, m_reg, mnA, alA);
    if (NT > 1) { VMW(); if constexpr (F32) { SWRITE_VF(1); SBAR(); if (NT > 2) SLOAD_F((const float*)Kh, KBASE(2)); } else SWRITE_H(1); }
    __syncthreads();
#define HALF_STEP(PX0, PX1, mnX, alX, PY0, PY1, alY, t, KB, VB, SB) do {                                                      \
        SBAR(); qkt<KB, SK>(PX0, PX1, K_lds, r32, hi, S.qr, ACT(t));                                             \
        finishSM(PY0, PY1, alY, l_reg, pa0, pa1, pa2, pa3); SBAR();                                                           \
        if ((t) + 1 < NT) { if constexpr (F32) { VMW(); SWRITE_KF(SB); SBAR(); SLOAD_F((const float*)Vh, KBASE((t) + 1)); }  \
                            else { SLOAD_H(Kh, Vh, KBASE((t) + 1)); } SBAR(); }                                               \
        pv_tile<VB, SK>(o, vb0, pa0, pa1, pa2, pa3, ACT((t) - 1)); MASKT(PX0, PX1, (t)); partialSM(PX0, PX1, m_reg, mnX, alX);                                        \
        __syncthreads();                                                                                                      \
        if ((t) + 1 < NT) { VMW(); if constexpr (F32) { SWRITE_VF(SB); SBAR(); if ((t) + 2 < NT) SLOAD_F((const float*)Kh, KBASE((t) + 2)); } \
                            else { SWRITE_H(SB); } }                                                                          \
        RESC(alX); __syncthreads(); } while (0)
    for (int t = 1; t + 1 < NT; t += 2) {
        HALF_STEP(pB0, pB1, mnB, alB, pA0, pA1, alA, t, 1, 0, 0);
        HALF_STEP(pA0, pA1, mnA, alA, pB0, pB1, alB, t + 1, 0, 1, 1);
    }
    const bool even = (NT & 1) == 0;
    if (even) { SBAR(); qkt<1, SK>(pB0, pB1, K_lds, r32, hi, S.qr, ACT(NT - 1)); SBAR(); }
#define QROW(e) (nxt.Q + (size_t)(wid * QBLK + r32) * LDP + ((e) >> 1) * 16 + hi * 8 + ((e) & 1) * 4)
    if constexpr (F32) { SLOAD_F((const float*)nxt.K, kbn); SBAR();
#pragma unroll
        for (int e = 0; e < 8; ++e) S.tq[e] = *(const f32x4*)QROW(e); }
    else { SLOAD_H(nxt.K, nxt.V, kbn); SBAR();
#pragma unroll
        for (int d0 = 0; d0 < 8; ++d0) S.qr[d0] = load8<TIn>(nxt.Q + (size_t)(wid * QBLK + r32) * LDP + d0 * 16 + hi * 8); }
    SBAR();
    finishSM(pA0, pA1, alA, l_reg, pa0, pa1, pa2, pa3); SBAR();
    if constexpr (F32) {
#pragma unroll
        for (int e = 8; e < 16; ++e) S.tq[e] = *(const f32x4*)QROW(e); SBAR(); }
#undef QROW
    pv_tile<0, SK>(o, vb0, pa0, pa1, pa2, pa3, ACT(even ? NT - 2 : NT - 1));
    if (even) { MASKT(pB0, pB1, NT - 1); partialSM(pB0, pB1, m_reg, mnB, alB); __syncthreads(); RESC(alB);
        finishSM(pB0, pB1, alB, l_reg, pa0, pa1, pa2, pa3); SBAR(); pv_tile<1, SK>(o, vb0, pa0, pa1, pa2, pa3, ACT(NT - 1)); }
    SBAR(); SEAM_K0();
    if (hi == 0) li_l[r32] = l_reg; asm volatile("s_waitcnt lgkmcnt(0)" ::: "memory");
    float rli[16];
#pragma unroll
    for (int r = 0; r < 16; ++r) rli[r] = __builtin_amdgcn_rcpf(li_l[crow(r, hi)]);
    TOut* Ow = cur.O + (size_t)(wid * QBLK) * LDO;
#pragma unroll
    for (int r = 0; r < 16; ++r) { const int orow = crow(r, hi);
#pragma unroll
        for (int d0 = 0; d0 < 4; ++d0) { const float v = o[d0][r] * rli[r];
            if constexpr (same_t<TOut, float>::v) { Ow[(size_t)orow * LDO + d0 * 32 + r32] = v; }
            else { const float vn = __shfl_xor(v, 1);
                   if ((r32 & 1) == 0) *(unsigned*)(Ow + (size_t)orow * LDO + d0 * 32 + r32) = cvtpk(v, vn); } } }
    if constexpr (F32) {
#pragma unroll
        for (int d0 = 0; d0 < 8; ++d0) S.qr[d0] = pack8(S.tq[2 * d0], S.tq[2 * d0 + 1]); }
    __syncthreads();
#undef RESC
#undef KBASE
#undef ACT
#undef MASKT
#undef SEAM_K0
#undef HALF_STEP
}
#undef ROW
#undef VMW
#undef VMWN
#undef SLOAD_H
#undef SWRITE_HK
#undef SWRITE_HV
#undef SWRITE_H
#undef SLOAD_F
#undef SWRITE_KF
#undef SWRITE_VF

constexpr int A2_V = 0;
constexpr int A2_K = 4 * SHM_V;
constexpr int A2_X = A2_K + 2 * SHM_K;
constexpr int A2_XS = 4096 + 512;
constexpr int A2_LDS = A2_X + 4 * A2_XS;
struct A2Ref { const bf16* Q; const bf16* K; const bf16* V0; const bf16* V1; bf16* O; int P0; };

__device__ __forceinline__ void attn2_block(const A2Ref& c, char* lds, const int mk_wave) {
    const int lane = (int)(__builtin_amdgcn_mbcnt_hi(~0u, __builtin_amdgcn_mbcnt_lo(~0u, 0u)) & 63u), wid = mk_wave & 7, tid = wid * 64 + lane, r32 = lane & 31, hi = lane >> 5, rg = wid & 3, vh = wid >> 2;
    char* V_lds = lds + A2_V; char* K_lds = lds + A2_K; char* X = lds + A2_X + rg * A2_XS;
    float* XA = (float*)(X + 4096); float* XM = XA + 32; float* XL = XA + 64;
    const int NT = (c.P0 + 127) / 64 + 1;
    const int qlo = c.P0 + rg * 32, qm = qlo + r32 - 4 * hi;
    const int sr = tid >> 4, sc = (tid & 15) * 8, vst0 = v_st(sr, sc), vst1 = v_st(32 + sr, sc), kws = KSWZ(sr, sc * 2);
    const int vb0 = (int)(uintptr_t)V_lds + vh * SHM_V + v_rd_base(lane);
    bf16x8 qr[8];
#pragma unroll
    for (int d0 = 0; d0 < 8; ++d0) qr[d0] = load8<bf16>(c.Q + (size_t)(rg * 32 + r32) * 128 + d0 * 16 + hi * 8);
    float m_reg = -1e30f, l_reg = 0.f; f32x16 o[4] = {};
    bf16x8 sk0, sk1, sa0, sa1, sb0, sb1;
#define A2_LOAD(kb) do { const size_t ro_ = (size_t)((kb) + sr) * 128 + sc; sk0 = load8<bf16>(c.K + ro_); sk1 = load8<bf16>(c.K + ro_ + 32 * 128); \
        sa0 = load8<bf16>(c.V0 + ro_); sa1 = load8<bf16>(c.V0 + ro_ + 32 * 128); sb0 = load8<bf16>(c.V1 + ro_); sb1 = load8<bf16>(c.V1 + ro_ + 32 * 128); } while (0)
#define A2_WRITE(buf) do { *(bf16x8*)(K_lds + (buf) * SHM_K + kws) = sk0; *(bf16x8*)(K_lds + (buf) * SHM_K + kws + 32 * 256) = sk1; \
        *(bf16x8*)(V_lds + (buf) * 2 * SHM_V + vst0) = sa0; *(bf16x8*)(V_lds + (buf) * 2 * SHM_V + vst1) = sa1; \
        *(bf16x8*)(V_lds + (buf) * 2 * SHM_V + SHM_V + vst0) = sb0; *(bf16x8*)(V_lds + (buf) * 2 * SHM_V + SHM_V + vst1) = sb1; } while (0)
#define A2_VMW() asm volatile("s_waitcnt vmcnt(0)" ::: "memory")
#define A2_STEP(t, B) do { const bool more_ = (t) + 1 < NT; if (more_) A2_LOAD(((t) + 1) * 64); \
        bf16x8 pa0, pa1, pa2, pa3; \
        if (vh == (B)) { f32x16 p0, p1; float mn, alpha; \
            qkt<(B), false>(p0, p1, K_lds, r32, hi, qr, true); \
            if (64 * (t) + 63 > qlo) mask_tile(p0, p1, qm - 64 * (t), 16384u); \
            partialSM(p0, p1, m_reg, mn, alpha); finishSM(p0, p1, alpha, l_reg, pa0, pa1, pa2, pa3); \
            *(bf16x8*)(X + lane * 16) = pa0; *(bf16x8*)(X + 1024 + lane * 16) = pa1; *(bf16x8*)(X + 2048 + lane * 16) = pa2; *(bf16x8*)(X + 3072 + lane * 16) = pa3; \
            if (hi == 0) { XA[r32] = alpha; XM[r32] = m_reg; XL[r32] = l_reg; } } \
        __syncthreads(); \
        if (vh != (B)) { pa0 = *(const bf16x8*)(X + lane * 16); pa1 = *(const bf16x8*)(X + 1024 + lane * 16); pa2 = *(const bf16x8*)(X + 2048 + lane * 16); pa3 = *(const bf16x8*)(X + 3072 + lane * 16); \
            m_reg = XM[r32]; l_reg = XL[r32]; } \
        { const float a_ = XA[r32]; if (__any(a_ < 1.f)) { \
            _Pragma("unroll") for (int d_ = 0; d_ < 4; ++d_) _Pragma("unroll") for (int r = 0; r < 16; ++r) o[d_][r] *= XA[crow(r, hi)]; } } \
        pv_tile<2 * (B), false>(o, vb0, pa0, pa1, pa2, pa3, true); \
        if (more_) { A2_VMW(); A2_WRITE((B) ^ 1); } \
        __syncthreads(); } while (0)
    A2_LOAD(0); A2_VMW(); A2_WRITE(0); __syncthreads();
    for (int t = 0; t < NT; t += 2) { A2_STEP(t, 0); A2_STEP(t + 1, 1); }
    float rli[16];
#pragma unroll
    for (int r = 0; r < 16; ++r) rli[r] = __builtin_amdgcn_rcpf(XL[crow(r, hi)]);
    bf16* Ow = c.O + (size_t)(rg * 32) * LDO + vh * 128;
#pragma unroll
    for (int r = 0; r < 16; ++r) { const int orow = crow(r, hi);
#pragma unroll
        for (int d0 = 0; d0 < 4; ++d0) { const float v = o[d0][r] * rli[r]; const float vn = __shfl_xor(v, 1);
            if ((r32 & 1) == 0) *(unsigned*)(Ow + (size_t)orow * LDO + d0 * 32 + r32) = cvtpk(v, vn); } }
    __syncthreads();
#undef A2_LOAD
#undef A2_WRITE
#undef A2_VMW
#undef A2_STEP
}

constexpr int A3_XS = 4096 + 2 * 384;
constexpr int A3_LDS = A2_X + 4 * A3_XS;
__device__ __forceinline__ void attn3_block(const A2Ref& c, char* lds, const int mk_wave) {
    int lane_ = (int)(__builtin_amdgcn_mbcnt_hi(~0u, __builtin_amdgcn_mbcnt_lo(~0u, 0u)) & 63u); asm volatile("" : "+v"(lane_));
    const int lane = lane_ & 63, wid = mk_wave & 7, tid = wid * 64 + lane, r32 = lane & 31, hi = lane >> 5, rg = wid & 3, vh = wid >> 2;
    char* V_lds = lds + A2_V; char* K_lds = lds + A2_K; char* X = lds + A2_X + rg * A3_XS;
    float* XS = (float*)(X + 4096);
    const int NT = (c.P0 + 127) / 64 + 1;
    const int qlo = c.P0 + rg * 32, qm = qlo + r32 - 4 * hi;
    const int sr = tid >> 4, sc = (tid & 15) * 8, vst0 = v_st(sr, sc), vst1 = v_st(32 + sr, sc), kws = KSWZ(sr, sc * 2);
    const int vb0 = (int)(uintptr_t)V_lds + vh * SHM_V + v_rd_base(lane);
    bf16x8 qr[8];
#pragma unroll
    for (int d0 = 0; d0 < 8; ++d0) qr[d0] = load8<bf16>(c.Q + (size_t)(rg * 32 + r32) * 128 + d0 * 16 + hi * 8);
    float m_reg = -1e30f, l_reg = 0.f; f32x16 o[4] = {};
    bf16x8 sk0, sk1, sa0, sa1, sb0, sb1, pa0, pa1, pa2, pa3;
    const unsigned so = (unsigned)(sr * 128 + sc) * 2u;
#define A3_G(base, kb, rows) (*(const bf16x8*)((const char*)((base) + (size_t)((kb) + (rows)) * 128) + so))
#define A3_LOADK(kb) do { sk0 = A3_G(c.K, kb, 0); sk1 = A3_G(c.K, kb, 32); } while (0)
#define A3_LOADV(kb) do { sa0 = A3_G(c.V0, kb, 0); sa1 = A3_G(c.V0, kb, 32); sb0 = A3_G(c.V1, kb, 0); sb1 = A3_G(c.V1, kb, 32); } while (0)
#define A3_WRITEK(buf) do { *(bf16x8*)(K_lds + (buf) * SHM_K + kws) = sk0; *(bf16x8*)(K_lds + (buf) * SHM_K + kws + 32 * 256) = sk1; } while (0)
#define A3_WRITEV(buf) do { *(bf16x8*)(V_lds + (buf) * 2 * SHM_V + vst0) = sa0; *(bf16x8*)(V_lds + (buf) * 2 * SHM_V + vst1) = sa1; \
        *(bf16x8*)(V_lds + (buf) * 2 * SHM_V + SHM_V + vst0) = sb0; *(bf16x8*)(V_lds + (buf) * 2 * SHM_V + SHM_V + vst1) = sb1; } while (0)
#define A3_VMW() asm volatile("s_waitcnt vmcnt(0)" ::: "memory")
#define A3_SOFTMAX_PUBLISH(T, PS) do { float mn_, alpha_; \
        if (64 * (T) + 63 > qlo) mask_tile(p0, p1, qm - 64 * (T), 16384u); \
        partialSM(p0, p1, m_reg, mn_, alpha_); finishSM(p0, p1, alpha_, l_reg, pa0, pa1, pa2, pa3); \
        *(bf16x8*)(X + lane * 16) = pa0; *(bf16x8*)(X + 1024 + lane * 16) = pa1; *(bf16x8*)(X + 2048 + lane * 16) = pa2; *(bf16x8*)(X + 3072 + lane * 16) = pa3; \
        if (hi == 0) { XS[(PS) * 96 + r32] = alpha_; XS[(PS) * 96 + 32 + r32] = m_reg; XS[(PS) * 96 + 64 + r32] = l_reg; } } while (0)
    A3_LOADK(0); A3_LOADV(0); A3_VMW(); A3_WRITEK(0); A3_WRITEV(0); A3_LOADK(64); A3_VMW(); A3_WRITEK(1);
    __syncthreads();
    if (vh == 0) { f32x16 p0, p1; qkt<0, false>(p0, p1, K_lds, r32, hi, qr, true); A3_SOFTMAX_PUBLISH(0, 0); }
    __syncthreads();
#define A3_STEP(t, B) do { const bool more1_ = (t) + 1 < NT, more2_ = (t) + 2 < NT; \
        f32x16 p0, p1; \
        if (vh != (B) && more1_) { qkt<(B) ^ 1, false>(p0, p1, K_lds, r32, hi, qr, true); } \
        SBAR(); \
        if (more2_) A3_LOADK(((t) + 2) * 64); if (more1_) A3_LOADV(((t) + 1) * 64); \
        if (vh != (B)) { pa0 = *(const bf16x8*)(X + lane * 16); pa1 = *(const bf16x8*)(X + 1024 + lane * 16); pa2 = *(const bf16x8*)(X + 2048 + lane * 16); pa3 = *(const bf16x8*)(X + 3072 + lane * 16); \
            m_reg = XS[(B) * 96 + 32 + r32]; l_reg = XS[(B) * 96 + 64 + r32]; } \
        { const float a_ = XS[(B) * 96 + r32]; if (__any(a_ < 1.f)) { \
            _Pragma("unroll") for (int d_ = 0; d_ < 4; ++d_) _Pragma("unroll") for (int r = 0; r < 16; ++r) o[d_][r] *= XS[(B) * 96 + crow(r, hi)]; } } \
        pv_tile<2 * (B), false>(o, vb0, pa0, pa1, pa2, pa3, true); \
        SBAR(); \
        if (vh != (B) && more1_) A3_SOFTMAX_PUBLISH((t) + 1, (B) ^ 1); \
        if (more1_) { A3_VMW(); if (more2_) A3_WRITEK(B); A3_WRITEV((B) ^ 1); } \
        __syncthreads(); } while (0)
    for (int t = 0; t < NT; t += 2) { A3_STEP(t, 0); A3_STEP(t + 1, 1); }
    float rli[16];
#pragma unroll
    for (int r = 0; r < 16; ++r) rli[r] = __builtin_amdgcn_rcpf(XS[96 + 64 + crow(r, hi)]);
    bf16* Ow = c.O + (size_t)(rg * 32) * LDO + vh * 128;
#pragma unroll
    for (int r = 0; r < 16; ++r) { const int orow = crow(r, hi);
#pragma unroll
        for (int d0 = 0; d0 < 4; ++d0) { const float v = o[d0][r] * rli[r]; const float vn = __shfl_xor(v, 1);
            if ((r32 & 1) == 0) *(unsigned*)(Ow + (size_t)orow * LDO + d0 * 32 + r32) = cvtpk(v, vn); } }
    __syncthreads();
#undef A3_G
#undef A3_LOADK
#undef A3_LOADV
#undef A3_WRITEK
#undef A3_WRITEV
#undef A3_VMW
#undef A3_SOFTMAX_PUBLISH
#undef A3_STEP
}

constexpr int A4_XS = 4096 + 512;
constexpr int A4_AL = A2_X + 4 * A4_XS;
constexpr int A4_LDS = A4_AL + 8 * 128;
__device__ __forceinline__ void attn4_block(const A2Ref& c, char* lds, const int mk_wave) {
    int lane_ = (int)(__builtin_amdgcn_mbcnt_hi(~0u, __builtin_amdgcn_mbcnt_lo(~0u, 0u)) & 63u); asm volatile("" : "+v"(lane_));
    const int lane = lane_ & 63, wid = mk_wave & 7, tid = wid * 64 + lane, r32 = lane & 31, hi = lane >> 5, rg = wid & 3, vh = wid >> 2;
    char* V_lds = lds + A2_V; char* K_lds = lds + A2_K; char* X = lds + A2_X + rg * A4_XS;
    float* XM = (float*)(X + 4096); float* XL = XM + 64; float* AL = (float*)(lds + A4_AL + wid * 128);
    const int NT = (c.P0 + 127) / 64 + 1;
    const int qlo = c.P0 + rg * 32, qm = qlo + r32 - 4 * hi;
    const int sr = tid >> 4, sc = (tid & 15) * 8, vst0 = v_st(sr, sc), vst1 = v_st(32 + sr, sc), kws = KSWZ(sr, sc * 2);
    const unsigned so = (unsigned)(sr * 128 + sc) * 2u;
    const int vb0 = (int)(uintptr_t)V_lds + vh * SHM_V + v_rd_base(lane);
    bf16x8 qr[8];
#pragma unroll
    for (int d0 = 0; d0 < 8; ++d0) qr[d0] = load8<bf16>(c.Q + (size_t)(rg * 32 + r32) * 128 + d0 * 16 + hi * 8);
    float m_reg = -1e30f, l_reg = 0.f; f32x16 o[4] = {};
    bf16x8 sk0, sk1, sa0, sa1, sb0, sb1;
    constexpr float C2 = 1.4426950408889634f * SCALE;
#define A4_G(base, kb, rows) (*(const bf16x8*)((const char*)((base) + (size_t)((kb) + (rows)) * 128) + so))
#define A4_LOAD(kb) do { sk0 = A4_G(c.K, kb, 0); sk1 = A4_G(c.K, kb, 32); sa0 = A4_G(c.V0, kb, 0); sa1 = A4_G(c.V0, kb, 32); sb0 = A4_G(c.V1, kb, 0); sb1 = A4_G(c.V1, kb, 32); } while (0)
#define A4_WRITE(buf) do { *(bf16x8*)(K_lds + (buf) * SHM_K + kws) = sk0; *(bf16x8*)(K_lds + (buf) * SHM_K + kws + 32 * 256) = sk1; \
        *(bf16x8*)(V_lds + (buf) * 2 * SHM_V + vst0) = sa0; *(bf16x8*)(V_lds + (buf) * 2 * SHM_V + vst1) = sa1; \
        *(bf16x8*)(V_lds + (buf) * 2 * SHM_V + SHM_V + vst0) = sb0; *(bf16x8*)(V_lds + (buf) * 2 * SHM_V + SHM_V + vst1) = sb1; } while (0)
#define A4_VMW() asm volatile("s_waitcnt vmcnt(0)" ::: "memory")
#define A4_PK(P, B_, OUT) do { unsigned a0_ = cvtpk(P[B_+0], P[B_+1]), a1_ = cvtpk(P[B_+2], P[B_+3]), b0_ = cvtpk(P[B_+4], P[B_+5]), b1_ = cvtpk(P[B_+6], P[B_+7]); \
        auto r0_ = __builtin_amdgcn_permlane32_swap(a0_, b0_, false, false); auto r1_ = __builtin_amdgcn_permlane32_swap(a1_, b1_, false, false); \
        u32x4 w_ = {r0_[0], r1_[0], r0_[1], r1_[1]}; OUT = *reinterpret_cast<bf16x8*>(&w_); } while (0)
    A4_LOAD(0); A4_VMW(); A4_WRITE(0); A4_LOAD(64);
    __syncthreads();
#define A4_STEP(t, B) do { \
        f32x16 p = f32x16{}; \
        { const char* kb_[4]; \
          _Pragma("unroll") for (int dd = 0; dd < 4; ++dd) kb_[dd] = K_lds + (B) * SHM_K + vh * (32 * 256) + KSWZ(r32, (dd * 16 + hi * 8) * 2); \
          _Pragma("unroll") for (int d0 = 0; d0 < 8; ++d0) { const bf16x8 b_ = *reinterpret_cast<const bf16x8*>(kb_[d0 & 3] + (d0 >> 2) * 128); p = __builtin_amdgcn_mfma_f32_32x32x16_bf16(b_, qr[d0], p, 0, 0, 0); } } \
        if (64 * (t) + 32 * vh + 31 > qlo) { const int dq_ = qm - 64 * (t) - 32 * vh; \
            _Pragma("unroll") for (int r = 0; r < 16; ++r) { const int cc_ = (r & 3) + 8 * (r >> 2); if ((unsigned)(dq_ - cc_) >= 16384u) p[r] = -__builtin_inff(); } } \
        float pmax_ = p[0]; \
        _Pragma("unroll") for (int r = 1; r < 16; ++r) pmax_ = fmaxf(pmax_, p[r]); \
        { auto rr_ = __builtin_amdgcn_permlane32_swap(__float_as_uint(pmax_), __float_as_uint(pmax_), false, false); pmax_ = fmaxf(__uint_as_float(rr_[0]), __uint_as_float(rr_[1])); } \
        if (hi == 0) XM[vh * 32 + r32] = pmax_; \
        __syncthreads(); \
        if ((t) + 1 < NT) { A4_VMW(); A4_WRITE((B) ^ 1); if ((t) + 2 < NT) A4_LOAD(((t) + 2) * 64); } \
        pmax_ = fmaxf(pmax_, XM[(vh ^ 1) * 32 + r32]); \
        float mn_, alpha_; \
        if (__builtin_expect(__all((pmax_ - m_reg) * SCALE <= THR), 1)) { mn_ = m_reg; alpha_ = 1.f; } \
        else { mn_ = fmaxf(m_reg, pmax_); alpha_ = __builtin_amdgcn_exp2f((m_reg - mn_) * C2); m_reg = mn_; } \
        { const float mnL_ = -mn_ * C2; float ps_ = 0.f; \
          _Pragma("unroll") for (int r = 0; r < 16; ++r) { p[r] = __builtin_amdgcn_exp2f(fmaf(p[r], C2, mnL_)); ps_ += p[r]; } \
          auto rr_ = __builtin_amdgcn_permlane32_swap(__float_as_uint(ps_), __float_as_uint(ps_), false, false); ps_ = __uint_as_float(rr_[0]) + __uint_as_float(rr_[1]); \
          l_reg = l_reg * alpha_ + ps_; } \
        bf16x8 pa0, pa1, pa2, pa3, pm0_, pm1_; \
        A4_PK(p, 0, pm0_); A4_PK(p, 8, pm1_); \
        *(bf16x8*)(X + vh * 2048 + lane * 16) = pm0_; *(bf16x8*)(X + vh * 2048 + 1024 + lane * 16) = pm1_; \
        if (hi == 0) AL[r32] = alpha_; \
        __syncthreads(); \
        { const bf16x8 po0_ = *(const bf16x8*)(X + (vh ^ 1) * 2048 + lane * 16), po1_ = *(const bf16x8*)(X + (vh ^ 1) * 2048 + 1024 + lane * 16); \
          if (vh == 0) { pa0 = pm0_; pa1 = pm1_; pa2 = po0_; pa3 = po1_; } else { pa0 = po0_; pa1 = po1_; pa2 = pm0_; pa3 = pm1_; } } \
        if (__any(alpha_ < 1.f)) { \
            _Pragma("unroll") for (int d_ = 0; d_ < 4; ++d_) _Pragma("unroll") for (int r = 0; r < 16; ++r) o[d_][r] *= AL[crow(r, hi)]; } \
        pv_tile<2 * (B), false>(o, vb0, pa0, pa1, pa2, pa3, true); \
    } while (0)
    for (int t = 0; t < NT; t += 2) { A4_STEP(t, 0); A4_STEP(t + 1, 1); }
    if (hi == 0) XL[vh * 32 + r32] = l_reg;
    __syncthreads();
    float rli[16];
#pragma unroll
    for (int r = 0; r < 16; ++r) rli[r] = __builtin_amdgcn_rcpf(XL[crow(r, hi)] + XL[32 + crow(r, hi)]);
    bf16* Ow = c.O + (size_t)(rg * 32) * LDO + vh * 128;
#pragma unroll
    for (int r = 0; r < 16; ++r) { const int orow = crow(r, hi);
#pragma unroll
        for (int d0 = 0; d0 < 4; ++d0) { const float v = o[d0][r] * rli[r]; const float vn = __shfl_xor(v, 1);
            if ((r32 & 1) == 0) *(unsigned*)(Ow + (size_t)orow * LDO + d0 * 32 + r32) = cvtpk(v, vn); } }
    __syncthreads();
#undef A4_G
#undef A4_LOAD
#undef A4_WRITE
#undef A4_VMW
#undef A4_PK
#undef A4_STEP
}

__device__ __forceinline__ void attn5_block(const A2Ref& c, char* lds, const int mk_wave) {
    int lane_ = (int)(__builtin_amdgcn_mbcnt_hi(~0u, __builtin_amdgcn_mbcnt_lo(~0u, 0u)) & 63u); asm volatile("" : "+v"(lane_));
    const int lane = lane_ & 63, wid = mk_wave & 7, tid = wid * 64 + lane, r32 = lane & 31, hi = lane >> 5, rg = wid & 3, vh = wid >> 2;
    char* V_lds = lds + A2_V; char* K_lds = lds + A2_K; char* X = lds + A2_X + rg * A4_XS;
    float* XM = (float*)(X + 4096); float* XL = XM + 64; float* AL = (float*)(lds + A4_AL + wid * 128);
    const int NT = (c.P0 + 127) / 64 + 1;
    const int qlo = c.P0 + rg * 32, qm = qlo + r32 - 4 * hi;
    const int sr = tid >> 4, sc = (tid & 15) * 8, vst0 = v_st(sr, sc), vst1 = v_st(32 + sr, sc), kws = KSWZ(sr, sc * 2);
    const unsigned so = (unsigned)(sr * 128 + sc) * 2u;
    const int vb0 = (int)(uintptr_t)V_lds + vh * SHM_V + v_rd_base(lane);
    bf16x8 qr[8];
#pragma unroll
    for (int d0 = 0; d0 < 8; ++d0) qr[d0] = load8<bf16>(c.Q + (size_t)(rg * 32 + r32) * 128 + d0 * 16 + hi * 8);
    float m_reg = -1e30f, l_reg = 0.f; f32x16 o[4] = {};
    bf16x8 sk0, sk1, sa0, sa1, sb0, sb1;
    constexpr float C2 = 1.4426950408889634f * SCALE;
#define A4_G(base, kb, rows) (*(const bf16x8*)((const char*)((base) + (size_t)((kb) + (rows)) * 128) + so))
#define A4_LOAD(kb) do { sk0 = A4_G(c.K, kb, 0); sk1 = A4_G(c.K, kb, 32); sa0 = A4_G(c.V0, kb, 0); sa1 = A4_G(c.V0, kb, 32); sb0 = A4_G(c.V1, kb, 0); sb1 = A4_G(c.V1, kb, 32); } while (0)
#define A4_WRITE(buf) do { *(bf16x8*)(K_lds + (buf) * SHM_K + kws) = sk0; *(bf16x8*)(K_lds + (buf) * SHM_K + kws + 32 * 256) = sk1; \
        *(bf16x8*)(V_lds + (buf) * 2 * SHM_V + vst0) = sa0; *(bf16x8*)(V_lds + (buf) * 2 * SHM_V + vst1) = sa1; \
        *(bf16x8*)(V_lds + (buf) * 2 * SHM_V + SHM_V + vst0) = sb0; *(bf16x8*)(V_lds + (buf) * 2 * SHM_V + SHM_V + vst1) = sb1; } while (0)
#define A4_VMW() asm volatile("s_waitcnt vmcnt(0)" ::: "memory")
#define A4_PK(P, B_, OUT) do { unsigned a0_ = cvtpk(P[B_+0], P[B_+1]), a1_ = cvtpk(P[B_+2], P[B_+3]), b0_ = cvtpk(P[B_+4], P[B_+5]), b1_ = cvtpk(P[B_+6], P[B_+7]); \
        auto r0_ = __builtin_amdgcn_permlane32_swap(a0_, b0_, false, false); auto r1_ = __builtin_amdgcn_permlane32_swap(a1_, b1_, false, false); \
        u32x4 w_ = {r0_[0], r1_[0], r0_[1], r1_[1]}; OUT = *reinterpret_cast<bf16x8*>(&w_); } while (0)
#define A5_QK(T, KB) do { p = f32x16{}; \
        { const char* kb_[4]; \
          _Pragma("unroll") for (int dd = 0; dd < 4; ++dd) kb_[dd] = K_lds + (KB) * SHM_K + vh * (32 * 256) + KSWZ(r32, (dd * 16 + hi * 8) * 2); \
          _Pragma("unroll") for (int d0 = 0; d0 < 8; ++d0) { const bf16x8 b_ = *reinterpret_cast<const bf16x8*>(kb_[d0 & 3] + (d0 >> 2) * 128); p = __builtin_amdgcn_mfma_f32_32x32x16_bf16(b_, qr[d0], p, 0, 0, 0); } } } while (0)
#define A5_MAX(T) do { \
        if (64 * (T) + 32 * vh + 31 > qlo) { const int dq_ = qm - 64 * (T) - 32 * vh; \
            _Pragma("unroll") for (int r = 0; r < 16; ++r) { const int cc_ = (r & 3) + 8 * (r >> 2); if ((unsigned)(dq_ - cc_) >= 16384u) p[r] = -__builtin_inff(); } } \
        pmax_ = p[0]; \
        _Pragma("unroll") for (int r = 1; r < 16; ++r) pmax_ = fmaxf(pmax_, p[r]); \
        { auto rr_ = __builtin_amdgcn_permlane32_swap(__float_as_uint(pmax_), __float_as_uint(pmax_), false, false); pmax_ = fmaxf(__uint_as_float(rr_[0]), __uint_as_float(rr_[1])); } \
        if (hi == 0) XM[vh * 32 + r32] = pmax_; } while (0)
#define A5_SOFTMAX() do { \
        pmax_ = fmaxf(pmax_, XM[(vh ^ 1) * 32 + r32]); \
        float mn_; \
        if (__builtin_expect(__all((pmax_ - m_reg) * SCALE <= THR), 1)) { mn_ = m_reg; alpha_ = 1.f; } \
        else { mn_ = fmaxf(m_reg, pmax_); alpha_ = __builtin_amdgcn_exp2f((m_reg - mn_) * C2); m_reg = mn_; } \
        { const float mnL_ = -mn_ * C2; float ps_ = 0.f; \
          _Pragma("unroll") for (int r = 0; r < 16; ++r) { p[r] = __builtin_amdgcn_exp2f(fmaf(p[r], C2, mnL_)); ps_ += p[r]; } \
          auto rr_ = __builtin_amdgcn_permlane32_swap(__float_as_uint(ps_), __float_as_uint(ps_), false, false); ps_ = __uint_as_float(rr_[0]) + __uint_as_float(rr_[1]); \
          l_reg = l_reg * alpha_ + ps_; } \
        A4_PK(p, 0, pm0_); A4_PK(p, 8, pm1_); \
        *(bf16x8*)(X + vh * 2048 + lane * 16) = pm0_; *(bf16x8*)(X + vh * 2048 + 1024 + lane * 16) = pm1_; \
        if (hi == 0) AL[r32] = alpha_; } while (0)
    f32x16 p; float pmax_, alpha_ = 1.f; bf16x8 pm0_, pm1_;
    A4_LOAD(0); A4_VMW(); A4_WRITE(0); A4_LOAD(64); A4_VMW(); A4_WRITE(1); if (2 < NT) A4_LOAD(128);
    __syncthreads();
    A5_QK(0, 0); A5_MAX(0);
    __syncthreads();
    A5_SOFTMAX();
    __syncthreads();
#define A5_STEP(t, B) do { \
        bf16x8 pa0, pa1, pa2, pa3; \
        { const bf16x8 po0_ = *(const bf16x8*)(X + (vh ^ 1) * 2048 + lane * 16), po1_ = *(const bf16x8*)(X + (vh ^ 1) * 2048 + 1024 + lane * 16); \
          if (vh == 0) { pa0 = pm0_; pa1 = pm1_; pa2 = po0_; pa3 = po1_; } else { pa0 = po0_; pa1 = po1_; pa2 = pm0_; pa3 = pm1_; } } \
        const bool more1_ = (t) + 1 < NT; \
        if (more1_) A5_QK((t) + 1, (B) ^ 1); \
        if (__any(alpha_ < 1.f)) { \
            _Pragma("unroll") for (int d_ = 0; d_ < 4; ++d_) _Pragma("unroll") for (int r = 0; r < 16; ++r) o[d_][r] *= AL[crow(r, hi)]; } \
        pv_tile<2 * (B), false>(o, vb0, pa0, pa1, pa2, pa3, true); \
        if (more1_) { A5_MAX((t) + 1); \
            __syncthreads(); \
            if ((t) + 2 < NT) { A4_VMW(); A4_WRITE(B); if ((t) + 3 < NT) A4_LOAD(((t) + 3) * 64); } \
            A5_SOFTMAX(); \
            __syncthreads(); } \
    } while (0)
    for (int t = 0; t < NT; t += 2) { A5_STEP(t, 0); A5_STEP(t + 1, 1); }
    __syncthreads();
    if (hi == 0) XL[vh * 32 + r32] = l_reg;
    __syncthreads();
    float rli[16];
#pragma unroll
    for (int r = 0; r < 16; ++r) rli[r] = __builtin_amdgcn_rcpf(XL[crow(r, hi)] + XL[32 + crow(r, hi)]);
    bf16* Ow = c.O + (size_t)(rg * 32) * LDO + vh * 128;
#pragma unroll
    for (int r = 0; r < 16; ++r) { const int orow = crow(r, hi);
#pragma unroll
        for (int d0 = 0; d0 < 4; ++d0) { const float v = o[d0][r] * rli[r]; const float vn = __shfl_xor(v, 1);
            if ((r32 & 1) == 0) *(unsigned*)(Ow + (size_t)orow * LDO + d0 * 32 + r32) = cvtpk(v, vn); } }
    __syncthreads();
#undef A4_G
#undef A4_LOAD
#undef A4_WRITE
#undef A4_VMW
#undef A4_PK
#undef A5_QK
#undef A5_MAX
#undef A5_SOFTMAX
#undef A5_STEP
}

}

constexpr int S_ = 16384, DM = 2048, FF = 5632, NIN = 6152, NINP = 6144, PLD = 3072;
constexpr int NWAVES = 8, NTHR = 512;
constexpr int C_MQ = 0, C_MK = 512, C_MV = 1024, C_MO = 2048;
constexpr size_t MiB = 1u << 20, KiB = 1u << 10;
constexpr size_t WS_ROWSS1 = 0, WS_ROWSS2 = 64 * KiB, WS_SC = 192 * KiB  , WS_DN = 256 * KiB, WS_GATES = 512 * KiB;
constexpr size_t WS_BAR = 128 * KiB;
constexpr size_t WS_WGU = 1 * MiB, WS_WD = 45 * MiB, WS_WIN = 67 * MiB, WS_WOUT = 92 * MiB;
constexpr size_t WS_XN = 100 * MiB;
constexpr size_t WS_BIG = 164 * MiB;
constexpr size_t WS_Y = 356 * MiB;
constexpr size_t WS_CT = 420 * MiB;
constexpr size_t WS_QC = 452 * MiB, WS_KC = 468 * MiB;
constexpr size_t WS_NST = 484 * MiB;
constexpr size_t WS_GW = 484 * MiB + 512 * KiB;
constexpr size_t WS_END = 485 * MiB;
constexpr int LDS_BYTES = 147456;

#define LAS __attribute__((address_space(3)))
typedef unsigned short bfu;
typedef unsigned v4u __attribute__((ext_vector_type(4)));
typedef unsigned v2u __attribute__((ext_vector_type(2)));
typedef float f32x4 __attribute__((ext_vector_type(4)));
typedef short bf16x8 __attribute__((ext_vector_type(8)));
#define MFMA16(a, b, c) __builtin_amdgcn_mfma_f32_16x16x32_bf16(a, b, c, 0, 0, 0)
#define LDS_WAIT() asm volatile("s_waitcnt lgkmcnt(0)" ::: "memory")
__device__ __forceinline__ unsigned f2bf(float f) { unsigned u = __builtin_bit_cast(unsigned, f); return (u + 0x7fffu + ((u >> 16) & 1u)) >> 16; }
__device__ __forceinline__ unsigned pk2(float lo, float hi) { return f2bf(lo) | (f2bf(hi) << 16); }
__device__ __forceinline__ float bf2f(unsigned b) { return __builtin_bit_cast(float, b << 16); }
__device__ __forceinline__ int mk_lane() { return (int)(__builtin_amdgcn_mbcnt_hi(~0u, __builtin_amdgcn_mbcnt_lo(~0u, 0u)) & 63u); }
__device__ __forceinline__ float wave_sum(float v) {
#pragma unroll
    for (int o = 1; o < 64; o <<= 1) v += __shfl_xor(v, o);
    return v;
}
__device__ __forceinline__ float silu(float x) { return x / (1.0f + __expf(-x)); }

__device__ __forceinline__ void cvt_item(const float* __restrict__ W, int ldw, int ncols, const float* __restrict__ gain, bfu* WT, int K, int dst_row0, int k0, int n0, LAS float* scr, int lane) {
    const int nq = (lane & 15) * 4, kr = lane >> 4, n = n0 + nq;
#pragma unroll 8
    for (int i = 0; i < 16; ++i) { const int kk = 4 * i + kr; f32x4 v = (f32x4){0.f, 0.f, 0.f, 0.f};
        if (n < ncols) v = *(const f32x4*)(W + (size_t)(k0 + kk) * ldw + n);
        if (gain) v = v * gain[k0 + kk];
        LAS float* d = scr + kk * 65 + nq; d[0] = v[0]; d[1] = v[1]; d[2] = v[2]; d[3] = v[3]; }
    LDS_WAIT(); asm volatile("" ::: "memory");
    const int c = lane & 7;
#pragma unroll
    for (int j = 0; j < 8; ++j) { const int nn = (lane >> 3) + 8 * j; const LAS float* s = scr + (8 * c) * 65 + nn;
        v4u o; o.x = pk2(s[0 * 65], s[1 * 65]); o.y = pk2(s[2 * 65], s[3 * 65]); o.z = pk2(s[4 * 65], s[5 * 65]); o.w = pk2(s[6 * 65], s[7 * 65]);
        *(v4u*)(WT + (size_t)(dst_row0 + nn) * K + k0 + 8 * c) = o; }
    LDS_WAIT(); asm volatile("" ::: "memory");
}
__device__ __forceinline__ void cvt_ffn_item(int it, const float* wg, const float* wu, const float* wd, const float* gain, bfu* Wgu, bfu* Wd, LAS float* scr, int lane) {
    if (it < 2 * 2816) { const int up = it >= 2816; const int r = up ? it - 2816 : it; const int kb = r / 88, nb = r % 88, n0 = nb * 64;
        cvt_item(up ? wu : wg, FF, FF, gain, Wgu, DM, 256 * (n0 >> 7) + (n0 & 127) + (up ? 128 : 0), kb * 64, n0, scr, lane); }
    else { const int r = it - 2 * 2816; const int kb = r / 32, nb = r % 32; cvt_item(wd, DM, DM, nullptr, Wd, FF, nb * 64, kb * 64, nb * 64, scr, lane); }
}

constexpr int GWP = 4112;
__device__ __forceinline__ void gates_rows(LAS unsigned char* lds, const bfu* __restrict__ XB, const float* __restrict__ rowss, const float* __restrict__ b_i, const float* __restrict__ b_f, float* GATES, int rb, int wave, int lane) {
    const int fr = lane & 15, fq = lane >> 4, rg = wave & 3, kh = wave >> 2;
    const LAS unsigned char* wl = lds + 16384;
    const bfu* xp = XB + (size_t)(rb * 64 + rg * 16 + fr) * DM + kh * 1024 + 8 * fq;
    f32x4 acc = (f32x4){0.f, 0.f, 0.f, 0.f};
    for (int k0 = 0; k0 < 32; k0 += 16) {
        bf16x8 xa[16];
#pragma unroll
        for (int ks = 0; ks < 16; ++ks) xa[ks] = *(const bf16x8*)(xp + (k0 + ks) * 32);
#pragma unroll
        for (int ks = 0; ks < 16; ++ks) { const bf16x8 wb = *(const LAS bf16x8*)(wl + fr * GWP + (kh * 1024 + (k0 + ks) * 32 + 8 * fq) * 2); acc = MFMA16(xa[ks], wb, acc); }
    }
    LAS f32x4* red = (LAS f32x4*)lds;
    if (kh == 1) red[rg * 64 + lane] = acc;
    __syncthreads();
    if (kh == 0 && fr < 8) {
        const f32x4 o = red[rg * 64 + lane]; const float bias = fr < 4 ? b_i[fr] : b_f[fr - 4];
#pragma unroll
        for (int j = 0; j < 4; ++j) { const int row = rb * 64 + rg * 16 + 4 * fq + j;
            const float pre = (acc[j] + o[j]) / sqrtf(rowss[row] * (1.0f / DM) + 1e-6f) + bias; const float capped = 15.0f * tanhf(pre * (1.0f / 15.0f));
            GATES[(size_t)row * 8 + fr] = fr < 4 ? capped : -log1pf(expf(-capped)); }
    }
    __syncthreads();
}

#define XB_TMO      128
#define XB_XCNT(j)  (256  + 64 * (j))
#define XB_XSUB(j)  (1280 + 64 * (j))
#define XB_XGEN(j)  (2304 + 64 * (j))
#define XB_TOP      3328
#define XB_TOPGEN   3392
#define XCD_BAR_WORDS 3456
#define XB_SPIN_CAP (1u << 18)
__device__ __forceinline__ unsigned xb_ld(unsigned* p)              { return __hip_atomic_load(p, __ATOMIC_RELAXED, __HIP_MEMORY_SCOPE_AGENT); }
__device__ __forceinline__ unsigned xb_add(unsigned* p, unsigned v) { return __hip_atomic_fetch_add(p, v, __ATOMIC_RELAXED, __HIP_MEMORY_SCOPE_AGENT); }
__device__ __forceinline__ unsigned xb_xcc_id() { return (unsigned)__builtin_amdgcn_s_getreg((3 << 11) | 20) & 0xFu; }
#define XB_SPIN(cond, bar) do { unsigned _sp = 0; while (cond) { __builtin_amdgcn_s_sleep(1); \
    if ((++_sp & 255u) == 0u) { if (xb_ld(&(bar)[XB_TMO])) break; if (_sp > XB_SPIN_CAP) { atomicAdd(&(bar)[XB_TMO], 1u); break; } } } } while (0)
__device__ __forceinline__ void xcd_barrier_complete(unsigned* bar, unsigned x, unsigned& nloc, unsigned& nx) {
    const unsigned G = gridDim.x * gridDim.y * gridDim.z;
    unsigned sum, cnt, mine, sp = 0u;
    for (;;) {
        sum = 0u; cnt = 0u; mine = 0u;
#pragma unroll
        for (unsigned j = 0; j < 16; ++j) { const unsigned c = xb_ld(&bar[XB_XCNT(j)]); sum += c; cnt += (c > 0u) ? 1u : 0u; mine = (j == x) ? c : mine; }
        if (sum == G) break;
        __builtin_amdgcn_s_sleep(1);
        if ((++sp & 255u) == 0u) { if (xb_ld(&bar[XB_TMO])) break; if (sp > XB_SPIN_CAP) { atomicAdd(&bar[XB_TMO], 1u); break; } }
    }
    nloc = mine > 0u ? mine : 1u; nx = cnt > 0u ? cnt : 1u;
}
__device__ __forceinline__ void xcd_barrier(unsigned* bar, volatile LAS unsigned* st, const bool first) {
    asm volatile("s_waitcnt vmcnt(0)" ::: "memory");
    __syncthreads();
    if (first) {
        const unsigned x = xb_xcc_id();
        __builtin_amdgcn_s_waitcnt(0);
        unsigned nloc = st[0], nx = st[1];
        if (nloc == 0u) { xcd_barrier_complete(bar, x, nloc, nx); st[0] = nloc; st[1] = nx; }
        const unsigned old = xb_add(&bar[XB_XSUB(x)], 1u);
        const unsigned gen = old / nloc;
        if (old + 1u == (gen + 1u) * nloc) {
            __builtin_amdgcn_fence(__ATOMIC_RELEASE, "agent");
            asm volatile("s_waitcnt vmcnt(0)" ::: "memory");
            const unsigned og = xb_add(&bar[XB_TOP], 1u);
            const unsigned tg = og / nx;
            if (og + 1u == (tg + 1u) * nx) xb_add(&bar[XB_TOPGEN], 1u);
            else XB_SPIN(xb_ld(&bar[XB_TOPGEN]) == tg, bar);
            __builtin_amdgcn_fence(__ATOMIC_ACQUIRE, "agent");
            xb_add(&bar[XB_XGEN(x)], 1u);
            asm volatile("s_waitcnt vmcnt(0)" ::: "memory");
        } else {
            XB_SPIN(xb_ld(&bar[XB_XGEN(x)]) == gen, bar);
            __builtin_amdgcn_fence(__ATOMIC_ACQUIRE, "agent");
            asm volatile("s_waitcnt vmcnt(0)" ::: "memory");
        }
    }
    __syncthreads();
}

struct Args { const float* in[23]; float* out; unsigned char* ws; int ph_lo, ph_hi; };
constexpr int NPH = 12;

constexpr int MP = 272;

__device__ __forceinline__ void mlstm_stage_a(LAS unsigned char* lds, const bfu* __restrict__ PROJ, const float* __restrict__ GATES, const float* __restrict__ conv_w, const float* __restrict__ conv_b,
                                              bfu* QC, bfu* KC, float* DELTA, float* DN, float* SC, int item, const int mk_wave) {
    int lane = mk_lane(); asm volatile("" : "+v"(lane));
    const int wid = mk_wave & 7, tid = wid * 64 + lane, fr = lane & 15, fq = lane >> 4;
    const int h = item & 3, row0 = (item >> 2) * 128;
    LAS float* fa = (LAS float*)lds; LAS unsigned char* KT = lds + 4096; LAS unsigned char* VT = KT + 128 * MP;
    if (tid < 128) { fa[tid] = GATES[(size_t)(row0 + tid) * 8 + 4 + h]; fa[128 + tid] = GATES[(size_t)(row0 + tid) * 8 + h]; }
    __syncthreads();
    if (tid < 128) { float b = 0.f; for (int s = 0; s <= tid; ++s) b += fa[s]; fa[256 + tid] = fa[128 + tid] - b; if (tid == 127) fa[385] = b; }
    __syncthreads();
    if (wid == 0) { float a = fmaxf(fa[256 + lane], fa[320 + lane]);
#pragma unroll
        for (int o = 1; o < 64; o <<= 1) a = fmaxf(a, __shfl_xor(a, o));
        if (lane == 0) fa[384] = a; }
    __syncthreads();
    const float amax = fa[384], blast = fa[385];
    if (tid < 128) fa[tid] = __expf(fa[256 + tid] - amax);
    if (tid == 0) { SC[item] = blast + amax; SC[512 + item] = blast; }
    __syncthreads();
    for (int task = tid; task < 4096; task += NTHR) {
        const int isk = task >> 11, t2 = task & 2047, d = t2 & 127, s0 = (t2 >> 7) * 8, ch = isk * 512 + h * 128 + d;
        const float w0 = conv_w[ch], w1 = conv_w[1024 + ch], w2 = conv_w[2048 + ch], w3 = conv_w[3072 + ch], bias = conv_b[ch];
        float x[11];
#pragma unroll
        for (int i = 0; i < 11; ++i) { const int r = row0 + s0 - 3 + i; x[i] = r >= 0 ? bf2f(PROJ[(size_t)r * PLD + C_MQ + ch]) : 0.f; }
        float y[8];
#pragma unroll
        for (int i = 0; i < 8; ++i) y[i] = silu(bias + w0 * x[i] + w1 * x[i + 1] + w2 * x[i + 2] + w3 * x[i + 3]);
        if (!isk) {
#pragma unroll
            for (int i = 0; i < 8; ++i) QC[(size_t)(row0 + s0 + i) * 512 + h * 128 + d] = (bfu)f2bf(y[i] * 0.08838834764831845f);
        } else {
#pragma unroll
            for (int i = 0; i < 8; ++i) { KC[(size_t)(row0 + s0 + i) * 512 + h * 128 + d] = (bfu)f2bf(y[i]); y[i] *= fa[s0 + i]; }
            v4u o; o.x = pk2(y[0], y[1]); o.y = pk2(y[2], y[3]); o.z = pk2(y[4], y[5]); o.w = pk2(y[6], y[7]);
            *(LAS v4u*)(KT + d * MP + s0 * 2) = o;
        }
    }
    for (int task = tid; task < 4096; task += NTHR) {
        const int sidx = task & 127, e0 = (task >> 7) * 8;
        const v4u v = *(const v4u*)(PROJ + (size_t)(row0 + sidx) * PLD + C_MV + h * 256 + e0);
        LAS unsigned short* d = (LAS unsigned short*)(VT + e0 * MP + sidx * 2);
        d[0 * (MP / 2)] = (unsigned short)(v.x & 0xffffu); d[1 * (MP / 2)] = (unsigned short)(v.x >> 16); d[2 * (MP / 2)] = (unsigned short)(v.y & 0xffffu); d[3 * (MP / 2)] = (unsigned short)(v.y >> 16);
        d[4 * (MP / 2)] = (unsigned short)(v.z & 0xffffu); d[5 * (MP / 2)] = (unsigned short)(v.z >> 16); d[6 * (MP / 2)] = (unsigned short)(v.w & 0xffffu); d[7 * (MP / 2)] = (unsigned short)(v.w >> 16);
    }
    __syncthreads();
    f32x4 acc[2][8];
#pragma unroll
    for (int mt = 0; mt < 2; ++mt)
#pragma unroll
        for (int nt = 0; nt < 8; ++nt) acc[mt][nt] = (f32x4){0.f, 0.f, 0.f, 0.f};
#pragma unroll
    for (int ks = 0; ks < 4; ++ks) {
        bf16x8 a[2];
#pragma unroll
        for (int mt = 0; mt < 2; ++mt) a[mt] = *(const LAS bf16x8*)(VT + (32 * wid + 16 * mt + fr) * MP + (32 * ks + 8 * fq) * 2);
#pragma unroll
        for (int nt = 0; nt < 8; ++nt) { const bf16x8 b = *(const LAS bf16x8*)(KT + (16 * nt + fr) * MP + (32 * ks + 8 * fq) * 2);
            acc[0][nt] = MFMA16(a[0], b, acc[0][nt]); acc[1][nt] = MFMA16(a[1], b, acc[1][nt]); }
    }
    float* dst = DELTA + (size_t)item * 32768;
#pragma unroll
    for (int mt = 0; mt < 2; ++mt)
#pragma unroll
        for (int nt = 0; nt < 8; ++nt)
#pragma unroll
            for (int j = 0; j < 4; ++j) dst[(32 * wid + 16 * mt + 4 * fq + j) * 128 + 16 * nt + fr] = acc[mt][nt][j];
    if (tid < 128) { float s = 0.f; for (int i = 0; i < 128; ++i) s += bf2f(*(const LAS unsigned short*)(KT + tid * MP + i * 2)); DN[(size_t)item * 128 + tid] = s; }
    __syncthreads();
}

__device__ __forceinline__ void mlstm_scan(LAS unsigned char* lds, const float* __restrict__ DELTA, const float* __restrict__ DN, const float* __restrict__ SC, float* MPREV, bfu* __restrict__ CT, float* __restrict__ NST,
                                           int tid, int gtid, int nthreads) {
    LAS float* fdec = (LAS float*)lds; LAS float* fin = fdec + 512; LAS float* mpv = fdec + 1024;
    if (tid < 4) { float m = 0.f;
        for (int c = 0; c < 128; ++c) { const int item = c * 4 + tid; const float mloc = SC[item], bl = SC[512 + item], mn = fmaxf(bl + m, mloc);
            mpv[tid * 128 + c] = m; fdec[tid * 128 + c] = __expf(bl + m - mn); fin[tid * 128 + c] = __expf(mloc - mn); m = mn; } }
    __syncthreads();
    for (int idx = gtid; idx < 4 * 32768 + 512; idx += nthreads) {
        const bool main_ = idx < 4 * 32768;
        const int h = main_ ? (idx >> 15) : ((idx - 4 * 32768) >> 7), rem = main_ ? (idx & 32767) : ((idx - 4 * 32768) & 127);
        const float* src = main_ ? DELTA + (size_t)h * 32768 + rem : DN + h * 128 + rem; const size_t sstride = main_ ? 4 * 32768 : 512;
        float C = 0.f; float d8[8], e8[8];
#pragma unroll
        for (int i = 0; i < 8; ++i) d8[i] = src[(size_t)i * sstride];
        for (int c0 = 0; c0 < 128; c0 += 8) {
            if (c0 + 8 < 128) {
#pragma unroll
                for (int i = 0; i < 8; ++i) e8[i] = src[(size_t)(c0 + 8 + i) * sstride];
            }
#pragma unroll
            for (int i = 0; i < 8; ++i) { const int c = c0 + i, item = c * 4 + h;
                if (main_) { CT[(size_t)item * 32768 + rem] = (bfu)f2bf(C); if (rem == 0) MPREV[item] = mpv[h * 128 + c]; } else NST[(size_t)item * 128 + rem] = C;
                C = fdec[h * 128 + c] * C + fin[h * 128 + c] * d8[i]; }
#pragma unroll
            for (int i = 0; i < 8; ++i) d8[i] = e8[i];
        }
    }
    __syncthreads();
}

__device__ __forceinline__ void mlstm_stage_c(LAS unsigned char* lds, const bfu* __restrict__ PROJ, const float* __restrict__ GATES, const bfu* __restrict__ QC, const bfu* __restrict__ KC,
                                              const bfu* __restrict__ CT, const float* __restrict__ NST, const float* __restrict__ MPREV, const float* __restrict__ hgain, bfu* Y, int item, const int mk_wave) {
    int lane = mk_lane(); asm volatile("" : "+v"(lane));
    const int wid = mk_wave & 7, tid = wid * 64 + lane, fr = lane & 15, fq = lane >> 4;
    const int h = item & 3, row0 = (item >> 2) * 128;
    LAS float* fa = (LAS float*)lds;
    LAS unsigned char* Qs = lds + 4096; LAS unsigned char* Ks = Qs + 128 * MP; LAS unsigned char* BUF = Ks + 128 * MP;
    if (tid < 128) { fa[768 + tid] = GATES[(size_t)(row0 + tid) * 8 + 4 + h]; fa[896 + tid] = GATES[(size_t)(row0 + tid) * 8 + h]; fa[640 + tid] = NST[(size_t)item * 128 + tid]; }
    __syncthreads();
    float bt_ = 0.f;
    if (tid < 128) { for (int s = 0; s <= tid; ++s) bt_ += fa[768 + s]; fa[tid] = fa[896 + tid] - bt_; }
    __syncthreads();
    if (tid < 128) { const float mp = MPREV[item]; float pm = -3.0e38f; for (int s = 0; s <= tid; ++s) pm = fmaxf(pm, fa[s]);
        const float M = fmaxf(mp, pm); fa[128 + tid] = M; fa[256 + tid] = __expf(mp - M); fa[384 + tid] = __expf(-(bt_ + M)); }
    for (int t = tid; t < 2048; t += NTHR) { const int r = t >> 4, c = t & 15;
        *(LAS v4u*)(Qs + r * MP + c * 16) = *(const v4u*)(QC + (size_t)(row0 + r) * 512 + h * 128 + c * 8);
        *(LAS v4u*)(Ks + r * MP + c * 16) = *(const v4u*)(KC + (size_t)(row0 + r) * 512 + h * 128 + c * 8); }
    for (int t = tid; t < 4096; t += NTHR) { const int r = t >> 4, c = t & 15; *(LAS v4u*)(BUF + r * MP + c * 16) = *(const v4u*)(CT + (size_t)item * 32768 + r * 128 + c * 8); }
    __syncthreads();
    {
        const int t = 16 * wid + fr; float s = 0.f;
#pragma unroll
        for (int i = 0; i < 32; ++i) s += bf2f(*(const LAS unsigned short*)(Qs + t * MP + (32 * fq + i) * 2)) * fa[640 + 32 * fq + i];
        s += __shfl_xor(s, 16); s += __shfl_xor(s, 32); if (fq == 0) fa[512 + t] = s;
    }
    f32x4 sa[8];
#pragma unroll
    for (int nt = 0; nt < 8; ++nt) sa[nt] = (f32x4){0.f, 0.f, 0.f, 0.f};
    bf16x8 qa[4];
#pragma unroll
    for (int ks = 0; ks < 4; ++ks) qa[ks] = *(const LAS bf16x8*)(Qs + (16 * wid + fr) * MP + (32 * ks + 8 * fq) * 2);
#pragma unroll
    for (int nt = 0; nt < 8; ++nt) if (nt <= wid) {
#pragma unroll
        for (int ks = 0; ks < 4; ++ks) { const bf16x8 b = *(const LAS bf16x8*)(Ks + (16 * nt + fr) * MP + (32 * ks + 8 * fq) * 2); sa[nt] = MFMA16(qa[ks], b, sa[nt]); } }
    float Mt[4], rsum[4];
#pragma unroll
    for (int j = 0; j < 4; ++j) { Mt[j] = fa[128 + 16 * wid + 4 * fq + j]; rsum[j] = 0.f; }
#pragma unroll
    for (int nt = 0; nt < 8; ++nt) { const int s = 16 * nt + fr; const float as = fa[s];
#pragma unroll
        for (int j = 0; j < 4; ++j) { const int t = 16 * wid + 4 * fq + j; const float p = (s <= t) ? sa[nt][j] * __expf(as - Mt[j]) : 0.f; sa[nt][j] = p; rsum[j] += p; } }
#pragma unroll
    for (int j = 0; j < 4; ++j) { float v = rsum[j]; v += __shfl_xor(v, 1); v += __shfl_xor(v, 2); v += __shfl_xor(v, 4); v += __shfl_xor(v, 8); rsum[j] = v; }
    f32x4 num[16];
#pragma unroll
    for (int nt = 0; nt < 16; ++nt) num[nt] = (f32x4){0.f, 0.f, 0.f, 0.f};
#pragma unroll
    for (int ks = 0; ks < 4; ++ks)
#pragma unroll
        for (int nt = 0; nt < 16; ++nt) { const bf16x8 b = *(const LAS bf16x8*)(BUF + (16 * nt + fr) * MP + (32 * ks + 8 * fq) * 2); num[nt] = MFMA16(qa[ks], b, num[nt]); if ((nt & 3) == 3) __builtin_amdgcn_sched_barrier(0); }
    float g4[4], den[4];
#pragma unroll
    for (int j = 0; j < 4; ++j) { const int t = 16 * wid + 4 * fq + j; g4[j] = fa[256 + t]; den[j] = fmaxf(fabsf(g4[j] * fa[512 + t] + rsum[j]), fa[384 + t]); }
#pragma unroll
    for (int nt = 0; nt < 16; ++nt)
#pragma unroll
        for (int j = 0; j < 4; ++j) num[nt][j] *= g4[j];
    __syncthreads();
#pragma unroll
    for (int nt = 0; nt < 8; ++nt)
#pragma unroll
        for (int j = 0; j < 4; ++j) *(LAS unsigned short*)(Ks + (16 * wid + 4 * fq + j) * MP + (16 * nt + fr) * 2) = (unsigned short)f2bf(sa[nt][j]);
    for (int task = tid; task < 4096; task += NTHR) {
        const int sidx = task & 127, e0 = (task >> 7) * 8;
        const v4u v = *(const v4u*)(PROJ + (size_t)(row0 + sidx) * PLD + C_MV + h * 256 + e0);
        LAS unsigned short* d = (LAS unsigned short*)(BUF + e0 * MP + sidx * 2);
        d[0 * (MP / 2)] = (unsigned short)(v.x & 0xffffu); d[1 * (MP / 2)] = (unsigned short)(v.x >> 16); d[2 * (MP / 2)] = (unsigned short)(v.y & 0xffffu); d[3 * (MP / 2)] = (unsigned short)(v.y >> 16);
        d[4 * (MP / 2)] = (unsigned short)(v.z & 0xffffu); d[5 * (MP / 2)] = (unsigned short)(v.z >> 16); d[6 * (MP / 2)] = (unsigned short)(v.w & 0xffffu); d[7 * (MP / 2)] = (unsigned short)(v.w >> 16);
    }
    __syncthreads();
#pragma unroll
    for (int ks = 0; ks < 4; ++ks) { const bf16x8 pa = *(const LAS bf16x8*)(Ks + (16 * wid + fr) * MP + (32 * ks + 8 * fq) * 2);
#pragma unroll
        for (int nt = 0; nt < 16; ++nt) { const bf16x8 b = *(const LAS bf16x8*)(BUF + (16 * nt + fr) * MP + (32 * ks + 8 * fq) * 2); num[nt] = MFMA16(pa, b, num[nt]); if ((nt & 3) == 3) __builtin_amdgcn_sched_barrier(0); } }
    float ssq[4];
#pragma unroll
    for (int j = 0; j < 4; ++j) { const float rd = 1.0f / den[j]; float s = 0.f;
#pragma unroll
        for (int nt = 0; nt < 16; ++nt) { const float v = num[nt][j] * rd; num[nt][j] = v; s += v * v; }
        s += __shfl_xor(s, 1); s += __shfl_xor(s, 2); s += __shfl_xor(s, 4); s += __shfl_xor(s, 8); ssq[j] = 1.0f / sqrtf(s * (1.0f / 256.0f) + 1e-6f); }
    __syncthreads();
    LAS float* HS = (LAS float*)(lds + 4096);
#pragma unroll
    for (int nt = 0; nt < 16; ++nt)
#pragma unroll
        for (int j = 0; j < 4; ++j) HS[(16 * wid + 4 * fq + j) * 260 + 16 * nt + fr] = num[nt][j] * ssq[j];
    __syncthreads();
    for (int task = tid; task < 4096; task += NTHR) {
        const int r = task >> 5, c8 = (task & 31) * 8; const size_t row = (size_t)(row0 + r);
        const f32x4 h0 = *(const LAS f32x4*)(HS + r * 260 + c8), h1 = *(const LAS f32x4*)(HS + r * 260 + c8 + 4);
        const f32x4 g0 = *(const f32x4*)(hgain + h * 256 + c8), g1 = *(const f32x4*)(hgain + h * 256 + c8 + 4);
        const v4u mo = *(const v4u*)(PROJ + row * PLD + C_MO + h * 256 + c8);
        v4u o;
        o.x = pk2(h0[0] * g0[0] / (1.0f + __expf(-bf2f(mo.x & 0xffffu))), h0[1] * g0[1] / (1.0f + __expf(-bf2f(mo.x >> 16))));
        o.y = pk2(h0[2] * g0[2] / (1.0f + __expf(-bf2f(mo.y & 0xffffu))), h0[3] * g0[3] / (1.0f + __expf(-bf2f(mo.y >> 16))));
        o.z = pk2(h1[0] * g1[0] / (1.0f + __expf(-bf2f(mo.z & 0xffffu))), h1[1] * g1[1] / (1.0f + __expf(-bf2f(mo.z >> 16))));
        o.w = pk2(h1[2] * g1[2] / (1.0f + __expf(-bf2f(mo.w & 0xffffu))), h1[3] * g1[3] / (1.0f + __expf(-bf2f(mo.w >> 16))));
        *(v4u*)(Y + row * DM + 1024 + h * 256 + c8) = o;
    }
    __syncthreads();
}

__device__ __forceinline__ att::BlockRef<att::bf16, att::bf16> att_ref(int i, int pass, const bfu* PROJ, bfu* OATT) {
    int ph, x;
    if (gridDim.x == 256) { ph = ((i >> 8) & 1) * 8 + (blockIdx.x & 7); x = blockIdx.x >> 3; }
    else { ph = (i >> 5) & 15; x = i & 31; }
    const int qb = pass ? 63 - x : x, h = ph >> 2, c = (ph >> 1) & 1, vh = ph & 1;
    att::BlockRef<att::bf16, att::bf16> r;
    constexpr size_t MSZ = (size_t)16384 * 128;
    r.Q = (const att::bf16*)(PROJ + (size_t)(2 * h + c) * MSZ + (size_t)qb * 256 * 128);
    r.K = (const att::bf16*)(PROJ + (size_t)(8 + 2 * h + c) * MSZ);
    r.V = (const att::bf16*)(PROJ + (size_t)(16 + 2 * h + vh) * MSZ);
    r.O = (att::bf16*)(OATT + (size_t)qb * 256 * 2048 + h * 512 + c * 256 + vh * 128);
    r.P0 = qb * 256;
    return r;
}
__device__ __forceinline__ void attn_phase(char* lds, const bfu* PROJ, bfu* OATT, const int TOTAL, const int mk_wave) {
    using namespace att;
    int i = blockIdx.x; if (i >= TOTAL) return;
    int pass = 0;
    BlockRef<bf16, bf16> cur = att_ref(i, 0, PROJ, OATT);
    Seam<bf16> S;
    causal_swa_prime<bf16, bf16>(cur, S_, lds, S, mk_wave);
    for (;;) {
        const bool more_pass = pass == 0, more_item = i + (int)gridDim.x < TOTAL, last = !more_pass && !more_item;
        int in_ = i, passn = pass + 1;
        if (!more_pass) { passn = 0; in_ = more_item ? i + (int)gridDim.x : i; }
        const BlockRef<bf16, bf16> nxt = last ? cur : att_ref(in_, passn, PROJ, OATT);
        causal_swa_block<bf16, bf16>(cur, nxt, S_, S_, lds, S, mk_wave);
        if (last) break;
        cur = nxt; i = in_; pass = passn;
    }
}

#ifndef ATTN2
#define ATTN2 4
#endif
__device__ __forceinline__ att::A2Ref att2_ref(int i, int pass, const bfu* PROJ, bfu* OATT) {
    int hc, x;
    if (gridDim.x == 256) { hc = blockIdx.x & 7; x = ((i >> 8) & 1) * 32 + (blockIdx.x >> 3); }
    else { hc = (i >> 6) & 7; x = i & 63; }
    const int qb = pass ? 127 - x : x, h = hc >> 1, c = hc & 1;
    constexpr size_t MSZ = (size_t)16384 * 128;
    att::A2Ref r;
    r.Q = (const att::bf16*)(PROJ + (size_t)(2 * h + c) * MSZ + (size_t)qb * 128 * 128);
    r.K = (const att::bf16*)(PROJ + (size_t)(8 + 2 * h + c) * MSZ);
    r.V0 = (const att::bf16*)(PROJ + (size_t)(16 + 2 * h) * MSZ); r.V1 = (const att::bf16*)(PROJ + (size_t)(16 + 2 * h + 1) * MSZ);
    r.O = (att::bf16*)(OATT + (size_t)qb * 128 * 2048 + h * 512 + c * 256);
    r.P0 = qb * 128;
    return r;
}
__device__ __forceinline__ void attn2_phase(char* lds, const bfu* PROJ, bfu* OATT, const int TOTAL, const int mk_wave) {
    for (int i = blockIdx.x; i < TOTAL; i += gridDim.x)
        for (int pass = 0; pass < 2; ++pass) { const att::A2Ref r = att2_ref(i, pass, PROJ, OATT); if (ATTN2 == 4) att::attn5_block(r, lds, mk_wave); else if (ATTN2 == 3) att::attn4_block(r, lds, mk_wave); else if (ATTN2 == 2) att::attn3_block(r, lds, mk_wave); else att::attn2_block(r, lds, mk_wave); }
}

__global__ void __launch_bounds__(NTHR, 2) mega_fwd(Args args) {
    extern __shared__ __attribute__((aligned(16))) unsigned char lds_raw[];
    LAS unsigned char* lds = (LAS unsigned char*)lds_raw;
    const int wave = __builtin_amdgcn_readfirstlane((int)threadIdx.x >> 6);
    const int G = gridDim.x, gw = blockIdx.x * NWAVES + wave, NGW = G * NWAVES;
#define AS4 __attribute__((address_space(4)))
#define PH_BEGIN int koff_ = 0; asm volatile("" : "+s"(koff_)); const AS4 char* kp_ = (const AS4 char*)__builtin_amdgcn_kernarg_segment_ptr() + koff_; \
    unsigned char* ws = *(unsigned char* const AS4*)(kp_ + 192); float* out = *(float* const AS4*)(kp_ + 184); (void)out; (void)ws; const int lane = mk_lane(), tid = wave * 64 + lane; (void)tid; (void)lane;
#define KIN(i) (*(const float* const AS4*)(kp_ + 8 * (i)))
#define Wgu ((bfu*)(ws + WS_WGU))
#define Wd ((bfu*)(ws + WS_WD))
#define Win ((bfu*)(ws + WS_WIN))
#define Wout ((bfu*)(ws + WS_WOUT))
#define XN ((bfu*)(ws + WS_XN))
#define BIG ((bfu*)(ws + WS_BIG))
#define Y ((bfu*)(ws + WS_Y))
#define CT ((bfu*)(ws + WS_CT))
#define QC ((bfu*)(ws + WS_QC))
#define KC ((bfu*)(ws + WS_KC))
#define NST ((float*)(ws + WS_NST))
#define rowss1 ((float*)(ws + WS_ROWSS1))
#define rowss2 ((float*)(ws + WS_ROWSS2))
#define SC ((float*)(ws + WS_SC))
#define DN ((float*)(ws + WS_DN))
#define GATES ((float*)(ws + WS_GATES))
#define DELTA ((float*)(ws + WS_XN))
#define OATT ((bfu*)(ws + WS_XN))
#define PROJM (BIG + (size_t)24 * 16384 * 128)
    const int lo = args.ph_lo, hi = args.ph_hi;
    if (hi - lo > 1) {
        if (wave == 0 && mk_lane() == 0) { volatile LAS unsigned* st = (volatile LAS unsigned*)(lds + LDS_BYTES - 64); st[0] = 0u; st[1] = 0u;
            (void)xb_add(&((unsigned*)(args.ws + WS_BAR))[XB_XCNT(xb_xcc_id())], 1u); }
        __syncthreads();
    }
#ifndef PHMASK
#define PHMASK 0xfff
#endif
#define IN(k) (((PHMASK >> (k)) & 1) && lo <= (k) && (k) < hi)
#ifndef PROBE_MASK
#define PROBE_MASK 0
#endif
#define NREP(k) (((PROBE_MASK >> (k)) & 1) ? 2 : 1)
#define STAGGER_DELAY(N) do { const int sn_ = (int)((blockIdx.x >> 3) & 3) * (N); for (int sd_ = 0; sd_ < sn_; ++sd_) __builtin_amdgcn_s_sleep(85); } while (0)
#define SYNC(k) do { if (IN(k) && IN((k) + 1)) { if (lo < 0) cg::this_grid().sync();     \
        { int kb_ = 0; asm volatile("" : "+s"(kb_)); unsigned char* wsb_ = *(unsigned char* const AS4*)((const AS4 char*)__builtin_amdgcn_kernarg_segment_ptr() + kb_ + 192); \
               xcd_barrier((unsigned*)(wsb_ + WS_BAR), (volatile LAS unsigned*)(lds + LDS_BYTES - 64), wave == 0 && mk_lane() == 0); \
               if ((PROBE_MASK >> 14) & 1) xcd_barrier((unsigned*)(wsb_ + WS_BAR), (volatile LAS unsigned*)(lds + LDS_BYTES - 64), wave == 0 && mk_lane() == 0); } } } while (0)

    if (IN(0)) for (int rep_ = 0; rep_ < NREP(0); ++rep_) { PH_BEGIN
        const float* x = KIN(0);
        LAS float* scr = (LAS float*)(lds + wave * 16640);
        constexpr int I_FFN = 3 * 2816, I_IN = 32 * 96, I_OUT = 32 * 32;
        for (int it = gw; it < I_FFN + I_IN + I_OUT; it += NGW) {
            if (it < I_FFN) cvt_ffn_item(it, KIN(2), KIN(3), KIN(4), KIN(1), Wgu, Wd, scr, lane);
            else if (it < I_FFN + I_IN) { const int r = it - I_FFN, kb = r / 96, nb = r % 96; cvt_item(KIN(6), NIN, NIN, KIN(5), Win, DM, nb * 64, kb * 64, nb * 64, scr, lane); }
            else { const int r = it - I_FFN - I_IN, kb = r / 32, nb = r % 32; cvt_item(KIN(17), DM, DM, nullptr, Wout, DM, nb * 64, kb * 64, nb * 64, scr, lane); }
        }
        for (int m = gw; m < S_; m += NGW) {
            const f32x4* xr = (const f32x4*)(x + (size_t)m * DM) + lane; f32x4 v[8]; float s = 0.f;
#pragma unroll
            for (int j = 0; j < 8; ++j) { v[j] = xr[64 * j]; s += (v[j][0] * v[j][0] + v[j][1] * v[j][1]) + (v[j][2] * v[j][2] + v[j][3] * v[j][3]); }
            const float rs = 1.0f / sqrtf(wave_sum(s) * (1.0f / DM) + 1e-6f);
            v2u* o8 = (v2u*)(XN + (size_t)m * DM) + lane;
#pragma unroll
            for (int j = 0; j < 8; ++j) { v2u w; w.x = pk2(v[j][0] * rs, v[j][1] * rs); w.y = pk2(v[j][2] * rs, v[j][3] * rs); o8[64 * j] = w; }
        }
        for (int i = blockIdx.x * NTHR + tid; i < 2 * S_; i += G * NTHR) rowss1[i] = 0.f;
        for (int k = blockIdx.x * NTHR + tid; k < DM + 8; k += G * NTHR) {
            unsigned char* gwp = ws + WS_GW; f32x4 w0 = (f32x4){0.f, 0.f, 0.f, 0.f}, w1 = w0;
            if (k < DM) { const float gk = KIN(5)[k]; w0 = *(const f32x4*)(KIN(6) + (size_t)k * NIN + 6144) * gk; w1 = *(const f32x4*)(KIN(6) + (size_t)k * NIN + 6148) * gk; }
#pragma unroll
            for (int j = 0; j < 4; ++j) { *(unsigned short*)(gwp + j * GWP + k * 2) = (unsigned short)f2bf(w0[j]); *(unsigned short*)(gwp + (4 + j) * GWP + k * 2) = (unsigned short)f2bf(w1[j]);
                *(unsigned short*)(gwp + (8 + j) * GWP + k * 2) = 0; *(unsigned short*)(gwp + (12 + j) * GWP + k * 2) = 0; }
        }
    }
    SYNC(0);
    if (IN(1)) { PH_BEGIN
        pg8::Gemm g{XN, Wgu, S_, 2 * FF, DM}; pg8::StaticOrder So; So.init(S_, 2 * FF, G, (int)blockIdx.x);
        pg8::EpiSwiGLU E{BIG, FF, nullptr, 0.f};
        STAGGER_DELAY(1); for (int rep_ = 0; rep_ < NREP(1); ++rep_) pg8::gemm_phase<pg8::EpiSwiGLU, pg8::StaticOrder, true, true>(lds, g, So, E, wave);
    }
    SYNC(1);
    if (IN(2)) { PH_BEGIN
        pg8::Gemm g{BIG, Wd, S_, DM, FF}; pg8::StaticOrder So; So.init(S_, DM, G, (int)blockIdx.x);
        pg8::EpiResid E{KIN(0), out, XN, rowss1, 0.5f, DM};
        STAGGER_DELAY(3); pg8::gemm_phase<pg8::EpiResid, pg8::StaticOrder, true, true>(lds, g, So, E, wave);
    }
    SYNC(2);
    if (IN(3)) { PH_BEGIN
        pg8::Gemm g{XN, Win, S_, NINP, DM}; pg8::StaticOrder So; So.init(S_, NINP, G, (int)blockIdx.x);
        pg8::EpiProj E{BIG, rowss1, 1.0f / DM};
        STAGGER_DELAY(1); for (int rep_ = 0; rep_ < NREP(3); ++rep_) pg8::gemm_phase<pg8::EpiProj, pg8::StaticOrder, true, true>(lds, g, So, E, wave);
        {
            const v4u* src = (const v4u*)(ws + WS_GW);
            for (int i = tid; i < 16 * GWP / 16; i += NTHR) *(LAS v4u*)(lds + 16384 + i * 16) = src[i];
            __syncthreads();
        }
        for (int rep_ = 0; rep_ < NREP(13); ++rep_) for (int rb = blockIdx.x; rb < S_ / 64; rb += G) gates_rows(lds, XN, rowss1, KIN(14), KIN(15), GATES, rb, wave, lane);
    }
    SYNC(3);
    if (IN(4)) { PH_BEGIN for (int item = blockIdx.x; item < 512 * NREP(4); item += G) mlstm_stage_a(lds, PROJM, GATES, KIN(12), KIN(13), QC, KC, DELTA, DN, SC, item & 511, wave); }
    SYNC(4);
    if (IN(5)) { PH_BEGIN for (int rep_ = 0; rep_ < NREP(5); ++rep_) mlstm_scan(lds, DELTA, DN, SC, SC + 1024, CT, NST, tid, blockIdx.x * NTHR + tid, G * NTHR); }
    SYNC(5);
    if (IN(6)) { PH_BEGIN
#ifndef NO_ATTN
#if ATTN2
        attn2_phase((char*)lds_raw, BIG, OATT, 512 * NREP(6), wave);
#else
        attn_phase((char*)lds_raw, BIG, OATT, 512 * NREP(6), wave);
#endif
#endif
        __syncthreads();
#ifndef NO_STAGEC
        for (int rep_ = 0; rep_ < NREP(12); ++rep_) for (int item = blockIdx.x; item < 512; item += G) mlstm_stage_c(lds, PROJM, GATES, QC, KC, CT, NST, SC + 1024, KIN(16), Y, item, wave);
#endif
    }
    SYNC(6);
    if (IN(7)) for (int rep_ = 0; rep_ < NREP(7); ++rep_) { PH_BEGIN
        const float l1 = wave_sum(KIN(7)[lane] * KIN(8)[lane] + KIN(7)[lane + 64] * KIN(8)[lane + 64]);
        const float l2 = wave_sum(KIN(9)[lane] * KIN(10)[lane] + KIN(9)[lane + 64] * KIN(10)[lane + 64]);
        const float lam = expf(l1) - expf(l2) + 0.2f;
        const float* hg = KIN(11);
        for (int m = gw; m < S_; m += NGW) {
#pragma unroll
            for (int h = 0; h < 4; ++h) {
                const v2u a = *((const v2u*)(OATT + (size_t)m * 2048 + h * 512) + lane), b = *((const v2u*)(OATT + (size_t)m * 2048 + h * 512 + 256) + lane);
                float y0 = bf2f(a.x & 0xffffu) - lam * bf2f(b.x & 0xffffu), y1 = bf2f(a.x >> 16) - lam * bf2f(b.x >> 16), y2 = bf2f(a.y & 0xffffu) - lam * bf2f(b.y & 0xffffu), y3 = bf2f(a.y >> 16) - lam * bf2f(b.y >> 16);
                const float rs = 0.8f / sqrtf(wave_sum((y0 * y0 + y1 * y1) + (y2 * y2 + y3 * y3)) * (1.0f / 256.0f) + 1e-6f);
                const f32x4 gn = *((const f32x4*)(hg + h * 256) + lane);
                v2u w; w.x = pk2(y0 * rs * gn[0], y1 * rs * gn[1]); w.y = pk2(y2 * rs * gn[2], y3 * rs * gn[3]);
                *((v2u*)(Y + (size_t)m * DM + h * 256) + lane) = w;
            }
        }
        LAS float* scr = (LAS float*)(lds + wave * 16640);
        for (int it = gw; it < 3 * 2816; it += NGW) cvt_ffn_item(it, KIN(19), KIN(20), KIN(21), KIN(18), Wgu, Wd, scr, lane);
    }
    SYNC(7);
    if (IN(8)) { PH_BEGIN
        pg8::Gemm g{Y, Wout, S_, DM, DM}; pg8::StaticOrder So; So.init(S_, DM, G, (int)blockIdx.x);
        pg8::EpiResid E{out, out, XN, rowss2, 1.0f, DM};
        STAGGER_DELAY(3); pg8::gemm_phase<pg8::EpiResid, pg8::StaticOrder, true, true>(lds, g, So, E, wave);
    }
    SYNC(8);
    if (IN(9)) { PH_BEGIN
        pg8::Gemm g{XN, Wgu, S_, 2 * FF, DM}; pg8::StaticOrder So; So.init(S_, 2 * FF, G, (int)blockIdx.x);
        pg8::EpiSwiGLU E{BIG, FF, rowss2, 1.0f / DM};
        STAGGER_DELAY(1); pg8::gemm_phase<pg8::EpiSwiGLU, pg8::StaticOrder, true, true>(lds, g, So, E, wave);
    }
    SYNC(9);
    if (IN(10)) { PH_BEGIN
        pg8::Gemm g{BIG, Wd, S_, DM, FF}; pg8::StaticOrder So; So.init(S_, DM, G, (int)blockIdx.x);
        pg8::EpiResid E{out, out, nullptr, nullptr, 0.5f, DM};
        STAGGER_DELAY(3); pg8::gemm_phase<pg8::EpiResid, pg8::StaticOrder, true, true>(lds, g, So, E, wave);
    }
    SYNC(10);
    if (IN(11)) { PH_BEGIN
        const float* fg = KIN(22);
        for (int m = gw; m < S_; m += NGW) {
            f32x4* xr = (f32x4*)(out + (size_t)m * DM) + lane; f32x4 v[8]; float s = 0.f;
#pragma unroll
            for (int j = 0; j < 8; ++j) { v[j] = xr[64 * j]; s += (v[j][0] * v[j][0] + v[j][1] * v[j][1]) + (v[j][2] * v[j][2] + v[j][3] * v[j][3]); }
            const float rs = 1.0f / sqrtf(wave_sum(s) * (1.0f / DM) + 1e-6f);
#pragma unroll
            for (int j = 0; j < 8; ++j) { const f32x4 gn = *((const f32x4*)fg + 64 * j + lane); xr[64 * j] = v[j] * rs * gn; }
        }
    }
#undef IN
#undef SYNC
}

extern "C" void kernel_launch(void* const* d_in, const int* in_sizes, int n_in, void* d_out, int out_size, void* d_ws, size_t ws_size, hipStream_t stream) {
    static int grid = 0;
    if (grid == 0) {
        if (n_in != 23 || in_sizes[0] != S_ * DM || out_size != S_ * DM || ws_size < WS_END) { fprintf(stderr, "kernel_launch: unexpected shapes (n_in %d, in0 %d, out %d, ws %zu)\n", n_in, n_in > 0 ? in_sizes[0] : -1, out_size, ws_size); grid = -1; return; }
        int dev = 0, cus = 0, per_cu = 0;
        (void)hipGetDevice(&dev); (void)hipDeviceGetAttribute(&cus, hipDeviceAttributeMultiprocessorCount, dev);
        if (hipFuncSetAttribute((const void*)mega_fwd, hipFuncAttributeMaxDynamicSharedMemorySize, LDS_BYTES) != hipSuccess) { fprintf(stderr, "kernel_launch: hipFuncSetAttribute failed\n"); grid = -1; return; }
        if (hipOccupancyMaxActiveBlocksPerMultiprocessor(&per_cu, (const void*)mega_fwd, NTHR, LDS_BYTES) != hipSuccess || per_cu < 1) per_cu = 1;
        grid = cus * per_cu;
        fprintf(stderr, "kernel_launch: grid %d (%d CUs x %d)\n", grid, cus, per_cu);
    }
    if (grid < 0) return;
    Args a{};
    for (int i = 0; i < 23; ++i) a.in[i] = (const float*)d_in[i];
    a.out = (float*)d_out; a.ws = (unsigned char*)d_ws;
#if MK_SPLIT
    for (int p = 0; p < NPH; ++p) { a.ph_lo = p; a.ph_hi = p + 1; hipLaunchKernelGGL(mega_fwd, dim3(grid), dim3(NTHR), LDS_BYTES, stream, a); }
#else
    a.ph_lo = 0; a.ph_hi = NPH;
    (void)hipMemsetAsync((char*)d_ws + WS_BAR, 0, XCD_BAR_WORDS * 4, stream);
    void* kargs[] = {&a};
    hipError_t e = hipLaunchCooperativeKernel((const void*)mega_fwd, dim3(grid), dim3(NTHR), kargs, LDS_BYTES, stream);
    if (e != hipSuccess) fprintf(stderr, "kernel_launch: cooperative launch failed: %s (grid %d)\n", hipGetErrorString(e), grid);
#endif
}
```

```cpp
#include <hip/hip_runtime.h>
#include <hip/hip_bf16.h>
#include <hip/hip_cooperative_groups.h>
#include <cstdio>
#include <cstdint>
namespace cg = cooperative_groups;

#ifndef MK_SPLIT
#define MK_SPLIT 0
#endif

namespace pg8 {
#define PG8_LAS __attribute__((address_space(3)))
typedef unsigned short bf16_t;
typedef short bf16x8 __attribute__((ext_vector_type(8)));
typedef float f32x4 __attribute__((ext_vector_type(4)));
typedef unsigned u32x4 __attribute__((ext_vector_type(4)));
constexpr int BM = 256, BK = 64, HALF = 128, HTB = HALF * BK * 2  , STAGE_BYTES = 8 * HTB, NXCD = 8, WGM = 8;

__host__ __device__ __forceinline__ int lds_byte(int r, int c) { const int st = (r >> 4) * 2 + (c >> 5), rr = r & 15, cc = c & 31, ob = rr * 64 + cc * 2; return st * 1024 + (ob ^ (((ob >> 9) & 1) << 5)); }
__host__ __device__ __forceinline__ void stage_rc(int b, int& R, int& C) { const int st = b / 1024, sb = b % 1024, swz = sb ^ (((sb >> 9) & 1) << 5); R = (st >> 1) * 16 + swz / 64; C = (st & 1) * 32 + (swz % 64) / 2; }
__host__ __device__ __forceinline__ int perm32(int rho) { const int n = rho >> 4, i = rho & 15; return 8 * (i >> 2) + 4 * n + (i & 3); }

struct Unit { int pm, pn; };
struct Gemm { const bf16_t* A; const bf16_t* Bt; int M, N, K; };

struct StaticOrder {
    int nM, nN, nwg, G, c;
    __host__ __device__ void init(int M, int N, int G_, int c_) { nM = M / BM; nN = N / BM; nwg = nM * nN; G = G_; c = c_; }
    __host__ __device__ bool next(int i, Unit& u) const {
        const long L = (long)i * G + c; if (L >= nwg) return false;
        int wgid = (int)L; { const int q = nwg / NXCD, r = nwg % NXCD, xcd = wgid % NXCD, off = wgid / NXCD; wgid = (xcd < r ? xcd * (q + 1) : r * (q + 1) + (xcd - r) * q) + off; }
        const int nig = WGM * nN, gid = wgid / nig, fm = gid * WGM, gsz = (nM - fm) < WGM ? (nM - fm) : WGM;
        u.pm = fm + ((wgid % nig) % gsz); u.pn = (wgid % nig) / gsz; return true;
    }
    __device__ __forceinline__ void a_ready(const Unit&) const {}
    __device__ __forceinline__ void done(const Unit&) const {}
};

__device__ __forceinline__ unsigned cvt_pk_bf16(float lo, float hi) { unsigned r; asm volatile("v_cvt_pk_bf16_f32 %0, %1, %2" : "=v"(r) : "v"(lo), "v"(hi)); return r; }

constexpr float RMS_EPS = 1e-6f;
__device__ __forceinline__ float silu_f(float x) { return x * __builtin_amdgcn_rcpf(1.0f + __builtin_amdgcn_exp2f(-1.4426950408889634f * x)); }
struct EpiSwiGLU {
    static constexpr bool PERM = true, AFTER_DRAIN = false;
    bf16_t* O; int ldo; const float* rowss; float inv_n;
    __device__ __forceinline__ void operator()(const f32x4 (&acc)[2][2][4][2], const Unit& u, int wr, int wc, int fr, int fq) const {
        const int row0 = u.pm * BM + wr * 64 + fr, col0 = u.pn * HALF + wc * 32 + 8 * fq;
#pragma unroll
        for (int ai = 0; ai < 2; ++ai)
#pragma unroll
            for (int m = 0; m < 4; ++m) {
                const int r = row0 + ai * HALF + m * 16;
                const float rs = rowss ? __builtin_amdgcn_rsqf(rowss[r] * inv_n + RMS_EPS) : 1.0f;
                const f32x4 g0 = acc[ai][0][m][0] * rs, g1 = acc[ai][0][m][1] * rs, u0 = acc[ai][1][m][0] * rs, u1 = acc[ai][1][m][1] * rs;
                u32x4 w;
                w.x = cvt_pk_bf16(silu_f(g0[0]) * u0[0], silu_f(g0[1]) * u0[1]); w.y = cvt_pk_bf16(silu_f(g0[2]) * u0[2], silu_f(g0[3]) * u0[3]);
                w.z = cvt_pk_bf16(silu_f(g1[0]) * u1[0], silu_f(g1[1]) * u1[1]); w.w = cvt_pk_bf16(silu_f(g1[2]) * u1[2], silu_f(g1[3]) * u1[3]);
                *(u32x4*)(O + (size_t)r * ldo + col0) = w;
            }
    }
};
struct EpiResid {
    static constexpr bool PERM = false, AFTER_DRAIN = false;
    const float* resid; float* out; bf16_t* xb; float* rowss; float alpha; int ld;
    __device__ __forceinline__ void operator()(const f32x4 (&acc)[2][2][4][2], const Unit& u, int wr, int wc, int fr, int fq) const {
        typedef unsigned u32x2v __attribute__((ext_vector_type(2)));
        const int row0 = u.pm * BM + wr * 64 + fr, col0 = u.pn * BM + wc * 32 + 4 * fq;
#pragma unroll
        for (int ai = 0; ai < 2; ++ai)
#pragma unroll
            for (int m = 0; m < 4; ++m) {
                const int r = row0 + ai * HALF + m * 16; float ss = 0.f;
#pragma unroll
                for (int bj = 0; bj < 2; ++bj)
#pragma unroll
                    for (int n = 0; n < 2; ++n) {
                        const size_t off = (size_t)r * ld + col0 + bj * HALF + n * 16;
                        const f32x4 b = *(const f32x4*)(resid + off); const f32x4 o = b + acc[ai][bj][m][n] * alpha;
                        *(f32x4*)(out + off) = o; ss += (o[0] * o[0] + o[1] * o[1]) + (o[2] * o[2] + o[3] * o[3]);
                        if (xb) { u32x2v w; w.x = cvt_pk_bf16(o[0], o[1]); w.y = cvt_pk_bf16(o[2], o[3]); *(u32x2v*)(xb + off) = w; }
                    }
                if (rowss) { ss += __shfl_xor(ss, 16); ss += __shfl_xor(ss, 32); if (fq == 0) atomicAdd(rowss + r, ss); }
            }
    }
};
struct EpiProj {
    static constexpr bool PERM = true, AFTER_DRAIN = false;
    bf16_t* O; const float* rowss; float inv_n;
    __device__ __forceinline__ void operator()(const f32x4 (&acc)[2][2][4][2], const Unit& u, int wr, int wc, int fr, int fq) const {
        const int row0 = u.pm * BM + wr * 64 + fr;
        {
            const bool dense = u.pn < 12;
            const size_t rstride = dense ? 128 : 3072;
            bf16_t* base = dense ? O + (size_t)(2 * u.pn) * ((size_t)16384 * 128) + wc * 32 + 8 * fq : O + (size_t)24 * 16384 * 128 + (u.pn - 12) * BM + wc * 32 + 8 * fq;
            const size_t bjstep = dense ? (size_t)16384 * 128 : 128;
#pragma unroll
            for (int ai = 0; ai < 2; ++ai)
#pragma unroll
                for (int m = 0; m < 4; ++m) {
                    const int r = row0 + ai * HALF + m * 16; const float rs = __builtin_amdgcn_rsqf(rowss[r] * inv_n + RMS_EPS);
#pragma unroll
                    for (int bj = 0; bj < 2; ++bj) { const f32x4 v0 = acc[ai][bj][m][0] * rs, v1 = acc[ai][bj][m][1] * rs; u32x4 w;
                        w.x = cvt_pk_bf16(v0[0], v0[1]); w.y = cvt_pk_bf16(v0[2], v0[3]); w.z = cvt_pk_bf16(v1[0], v1[1]); w.w = cvt_pk_bf16(v1[2], v1[3]);
                        *(u32x4*)(base + (size_t)r * rstride + bj * bjstep) = w; }
                }
        }
    }
};
template <class Epi, class Sched, bool ALIGN_EPI = false, bool SP2 = false>
__device__ __forceinline__ void gemm_phase(PG8_LAS unsigned char* lds, const Gemm g, const Sched& S, const Epi& E, const int mk_wave) {
    const int lane = (int)(__builtin_amdgcn_mbcnt_hi(~0u, __builtin_amdgcn_mbcnt_lo(~0u, 0u)) & 63u), wid = mk_wave & 7, tid = wid * 64 + lane, wr = wid >> 2, wc = wid & 3, fr = lane & 15, fq = lane >> 4;
    const int K = g.K, nt = K / BK;
    unsigned voffA[2], voffB[2];
#pragma unroll
    for (int i = 0; i < 2; ++i) { int R, C; stage_rc(tid * 16 + i * 8192, R, C); const int Rb = Epi::PERM ? ((R & ~31) + perm32(R & 31)) : R;
        voffA[i] = (unsigned)(R * K + C) * 2u; voffB[i] = (unsigned)(Rb * K + C) * 2u; }
    const size_t kstep = (size_t)(BK * 2);
    const size_t hstep = (size_t)HALF * K * 2;
    const size_t tstep = 2 * hstep;
    const unsigned ldsw = (unsigned)wid * 1024u;
    const int aoff = lds_byte(wr * 64 + fr, fq * 8), boff = lds_byte(wc * 32 + fr, fq * 8);
#define PG8_SA(b, h) (((b) * 2 + (h)) * HTB)
#define PG8_SB(b, h) ((4 + (b) * 2 + (h)) * HTB)
#define PG8_STAGE(bufoff, gbase, voff) do { _Pragma("unroll") for (int _i = 0; _i < 2; ++_i) \
        __builtin_amdgcn_global_load_lds((const unsigned*)((const char*)(gbase) + (voff)[_i]), (PG8_LAS unsigned*)(lds + (bufoff) + ldsw + _i * 8192), 16, 0, 0); } while (0)
#define PG8_LDA(dst, b, h) do { _Pragma("unroll") for (int m = 0; m < 4; ++m) _Pragma("unroll") for (int k = 0; k < 2; ++k) dst[m][k] = *(const PG8_LAS bf16x8*)(lds + PG8_SA(b, h) + aoff + m * 2048 + k * 1024); } while (0)
#define PG8_LDB(dst, b, h) do { _Pragma("unroll") for (int n = 0; n < 2; ++n) _Pragma("unroll") for (int k = 0; k < 2; ++k) dst[n][k] = *(const PG8_LAS bf16x8*)(lds + PG8_SB(b, h) + boff + n * 2048 + k * 1024); } while (0)
#define PG8_MMA(ai, bj, At, Bt) do { __builtin_amdgcn_s_setprio(1); _Pragma("unroll") for (int m = 0; m < 4; ++m) _Pragma("unroll") for (int n = 0; n < 2; ++n) _Pragma("unroll") for (int k = 0; k < 2; ++k) \
        acc[ai][bj][m][n] = __builtin_amdgcn_mfma_f32_16x16x32_bf16(Bt[n][k], At[m][k], acc[ai][bj][m][n], 0, 0, 0); __builtin_amdgcn_s_setprio(0); } while (0)
#define PG8_WAIT_V(n) asm volatile("s_waitcnt vmcnt(" #n ")" ::: "memory")
#define PG8_WAIT_L(n) asm volatile("s_waitcnt lgkmcnt(" #n ")" ::: "memory")
#define PG8_BAR __builtin_amdgcn_s_barrier()
#define PG8_SCHED __builtin_amdgcn_sched_barrier(0)
    Unit cur, nxt; int ui = 0;
    if (!S.next(0, cur)) return;
    f32x4 acc[2][2][4][2];
#pragma unroll
    for (int a = 0; a < 2; ++a)
#pragma unroll
        for (int b = 0; b < 2; ++b)
#pragma unroll
            for (int m = 0; m < 4; ++m)
#pragma unroll
                for (int n = 0; n < 2; ++n) acc[a][b][m][n] = (f32x4){0.f, 0.f, 0.f, 0.f};
    bf16x8 At[4][2], B0[2][2], B1[2][2];
    const char* cA = (const char*)g.A + (size_t)cur.pm * tstep; const char* cB = (const char*)g.Bt + (size_t)cur.pn * tstep;
    S.a_ready(cur);
    if constexpr (SP2) {
        PG8_STAGE(PG8_SB(0, 0), cB, voffB); PG8_STAGE(PG8_SB(0, 1), cB + hstep, voffB); PG8_STAGE(PG8_SA(0, 0), cA, voffA); PG8_STAGE(PG8_SA(0, 1), cA + hstep, voffA);
        if (wr == 1) PG8_BAR;
        PG8_WAIT_V(2); PG8_BAR;
        PG8_STAGE(PG8_SB(1, 0), cB + kstep, voffB); PG8_STAGE(PG8_SA(1, 0), cA + kstep, voffA); PG8_STAGE(PG8_SB(1, 1), cB + hstep + kstep, voffB);
        PG8_WAIT_V(6); PG8_BAR;
    } else {
        PG8_STAGE(PG8_SB(0, 0), cB, voffB); PG8_STAGE(PG8_SA(0, 0), cA, voffA); PG8_STAGE(PG8_SB(0, 1), cB + hstep, voffB); PG8_STAGE(PG8_SA(0, 1), cA + hstep, voffA);
        if (wr == 1) PG8_BAR;
        PG8_WAIT_V(4); PG8_BAR;
        PG8_STAGE(PG8_SB(1, 0), cB + kstep, voffB); PG8_STAGE(PG8_SA(1, 0), cA + kstep, voffA); PG8_STAGE(PG8_SB(1, 1), cB + hstep + kstep, voffB);
        PG8_WAIT_V(6); PG8_BAR;
    }
    for (;;) {
        const bool has_next = S.next(ui + 1, nxt);
        const char* nA = has_next ? (const char*)g.A + (size_t)nxt.pm * tstep : cA; const char* nB = has_next ? (const char*)g.Bt + (size_t)nxt.pn * tstep : cB;
        for (int t = 0; t < nt; t += 2) {
            const bool last = (t == nt - 2);
            const char* a1 = cA + (size_t)(t + 1) * kstep;
            const char* a2 = last ? nA : cA + (size_t)(t + 2) * kstep; const char* b2 = last ? nB : cB + (size_t)(t + 2) * kstep;
            const char* a3 = a2 + kstep; const char* b3 = b2 + kstep;
            if (last && has_next) S.a_ready(nxt);
            if constexpr (SP2) {
            PG8_LDB(B0, 0, 0); PG8_LDB(B1, 0, 1); PG8_SCHED; PG8_LDA(At, 0, 0); PG8_STAGE(PG8_SA(1, 1), a1 + hstep, voffA);
            PG8_WAIT_V(8); PG8_WAIT_L(0); PG8_BAR; PG8_MMA(0, 0, At, B0); PG8_MMA(0, 1, At, B1); PG8_BAR; PG8_SCHED;
            PG8_LDA(At, 0, 1); PG8_STAGE(PG8_SB(0, 0), b2, voffB); PG8_STAGE(PG8_SB(0, 1), b2 + hstep, voffB); PG8_STAGE(PG8_SA(0, 0), a2, voffA);
            PG8_WAIT_V(8); PG8_WAIT_L(0); PG8_BAR; PG8_MMA(1, 0, At, B0); PG8_MMA(1, 1, At, B1); PG8_BAR; PG8_SCHED;
            PG8_LDB(B0, 1, 0); PG8_LDB(B1, 1, 1); PG8_SCHED; PG8_LDA(At, 1, 0); PG8_STAGE(PG8_SA(0, 1), a2 + hstep, voffA);
            PG8_WAIT_V(8); PG8_WAIT_L(0); PG8_BAR; PG8_MMA(0, 0, At, B0); PG8_MMA(0, 1, At, B1); PG8_BAR; PG8_SCHED;
            PG8_LDA(At, 1, 1); PG8_STAGE(PG8_SB(1, 0), b3, voffB); PG8_STAGE(PG8_SB(1, 1), b3 + hstep, voffB); PG8_STAGE(PG8_SA(1, 0), a3, voffA);
            PG8_WAIT_V(8); PG8_WAIT_L(0); PG8_BAR; PG8_MMA(1, 0, At, B0); PG8_MMA(1, 1, At, B1); PG8_BAR; PG8_SCHED;
            } else {
            PG8_LDB(B0, 0, 0); PG8_SCHED; PG8_LDA(At, 0, 0); PG8_STAGE(PG8_SA(1, 1), a1 + hstep, voffA);
            PG8_WAIT_L(8); PG8_BAR; PG8_WAIT_L(0); PG8_MMA(0, 0, At, B0); PG8_BAR; PG8_SCHED;
            PG8_LDB(B1, 0, 1); PG8_STAGE(PG8_SB(0, 0), b2, voffB);
            PG8_BAR; PG8_WAIT_L(0); PG8_MMA(0, 1, At, B1); PG8_BAR;
            PG8_LDA(At, 0, 1); PG8_STAGE(PG8_SA(0, 0), a2, voffA);
            PG8_BAR; PG8_WAIT_L(0); PG8_MMA(1, 0, At, B0); PG8_BAR; PG8_SCHED;
            PG8_STAGE(PG8_SB(0, 1), b2 + hstep, voffB);
            PG8_WAIT_V(6); PG8_BAR; PG8_MMA(1, 1, At, B1); PG8_BAR;
            PG8_LDB(B0, 1, 0); PG8_SCHED; PG8_LDA(At, 1, 0); PG8_STAGE(PG8_SA(0, 1), a2 + hstep, voffA);
            PG8_WAIT_L(8); PG8_BAR; PG8_WAIT_L(0); PG8_MMA(0, 0, At, B0); PG8_BAR; PG8_SCHED;
            PG8_LDB(B1, 1, 1); PG8_STAGE(PG8_SB(1, 0), b3, voffB);
            PG8_BAR; PG8_WAIT_L(0); PG8_MMA(0, 1, At, B1); PG8_BAR;
            PG8_LDA(At, 1, 1); PG8_STAGE(PG8_SA(1, 0), a3, voffA);
            PG8_BAR; PG8_WAIT_L(0); PG8_MMA(1, 0, At, B0); PG8_BAR; PG8_SCHED;
            PG8_STAGE(PG8_SB(1, 1), b3 + hstep, voffB);
            PG8_WAIT_V(6); PG8_BAR; PG8_MMA(1, 1, At, B1); PG8_BAR;
            }
        }
        if constexpr (ALIGN_EPI) { if (wr == 0) PG8_BAR; }
        if constexpr (!Epi::AFTER_DRAIN) { E(acc, cur, wr, wc, fr, fq); S.done(cur); }
        if (!has_next) break;
#pragma unroll
        for (int a = 0; a < 2; ++a)
#pragma unroll
            for (int b = 0; b < 2; ++b)
#pragma unroll
                for (int m = 0; m < 4; ++m)
#pragma unroll
                    for (int n = 0; n < 2; ++n) acc[a][b][m][n] = (f32x4){0.f, 0.f, 0.f, 0.f};
        cur = nxt; cA = nA; cB = nB; ++ui;
        if constexpr (ALIGN_EPI) { if (wr == 1) PG8_BAR; }
    }
    PG8_WAIT_V(0);
    if constexpr (!ALIGN_EPI) { if (wr == 0) PG8_BAR; }
    PG8_BAR;
    if constexpr (Epi::AFTER_DRAIN) { E.fused(acc, cur, wr, wc, fr, fq, lds, wid, lane); S.done(cur); }
#undef PG8_SA
#undef PG8_SB
#undef PG8_STAGE
#undef PG8_LDA
#undef PG8_LDB
#undef PG8_MMA
#undef PG8_WAIT_V
#undef PG8_WAIT_L
#undef PG8_BAR
#undef PG8_SCHED
}
}

namespace att {
constexpr int D = 128; constexpr float THR = 8.f; constexpr bool WSKIP = false; constexpr int LDP = 128, LDO = 2048;
constexpr float SCALE = 0.08838834764831845f;
constexpr int NW = 8, QBLK = 32, KVBLK = 64, QB = NW * QBLK;
constexpr int SHM_V = KVBLK * D * 2, SHM_K = KVBLK * D * 2;
constexpr int LDS_BYTES = 2 * SHM_V + 2 * SHM_K + NW * 64 * 4;

using bf16 = __hip_bfloat16;
typedef short bf16x8 __attribute__((ext_vector_type(8)));
typedef short s16x4 __attribute__((ext_vector_type(4)));
typedef float f32x16 __attribute__((ext_vector_type(16)));
typedef float f32x4 __attribute__((ext_vector_type(4)));
typedef unsigned u32x4 __attribute__((ext_vector_type(4)));
template <class A, class Bt> struct same_t { static constexpr bool v = false; };
template <class A> struct same_t<A, A> { static constexpr bool v = true; };

#define KSWZ(row, colB) ((row) * 256 + ((colB) ^ (((row) & 7) << 4)))
#define SBAR() __builtin_amdgcn_sched_barrier(0)
__device__ __forceinline__ int v_st(int k, int c) { const int kk = (k & ~0xC) | ((k & 4) << 1) | ((k & 8) >> 1); return ((kk >> 3) * 4 + (c >> 5)) * 512 + ((kk & 7) * 32 + (c & 31)) * 2; }
__device__ __forceinline__ int v_rd_base(int lane) { return ((lane & 3) << 3) | (((lane >> 2) & 3) << 6) | (((lane >> 4) & 1) << 5) | (((lane >> 5) & 1) << 8); }
constexpr int v_rd_off(int d0, int ks, int half) { return d0 * 512 + ks * 4096 + half * 2048; }
__device__ __forceinline__ int crow(int r, int hi) { return (r & 3) + 8 * (r >> 2) + 4 * hi; }
__device__ __forceinline__ unsigned cvtpk(float lo, float hi) {
    unsigned r; asm volatile("v_cvt_pk_bf16_f32 %0, %1, %2" : "=v"(r) : "v"(lo), "v"(hi)); return r;
}
__device__ __forceinline__ bf16x8 pack8(f32x4 a, f32x4 b) {
    u32x4 w = {cvtpk(a[0], a[1]), cvtpk(a[2], a[3]), cvtpk(b[0], b[1]), cvtpk(b[2], b[3])};
    return *reinterpret_cast<bf16x8*>(&w);
}
template <class T> __device__ __forceinline__ bf16x8 load8(const T* p) {
    if constexpr (same_t<T, float>::v) { return pack8(*(const f32x4*)p, *(const f32x4*)(p + 4)); }
    else { return *reinterpret_cast<const bf16x8*>(p); }
}
__device__ __forceinline__ void mask_tile(f32x16& p0, f32x16& p1, int dq, unsigned W) {
    const float NEG = -__builtin_inff();
#pragma unroll
    for (int r = 0; r < 16; ++r) {
        const int c = (r & 3) + 8 * (r >> 2);
        if ((unsigned)(dq - c) >= W) p0[r] = NEG;
        if ((unsigned)(dq - c - 32) >= W) p1[r] = NEG;
    }
}
__device__ __forceinline__ void partialSM(f32x16& p0, f32x16& p1, float& m_reg, float& mn, float& alpha) {
    float pmax = p0[0]; for (int r = 1; r < 16; ++r) pmax = fmaxf(pmax, p0[r]); for (int r = 0; r < 16; ++r) pmax = fmaxf(pmax, p1[r]);
    { auto rr = __builtin_amdgcn_permlane32_swap(__float_as_uint(pmax), __float_as_uint(pmax), false, false);
      pmax = fmaxf(__uint_as_float(rr[0]), __uint_as_float(rr[1])); }
    constexpr float C2 = 1.4426950408889634f * SCALE;
    if (__builtin_expect(__all((pmax - m_reg) * SCALE <= THR), 1)) { mn = m_reg; alpha = 1.f; }
    else { mn = fmaxf(m_reg, pmax); alpha = __builtin_amdgcn_exp2f((m_reg - mn) * C2); m_reg = mn; }
    const float mnL = -mn * C2;
    for (int r = 0; r < 16; ++r) p0[r] = fmaf(p0[r], C2, mnL); for (int r = 0; r < 16; ++r) p1[r] = fmaf(p1[r], C2, mnL);
    for (int r = 0; r < 16; ++r) p0[r] = __builtin_amdgcn_exp2f(p0[r]);
}
__device__ __forceinline__ void finishSM(f32x16& p0, f32x16& p1, float alpha, float& l_reg, bf16x8& pa0, bf16x8& pa1, bf16x8& pa2, bf16x8& pa3) {
    for (int r = 0; r < 16; ++r) p1[r] = __builtin_amdgcn_exp2f(p1[r]);
    float ps = 0; for (int r = 0; r < 16; ++r) ps += p0[r]; for (int r = 0; r < 16; ++r) ps += p1[r];
    { auto rr = __builtin_amdgcn_permlane32_swap(__float_as_uint(ps), __float_as_uint(ps), false, false);
      ps = __uint_as_float(rr[0]) + __uint_as_float(rr[1]); }
    l_reg = l_reg * alpha + ps;
#define PK4(P, B_, OUT) do { unsigned a0 = cvtpk(P[B_+0], P[B_+1]), a1 = cvtpk(P[B_+2], P[B_+3]);                          \
        unsigned b0 = cvtpk(P[B_+4], P[B_+5]), b1 = cvtpk(P[B_+6], P[B_+7]);                                             \
        auto r0 = __builtin_amdgcn_permlane32_swap(a0, b0, false, false); auto r1 = __builtin_amdgcn_permlane32_swap(a1, b1, false, false); \
        u32x4 w = {r0[0], r1[0], r0[1], r1[1]}; OUT = *reinterpret_cast<bf16x8*>(&w); } while (0)
    PK4(p0, 0, pa0); PK4(p0, 8, pa1); PK4(p1, 0, pa2); PK4(p1, 8, pa3);
#undef PK4
}
template <int KB, bool SK>
__device__ __forceinline__ void qkt(f32x16& p0, f32x16& p1, const char* K_lds, int r32, int hi, const bf16x8* qr, bool act) {
    if (SK && !act) { const float NEG = -__builtin_inff();
#pragma unroll
        for (int r = 0; r < 16; ++r) { p0[r] = NEG; p1[r] = NEG; } return; }
    p0 = f32x16{}; p1 = f32x16{};
    const char* kb[4];
#pragma unroll
    for (int dd = 0; dd < 4; ++dd) kb[dd] = K_lds + KB * SHM_K + KSWZ(r32, (dd * 16 + hi * 8) * 2);
#pragma unroll
    for (int d0 = 0; d0 < 8; ++d0) { const char* a = kb[d0 & 3] + (d0 >> 2) * 128;
        bf16x8 b0 = *reinterpret_cast<const bf16x8*>(a);
        bf16x8 b1 = *reinterpret_cast<const bf16x8*>(a + 32 * 256);
        p0 = __builtin_amdgcn_mfma_f32_32x32x16_bf16(b0, qr[d0], p0, 0, 0, 0);
        p1 = __builtin_amdgcn_mfma_f32_32x32x16_bf16(b1, qr[d0], p1, 0, 0, 0); }
}
template <int VB, bool SK>
__device__ __forceinline__ void pv_tile(f32x16* o, int vb0, bf16x8 pa0, bf16x8 pa1, bf16x8 pa2, bf16x8 pa3, bool act) {
    if (SK && !act) return;
#define TRRD(dst, off) asm volatile("ds_read_b64_tr_b16 %0, %1 offset:%2" : "=&v"(dst) : "v"(vb0), "i"(off) : "memory")
#define PV_D0(d0) do { s16x4 l0, l1, l2, l3, h0, h1, h2, h3; constexpr int b_ = VB * SHM_V + v_rd_off(d0, 0, 0);     \
        TRRD(l0, b_); TRRD(h0, b_ + 2048); TRRD(l1, b_ + 4096); TRRD(h1, b_ + 6144); TRRD(l2, b_ + 8192); TRRD(h2, b_ + 10240); TRRD(l3, b_ + 12288); TRRD(h3, b_ + 14336); \
        asm volatile("s_waitcnt lgkmcnt(0)" ::: "memory"); SBAR();                 \
        o[d0] = __builtin_amdgcn_mfma_f32_32x32x16_bf16(pa0, (bf16x8){l0[0], l0[1], l0[2], l0[3], h0[0], h0[1], h0[2], h0[3]}, o[d0], 0, 0, 0);   \
        o[d0] = __builtin_amdgcn_mfma_f32_32x32x16_bf16(pa1, (bf16x8){l1[0], l1[1], l1[2], l1[3], h1[0], h1[1], h1[2], h1[3]}, o[d0], 0, 0, 0);   \
        o[d0] = __builtin_amdgcn_mfma_f32_32x32x16_bf16(pa2, (bf16x8){l2[0], l2[1], l2[2], l2[3], h2[0], h2[1], h2[2], h2[3]}, o[d0], 0, 0, 0);   \
        o[d0] = __builtin_amdgcn_mfma_f32_32x32x16_bf16(pa3, (bf16x8){l3[0], l3[1], l3[2], l3[3], h3[0], h3[1], h3[2], h3[3]}, o[d0], 0, 0, 0); } while (0)
    PV_D0(0); PV_D0(1); PV_D0(2); PV_D0(3);
#undef PV_D0
#undef TRRD
}

template <class TIn, class TOut> struct BlockRef { const TIn* Q; const TIn* K; const TIn* V; TOut* O; int P0; };
template <class TIn> struct Seam {
    bf16x8 qr[8];
    bf16x8 st_v0, st_v1, st_k0, st_k1; f32x4 sf0, sf1, sf2, sf3;
    f32x4 tq[16];
};
__device__ __forceinline__ int swa_jlo(int P0, int W) { const int lowk = P0 - W + 1; return lowk > 0 ? lowk / KVBLK : 0; }
#define ROW(p, k0, rr) ((p) + (size_t)((k0) + (rr)) * LDP + sc)
#define VMW() asm volatile("s_waitcnt vmcnt(0)" ::: "memory")
#define VMWN(n) asm volatile("s_waitcnt vmcnt(%0)" :: "i"(n) : "memory")
#define SLOAD_H(Kp, Vp, k0) do { S.st_v0 = load8<TIn>(ROW(Vp, k0, sr)); S.st_v1 = load8<TIn>(ROW(Vp, k0, 32 + sr));              \
                         S.st_k0 = load8<TIn>(ROW(Kp, k0, sr)); S.st_k1 = load8<TIn>(ROW(Kp, k0, 32 + sr)); } while (0)
#define SWRITE_HK(bf) do { *(bf16x8*)(K_lds + (bf) * SHM_K + kws) = S.st_k0; *(bf16x8*)(K_lds + (bf) * SHM_K + kws + 32 * 256) = S.st_k1; } while (0)
#define SWRITE_HV(bf) do { *(bf16x8*)(V_lds + (bf) * SHM_V + vst0) = S.st_v0; *(bf16x8*)(V_lds + (bf) * SHM_V + vst1) = S.st_v1; } while (0)
#define SWRITE_H(bf) do { SWRITE_HV(bf); SWRITE_HK(bf); } while (0)
#define SLOAD_F(p, k0) do { S.sf0 = *(const f32x4*)ROW(p, k0, sr); S.sf1 = *(const f32x4*)(ROW(p, k0, sr) + 4);                \
                            S.sf2 = *(const f32x4*)ROW(p, k0, 32 + sr); S.sf3 = *(const f32x4*)(ROW(p, k0, 32 + sr) + 4); } while (0)
#define SWRITE_KF(bf) do { *(bf16x8*)(K_lds + (bf) * SHM_K + kws) = pack8(S.sf0, S.sf1); *(bf16x8*)(K_lds + (bf) * SHM_K + kws + 32 * 256) = pack8(S.sf2, S.sf3); } while (0)
#define SWRITE_VF(bf) do { *(bf16x8*)(V_lds + (bf) * SHM_V + vst0) = pack8(S.sf0, S.sf1); *(bf16x8*)(V_lds + (bf) * SHM_V + vst1) = pack8(S.sf2, S.sf3); } while (0)
template <class TIn, class TOut>
__device__ __forceinline__ void causal_swa_prime(const BlockRef<TIn, TOut>& cur, int W, char* lds, Seam<TIn>& S, const int mk_wave) {
    constexpr bool F32 = same_t<TIn, float>::v;
    const int lane = (int)(__builtin_amdgcn_mbcnt_hi(~0u, __builtin_amdgcn_mbcnt_lo(~0u, 0u)) & 63u), wid = mk_wave & 7, tid = wid * 64 + lane, r32 = lane & 31, hi = lane >> 5;
    const int sr = tid >> 4, sc = (tid & 15) * 8, kws = KSWZ(sr, sc * 2); char* K_lds = lds + 2 * SHM_V;
    const int kb0 = swa_jlo(cur.P0, W) * KVBLK;
    for (int d0 = 0; d0 < 8; ++d0) S.qr[d0] = load8<TIn>(cur.Q + (size_t)(wid * QBLK + r32) * LDP + d0 * 16 + hi * 8);
    if constexpr (F32) { SLOAD_F((const float*)cur.K, kb0); VMW(); SWRITE_KF(0); SBAR(); SLOAD_F((const float*)cur.V, kb0); }
    else { SLOAD_H(cur.K, cur.V, kb0); VMW(); SWRITE_HK(0); }
    __syncthreads();
}
template <class TIn, class TOut>
__device__ __forceinline__ void causal_swa_block(const BlockRef<TIn, TOut>& cur, const BlockRef<TIn, TOut>& nxt, int skv, int W, char* lds, Seam<TIn>& S, const int mk_wave) {
    constexpr bool F32 = same_t<TIn, float>::v;
    const int lane = (int)(__builtin_amdgcn_mbcnt_hi(~0u, __builtin_amdgcn_mbcnt_lo(~0u, 0u)) & 63u), wid = mk_wave & 7, tid = wid * 64 + lane, r32 = lane & 31, hi = lane >> 5;
    const int j_lo = swa_jlo(cur.P0, W);
    int j_hi = (cur.P0 + QB - 1) / KVBLK + 1; if (j_hi > skv / KVBLK) j_hi = skv / KVBLK;
    const int NT = j_hi - j_lo;
    const int kbn = swa_jlo(nxt.P0, W) * KVBLK;
    const int qlo = cur.P0 + wid * QBLK, qm = qlo + r32 - 4 * hi;
    char* V_lds = lds; char* K_lds = lds + 2 * SHM_V;
    float* ws = (float*)(lds + 2 * SHM_V + 2 * SHM_K) + wid * 64; float* li_l = ws, * al_l = ws + 32;
    float m_reg = -1e30f, l_reg = 0; f32x16 o[4] = {};
    const int sr = tid >> 4, sc = (tid & 15) * 8, vst0 = v_st(sr, sc), vst1 = v_st(32 + sr, sc), kws = KSWZ(sr, sc * 2);
    const int vb0 = (int)(uintptr_t)V_lds + v_rd_base(lane);
    const TIn* Kh = cur.K; const TIn* Vh = cur.V;
#define RESC(a) do { if (__any((a) < 1.f)) { if (hi == 0) al_l[r32] = (a); asm volatile("s_waitcnt lgkmcnt(0)" ::: "memory");              \
                     for (int d_ = 0; d_ < 4; ++d_) for (int r = 0; r < 16; ++r) o[d_][r] *= al_l[crow(r, hi)]; } } while (0)
#define KBASE(t) ((j_lo + (t)) * KVBLK)
#define ACT(t) (KBASE(t) <= qlo + QBLK - 1 && KBASE(t) + KVBLK - 1 >= qlo - W + 1)
#define MASKT(P0_, P1_, t) do { const int kb_ = KBASE(t); if ((!SK || ACT(t)) && (kb_ + KVBLK - 1 > qlo || kb_ <= qlo + QBLK - 1 - W)) mask_tile(P0_, P1_, qm - kb_, (unsigned)W); } while (0)
    constexpr int NQL = F32 ? 16 : 8;
    constexpr bool SK = WSKIP && !F32;
#define SEAM_K0() do { VMWN(NQL); if constexpr (F32) { SWRITE_KF(0); SBAR(); SLOAD_F((const float*)nxt.V, kbn); } else { SWRITE_HK(0); } SBAR(); } while (0)
    f32x16 pA0, pA1, pB0, pB1; float mnA, mnB, alA, alB; bf16x8 pa0, pa1, pa2, pa3;
    if constexpr (F32) { VMW(); SWRITE_VF(0); SBAR(); } else { SWRITE_HV(0); SBAR(); }
    if (NT > 1) { if constexpr (F32) SLOAD_F((const float*)Kh, KBASE(1)); else SLOAD_H(Kh, Vh, KBASE(1)); }
    SBAR(); qkt<0, SK>(pA0, pA1, K_lds, r32, hi, S.qr, ACT(0));
    if constexpr (F32) { if (NT > 1) { VMW(); SWRITE_KF(1); SBAR(); SLOAD_F((const float*)Vh, KBASE(1)); } }
    MASKT(pA0, pA1, 0); partialSM(pA0, pA1, m_reg, mnA, alA);
    if (NT > 1) { VMW(); if constexpr (F32) { SWRITE_VF(1); SBAR(); if (NT > 2) SLOAD_F((const float*)Kh, KBASE(2)); } else SWRITE_H(1); }
    __syncthreads();
#define HALF_STEP(PX0, PX1, mnX, alX, PY0, PY1, alY, t, KB, VB, SB) do {                                                      \
        SBAR(); qkt<KB, SK>(PX0, PX1, K_lds, r32, hi, S.qr, ACT(t));                                             \
        finishSM(PY0, PY1, alY, l_reg, pa0, pa1, pa2, pa3); SBAR();                                                           \
        if ((t) + 1 < NT) { if constexpr (F32) { VMW(); SWRITE_KF(SB); SBAR(); SLOAD_F((const float*)Vh, KBASE((t) + 1)); }  \
                            else { SLOAD_H(Kh, Vh, KBASE((t) + 1)); } SBAR(); }                                               \
        pv_tile<VB, SK>(o, vb0, pa0, pa1, pa2, pa3, ACT((t) - 1)); MASKT(PX0, PX1, (t)); partialSM(PX0, PX1, m_reg, mnX, alX);                                        \
        __syncthreads();                                                                                                      \
        if ((t) + 1 < NT) { VMW(); if constexpr (F32) { SWRITE_VF(SB); SBAR(); if ((t) + 2 < NT) SLOAD_F((const float*)Kh, KBASE((t) + 2)); } \
                            else { SWRITE_H(SB); } }                                                                          \
        RESC(alX); __syncthreads(); } while (0)
    for (int t = 1; t + 1 < NT; t += 2) {
        HALF_STEP(pB0, pB1, mnB, alB, pA0, pA1, alA, t, 1, 0, 0);
        HALF_STEP(pA0, pA1, mnA, alA, pB0, pB1, alB, t + 1, 0, 1, 1);
    }
    const bool even = (NT & 1) == 0;
    if (even) { SBAR(); qkt<1, SK>(pB0, pB1, K_lds, r32, hi, S.qr, ACT(NT - 1)); SBAR(); }
#define QROW(e) (nxt.Q + (size_t)(wid * QBLK + r32) * LDP + ((e) >> 1) * 16 + hi * 8 + ((e) & 1) * 4)
    if constexpr (F32) { SLOAD_F((const float*)nxt.K, kbn); SBAR();
#pragma unroll
        for (int e = 0; e < 8; ++e) S.tq[e] = *(const f32x4*)QROW(e); }
    else { SLOAD_H(nxt.K, nxt.V, kbn); SBAR();
#pragma unroll
        for (int d0 = 0; d0 < 8; ++d0) S.qr[d0] = load8<TIn>(nxt.Q + (size_t)(wid * QBLK + r32) * LDP + d0 * 16 + hi * 8); }
    SBAR();
    finishSM(pA0, pA1, alA, l_reg, pa0, pa1, pa2, pa3); SBAR();
    if constexpr (F32) {
#pragma unroll
        for (int e = 8; e < 16; ++e) S.tq[e] = *(const f32x4*)QROW(e); SBAR(); }
#undef QROW
    pv_tile<0, SK>(o, vb0, pa0, pa1, pa2, pa3, ACT(even ? NT - 2 : NT - 1));
    if (even) { MASKT(pB0, pB1, NT - 1); partialSM(pB0, pB1, m_reg, mnB, alB); __syncthreads(); RESC(alB);
        finishSM(pB0, pB1, alB, l_reg, pa0, pa1, pa2, pa3); SBAR(); pv_tile<1, SK>(o, vb0, pa0, pa1, pa2, pa3, ACT(NT - 1)); }
    SBAR(); SEAM_K0();
    if (hi == 0) li_l[r32] = l_reg; asm volatile("s_waitcnt lgkmcnt(0)" ::: "memory");
    float rli[16];
#pragma unroll
    for (int r = 0; r < 16; ++r) rli[r] = __builtin_amdgcn_rcpf(li_l[crow(r, hi)]);
    TOut* Ow = cur.O + (size_t)(wid * QBLK) * LDO;
#pragma unroll
    for (int r = 0; r < 16; ++r) { const int orow = crow(r, hi);
#pragma unroll
        for (int d0 = 0; d0 < 4; ++d0) { const float v = o[d0][r] * rli[r];
            if constexpr (same_t<TOut, float>::v) { Ow[(size_t)orow * LDO + d0 * 32 + r32] = v; }
            else { const float vn = __shfl_xor(v, 1);
                   if ((r32 & 1) == 0) *(unsigned*)(Ow + (size_t)orow * LDO + d0 * 32 + r32) = cvtpk(v, vn); } } }
    if constexpr (F32) {
#pragma unroll
        for (int d0 = 0; d0 < 8; ++d0) S.qr[d0] = pack8(S.tq[2 * d0], S.tq[2 * d0 + 1]); }
    __syncthreads();
#undef RESC
#undef KBASE
#undef ACT
#undef MASKT
#undef SEAM_K0
#undef HALF_STEP
}
#undef ROW
#undef VMW
#undef VMWN
#undef SLOAD_H
#undef SWRITE_HK
#undef SWRITE_HV
#undef SWRITE_H
#undef SLOAD_F
#undef SWRITE_KF
#undef SWRITE_VF

constexpr int A2_V = 0;
constexpr int A2_K = 4 * SHM_V;
constexpr int A2_X = A2_K + 2 * SHM_K;
constexpr int A2_XS = 4096 + 512;
constexpr int A2_LDS = A2_X + 4 * A2_XS;
struct A2Ref { const bf16* Q; const bf16* K; const bf16* V0; const bf16* V1; bf16* O; int P0; };

__device__ __forceinline__ void attn2_block(const A2Ref& c, char* lds, const int mk_wave) {
    const int lane = (int)(__builtin_amdgcn_mbcnt_hi(~0u, __builtin_amdgcn_mbcnt_lo(~0u, 0u)) & 63u), wid = mk_wave & 7, tid = wid * 64 + lane, r32 = lane & 31, hi = lane >> 5, rg = wid & 3, vh = wid >> 2;
    char* V_lds = lds + A2_V; char* K_lds = lds + A2_K; char* X = lds + A2_X + rg * A2_XS;
    float* XA = (float*)(X + 4096); float* XM = XA + 32; float* XL = XA + 64;
    const int NT = (c.P0 + 127) / 64 + 1;
    const int qlo = c.P0 + rg * 32, qm = qlo + r32 - 4 * hi;
    const int sr = tid >> 4, sc = (tid & 15) * 8, vst0 = v_st(sr, sc), vst1 = v_st(32 + sr, sc), kws = KSWZ(sr, sc * 2);
    const int vb0 = (int)(uintptr_t)V_lds + vh * SHM_V + v_rd_base(lane);
    bf16x8 qr[8];
#pragma unroll
    for (int d0 = 0; d0 < 8; ++d0) qr[d0] = load8<bf16>(c.Q + (size_t)(rg * 32 + r32) * 128 + d0 * 16 + hi * 8);
    float m_reg = -1e30f, l_reg = 0.f; f32x16 o[4] = {};
    bf16x8 sk0, sk1, sa0, sa1, sb0, sb1;
#define A2_LOAD(kb) do { const size_t ro_ = (size_t)((kb) + sr) * 128 + sc; sk0 = load8<bf16>(c.K + ro_); sk1 = load8<bf16>(c.K + ro_ + 32 * 128); \
        sa0 = load8<bf16>(c.V0 + ro_); sa1 = load8<bf16>(c.V0 + ro_ + 32 * 128); sb0 = load8<bf16>(c.V1 + ro_); sb1 = load8<bf16>(c.V1 + ro_ + 32 * 128); } while (0)
#define A2_WRITE(buf) do { *(bf16x8*)(K_lds + (buf) * SHM_K + kws) = sk0; *(bf16x8*)(K_lds + (buf) * SHM_K + kws + 32 * 256) = sk1; \
        *(bf16x8*)(V_lds + (buf) * 2 * SHM_V + vst0) = sa0; *(bf16x8*)(V_lds + (buf) * 2 * SHM_V + vst1) = sa1; \
        *(bf16x8*)(V_lds + (buf) * 2 * SHM_V + SHM_V + vst0) = sb0; *(bf16x8*)(V_lds + (buf) * 2 * SHM_V + SHM_V + vst1) = sb1; } while (0)
#define A2_VMW() asm volatile("s_waitcnt vmcnt(0)" ::: "memory")
#define A2_STEP(t, B) do { const bool more_ = (t) + 1 < NT; if (more_) A2_LOAD(((t) + 1) * 64); \
        bf16x8 pa0, pa1, pa2, pa3; \
        if (vh == (B)) { f32x16 p0, p1; float mn, alpha; \
            qkt<(B), false>(p0, p1, K_lds, r32, hi, qr, true); \
            if (64 * (t) + 63 > qlo) mask_tile(p0, p1, qm - 64 * (t), 16384u); \
            partialSM(p0, p1, m_reg, mn, alpha); finishSM(p0, p1, alpha, l_reg, pa0, pa1, pa2, pa3); \
            *(bf16x8*)(X + lane * 16) = pa0; *(bf16x8*)(X + 1024 + lane * 16) = pa1; *(bf16x8*)(X + 2048 + lane * 16) = pa2; *(bf16x8*)(X + 3072 + lane * 16) = pa3; \
            if (hi == 0) { XA[r32] = alpha; XM[r32] = m_reg; XL[r32] = l_reg; } } \
        __syncthreads(); \
        if (vh != (B)) { pa0 = *(const bf16x8*)(X + lane * 16); pa1 = *(const bf16x8*)(X + 1024 + lane * 16); pa2 = *(const bf16x8*)(X + 2048 + lane * 16); pa3 = *(const bf16x8*)(X + 3072 + lane * 16); \
            m_reg = XM[r32]; l_reg = XL[r32]; } \
        { const float a_ = XA[r32]; if (__any(a_ < 1.f)) { \
            _Pragma("unroll") for (int d_ = 0; d_ < 4; ++d_) _Pragma("unroll") for (int r = 0; r < 16; ++r) o[d_][r] *= XA[crow(r, hi)]; } } \
        pv_tile<2 * (B), false>(o, vb0, pa0, pa1, pa2, pa3, true); \
        if (more_) { A2_VMW(); A2_WRITE((B) ^ 1); } \
        __syncthreads(); } while (0)
    A2_LOAD(0); A2_VMW(); A2_WRITE(0); __syncthreads();
    for (int t = 0; t < NT; t += 2) { A2_STEP(t, 0); A2_STEP(t + 1, 1); }
    float rli[16];
#pragma unroll
    for (int r = 0; r < 16; ++r) rli[r] = __builtin_amdgcn_rcpf(XL[crow(r, hi)]);
    bf16* Ow = c.O + (size_t)(rg * 32) * LDO + vh * 128;
#pragma unroll
    for (int r = 0; r < 16; ++r) { const int orow = crow(r, hi);
#pragma unroll
        for (int d0 = 0; d0 < 4; ++d0) { const float v = o[d0][r] * rli[r]; const float vn = __shfl_xor(v, 1);
            if ((r32 & 1) == 0) *(unsigned*)(Ow + (size_t)orow * LDO + d0 * 32 + r32) = cvtpk(v, vn); } }
    __syncthreads();
#undef A2_LOAD
#undef A2_WRITE
#undef A2_VMW
#undef A2_STEP
}

constexpr int A3_XS = 4096 + 2 * 384;
constexpr int A3_LDS = A2_X + 4 * A3_XS;
__device__ __forceinline__ void attn3_block(const A2Ref& c, char* lds, const int mk_wave) {
    int lane_ = (int)(__builtin_amdgcn_mbcnt_hi(~0u, __builtin_amdgcn_mbcnt_lo(~0u, 0u)) & 63u); asm volatile("" : "+v"(lane_));
    const int lane = lane_ & 63, wid = mk_wave & 7, tid = wid * 64 + lane, r32 = lane & 31, hi = lane >> 5, rg = wid & 3, vh = wid >> 2;
    char* V_lds = lds + A2_V; char* K_lds = lds + A2_K; char* X = lds + A2_X + rg * A3_XS;
    float* XS = (float*)(X + 4096);
    const int NT = (c.P0 + 127) / 64 + 1;
    const int qlo = c.P0 + rg * 32, qm = qlo + r32 - 4 * hi;
    const int sr = tid >> 4, sc = (tid & 15) * 8, vst0 = v_st(sr, sc), vst1 = v_st(32 + sr, sc), kws = KSWZ(sr, sc * 2);
    const int vb0 = (int)(uintptr_t)V_lds + vh * SHM_V + v_rd_base(lane);
    bf16x8 qr[8];
#pragma unroll
    for (int d0 = 0; d0 < 8; ++d0) qr[d0] = load8<bf16>(c.Q + (size_t)(rg * 32 + r32) * 128 + d0 * 16 + hi * 8);
    float m_reg = -1e30f, l_reg = 0.f; f32x16 o[4] = {};
    bf16x8 sk0, sk1, sa0, sa1, sb0, sb1, pa0, pa1, pa2, pa3;
    const unsigned so = (unsigned)(sr * 128 + sc) * 2u;
#define A3_G(base, kb, rows) (*(const bf16x8*)((const char*)((base) + (size_t)((kb) + (rows)) * 128) + so))
#define A3_LOADK(kb) do { sk0 = A3_G(c.K, kb, 0); sk1 = A3_G(c.K, kb, 32); } while (0)
#define A3_LOADV(kb) do { sa0 = A3_G(c.V0, kb, 0); sa1 = A3_G(c.V0, kb, 32); sb0 = A3_G(c.V1, kb, 0); sb1 = A3_G(c.V1, kb, 32); } while (0)
#define A3_WRITEK(buf) do { *(bf16x8*)(K_lds + (buf) * SHM_K + kws) = sk0; *(bf16x8*)(K_lds + (buf) * SHM_K + kws + 32 * 256) = sk1; } while (0)
#define A3_WRITEV(buf) do { *(bf16x8*)(V_lds + (buf) * 2 * SHM_V + vst0) = sa0; *(bf16x8*)(V_lds + (buf) * 2 * SHM_V + vst1) = sa1; \
        *(bf16x8*)(V_lds + (buf) * 2 * SHM_V + SHM_V + vst0) = sb0; *(bf16x8*)(V_lds + (buf) * 2 * SHM_V + SHM_V + vst1) = sb1; } while (0)
#define A3_VMW() asm volatile("s_waitcnt vmcnt(0)" ::: "memory")
#define A3_SOFTMAX_PUBLISH(T, PS) do { float mn_, alpha_; \
        if (64 * (T) + 63 > qlo) mask_tile(p0, p1, qm - 64 * (T), 16384u); \
        partialSM(p0, p1, m_reg, mn_, alpha_); finishSM(p0, p1, alpha_, l_reg, pa0, pa1, pa2, pa3); \
        *(bf16x8*)(X + lane * 16) = pa0; *(bf16x8*)(X + 1024 + lane * 16) = pa1; *(bf16x8*)(X + 2048 + lane * 16) = pa2; *(bf16x8*)(X + 3072 + lane * 16) = pa3; \
        if (hi == 0) { XS[(PS) * 96 + r32] = alpha_; XS[(PS) * 96 + 32 + r32] = m_reg; XS[(PS) * 96 + 64 + r32] = l_reg; } } while (0)
    A3_LOADK(0); A3_LOADV(0); A3_VMW(); A3_WRITEK(0); A3_WRITEV(0); A3_LOADK(64); A3_VMW(); A3_WRITEK(1);
    __syncthreads();
    if (vh == 0) { f32x16 p0, p1; qkt<0, false>(p0, p1, K_lds, r32, hi, qr, true); A3_SOFTMAX_PUBLISH(0, 0); }
    __syncthreads();
#define A3_STEP(t, B) do { const bool more1_ = (t) + 1 < NT, more2_ = (t) + 2 < NT; \
        f32x16 p0, p1; \
        if (vh != (B) && more1_) { qkt<(B) ^ 1, false>(p0, p1, K_lds, r32, hi, qr, true); } \
        SBAR(); \
        if (more2_) A3_LOADK(((t) + 2) * 64); if (more1_) A3_LOADV(((t) + 1) * 64); \
        if (vh != (B)) { pa0 = *(const bf16x8*)(X + lane * 16); pa1 = *(const bf16x8*)(X + 1024 + lane * 16); pa2 = *(const bf16x8*)(X + 2048 + lane * 16); pa3 = *(const bf16x8*)(X + 3072 + lane * 16); \
            m_reg = XS[(B) * 96 + 32 + r32]; l_reg = XS[(B) * 96 + 64 + r32]; } \
        { const float a_ = XS[(B) * 96 + r32]; if (__any(a_ < 1.f)) { \
            _Pragma("unroll") for (int d_ = 0; d_ < 4; ++d_) _Pragma("unroll") for (int r = 0; r < 16; ++r) o[d_][r] *= XS[(B) * 96 + crow(r, hi)]; } } \
        pv_tile<2 * (B), false>(o, vb0, pa0, pa1, pa2, pa3, true); \
        SBAR(); \
        if (vh != (B) && more1_) A3_SOFTMAX_PUBLISH((t) + 1, (B) ^ 1); \
        if (more1_) { A3_VMW(); if (more2_) A3_WRITEK(B); A3_WRITEV((B) ^ 1); } \
        __syncthreads(); } while (0)
    for (int t = 0; t < NT; t += 2) { A3_STEP(t, 0); A3_STEP(t + 1, 1); }
    float rli[16];
#pragma unroll
    for (int r = 0; r < 16; ++r) rli[r] = __builtin_amdgcn_rcpf(XS[96 + 64 + crow(r, hi)]);
    bf16* Ow = c.O + (size_t)(rg * 32) * LDO + vh * 128;
#pragma unroll
    for (int r = 0; r < 16; ++r) { const int orow = crow(r, hi);
#pragma unroll
        for (int d0 = 0; d0 < 4; ++d0) { const float v = o[d0][r] * rli[r]; const float vn = __shfl_xor(v, 1);
            if ((r32 & 1) == 0) *(unsigned*)(Ow + (size_t)orow * LDO + d0 * 32 + r32) = cvtpk(v, vn); } }
    __syncthreads();
#undef A3_G
#undef A3_LOADK
#undef A3_LOADV
#undef A3_WRITEK
#undef A3_WRITEV
#undef A3_VMW
#undef A3_SOFTMAX_PUBLISH
#undef A3_STEP
}

constexpr int A4_XS = 4096 + 512;
constexpr int A4_AL = A2_X + 4 * A4_XS;
constexpr int A4_LDS = A4_AL + 8 * 128;
__device__ __forceinline__ void attn4_block(const A2Ref& c, char* lds, const int mk_wave) {
    int lane_ = (int)(__builtin_amdgcn_mbcnt_hi(~0u, __builtin_amdgcn_mbcnt_lo(~0u, 0u)) & 63u); asm volatile("" : "+v"(lane_));
    const int lane = lane_ & 63, wid = mk_wave & 7, tid = wid * 64 + lane, r32 = lane & 31, hi = lane >> 5, rg = wid & 3, vh = wid >> 2;
    char* V_lds = lds + A2_V; char* K_lds = lds + A2_K; char* X = lds + A2_X + rg * A4_XS;
    float* XM = (float*)(X + 4096); float* XL = XM + 64; float* AL = (float*)(lds + A4_AL + wid * 128);
    const int NT = (c.P0 + 127) / 64 + 1;
    const int qlo = c.P0 + rg * 32, qm = qlo + r32 - 4 * hi;
    const int sr = tid >> 4, sc = (tid & 15) * 8, vst0 = v_st(sr, sc), vst1 = v_st(32 + sr, sc), kws = KSWZ(sr, sc * 2);
    const unsigned so = (unsigned)(sr * 128 + sc) * 2u;
    const int vb0 = (int)(uintptr_t)V_lds + vh * SHM_V + v_rd_base(lane);
    bf16x8 qr[8];
#pragma unroll
    for (int d0 = 0; d0 < 8; ++d0) qr[d0] = load8<bf16>(c.Q + (size_t)(rg * 32 + r32) * 128 + d0 * 16 + hi * 8);
    float m_reg = -1e30f, l_reg = 0.f; f32x16 o[4] = {};
    bf16x8 sk0, sk1, sa0, sa1, sb0, sb1;
    constexpr float C2 = 1.4426950408889634f * SCALE;
#define A4_G(base, kb, rows) (*(const bf16x8*)((const char*)((base) + (size_t)((kb) + (rows)) * 128) + so))
#define A4_LOAD(kb) do { sk0 = A4_G(c.K, kb, 0); sk1 = A4_G(c.K, kb, 32); sa0 = A4_G(c.V0, kb, 0); sa1 = A4_G(c.V0, kb, 32); sb0 = A4_G(c.V1, kb, 0); sb1 = A4_G(c.V1, kb, 32); } while (0)
#define A4_WRITE(buf) do { *(bf16x8*)(K_lds + (buf) * SHM_K + kws) = sk0; *(bf16x8*)(K_lds + (buf) * SHM_K + kws + 32 * 256) = sk1; \
        *(bf16x8*)(V_lds + (buf) * 2 * SHM_V + vst0) = sa0; *(bf16x8*)(V_lds + (buf) * 2 * SHM_V + vst1) = sa1; \
        *(bf16x8*)(V_lds + (buf) * 2 * SHM_V + SHM_V + vst0) = sb0; *(bf16x8*)(V_lds + (buf) * 2 * SHM_V + SHM_V + vst1) = sb1; } while (0)
#define A4_VMW() asm volatile("s_waitcnt vmcnt(0)" ::: "memory")
#define A4_PK(P, B_, OUT) do { unsigned a0_ = cvtpk(P[B_+0], P[B_+1]), a1_ = cvtpk(P[B_+2], P[B_+3]), b0_ = cvtpk(P[B_+4], P[B_+5]), b1_ = cvtpk(P[B_+6], P[B_+7]); \
        auto r0_ = __builtin_amdgcn_permlane32_swap(a0_, b0_, false, false); auto r1_ = __builtin_amdgcn_permlane32_swap(a1_, b1_, false, false); \
        u32x4 w_ = {r0_[0], r1_[0], r0_[1], r1_[1]}; OUT = *reinterpret_cast<bf16x8*>(&w_); } while (0)
    A4_LOAD(0); A4_VMW(); A4_WRITE(0); A4_LOAD(64);
    __syncthreads();
#define A4_STEP(t, B) do { \
        f32x16 p = f32x16{}; \
        { const char* kb_[4]; \
          _Pragma("unroll") for (int dd = 0; dd < 4; ++dd) kb_[dd] = K_lds + (B) * SHM_K + vh * (32 * 256) + KSWZ(r32, (dd * 16 + hi * 8) * 2); \
          _Pragma("unroll") for (int d0 = 0; d0 < 8; ++d0) { const bf16x8 b_ = *reinterpret_cast<const bf16x8*>(kb_[d0 & 3] + (d0 >> 2) * 128); p = __builtin_amdgcn_mfma_f32_32x32x16_bf16(b_, qr[d0], p, 0, 0, 0); } } \
        if (64 * (t) + 32 * vh + 31 > qlo) { const int dq_ = qm - 64 * (t) - 32 * vh; \
            _Pragma("unroll") for (int r = 0; r < 16; ++r) { const int cc_ = (r & 3) + 8 * (r >> 2); if ((unsigned)(dq_ - cc_) >= 16384u) p[r] = -__builtin_inff(); } } \
        float pmax_ = p[0]; \
        _Pragma("unroll") for (int r = 1; r < 16; ++r) pmax_ = fmaxf(pmax_, p[r]); \
        { auto rr_ = __builtin_amdgcn_permlane32_swap(__float_as_uint(pmax_), __float_as_uint(pmax_), false, false); pmax_ = fmaxf(__uint_as_float(rr_[0]), __uint_as_float(rr_[1])); } \
        if (hi == 0) XM[vh * 32 + r32] = pmax_; \
        __syncthreads(); \
        if ((t) + 1 < NT) { A4_VMW(); A4_WRITE((B) ^ 1); if ((t) + 2 < NT) A4_LOAD(((t) + 2) * 64); } \
        pmax_ = fmaxf(pmax_, XM[(vh ^ 1) * 32 + r32]); \
        float mn_, alpha_; \
        if (__builtin_expect(__all((pmax_ - m_reg) * SCALE <= THR), 1)) { mn_ = m_reg; alpha_ = 1.f; } \
        else { mn_ = fmaxf(m_reg, pmax_); alpha_ = __builtin_amdgcn_exp2f((m_reg - mn_) * C2); m_reg = mn_; } \
        { const float mnL_ = -mn_ * C2; float ps_ = 0.f; \
          _Pragma("unroll") for (int r = 0; r < 16; ++r) { p[r] = __builtin_amdgcn_exp2f(fmaf(p[r], C2, mnL_)); ps_ += p[r]; } \
          auto rr_ = __builtin_amdgcn_permlane32_swap(__float_as_uint(ps_), __float_as_uint(ps_), false, false); ps_ = __uint_as_float(rr_[0]) + __uint_as_float(rr_[1]); \
          l_reg = l_reg * alpha_ + ps_; } \
        bf16x8 pa0, pa1, pa2, pa3, pm0_, pm1_; \
        A4_PK(p, 0, pm0_); A4_PK(p, 8, pm1_); \
        *(bf16x8*)(X + vh * 2048 + lane * 16) = pm0_; *(bf16x8*)(X + vh * 2048 + 1024 + lane * 16) = pm1_; \
        if (hi == 0) AL[r32] = alpha_; \
        __syncthreads(); \
        { const bf16x8 po0_ = *(const bf16x8*)(X + (vh ^ 1) * 2048 + lane * 16), po1_ = *(const bf16x8*)(X + (vh ^ 1) * 2048 + 1024 + lane * 16); \
          if (vh == 0) { pa0 = pm0_; pa1 = pm1_; pa2 = po0_; pa3 = po1_; } else { pa0 = po0_; pa1 = po1_; pa2 = pm0_; pa3 = pm1_; } } \
        if (__any(alpha_ < 1.f)) { \
            _Pragma("unroll") for (int d_ = 0; d_ < 4; ++d_) _Pragma("unroll") for (int r = 0; r < 16; ++r) o[d_][r] *= AL[crow(r, hi)]; } \
        pv_tile<2 * (B), false>(o, vb0, pa0, pa1, pa2, pa3, true); \
    } while (0)
    for (int t = 0; t < NT; t += 2) { A4_STEP(t, 0); A4_STEP(t + 1, 1); }
    if (hi == 0) XL[vh * 32 + r32] = l_reg;
    __syncthreads();
    float rli[16];
#pragma unroll
    for (int r = 0; r < 16; ++r) rli[r] = __builtin_amdgcn_rcpf(XL[crow(r, hi)] + XL[32 + crow(r, hi)]);
    bf16* Ow = c.O + (size_t)(rg * 32) * LDO + vh * 128;
#pragma unroll
    for (int r = 0; r < 16; ++r) { const int orow = crow(r, hi);
#pragma unroll
        for (int d0 = 0; d0 < 4; ++d0) { const float v = o[d0][r] * rli[r]; const float vn = __shfl_xor(v, 1);
            if ((r32 & 1) == 0) *(unsigned*)(Ow + (size_t)orow * LDO + d0 * 32 + r32) = cvtpk(v, vn); } }
    __syncthreads();
#undef A4_G
#undef A4_LOAD
#undef A4_WRITE
#undef A4_VMW
#undef A4_PK
#undef A4_STEP
}

__device__ __forceinline__ void attn5_block(const A2Ref& c, char* lds, const int mk_wave) {
    int lane_ = (int)(__builtin_amdgcn_mbcnt_hi(~0u, __builtin_amdgcn_mbcnt_lo(~0u, 0u)) & 63u); asm volatile("" : "+v"(lane_));
    const int lane = lane_ & 63, wid = mk_wave & 7, tid = wid * 64 + lane, r32 = lane & 31, hi = lane >> 5, rg = wid & 3, vh = wid >> 2;
    char* V_lds = lds + A2_V; char* K_lds = lds + A2_K; char* X = lds + A2_X + rg * A4_XS;
    float* XM = (float*)(X + 4096); float* XL = XM + 64; float* AL = (float*)(lds + A4_AL + wid * 128);
    const int NT = (c.P0 + 127) / 64 + 1;
    const int qlo = c.P0 + rg * 32, qm = qlo + r32 - 4 * hi;
    const int sr = tid >> 4, sc = (tid & 15) * 8, vst0 = v_st(sr, sc), vst1 = v_st(32 + sr, sc), kws = KSWZ(sr, sc * 2);
    const unsigned so = (unsigned)(sr * 128 + sc) * 2u;
    const int vb0 = (int)(uintptr_t)V_lds + vh * SHM_V + v_rd_base(lane);
    bf16x8 qr[8];
#pragma unroll
    for (int d0 = 0; d0 < 8; ++d0) qr[d0] = load8<bf16>(c.Q + (size_t)(rg * 32 + r32) * 128 + d0 * 16 + hi * 8);
    float m_reg = -1e30f, l_reg = 0.f; f32x16 o[4] = {};
    bf16x8 sk0, sk1, sa0, sa1, sb0, sb1;
    constexpr float C2 = 1.4426950408889634f * SCALE;
#define A4_G(base, kb, rows) (*(const bf16x8*)((const char*)((base) + (size_t)((kb) + (rows)) * 128) + so))
#define A4_LOAD(kb) do { sk0 = A4_G(c.K, kb, 0); sk1 = A4_G(c.K, kb, 32); sa0 = A4_G(c.V0, kb, 0); sa1 = A4_G(c.V0, kb, 32); sb0 = A4_G(c.V1, kb, 0); sb1 = A4_G(c.V1, kb, 32); } while (0)
#define A4_WRITE(buf) do { *(bf16x8*)(K_lds + (buf) * SHM_K + kws) = sk0; *(bf16x8*)(K_lds + (buf) * SHM_K + kws + 32 * 256) = sk1; \
        *(bf16x8*)(V_lds + (buf) * 2 * SHM_V + vst0) = sa0; *(bf16x8*)(V_lds + (buf) * 2 * SHM_V + vst1) = sa1; \
        *(bf16x8*)(V_lds + (buf) * 2 * SHM_V + SHM_V + vst0) = sb0; *(bf16x8*)(V_lds + (buf) * 2 * SHM_V + SHM_V + vst1) = sb1; } while (0)
#define A4_VMW() asm volatile("s_waitcnt vmcnt(0)" ::: "memory")
#define A4_PK(P, B_, OUT) do { unsigned a0_ = cvtpk(P[B_+0], P[B_+1]), a1_ = cvtpk(P[B_+2], P[B_+3]), b0_ = cvtpk(P[B_+4], P[B_+5]), b1_ = cvtpk(P[B_+6], P[B_+7]); \
        auto r0_ = __builtin_amdgcn_permlane32_swap(a0_, b0_, false, false); auto r1_ = __builtin_amdgcn_permlane32_swap(a1_, b1_, false, false); \
        u32x4 w_ = {r0_[0], r1_[0], r0_[1], r1_[1]}; OUT = *reinterpret_cast<bf16x8*>(&w_); } while (0)
#define A5_QK(T, KB) do { p = f32x16{}; \
        { const char* kb_[4]; \
          _Pragma("unroll") for (int dd = 0; dd < 4; ++dd) kb_[dd] = K_lds + (KB) * SHM_K + vh * (32 * 256) + KSWZ(r32, (dd * 16 + hi * 8) * 2); \
          _Pragma("unroll") for (int d0 = 0; d0 < 8; ++d0) { const bf16x8 b_ = *reinterpret_cast<const bf16x8*>(kb_[d0 & 3] + (d0 >> 2) * 128); p = __builtin_amdgcn_mfma_f32_32x32x16_bf16(b_, qr[d0], p, 0, 0, 0); } } } while (0)
#define A5_MAX(T) do { \
        if (64 * (T) + 32 * vh + 31 > qlo) { const int dq_ = qm - 64 * (T) - 32 * vh; \
            _Pragma("unroll") for (int r = 0; r < 16; ++r) { const int cc_ = (r & 3) + 8 * (r >> 2); if ((unsigned)(dq_ - cc_) >= 16384u) p[r] = -__builtin_inff(); } } \
        pmax_ = p[0]; \
        _Pragma("unroll") for (int r = 1; r < 16; ++r) pmax_ = fmaxf(pmax_, p[r]); \
        { auto rr_ = __builtin_amdgcn_permlane32_swap(__float_as_uint(pmax_), __float_as_uint(pmax_), false, false); pmax_ = fmaxf(__uint_as_float(rr_[0]), __uint_as_float(rr_[1])); } \
        if (hi == 0) XM[vh * 32 + r32] = pmax_; } while (0)
#define A5_SOFTMAX() do { \
        pmax_ = fmaxf(pmax_, XM[(vh ^ 1) * 32 + r32]); \
        float mn_; \
        if (__builtin_expect(__all((pmax_ - m_reg) * SCALE <= THR), 1)) { mn_ = m_reg; alpha_ = 1.f; } \
        else { mn_ = fmaxf(m_reg, pmax_); alpha_ = __builtin_amdgcn_exp2f((m_reg - mn_) * C2); m_reg = mn_; } \
        { const float mnL_ = -mn_ * C2; float ps_ = 0.f; \
          _Pragma("unroll") for (int r = 0; r < 16; ++r) { p[r] = __builtin_amdgcn_exp2f(fmaf(p[r], C2, mnL_)); ps_ += p[r]; } \
          auto rr_ = __builtin_amdgcn_permlane32_swap(__float_as_uint(ps_), __float_as_uint(ps_), false, false); ps_ = __uint_as_float(rr_[0]) + __uint_as_float(rr_[1]); \
          l_reg = l_reg * alpha_ + ps_; } \
        A4_PK(p, 0, pm0_); A4_PK(p, 8, pm1_); \
        *(bf16x8*)(X + vh * 2048 + lane * 16) = pm0_; *(bf16x8*)(X + vh * 2048 + 1024 + lane * 16) = pm1_; \
        if (hi == 0) AL[r32] = alpha_; } while (0)
    f32x16 p; float pmax_, alpha_ = 1.f; bf16x8 pm0_, pm1_;
    A4_LOAD(0); A4_VMW(); A4_WRITE(0); A4_LOAD(64); A4_VMW(); A4_WRITE(1); if (2 < NT) A4_LOAD(128);
    __syncthreads();
    A5_QK(0, 0); A5_MAX(0);
    __syncthreads();
    A5_SOFTMAX();
    __syncthreads();
#define A5_STEP(t, B) do { \
        bf16x8 pa0, pa1, pa2, pa3; \
        { const bf16x8 po0_ = *(const bf16x8*)(X + (vh ^ 1) * 2048 + lane * 16), po1_ = *(const bf16x8*)(X + (vh ^ 1) * 2048 + 1024 + lane * 16); \
          if (vh == 0) { pa0 = pm0_; pa1 = pm1_; pa2 = po0_; pa3 = po1_; } else { pa0 = po0_; pa1 = po1_; pa2 = pm0_; pa3 = pm1_; } } \
        const bool more1_ = (t) + 1 < NT; \
        if (more1_) A5_QK((t) + 1, (B) ^ 1); \
        if (__any(alpha_ < 1.f)) { \
            _Pragma("unroll") for (int d_ = 0; d_ < 4; ++d_) _Pragma("unroll") for (int r = 0; r < 16; ++r) o[d_][r] *= AL[crow(r, hi)]; } \
        pv_tile<2 * (B), false>(o, vb0, pa0, pa1, pa2, pa3, true); \
        if (more1_) { A5_MAX((t) + 1); \
            __syncthreads(); \
            if ((t) + 2 < NT) { A4_VMW(); A4_WRITE(B); if ((t) + 3 < NT) A4_LOAD(((t) + 3) * 64); } \
            A5_SOFTMAX(); \
            __syncthreads(); } \
    } while (0)
    for (int t = 0; t < NT; t += 2) { A5_STEP(t, 0); A5_STEP(t + 1, 1); }
    __syncthreads();
    if (hi == 0) XL[vh * 32 + r32] = l_reg;
    __syncthreads();
    float rli[16];
#pragma unroll
    for (int r = 0; r < 16; ++r) rli[r] = __builtin_amdgcn_rcpf(XL[crow(r, hi)] + XL[32 + crow(r, hi)]);
    bf16* Ow = c.O + (size_t)(rg * 32) * LDO + vh * 128;
#pragma unroll
    for (int r = 0; r < 16; ++r) { const int orow = crow(r, hi);
#pragma unroll
        for (int d0 = 0; d0 < 4; ++d0) { const float v = o[d0][r] * rli[r]; const float vn = __shfl_xor(v, 1);
            if ((r32 & 1) == 0) *(unsigned*)(Ow + (size_t)orow * LDO + d0 * 32 + r32) = cvtpk(v, vn); } }
    __syncthreads();
#undef A4_G
#undef A4_LOAD
#undef A4_WRITE
#undef A4_VMW
#undef A4_PK
#undef A5_QK
#undef A5_MAX
#undef A5_SOFTMAX
#undef A5_STEP
}

constexpr int A6_XS = 8192 + 1024;
constexpr int A6_LDS = A2_X + 4 * A6_XS + 8 * 128;
__device__ __forceinline__ void attn6_block(const A2Ref& c, char* lds, const int mk_wave) {
    int lane_ = (int)(__builtin_amdgcn_mbcnt_hi(~0u, __builtin_amdgcn_mbcnt_lo(~0u, 0u)) & 63u); asm volatile("" : "+v"(lane_));
    const int lane = lane_ & 63, wid = mk_wave & 7, tid = wid * 64 + lane, r32 = lane & 31, hi = lane >> 5, rg = wid & 3, vh = wid >> 2;
    char* V_lds = lds + A2_V; char* K_lds = lds + A2_K; char* X = lds + A2_X + rg * A6_XS;
    float* XM = (float*)(X + 8192); float* XL = XM + 128; float* AL = (float*)(lds + A2_X + 4 * A6_XS + wid * 128);
    const int NT = (c.P0 + 127) / 64 + 1;
    const int qlo = c.P0 + rg * 32, qm = qlo + r32 - 4 * hi;
    const int sr = tid >> 4, sc = (tid & 15) * 8, vst0 = v_st(sr, sc), vst1 = v_st(32 + sr, sc), kws = KSWZ(sr, sc * 2);
    const unsigned so = (unsigned)(sr * 128 + sc) * 2u;
    const int vb0 = (int)(uintptr_t)V_lds + vh * SHM_V + v_rd_base(lane);
    bf16x8 qr[8];
#pragma unroll
    for (int d0 = 0; d0 < 8; ++d0) qr[d0] = load8<bf16>(c.Q + (size_t)(rg * 32 + r32) * 128 + d0 * 16 + hi * 8);
    float m_reg = -1e30f, l_reg = 0.f; f32x16 o[4] = {};
    bf16x8 sk0, sk1, sa0, sa1, sb0, sb1;
    constexpr float C2 = 1.4426950408889634f * SCALE;
#define A4_G(base, kb, rows) (*(const bf16x8*)((const char*)((base) + (size_t)((kb) + (rows)) * 128) + so))
#define A4_LOAD(kb) do { sk0 = A4_G(c.K, kb, 0); sk1 = A4_G(c.K, kb, 32); sa0 = A4_G(c.V0, kb, 0); sa1 = A4_G(c.V0, kb, 32); sb0 = A4_G(c.V1, kb, 0); sb1 = A4_G(c.V1, kb, 32); } while (0)
#define A4_WRITE(buf) do { *(bf16x8*)(K_lds + (buf) * SHM_K + kws) = sk0; *(bf16x8*)(K_lds + (buf) * SHM_K + kws + 32 * 256) = sk1; \
        *(bf16x8*)(V_lds + (buf) * 2 * SHM_V + vst0) = sa0; *(bf16x8*)(V_lds + (buf) * 2 * SHM_V + vst1) = sa1; \
        *(bf16x8*)(V_lds + (buf) * 2 * SHM_V + SHM_V + vst0) = sb0; *(bf16x8*)(V_lds + (buf) * 2 * SHM_V + SHM_V + vst1) = sb1; } while (0)
#define A6_LOADK(kb) do { sk0 = A4_G(c.K, kb, 0); sk1 = A4_G(c.K, kb, 32); } while (0)
#define A6_LOADV(kb) do { sa0 = A4_G(c.V0, kb, 0); sa1 = A4_G(c.V0, kb, 32); sb0 = A4_G(c.V1, kb, 0); sb1 = A4_G(c.V1, kb, 32); } while (0)
#define A6_WRITEK(buf) do { *(bf16x8*)(K_lds + (buf) * SHM_K + kws) = sk0; *(bf16x8*)(K_lds + (buf) * SHM_K + kws + 32 * 256) = sk1; } while (0)
#define A6_WRITEV(buf) do { *(bf16x8*)(V_lds + (buf) * 2 * SHM_V + vst0) = sa0; *(bf16x8*)(V_lds + (buf) * 2 * SHM_V + vst1) = sa1; \
        *(bf16x8*)(V_lds + (buf) * 2 * SHM_V + SHM_V + vst0) = sb0; *(bf16x8*)(V_lds + (buf) * 2 * SHM_V + SHM_V + vst1) = sb1; } while (0)
#define A4_VMW() asm volatile("s_waitcnt vmcnt(0)" ::: "memory")
#define A4_PK(P, B_, OUT) do { unsigned a0_ = cvtpk(P[B_+0], P[B_+1]), a1_ = cvtpk(P[B_+2], P[B_+3]), b0_ = cvtpk(P[B_+4], P[B_+5]), b1_ = cvtpk(P[B_+6], P[B_+7]); \
        auto r0_ = __builtin_amdgcn_permlane32_swap(a0_, b0_, false, false); auto r1_ = __builtin_amdgcn_permlane32_swap(a1_, b1_, false, false); \
        u32x4 w_ = {r0_[0], r1_[0], r0_[1], r1_[1]}; OUT = *reinterpret_cast<bf16x8*>(&w_); } while (0)
#define A5_QK(T, KB) do { p = f32x16{}; \
        { const char* kb_[4]; \
          _Pragma("unroll") for (int dd = 0; dd < 4; ++dd) kb_[dd] = K_lds + (KB) * SHM_K + vh * (32 * 256) + KSWZ(r32, (dd * 16 + hi * 8) * 2); \
          _Pragma("unroll") for (int d0 = 0; d0 < 8; ++d0) { const bf16x8 b_ = *reinterpret_cast<const bf16x8*>(kb_[d0 & 3] + (d0 >> 2) * 128); p = __builtin_amdgcn_mfma_f32_32x32x16_bf16(b_, qr[d0], p, 0, 0, 0); } } } while (0)
#define A5_MAX(T) do { \
        if (64 * (T) + 32 * vh + 31 > qlo) { const int dq_ = qm - 64 * (T) - 32 * vh; \
            _Pragma("unroll") for (int r = 0; r < 16; ++r) { const int cc_ = (r & 3) + 8 * (r >> 2); if ((unsigned)(dq_ - cc_) >= 16384u) p[r] = -__builtin_inff(); } } \
        pmax_ = p[0]; \
        _Pragma("unroll") for (int r = 1; r < 16; ++r) pmax_ = fmaxf(pmax_, p[r]); \
        { auto rr_ = __builtin_amdgcn_permlane32_swap(__float_as_uint(pmax_), __float_as_uint(pmax_), false, false); pmax_ = fmaxf(__uint_as_float(rr_[0]), __uint_as_float(rr_[1])); } \
        if (hi == 0) XM[vh * 32 + r32] = pmax_; } while (0)
#define A5_SOFTMAX() do { \
        pmax_ = fmaxf(pmax_, XM[(vh ^ 1) * 32 + r32]); \
        float mn_; \
        if (__builtin_expect(__all((pmax_ - m_reg) * SCALE <= THR), 1)) { mn_ = m_reg; alpha_ = 1.f; } \
        else { mn_ = fmaxf(m_reg, pmax_); alpha_ = __builtin_amdgcn_exp2f((m_reg - mn_) * C2); m_reg = mn_; } \
        { const float mnL_ = -mn_ * C2; float ps_ = 0.f; \
          _Pragma("unroll") for (int r = 0; r < 16; ++r) { p[r] = __builtin_amdgcn_exp2f(fmaf(p[r], C2, mnL_)); ps_ += p[r]; } \
          auto rr_ = __builtin_amdgcn_permlane32_swap(__float_as_uint(ps_), __float_as_uint(ps_), false, false); ps_ = __uint_as_float(rr_[0]) + __uint_as_float(rr_[1]); \
          l_reg = l_reg * alpha_ + ps_; } \
        A4_PK(p, 0, pm0_); A4_PK(p, 8, pm1_); \
        *(bf16x8*)(X + vh * 2048 + lane * 16) = pm0_; *(bf16x8*)(X + vh * 2048 + 1024 + lane * 16) = pm1_; \
        if (hi == 0) AL[r32] = alpha_; } while (0)
    f32x16 p; float pmax_, alpha_ = 1.f; bf16x8 pm0_, pm1_;
    A4_LOAD(0); A4_VMW(); A4_WRITE(0); A6_LOADK(64); A4_VMW(); A6_WRITEK(1); A6_LOADV(64); if (2 < NT) A6_LOADK(128);
    __syncthreads();
    A5_QK(0, 0); A5_MAX(0);
    __syncthreads();
    A5_SOFTMAX();
    __syncthreads();
#define A6_STEP(t, B) do { \
        bf16x8 pa0, pa1, pa2, pa3; \
        { const bf16x8 po0_ = *(const bf16x8*)(X + (B) * 4096 + (vh ^ 1) * 2048 + lane * 16), po1_ = *(const bf16x8*)(X + (B) * 4096 + (vh ^ 1) * 2048 + 1024 + lane * 16); \
          if (vh == 0) { pa0 = pm0_; pa1 = pm1_; pa2 = po0_; pa3 = po1_; } else { pa0 = po0_; pa1 = po1_; pa2 = pm0_; pa3 = pm1_; } } \
        const float cand_ = fmaxf(pmax_, XM[(B) * 64 + (vh ^ 1) * 32 + r32]);                         \
        const bool more1_ = (t) + 1 < NT; \
        if (more1_) { A4_VMW(); A6_WRITEV((B) ^ 1); if ((t) + 2 < NT) A6_LOADV(((t) + 2) * 64); }     \
        if (more1_) A5_QK((t) + 1, (B) ^ 1); \
        pv_tile<2 * (B), false>(o, vb0, pa0, pa1, pa2, pa3, true); \
        if (!__all((cand_ - m_reg) * SCALE <= THR)) {                                      \
            const float mn_ = fmaxf(m_reg, cand_), al_ = __builtin_amdgcn_exp2f((m_reg - mn_) * C2); m_reg = mn_; l_reg *= al_; \
            if (hi == 0) AL[r32] = al_; asm volatile("s_waitcnt lgkmcnt(0)" ::: "memory"); \
            _Pragma("unroll") for (int d_ = 0; d_ < 4; ++d_) _Pragma("unroll") for (int r = 0; r < 16; ++r) o[d_][r] *= AL[crow(r, hi)]; } \
        if (more1_) { \
            if (64 * ((t) + 1) + 32 * vh + 31 > qlo) { const int dq_ = qm - 64 * ((t) + 1) - 32 * vh; \
                _Pragma("unroll") for (int r = 0; r < 16; ++r) { const int cc_ = (r & 3) + 8 * (r >> 2); if ((unsigned)(dq_ - cc_) >= 16384u) p[r] = -__builtin_inff(); } } \
            pmax_ = p[0]; \
            _Pragma("unroll") for (int r = 1; r < 16; ++r) pmax_ = fmaxf(pmax_, p[r]); \
            { auto rr_ = __builtin_amdgcn_permlane32_swap(__float_as_uint(pmax_), __float_as_uint(pmax_), false, false); pmax_ = fmaxf(__uint_as_float(rr_[0]), __uint_as_float(rr_[1])); } \
            { const float mnL_ = -m_reg * C2; float ps_ = 0.f; \
              _Pragma("unroll") for (int r = 0; r < 16; ++r) { p[r] = __builtin_amdgcn_exp2f(fmaf(p[r], C2, mnL_)); ps_ += p[r]; } \
              auto rr_ = __builtin_amdgcn_permlane32_swap(__float_as_uint(ps_), __float_as_uint(ps_), false, false); ps_ = __uint_as_float(rr_[0]) + __uint_as_float(rr_[1]); \
              l_reg += ps_; } \
            A4_PK(p, 0, pm0_); A4_PK(p, 8, pm1_); \
            *(bf16x8*)(X + ((B) ^ 1) * 4096 + vh * 2048 + lane * 16) = pm0_; *(bf16x8*)(X + ((B) ^ 1) * 4096 + vh * 2048 + 1024 + lane * 16) = pm1_; \
            if (hi == 0) XM[((B) ^ 1) * 64 + vh * 32 + r32] = pmax_; \
            if ((t) + 2 < NT) { A6_WRITEK(B); if ((t) + 3 < NT) A6_LOADK(((t) + 3) * 64); }     \
            __syncthreads(); } \
    } while (0)
    for (int t = 0; t < NT; t += 2) { A6_STEP(t, 0); A6_STEP(t + 1, 1); }
    __syncthreads();
    if (hi == 0) XL[vh * 32 + r32] = l_reg;
    __syncthreads();
    float rli[16];
#pragma unroll
    for (int r = 0; r < 16; ++r) rli[r] = __builtin_amdgcn_rcpf(XL[crow(r, hi)] + XL[32 + crow(r, hi)]);
    bf16* Ow = c.O + (size_t)(rg * 32) * LDO + vh * 128;
#pragma unroll
    for (int r = 0; r < 16; ++r) { const int orow = crow(r, hi);
#pragma unroll
        for (int d0 = 0; d0 < 4; ++d0) { const float v = o[d0][r] * rli[r]; const float vn = __shfl_xor(v, 1);
            if ((r32 & 1) == 0) *(unsigned*)(Ow + (size_t)orow * LDO + d0 * 32 + r32) = cvtpk(v, vn); } }
    __syncthreads();
#undef A4_G
#undef A4_LOAD
#undef A4_WRITE
#undef A4_VMW
#undef A4_PK
#undef A5_QK
#undef A5_MAX
#undef A5_SOFTMAX
#undef A6_STEP
#undef A6_WRITEK
#undef A6_LOADK
#undef A6_LOADV
#undef A6_WRITEV
}

}

constexpr int S_ = 16384, DM = 2048, FF = 5632, NIN = 6152, NINP = 6144, PLD = 3072;
constexpr int NWAVES = 8, NTHR = 512;
constexpr int C_MQ = 0, C_MK = 512, C_MV = 1024, C_MO = 2048;
constexpr size_t MiB = 1u << 20, KiB = 1u << 10;
constexpr size_t WS_ROWSS1 = 0, WS_ROWSS2 = 64 * KiB, WS_SC = 192 * KiB  , WS_DN = 256 * KiB, WS_GATES = 512 * KiB;
constexpr size_t WS_BAR = 128 * KiB;
constexpr size_t WS_WGU = 1 * MiB, WS_WD = 45 * MiB, WS_WIN = 67 * MiB, WS_WOUT = 92 * MiB;
constexpr size_t WS_XN = 100 * MiB;
constexpr size_t WS_BIG = 164 * MiB;
constexpr size_t WS_Y = 356 * MiB;
constexpr size_t WS_CT = 420 * MiB;
constexpr size_t WS_QC = 452 * MiB, WS_KC = 468 * MiB;
constexpr size_t WS_NST = 484 * MiB;
constexpr size_t WS_GW = 484 * MiB + 512 * KiB;
constexpr size_t WS_END = 485 * MiB;
constexpr int LDS_BYTES = 147456;

#define LAS __attribute__((address_space(3)))
typedef unsigned short bfu;
typedef unsigned v4u __attribute__((ext_vector_type(4)));
typedef unsigned v2u __attribute__((ext_vector_type(2)));
typedef float f32x4 __attribute__((ext_vector_type(4)));
typedef short bf16x8 __attribute__((ext_vector_type(8)));
#define MFMA16(a, b, c) __builtin_amdgcn_mfma_f32_16x16x32_bf16(a, b, c, 0, 0, 0)
#define LDS_WAIT() asm volatile("s_waitcnt lgkmcnt(0)" ::: "memory")
__device__ __forceinline__ unsigned f2bf(float f) { unsigned u = __builtin_bit_cast(unsigned, f); return (u + 0x7fffu + ((u >> 16) & 1u)) >> 16; }
__device__ __forceinline__ unsigned pk2(float lo, float hi) { return f2bf(lo) | (f2bf(hi) << 16); }
__device__ __forceinline__ float bf2f(unsigned b) { return __builtin_bit_cast(float, b << 16); }
__device__ __forceinline__ int mk_lane() { return (int)(__builtin_amdgcn_mbcnt_hi(~0u, __builtin_amdgcn_mbcnt_lo(~0u, 0u)) & 63u); }
__device__ __forceinline__ float wave_sum(float v) {
#pragma unroll
    for (int o = 1; o < 64; o <<= 1) v += __shfl_xor(v, o);
    return v;
}
__device__ __forceinline__ float silu(float x) { return x / (1.0f + __expf(-x)); }

__device__ __forceinline__ void cvt_item(const float* __restrict__ W, int ldw, int ncols, const float* __restrict__ gain, bfu* WT, int K, int dst_row0, int k0, int n0, LAS float* scr, int lane) {
    const int nq = (lane & 15) * 4, kr = lane >> 4, n = n0 + nq;
#pragma unroll 8
    for (int i = 0; i < 16; ++i) { const int kk = 4 * i + kr; f32x4 v = (f32x4){0.f, 0.f, 0.f, 0.f};
        if (n < ncols) v = *(const f32x4*)(W + (size_t)(k0 + kk) * ldw + n);
        if (gain) v = v * gain[k0 + kk];
        LAS float* d = scr + kk * 65 + nq; d[0] = v[0]; d[1] = v[1]; d[2] = v[2]; d[3] = v[3]; }
    LDS_WAIT(); asm volatile("" ::: "memory");
    const int c = lane & 7;
#pragma unroll
    for (int j = 0; j < 8; ++j) { const int nn = (lane >> 3) + 8 * j; const LAS float* s = scr + (8 * c) * 65 + nn;
        v4u o; o.x = pk2(s[0 * 65], s[1 * 65]); o.y = pk2(s[2 * 65], s[3 * 65]); o.z = pk2(s[4 * 65], s[5 * 65]); o.w = pk2(s[6 * 65], s[7 * 65]);
        *(v4u*)(WT + (size_t)(dst_row0 + nn) * K + k0 + 8 * c) = o; }
    LDS_WAIT(); asm volatile("" ::: "memory");
}
__device__ __forceinline__ void cvt_ffn_item(int it, const float* wg, const float* wu, const float* wd, const float* gain, bfu* Wgu, bfu* Wd, LAS float* scr, int lane) {
    if (it < 2 * 2816) { const int up = it >= 2816; const int r = up ? it - 2816 : it; const int kb = r / 88, nb = r % 88, n0 = nb * 64;
        cvt_item(up ? wu : wg, FF, FF, gain, Wgu, DM, 256 * (n0 >> 7) + (n0 & 127) + (up ? 128 : 0), kb * 64, n0, scr, lane); }
    else { const int r = it - 2 * 2816; const int kb = r / 32, nb = r % 32; cvt_item(wd, DM, DM, nullptr, Wd, FF, nb * 64, kb * 64, nb * 64, scr, lane); }
}

constexpr int GWP = 4112;
__device__ __forceinline__ void gates_rows(LAS unsigned char* lds, const bfu* __restrict__ XB, const float* __restrict__ rowss, const float* __restrict__ b_i, const float* __restrict__ b_f, float* GATES, int rb, int wave, int lane) {
    const int fr = lane & 15, fq = lane >> 4, rg = wave & 3, kh = wave >> 2;
    const LAS unsigned char* wl = lds + 16384;
    const bfu* xp = XB + (size_t)(rb * 64 + rg * 16 + fr) * DM + kh * 1024 + 8 * fq;
    f32x4 acc = (f32x4){0.f, 0.f, 0.f, 0.f};
    for (int k0 = 0; k0 < 32; k0 += 16) {
        bf16x8 xa[16];
#pragma unroll
        for (int ks = 0; ks < 16; ++ks) xa[ks] = *(const bf16x8*)(xp + (k0 + ks) * 32);
#pragma unroll
        for (int ks = 0; ks < 16; ++ks) { const bf16x8 wb = *(const LAS bf16x8*)(wl + fr * GWP + (kh * 1024 + (k0 + ks) * 32 + 8 * fq) * 2); acc = MFMA16(xa[ks], wb, acc); }
    }
    LAS f32x4* red = (LAS f32x4*)lds;
    if (kh == 1) red[rg * 64 + lane] = acc;
    __syncthreads();
    if (kh == 0 && fr < 8) {
        const f32x4 o = red[rg * 64 + lane]; const float bias = fr < 4 ? b_i[fr] : b_f[fr - 4];
#pragma unroll
        for (int j = 0; j < 4; ++j) { const int row = rb * 64 + rg * 16 + 4 * fq + j;
            const float pre = (acc[j] + o[j]) / sqrtf(rowss[row] * (1.0f / DM) + 1e-6f) + bias; const float capped = 15.0f * tanhf(pre * (1.0f / 15.0f));
            GATES[(size_t)row * 8 + fr] = fr < 4 ? capped : -log1pf(expf(-capped)); }
    }
    __syncthreads();
}

#define XB_TMO      128
#define XB_XCNT(j)  (256  + 64 * (j))
#define XB_XSUB(j)  (1280 + 64 * (j))
#define XB_XGEN(j)  (2304 + 64 * (j))
#define XB_TOP      3328
#define XB_TOPGEN   3392
#define XCD_BAR_WORDS 3456
#define XB_SPIN_CAP (1u << 18)
__device__ __forceinline__ unsigned xb_ld(unsigned* p)              { return __hip_atomic_load(p, __ATOMIC_RELAXED, __HIP_MEMORY_SCOPE_AGENT); }
__device__ __forceinline__ unsigned xb_add(unsigned* p, unsigned v) { return __hip_atomic_fetch_add(p, v, __ATOMIC_RELAXED, __HIP_MEMORY_SCOPE_AGENT); }
__device__ __forceinline__ unsigned xb_xcc_id() { return (unsigned)__builtin_amdgcn_s_getreg((3 << 11) | 20) & 0xFu; }
#define XB_SPIN(cond, bar) do { unsigned _sp = 0; while (cond) { __builtin_amdgcn_s_sleep(1); \
    if ((++_sp & 255u) == 0u) { if (xb_ld(&(bar)[XB_TMO])) break; if (_sp > XB_SPIN_CAP) { atomicAdd(&(bar)[XB_TMO], 1u); break; } } } } while (0)
__device__ __forceinline__ void xcd_barrier_complete(unsigned* bar, unsigned x, unsigned& nloc, unsigned& nx) {
    const unsigned G = gridDim.x * gridDim.y * gridDim.z;
    unsigned sum, cnt, mine, sp = 0u;
    for (;;) {
        sum = 0u; cnt = 0u; mine = 0u;
#pragma unroll
        for (unsigned j = 0; j < 16; ++j) { const unsigned c = xb_ld(&bar[XB_XCNT(j)]); sum += c; cnt += (c > 0u) ? 1u : 0u; mine = (j == x) ? c : mine; }
        if (sum == G) break;
        __builtin_amdgcn_s_sleep(1);
        if ((++sp & 255u) == 0u) { if (xb_ld(&bar[XB_TMO])) break; if (sp > XB_SPIN_CAP) { atomicAdd(&bar[XB_TMO], 1u); break; } }
    }
    nloc = mine > 0u ? mine : 1u; nx = cnt > 0u ? cnt : 1u;
}
__device__ __forceinline__ void xcd_barrier(unsigned* bar, volatile LAS unsigned* st, const bool first) {
    asm volatile("s_waitcnt vmcnt(0)" ::: "memory");
    __syncthreads();
    if (first) {
        const unsigned x = xb_xcc_id();
        __builtin_amdgcn_s_waitcnt(0);
        unsigned nloc = st[0], nx = st[1];
        if (nloc == 0u) { xcd_barrier_complete(bar, x, nloc, nx); st[0] = nloc; st[1] = nx; }
        const unsigned old = xb_add(&bar[XB_XSUB(x)], 1u);
        const unsigned gen = old / nloc;
        if (old + 1u == (gen + 1u) * nloc) {
            __builtin_amdgcn_fence(__ATOMIC_RELEASE, "agent");
            asm volatile("s_waitcnt vmcnt(0)" ::: "memory");
            const unsigned og = xb_add(&bar[XB_TOP], 1u);
            const unsigned tg = og / nx;
            if (og + 1u == (tg + 1u) * nx) xb_add(&bar[XB_TOPGEN], 1u);
            else XB_SPIN(xb_ld(&bar[XB_TOPGEN]) == tg, bar);
            __builtin_amdgcn_fence(__ATOMIC_ACQUIRE, "agent");
            xb_add(&bar[XB_XGEN(x)], 1u);
            asm volatile("s_waitcnt vmcnt(0)" ::: "memory");
        } else {
            XB_SPIN(xb_ld(&bar[XB_XGEN(x)]) == gen, bar);
            __builtin_amdgcn_fence(__ATOMIC_ACQUIRE, "agent");
            asm volatile("s_waitcnt vmcnt(0)" ::: "memory");
        }
    }
    __syncthreads();
}

struct Args { const float* in[23]; float* out; unsigned char* ws; int ph_lo, ph_hi; };
constexpr int NPH = 12;

constexpr int MP = 272;

__device__ __forceinline__ void mlstm_stage_a(LAS unsigned char* lds, const bfu* __restrict__ PROJ, const float* __restrict__ GATES, const float* __restrict__ conv_w, const float* __restrict__ conv_b,
                                              bfu* QC, bfu* KC, float* DELTA, float* DN, float* SC, int item, const int mk_wave) {
    int lane = mk_lane(); asm volatile("" : "+v"(lane));
    const int wid = mk_wave & 7, tid = wid * 64 + lane, fr = lane & 15, fq = lane >> 4;
    const int h = item & 3, row0 = (item >> 2) * 128;
    LAS float* fa = (LAS float*)lds; LAS unsigned char* KT = lds + 4096; LAS unsigned char* VT = KT + 128 * MP;
    if (tid < 128) { fa[tid] = GATES[(size_t)(row0 + tid) * 8 + 4 + h]; fa[128 + tid] = GATES[(size_t)(row0 + tid) * 8 + h]; }
    __syncthreads();
    if (tid < 128) { float b = 0.f; for (int s = 0; s <= tid; ++s) b += fa[s]; fa[256 + tid] = fa[128 + tid] - b; if (tid == 127) fa[385] = b; }
    __syncthreads();
    if (wid == 0) { float a = fmaxf(fa[256 + lane], fa[320 + lane]);
#pragma unroll
        for (int o = 1; o < 64; o <<= 1) a = fmaxf(a, __shfl_xor(a, o));
        if (lane == 0) fa[384] = a; }
    __syncthreads();
    const float amax = fa[384], blast = fa[385];
    if (tid < 128) fa[tid] = __expf(fa[256 + tid] - amax);
    if (tid == 0) { SC[item] = blast + amax; SC[512 + item] = blast; }
    __syncthreads();
    for (int task = tid; task < 4096; task += NTHR) {
        const int isk = task >> 11, t2 = task & 2047, d = t2 & 127, s0 = (t2 >> 7) * 8, ch = isk * 512 + h * 128 + d;
        const float w0 = conv_w[ch], w1 = conv_w[1024 + ch], w2 = conv_w[2048 + ch], w3 = conv_w[3072 + ch], bias = conv_b[ch];
        float x[11];
#pragma unroll
        for (int i = 0; i < 11; ++i) { const int r = row0 + s0 - 3 + i; x[i] = r >= 0 ? bf2f(PROJ[(size_t)r * PLD + C_MQ + ch]) : 0.f; }
        float y[8];
#pragma unroll
        for (int i = 0; i < 8; ++i) y[i] = silu(bias + w0 * x[i] + w1 * x[i + 1] + w2 * x[i + 2] + w3 * x[i + 3]);
        if (!isk) {
#pragma unroll
            for (int i = 0; i < 8; ++i) QC[(size_t)(row0 + s0 + i) * 512 + h * 128 + d] = (bfu)f2bf(y[i] * 0.08838834764831845f);
        } else {
#pragma unroll
            for (int i = 0; i < 8; ++i) { KC[(size_t)(row0 + s0 + i) * 512 + h * 128 + d] = (bfu)f2bf(y[i]); y[i] *= fa[s0 + i]; }
            v4u o; o.x = pk2(y[0], y[1]); o.y = pk2(y[2], y[3]); o.z = pk2(y[4], y[5]); o.w = pk2(y[6], y[7]);
            *(LAS v4u*)(KT + d * MP + s0 * 2) = o;
        }
    }
    for (int task = tid; task < 4096; task += NTHR) {
        const int sidx = task & 127, e0 = (task >> 7) * 8;
        const v4u v = *(const v4u*)(PROJ + (size_t)(row0 + sidx) * PLD + C_MV + h * 256 + e0);
        LAS unsigned short* d = (LAS unsigned short*)(VT + e0 * MP + sidx * 2);
        d[0 * (MP / 2)] = (unsigned short)(v.x & 0xffffu); d[1 * (MP / 2)] = (unsigned short)(v.x >> 16); d[2 * (MP / 2)] = (unsigned short)(v.y & 0xffffu); d[3 * (MP / 2)] = (unsigned short)(v.y >> 16);
        d[4 * (MP / 2)] = (unsigned short)(v.z & 0xffffu); d[5 * (MP / 2)] = (unsigned short)(v.z >> 16); d[6 * (MP / 2)] = (unsigned short)(v.w & 0xffffu); d[7 * (MP / 2)] = (unsigned short)(v.w >> 16);
    }
    __syncthreads();
    f32x4 acc[2][8];
#pragma unroll
    for (int mt = 0; mt < 2; ++mt)
#pragma unroll
        for (int nt = 0; nt < 8; ++nt) acc[mt][nt] = (f32x4){0.f, 0.f, 0.f, 0.f};
#pragma unroll
    for (int ks = 0; ks < 4; ++ks) {
        bf16x8 a[2];
#pragma unroll
        for (int mt = 0; mt < 2; ++mt) a[mt] = *(const LAS bf16x8*)(VT + (32 * wid + 16 * mt + fr) * MP + (32 * ks + 8 * fq) * 2);
#pragma unroll
        for (int nt = 0; nt < 8; ++nt) { const bf16x8 b = *(const LAS bf16x8*)(KT + (16 * nt + fr) * MP + (32 * ks + 8 * fq) * 2);
            acc[0][nt] = MFMA16(a[0], b, acc[0][nt]); acc[1][nt] = MFMA16(a[1], b, acc[1][nt]); }
    }
    float* dst = DELTA + (size_t)item * 32768;
#pragma unroll
    for (int mt = 0; mt < 2; ++mt)
#pragma unroll
        for (int nt = 0; nt < 8; ++nt)
#pragma unroll
            for (int j = 0; j < 4; ++j) dst[(32 * wid + 16 * mt + 4 * fq + j) * 128 + 16 * nt + fr] = acc[mt][nt][j];
    if (tid < 128) { float s = 0.f; for (int i = 0; i < 128; ++i) s += bf2f(*(const LAS unsigned short*)(KT + tid * MP + i * 2)); DN[(size_t)item * 128 + tid] = s; }
    __syncthreads();
}

__device__ __forceinline__ void mlstm_scan(LAS unsigned char* lds, const float* __restrict__ DELTA, const float* __restrict__ DN, const float* __restrict__ SC, float* MPREV, bfu* __restrict__ CT, float* __restrict__ NST,
                                           int tid, int gtid, int nthreads) {
    LAS float* fdec = (LAS float*)lds; LAS float* fin = fdec + 512; LAS float* mpv = fdec + 1024;
    if (tid < 4) { float m = 0.f;
        for (int c = 0; c < 128; ++c) { const int item = c * 4 + tid; const float mloc = SC[item], bl = SC[512 + item], mn = fmaxf(bl + m, mloc);
            mpv[tid * 128 + c] = m; fdec[tid * 128 + c] = __expf(bl + m - mn); fin[tid * 128 + c] = __expf(mloc - mn); m = mn; } }
    __syncthreads();
    for (int idx = gtid; idx < 4 * 32768 + 512; idx += nthreads) {
        const bool main_ = idx < 4 * 32768;
        const int h = main_ ? (idx >> 15) : ((idx - 4 * 32768) >> 7), rem = main_ ? (idx & 32767) : ((idx - 4 * 32768) & 127);
        const float* src = main_ ? DELTA + (size_t)h * 32768 + rem : DN + h * 128 + rem; const size_t sstride = main_ ? 4 * 32768 : 512;
        float C = 0.f; float d8[8], e8[8];
#pragma unroll
        for (int i = 0; i < 8; ++i) d8[i] = src[(size_t)i * sstride];
        for (int c0 = 0; c0 < 128; c0 += 8) {
            if (c0 + 8 < 128) {
#pragma unroll
                for (int i = 0; i < 8; ++i) e8[i] = src[(size_t)(c0 + 8 + i) * sstride];
            }
#pragma unroll
            for (int i = 0; i < 8; ++i) { const int c = c0 + i, item = c * 4 + h;
                if (main_) { CT[(size_t)item * 32768 + rem] = (bfu)f2bf(C); if (rem == 0) MPREV[item] = mpv[h * 128 + c]; } else NST[(size_t)item * 128 + rem] = C;
                C = fdec[h * 128 + c] * C + fin[h * 128 + c] * d8[i]; }
#pragma unroll
            for (int i = 0; i < 8; ++i) d8[i] = e8[i];
        }
    }
    __syncthreads();
}

__device__ __forceinline__ void mlstm_stage_c(LAS unsigned char* lds, const bfu* __restrict__ PROJ, const float* __restrict__ GATES, const bfu* __restrict__ QC, const bfu* __restrict__ KC,
                                              const bfu* __restrict__ CT, const float* __restrict__ NST, const float* __restrict__ MPREV, const float* __restrict__ hgain, bfu* Y, int item, const int mk_wave) {
    int lane = mk_lane(); asm volatile("" : "+v"(lane));
    const int wid = mk_wave & 7, tid = wid * 64 + lane, fr = lane & 15, fq = lane >> 4;
    const int h = item & 3, row0 = (item >> 2) * 128;
    LAS float* fa = (LAS float*)lds;
    LAS unsigned char* Qs = lds + 4096; LAS unsigned char* Ks = Qs + 128 * MP; LAS unsigned char* BUF = Ks + 128 * MP;
    if (tid < 128) { fa[768 + tid] = GATES[(size_t)(row0 + tid) * 8 + 4 + h]; fa[896 + tid] = GATES[(size_t)(row0 + tid) * 8 + h]; fa[640 + tid] = NST[(size_t)item * 128 + tid]; }
    __syncthreads();
    float bt_ = 0.f;
    if (tid < 128) { for (int s = 0; s <= tid; ++s) bt_ += fa[768 + s]; fa[tid] = fa[896 + tid] - bt_; }
    __syncthreads();
    if (tid < 128) { const float mp = MPREV[item]; float pm = -3.0e38f; for (int s = 0; s <= tid; ++s) pm = fmaxf(pm, fa[s]);
        const float M = fmaxf(mp, pm); fa[128 + tid] = M; fa[256 + tid] = __expf(mp - M); fa[384 + tid] = __expf(-(bt_ + M)); }
    for (int t = tid; t < 2048; t += NTHR) { const int r = t >> 4, c = t & 15;
        *(LAS v4u*)(Qs + r * MP + c * 16) = *(const v4u*)(QC + (size_t)(row0 + r) * 512 + h * 128 + c * 8);
        *(LAS v4u*)(Ks + r * MP + c * 16) = *(const v4u*)(KC + (size_t)(row0 + r) * 512 + h * 128 + c * 8); }
    for (int t = tid; t < 4096; t += NTHR) { const int r = t >> 4, c = t & 15; *(LAS v4u*)(BUF + r * MP + c * 16) = *(const v4u*)(CT + (size_t)item * 32768 + r * 128 + c * 8); }
    __syncthreads();
    {
        const int t = 16 * wid + fr; float s = 0.f;
#pragma unroll
        for (int i = 0; i < 32; ++i) s += bf2f(*(const LAS unsigned short*)(Qs + t * MP + (32 * fq + i) * 2)) * fa[640 + 32 * fq + i];
        s += __shfl_xor(s, 16); s += __shfl_xor(s, 32); if (fq == 0) fa[512 + t] = s;
    }
    f32x4 sa[8];
#pragma unroll
    for (int nt = 0; nt < 8; ++nt) sa[nt] = (f32x4){0.f, 0.f, 0.f, 0.f};
    bf16x8 qa[4];
#pragma unroll
    for (int ks = 0; ks < 4; ++ks) qa[ks] = *(const LAS bf16x8*)(Qs + (16 * wid + fr) * MP + (32 * ks + 8 * fq) * 2);
#pragma unroll
    for (int nt = 0; nt < 8; ++nt) if (nt <= wid) {
#pragma unroll
        for (int ks = 0; ks < 4; ++ks) { const bf16x8 b = *(const LAS bf16x8*)(Ks + (16 * nt + fr) * MP + (32 * ks + 8 * fq) * 2); sa[nt] = MFMA16(qa[ks], b, sa[nt]); } }
    float Mt[4], rsum[4];
#pragma unroll
    for (int j = 0; j < 4; ++j) { Mt[j] = fa[128 + 16 * wid + 4 * fq + j]; rsum[j] = 0.f; }
#pragma unroll
    for (int nt = 0; nt < 8; ++nt) { const int s = 16 * nt + fr; const float as = fa[s];
#pragma unroll
        for (int j = 0; j < 4; ++j) { const int t = 16 * wid + 4 * fq + j; const float p = (s <= t) ? sa[nt][j] * __expf(as - Mt[j]) : 0.f; sa[nt][j] = p; rsum[j] += p; } }
#pragma unroll
    for (int j = 0; j < 4; ++j) { float v = rsum[j]; v += __shfl_xor(v, 1); v += __shfl_xor(v, 2); v += __shfl_xor(v, 4); v += __shfl_xor(v, 8); rsum[j] = v; }
    f32x4 num[16];
#pragma unroll
    for (int nt = 0; nt < 16; ++nt) num[nt] = (f32x4){0.f, 0.f, 0.f, 0.f};
#pragma unroll
    for (int ks = 0; ks < 4; ++ks)
#pragma unroll
        for (int nt = 0; nt < 16; ++nt) { const bf16x8 b = *(const LAS bf16x8*)(BUF + (16 * nt + fr) * MP + (32 * ks + 8 * fq) * 2); num[nt] = MFMA16(qa[ks], b, num[nt]); if ((nt & 3) == 3) __builtin_amdgcn_sched_barrier(0); }
    float g4[4], den[4];
#pragma unroll
    for (int j = 0; j < 4; ++j) { const int t = 16 * wid + 4 * fq + j; g4[j] = fa[256 + t]; den[j] = fmaxf(fabsf(g4[j] * fa[512 + t] + rsum[j]), fa[384 + t]); }
#pragma unroll
    for (int nt = 0; nt < 16; ++nt)
#pragma unroll
        for (int j = 0; j < 4; ++j) num[nt][j] *= g4[j];
    __syncthreads();
#pragma unroll
    for (int nt = 0; nt < 8; ++nt)
#pragma unroll
        for (int j = 0; j < 4; ++j) *(LAS unsigned short*)(Ks + (16 * wid + 4 * fq + j) * MP + (16 * nt + fr) * 2) = (unsigned short)f2bf(sa[nt][j]);
    for (int task = tid; task < 4096; task += NTHR) {
        const int sidx = task & 127, e0 = (task >> 7) * 8;
        const v4u v = *(const v4u*)(PROJ + (size_t)(row0 + sidx) * PLD + C_MV + h * 256 + e0);
        LAS unsigned short* d = (LAS unsigned short*)(BUF + e0 * MP + sidx * 2);
        d[0 * (MP / 2)] = (unsigned short)(v.x & 0xffffu); d[1 * (MP / 2)] = (unsigned short)(v.x >> 16); d[2 * (MP / 2)] = (unsigned short)(v.y & 0xffffu); d[3 * (MP / 2)] = (unsigned short)(v.y >> 16);
        d[4 * (MP / 2)] = (unsigned short)(v.z & 0xffffu); d[5 * (MP / 2)] = (unsigned short)(v.z >> 16); d[6 * (MP / 2)] = (unsigned short)(v.w & 0xffffu); d[7 * (MP / 2)] = (unsigned short)(v.w >> 16);
    }
    __syncthreads();
#pragma unroll
    for (int ks = 0; ks < 4; ++ks) { const bf16x8 pa = *(const LAS bf16x8*)(Ks + (16 * wid + fr) * MP + (32 * ks + 8 * fq) * 2);
#pragma unroll
        for (int nt = 0; nt < 16; ++nt) { const bf16x8 b = *(const LAS bf16x8*)(BUF + (16 * nt + fr) * MP + (32 * ks + 8 * fq) * 2); num[nt] = MFMA16(pa, b, num[nt]); if ((nt & 3) == 3) __builtin_amdgcn_sched_barrier(0); } }
    float ssq[4];
#pragma unroll
    for (int j = 0; j < 4; ++j) { const float rd = 1.0f / den[j]; float s = 0.f;
#pragma unroll
        for (int nt = 0; nt < 16; ++nt) { const float v = num[nt][j] * rd; num[nt][j] = v; s += v * v; }
        s += __shfl_xor(s, 1); s += __shfl_xor(s, 2); s += __shfl_xor(s, 4); s += __shfl_xor(s, 8); ssq[j] = 1.0f / sqrtf(s * (1.0f / 256.0f) + 1e-6f); }
    __syncthreads();
    LAS float* HS = (LAS float*)(lds + 4096);
#pragma unroll
    for (int nt = 0; nt < 16; ++nt)
#pragma unroll
        for (int j = 0; j < 4; ++j) HS[(16 * wid + 4 * fq + j) * 260 + 16 * nt + fr] = num[nt][j] * ssq[j];
    __syncthreads();
    for (int task = tid; task < 4096; task += NTHR) {
        const int r = task >> 5, c8 = (task & 31) * 8; const size_t row = (size_t)(row0 + r);
        const f32x4 h0 = *(const LAS f32x4*)(HS + r * 260 + c8), h1 = *(const LAS f32x4*)(HS + r * 260 + c8 + 4);
        const f32x4 g0 = *(const f32x4*)(hgain + h * 256 + c8), g1 = *(const f32x4*)(hgain + h * 256 + c8 + 4);
        const v4u mo = *(const v4u*)(PROJ + row * PLD + C_MO + h * 256 + c8);
        v4u o;
        o.x = pk2(h0[0] * g0[0] / (1.0f + __expf(-bf2f(mo.x & 0xffffu))), h0[1] * g0[1] / (1.0f + __expf(-bf2f(mo.x >> 16))));
        o.y = pk2(h0[2] * g0[2] / (1.0f + __expf(-bf2f(mo.y & 0xffffu))), h0[3] * g0[3] / (1.0f + __expf(-bf2f(mo.y >> 16))));
        o.z = pk2(h1[0] * g1[0] / (1.0f + __expf(-bf2f(mo.z & 0xffffu))), h1[1] * g1[1] / (1.0f + __expf(-bf2f(mo.z >> 16))));
        o.w = pk2(h1[2] * g1[2] / (1.0f + __expf(-bf2f(mo.w & 0xffffu))), h1[3] * g1[3] / (1.0f + __expf(-bf2f(mo.w >> 16))));
        *(v4u*)(Y + row * DM + 1024 + h * 256 + c8) = o;
    }
    __syncthreads();
}

__device__ __forceinline__ att::BlockRef<att::bf16, att::bf16> att_ref(int i, int pass, const bfu* PROJ, bfu* OATT) {
    int ph, x;
    if (gridDim.x == 256) { ph = ((i >> 8) & 1) * 8 + (blockIdx.x & 7); x = blockIdx.x >> 3; }
    else { ph = (i >> 5) & 15; x = i & 31; }
    const int qb = pass ? 63 - x : x, h = ph >> 2, c = (ph >> 1) & 1, vh = ph & 1;
    att::BlockRef<att::bf16, att::bf16> r;
    constexpr size_t MSZ = (size_t)16384 * 128;
    r.Q = (const att::bf16*)(PROJ + (size_t)(2 * h + c) * MSZ + (size_t)qb * 256 * 128);
    r.K = (const att::bf16*)(PROJ + (size_t)(8 + 2 * h + c) * MSZ);
    r.V = (const att::bf16*)(PROJ + (size_t)(16 + 2 * h + vh) * MSZ);
    r.O = (att::bf16*)(OATT + (size_t)qb * 256 * 2048 + h * 512 + c * 256 + vh * 128);
    r.P0 = qb * 256;
    return r;
}
__device__ __forceinline__ void attn_phase(char* lds, const bfu* PROJ, bfu* OATT, const int TOTAL, const int mk_wave) {
    using namespace att;
    int i = blockIdx.x; if (i >= TOTAL) return;
    int pass = 0;
    BlockRef<bf16, bf16> cur = att_ref(i, 0, PROJ, OATT);
    Seam<bf16> S;
    causal_swa_prime<bf16, bf16>(cur, S_, lds, S, mk_wave);
    for (;;) {
        const bool more_pass = pass == 0, more_item = i + (int)gridDim.x < TOTAL, last = !more_pass && !more_item;
        int in_ = i, passn = pass + 1;
        if (!more_pass) { passn = 0; in_ = more_item ? i + (int)gridDim.x : i; }
        const BlockRef<bf16, bf16> nxt = last ? cur : att_ref(in_, passn, PROJ, OATT);
        causal_swa_block<bf16, bf16>(cur, nxt, S_, S_, lds, S, mk_wave);
        if (last) break;
        cur = nxt; i = in_; pass = passn;
    }
}

#ifndef ATTN2
#define ATTN2 5
#endif
__device__ __forceinline__ att::A2Ref att2_ref(int i, int pass, const bfu* PROJ, bfu* OATT) {
    int hc, x;
    if (gridDim.x == 256) { hc = blockIdx.x & 7; x = ((i >> 8) & 1) * 32 + (blockIdx.x >> 3); }
    else { hc = (i >> 6) & 7; x = i & 63; }
    const int qb = pass ? 127 - x : x, h = hc >> 1, c = hc & 1;
    constexpr size_t MSZ = (size_t)16384 * 128;
    att::A2Ref r;
    r.Q = (const att::bf16*)(PROJ + (size_t)(2 * h + c) * MSZ + (size_t)qb * 128 * 128);
    r.K = (const att::bf16*)(PROJ + (size_t)(8 + 2 * h + c) * MSZ);
    r.V0 = (const att::bf16*)(PROJ + (size_t)(16 + 2 * h) * MSZ); r.V1 = (const att::bf16*)(PROJ + (size_t)(16 + 2 * h + 1) * MSZ);
    r.O = (att::bf16*)(OATT + (size_t)qb * 128 * 2048 + h * 512 + c * 256);
    r.P0 = qb * 128;
    return r;
}
__device__ __forceinline__ void attn2_phase(char* lds, const bfu* PROJ, bfu* OATT, const int TOTAL, const int mk_wave) {
    for (int i = blockIdx.x; i < TOTAL; i += gridDim.x)
        for (int pass = 0; pass < 2; ++pass) { const att::A2Ref r = att2_ref(i, pass, PROJ, OATT); if (ATTN2 == 5) att::attn6_block(r, lds, mk_wave); else if (ATTN2 == 4) att::attn5_block(r, lds, mk_wave); else if (ATTN2 == 3) att::attn4_block(r, lds, mk_wave); else if (ATTN2 == 2) att::attn3_block(r, lds, mk_wave); else att::attn2_block(r, lds, mk_wave); }
}

__global__ void __launch_bounds__(NTHR, 2) mega_fwd(Args args) {
    extern __shared__ __attribute__((aligned(16))) unsigned char lds_raw[];
    LAS unsigned char* lds = (LAS unsigned char*)lds_raw;
    const int wave = __builtin_amdgcn_readfirstlane((int)threadIdx.x >> 6);
    const int G = gridDim.x, gw = blockIdx.x * NWAVES + wave, NGW = G * NWAVES;
#define AS4 __attribute__((address_space(4)))
#define PH_BEGIN int koff_ = 0; asm volatile("" : "+s"(koff_)); const AS4 char* kp_ = (const AS4 char*)__builtin_amdgcn_kernarg_segment_ptr() + koff_; \
    unsigned char* ws = *(unsigned char* const AS4*)(kp_ + 192); float* out = *(float* const AS4*)(kp_ + 184); (void)out; (void)ws; const int lane = mk_lane(), tid = wave * 64 + lane; (void)tid; (void)lane;
#define KIN(i) (*(const float* const AS4*)(kp_ + 8 * (i)))
#define Wgu ((bfu*)(ws + WS_WGU))
#define Wd ((bfu*)(ws + WS_WD))
#define Win ((bfu*)(ws + WS_WIN))
#define Wout ((bfu*)(ws + WS_WOUT))
#define XN ((bfu*)(ws + WS_XN))
#define BIG ((bfu*)(ws + WS_BIG))
#define Y ((bfu*)(ws + WS_Y))
#define CT ((bfu*)(ws + WS_CT))
#define QC ((bfu*)(ws + WS_QC))
#define KC ((bfu*)(ws + WS_KC))
#define NST ((float*)(ws + WS_NST))
#define rowss1 ((float*)(ws + WS_ROWSS1))
#define rowss2 ((float*)(ws + WS_ROWSS2))
#define SC ((float*)(ws + WS_SC))
#define DN ((float*)(ws + WS_DN))
#define GATES ((float*)(ws + WS_GATES))
#define DELTA ((float*)(ws + WS_XN))
#define OATT ((bfu*)(ws + WS_XN))
#define PROJM (BIG + (size_t)24 * 16384 * 128)
    const int lo = args.ph_lo, hi = args.ph_hi;
    if (hi - lo > 1) {
        if (wave == 0 && mk_lane() == 0) { volatile LAS unsigned* st = (volatile LAS unsigned*)(lds + LDS_BYTES - 64); st[0] = 0u; st[1] = 0u;
            (void)xb_add(&((unsigned*)(args.ws + WS_BAR))[XB_XCNT(xb_xcc_id())], 1u); }
        __syncthreads();
    }
#ifndef PHMASK
#define PHMASK 0xfff
#endif
#define IN(k) (((PHMASK >> (k)) & 1) && lo <= (k) && (k) < hi)
#ifndef PROBE_MASK
#define PROBE_MASK 0
#endif
#define NREP(k) (((PROBE_MASK >> (k)) & 1) ? 2 : 1)
#define STAGGER_DELAY(N) do { const int sn_ = (int)((blockIdx.x >> 3) & 3) * (N); for (int sd_ = 0; sd_ < sn_; ++sd_) __builtin_amdgcn_s_sleep(85); } while (0)
#define SYNC(k) do { if (IN(k) && IN((k) + 1)) { if (lo < 0) cg::this_grid().sync();     \
        { int kb_ = 0; asm volatile("" : "+s"(kb_)); unsigned char* wsb_ = *(unsigned char* const AS4*)((const AS4 char*)__builtin_amdgcn_kernarg_segment_ptr() + kb_ + 192); \
               xcd_barrier((unsigned*)(wsb_ + WS_BAR), (volatile LAS unsigned*)(lds + LDS_BYTES - 64), wave == 0 && mk_lane() == 0); \
               if ((PROBE_MASK >> 14) & 1) xcd_barrier((unsigned*)(wsb_ + WS_BAR), (volatile LAS unsigned*)(lds + LDS_BYTES - 64), wave == 0 && mk_lane() == 0); } } } while (0)

    if (IN(0)) for (int rep_ = 0; rep_ < NREP(0); ++rep_) { PH_BEGIN
        const float* x = KIN(0);
        LAS float* scr = (LAS float*)(lds + wave * 16640);
        constexpr int I_FFN = 3 * 2816, I_IN = 32 * 96, I_OUT = 32 * 32;
        for (int it = gw; it < I_FFN + I_IN + I_OUT; it += NGW) {
            if (it < I_FFN) cvt_ffn_item(it, KIN(2), KIN(3), KIN(4), KIN(1), Wgu, Wd, scr, lane);
            else if (it < I_FFN + I_IN) { const int r = it - I_FFN, kb = r / 96, nb = r % 96; cvt_item(KIN(6), NIN, NIN, KIN(5), Win, DM, nb * 64, kb * 64, nb * 64, scr, lane); }
            else { const int r = it - I_FFN - I_IN, kb = r / 32, nb = r % 32; cvt_item(KIN(17), DM, DM, nullptr, Wout, DM, nb * 64, kb * 64, nb * 64, scr, lane); }
        }
        for (int m = gw; m < S_; m += NGW) {
            const f32x4* xr = (const f32x4*)(x + (size_t)m * DM) + lane; f32x4 v[8]; float s = 0.f;
#pragma unroll
            for (int j = 0; j < 8; ++j) { v[j] = xr[64 * j]; s += (v[j][0] * v[j][0] + v[j][1] * v[j][1]) + (v[j][2] * v[j][2] + v[j][3] * v[j][3]); }
            const float rs = 1.0f / sqrtf(wave_sum(s) * (1.0f / DM) + 1e-6f);
            v2u* o8 = (v2u*)(XN + (size_t)m * DM) + lane;
#pragma unroll
            for (int j = 0; j < 8; ++j) { v2u w; w.x = pk2(v[j][0] * rs, v[j][1] * rs); w.y = pk2(v[j][2] * rs, v[j][3] * rs); o8[64 * j] = w; }
        }
        for (int i = blockIdx.x * NTHR + tid; i < 2 * S_; i += G * NTHR) rowss1[i] = 0.f;
        for (int k = blockIdx.x * NTHR + tid; k < DM + 8; k += G * NTHR) {
            unsigned char* gwp = ws + WS_GW; f32x4 w0 = (f32x4){0.f, 0.f, 0.f, 0.f}, w1 = w0;
            if (k < DM) { const float gk = KIN(5)[k]; w0 = *(const f32x4*)(KIN(6) + (size_t)k * NIN + 6144) * gk; w1 = *(const f32x4*)(KIN(6) + (size_t)k * NIN + 6148) * gk; }
#pragma unroll
            for (int j = 0; j < 4; ++j) { *(unsigned short*)(gwp + j * GWP + k * 2) = (unsigned short)f2bf(w0[j]); *(unsigned short*)(gwp + (4 + j) * GWP + k * 2) = (unsigned short)f2bf(w1[j]);
                *(unsigned short*)(gwp + (8 + j) * GWP + k * 2) = 0; *(unsigned short*)(gwp + (12 + j) * GWP + k * 2) = 0; }
        }
    }
    SYNC(0);
    if (IN(1)) { PH_BEGIN
        pg8::Gemm g{XN, Wgu, S_, 2 * FF, DM}; pg8::StaticOrder So; So.init(S_, 2 * FF, G, (int)blockIdx.x);
        pg8::EpiSwiGLU E{BIG, FF, nullptr, 0.f};
        STAGGER_DELAY(1); for (int rep_ = 0; rep_ < NREP(1); ++rep_) pg8::gemm_phase<pg8::EpiSwiGLU, pg8::StaticOrder, true, true>(lds, g, So, E, wave);
    }
    SYNC(1);
    if (IN(2)) { PH_BEGIN
        pg8::Gemm g{BIG, Wd, S_, DM, FF}; pg8::StaticOrder So; So.init(S_, DM, G, (int)blockIdx.x);
        pg8::EpiResid E{KIN(0), out, XN, rowss1, 0.5f, DM};
        STAGGER_DELAY(3); pg8::gemm_phase<pg8::EpiResid, pg8::StaticOrder, true, true>(lds, g, So, E, wave);
    }
    SYNC(2);
    if (IN(3)) { PH_BEGIN
        pg8::Gemm g{XN, Win, S_, NINP, DM}; pg8::StaticOrder So; So.init(S_, NINP, G, (int)blockIdx.x);
        pg8::EpiProj E{BIG, rowss1, 1.0f / DM};
        STAGGER_DELAY(1); for (int rep_ = 0; rep_ < NREP(3); ++rep_) pg8::gemm_phase<pg8::EpiProj, pg8::StaticOrder, true, true>(lds, g, So, E, wave);
        {
            const v4u* src = (const v4u*)(ws + WS_GW);
            for (int i = tid; i < 16 * GWP / 16; i += NTHR) *(LAS v4u*)(lds + 16384 + i * 16) = src[i];
            __syncthreads();
        }
        for (int rep_ = 0; rep_ < NREP(13); ++rep_) for (int rb = blockIdx.x; rb < S_ / 64; rb += G) gates_rows(lds, XN, rowss1, KIN(14), KIN(15), GATES, rb, wave, lane);
    }
    SYNC(3);
    if (IN(4)) { PH_BEGIN for (int item = blockIdx.x; item < 512 * NREP(4); item += G) mlstm_stage_a(lds, PROJM, GATES, KIN(12), KIN(13), QC, KC, DELTA, DN, SC, item & 511, wave); }
    SYNC(4);
    if (IN(5)) { PH_BEGIN for (int rep_ = 0; rep_ < NREP(5); ++rep_) mlstm_scan(lds, DELTA, DN, SC, SC + 1024, CT, NST, tid, blockIdx.x * NTHR + tid, G * NTHR); }
    SYNC(5);
    if (IN(6)) { PH_BEGIN
#ifndef NO_ATTN
#if ATTN2
        attn2_phase((char*)lds_raw, BIG, OATT, 512 * NREP(6), wave);
#else
        attn_phase((char*)lds_raw, BIG, OATT, 512 * NREP(6), wave);
#endif
#endif
        __syncthreads();
#ifndef NO_STAGEC
        for (int rep_ = 0; rep_ < NREP(12); ++rep_) for (int item = blockIdx.x; item < 512; item += G) mlstm_stage_c(lds, PROJM, GATES, QC, KC, CT, NST, SC + 1024, KIN(16), Y, item, wave);
#endif
    }
    SYNC(6);
    if (IN(7)) for (int rep_ = 0; rep_ < NREP(7); ++rep_) { PH_BEGIN
        const float l1 = wave_sum(KIN(7)[lane] * KIN(8)[lane] + KIN(7)[lane + 64] * KIN(8)[lane + 64]);
        const float l2 = wave_sum(KIN(9)[lane] * KIN(10)[lane] + KIN(9)[lane + 64] * KIN(10)[lane + 64]);
        const float lam = expf(l1) - expf(l2) + 0.2f;
        const float* hg = KIN(11);
        for (int m = gw; m < S_; m += NGW) {
#pragma unroll
            for (int h = 0; h < 4; ++h) {
                const v2u a = *((const v2u*)(OATT + (size_t)m * 2048 + h * 512) + lane), b = *((const v2u*)(OATT + (size_t)m * 2048 + h * 512 + 256) + lane);
                float y0 = bf2f(a.x & 0xffffu) - lam * bf2f(b.x & 0xffffu), y1 = bf2f(a.x >> 16) - lam * bf2f(b.x >> 16), y2 = bf2f(a.y & 0xffffu) - lam * bf2f(b.y & 0xffffu), y3 = bf2f(a.y >> 16) - lam * bf2f(b.y >> 16);
                const float rs = 0.8f / sqrtf(wave_sum((y0 * y0 + y1 * y1) + (y2 * y2 + y3 * y3)) * (1.0f / 256.0f) + 1e-6f);
                const f32x4 gn = *((const f32x4*)(hg + h * 256) + lane);
                v2u w; w.x = pk2(y0 * rs * gn[0], y1 * rs * gn[1]); w.y = pk2(y2 * rs * gn[2], y3 * rs * gn[3]);
                *((v2u*)(Y + (size_t)m * DM + h * 256) + lane) = w;
            }
        }
        LAS float* scr = (LAS float*)(lds + wave * 16640);
        for (int it = gw; it < 3 * 2816; it += NGW) cvt_ffn_item(it, KIN(19), KIN(20), KIN(21), KIN(18), Wgu, Wd, scr, lane);
    }
    SYNC(7);
    if (IN(8)) { PH_BEGIN
        pg8::Gemm g{Y, Wout, S_, DM, DM}; pg8::StaticOrder So; So.init(S_, DM, G, (int)blockIdx.x);
        pg8::EpiResid E{out, out, XN, rowss2, 1.0f, DM};
        STAGGER_DELAY(3); pg8::gemm_phase<pg8::EpiResid, pg8::StaticOrder, true, true>(lds, g, So, E, wave);
    }
    SYNC(8);
    if (IN(9)) { PH_BEGIN
        pg8::Gemm g{XN, Wgu, S_, 2 * FF, DM}; pg8::StaticOrder So; So.init(S_, 2 * FF, G, (int)blockIdx.x);
        pg8::EpiSwiGLU E{BIG, FF, rowss2, 1.0f / DM};
        STAGGER_DELAY(1); pg8::gemm_phase<pg8::EpiSwiGLU, pg8::StaticOrder, true, true>(lds, g, So, E, wave);
    }
    SYNC(9);
    if (IN(10)) { PH_BEGIN
        pg8::Gemm g{BIG, Wd, S_, DM, FF}; pg8::StaticOrder So; So.init(S_, DM, G, (int)blockIdx.x);
        pg8::EpiResid E{out, out, nullptr, nullptr, 0.5f, DM};
        STAGGER_DELAY(3); pg8::gemm_phase<pg8::EpiResid, pg8::StaticOrder, true, true>(lds, g, So, E, wave);
    }
    SYNC(10);
    if (IN(11)) { PH_BEGIN
        const float* fg = KIN(22);
        for (int m = gw; m < S_; m += NGW) {
            f32x4* xr = (f32x4*)(out + (size_t)m * DM) + lane; f32x4 v[8]; float s = 0.f;
#pragma unroll
            for (int j = 0; j < 8; ++j) { v[j] = xr[64 * j]; s += (v[j][0] * v[j][0] + v[j][1] * v[j][1]) + (v[j][2] * v[j][2] + v[j][3] * v[j][3]); }
            const float rs = 1.0f / sqrtf(wave_sum(s) * (1.0f / DM) + 1e-6f);
#pragma unroll
            for (int j = 0; j < 8; ++j) { const f32x4 gn = *((const f32x4*)fg + 64 * j + lane); xr[64 * j] = v[j] * rs * gn; }
        }
    }
#undef IN
#undef SYNC
}

extern "C" void kernel_launch(void* const* d_in, const int* in_sizes, int n_in, void* d_out, int out_size, void* d_ws, size_t ws_size, hipStream_t stream) {
    static int grid = 0;
    if (grid == 0) {
        if (n_in != 23 || in_sizes[0] != S_ * DM || out_size != S_ * DM || ws_size < WS_END) { fprintf(stderr, "kernel_launch: unexpected shapes (n_in %d, in0 %d, out %d, ws %zu)\n", n_in, n_in > 0 ? in_sizes[0] : -1, out_size, ws_size); grid = -1; return; }
        int dev = 0, cus = 0, per_cu = 0;
        (void)hipGetDevice(&dev); (void)hipDeviceGetAttribute(&cus, hipDeviceAttributeMultiprocessorCount, dev);
        if (hipFuncSetAttribute((const void*)mega_fwd, hipFuncAttributeMaxDynamicSharedMemorySize, LDS_BYTES) != hipSuccess) { fprintf(stderr, "kernel_launch: hipFuncSetAttribute failed\n"); grid = -1; return; }
        if (hipOccupancyMaxActiveBlocksPerMultiprocessor(&per_cu, (const void*)mega_fwd, NTHR, LDS_BYTES) != hipSuccess || per_cu < 1) per_cu = 1;
        grid = cus * per_cu;
        fprintf(stderr, "kernel_launch: grid %d (%d CUs x %d)\n", grid, cus, per_cu);
    }
    if (grid < 0) return;
    Args a{};
    for (int i = 0; i < 23; ++i) a.in[i] = (const float*)d_in[i];
    a.out = (float*)d_out; a.ws = (unsigned char*)d_ws;
#if MK_SPLIT
    for (int p = 0; p < NPH; ++p) { a.ph_lo = p; a.ph_hi = p + 1; hipLaunchKernelGGL(mega_fwd, dim3(grid), dim3(NTHR), LDS_BYTES, stream, a); }
#else
    a.ph_lo = 0; a.ph_hi = NPH;
    (void)hipMemsetAsync((char*)d_ws + WS_BAR, 0, XCD_BAR_WORDS * 4, stream);
    void* kargs[] = {&a};
    hipError_t e = hipLaunchCooperativeKernel((const void*)mega_fwd, dim3(grid), dim3(NTHR), kargs, LDS_BYTES, stream);
    if (e != hipSuccess) fprintf(stderr, "kernel_launch: cooperative launch failed: %s (grid %d)\n", hipGetErrorString(e), grid);
#endif
}
```

```cpp
#include <hip/hip_runtime.h>
#include <hip/hip_bf16.h>
#include <hip/hip_cooperative_groups.h>
#include <cstdio>
#include <cstdint>
namespace cg = cooperative_groups;

#ifndef MK_SPLIT
#define MK_SPLIT 0
#endif

namespace pg8 {
#define PG8_LAS __attribute__((address_space(3)))
typedef unsigned short bf16_t;
typedef short bf16x8 __attribute__((ext_vector_type(8)));
typedef float f32x4 __attribute__((ext_vector_type(4)));
typedef unsigned u32x4 __attribute__((ext_vector_type(4)));
constexpr int BM = 256, BK = 64, HALF = 128, HTB = HALF * BK * 2  , STAGE_BYTES = 8 * HTB, NXCD = 8, WGM = 8;

__host__ __device__ __forceinline__ int lds_byte(int r, int c) { const int st = (r >> 4) * 2 + (c >> 5), rr = r & 15, cc = c & 31, ob = rr * 64 + cc * 2; return st * 1024 + (ob ^ (((ob >> 9) & 1) << 5)); }
__host__ __device__ __forceinline__ void stage_rc(int b, int& R, int& C) { const int st = b / 1024, sb = b % 1024, swz = sb ^ (((sb >> 9) & 1) << 5); R = (st >> 1) * 16 + swz / 64; C = (st & 1) * 32 + (swz % 64) / 2; }
__host__ __device__ __forceinline__ int perm32(int rho) { const int n = rho >> 4, i = rho & 15; return 8 * (i >> 2) + 4 * n + (i & 3); }

struct Unit { int pm, pn; };
struct Gemm { const bf16_t* A; const bf16_t* Bt; int M, N, K; };

struct StaticOrder {
    int nM, nN, nwg, G, c;
    __host__ __device__ void init(int M, int N, int G_, int c_) { nM = M / BM; nN = N / BM; nwg = nM * nN; G = G_; c = c_; }
    __host__ __device__ bool next(int i, Unit& u) const {
        const long L = (long)i * G + c; if (L >= nwg) return false;
        int wgid = (int)L; { const int q = nwg / NXCD, r = nwg % NXCD, xcd = wgid % NXCD, off = wgid / NXCD; wgid = (xcd < r ? xcd * (q + 1) : r * (q + 1) + (xcd - r) * q) + off; }
        const int nig = WGM * nN, gid = wgid / nig, fm = gid * WGM, gsz = (nM - fm) < WGM ? (nM - fm) : WGM;
        u.pm = fm + ((wgid % nig) % gsz); u.pn = (wgid % nig) / gsz; return true;
    }
    __device__ __forceinline__ void a_ready(const Unit&) const {}
    __device__ __forceinline__ void done(const Unit&) const {}
};

__device__ __forceinline__ unsigned cvt_pk_bf16(float lo, float hi) { unsigned r; asm volatile("v_cvt_pk_bf16_f32 %0, %1, %2" : "=v"(r) : "v"(lo), "v"(hi)); return r; }

constexpr float RMS_EPS = 1e-6f;
__device__ __forceinline__ float silu_f(float x) { return x * __builtin_amdgcn_rcpf(1.0f + __builtin_amdgcn_exp2f(-1.4426950408889634f * x)); }
struct EpiSwiGLU {
    static constexpr bool PERM = true, AFTER_DRAIN = false;
    bf16_t* O; int ldo; const float* rowss; float inv_n;
    __device__ __forceinline__ void operator()(const f32x4 (&acc)[2][2][4][2], const Unit& u, int wr, int wc, int fr, int fq) const {
        const int row0 = u.pm * BM + wr * 64 + fr, col0 = u.pn * HALF + wc * 32 + 8 * fq;
#pragma unroll
        for (int ai = 0; ai < 2; ++ai)
#pragma unroll
            for (int m = 0; m < 4; ++m) {
                const int r = row0 + ai * HALF + m * 16;
                const float rs = rowss ? __builtin_amdgcn_rsqf(rowss[r] * inv_n + RMS_EPS) : 1.0f;
                const f32x4 g0 = acc[ai][0][m][0] * rs, g1 = acc[ai][0][m][1] * rs, u0 = acc[ai][1][m][0] * rs, u1 = acc[ai][1][m][1] * rs;
                u32x4 w;
                w.x = cvt_pk_bf16(silu_f(g0[0]) * u0[0], silu_f(g0[1]) * u0[1]); w.y = cvt_pk_bf16(silu_f(g0[2]) * u0[2], silu_f(g0[3]) * u0[3]);
                w.z = cvt_pk_bf16(silu_f(g1[0]) * u1[0], silu_f(g1[1]) * u1[1]); w.w = cvt_pk_bf16(silu_f(g1[2]) * u1[2], silu_f(g1[3]) * u1[3]);
                *(u32x4*)(O + (size_t)r * ldo + col0) = w;
            }
    }
};
struct EpiResid {
    static constexpr bool PERM = false, AFTER_DRAIN = false;
    const float* resid; float* out; bf16_t* xb; float* rowss; float alpha; int ld;
    __device__ __forceinline__ void operator()(const f32x4 (&acc)[2][2][4][2], const Unit& u, int wr, int wc, int fr, int fq) const {
        typedef unsigned u32x2v __attribute__((ext_vector_type(2)));
        const int row0 = u.pm * BM + wr * 64 + fr, col0 = u.pn * BM + wc * 32 + 4 * fq;
#pragma unroll
        for (int ai = 0; ai < 2; ++ai)
#pragma unroll
            for (int m = 0; m < 4; ++m) {
                const int r = row0 + ai * HALF + m * 16; float ss = 0.f;
#pragma unroll
                for (int bj = 0; bj < 2; ++bj)
#pragma unroll
                    for (int n = 0; n < 2; ++n) {
                        const size_t off = (size_t)r * ld + col0 + bj * HALF + n * 16;
                        const f32x4 b = *(const f32x4*)(resid + off); const f32x4 o = b + acc[ai][bj][m][n] * alpha;
                        *(f32x4*)(out + off) = o; ss += (o[0] * o[0] + o[1] * o[1]) + (o[2] * o[2] + o[3] * o[3]);
                        if (xb) { u32x2v w; w.x = cvt_pk_bf16(o[0], o[1]); w.y = cvt_pk_bf16(o[2], o[3]); *(u32x2v*)(xb + off) = w; }
                    }
                if (rowss) { ss += __shfl_xor(ss, 16); ss += __shfl_xor(ss, 32); if (fq == 0) atomicAdd(rowss + r, ss); }
            }
    }
};
struct EpiProj {
    static constexpr bool PERM = true, AFTER_DRAIN = false;
    bf16_t* O; const float* rowss; float inv_n;
    __device__ __forceinline__ void operator()(const f32x4 (&acc)[2][2][4][2], const Unit& u, int wr, int wc, int fr, int fq) const {
        const int row0 = u.pm * BM + wr * 64 + fr;
        {
            const bool dense = u.pn < 12;
            const size_t rstride = dense ? 128 : 3072;
            bf16_t* base = dense ? O + (size_t)(2 * u.pn) * ((size_t)16384 * 128) + wc * 32 + 8 * fq : O + (size_t)24 * 16384 * 128 + (u.pn - 12) * BM + wc * 32 + 8 * fq;
            const size_t bjstep = dense ? (size_t)16384 * 128 : 128;
#pragma unroll
            for (int ai = 0; ai < 2; ++ai)
#pragma unroll
                for (int m = 0; m < 4; ++m) {
                    const int r = row0 + ai * HALF + m * 16; const float rs = __builtin_amdgcn_rsqf(rowss[r] * inv_n + RMS_EPS);
#pragma unroll
                    for (int bj = 0; bj < 2; ++bj) { const f32x4 v0 = acc[ai][bj][m][0] * rs, v1 = acc[ai][bj][m][1] * rs; u32x4 w;
                        w.x = cvt_pk_bf16(v0[0], v0[1]); w.y = cvt_pk_bf16(v0[2], v0[3]); w.z = cvt_pk_bf16(v1[0], v1[1]); w.w = cvt_pk_bf16(v1[2], v1[3]);
                        *(u32x4*)(base + (size_t)r * rstride + bj * bjstep) = w; }
                }
        }
    }
};
template <class Epi, class Sched, bool ALIGN_EPI = false, bool SP2 = false>
__device__ __forceinline__ void gemm_phase(PG8_LAS unsigned char* lds, const Gemm g, const Sched& S, const Epi& E, const int mk_wave) {
    const int lane = (int)(__builtin_amdgcn_mbcnt_hi(~0u, __builtin_amdgcn_mbcnt_lo(~0u, 0u)) & 63u), wid = mk_wave & 7, tid = wid * 64 + lane, wr = wid >> 2, wc = wid & 3, fr = lane & 15, fq = lane >> 4;
    const int K = g.K, nt = K / BK;
    unsigned voffA[2], voffB[2];
#pragma unroll
    for (int i = 0; i < 2; ++i) { int R, C; stage_rc(tid * 16 + i * 8192, R, C); const int Rb = Epi::PERM ? ((R & ~31) + perm32(R & 31)) : R;
        voffA[i] = (unsigned)(R * K + C) * 2u; voffB[i] = (unsigned)(Rb * K + C) * 2u; }
    const size_t kstep = (size_t)(BK * 2);
    const size_t hstep = (size_t)HALF * K * 2;
    const size_t tstep = 2 * hstep;
    const unsigned ldsw = (unsigned)wid * 1024u;
    const int aoff = lds_byte(wr * 64 + fr, fq * 8), boff = lds_byte(wc * 32 + fr, fq * 8);
#define PG8_SA(b, h) (((b) * 2 + (h)) * HTB)
#define PG8_SB(b, h) ((4 + (b) * 2 + (h)) * HTB)
#define PG8_STAGE(bufoff, gbase, voff) do { _Pragma("unroll") for (int _i = 0; _i < 2; ++_i) \
        __builtin_amdgcn_global_load_lds((const unsigned*)((const char*)(gbase) + (voff)[_i]), (PG8_LAS unsigned*)(lds + (bufoff) + ldsw + _i * 8192), 16, 0, 0); } while (0)
#define PG8_LDA(dst, b, h) do { _Pragma("unroll") for (int m = 0; m < 4; ++m) _Pragma("unroll") for (int k = 0; k < 2; ++k) dst[m][k] = *(const PG8_LAS bf16x8*)(lds + PG8_SA(b, h) + aoff + m * 2048 + k * 1024); } while (0)
#define PG8_LDB(dst, b, h) do { _Pragma("unroll") for (int n = 0; n < 2; ++n) _Pragma("unroll") for (int k = 0; k < 2; ++k) dst[n][k] = *(const PG8_LAS bf16x8*)(lds + PG8_SB(b, h) + boff + n * 2048 + k * 1024); } while (0)
#define PG8_MMA(ai, bj, At, Bt) do { __builtin_amdgcn_s_setprio(1); _Pragma("unroll") for (int m = 0; m < 4; ++m) _Pragma("unroll") for (int n = 0; n < 2; ++n) _Pragma("unroll") for (int k = 0; k < 2; ++k) \
        acc[ai][bj][m][n] = __builtin_amdgcn_mfma_f32_16x16x32_bf16(Bt[n][k], At[m][k], acc[ai][bj][m][n], 0, 0, 0); __builtin_amdgcn_s_setprio(0); } while (0)
#define PG8_WAIT_V(n) asm volatile("s_waitcnt vmcnt(" #n ")" ::: "memory")
#define PG8_WAIT_L(n) asm volatile("s_waitcnt lgkmcnt(" #n ")" ::: "memory")
#define PG8_BAR __builtin_amdgcn_s_barrier()
#define PG8_SCHED __builtin_amdgcn_sched_barrier(0)
    Unit cur, nxt; int ui = 0;
    if (!S.next(0, cur)) return;
    f32x4 acc[2][2][4][2];
#pragma unroll
    for (int a = 0; a < 2; ++a)
#pragma unroll
        for (int b = 0; b < 2; ++b)
#pragma unroll
            for (int m = 0; m < 4; ++m)
#pragma unroll
                for (int n = 0; n < 2; ++n) acc[a][b][m][n] = (f32x4){0.f, 0.f, 0.f, 0.f};
    bf16x8 At[4][2], B0[2][2], B1[2][2];
    const char* cA = (const char*)g.A + (size_t)cur.pm * tstep; const char* cB = (const char*)g.Bt + (size_t)cur.pn * tstep;
    S.a_ready(cur);
    if constexpr (SP2) {
        PG8_STAGE(PG8_SB(0, 0), cB, voffB); PG8_STAGE(PG8_SB(0, 1), cB + hstep, voffB); PG8_STAGE(PG8_SA(0, 0), cA, voffA); PG8_STAGE(PG8_SA(0, 1), cA + hstep, voffA);
        if (wr == 1) PG8_BAR;
        PG8_WAIT_V(2); PG8_BAR;
        PG8_STAGE(PG8_SB(1, 0), cB + kstep, voffB); PG8_STAGE(PG8_SA(1, 0), cA + kstep, voffA); PG8_STAGE(PG8_SB(1, 1), cB + hstep + kstep, voffB);
        PG8_WAIT_V(6); PG8_BAR;
    } else {
        PG8_STAGE(PG8_SB(0, 0), cB, voffB); PG8_STAGE(PG8_SA(0, 0), cA, voffA); PG8_STAGE(PG8_SB(0, 1), cB + hstep, voffB); PG8_STAGE(PG8_SA(0, 1), cA + hstep, voffA);
        if (wr == 1) PG8_BAR;
        PG8_WAIT_V(4); PG8_BAR;
        PG8_STAGE(PG8_SB(1, 0), cB + kstep, voffB); PG8_STAGE(PG8_SA(1, 0), cA + kstep, voffA); PG8_STAGE(PG8_SB(1, 1), cB + hstep + kstep, voffB);
        PG8_WAIT_V(6); PG8_BAR;
    }
    for (;;) {
        const bool has_next = S.next(ui + 1, nxt);
        const char* nA = has_next ? (const char*)g.A + (size_t)nxt.pm * tstep : cA; const char* nB = has_next ? (const char*)g.Bt + (size_t)nxt.pn * tstep : cB;
        for (int t = 0; t < nt; t += 2) {
            const bool last = (t == nt - 2);
            const char* a1 = cA + (size_t)(t + 1) * kstep;
            const char* a2 = last ? nA : cA + (size_t)(t + 2) * kstep; const char* b2 = last ? nB : cB + (size_t)(t + 2) * kstep;
            const char* a3 = a2 + kstep; const char* b3 = b2 + kstep;
            if (last && has_next) S.a_ready(nxt);
            if constexpr (SP2) {
            PG8_LDB(B0, 0, 0); PG8_LDB(B1, 0, 1); PG8_SCHED; PG8_LDA(At, 0, 0); PG8_STAGE(PG8_SA(1, 1), a1 + hstep, voffA);
            PG8_WAIT_V(8); PG8_WAIT_L(0); PG8_BAR; PG8_MMA(0, 0, At, B0); PG8_MMA(0, 1, At, B1); PG8_BAR; PG8_SCHED;
            PG8_LDA(At, 0, 1); PG8_STAGE(PG8_SB(0, 0), b2, voffB); PG8_STAGE(PG8_SB(0, 1), b2 + hstep, voffB); PG8_STAGE(PG8_SA(0, 0), a2, voffA);
            PG8_WAIT_V(8); PG8_WAIT_L(0); PG8_BAR; PG8_MMA(1, 0, At, B0); PG8_MMA(1, 1, At, B1); PG8_BAR; PG8_SCHED;
            PG8_LDB(B0, 1, 0); PG8_LDB(B1, 1, 1); PG8_SCHED; PG8_LDA(At, 1, 0); PG8_STAGE(PG8_SA(0, 1), a2 + hstep, voffA);
            PG8_WAIT_V(8); PG8_WAIT_L(0); PG8_BAR; PG8_MMA(0, 0, At, B0); PG8_MMA(0, 1, At, B1); PG8_BAR; PG8_SCHED;
            PG8_LDA(At, 1, 1); PG8_STAGE(PG8_SB(1, 0), b3, voffB); PG8_STAGE(PG8_SB(1, 1), b3 + hstep, voffB); PG8_STAGE(PG8_SA(1, 0), a3, voffA);
            PG8_WAIT_V(8); PG8_WAIT_L(0); PG8_BAR; PG8_MMA(1, 0, At, B0); PG8_MMA(1, 1, At, B1); PG8_BAR; PG8_SCHED;
            } else {
            PG8_LDB(B0, 0, 0); PG8_SCHED; PG8_LDA(At, 0, 0); PG8_STAGE(PG8_SA(1, 1), a1 + hstep, voffA);
            PG8_WAIT_L(8); PG8_BAR; PG8_WAIT_L(0); PG8_MMA(0, 0, At, B0); PG8_BAR; PG8_SCHED;
            PG8_LDB(B1, 0, 1); PG8_STAGE(PG8_SB(0, 0), b2, voffB);
            PG8_BAR; PG8_WAIT_L(0); PG8_MMA(0, 1, At, B1); PG8_BAR;
            PG8_LDA(At, 0, 1); PG8_STAGE(PG8_SA(0, 0), a2, voffA);
            PG8_BAR; PG8_WAIT_L(0); PG8_MMA(1, 0, At, B0); PG8_BAR; PG8_SCHED;
            PG8_STAGE(PG8_SB(0, 1), b2 + hstep, voffB);
            PG8_WAIT_V(6); PG8_BAR; PG8_MMA(1, 1, At, B1); PG8_BAR;
            PG8_LDB(B0, 1, 0); PG8_SCHED; PG8_LDA(At, 1, 0); PG8_STAGE(PG8_SA(0, 1), a2 + hstep, voffA);
            PG8_WAIT_L(8); PG8_BAR; PG8_WAIT_L(0); PG8_MMA(0, 0, At, B0); PG8_BAR; PG8_SCHED;
            PG8_LDB(B1, 1, 1); PG8_STAGE(PG8_SB(1, 0), b3, voffB);
            PG8_BAR; PG8_WAIT_L(0); PG8_MMA(0, 1, At, B1); PG8_BAR;
            PG8_LDA(At, 1, 1); PG8_STAGE(PG8_SA(1, 0), a3, voffA);
            PG8_BAR; PG8_WAIT_L(0); PG8_MMA(1, 0, At, B0); PG8_BAR; PG8_SCHED;
            PG8_STAGE(PG8_SB(1, 1), b3 + hstep, voffB);
            PG8_WAIT_V(6); PG8_BAR; PG8_MMA(1, 1, At, B1); PG8_BAR;
            }
        }
        if constexpr (ALIGN_EPI) { if (wr == 0) PG8_BAR; }
        if constexpr (!Epi::AFTER_DRAIN) { E(acc, cur, wr, wc, fr, fq); S.done(cur); }
        if (!has_next) break;
#pragma unroll
        for (int a = 0; a < 2; ++a)
#pragma unroll
            for (int b = 0; b < 2; ++b)
#pragma unroll
                for (int m = 0; m < 4; ++m)
#pragma unroll
                    for (int n = 0; n < 2; ++n) acc[a][b][m][n] = (f32x4){0.f, 0.f, 0.f, 0.f};
        cur = nxt; cA = nA; cB = nB; ++ui;
        if constexpr (ALIGN_EPI) { if (wr == 1) PG8_BAR; }
    }
    PG8_WAIT_V(0);
    if constexpr (!ALIGN_EPI) { if (wr == 0) PG8_BAR; }
    PG8_BAR;
    if constexpr (Epi::AFTER_DRAIN) { E.fused(acc, cur, wr, wc, fr, fq, lds, wid, lane); S.done(cur); }
#undef PG8_SA
#undef PG8_SB
#undef PG8_STAGE
#undef PG8_LDA
#undef PG8_LDB
#undef PG8_MMA
#undef PG8_WAIT_V
#undef PG8_WAIT_L
#undef PG8_BAR
#undef PG8_SCHED
}
}

namespace att {
constexpr int D = 128; constexpr float THR = 8.f; constexpr bool WSKIP = false; constexpr int LDP = 128, LDO = 2048;
constexpr float SCALE = 0.08838834764831845f;
constexpr int NW = 8, QBLK = 32, KVBLK = 64, QB = NW * QBLK;
constexpr int SHM_V = KVBLK * D * 2, SHM_K = KVBLK * D * 2;
constexpr int LDS_BYTES = 2 * SHM_V + 2 * SHM_K + NW * 64 * 4;

using bf16 = __hip_bfloat16;
typedef short bf16x8 __attribute__((ext_vector_type(8)));
typedef short s16x4 __attribute__((ext_vector_type(4)));
typedef float f32x16 __attribute__((ext_vector_type(16)));
typedef float f32x4 __attribute__((ext_vector_type(4)));
typedef unsigned u32x4 __attribute__((ext_vector_type(4)));
template <class A, class Bt> struct same_t { static constexpr bool v = false; };
template <class A> struct same_t<A, A> { static constexpr bool v = true; };

#define KSWZ(row, colB) ((row) * 256 + ((colB) ^ (((row) & 7) << 4)))
#define SBAR() __builtin_amdgcn_sched_barrier(0)
__device__ __forceinline__ int v_st(int k, int c) { const int kk = (k & ~0xC) | ((k & 4) << 1) | ((k & 8) >> 1); return ((kk >> 3) * 4 + (c >> 5)) * 512 + ((kk & 7) * 32 + (c & 31)) * 2; }
__device__ __forceinline__ int v_rd_base(int lane) { return ((lane & 3) << 3) | (((lane >> 2) & 3) << 6) | (((lane >> 4) & 1) << 5) | (((lane >> 5) & 1) << 8); }
constexpr int v_rd_off(int d0, int ks, int half) { return d0 * 512 + ks * 4096 + half * 2048; }
__device__ __forceinline__ int crow(int r, int hi) { return (r & 3) + 8 * (r >> 2) + 4 * hi; }
__device__ __forceinline__ unsigned cvtpk(float lo, float hi) {
    unsigned r; asm volatile("v_cvt_pk_bf16_f32 %0, %1, %2" : "=v"(r) : "v"(lo), "v"(hi)); return r;
}
__device__ __forceinline__ bf16x8 pack8(f32x4 a, f32x4 b) {
    u32x4 w = {cvtpk(a[0], a[1]), cvtpk(a[2], a[3]), cvtpk(b[0], b[1]), cvtpk(b[2], b[3])};
    return *reinterpret_cast<bf16x8*>(&w);
}
template <class T> __device__ __forceinline__ bf16x8 load8(const T* p) {
    if constexpr (same_t<T, float>::v) { return pack8(*(const f32x4*)p, *(const f32x4*)(p + 4)); }
    else { return *reinterpret_cast<const bf16x8*>(p); }
}
__device__ __forceinline__ void mask_tile(f32x16& p0, f32x16& p1, int dq, unsigned W) {
    const float NEG = -__builtin_inff();
#pragma unroll
    for (int r = 0; r < 16; ++r) {
        const int c = (r & 3) + 8 * (r >> 2);
        if ((unsigned)(dq - c) >= W) p0[r] = NEG;
        if ((unsigned)(dq - c - 32) >= W) p1[r] = NEG;
    }
}
__device__ __forceinline__ void partialSM(f32x16& p0, f32x16& p1, float& m_reg, float& mn, float& alpha) {
    float pmax = p0[0]; for (int r = 1; r < 16; ++r) pmax = fmaxf(pmax, p0[r]); for (int r = 0; r < 16; ++r) pmax = fmaxf(pmax, p1[r]);
    { auto rr = __builtin_amdgcn_permlane32_swap(__float_as_uint(pmax), __float_as_uint(pmax), false, false);
      pmax = fmaxf(__uint_as_float(rr[0]), __uint_as_float(rr[1])); }
    constexpr float C2 = 1.4426950408889634f * SCALE;
    if (__builtin_expect(__all((pmax - m_reg) * SCALE <= THR), 1)) { mn = m_reg; alpha = 1.f; }
    else { mn = fmaxf(m_reg, pmax); alpha = __builtin_amdgcn_exp2f((m_reg - mn) * C2); m_reg = mn; }
    const float mnL = -mn * C2;
    for (int r = 0; r < 16; ++r) p0[r] = fmaf(p0[r], C2, mnL); for (int r = 0; r < 16; ++r) p1[r] = fmaf(p1[r], C2, mnL);
    for (int r = 0; r < 16; ++r) p0[r] = __builtin_amdgcn_exp2f(p0[r]);
}
__device__ __forceinline__ void finishSM(f32x16& p0, f32x16& p1, float alpha, float& l_reg, bf16x8& pa0, bf16x8& pa1, bf16x8& pa2, bf16x8& pa3) {
    for (int r = 0; r < 16; ++r) p1[r] = __builtin_amdgcn_exp2f(p1[r]);
    float ps = 0; for (int r = 0; r < 16; ++r) ps += p0[r]; for (int r = 0; r < 16; ++r) ps += p1[r];
    { auto rr = __builtin_amdgcn_permlane32_swap(__float_as_uint(ps), __float_as_uint(ps), false, false);
      ps = __uint_as_float(rr[0]) + __uint_as_float(rr[1]); }
    l_reg = l_reg * alpha + ps;
#define PK4(P, B_, OUT) do { unsigned a0 = cvtpk(P[B_+0], P[B_+1]), a1 = cvtpk(P[B_+2], P[B_+3]);                          \
        unsigned b0 = cvtpk(P[B_+4], P[B_+5]), b1 = cvtpk(P[B_+6], P[B_+7]);                                             \
        auto r0 = __builtin_amdgcn_permlane32_swap(a0, b0, false, false); auto r1 = __builtin_amdgcn_permlane32_swap(a1, b1, false, false); \
        u32x4 w = {r0[0], r1[0], r0[1], r1[1]}; OUT = *reinterpret_cast<bf16x8*>(&w); } while (0)
    PK4(p0, 0, pa0); PK4(p0, 8, pa1); PK4(p1, 0, pa2); PK4(p1, 8, pa3);
#undef PK4
}
template <int KB, bool SK>
__device__ __forceinline__ void qkt(f32x16& p0, f32x16& p1, const char* K_lds, int r32, int hi, const bf16x8* qr, bool act) {
    if (SK && !act) { const float NEG = -__builtin_inff();
#pragma unroll
        for (int r = 0; r < 16; ++r) { p0[r] = NEG; p1[r] = NEG; } return; }
    p0 = f32x16{}; p1 = f32x16{};
    const char* kb[4];
#pragma unroll
    for (int dd = 0; dd < 4; ++dd) kb[dd] = K_lds + KB * SHM_K + KSWZ(r32, (dd * 16 + hi * 8) * 2);
#pragma unroll
    for (int d0 = 0; d0 < 8; ++d0) { const char* a = kb[d0 & 3] + (d0 >> 2) * 128;
        bf16x8 b0 = *reinterpret_cast<const bf16x8*>(a);
        bf16x8 b1 = *reinterpret_cast<const bf16x8*>(a + 32 * 256);
        p0 = __builtin_amdgcn_mfma_f32_32x32x16_bf16(b0, qr[d0], p0, 0, 0, 0);
        p1 = __builtin_amdgcn_mfma_f32_32x32x16_bf16(b1, qr[d0], p1, 0, 0, 0); }
}
template <int VB, bool SK>
__device__ __forceinline__ void pv_tile(f32x16* o, int vb0, bf16x8 pa0, bf16x8 pa1, bf16x8 pa2, bf16x8 pa3, bool act) {
    if (SK && !act) return;
#define TRRD(dst, off) asm volatile("ds_read_b64_tr_b16 %0, %1 offset:%2" : "=&v"(dst) : "v"(vb0), "i"(off) : "memory")
#define PV_D0(d0) do { s16x4 l0, l1, l2, l3, h0, h1, h2, h3; constexpr int b_ = VB * SHM_V + v_rd_off(d0, 0, 0);     \
        TRRD(l0, b_); TRRD(h0, b_ + 2048); TRRD(l1, b_ + 4096); TRRD(h1, b_ + 6144); TRRD(l2, b_ + 8192); TRRD(h2, b_ + 10240); TRRD(l3, b_ + 12288); TRRD(h3, b_ + 14336); \
        asm volatile("s_waitcnt lgkmcnt(0)" ::: "memory"); SBAR();                 \
        o[d0] = __builtin_amdgcn_mfma_f32_32x32x16_bf16(pa0, (bf16x8){l0[0], l0[1], l0[2], l0[3], h0[0], h0[1], h0[2], h0[3]}, o[d0], 0, 0, 0);   \
        o[d0] = __builtin_amdgcn_mfma_f32_32x32x16_bf16(pa1, (bf16x8){l1[0], l1[1], l1[2], l1[3], h1[0], h1[1], h1[2], h1[3]}, o[d0], 0, 0, 0);   \
        o[d0] = __builtin_amdgcn_mfma_f32_32x32x16_bf16(pa2, (bf16x8){l2[0], l2[1], l2[2], l2[3], h2[0], h2[1], h2[2], h2[3]}, o[d0], 0, 0, 0);   \
        o[d0] = __builtin_amdgcn_mfma_f32_32x32x16_bf16(pa3, (bf16x8){l3[0], l3[1], l3[2], l3[3], h3[0], h3[1], h3[2], h3[3]}, o[d0], 0, 0, 0); } while (0)
    PV_D0(0); PV_D0(1); PV_D0(2); PV_D0(3);
#undef PV_D0
#undef TRRD
}

template <class TIn, class TOut> struct BlockRef { const TIn* Q; const TIn* K; const TIn* V; TOut* O; int P0; };
template <class TIn> struct Seam {
    bf16x8 qr[8];
    bf16x8 st_v0, st_v1, st_k0, st_k1; f32x4 sf0, sf1, sf2, sf3;
    f32x4 tq[16];
};
__device__ __forceinline__ int swa_jlo(int P0, int W) { const int lowk = P0 - W + 1; return lowk > 0 ? lowk / KVBLK : 0; }
#define ROW(p, k0, rr) ((p) + (size_t)((k0) + (rr)) * LDP + sc)
#define VMW() asm volatile("s_waitcnt vmcnt(0)" ::: "memory")
#define VMWN(n) asm volatile("s_waitcnt vmcnt(%0)" :: "i"(n) : "memory")
#define SLOAD_H(Kp, Vp, k0) do { S.st_v0 = load8<TIn>(ROW(Vp, k0, sr)); S.st_v1 = load8<TIn>(ROW(Vp, k0, 32 + sr));              \
                         S.st_k0 = load8<TIn>(ROW(Kp, k0, sr)); S.st_k1 = load8<TIn>(ROW(Kp, k0, 32 + sr)); } while (0)
#define SWRITE_HK(bf) do { *(bf16x8*)(K_lds + (bf) * SHM_K + kws) = S.st_k0; *(bf16x8*)(K_lds + (bf) * SHM_K + kws + 32 * 256) = S.st_k1; } while (0)
#define SWRITE_HV(bf) do { *(bf16x8*)(V_lds + (bf) * SHM_V + vst0) = S.st_v0; *(bf16x8*)(V_lds + (bf) * SHM_V + vst1) = S.st_v1; } while (0)
#define SWRITE_H(bf) do { SWRITE_HV(bf); SWRITE_HK(bf); } while (0)
#define SLOAD_F(p, k0) do { S.sf0 = *(const f32x4*)ROW(p, k0, sr); S.sf1 = *(const f32x4*)(ROW(p, k0, sr) + 4);                \
                            S.sf2 = *(const f32x4*)ROW(p, k0, 32 + sr); S.sf3 = *(const f32x4*)(ROW(p, k0, 32 + sr) + 4); } while (0)
#define SWRITE_KF(bf) do { *(bf16x8*)(K_lds + (bf) * SHM_K + kws) = pack8(S.sf0, S.sf1); *(bf16x8*)(K_lds + (bf) * SHM_K + kws + 32 * 256) = pack8(S.sf2, S.sf3); } while (0)
#define SWRITE_VF(bf) do { *(bf16x8*)(V_lds + (bf) * SHM_V + vst0) = pack8(S.sf0, S.sf1); *(bf16x8*)(V_lds + (bf) * SHM_V + vst1) = pack8(S.sf2, S.sf3); } while (0)
template <class TIn, class TOut>
__device__ __forceinline__ void causal_swa_prime(const BlockRef<TIn, TOut>& cur, int W, char* lds, Seam<TIn>& S, const int mk_wave) {
    constexpr bool F32 = same_t<TIn, float>::v;
    const int lane = (int)(__builtin_amdgcn_mbcnt_hi(~0u, __builtin_amdgcn_mbcnt_lo(~0u, 0u)) & 63u), wid = mk_wave & 7, tid = wid * 64 + lane, r32 = lane & 31, hi = lane >> 5;
    const int sr = tid >> 4, sc = (tid & 15) * 8, kws = KSWZ(sr, sc * 2); char* K_lds = lds + 2 * SHM_V;
    const int kb0 = swa_jlo(cur.P0, W) * KVBLK;
    for (int d0 = 0; d0 < 8; ++d0) S.qr[d0] = load8<TIn>(cur.Q + (size_t)(wid * QBLK + r32) * LDP + d0 * 16 + hi * 8);
    if constexpr (F32) { SLOAD_F((const float*)cur.K, kb0); VMW(); SWRITE_KF(0); SBAR(); SLOAD_F((const float*)cur.V, kb0); }
    else { SLOAD_H(cur.K, cur.V, kb0); VMW(); SWRITE_HK(0); }
    __syncthreads();
}
template <class TIn, class TOut>
__device__ __forceinline__ void causal_swa_block(const BlockRef<TIn, TOut>& cur, const BlockRef<TIn, TOut>& nxt, int skv, int W, char* lds, Seam<TIn>& S, const int mk_wave) {
    constexpr bool F32 = same_t<TIn, float>::v;
    const int lane = (int)(__builtin_amdgcn_mbcnt_hi(~0u, __builtin_amdgcn_mbcnt_lo(~0u, 0u)) & 63u), wid = mk_wave & 7, tid = wid * 64 + lane, r32 = lane & 31, hi = lane >> 5;
    const int j_lo = swa_jlo(cur.P0, W);
    int j_hi = (cur.P0 + QB - 1) / KVBLK + 1; if (j_hi > skv / KVBLK) j_hi = skv / KVBLK;
    const int NT = j_hi - j_lo;
    const int kbn = swa_jlo(nxt.P0, W) * KVBLK;
    const int qlo = cur.P0 + wid * QBLK, qm = qlo + r32 - 4 * hi;
    char* V_lds = lds; char* K_lds = lds + 2 * SHM_V;
    float* ws = (float*)(lds + 2 * SHM_V + 2 * SHM_K) + wid * 64; float* li_l = ws, * al_l = ws + 32;
    float m_reg = -1e30f, l_reg = 0; f32x16 o[4] = {};
    const int sr = tid >> 4, sc = (tid & 15) * 8, vst0 = v_st(sr, sc), vst1 = v_st(32 + sr, sc), kws = KSWZ(sr, sc * 2);
    const int vb0 = (int)(uintptr_t)V_lds + v_rd_base(lane);
    const TIn* Kh = cur.K; const TIn* Vh = cur.V;
#define RESC(a) do { if (__any((a) < 1.f)) { if (hi == 0) al_l[r32] = (a); asm volatile("s_waitcnt lgkmcnt(0)" ::: "memory");              \
                     for (int d_ = 0; d_ < 4; ++d_) for (int r = 0; r < 16; ++r) o[d_][r] *= al_l[crow(r, hi)]; } } while (0)
#define KBASE(t) ((j_lo + (t)) * KVBLK)
#define ACT(t) (KBASE(t) <= qlo + QBLK - 1 && KBASE(t) + KVBLK - 1 >= qlo - W + 1)
#define MASKT(P0_, P1_, t) do { const int kb_ = KBASE(t); if ((!SK || ACT(t)) && (kb_ + KVBLK - 1 > qlo || kb_ <= qlo + QBLK - 1 - W)) mask_tile(P0_, P1_, qm - kb_, (unsigned)W); } while (0)
    constexpr int NQL = F32 ? 16 : 8;
    constexpr bool SK = WSKIP && !F32;
#define SEAM_K0() do { VMWN(NQL); if constexpr (F32) { SWRITE_KF(0); SBAR(); SLOAD_F((const float*)nxt.V, kbn); } else { SWRITE_HK(0); } SBAR(); } while (0)
    f32x16 pA0, pA1, pB0, pB1; float mnA, mnB, alA, alB; bf16x8 pa0, pa1, pa2, pa3;
    if constexpr (F32) { VMW(); SWRITE_VF(0); SBAR(); } else { SWRITE_HV(0); SBAR(); }
    if (NT > 1) { if constexpr (F32) SLOAD_F((const float*)Kh, KBASE(1)); else SLOAD_H(Kh, Vh, KBASE(1)); }
    SBAR(); qkt<0, SK>(pA0, pA1, K_lds, r32, hi, S.qr, ACT(0));
    if constexpr (F32) { if (NT > 1) { VMW(); SWRITE_KF(1); SBAR(); SLOAD_F((const float*)Vh, KBASE(1)); } }
    MASKT(pA0, pA1, 0); partialSM(pA0, pA1, m_reg, mnA, alA);
    if (NT > 1) { VMW(); if constexpr (F32) { SWRITE_VF(1); SBAR(); if (NT > 2) SLOAD_F((const float*)Kh, KBASE(2)); } else SWRITE_H(1); }
    __syncthreads();
#define HALF_STEP(PX0, PX1, mnX, alX, PY0, PY1, alY, t, KB, VB, SB) do {                                                      \
        SBAR(); qkt<KB, SK>(PX0, PX1, K_lds, r32, hi, S.qr, ACT(t));                                             \
        finishSM(PY0, PY1, alY, l_reg, pa0, pa1, pa2, pa3); SBAR();                                                           \
        if ((t) + 1 < NT) { if constexpr (F32) { VMW(); SWRITE_KF(SB); SBAR(); SLOAD_F((const float*)Vh, KBASE((t) + 1)); }  \
                            else { SLOAD_H(Kh, Vh, KBASE((t) + 1)); } SBAR(); }                                               \
        pv_tile<VB, SK>(o, vb0, pa0, pa1, pa2, pa3, ACT((t) - 1)); MASKT(PX0, PX1, (t)); partialSM(PX0, PX1, m_reg, mnX, alX);                                        \
        __syncthreads();                                                                                                      \
        if ((t) + 1 < NT) { VMW(); if constexpr (F32) { SWRITE_VF(SB); SBAR(); if ((t) + 2 < NT) SLOAD_F((const float*)Kh, KBASE((t) + 2)); } \
                            else { SWRITE_H(SB); } }                                                                          \
        RESC(alX); __syncthreads(); } while (0)
    for (int t = 1; t + 1 < NT; t += 2) {
        HALF_STEP(pB0, pB1, mnB, alB, pA0, pA1, alA, t, 1, 0, 0);
        HALF_STEP(pA0, pA1, mnA, alA, pB0, pB1, alB, t + 1, 0, 1, 1);
    }
    const bool even = (NT & 1) == 0;
    if (even) { SBAR(); qkt<1, SK>(pB0, pB1, K_lds, r32, hi, S.qr, ACT(NT - 1)); SBAR(); }
#define QROW(e) (nxt.Q + (size_t)(wid * QBLK + r32) * LDP + ((e) >> 1) * 16 + hi * 8 + ((e) & 1) * 4)
    if constexpr (F32) { SLOAD_F((const float*)nxt.K, kbn); SBAR();
#pragma unroll
        for (int e = 0; e < 8; ++e) S.tq[e] = *(const f32x4*)QROW(e); }
    else { SLOAD_H(nxt.K, nxt.V, kbn); SBAR();
#pragma unroll
        for (int d0 = 0; d0 < 8; ++d0) S.qr[d0] = load8<TIn>(nxt.Q + (size_t)(wid * QBLK + r32) * LDP + d0 * 16 + hi * 8); }
    SBAR();
    finishSM(pA0, pA1, alA, l_reg, pa0, pa1, pa2, pa3); SBAR();
    if constexpr (F32) {
#pragma unroll
        for (int e = 8; e < 16; ++e) S.tq[e] = *(const f32x4*)QROW(e); SBAR(); }
#undef QROW
    pv_tile<0, SK>(o, vb0, pa0, pa1, pa2, pa3, ACT(even ? NT - 2 : NT - 1));
    if (even) { MASKT(pB0, pB1, NT - 1); partialSM(pB0, pB1, m_reg, mnB, alB); __syncthreads(); RESC(alB);
        finishSM(pB0, pB1, alB, l_reg, pa0, pa1, pa2, pa3); SBAR(); pv_tile<1, SK>(o, vb0, pa0, pa1, pa2, pa3, ACT(NT - 1)); }
    SBAR(); SEAM_K0();
    if (hi == 0) li_l[r32] = l_reg; asm volatile("s_waitcnt lgkmcnt(0)" ::: "memory");
    float rli[16];
#pragma unroll
    for (int r = 0; r < 16; ++r) rli[r] = __builtin_amdgcn_rcpf(li_l[crow(r, hi)]);
    TOut* Ow = cur.O + (size_t)(wid * QBLK) * LDO;
#pragma unroll
    for (int r = 0; r < 16; ++r) { const int orow = crow(r, hi);
#pragma unroll
        for (int d0 = 0; d0 < 4; ++d0) { const float v = o[d0][r] * rli[r];
            if constexpr (same_t<TOut, float>::v) { Ow[(size_t)orow * LDO + d0 * 32 + r32] = v; }
            else { const float vn = __shfl_xor(v, 1);
                   if ((r32 & 1) == 0) *(unsigned*)(Ow + (size_t)orow * LDO + d0 * 32 + r32) = cvtpk(v, vn); } } }
    if constexpr (F32) {
#pragma unroll
        for (int d0 = 0; d0 < 8; ++d0) S.qr[d0] = pack8(S.tq[2 * d0], S.tq[2 * d0 + 1]); }
    __syncthreads();
#undef RESC
#undef KBASE
#undef ACT
#undef MASKT
#undef SEAM_K0
#undef HALF_STEP
}
#undef ROW
#undef VMW
#undef VMWN
#undef SLOAD_H
#undef SWRITE_HK
#undef SWRITE_HV
#undef SWRITE_H
#undef SLOAD_F
#undef SWRITE_KF
#undef SWRITE_VF

constexpr int A2_V = 0;
constexpr int A2_K = 4 * SHM_V;
constexpr int A2_X = A2_K + 2 * SHM_K;
constexpr int A2_XS = 4096 + 512;
constexpr int A2_LDS = A2_X + 4 * A2_XS;
struct A2Ref { const bf16* Q; const bf16* K; const bf16* V0; const bf16* V1; bf16* O; int P0; };

__device__ __forceinline__ void attn2_block(const A2Ref& c, char* lds, const int mk_wave) {
    const int lane = (int)(__builtin_amdgcn_mbcnt_hi(~0u, __builtin_amdgcn_mbcnt_lo(~0u, 0u)) & 63u), wid = mk_wave & 7, tid = wid * 64 + lane, r32 = lane & 31, hi = lane >> 5, rg = wid & 3, vh = wid >> 2;
    char* V_lds = lds + A2_V; char* K_lds = lds + A2_K; char* X = lds + A2_X + rg * A2_XS;
    float* XA = (float*)(X + 4096); float* XM = XA + 32; float* XL = XA + 64;
    const int NT = (c.P0 + 127) / 64 + 1;
    const int qlo = c.P0 + rg * 32, qm = qlo + r32 - 4 * hi;
    const int sr = tid >> 4, sc = (tid & 15) * 8, vst0 = v_st(sr, sc), vst1 = v_st(32 + sr, sc), kws = KSWZ(sr, sc * 2);
    const int vb0 = (int)(uintptr_t)V_lds + vh * SHM_V + v_rd_base(lane);
    bf16x8 qr[8];
#pragma unroll
    for (int d0 = 0; d0 < 8; ++d0) qr[d0] = load8<bf16>(c.Q + (size_t)(rg * 32 + r32) * 128 + d0 * 16 + hi * 8);
    float m_reg = -1e30f, l_reg = 0.f; f32x16 o[4] = {};
    bf16x8 sk0, sk1, sa0, sa1, sb0, sb1;
#define A2_LOAD(kb) do { const size_t ro_ = (size_t)((kb) + sr) * 128 + sc; sk0 = load8<bf16>(c.K + ro_); sk1 = load8<bf16>(c.K + ro_ + 32 * 128); \
        sa0 = load8<bf16>(c.V0 + ro_); sa1 = load8<bf16>(c.V0 + ro_ + 32 * 128); sb0 = load8<bf16>(c.V1 + ro_); sb1 = load8<bf16>(c.V1 + ro_ + 32 * 128); } while (0)
#define A2_WRITE(buf) do { *(bf16x8*)(K_lds + (buf) * SHM_K + kws) = sk0; *(bf16x8*)(K_lds + (buf) * SHM_K + kws + 32 * 256) = sk1; \
        *(bf16x8*)(V_lds + (buf) * 2 * SHM_V + vst0) = sa0; *(bf16x8*)(V_lds + (buf) * 2 * SHM_V + vst1) = sa1; \
        *(bf16x8*)(V_lds + (buf) * 2 * SHM_V + SHM_V + vst0) = sb0; *(bf16x8*)(V_lds + (buf) * 2 * SHM_V + SHM_V + vst1) = sb1; } while (0)
#define A2_VMW() asm volatile("s_waitcnt vmcnt(0)" ::: "memory")
#define A2_STEP(t, B) do { const bool more_ = (t) + 1 < NT; if (more_) A2_LOAD(((t) + 1) * 64); \
        bf16x8 pa0, pa1, pa2, pa3; \
        if (vh == (B)) { f32x16 p0, p1; float mn, alpha; \
            qkt<(B), false>(p0, p1, K_lds, r32, hi, qr, true); \
            if (64 * (t) + 63 > qlo) mask_tile(p0, p1, qm - 64 * (t), 16384u); \
            partialSM(p0, p1, m_reg, mn, alpha); finishSM(p0, p1, alpha, l_reg, pa0, pa1, pa2, pa3); \
            *(bf16x8*)(X + lane * 16) = pa0; *(bf16x8*)(X + 1024 + lane * 16) = pa1; *(bf16x8*)(X + 2048 + lane * 16) = pa2; *(bf16x8*)(X + 3072 + lane * 16) = pa3; \
            if (hi == 0) { XA[r32] = alpha; XM[r32] = m_reg; XL[r32] = l_reg; } } \
        __syncthreads(); \
        if (vh != (B)) { pa0 = *(const bf16x8*)(X + lane * 16); pa1 = *(const bf16x8*)(X + 1024 + lane * 16); pa2 = *(const bf16x8*)(X + 2048 + lane * 16); pa3 = *(const bf16x8*)(X + 3072 + lane * 16); \
            m_reg = XM[r32]; l_reg = XL[r32]; } \
        { const float a_ = XA[r32]; if (__any(a_ < 1.f)) { \
            _Pragma("unroll") for (int d_ = 0; d_ < 4; ++d_) _Pragma("unroll") for (int r = 0; r < 16; ++r) o[d_][r] *= XA[crow(r, hi)]; } } \
        pv_tile<2 * (B), false>(o, vb0, pa0, pa1, pa2, pa3, true); \
        if (more_) { A2_VMW(); A2_WRITE((B) ^ 1); } \
        __syncthreads(); } while (0)
    A2_LOAD(0); A2_VMW(); A2_WRITE(0); __syncthreads();
    for (int t = 0; t < NT; t += 2) { A2_STEP(t, 0); A2_STEP(t + 1, 1); }
    float rli[16];
#pragma unroll
    for (int r = 0; r < 16; ++r) rli[r] = __builtin_amdgcn_rcpf(XL[crow(r, hi)]);
    bf16* Ow = c.O + (size_t)(rg * 32) * LDO + vh * 128;
#pragma unroll
    for (int r = 0; r < 16; ++r) { const int orow = crow(r, hi);
#pragma unroll
        for (int d0 = 0; d0 < 4; ++d0) { const float v = o[d0][r] * rli[r]; const float vn = __shfl_xor(v, 1);
            if ((r32 & 1) == 0) *(unsigned*)(Ow + (size_t)orow * LDO + d0 * 32 + r32) = cvtpk(v, vn); } }
    __syncthreads();
#undef A2_LOAD
#undef A2_WRITE
#undef A2_VMW
#undef A2_STEP
}

constexpr int A6_XS = 8192 + 1024;
constexpr int A6_LDS = A2_X + 4 * A6_XS + 8 * 128;
__device__ __forceinline__ void attn6_block(const A2Ref& c, char* lds, const int mk_wave) {
    int lane_ = (int)(__builtin_amdgcn_mbcnt_hi(~0u, __builtin_amdgcn_mbcnt_lo(~0u, 0u)) & 63u); asm volatile("" : "+v"(lane_));
    const int lane = lane_ & 63, wid = mk_wave & 7, tid = wid * 64 + lane, r32 = lane & 31, hi = lane >> 5, rg = wid & 3, vh = wid >> 2;
    char* V_lds = lds + A2_V; char* K_lds = lds + A2_K; char* X = lds + A2_X + rg * A6_XS;
    float* XM = (float*)(X + 8192); float* XL = XM + 128; float* AL = (float*)(lds + A2_X + 4 * A6_XS + wid * 128);
    const int NT = (c.P0 + 127) / 64 + 1;
    const int qlo = c.P0 + rg * 32, qm = qlo + r32 - 4 * hi;
    const int sr = tid >> 4, sc = (tid & 15) * 8, vst0 = v_st(sr, sc), vst1 = v_st(32 + sr, sc), kws = KSWZ(sr, sc * 2);
    const unsigned so = (unsigned)(sr * 128 + sc) * 2u;
    const int vb0 = (int)(uintptr_t)V_lds + vh * SHM_V + v_rd_base(lane);
    bf16x8 qr[8];
#pragma unroll
    for (int d0 = 0; d0 < 8; ++d0) qr[d0] = load8<bf16>(c.Q + (size_t)(rg * 32 + r32) * 128 + d0 * 16 + hi * 8);
    float m_reg = -1e30f, l_reg = 0.f; f32x16 o[4] = {};
    bf16x8 sk0, sk1, sa0, sa1, sb0, sb1;
    constexpr float C2 = 1.4426950408889634f * SCALE;
#define A4_G(base, kb, rows) (*(const bf16x8*)((const char*)((base) + (size_t)((kb) + (rows)) * 128) + so))
#define A4_LOAD(kb) do { sk0 = A4_G(c.K, kb, 0); sk1 = A4_G(c.K, kb, 32); sa0 = A4_G(c.V0, kb, 0); sa1 = A4_G(c.V0, kb, 32); sb0 = A4_G(c.V1, kb, 0); sb1 = A4_G(c.V1, kb, 32); } while (0)
#define A4_WRITE(buf) do { *(bf16x8*)(K_lds + (buf) * SHM_K + kws) = sk0; *(bf16x8*)(K_lds + (buf) * SHM_K + kws + 32 * 256) = sk1; \
        *(bf16x8*)(V_lds + (buf) * 2 * SHM_V + vst0) = sa0; *(bf16x8*)(V_lds + (buf) * 2 * SHM_V + vst1) = sa1; \
        *(bf16x8*)(V_lds + (buf) * 2 * SHM_V + SHM_V + vst0) = sb0; *(bf16x8*)(V_lds + (buf) * 2 * SHM_V + SHM_V + vst1) = sb1; } while (0)
#define A6_LOADK(kb) do { sk0 = A4_G(c.K, kb, 0); sk1 = A4_G(c.K, kb, 32); } while (0)
#define A6_LOADV(kb) do { sa0 = A4_G(c.V0, kb, 0); sa1 = A4_G(c.V0, kb, 32); sb0 = A4_G(c.V1, kb, 0); sb1 = A4_G(c.V1, kb, 32); } while (0)
#define A6_WRITEK(buf) do { *(bf16x8*)(K_lds + (buf) * SHM_K + kws) = sk0; *(bf16x8*)(K_lds + (buf) * SHM_K + kws + 32 * 256) = sk1; } while (0)
#define A6_WRITEV(buf) do { *(bf16x8*)(V_lds + (buf) * 2 * SHM_V + vst0) = sa0; *(bf16x8*)(V_lds + (buf) * 2 * SHM_V + vst1) = sa1; \
        *(bf16x8*)(V_lds + (buf) * 2 * SHM_V + SHM_V + vst0) = sb0; *(bf16x8*)(V_lds + (buf) * 2 * SHM_V + SHM_V + vst1) = sb1; } while (0)
#define A4_VMW() asm volatile("s_waitcnt vmcnt(0)" ::: "memory")
#define A4_PK(P, B_, OUT) do { unsigned a0_ = cvtpk(P[B_+0], P[B_+1]), a1_ = cvtpk(P[B_+2], P[B_+3]), b0_ = cvtpk(P[B_+4], P[B_+5]), b1_ = cvtpk(P[B_+6], P[B_+7]); \
        auto r0_ = __builtin_amdgcn_permlane32_swap(a0_, b0_, false, false); auto r1_ = __builtin_amdgcn_permlane32_swap(a1_, b1_, false, false); \
        u32x4 w_ = {r0_[0], r1_[0], r0_[1], r1_[1]}; OUT = *reinterpret_cast<bf16x8*>(&w_); } while (0)
#define A5_QK(T, KB) do { p = f32x16{}; \
        { const char* kb_[4]; \
          _Pragma("unroll") for (int dd = 0; dd < 4; ++dd) kb_[dd] = K_lds + (KB) * SHM_K + vh * (32 * 256) + KSWZ(r32, (dd * 16 + hi * 8) * 2); \
          _Pragma("unroll") for (int d0 = 0; d0 < 8; ++d0) { const bf16x8 b_ = *reinterpret_cast<const bf16x8*>(kb_[d0 & 3] + (d0 >> 2) * 128); p = __builtin_amdgcn_mfma_f32_32x32x16_bf16(b_, qr[d0], p, 0, 0, 0); } } } while (0)
#define A5_MAX(T) do { \
        if (64 * (T) + 32 * vh + 31 > qlo) { const int dq_ = qm - 64 * (T) - 32 * vh; \
            _Pragma("unroll") for (int r = 0; r < 16; ++r) { const int cc_ = (r & 3) + 8 * (r >> 2); if ((unsigned)(dq_ - cc_) >= 16384u) p[r] = -__builtin_inff(); } } \
        pmax_ = p[0]; \
        _Pragma("unroll") for (int r = 1; r < 16; ++r) pmax_ = fmaxf(pmax_, p[r]); \
        { auto rr_ = __builtin_amdgcn_permlane32_swap(__float_as_uint(pmax_), __float_as_uint(pmax_), false, false); pmax_ = fmaxf(__uint_as_float(rr_[0]), __uint_as_float(rr_[1])); } \
        if (hi == 0) XM[vh * 32 + r32] = pmax_; } while (0)
#define A5_SOFTMAX() do { \
        pmax_ = fmaxf(pmax_, XM[(vh ^ 1) * 32 + r32]); \
        float mn_; \
        if (__builtin_expect(__all((pmax_ - m_reg) * SCALE <= THR), 1)) { mn_ = m_reg; alpha_ = 1.f; } \
        else { mn_ = fmaxf(m_reg, pmax_); alpha_ = __builtin_amdgcn_exp2f((m_reg - mn_) * C2); m_reg = mn_; } \
        { const float mnL_ = -mn_ * C2; float ps_ = 0.f; \
          _Pragma("unroll") for (int r = 0; r < 16; ++r) { p[r] = __builtin_amdgcn_exp2f(fmaf(p[r], C2, mnL_)); ps_ += p[r]; } \
          auto rr_ = __builtin_amdgcn_permlane32_swap(__float_as_uint(ps_), __float_as_uint(ps_), false, false); ps_ = __uint_as_float(rr_[0]) + __uint_as_float(rr_[1]); \
          l_reg = l_reg * alpha_ + ps_; } \
        A4_PK(p, 0, pm0_); A4_PK(p, 8, pm1_); \
        *(bf16x8*)(X + vh * 2048 + lane * 16) = pm0_; *(bf16x8*)(X + vh * 2048 + 1024 + lane * 16) = pm1_; \
        if (hi == 0) AL[r32] = alpha_; } while (0)
    f32x16 p; float pmax_, alpha_ = 1.f; bf16x8 pm0_, pm1_;
    A4_LOAD(0); A4_VMW(); A4_WRITE(0); A6_LOADK(64); A4_VMW(); A6_WRITEK(1); A6_LOADV(64); if (2 < NT) A6_LOADK(128);
    __syncthreads();
    A5_QK(0, 0); A5_MAX(0);
    __syncthreads();
    A5_SOFTMAX();
    __syncthreads();
#define A6_STEP(t, B) do { \
        bf16x8 pa0, pa1, pa2, pa3; \
        { const bf16x8 po0_ = *(const bf16x8*)(X + (B) * 4096 + (vh ^ 1) * 2048 + lane * 16), po1_ = *(const bf16x8*)(X + (B) * 4096 + (vh ^ 1) * 2048 + 1024 + lane * 16); \
          if (vh == 0) { pa0 = pm0_; pa1 = pm1_; pa2 = po0_; pa3 = po1_; } else { pa0 = po0_; pa1 = po1_; pa2 = pm0_; pa3 = pm1_; } } \
        const float cand_ = fmaxf(pmax_, XM[(B) * 64 + (vh ^ 1) * 32 + r32]);                         \
        const bool more1_ = (t) + 1 < NT; \
        if (more1_) { A4_VMW(); A6_WRITEV((B) ^ 1); if ((t) + 2 < NT) A6_LOADV(((t) + 2) * 64); }     \
        if (more1_) A5_QK((t) + 1, (B) ^ 1); \
        pv_tile<2 * (B), false>(o, vb0, pa0, pa1, pa2, pa3, true); \
        if (!__all((cand_ - m_reg) * SCALE <= THR)) {                                      \
            const float mn_ = fmaxf(m_reg, cand_), al_ = __builtin_amdgcn_exp2f((m_reg - mn_) * C2); m_reg = mn_; l_reg *= al_; \
            if (hi == 0) AL[r32] = al_; asm volatile("s_waitcnt lgkmcnt(0)" ::: "memory"); \
            _Pragma("unroll") for (int d_ = 0; d_ < 4; ++d_) _Pragma("unroll") for (int r = 0; r < 16; ++r) o[d_][r] *= AL[crow(r, hi)]; } \
        if (more1_) { \
            if (64 * ((t) + 1) + 32 * vh + 31 > qlo) { const int dq_ = qm - 64 * ((t) + 1) - 32 * vh; \
                _Pragma("unroll") for (int r = 0; r < 16; ++r) { const int cc_ = (r & 3) + 8 * (r >> 2); if ((unsigned)(dq_ - cc_) >= 16384u) p[r] = -__builtin_inff(); } } \
            pmax_ = p[0]; \
            _Pragma("unroll") for (int r = 1; r < 16; ++r) pmax_ = fmaxf(pmax_, p[r]); \
            { auto rr_ = __builtin_amdgcn_permlane32_swap(__float_as_uint(pmax_), __float_as_uint(pmax_), false, false); pmax_ = fmaxf(__uint_as_float(rr_[0]), __uint_as_float(rr_[1])); } \
            { const float mnL_ = -m_reg * C2; float ps_ = 0.f; \
              _Pragma("unroll") for (int r = 0; r < 16; ++r) { p[r] = __builtin_amdgcn_exp2f(fmaf(p[r], C2, mnL_)); ps_ += p[r]; } \
              auto rr_ = __builtin_amdgcn_permlane32_swap(__float_as_uint(ps_), __float_as_uint(ps_), false, false); ps_ = __uint_as_float(rr_[0]) + __uint_as_float(rr_[1]); \
              l_reg += ps_; } \
            A4_PK(p, 0, pm0_); A4_PK(p, 8, pm1_); \
            *(bf16x8*)(X + ((B) ^ 1) * 4096 + vh * 2048 + lane * 16) = pm0_; *(bf16x8*)(X + ((B) ^ 1) * 4096 + vh * 2048 + 1024 + lane * 16) = pm1_; \
            if (hi == 0) XM[((B) ^ 1) * 64 + vh * 32 + r32] = pmax_; \
            if ((t) + 2 < NT) { A6_WRITEK(B); if ((t) + 3 < NT) A6_LOADK(((t) + 3) * 64); }     \
            __syncthreads(); } \
    } while (0)
    for (int t = 0; t < NT; t += 2) { A6_STEP(t, 0); A6_STEP(t + 1, 1); }
    __syncthreads();
    if (hi == 0) XL[vh * 32 + r32] = l_reg;
    __syncthreads();
    float rli[16];
#pragma unroll
    for (int r = 0; r < 16; ++r) rli[r] = __builtin_amdgcn_rcpf(XL[crow(r, hi)] + XL[32 + crow(r, hi)]);
    bf16* Ow = c.O + (size_t)(rg * 32) * LDO + vh * 128;
#pragma unroll
    for (int r = 0; r < 16; ++r) { const int orow = crow(r, hi);
#pragma unroll
        for (int d0 = 0; d0 < 4; ++d0) { const float v = o[d0][r] * rli[r]; const float vn = __shfl_xor(v, 1);
            if ((r32 & 1) == 0) *(unsigned*)(Ow + (size_t)orow * LDO + d0 * 32 + r32) = cvtpk(v, vn); } }
    __syncthreads();
#undef A4_G
#undef A4_LOAD
#undef A4_WRITE
#undef A4_VMW
#undef A4_PK
#undef A5_QK
#undef A5_MAX
#undef A5_SOFTMAX
#undef A6_STEP
#undef A6_WRITEK
#undef A6_LOADK
#undef A6_LOADV
#undef A6_WRITEV
}

}

constexpr int S_ = 16384, DM = 2048, FF = 5632, NIN = 6152, NINP = 6144, PLD = 3072;
constexpr int NWAVES = 8, NTHR = 512;
constexpr int C_MQ = 0, C_MK = 512, C_MV = 1024, C_MO = 2048;
constexpr size_t MiB = 1u << 20, KiB = 1u << 10;
constexpr size_t WS_ROWSS1 = 0, WS_ROWSS2 = 64 * KiB, WS_SC = 192 * KiB  , WS_DN = 256 * KiB, WS_GATES = 512 * KiB;
constexpr size_t WS_BAR = 128 * KiB;
constexpr size_t WS_WGU = 1 * MiB, WS_WD = 45 * MiB, WS_WIN = 67 * MiB, WS_WOUT = 92 * MiB;
constexpr size_t WS_XN = 100 * MiB;
constexpr size_t WS_BIG = 164 * MiB;
constexpr size_t WS_Y = 356 * MiB;
constexpr size_t WS_CT = 420 * MiB;
constexpr size_t WS_QC = 452 * MiB, WS_KC = 468 * MiB;
constexpr size_t WS_NST = 484 * MiB;
constexpr size_t WS_GW = 484 * MiB + 512 * KiB;
constexpr size_t WS_END = 485 * MiB;
constexpr int LDS_BYTES = 147456;

#define LAS __attribute__((address_space(3)))
typedef unsigned short bfu;
typedef unsigned v4u __attribute__((ext_vector_type(4)));
typedef unsigned v2u __attribute__((ext_vector_type(2)));
typedef float f32x4 __attribute__((ext_vector_type(4)));
typedef short bf16x8 __attribute__((ext_vector_type(8)));
#define MFMA16(a, b, c) __builtin_amdgcn_mfma_f32_16x16x32_bf16(a, b, c, 0, 0, 0)
#define LDS_WAIT() asm volatile("s_waitcnt lgkmcnt(0)" ::: "memory")
__device__ __forceinline__ unsigned f2bf(float f) { unsigned u = __builtin_bit_cast(unsigned, f); return (u + 0x7fffu + ((u >> 16) & 1u)) >> 16; }
__device__ __forceinline__ unsigned pk2(float lo, float hi) { return f2bf(lo) | (f2bf(hi) << 16); }
__device__ __forceinline__ float bf2f(unsigned b) { return __builtin_bit_cast(float, b << 16); }
__device__ __forceinline__ int mk_lane() { return (int)(__builtin_amdgcn_mbcnt_hi(~0u, __builtin_amdgcn_mbcnt_lo(~0u, 0u)) & 63u); }
__device__ __forceinline__ float wave_sum(float v) {
#pragma unroll
    for (int o = 1; o < 64; o <<= 1) v += __shfl_xor(v, o);
    return v;
}
__device__ __forceinline__ float silu(float x) { return x / (1.0f + __expf(-x)); }

__device__ __forceinline__ void cvt_item(const float* __restrict__ W, int ldw, int ncols, const float* __restrict__ gain, bfu* WT, int K, int dst_row0, int k0, int n0, LAS float* scr, int lane) {
    const int nq = (lane & 15) * 4, kr = lane >> 4, n = n0 + nq;
#pragma unroll 8
    for (int i = 0; i < 16; ++i) { const int kk = 4 * i + kr; f32x4 v = (f32x4){0.f, 0.f, 0.f, 0.f};
        if (n < ncols) v = *(const f32x4*)(W + (size_t)(k0 + kk) * ldw + n);
        if (gain) v = v * gain[k0 + kk];
        LAS float* d = scr + kk * 65 + nq; d[0] = v[0]; d[1] = v[1]; d[2] = v[2]; d[3] = v[3]; }
    LDS_WAIT(); asm volatile("" ::: "memory");
    const int c = lane & 7;
#pragma unroll
    for (int j = 0; j < 8; ++j) { const int nn = (lane >> 3) + 8 * j; const LAS float* s = scr + (8 * c) * 65 + nn;
        v4u o; o.x = pk2(s[0 * 65], s[1 * 65]); o.y = pk2(s[2 * 65], s[3 * 65]); o.z = pk2(s[4 * 65], s[5 * 65]); o.w = pk2(s[6 * 65], s[7 * 65]);
        *(v4u*)(WT + (size_t)(dst_row0 + nn) * K + k0 + 8 * c) = o; }
    LDS_WAIT(); asm volatile("" ::: "memory");
}
__device__ __forceinline__ void cvt_ffn_item(int it, const float* wg, const float* wu, const float* wd, const float* gain, bfu* Wgu, bfu* Wd, LAS float* scr, int lane) {
    if (it < 2 * 2816) { const int up = it >= 2816; const int r = up ? it - 2816 : it; const int kb = r / 88, nb = r % 88, n0 = nb * 64;
        cvt_item(up ? wu : wg, FF, FF, gain, Wgu, DM, 256 * (n0 >> 7) + (n0 & 127) + (up ? 128 : 0), kb * 64, n0, scr, lane); }
    else { const int r = it - 2 * 2816; const int kb = r / 32, nb = r % 32; cvt_item(wd, DM, DM, nullptr, Wd, FF, nb * 64, kb * 64, nb * 64, scr, lane); }
}

constexpr int GWP = 4112;
__device__ __forceinline__ void gates_rows(LAS unsigned char* lds, const bfu* __restrict__ XB, const float* __restrict__ rowss, const float* __restrict__ b_i, const float* __restrict__ b_f, float* GATES, int rb, int wave, int lane) {
    const int fr = lane & 15, fq = lane >> 4, rg = wave & 3, kh = wave >> 2;
    const LAS unsigned char* wl = lds + 16384;
    const bfu* xp = XB + (size_t)(rb * 64 + rg * 16 + fr) * DM + kh * 1024 + 8 * fq;
    f32x4 acc = (f32x4){0.f, 0.f, 0.f, 0.f};
    for (int k0 = 0; k0 < 32; k0 += 16) {
        bf16x8 xa[16];
#pragma unroll
        for (int ks = 0; ks < 16; ++ks) xa[ks] = *(const bf16x8*)(xp + (k0 + ks) * 32);
#pragma unroll
        for (int ks = 0; ks < 16; ++ks) { const bf16x8 wb = *(const LAS bf16x8*)(wl + fr * GWP + (kh * 1024 + (k0 + ks) * 32 + 8 * fq) * 2); acc = MFMA16(xa[ks], wb, acc); }
    }
    LAS f32x4* red = (LAS f32x4*)lds;
    if (kh == 1) red[rg * 64 + lane] = acc;
    __syncthreads();
    if (kh == 0 && fr < 8) {
        const f32x4 o = red[rg * 64 + lane]; const float bias = fr < 4 ? b_i[fr] : b_f[fr - 4];
#pragma unroll
        for (int j = 0; j < 4; ++j) { const int row = rb * 64 + rg * 16 + 4 * fq + j;
            const float pre = (acc[j] + o[j]) / sqrtf(rowss[row] * (1.0f / DM) + 1e-6f) + bias; const float capped = 15.0f * tanhf(pre * (1.0f / 15.0f));
            GATES[(size_t)row * 8 + fr] = fr < 4 ? capped : -log1pf(expf(-capped)); }
    }
    __syncthreads();
}

#define XB_TMO      128
#define XB_XCNT(j)  (256  + 64 * (j))
#define XB_XSUB(j)  (1280 + 64 * (j))
#define XB_XGEN(j)  (2304 + 64 * (j))
#define XB_TOP      3328
#define XB_TOPGEN   3392
#define XCD_BAR_WORDS 3456
#define XB_SPIN_CAP (1u << 18)
__device__ __forceinline__ unsigned xb_ld(unsigned* p)              { return __hip_atomic_load(p, __ATOMIC_RELAXED, __HIP_MEMORY_SCOPE_AGENT); }
__device__ __forceinline__ unsigned xb_add(unsigned* p, unsigned v) { return __hip_atomic_fetch_add(p, v, __ATOMIC_RELAXED, __HIP_MEMORY_SCOPE_AGENT); }
__device__ __forceinline__ unsigned xb_xcc_id() { return (unsigned)__builtin_amdgcn_s_getreg((3 << 11) | 20) & 0xFu; }
#define XB_SPIN(cond, bar) do { unsigned _sp = 0; while (cond) { __builtin_amdgcn_s_sleep(1); \
    if ((++_sp & 255u) == 0u) { if (xb_ld(&(bar)[XB_TMO])) break; if (_sp > XB_SPIN_CAP) { atomicAdd(&(bar)[XB_TMO], 1u); break; } } } } while (0)
__device__ __forceinline__ void xcd_barrier_complete(unsigned* bar, unsigned x, unsigned& nloc, unsigned& nx) {
    const unsigned G = gridDim.x * gridDim.y * gridDim.z;
    unsigned sum, cnt, mine, sp = 0u;
    for (;;) {
        sum = 0u; cnt = 0u; mine = 0u;
#pragma unroll
        for (unsigned j = 0; j < 16; ++j) { const unsigned c = xb_ld(&bar[XB_XCNT(j)]); sum += c; cnt += (c > 0u) ? 1u : 0u; mine = (j == x) ? c : mine; }
        if (sum == G) break;
        __builtin_amdgcn_s_sleep(1);
        if ((++sp & 255u) == 0u) { if (xb_ld(&bar[XB_TMO])) break; if (sp > XB_SPIN_CAP) { atomicAdd(&bar[XB_TMO], 1u); break; } }
    }
    nloc = mine > 0u ? mine : 1u; nx = cnt > 0u ? cnt : 1u;
}
__device__ __forceinline__ void xcd_barrier(unsigned* bar, volatile LAS unsigned* st, const bool first) {
    asm volatile("s_waitcnt vmcnt(0)" ::: "memory");
    __syncthreads();
    if (first) {
        const unsigned x = xb_xcc_id();
        __builtin_amdgcn_s_waitcnt(0);
        unsigned nloc = st[0], nx = st[1];
        if (nloc == 0u) { xcd_barrier_complete(bar, x, nloc, nx); st[0] = nloc; st[1] = nx; }
        const unsigned old = xb_add(&bar[XB_XSUB(x)], 1u);
        const unsigned gen = old / nloc;
        if (old + 1u == (gen + 1u) * nloc) {
            __builtin_amdgcn_fence(__ATOMIC_RELEASE, "agent");
            asm volatile("s_waitcnt vmcnt(0)" ::: "memory");
            const unsigned og = xb_add(&bar[XB_TOP], 1u);
            const unsigned tg = og / nx;
            if (og + 1u == (tg + 1u) * nx) xb_add(&bar[XB_TOPGEN], 1u);
            else XB_SPIN(xb_ld(&bar[XB_TOPGEN]) == tg, bar);
            __builtin_amdgcn_fence(__ATOMIC_ACQUIRE, "agent");
            xb_add(&bar[XB_XGEN(x)], 1u);
            asm volatile("s_waitcnt vmcnt(0)" ::: "memory");
        } else {
            XB_SPIN(xb_ld(&bar[XB_XGEN(x)]) == gen, bar);
            __builtin_amdgcn_fence(__ATOMIC_ACQUIRE, "agent");
            asm volatile("s_waitcnt vmcnt(0)" ::: "memory");
        }
    }
    __syncthreads();
}

struct Args { const float* in[23]; float* out; unsigned char* ws; int ph_lo, ph_hi; };
constexpr int NPH = 12;

constexpr int MP = 272;

__device__ __forceinline__ void mlstm_stage_a(LAS unsigned char* lds, const bfu* __restrict__ PROJ, const float* __restrict__ GATES, const float* __restrict__ conv_w, const float* __restrict__ conv_b,
                                              bfu* QC, bfu* KC, float* DELTA, float* DN, float* SC, int item, const int mk_wave) {
    int lane = mk_lane(); asm volatile("" : "+v"(lane));
    const int wid = mk_wave & 7, tid = wid * 64 + lane, fr = lane & 15, fq = lane >> 4;
    const int h = item & 3, row0 = (item >> 2) * 128;
    LAS float* fa = (LAS float*)lds; LAS unsigned char* KT = lds + 4096; LAS unsigned char* VT = KT + 128 * MP;
    if (tid < 128) { fa[tid] = GATES[(size_t)(row0 + tid) * 8 + 4 + h]; fa[128 + tid] = GATES[(size_t)(row0 + tid) * 8 + h]; }
    __syncthreads();
    if (tid < 128) { float b = 0.f; for (int s = 0; s <= tid; ++s) b += fa[s]; fa[256 + tid] = fa[128 + tid] - b; if (tid == 127) fa[385] = b; }
    __syncthreads();
    if (wid == 0) { float a = fmaxf(fa[256 + lane], fa[320 + lane]);
#pragma unroll
        for (int o = 1; o < 64; o <<= 1) a = fmaxf(a, __shfl_xor(a, o));
        if (lane == 0) fa[384] = a; }
    __syncthreads();
    const float amax = fa[384], blast = fa[385];
    if (tid < 128) fa[tid] = __expf(fa[256 + tid] - amax);
    if (tid == 0) { SC[item] = blast + amax; SC[512 + item] = blast; }
    __syncthreads();
    for (int task = tid; task < 4096; task += NTHR) {
        const int isk = task >> 11, t2 = task & 2047, d = t2 & 127, s0 = (t2 >> 7) * 8, ch = isk * 512 + h * 128 + d;
        const float w0 = conv_w[ch], w1 = conv_w[1024 + ch], w2 = conv_w[2048 + ch], w3 = conv_w[3072 + ch], bias = conv_b[ch];
        float x[11];
#pragma unroll
        for (int i = 0; i < 11; ++i) { const int r = row0 + s0 - 3 + i; x[i] = r >= 0 ? bf2f(PROJ[(size_t)r * PLD + C_MQ + ch]) : 0.f; }
        float y[8];
#pragma unroll
        for (int i = 0; i < 8; ++i) y[i] = silu(bias + w0 * x[i] + w1 * x[i + 1] + w2 * x[i + 2] + w3 * x[i + 3]);
        if (!isk) {
#pragma unroll
            for (int i = 0; i < 8; ++i) QC[(size_t)(row0 + s0 + i) * 512 + h * 128 + d] = (bfu)f2bf(y[i] * 0.08838834764831845f);
        } else {
#pragma unroll
            for (int i = 0; i < 8; ++i) { KC[(size_t)(row0 + s0 + i) * 512 + h * 128 + d] = (bfu)f2bf(y[i]); y[i] *= fa[s0 + i]; }
            v4u o; o.x = pk2(y[0], y[1]); o.y = pk2(y[2], y[3]); o.z = pk2(y[4], y[5]); o.w = pk2(y[6], y[7]);
            *(LAS v4u*)(KT + d * MP + s0 * 2) = o;
        }
    }
    for (int task = tid; task < 4096; task += NTHR) {
        const int sidx = task & 127, e0 = (task >> 7) * 8;
        const v4u v = *(const v4u*)(PROJ + (size_t)(row0 + sidx) * PLD + C_MV + h * 256 + e0);
        LAS unsigned short* d = (LAS unsigned short*)(VT + e0 * MP + sidx * 2);
        d[0 * (MP / 2)] = (unsigned short)(v.x & 0xffffu); d[1 * (MP / 2)] = (unsigned short)(v.x >> 16); d[2 * (MP / 2)] = (unsigned short)(v.y & 0xffffu); d[3 * (MP / 2)] = (unsigned short)(v.y >> 16);
        d[4 * (MP / 2)] = (unsigned short)(v.z & 0xffffu); d[5 * (MP / 2)] = (unsigned short)(v.z >> 16); d[6 * (MP / 2)] = (unsigned short)(v.w & 0xffffu); d[7 * (MP / 2)] = (unsigned short)(v.w >> 16);
    }
    __syncthreads();
    f32x4 acc[2][8];
#pragma unroll
    for (int mt = 0; mt < 2; ++mt)
#pragma unroll
        for (int nt = 0; nt < 8; ++nt) acc[mt][nt] = (f32x4){0.f, 0.f, 0.f, 0.f};
#pragma unroll
    for (int ks = 0; ks < 4; ++ks) {
        bf16x8 a[2];
#pragma unroll
        for (int mt = 0; mt < 2; ++mt) a[mt] = *(const LAS bf16x8*)(VT + (32 * wid + 16 * mt + fr) * MP + (32 * ks + 8 * fq) * 2);
#pragma unroll
        for (int nt = 0; nt < 8; ++nt) { const bf16x8 b = *(const LAS bf16x8*)(KT + (16 * nt + fr) * MP + (32 * ks + 8 * fq) * 2);
            acc[0][nt] = MFMA16(a[0], b, acc[0][nt]); acc[1][nt] = MFMA16(a[1], b, acc[1][nt]); }
    }
    float* dst = DELTA + (size_t)item * 32768;
#pragma unroll
    for (int mt = 0; mt < 2; ++mt)
#pragma unroll
        for (int nt = 0; nt < 8; ++nt)
#pragma unroll
            for (int j = 0; j < 4; ++j) dst[(32 * wid + 16 * mt + 4 * fq + j) * 128 + 16 * nt + fr] = acc[mt][nt][j];
    if (tid < 128) { float s = 0.f; for (int i = 0; i < 128; ++i) s += bf2f(*(const LAS unsigned short*)(KT + tid * MP + i * 2)); DN[(size_t)item * 128 + tid] = s; }
    __syncthreads();
}

__device__ __forceinline__ void mlstm_scan(LAS unsigned char* lds, const float* __restrict__ DELTA, const float* __restrict__ DN, const float* __restrict__ SC, float* MPREV, bfu* __restrict__ CT, float* __restrict__ NST,
                                           int tid, int gtid, int nthreads) {
    LAS float* fdec = (LAS float*)lds; LAS float* fin = fdec + 512; LAS float* mpv = fdec + 1024;
    if (tid < 4) { float m = 0.f;
        for (int c = 0; c < 128; ++c) { const int item = c * 4 + tid; const float mloc = SC[item], bl = SC[512 + item], mn = fmaxf(bl + m, mloc);
            mpv[tid * 128 + c] = m; fdec[tid * 128 + c] = __expf(bl + m - mn); fin[tid * 128 + c] = __expf(mloc - mn); m = mn; } }
    __syncthreads();
    for (int idx = gtid; idx < 4 * 32768 + 512; idx += nthreads) {
        const bool main_ = idx < 4 * 32768;
        const int h = main_ ? (idx >> 15) : ((idx - 4 * 32768) >> 7), rem = main_ ? (idx & 32767) : ((idx - 4 * 32768) & 127);
        const float* src = main_ ? DELTA + (size_t)h * 32768 + rem : DN + h * 128 + rem; const size_t sstride = main_ ? 4 * 32768 : 512;
        float C = 0.f; float d8[8], e8[8];
#pragma unroll
        for (int i = 0; i < 8; ++i) d8[i] = src[(size_t)i * sstride];
        for (int c0 = 0; c0 < 128; c0 += 8) {
            if (c0 + 8 < 128) {
#pragma unroll
                for (int i = 0; i < 8; ++i) e8[i] = src[(size_t)(c0 + 8 + i) * sstride];
            }
#pragma unroll
            for (int i = 0; i < 8; ++i) { const int c = c0 + i, item = c * 4 + h;
                if (main_) { CT[(size_t)item * 32768 + rem] = (bfu)f2bf(C); if (rem == 0) MPREV[item] = mpv[h * 128 + c]; } else NST[(size_t)item * 128 + rem] = C;
                C = fdec[h * 128 + c] * C + fin[h * 128 + c] * d8[i]; }
#pragma unroll
            for (int i = 0; i < 8; ++i) d8[i] = e8[i];
        }
    }
    __syncthreads();
}

__device__ __forceinline__ void mlstm_stage_c(LAS unsigned char* lds, const bfu* __restrict__ PROJ, const float* __restrict__ GATES, const bfu* __restrict__ QC, const bfu* __restrict__ KC,
                                              const bfu* __restrict__ CT, const float* __restrict__ NST, const float* __restrict__ MPREV, const float* __restrict__ hgain, bfu* Y, int item, const int mk_wave) {
    int lane = mk_lane(); asm volatile("" : "+v"(lane));
    const int wid = mk_wave & 7, tid = wid * 64 + lane, fr = lane & 15, fq = lane >> 4;
    const int h = item & 3, row0 = (item >> 2) * 128;
    LAS float* fa = (LAS float*)lds;
    LAS unsigned char* Qs = lds + 4096; LAS unsigned char* Ks = Qs + 128 * MP; LAS unsigned char* BUF = Ks + 128 * MP;
    if (tid < 128) { fa[768 + tid] = GATES[(size_t)(row0 + tid) * 8 + 4 + h]; fa[896 + tid] = GATES[(size_t)(row0 + tid) * 8 + h]; fa[640 + tid] = NST[(size_t)item * 128 + tid]; }
    __syncthreads();
    float bt_ = 0.f;
    if (tid < 128) { for (int s = 0; s <= tid; ++s) bt_ += fa[768 + s]; fa[tid] = fa[896 + tid] - bt_; }
    __syncthreads();
    if (tid < 128) { const float mp = MPREV[item]; float pm = -3.0e38f; for (int s = 0; s <= tid; ++s) pm = fmaxf(pm, fa[s]);
        const float M = fmaxf(mp, pm); fa[128 + tid] = M; fa[256 + tid] = __expf(mp - M); fa[384 + tid] = __expf(-(bt_ + M)); }
    for (int t = tid; t < 2048; t += NTHR) { const int r = t >> 4, c = t & 15;
        *(LAS v4u*)(Qs + r * MP + c * 16) = *(const v4u*)(QC + (size_t)(row0 + r) * 512 + h * 128 + c * 8);
        *(LAS v4u*)(Ks + r * MP + c * 16) = *(const v4u*)(KC + (size_t)(row0 + r) * 512 + h * 128 + c * 8); }
    for (int t = tid; t < 4096; t += NTHR) { const int r = t >> 4, c = t & 15; *(LAS v4u*)(BUF + r * MP + c * 16) = *(const v4u*)(CT + (size_t)item * 32768 + r * 128 + c * 8); }
    __syncthreads();
    {
        const int t = 16 * wid + fr; float s = 0.f;
#pragma unroll
        for (int i = 0; i < 32; ++i) s += bf2f(*(const LAS unsigned short*)(Qs + t * MP + (32 * fq + i) * 2)) * fa[640 + 32 * fq + i];
        s += __shfl_xor(s, 16); s += __shfl_xor(s, 32); if (fq == 0) fa[512 + t] = s;
    }
    f32x4 sa[8];
#pragma unroll
    for (int nt = 0; nt < 8; ++nt) sa[nt] = (f32x4){0.f, 0.f, 0.f, 0.f};
    bf16x8 qa[4];
#pragma unroll
    for (int ks = 0; ks < 4; ++ks) qa[ks] = *(const LAS bf16x8*)(Qs + (16 * wid + fr) * MP + (32 * ks + 8 * fq) * 2);
#pragma unroll
    for (int nt = 0; nt < 8; ++nt) if (nt <= wid) {
#pragma unroll
        for (int ks = 0; ks < 4; ++ks) { const bf16x8 b = *(const LAS bf16x8*)(Ks + (16 * nt + fr) * MP + (32 * ks + 8 * fq) * 2); sa[nt] = MFMA16(qa[ks], b, sa[nt]); } }
    float Mt[4], rsum[4];
#pragma unroll
    for (int j = 0; j < 4; ++j) { Mt[j] = fa[128 + 16 * wid + 4 * fq + j]; rsum[j] = 0.f; }
#pragma unroll
    for (int nt = 0; nt < 8; ++nt) { const int s = 16 * nt + fr; const float as = fa[s];
#pragma unroll
        for (int j = 0; j < 4; ++j) { const int t = 16 * wid + 4 * fq + j; const float p = (s <= t) ? sa[nt][j] * __expf(as - Mt[j]) : 0.f; sa[nt][j] = p; rsum[j] += p; } }
#pragma unroll
    for (int j = 0; j < 4; ++j) { float v = rsum[j]; v += __shfl_xor(v, 1); v += __shfl_xor(v, 2); v += __shfl_xor(v, 4); v += __shfl_xor(v, 8); rsum[j] = v; }
    f32x4 num[16];
#pragma unroll
    for (int nt = 0; nt < 16; ++nt) num[nt] = (f32x4){0.f, 0.f, 0.f, 0.f};
#pragma unroll
    for (int ks = 0; ks < 4; ++ks)
#pragma unroll
        for (int nt = 0; nt < 16; ++nt) { const bf16x8 b = *(const LAS bf16x8*)(BUF + (16 * nt + fr) * MP + (32 * ks + 8 * fq) * 2); num[nt] = MFMA16(qa[ks], b, num[nt]); if ((nt & 3) == 3) __builtin_amdgcn_sched_barrier(0); }
    float g4[4], den[4];
#pragma unroll
    for (int j = 0; j < 4; ++j) { const int t = 16 * wid + 4 * fq + j; g4[j] = fa[256 + t]; den[j] = fmaxf(fabsf(g4[j] * fa[512 + t] + rsum[j]), fa[384 + t]); }
#pragma unroll
    for (int nt = 0; nt < 16; ++nt)
#pragma unroll
        for (int j = 0; j < 4; ++j) num[nt][j] *= g4[j];
    __syncthreads();
#pragma unroll
    for (int nt = 0; nt < 8; ++nt)
#pragma unroll
        for (int j = 0; j < 4; ++j) *(LAS unsigned short*)(Ks + (16 * wid + 4 * fq + j) * MP + (16 * nt + fr) * 2) = (unsigned short)f2bf(sa[nt][j]);
    for (int task = tid; task < 4096; task += NTHR) {
        const int sidx = task & 127, e0 = (task >> 7) * 8;
        const v4u v = *(const v4u*)(PROJ + (size_t)(row0 + sidx) * PLD + C_MV + h * 256 + e0);
        LAS unsigned short* d = (LAS unsigned short*)(BUF + e0 * MP + sidx * 2);
        d[0 * (MP / 2)] = (unsigned short)(v.x & 0xffffu); d[1 * (MP / 2)] = (unsigned short)(v.x >> 16); d[2 * (MP / 2)] = (unsigned short)(v.y & 0xffffu); d[3 * (MP / 2)] = (unsigned short)(v.y >> 16);
        d[4 * (MP / 2)] = (unsigned short)(v.z & 0xffffu); d[5 * (MP / 2)] = (unsigned short)(v.z >> 16); d[6 * (MP / 2)] = (unsigned short)(v.w & 0xffffu); d[7 * (MP / 2)] = (unsigned short)(v.w >> 16);
    }
    __syncthreads();
#pragma unroll
    for (int ks = 0; ks < 4; ++ks) { const bf16x8 pa = *(const LAS bf16x8*)(Ks + (16 * wid + fr) * MP + (32 * ks + 8 * fq) * 2);
#pragma unroll
        for (int nt = 0; nt < 16; ++nt) { const bf16x8 b = *(const LAS bf16x8*)(BUF + (16 * nt + fr) * MP + (32 * ks + 8 * fq) * 2); num[nt] = MFMA16(pa, b, num[nt]); if ((nt & 3) == 3) __builtin_amdgcn_sched_barrier(0); } }
    float ssq[4];
#pragma unroll
    for (int j = 0; j < 4; ++j) { const float rd = 1.0f / den[j]; float s = 0.f;
#pragma unroll
        for (int nt = 0; nt < 16; ++nt) { const float v = num[nt][j] * rd; num[nt][j] = v; s += v * v; }
        s += __shfl_xor(s, 1); s += __shfl_xor(s, 2); s += __shfl_xor(s, 4); s += __shfl_xor(s, 8); ssq[j] = 1.0f / sqrtf(s * (1.0f / 256.0f) + 1e-6f); }
    __syncthreads();
    LAS float* HS = (LAS float*)(lds + 4096);
#pragma unroll
    for (int nt = 0; nt < 16; ++nt)
#pragma unroll
        for (int j = 0; j < 4; ++j) HS[(16 * wid + 4 * fq + j) * 260 + 16 * nt + fr] = num[nt][j] * ssq[j];
    __syncthreads();
    for (int task = tid; task < 4096; task += NTHR) {
        const int r = task >> 5, c8 = (task & 31) * 8; const size_t row = (size_t)(row0 + r);
        const f32x4 h0 = *(const LAS f32x4*)(HS + r * 260 + c8), h1 = *(const LAS f32x4*)(HS + r * 260 + c8 + 4);
        const f32x4 g0 = *(const f32x4*)(hgain + h * 256 + c8), g1 = *(const f32x4*)(hgain + h * 256 + c8 + 4);
        const v4u mo = *(const v4u*)(PROJ + row * PLD + C_MO + h * 256 + c8);
        v4u o;
        o.x = pk2(h0[0] * g0[0] / (1.0f + __expf(-bf2f(mo.x & 0xffffu))), h0[1] * g0[1] / (1.0f + __expf(-bf2f(mo.x >> 16))));
        o.y = pk2(h0[2] * g0[2] / (1.0f + __expf(-bf2f(mo.y & 0xffffu))), h0[3] * g0[3] / (1.0f + __expf(-bf2f(mo.y >> 16))));
        o.z = pk2(h1[0] * g1[0] / (1.0f + __expf(-bf2f(mo.z & 0xffffu))), h1[1] * g1[1] / (1.0f + __expf(-bf2f(mo.z >> 16))));
        o.w = pk2(h1[2] * g1[2] / (1.0f + __expf(-bf2f(mo.w & 0xffffu))), h1[3] * g1[3] / (1.0f + __expf(-bf2f(mo.w >> 16))));
        *(v4u*)(Y + row * DM + 1024 + h * 256 + c8) = o;
    }
    __syncthreads();
}

__device__ __forceinline__ att::BlockRef<att::bf16, att::bf16> att_ref(int i, int pass, const bfu* PROJ, bfu* OATT) {
    int ph, x;
    if (gridDim.x == 256) { ph = ((i >> 8) & 1) * 8 + (blockIdx.x & 7); x = blockIdx.x >> 3; }
    else { ph = (i >> 5) & 15; x = i & 31; }
    const int qb = pass ? 63 - x : x, h = ph >> 2, c = (ph >> 1) & 1, vh = ph & 1;
    att::BlockRef<att::bf16, att::bf16> r;
    constexpr size_t MSZ = (size_t)16384 * 128;
    r.Q = (const att::bf16*)(PROJ + (size_t)(2 * h + c) * MSZ + (size_t)qb * 256 * 128);
    r.K = (const att::bf16*)(PROJ + (size_t)(8 + 2 * h + c) * MSZ);
    r.V = (const att::bf16*)(PROJ + (size_t)(16 + 2 * h + vh) * MSZ);
    r.O = (att::bf16*)(OATT + (size_t)qb * 256 * 2048 + h * 512 + c * 256 + vh * 128);
    r.P0 = qb * 256;
    return r;
}
__device__ __forceinline__ void attn_phase(char* lds, const bfu* PROJ, bfu* OATT, const int TOTAL, const int mk_wave) {
    using namespace att;
    int i = blockIdx.x; if (i >= TOTAL) return;
    int pass = 0;
    BlockRef<bf16, bf16> cur = att_ref(i, 0, PROJ, OATT);
    Seam<bf16> S;
    causal_swa_prime<bf16, bf16>(cur, S_, lds, S, mk_wave);
    for (;;) {
        const bool more_pass = pass == 0, more_item = i + (int)gridDim.x < TOTAL, last = !more_pass && !more_item;
        int in_ = i, passn = pass + 1;
        if (!more_pass) { passn = 0; in_ = more_item ? i + (int)gridDim.x : i; }
        const BlockRef<bf16, bf16> nxt = last ? cur : att_ref(in_, passn, PROJ, OATT);
        causal_swa_block<bf16, bf16>(cur, nxt, S_, S_, lds, S, mk_wave);
        if (last) break;
        cur = nxt; i = in_; pass = passn;
    }
}

#ifndef ATTN2
#define ATTN2 5
#endif
__device__ __forceinline__ att::A2Ref att2_ref(int i, int pass, const bfu* PROJ, bfu* OATT) {
    int hc, x;
    if (gridDim.x == 256) { hc = blockIdx.x & 7; x = ((i >> 8) & 1) * 32 + (blockIdx.x >> 3); }
    else { hc = (i >> 6) & 7; x = i & 63; }
    const int qb = pass ? 127 - x : x, h = hc >> 1, c = hc & 1;
    constexpr size_t MSZ = (size_t)16384 * 128;
    att::A2Ref r;
    r.Q = (const att::bf16*)(PROJ + (size_t)(2 * h + c) * MSZ + (size_t)qb * 128 * 128);
    r.K = (const att::bf16*)(PROJ + (size_t)(8 + 2 * h + c) * MSZ);
    r.V0 = (const att::bf16*)(PROJ + (size_t)(16 + 2 * h) * MSZ); r.V1 = (const att::bf16*)(PROJ + (size_t)(16 + 2 * h + 1) * MSZ);
    r.O = (att::bf16*)(OATT + (size_t)qb * 128 * 2048 + h * 512 + c * 256);
    r.P0 = qb * 128;
    return r;
}
__device__ __forceinline__ void attn2_phase(char* lds, const bfu* PROJ, bfu* OATT, const int TOTAL, const int mk_wave) {
    for (int i = blockIdx.x; i < TOTAL; i += gridDim.x)
        for (int pass = 0; pass < 2; ++pass) { const att::A2Ref r = att2_ref(i, pass, PROJ, OATT); att::attn6_block(r, lds, mk_wave); }
}

__global__ void __launch_bounds__(NTHR, 2) mega_fwd(Args args) {
    extern __shared__ __attribute__((aligned(16))) unsigned char lds_raw[];
    LAS unsigned char* lds = (LAS unsigned char*)lds_raw;
    const int wave = __builtin_amdgcn_readfirstlane((int)threadIdx.x >> 6);
    const int G = gridDim.x, gw = blockIdx.x * NWAVES + wave, NGW = G * NWAVES;
#define AS4 __attribute__((address_space(4)))
#define PH_BEGIN int koff_ = 0; asm volatile("" : "+s"(koff_)); const AS4 char* kp_ = (const AS4 char*)__builtin_amdgcn_kernarg_segment_ptr() + koff_; \
    unsigned char* ws = *(unsigned char* const AS4*)(kp_ + 192); float* out = *(float* const AS4*)(kp_ + 184); (void)out; (void)ws; const int lane = mk_lane(), tid = wave * 64 + lane; (void)tid; (void)lane;
#define KIN(i) (*(const float* const AS4*)(kp_ + 8 * (i)))
#define Wgu ((bfu*)(ws + WS_WGU))
#define Wd ((bfu*)(ws + WS_WD))
#define Win ((bfu*)(ws + WS_WIN))
#define Wout ((bfu*)(ws + WS_WOUT))
#define XN ((bfu*)(ws + WS_XN))
#define BIG ((bfu*)(ws + WS_BIG))
#define Y ((bfu*)(ws + WS_Y))
#define CT ((bfu*)(ws + WS_CT))
#define QC ((bfu*)(ws + WS_QC))
#define KC ((bfu*)(ws + WS_KC))
#define NST ((float*)(ws + WS_NST))
#define rowss1 ((float*)(ws + WS_ROWSS1))
#define rowss2 ((float*)(ws + WS_ROWSS2))
#define SC ((float*)(ws + WS_SC))
#define DN ((float*)(ws + WS_DN))
#define GATES ((float*)(ws + WS_GATES))
#define DELTA ((float*)(ws + WS_XN))
#define OATT ((bfu*)(ws + WS_XN))
#define PROJM (BIG + (size_t)24 * 16384 * 128)
    const int lo = args.ph_lo, hi = args.ph_hi;
    if (hi - lo > 1) {
        if (wave == 0 && mk_lane() == 0) { volatile LAS unsigned* st = (volatile LAS unsigned*)(lds + LDS_BYTES - 64); st[0] = 0u; st[1] = 0u;
            (void)xb_add(&((unsigned*)(args.ws + WS_BAR))[XB_XCNT(xb_xcc_id())], 1u); }
        __syncthreads();
    }
#ifndef PHMASK
#define PHMASK 0xfff
#endif
#define IN(k) (((PHMASK >> (k)) & 1) && lo <= (k) && (k) < hi)
#ifndef PROBE_MASK
#define PROBE_MASK 0
#endif
#define NREP(k) (((PROBE_MASK >> (k)) & 1) ? 2 : 1)
#define STAGGER_DELAY(N) do { const int sn_ = (int)((blockIdx.x >> 3) & 3) * (N); for (int sd_ = 0; sd_ < sn_; ++sd_) __builtin_amdgcn_s_sleep(85); } while (0)
#define SYNC(k) do { if (IN(k) && IN((k) + 1)) { if (lo < 0) cg::this_grid().sync();     \
        { int kb_ = 0; asm volatile("" : "+s"(kb_)); unsigned char* wsb_ = *(unsigned char* const AS4*)((const AS4 char*)__builtin_amdgcn_kernarg_segment_ptr() + kb_ + 192); \
               xcd_barrier((unsigned*)(wsb_ + WS_BAR), (volatile LAS unsigned*)(lds + LDS_BYTES - 64), wave == 0 && mk_lane() == 0); \
               if ((PROBE_MASK >> 14) & 1) xcd_barrier((unsigned*)(wsb_ + WS_BAR), (volatile LAS unsigned*)(lds + LDS_BYTES - 64), wave == 0 && mk_lane() == 0); } } } while (0)

    if (IN(0)) for (int rep_ = 0; rep_ < NREP(0); ++rep_) { PH_BEGIN
        const float* x = KIN(0);
        LAS float* scr = (LAS float*)(lds + wave * 16640);
        constexpr int I_FFN = 3 * 2816, I_IN = 32 * 96, I_OUT = 32 * 32;
        for (int it = gw; it < I_FFN + I_IN + I_OUT; it += NGW) {
            if (it < I_FFN) cvt_ffn_item(it, KIN(2), KIN(3), KIN(4), KIN(1), Wgu, Wd, scr, lane);
            else if (it < I_FFN + I_IN) { const int r = it - I_FFN, kb = r / 96, nb = r % 96; cvt_item(KIN(6), NIN, NIN, KIN(5), Win, DM, nb * 64, kb * 64, nb * 64, scr, lane); }
            else { const int r = it - I_FFN - I_IN, kb = r / 32, nb = r % 32; cvt_item(KIN(17), DM, DM, nullptr, Wout, DM, nb * 64, kb * 64, nb * 64, scr, lane); }
        }
        for (int m = gw; m < S_; m += NGW) {
            const f32x4* xr = (const f32x4*)(x + (size_t)m * DM) + lane; f32x4 v[8]; float s = 0.f;
#pragma unroll
            for (int j = 0; j < 8; ++j) { v[j] = xr[64 * j]; s += (v[j][0] * v[j][0] + v[j][1] * v[j][1]) + (v[j][2] * v[j][2] + v[j][3] * v[j][3]); }
            const float rs = 1.0f / sqrtf(wave_sum(s) * (1.0f / DM) + 1e-6f);
            v2u* o8 = (v2u*)(XN + (size_t)m * DM) + lane;
#pragma unroll
            for (int j = 0; j < 8; ++j) { v2u w; w.x = pk2(v[j][0] * rs, v[j][1] * rs); w.y = pk2(v[j][2] * rs, v[j][3] * rs); o8[64 * j] = w; }
        }
        for (int i = blockIdx.x * NTHR + tid; i < 2 * S_; i += G * NTHR) rowss1[i] = 0.f;
        for (int k = blockIdx.x * NTHR + tid; k < DM + 8; k += G * NTHR) {
            unsigned char* gwp = ws + WS_GW; f32x4 w0 = (f32x4){0.f, 0.f, 0.f, 0.f}, w1 = w0;
            if (k < DM) { const float gk = KIN(5)[k]; w0 = *(const f32x4*)(KIN(6) + (size_t)k * NIN + 6144) * gk; w1 = *(const f32x4*)(KIN(6) + (size_t)k * NIN + 6148) * gk; }
#pragma unroll
            for (int j = 0; j < 4; ++j) { *(unsigned short*)(gwp + j * GWP + k * 2) = (unsigned short)f2bf(w0[j]); *(unsigned short*)(gwp + (4 + j) * GWP + k * 2) = (unsigned short)f2bf(w1[j]);
                *(unsigned short*)(gwp + (8 + j) * GWP + k * 2) = 0; *(unsigned short*)(gwp + (12 + j) * GWP + k * 2) = 0; }
        }
    }
    SYNC(0);
    if (IN(1)) { PH_BEGIN
        pg8::Gemm g{XN, Wgu, S_, 2 * FF, DM}; pg8::StaticOrder So; So.init(S_, 2 * FF, G, (int)blockIdx.x);
        pg8::EpiSwiGLU E{BIG, FF, nullptr, 0.f};
        STAGGER_DELAY(1); for (int rep_ = 0; rep_ < NREP(1); ++rep_) pg8::gemm_phase<pg8::EpiSwiGLU, pg8::StaticOrder, true, true>(lds, g, So, E, wave);
    }
    SYNC(1);
    if (IN(2)) { PH_BEGIN
        pg8::Gemm g{BIG, Wd, S_, DM, FF}; pg8::StaticOrder So; So.init(S_, DM, G, (int)blockIdx.x);
        pg8::EpiResid E{KIN(0), out, XN, rowss1, 0.5f, DM};
        STAGGER_DELAY(3); pg8::gemm_phase<pg8::EpiResid, pg8::StaticOrder, true, true>(lds, g, So, E, wave);
    }
    SYNC(2);
    if (IN(3)) { PH_BEGIN
        pg8::Gemm g{XN, Win, S_, NINP, DM}; pg8::StaticOrder So; So.init(S_, NINP, G, (int)blockIdx.x);
        pg8::EpiProj E{BIG, rowss1, 1.0f / DM};
        STAGGER_DELAY(1); for (int rep_ = 0; rep_ < NREP(3); ++rep_) pg8::gemm_phase<pg8::EpiProj, pg8::StaticOrder, true, true>(lds, g, So, E, wave);
        {
            const v4u* src = (const v4u*)(ws + WS_GW);
            for (int i = tid; i < 16 * GWP / 16; i += NTHR) *(LAS v4u*)(lds + 16384 + i * 16) = src[i];
            __syncthreads();
        }
        for (int rep_ = 0; rep_ < NREP(13); ++rep_) for (int rb = blockIdx.x; rb < S_ / 64; rb += G) gates_rows(lds, XN, rowss1, KIN(14), KIN(15), GATES, rb, wave, lane);
    }
    SYNC(3);
    if (IN(4)) { PH_BEGIN for (int item = blockIdx.x; item < 512 * NREP(4); item += G) mlstm_stage_a(lds, PROJM, GATES, KIN(12), KIN(13), QC, KC, DELTA, DN, SC, item & 511, wave); }
    SYNC(4);
    if (IN(5)) { PH_BEGIN for (int rep_ = 0; rep_ < NREP(5); ++rep_) mlstm_scan(lds, DELTA, DN, SC, SC + 1024, CT, NST, tid, blockIdx.x * NTHR + tid, G * NTHR); }
    SYNC(5);
    if (IN(6)) { PH_BEGIN
#ifndef NO_ATTN
#if ATTN2
        attn2_phase((char*)lds_raw, BIG, OATT, 512 * NREP(6), wave);
#else
        attn_phase((char*)lds_raw, BIG, OATT, 512 * NREP(6), wave);
#endif
#endif
        __syncthreads();
#ifndef NO_STAGEC
        for (int rep_ = 0; rep_ < NREP(12); ++rep_) for (int item = blockIdx.x; item < 512; item += G) mlstm_stage_c(lds, PROJM, GATES, QC, KC, CT, NST, SC + 1024, KIN(16), Y, item, wave);
#endif
    }
    SYNC(6);
    if (IN(7)) for (int rep_ = 0; rep_ < NREP(7); ++rep_) { PH_BEGIN
        const float l1 = wave_sum(KIN(7)[lane] * KIN(8)[lane] + KIN(7)[lane + 64] * KIN(8)[lane + 64]);
        const float l2 = wave_sum(KIN(9)[lane] * KIN(10)[lane] + KIN(9)[lane + 64] * KIN(10)[lane + 64]);
        const float lam = expf(l1) - expf(l2) + 0.2f;
        const float* hg = KIN(11);
        for (int m = gw; m < S_; m += NGW) {
#pragma unroll
            for (int h = 0; h < 4; ++h) {
                const v2u a = *((const v2u*)(OATT + (size_t)m * 2048 + h * 512) + lane), b = *((const v2u*)(OATT + (size_t)m * 2048 + h * 512 + 256) + lane);
                float y0 = bf2f(a.x & 0xffffu) - lam * bf2f(b.x & 0xffffu), y1 = bf2f(a.x >> 16) - lam * bf2f(b.x >> 16), y2 = bf2f(a.y & 0xffffu) - lam * bf2f(b.y & 0xffffu), y3 = bf2f(a.y >> 16) - lam * bf2f(b.y >> 16);
                const float rs = 0.8f / sqrtf(wave_sum((y0 * y0 + y1 * y1) + (y2 * y2 + y3 * y3)) * (1.0f / 256.0f) + 1e-6f);
                const f32x4 gn = *((const f32x4*)(hg + h * 256) + lane);
                v2u w; w.x = pk2(y0 * rs * gn[0], y1 * rs * gn[1]); w.y = pk2(y2 * rs * gn[2], y3 * rs * gn[3]);
                *((v2u*)(Y + (size_t)m * DM + h * 256) + lane) = w;
            }
        }
        LAS float* scr = (LAS float*)(lds + wave * 16640);
        for (int it = gw; it < 3 * 2816; it += NGW) cvt_ffn_item(it, KIN(19), KIN(20), KIN(21), KIN(18), Wgu, Wd, scr, lane);
    }
    SYNC(7);
    if (IN(8)) { PH_BEGIN
        pg8::Gemm g{Y, Wout, S_, DM, DM}; pg8::StaticOrder So; So.init(S_, DM, G, (int)blockIdx.x);
        pg8::EpiResid E{out, out, XN, rowss2, 1.0f, DM};
        STAGGER_DELAY(3); pg8::gemm_phase<pg8::EpiResid, pg8::StaticOrder, true, true>(lds, g, So, E, wave);
    }
    SYNC(8);
    if (IN(9)) { PH_BEGIN
        pg8::Gemm g{XN, Wgu, S_, 2 * FF, DM}; pg8::StaticOrder So; So.init(S_, 2 * FF, G, (int)blockIdx.x);
        pg8::EpiSwiGLU E{BIG, FF, rowss2, 1.0f / DM};
        STAGGER_DELAY(1); pg8::gemm_phase<pg8::EpiSwiGLU, pg8::StaticOrder, true, true>(lds, g, So, E, wave);
    }
    SYNC(9);
    if (IN(10)) { PH_BEGIN
        pg8::Gemm g{BIG, Wd, S_, DM, FF}; pg8::StaticOrder So; So.init(S_, DM, G, (int)blockIdx.x);
        pg8::EpiResid E{out, out, nullptr, nullptr, 0.5f, DM};
        STAGGER_DELAY(3); pg8::gemm_phase<pg8::EpiResid, pg8::StaticOrder, true, true>(lds, g, So, E, wave);
    }
    SYNC(10);
    if (IN(11)) { PH_BEGIN
        const float* fg = KIN(22);
        for (int m = gw; m < S_; m += NGW) {
            f32x4* xr = (f32x4*)(out + (size_t)m * DM) + lane; f32x4 v[8]; float s = 0.f;
#pragma unroll
            for (int j = 0; j < 8; ++j) { v[j] = xr[64 * j]; s += (v[j][0] * v[j][0] + v[j][1] * v[j][1]) + (v[j][2] * v[j][2] + v[j][3] * v[j][3]); }
            const float rs = 1.0f / sqrtf(wave_sum(s) * (1.0f / DM) + 1e-6f);
#pragma unroll
            for (int j = 0; j < 8; ++j) { const f32x4 gn = *((const f32x4*)fg + 64 * j + lane); xr[64 * j] = v[j] * rs * gn; }
        }
    }
#undef IN
#undef SYNC
}

extern "C" void kernel_launch(void* const* d_in, const int* in_sizes, int n_in, void* d_out, int out_size, void* d_ws, size_t ws_size, hipStream_t stream) {
    static int grid = 0;
    if (grid == 0) {
        if (n_in != 23 || in_sizes[0] != S_ * DM || out_size != S_ * DM || ws_size < WS_END) { fprintf(stderr, "kernel_launch: unexpected shapes (n_in %d, in0 %d, out %d, ws %zu)\n", n_in, n_in > 0 ? in_sizes[0] : -1, out_size, ws_size); grid = -1; return; }
        int dev = 0, cus = 0, per_cu = 0;
        (void)hipGetDevice(&dev); (void)hipDeviceGetAttribute(&cus, hipDeviceAttributeMultiprocessorCount, dev);
        if (hipFuncSetAttribute((const void*)mega_fwd, hipFuncAttributeMaxDynamicSharedMemorySize, LDS_BYTES) != hipSuccess) { fprintf(stderr, "kernel_launch: hipFuncSetAttribute failed\n"); grid = -1; return; }
        if (hipOccupancyMaxActiveBlocksPerMultiprocessor(&per_cu, (const void*)mega_fwd, NTHR, LDS_BYTES) != hipSuccess || per_cu < 1) per_cu = 1;
        grid = cus * per_cu;
        fprintf(stderr, "kernel_launch: grid %d (%d CUs x %d)\n", grid, cus, per_cu);
    }
    if (grid < 0) return;
    Args a{};
    for (int i = 0; i < 23; ++i) a.in[i] = (const float*)d_in[i];
    a.out = (float*)d_out; a.ws = (unsigned char*)d_ws;
#if MK_SPLIT
    for (int p = 0; p < NPH; ++p) { a.ph_lo = p; a.ph_hi = p + 1; hipLaunchKernelGGL(mega_fwd, dim3(grid), dim3(NTHR), LDS_BYTES, stream, a); }
#else
    a.ph_lo = 0; a.ph_hi = NPH;
    (void)hipMemsetAsync((char*)d_ws + WS_BAR, 0, XCD_BAR_WORDS * 4, stream);
    void* kargs[] = {&a};
    hipError_t e = hipLaunchCooperativeKernel((const void*)mega_fwd, dim3(grid), dim3(NTHR), kargs, LDS_BYTES, stream);
    if (e != hipSuccess) fprintf(stderr, "kernel_launch: cooperative launch failed: %s (grid %d)\n", hipGetErrorString(e), grid);
#endif
}
```

```cpp
#include <hip/hip_runtime.h>
#include <hip/hip_bf16.h>
#include <hip/hip_cooperative_groups.h>
#include <cstdio>
#include <cstdint>
namespace cg = cooperative_groups;

#ifndef MK_SPLIT
#define MK_SPLIT 0
#endif

namespace pg8 {
#define PG8_LAS __attribute__((address_space(3)))
typedef unsigned short bf16_t;
typedef short bf16x8 __attribute__((ext_vector_type(8)));
typedef float f32x4 __attribute__((ext_vector_type(4)));
typedef unsigned u32x4 __attribute__((ext_vector_type(4)));
constexpr int BM = 256, BK = 64, HALF = 128, HTB = HALF * BK * 2  , STAGE_BYTES = 8 * HTB, NXCD = 8, WGM = 8;

__host__ __device__ __forceinline__ int lds_byte(int r, int c) { const int st = (r >> 4) * 2 + (c >> 5), rr = r & 15, cc = c & 31, ob = rr * 64 + cc * 2; return st * 1024 + (ob ^ (((ob >> 9) & 1) << 5)); }
__host__ __device__ __forceinline__ void stage_rc(int b, int& R, int& C) { const int st = b / 1024, sb = b % 1024, swz = sb ^ (((sb >> 9) & 1) << 5); R = (st >> 1) * 16 + swz / 64; C = (st & 1) * 32 + (swz % 64) / 2; }
__host__ __device__ __forceinline__ int perm32(int rho) { const int n = rho >> 4, i = rho & 15; return 8 * (i >> 2) + 4 * n + (i & 3); }

struct Unit { int pm, pn; };
struct Gemm { const bf16_t* A; const bf16_t* Bt; int M, N, K; };

struct StaticOrder {
    int nM, nN, nwg, G, c;
    __host__ __device__ void init(int M, int N, int G_, int c_) { nM = M / BM; nN = N / BM; nwg = nM * nN; G = G_; c = c_; }
    __host__ __device__ bool next(int i, Unit& u) const {
        const long L = (long)i * G + c; if (L >= nwg) return false;
        int wgid = (int)L; { const int q = nwg / NXCD, r = nwg % NXCD, xcd = wgid % NXCD, off = wgid / NXCD; wgid = (xcd < r ? xcd * (q + 1) : r * (q + 1) + (xcd - r) * q) + off; }
        const int nig = WGM * nN, gid = wgid / nig, fm = gid * WGM, gsz = (nM - fm) < WGM ? (nM - fm) : WGM;
        u.pm = fm + ((wgid % nig) % gsz); u.pn = (wgid % nig) / gsz; return true;
    }
    __device__ __forceinline__ void a_ready(const Unit&) const {}
    __device__ __forceinline__ void done(const Unit&) const {}
};

__device__ __forceinline__ unsigned cvt_pk_bf16(float lo, float hi) { unsigned r; asm volatile("v_cvt_pk_bf16_f32 %0, %1, %2" : "=v"(r) : "v"(lo), "v"(hi)); return r; }

constexpr float RMS_EPS = 1e-6f;
__device__ __forceinline__ float silu_f(float x) { return x * __builtin_amdgcn_rcpf(1.0f + __builtin_amdgcn_exp2f(-1.4426950408889634f * x)); }
struct EpiSwiGLU {
    static constexpr bool PERM = true, AFTER_DRAIN = false;
    bf16_t* O; int ldo; const float* rowss; float inv_n;
    __device__ __forceinline__ void operator()(const f32x4 (&acc)[2][2][4][2], const Unit& u, int wr, int wc, int fr, int fq) const {
        const int row0 = u.pm * BM + wr * 64 + fr, col0 = u.pn * HALF + wc * 32 + 8 * fq;
#pragma unroll
        for (int ai = 0; ai < 2; ++ai)
#pragma unroll
            for (int m = 0; m < 4; ++m) {
                const int r = row0 + ai * HALF + m * 16;
                const float rs = rowss ? __builtin_amdgcn_rsqf(rowss[r] * inv_n + RMS_EPS) : 1.0f;
                const f32x4 g0 = acc[ai][0][m][0] * rs, g1 = acc[ai][0][m][1] * rs, u0 = acc[ai][1][m][0] * rs, u1 = acc[ai][1][m][1] * rs;
                u32x4 w;
                w.x = cvt_pk_bf16(silu_f(g0[0]) * u0[0], silu_f(g0[1]) * u0[1]); w.y = cvt_pk_bf16(silu_f(g0[2]) * u0[2], silu_f(g0[3]) * u0[3]);
                w.z = cvt_pk_bf16(silu_f(g1[0]) * u1[0], silu_f(g1[1]) * u1[1]); w.w = cvt_pk_bf16(silu_f(g1[2]) * u1[2], silu_f(g1[3]) * u1[3]);
                *(u32x4*)(O + (size_t)r * ldo + col0) = w;
            }
    }
};
struct EpiResid {
    static constexpr bool PERM = false, AFTER_DRAIN = false;
    const float* resid; float* out; bf16_t* xb; float* rowss; float alpha; int ld;
    __device__ __forceinline__ void operator()(const f32x4 (&acc)[2][2][4][2], const Unit& u, int wr, int wc, int fr, int fq) const {
        typedef unsigned u32x2v __attribute__((ext_vector_type(2)));
        const int row0 = u.pm * BM + wr * 64 + fr, col0 = u.pn * BM + wc * 32 + 4 * fq;
#pragma unroll
        for (int ai = 0; ai < 2; ++ai)
#pragma unroll
            for (int m = 0; m < 4; ++m) {
                const int r = row0 + ai * HALF + m * 16; float ss = 0.f;
#pragma unroll
                for (int bj = 0; bj < 2; ++bj)
#pragma unroll
                    for (int n = 0; n < 2; ++n) {
                        const size_t off = (size_t)r * ld + col0 + bj * HALF + n * 16;
                        const f32x4 b = *(const f32x4*)(resid + off); const f32x4 o = b + acc[ai][bj][m][n] * alpha;
                        *(f32x4*)(out + off) = o; ss += (o[0] * o[0] + o[1] * o[1]) + (o[2] * o[2] + o[3] * o[3]);
                        if (xb) { u32x2v w; w.x = cvt_pk_bf16(o[0], o[1]); w.y = cvt_pk_bf16(o[2], o[3]); *(u32x2v*)(xb + off) = w; }
                    }
                if (rowss) { ss += __shfl_xor(ss, 16); ss += __shfl_xor(ss, 32); if (fq == 0) atomicAdd(rowss + r, ss); }
            }
    }
};
struct EpiProj {
    static constexpr bool PERM = true, AFTER_DRAIN = false;
    bf16_t* O; const float* rowss; float inv_n;
    __device__ __forceinline__ void operator()(const f32x4 (&acc)[2][2][4][2], const Unit& u, int wr, int wc, int fr, int fq) const {
        const int row0 = u.pm * BM + wr * 64 + fr;
        {
            const bool dense = u.pn < 12;
            const size_t rstride = dense ? 128 : 3072;
            bf16_t* base = dense ? O + (size_t)(2 * u.pn) * ((size_t)16384 * 128) + wc * 32 + 8 * fq : O + (size_t)24 * 16384 * 128 + (u.pn - 12) * BM + wc * 32 + 8 * fq;
            const size_t bjstep = dense ? (size_t)16384 * 128 : 128;
#pragma unroll
            for (int ai = 0; ai < 2; ++ai)
#pragma unroll
                for (int m = 0; m < 4; ++m) {
                    const int r = row0 + ai * HALF + m * 16; const float rs = __builtin_amdgcn_rsqf(rowss[r] * inv_n + RMS_EPS);
#pragma unroll
                    for (int bj = 0; bj < 2; ++bj) { const f32x4 v0 = acc[ai][bj][m][0] * rs, v1 = acc[ai][bj][m][1] * rs; u32x4 w;
                        w.x = cvt_pk_bf16(v0[0], v0[1]); w.y = cvt_pk_bf16(v0[2], v0[3]); w.z = cvt_pk_bf16(v1[0], v1[1]); w.w = cvt_pk_bf16(v1[2], v1[3]);
                        *(u32x4*)(base + (size_t)r * rstride + bj * bjstep) = w; }
                }
        }
    }
};
template <class Epi, class Sched, bool ALIGN_EPI = false, bool SP2 = false>
__device__ __forceinline__ void gemm_phase(PG8_LAS unsigned char* lds, const Gemm g, const Sched& S, const Epi& E, const int mk_wave) {
    const int lane = (int)(__builtin_amdgcn_mbcnt_hi(~0u, __builtin_amdgcn_mbcnt_lo(~0u, 0u)) & 63u), wid = mk_wave & 7, tid = wid * 64 + lane, wr = wid >> 2, wc = wid & 3, fr = lane & 15, fq = lane >> 4;
    const int K = g.K, nt = K / BK;
    unsigned voffA[2], voffB[2];
#pragma unroll
    for (int i = 0; i < 2; ++i) { int R, C; stage_rc(tid * 16 + i * 8192, R, C); const int Rb = Epi::PERM ? ((R & ~31) + perm32(R & 31)) : R;
        voffA[i] = (unsigned)(R * K + C) * 2u; voffB[i] = (unsigned)(Rb * K + C) * 2u; }
    const size_t kstep = (size_t)(BK * 2);
    const size_t hstep = (size_t)HALF * K * 2;
    const size_t tstep = 2 * hstep;
    const unsigned ldsw = (unsigned)wid * 1024u;
    const int aoff = lds_byte(wr * 64 + fr, fq * 8), boff = lds_byte(wc * 32 + fr, fq * 8);
#define PG8_SA(b, h) (((b) * 2 + (h)) * HTB)
#define PG8_SB(b, h) ((4 + (b) * 2 + (h)) * HTB)
#define PG8_STAGE(bufoff, gbase, voff) do { _Pragma("unroll") for (int _i = 0; _i < 2; ++_i) \
        __builtin_amdgcn_global_load_lds((const unsigned*)((const char*)(gbase) + (voff)[_i]), (PG8_LAS unsigned*)(lds + (bufoff) + ldsw + _i * 8192), 16, 0, 0); } while (0)
#define PG8_LDA(dst, b, h) do { _Pragma("unroll") for (int m = 0; m < 4; ++m) _Pragma("unroll") for (int k = 0; k < 2; ++k) dst[m][k] = *(const PG8_LAS bf16x8*)(lds + PG8_SA(b, h) + aoff + m * 2048 + k * 1024); } while (0)
#define PG8_LDB(dst, b, h) do { _Pragma("unroll") for (int n = 0; n < 2; ++n) _Pragma("unroll") for (int k = 0; k < 2; ++k) dst[n][k] = *(const PG8_LAS bf16x8*)(lds + PG8_SB(b, h) + boff + n * 2048 + k * 1024); } while (0)
#define PG8_MMA(ai, bj, At, Bt) do { __builtin_amdgcn_s_setprio(1); _Pragma("unroll") for (int m = 0; m < 4; ++m) _Pragma("unroll") for (int n = 0; n < 2; ++n) _Pragma("unroll") for (int k = 0; k < 2; ++k) \
        acc[ai][bj][m][n] = __builtin_amdgcn_mfma_f32_16x16x32_bf16(Bt[n][k], At[m][k], acc[ai][bj][m][n], 0, 0, 0); __builtin_amdgcn_s_setprio(0); } while (0)
#define PG8_WAIT_V(n) asm volatile("s_waitcnt vmcnt(" #n ")" ::: "memory")
#define PG8_WAIT_L(n) asm volatile("s_waitcnt lgkmcnt(" #n ")" ::: "memory")
#define PG8_BAR __builtin_amdgcn_s_barrier()
#define PG8_SCHED __builtin_amdgcn_sched_barrier(0)
    Unit cur, nxt; int ui = 0;
    if (!S.next(0, cur)) return;
    f32x4 acc[2][2][4][2];
#pragma unroll
    for (int a = 0; a < 2; ++a)
#pragma unroll
        for (int b = 0; b < 2; ++b)
#pragma unroll
            for (int m = 0; m < 4; ++m)
#pragma unroll
                for (int n = 0; n < 2; ++n) acc[a][b][m][n] = (f32x4){0.f, 0.f, 0.f, 0.f};
    bf16x8 At[4][2], B0[2][2], B1[2][2];
    const char* cA = (const char*)g.A + (size_t)cur.pm * tstep; const char* cB = (const char*)g.Bt + (size_t)cur.pn * tstep;
    S.a_ready(cur);
    if constexpr (SP2) {
        PG8_STAGE(PG8_SB(0, 0), cB, voffB); PG8_STAGE(PG8_SB(0, 1), cB + hstep, voffB); PG8_STAGE(PG8_SA(0, 0), cA, voffA); PG8_STAGE(PG8_SA(0, 1), cA + hstep, voffA);
        if (wr == 1) PG8_BAR;
        PG8_WAIT_V(2); PG8_BAR;
        PG8_STAGE(PG8_SB(1, 0), cB + kstep, voffB); PG8_STAGE(PG8_SA(1, 0), cA + kstep, voffA); PG8_STAGE(PG8_SB(1, 1), cB + hstep + kstep, voffB);
        PG8_WAIT_V(6); PG8_BAR;
    } else {
        PG8_STAGE(PG8_SB(0, 0), cB, voffB); PG8_STAGE(PG8_SA(0, 0), cA, voffA); PG8_STAGE(PG8_SB(0, 1), cB + hstep, voffB); PG8_STAGE(PG8_SA(0, 1), cA + hstep, voffA);
        if (wr == 1) PG8_BAR;
        PG8_WAIT_V(4); PG8_BAR;
        PG8_STAGE(PG8_SB(1, 0), cB + kstep, voffB); PG8_STAGE(PG8_SA(1, 0), cA + kstep, voffA); PG8_STAGE(PG8_SB(1, 1), cB + hstep + kstep, voffB);
        PG8_WAIT_V(6); PG8_BAR;
    }
    for (;;) {
        const bool has_next = S.next(ui + 1, nxt);
        const char* nA = has_next ? (const char*)g.A + (size_t)nxt.pm * tstep : cA; const char* nB = has_next ? (const char*)g.Bt + (size_t)nxt.pn * tstep : cB;
        for (int t = 0; t < nt; t += 2) {
            const bool last = (t == nt - 2);
            const char* a1 = cA + (size_t)(t + 1) * kstep;
            const char* a2 = last ? nA : cA + (size_t)(t + 2) * kstep; const char* b2 = last ? nB : cB + (size_t)(t + 2) * kstep;
            const char* a3 = a2 + kstep; const char* b3 = b2 + kstep;
            if (last && has_next) S.a_ready(nxt);
            if constexpr (SP2) {
            PG8_LDB(B0, 0, 0); PG8_LDB(B1, 0, 1); PG8_SCHED; PG8_LDA(At, 0, 0); PG8_STAGE(PG8_SA(1, 1), a1 + hstep, voffA);
            PG8_WAIT_V(8); PG8_WAIT_L(0); PG8_BAR; PG8_MMA(0, 0, At, B0); PG8_MMA(0, 1, At, B1); PG8_BAR; PG8_SCHED;
            PG8_LDA(At, 0, 1); PG8_STAGE(PG8_SB(0, 0), b2, voffB); PG8_STAGE(PG8_SB(0, 1), b2 + hstep, voffB); PG8_STAGE(PG8_SA(0, 0), a2, voffA);
            PG8_WAIT_V(8); PG8_WAIT_L(0); PG8_BAR; PG8_MMA(1, 0, At, B0); PG8_MMA(1, 1, At, B1); PG8_BAR; PG8_SCHED;
            PG8_LDB(B0, 1, 0); PG8_LDB(B1, 1, 1); PG8_SCHED; PG8_LDA(At, 1, 0); PG8_STAGE(PG8_SA(0, 1), a2 + hstep, voffA);
            PG8_WAIT_V(8); PG8_WAIT_L(0); PG8_BAR; PG8_MMA(0, 0, At, B0); PG8_MMA(0, 1, At, B1); PG8_BAR; PG8_SCHED;
            PG8_LDA(At, 1, 1); PG8_STAGE(PG8_SB(1, 0), b3, voffB); PG8_STAGE(PG8_SB(1, 1), b3 + hstep, voffB); PG8_STAGE(PG8_SA(1, 0), a3, voffA);
            PG8_WAIT_V(8); PG8_WAIT_L(0); PG8_BAR; PG8_MMA(1, 0, At, B0); PG8_MMA(1, 1, At, B1); PG8_BAR; PG8_SCHED;
            } else {
            PG8_LDB(B0, 0, 0); PG8_SCHED; PG8_LDA(At, 0, 0); PG8_STAGE(PG8_SA(1, 1), a1 + hstep, voffA);
            PG8_WAIT_L(8); PG8_BAR; PG8_WAIT_L(0); PG8_MMA(0, 0, At, B0); PG8_BAR; PG8_SCHED;
            PG8_LDB(B1, 0, 1); PG8_STAGE(PG8_SB(0, 0), b2, voffB);
            PG8_BAR; PG8_WAIT_L(0); PG8_MMA(0, 1, At, B1); PG8_BAR;
            PG8_LDA(At, 0, 1); PG8_STAGE(PG8_SA(0, 0), a2, voffA);
            PG8_BAR; PG8_WAIT_L(0); PG8_MMA(1, 0, At, B0); PG8_BAR; PG8_SCHED;
            PG8_STAGE(PG8_SB(0, 1), b2 + hstep, voffB);
            PG8_WAIT_V(6); PG8_BAR; PG8_MMA(1, 1, At, B1); PG8_BAR;
            PG8_LDB(B0, 1, 0); PG8_SCHED; PG8_LDA(At, 1, 0); PG8_STAGE(PG8_SA(0, 1), a2 + hstep, voffA);
            PG8_WAIT_L(8); PG8_BAR; PG8_WAIT_L(0); PG8_MMA(0, 0, At, B0); PG8_BAR; PG8_SCHED;
            PG8_LDB(B1, 1, 1); PG8_STAGE(PG8_SB(1, 0), b3, voffB);
            PG8_BAR; PG8_WAIT_L(0); PG8_MMA(0, 1, At, B1); PG8_BAR;
            PG8_LDA(At, 1, 1); PG8_STAGE(PG8_SA(1, 0), a3, voffA);
            PG8_BAR; PG8_WAIT_L(0); PG8_MMA(1, 0, At, B0); PG8_BAR; PG8_SCHED;
            PG8_STAGE(PG8_SB(1, 1), b3 + hstep, voffB);
            PG8_WAIT_V(6); PG8_BAR; PG8_MMA(1, 1, At, B1); PG8_BAR;
            }
        }
        if constexpr (ALIGN_EPI) { if (wr == 0) PG8_BAR; }
        if constexpr (!Epi::AFTER_DRAIN) { E(acc, cur, wr, wc, fr, fq); S.done(cur); }
        if (!has_next) break;
#pragma unroll
        for (int a = 0; a < 2; ++a)
#pragma unroll
            for (int b = 0; b < 2; ++b)
#pragma unroll
                for (int m = 0; m < 4; ++m)
#pragma unroll
                    for (int n = 0; n < 2; ++n) acc[a][b][m][n] = (f32x4){0.f, 0.f, 0.f, 0.f};
        cur = nxt; cA = nA; cB = nB; ++ui;
        if constexpr (ALIGN_EPI) { if (wr == 1) PG8_BAR; }
    }
    PG8_WAIT_V(0);
    if constexpr (!ALIGN_EPI) { if (wr == 0) PG8_BAR; }
    PG8_BAR;
    if constexpr (Epi::AFTER_DRAIN) { E.fused(acc, cur, wr, wc, fr, fq, lds, wid, lane); S.done(cur); }
#undef PG8_SA
#undef PG8_SB
#undef PG8_STAGE
#undef PG8_LDA
#undef PG8_LDB
#undef PG8_MMA
#undef PG8_WAIT_V
#undef PG8_WAIT_L
#undef PG8_BAR
#undef PG8_SCHED
}
}

namespace att {
constexpr int D = 128; constexpr float THR = 8.f; constexpr bool WSKIP = false; constexpr int LDP = 128, LDO = 2048;
constexpr float SCALE = 0.08838834764831845f;
constexpr int NW = 8, QBLK = 32, KVBLK = 64, QB = NW * QBLK;
constexpr int SHM_V = KVBLK * D * 2, SHM_K = KVBLK * D * 2;
constexpr int LDS_BYTES = 2 * SHM_V + 2 * SHM_K + NW * 64 * 4;

using bf16 = __hip_bfloat16;
typedef short bf16x8 __attribute__((ext_vector_type(8)));
typedef short s16x4 __attribute__((ext_vector_type(4)));
typedef float f32x16 __attribute__((ext_vector_type(16)));
typedef float f32x4 __attribute__((ext_vector_type(4)));
typedef unsigned u32x4 __attribute__((ext_vector_type(4)));
template <class A, class Bt> struct same_t { static constexpr bool v = false; };
template <class A> struct same_t<A, A> { static constexpr bool v = true; };

#define KSWZ(row, colB) ((row) * 256 + ((colB) ^ (((row) & 7) << 4)))
#define SBAR() __builtin_amdgcn_sched_barrier(0)
__device__ __forceinline__ int v_st(int k, int c) { const int kk = (k & ~0xC) | ((k & 4) << 1) | ((k & 8) >> 1); return ((kk >> 3) * 4 + (c >> 5)) * 512 + ((kk & 7) * 32 + (c & 31)) * 2; }
__device__ __forceinline__ int v_rd_base(int lane) { return ((lane & 3) << 3) | (((lane >> 2) & 3) << 6) | (((lane >> 4) & 1) << 5) | (((lane >> 5) & 1) << 8); }
constexpr int v_rd_off(int d0, int ks, int half) { return d0 * 512 + ks * 4096 + half * 2048; }
__device__ __forceinline__ int crow(int r, int hi) { return (r & 3) + 8 * (r >> 2) + 4 * hi; }
__device__ __forceinline__ unsigned cvtpk(float lo, float hi) {
    unsigned r; asm volatile("v_cvt_pk_bf16_f32 %0, %1, %2" : "=v"(r) : "v"(lo), "v"(hi)); return r;
}
__device__ __forceinline__ bf16x8 pack8(f32x4 a, f32x4 b) {
    u32x4 w = {cvtpk(a[0], a[1]), cvtpk(a[2], a[3]), cvtpk(b[0], b[1]), cvtpk(b[2], b[3])};
    return *reinterpret_cast<bf16x8*>(&w);
}
template <class T> __device__ __forceinline__ bf16x8 load8(const T* p) {
    if constexpr (same_t<T, float>::v) { return pack8(*(const f32x4*)p, *(const f32x4*)(p + 4)); }
    else { return *reinterpret_cast<const bf16x8*>(p); }
}
__device__ __forceinline__ void mask_tile(f32x16& p0, f32x16& p1, int dq, unsigned W) {
    const float NEG = -__builtin_inff();
#pragma unroll
    for (int r = 0; r < 16; ++r) {
        const int c = (r & 3) + 8 * (r >> 2);
        if ((unsigned)(dq - c) >= W) p0[r] = NEG;
        if ((unsigned)(dq - c - 32) >= W) p1[r] = NEG;
    }
}
__device__ __forceinline__ void partialSM(f32x16& p0, f32x16& p1, float& m_reg, float& mn, float& alpha) {
    float pmax = p0[0]; for (int r = 1; r < 16; ++r) pmax = fmaxf(pmax, p0[r]); for (int r = 0; r < 16; ++r) pmax = fmaxf(pmax, p1[r]);
    { auto rr = __builtin_amdgcn_permlane32_swap(__float_as_uint(pmax), __float_as_uint(pmax), false, false);
      pmax = fmaxf(__uint_as_float(rr[0]), __uint_as_float(rr[1])); }
    constexpr float C2 = 1.4426950408889634f * SCALE;
    if (__builtin_expect(__all((pmax - m_reg) * SCALE <= THR), 1)) { mn = m_reg; alpha = 1.f; }
    else { mn = fmaxf(m_reg, pmax); alpha = __builtin_amdgcn_exp2f((m_reg - mn) * C2); m_reg = mn; }
    const float mnL = -mn * C2;
    for (int r = 0; r < 16; ++r) p0[r] = fmaf(p0[r], C2, mnL); for (int r = 0; r < 16; ++r) p1[r] = fmaf(p1[r], C2, mnL);
    for (int r = 0; r < 16; ++r) p0[r] = __builtin_amdgcn_exp2f(p0[r]);
}
__device__ __forceinline__ void finishSM(f32x16& p0, f32x16& p1, float alpha, float& l_reg, bf16x8& pa0, bf16x8& pa1, bf16x8& pa2, bf16x8& pa3) {
    for (int r = 0; r < 16; ++r) p1[r] = __builtin_amdgcn_exp2f(p1[r]);
    float ps = 0; for (int r = 0; r < 16; ++r) ps += p0[r]; for (int r = 0; r < 16; ++r) ps += p1[r];
    { auto rr = __builtin_amdgcn_permlane32_swap(__float_as_uint(ps), __float_as_uint(ps), false, false);
      ps = __uint_as_float(rr[0]) + __uint_as_float(rr[1]); }
    l_reg = l_reg * alpha + ps;
#define PK4(P, B_, OUT) do { unsigned a0 = cvtpk(P[B_+0], P[B_+1]), a1 = cvtpk(P[B_+2], P[B_+3]);                          \
        unsigned b0 = cvtpk(P[B_+4], P[B_+5]), b1 = cvtpk(P[B_+6], P[B_+7]);                                             \
        auto r0 = __builtin_amdgcn_permlane32_swap(a0, b0, false, false); auto r1 = __builtin_amdgcn_permlane32_swap(a1, b1, false, false); \
        u32x4 w = {r0[0], r1[0], r0[1], r1[1]}; OUT = *reinterpret_cast<bf16x8*>(&w); } while (0)
    PK4(p0, 0, pa0); PK4(p0, 8, pa1); PK4(p1, 0, pa2); PK4(p1, 8, pa3);
#undef PK4
}
template <int KB, bool SK>
__device__ __forceinline__ void qkt(f32x16& p0, f32x16& p1, const char* K_lds, int r32, int hi, const bf16x8* qr, bool act) {
    if (SK && !act) { const float NEG = -__builtin_inff();
#pragma unroll
        for (int r = 0; r < 16; ++r) { p0[r] = NEG; p1[r] = NEG; } return; }
    p0 = f32x16{}; p1 = f32x16{};
    const char* kb[4];
#pragma unroll
    for (int dd = 0; dd < 4; ++dd) kb[dd] = K_lds + KB * SHM_K + KSWZ(r32, (dd * 16 + hi * 8) * 2);
#pragma unroll
    for (int d0 = 0; d0 < 8; ++d0) { const char* a = kb[d0 & 3] + (d0 >> 2) * 128;
        bf16x8 b0 = *reinterpret_cast<const bf16x8*>(a);
        bf16x8 b1 = *reinterpret_cast<const bf16x8*>(a + 32 * 256);
        p0 = __builtin_amdgcn_mfma_f32_32x32x16_bf16(b0, qr[d0], p0, 0, 0, 0);
        p1 = __builtin_amdgcn_mfma_f32_32x32x16_bf16(b1, qr[d0], p1, 0, 0, 0); }
}
template <int VB, bool SK>
__device__ __forceinline__ void pv_tile(f32x16* o, int vb0, bf16x8 pa0, bf16x8 pa1, bf16x8 pa2, bf16x8 pa3, bool act) {
    if (SK && !act) return;
#define TRRD(dst, off) asm volatile("ds_read_b64_tr_b16 %0, %1 offset:%2" : "=&v"(dst) : "v"(vb0), "i"(off) : "memory")
#define PV_D0(d0) do { s16x4 l0, l1, l2, l3, h0, h1, h2, h3; constexpr int b_ = VB * SHM_V + v_rd_off(d0, 0, 0);     \
        TRRD(l0, b_); TRRD(h0, b_ + 2048); TRRD(l1, b_ + 4096); TRRD(h1, b_ + 6144); TRRD(l2, b_ + 8192); TRRD(h2, b_ + 10240); TRRD(l3, b_ + 12288); TRRD(h3, b_ + 14336); \
        asm volatile("s_waitcnt lgkmcnt(0)" ::: "memory"); SBAR();                 \
        o[d0] = __builtin_amdgcn_mfma_f32_32x32x16_bf16(pa0, (bf16x8){l0[0], l0[1], l0[2], l0[3], h0[0], h0[1], h0[2], h0[3]}, o[d0], 0, 0, 0);   \
        o[d0] = __builtin_amdgcn_mfma_f32_32x32x16_bf16(pa1, (bf16x8){l1[0], l1[1], l1[2], l1[3], h1[0], h1[1], h1[2], h1[3]}, o[d0], 0, 0, 0);   \
        o[d0] = __builtin_amdgcn_mfma_f32_32x32x16_bf16(pa2, (bf16x8){l2[0], l2[1], l2[2], l2[3], h2[0], h2[1], h2[2], h2[3]}, o[d0], 0, 0, 0);   \
        o[d0] = __builtin_amdgcn_mfma_f32_32x32x16_bf16(pa3, (bf16x8){l3[0], l3[1], l3[2], l3[3], h3[0], h3[1], h3[2], h3[3]}, o[d0], 0, 0, 0); } while (0)
    PV_D0(0); PV_D0(1); PV_D0(2); PV_D0(3);
#undef PV_D0
#undef TRRD
}

template <class TIn, class TOut> struct BlockRef { const TIn* Q; const TIn* K; const TIn* V; TOut* O; int P0; };
template <class TIn> struct Seam {
    bf16x8 qr[8];
    bf16x8 st_v0, st_v1, st_k0, st_k1; f32x4 sf0, sf1, sf2, sf3;
    f32x4 tq[16];
};
__device__ __forceinline__ int swa_jlo(int P0, int W) { const int lowk = P0 - W + 1; return lowk > 0 ? lowk / KVBLK : 0; }
#define ROW(p, k0, rr) ((p) + (size_t)((k0) + (rr)) * LDP + sc)
#define VMW() asm volatile("s_waitcnt vmcnt(0)" ::: "memory")
#define VMWN(n) asm volatile("s_waitcnt vmcnt(%0)" :: "i"(n) : "memory")
#define SLOAD_H(Kp, Vp, k0) do { S.st_v0 = load8<TIn>(ROW(Vp, k0, sr)); S.st_v1 = load8<TIn>(ROW(Vp, k0, 32 + sr));              \
                         S.st_k0 = load8<TIn>(ROW(Kp, k0, sr)); S.st_k1 = load8<TIn>(ROW(Kp, k0, 32 + sr)); } while (0)
#define SWRITE_HK(bf) do { *(bf16x8*)(K_lds + (bf) * SHM_K + kws) = S.st_k0; *(bf16x8*)(K_lds + (bf) * SHM_K + kws + 32 * 256) = S.st_k1; } while (0)
#define SWRITE_HV(bf) do { *(bf16x8*)(V_lds + (bf) * SHM_V + vst0) = S.st_v0; *(bf16x8*)(V_lds + (bf) * SHM_V + vst1) = S.st_v1; } while (0)
#define SWRITE_H(bf) do { SWRITE_HV(bf); SWRITE_HK(bf); } while (0)
#define SLOAD_F(p, k0) do { S.sf0 = *(const f32x4*)ROW(p, k0, sr); S.sf1 = *(const f32x4*)(ROW(p, k0, sr) + 4);                \
                            S.sf2 = *(const f32x4*)ROW(p, k0, 32 + sr); S.sf3 = *(const f32x4*)(ROW(p, k0, 32 + sr) + 4); } while (0)
#define SWRITE_KF(bf) do { *(bf16x8*)(K_lds + (bf) * SHM_K + kws) = pack8(S.sf0, S.sf1); *(bf16x8*)(K_lds + (bf) * SHM_K + kws + 32 * 256) = pack8(S.sf2, S.sf3); } while (0)
#define SWRITE_VF(bf) do { *(bf16x8*)(V_lds + (bf) * SHM_V + vst0) = pack8(S.sf0, S.sf1); *(bf16x8*)(V_lds + (bf) * SHM_V + vst1) = pack8(S.sf2, S.sf3); } while (0)
template <class TIn, class TOut>
__device__ __forceinline__ void causal_swa_prime(const BlockRef<TIn, TOut>& cur, int W, char* lds, Seam<TIn>& S, const int mk_wave) {
    constexpr bool F32 = same_t<TIn, float>::v;
    const int lane = (int)(__builtin_amdgcn_mbcnt_hi(~0u, __builtin_amdgcn_mbcnt_lo(~0u, 0u)) & 63u), wid = mk_wave & 7, tid = wid * 64 + lane, r32 = lane & 31, hi = lane >> 5;
    const int sr = tid >> 4, sc = (tid & 15) * 8, kws = KSWZ(sr, sc * 2); char* K_lds = lds + 2 * SHM_V;
    const int kb0 = swa_jlo(cur.P0, W) * KVBLK;
    for (int d0 = 0; d0 < 8; ++d0) S.qr[d0] = load8<TIn>(cur.Q + (size_t)(wid * QBLK + r32) * LDP + d0 * 16 + hi * 8);
    if constexpr (F32) { SLOAD_F((const float*)cur.K, kb0); VMW(); SWRITE_KF(0); SBAR(); SLOAD_F((const float*)cur.V, kb0); }
    else { SLOAD_H(cur.K, cur.V, kb0); VMW(); SWRITE_HK(0); }
    __syncthreads();
}
template <class TIn, class TOut>
__device__ __forceinline__ void causal_swa_block(const BlockRef<TIn, TOut>& cur, const BlockRef<TIn, TOut>& nxt, int skv, int W, char* lds, Seam<TIn>& S, const int mk_wave) {
    constexpr bool F32 = same_t<TIn, float>::v;
    const int lane = (int)(__builtin_amdgcn_mbcnt_hi(~0u, __builtin_amdgcn_mbcnt_lo(~0u, 0u)) & 63u), wid = mk_wave & 7, tid = wid * 64 + lane, r32 = lane & 31, hi = lane >> 5;
    const int j_lo = swa_jlo(cur.P0, W);
    int j_hi = (cur.P0 + QB - 1) / KVBLK + 1; if (j_hi > skv / KVBLK) j_hi = skv / KVBLK;
    const int NT = j_hi - j_lo;
    const int kbn = swa_jlo(nxt.P0, W) * KVBLK;
    const int qlo = cur.P0 + wid * QBLK, qm = qlo + r32 - 4 * hi;
    char* V_lds = lds; char* K_lds = lds + 2 * SHM_V;
    float* ws = (float*)(lds + 2 * SHM_V + 2 * SHM_K) + wid * 64; float* li_l = ws, * al_l = ws + 32;
    float m_reg = -1e30f, l_reg = 0; f32x16 o[4] = {};
    const int sr = tid >> 4, sc = (tid & 15) * 8, vst0 = v_st(sr, sc), vst1 = v_st(32 + sr, sc), kws = KSWZ(sr, sc * 2);
    const int vb0 = (int)(uintptr_t)V_lds + v_rd_base(lane);
    const TIn* Kh = cur.K; const TIn* Vh = cur.V;
#define RESC(a) do { if (__any((a) < 1.f)) { if (hi == 0) al_l[r32] = (a); asm volatile("s_waitcnt lgkmcnt(0)" ::: "memory");              \
                     for (int d_ = 0; d_ < 4; ++d_) for (int r = 0; r < 16; ++r) o[d_][r] *= al_l[crow(r, hi)]; } } while (0)
#define KBASE(t) ((j_lo + (t)) * KVBLK)
#define ACT(t) (KBASE(t) <= qlo + QBLK - 1 && KBASE(t) + KVBLK - 1 >= qlo - W + 1)
#define MASKT(P0_, P1_, t) do { const int kb_ = KBASE(t); if ((!SK || ACT(t)) && (kb_ + KVBLK - 1 > qlo || kb_ <= qlo + QBLK - 1 - W)) mask_tile(P0_, P1_, qm - kb_, (unsigned)W); } while (0)
    constexpr int NQL = F32 ? 16 : 8;
    constexpr bool SK = WSKIP && !F32;
#define SEAM_K0() do { VMWN(NQL); if constexpr (F32) { SWRITE_KF(0); SBAR(); SLOAD_F((const float*)nxt.V, kbn); } else { SWRITE_HK(0); } SBAR(); } while (0)
    f32x16 pA0, pA1, pB0, pB1; float mnA, mnB, alA, alB; bf16x8 pa0, pa1, pa2, pa3;
    if constexpr (F32) { VMW(); SWRITE_VF(0); SBAR(); } else { SWRITE_HV(0); SBAR(); }
    if (NT > 1) { if constexpr (F32) SLOAD_F((const float*)Kh, KBASE(1)); else SLOAD_H(Kh, Vh, KBASE(1)); }
    SBAR(); qkt<0, SK>(pA0, pA1, K_lds, r32, hi, S.qr, ACT(0));
    if constexpr (F32) { if (NT > 1) { VMW(); SWRITE_KF(1); SBAR(); SLOAD_F((const float*)Vh, KBASE(1)); } }
    MASKT(pA0, pA1, 0); partialSM(pA0, pA1, m_reg, mnA, alA);
    if (NT > 1) { VMW(); if constexpr (F32) { SWRITE_VF(1); SBAR(); if (NT > 2) SLOAD_F((const float*)Kh, KBASE(2)); } else SWRITE_H(1); }
    __syncthreads();
#define HALF_STEP(PX0, PX1, mnX, alX, PY0, PY1, alY, t, KB, VB, SB) do {                                                      \
        SBAR(); qkt<KB, SK>(PX0, PX1, K_lds, r32, hi, S.qr, ACT(t));                                             \
        finishSM(PY0, PY1, alY, l_reg, pa0, pa1, pa2, pa3); SBAR();                                                           \
        if ((t) + 1 < NT) { if constexpr (F32) { VMW(); SWRITE_KF(SB); SBAR(); SLOAD_F((const float*)Vh, KBASE((t) + 1)); }  \
                            else { SLOAD_H(Kh, Vh, KBASE((t) + 1)); } SBAR(); }                                               \
        pv_tile<VB, SK>(o, vb0, pa0, pa1, pa2, pa3, ACT((t) - 1)); MASKT(PX0, PX1, (t)); partialSM(PX0, PX1, m_reg, mnX, alX);                                        \
        __syncthreads();                                                                                                      \
        if ((t) + 1 < NT) { VMW(); if constexpr (F32) { SWRITE_VF(SB); SBAR(); if ((t) + 2 < NT) SLOAD_F((const float*)Kh, KBASE((t) + 2)); } \
                            else { SWRITE_H(SB); } }                                                                          \
        RESC(alX); __syncthreads(); } while (0)
    for (int t = 1; t + 1 < NT; t += 2) {
        HALF_STEP(pB0, pB1, mnB, alB, pA0, pA1, alA, t, 1, 0, 0);
        HALF_STEP(pA0, pA1, mnA, alA, pB0, pB1, alB, t + 1, 0, 1, 1);
    }
    const bool even = (NT & 1) == 0;
    if (even) { SBAR(); qkt<1, SK>(pB0, pB1, K_lds, r32, hi, S.qr, ACT(NT - 1)); SBAR(); }
#define QROW(e) (nxt.Q + (size_t)(wid * QBLK + r32) * LDP + ((e) >> 1) * 16 + hi * 8 + ((e) & 1) * 4)
    if constexpr (F32) { SLOAD_F((const float*)nxt.K, kbn); SBAR();
#pragma unroll
        for (int e = 0; e < 8; ++e) S.tq[e] = *(const f32x4*)QROW(e); }
    else { SLOAD_H(nxt.K, nxt.V, kbn); SBAR();
#pragma unroll
        for (int d0 = 0; d0 < 8; ++d0) S.qr[d0] = load8<TIn>(nxt.Q + (size_t)(wid * QBLK + r32) * LDP + d0 * 16 + hi * 8); }
    SBAR();
    finishSM(pA0, pA1, alA, l_reg, pa0, pa1, pa2, pa3); SBAR();
    if constexpr (F32) {
#pragma unroll
        for (int e = 8; e < 16; ++e) S.tq[e] = *(const f32x4*)QROW(e); SBAR(); }
#undef QROW
    pv_tile<0, SK>(o, vb0, pa0, pa1, pa2, pa3, ACT(even ? NT - 2 : NT - 1));
    if (even) { MASKT(pB0, pB1, NT - 1); partialSM(pB0, pB1, m_reg, mnB, alB); __syncthreads(); RESC(alB);
        finishSM(pB0, pB1, alB, l_reg, pa0, pa1, pa2, pa3); SBAR(); pv_tile<1, SK>(o, vb0, pa0, pa1, pa2, pa3, ACT(NT - 1)); }
    SBAR(); SEAM_K0();
    if (hi == 0) li_l[r32] = l_reg; asm volatile("s_waitcnt lgkmcnt(0)" ::: "memory");
    float rli[16];
#pragma unroll
    for (int r = 0; r < 16; ++r) rli[r] = __builtin_amdgcn_rcpf(li_l[crow(r, hi)]);
    TOut* Ow = cur.O + (size_t)(wid * QBLK) * LDO;
#pragma unroll
    for (int r = 0; r < 16; ++r) { const int orow = crow(r, hi);
#pragma unroll
        for (int d0 = 0; d0 < 4; ++d0) { const float v = o[d0][r] * rli[r];
            if constexpr (same_t<TOut, float>::v) { Ow[(size_t)orow * LDO + d0 * 32 + r32] = v; }
            else { const float vn = __shfl_xor(v, 1);
                   if ((r32 & 1) == 0) *(unsigned*)(Ow + (size_t)orow * LDO + d0 * 32 + r32) = cvtpk(v, vn); } } }
    if constexpr (F32) {
#pragma unroll
        for (int d0 = 0; d0 < 8; ++d0) S.qr[d0] = pack8(S.tq[2 * d0], S.tq[2 * d0 + 1]); }
    __syncthreads();
#undef RESC
#undef KBASE
#undef ACT
#undef MASKT
#undef SEAM_K0
#undef HALF_STEP
}
#undef ROW
#undef VMW
#undef VMWN
#undef SLOAD_H
#undef SWRITE_HK
#undef SWRITE_HV
#undef SWRITE_H
#undef SLOAD_F
#undef SWRITE_KF
#undef SWRITE_VF

constexpr int A2_V = 0;
constexpr int A2_K = 4 * SHM_V;
constexpr int A2_X = A2_K + 2 * SHM_K;
constexpr int A2_XS = 4096 + 512;
constexpr int A2_LDS = A2_X + 4 * A2_XS;
struct A2Ref { const bf16* Q; const bf16* K; const bf16* V0; const bf16* V1; bf16* O; int P0; };

__device__ __forceinline__ void attn2_block(const A2Ref& c, char* lds, const int mk_wave) {
    const int lane = (int)(__builtin_amdgcn_mbcnt_hi(~0u, __builtin_amdgcn_mbcnt_lo(~0u, 0u)) & 63u), wid = mk_wave & 7, tid = wid * 64 + lane, r32 = lane & 31, hi = lane >> 5, rg = wid & 3, vh = wid >> 2;
    char* V_lds = lds + A2_V; char* K_lds = lds + A2_K; char* X = lds + A2_X + rg * A2_XS;
    float* XA = (float*)(X + 4096); float* XM = XA + 32; float* XL = XA + 64;
    const int NT = (c.P0 + 127) / 64 + 1;
    const int qlo = c.P0 + rg * 32, qm = qlo + r32 - 4 * hi;
    const int sr = tid >> 4, sc = (tid & 15) * 8, vst0 = v_st(sr, sc), vst1 = v_st(32 + sr, sc), kws = KSWZ(sr, sc * 2);
    const int vb0 = (int)(uintptr_t)V_lds + vh * SHM_V + v_rd_base(lane);
    bf16x8 qr[8];
#pragma unroll
    for (int d0 = 0; d0 < 8; ++d0) qr[d0] = load8<bf16>(c.Q + (size_t)(rg * 32 + r32) * 128 + d0 * 16 + hi * 8);
    float m_reg = -1e30f, l_reg = 0.f; f32x16 o[4] = {};
    bf16x8 sk0, sk1, sa0, sa1, sb0, sb1;
#define A2_LOAD(kb) do { const size_t ro_ = (size_t)((kb) + sr) * 128 + sc; sk0 = load8<bf16>(c.K + ro_); sk1 = load8<bf16>(c.K + ro_ + 32 * 128); \
        sa0 = load8<bf16>(c.V0 + ro_); sa1 = load8<bf16>(c.V0 + ro_ + 32 * 128); sb0 = load8<bf16>(c.V1 + ro_); sb1 = load8<bf16>(c.V1 + ro_ + 32 * 128); } while (0)
#define A2_WRITE(buf) do { *(bf16x8*)(K_lds + (buf) * SHM_K + kws) = sk0; *(bf16x8*)(K_lds + (buf) * SHM_K + kws + 32 * 256) = sk1; \
        *(bf16x8*)(V_lds + (buf) * 2 * SHM_V + vst0) = sa0; *(bf16x8*)(V_lds + (buf) * 2 * SHM_V + vst1) = sa1; \
        *(bf16x8*)(V_lds + (buf) * 2 * SHM_V + SHM_V + vst0) = sb0; *(bf16x8*)(V_lds + (buf) * 2 * SHM_V + SHM_V + vst1) = sb1; } while (0)
#define A2_VMW() asm volatile("s_waitcnt vmcnt(0)" ::: "memory")
#define A2_STEP(t, B) do { const bool more_ = (t) + 1 < NT; if (more_) A2_LOAD(((t) + 1) * 64); \
        bf16x8 pa0, pa1, pa2, pa3; \
        if (vh == (B)) { f32x16 p0, p1; float mn, alpha; \
            qkt<(B), false>(p0, p1, K_lds, r32, hi, qr, true); \
            if (64 * (t) + 63 > qlo) mask_tile(p0, p1, qm - 64 * (t), 16384u); \
            partialSM(p0, p1, m_reg, mn, alpha); finishSM(p0, p1, alpha, l_reg, pa0, pa1, pa2, pa3); \
            *(bf16x8*)(X + lane * 16) = pa0; *(bf16x8*)(X + 1024 + lane * 16) = pa1; *(bf16x8*)(X + 2048 + lane * 16) = pa2; *(bf16x8*)(X + 3072 + lane * 16) = pa3; \
            if (hi == 0) { XA[r32] = alpha; XM[r32] = m_reg; XL[r32] = l_reg; } } \
        __syncthreads(); \
        if (vh != (B)) { pa0 = *(const bf16x8*)(X + lane * 16); pa1 = *(const bf16x8*)(X + 1024 + lane * 16); pa2 = *(const bf16x8*)(X + 2048 + lane * 16); pa3 = *(const bf16x8*)(X + 3072 + lane * 16); \
            m_reg = XM[r32]; l_reg = XL[r32]; } \
        { const float a_ = XA[r32]; if (__any(a_ < 1.f)) { \
            _Pragma("unroll") for (int d_ = 0; d_ < 4; ++d_) _Pragma("unroll") for (int r = 0; r < 16; ++r) o[d_][r] *= XA[crow(r, hi)]; } } \
        pv_tile<2 * (B), false>(o, vb0, pa0, pa1, pa2, pa3, true); \
        if (more_) { A2_VMW(); A2_WRITE((B) ^ 1); } \
        __syncthreads(); } while (0)
    A2_LOAD(0); A2_VMW(); A2_WRITE(0); __syncthreads();
    for (int t = 0; t < NT; t += 2) { A2_STEP(t, 0); A2_STEP(t + 1, 1); }
    float rli[16];
#pragma unroll
    for (int r = 0; r < 16; ++r) rli[r] = __builtin_amdgcn_rcpf(XL[crow(r, hi)]);
    bf16* Ow = c.O + (size_t)(rg * 32) * LDO + vh * 128;
#pragma unroll
    for (int r = 0; r < 16; ++r) { const int orow = crow(r, hi);
#pragma unroll
        for (int d0 = 0; d0 < 4; ++d0) { const float v = o[d0][r] * rli[r]; const float vn = __shfl_xor(v, 1);
            if ((r32 & 1) == 0) *(unsigned*)(Ow + (size_t)orow * LDO + d0 * 32 + r32) = cvtpk(v, vn); } }
    __syncthreads();
#undef A2_LOAD
#undef A2_WRITE
#undef A2_VMW
#undef A2_STEP
}

constexpr int A6_XS = 8192 + 1024;
constexpr int A6_LDS = A2_X + 4 * A6_XS + 8 * 128;
__device__ __forceinline__ void attn6_block(const A2Ref& c, char* lds, const int mk_wave) {
    int lane_ = (int)(__builtin_amdgcn_mbcnt_hi(~0u, __builtin_amdgcn_mbcnt_lo(~0u, 0u)) & 63u); asm volatile("" : "+v"(lane_));
    const int lane = lane_ & 63, wid = mk_wave & 7, tid = wid * 64 + lane, r32 = lane & 31, hi = lane >> 5, rg = wid & 3, vh = wid >> 2;
    char* V_lds = lds + A2_V; char* K_lds = lds + A2_K; char* X = lds + A2_X + rg * A6_XS;
    float* XM = (float*)(X + 8192); float* XL = XM + 128; float* AL = (float*)(lds + A2_X + 4 * A6_XS + wid * 128);
    const int NT = (c.P0 + 127) / 64 + 1;
    const int qlo = c.P0 + rg * 32, qm = qlo + r32 - 4 * hi;
    const int sr = tid >> 4, sc = (tid & 15) * 8, vst0 = v_st(sr, sc), vst1 = v_st(32 + sr, sc), kws = KSWZ(sr, sc * 2);
    const unsigned so = (unsigned)(sr * 128 + sc) * 2u;
    const int vb0 = (int)(uintptr_t)V_lds + vh * SHM_V + v_rd_base(lane);
    bf16x8 qr[8];
#pragma unroll
    for (int d0 = 0; d0 < 8; ++d0) qr[d0] = load8<bf16>(c.Q + (size_t)(rg * 32 + r32) * 128 + d0 * 16 + hi * 8);
    float m_reg = -1e30f, l_reg = 0.f; f32x16 o[4] = {};
    bf16x8 sk0, sk1, sa0, sa1, sb0, sb1;
    constexpr float C2 = 1.4426950408889634f * SCALE;
#define A4_G(base, kb, rows) (*(const bf16x8*)((const char*)((base) + (size_t)((kb) + (rows)) * 128) + so))
#define A4_LOAD(kb) do { sk0 = A4_G(c.K, kb, 0); sk1 = A4_G(c.K, kb, 32); sa0 = A4_G(c.V0, kb, 0); sa1 = A4_G(c.V0, kb, 32); sb0 = A4_G(c.V1, kb, 0); sb1 = A4_G(c.V1, kb, 32); } while (0)
#define A4_WRITE(buf) do { *(bf16x8*)(K_lds + (buf) * SHM_K + kws) = sk0; *(bf16x8*)(K_lds + (buf) * SHM_K + kws + 32 * 256) = sk1; \
        *(bf16x8*)(V_lds + (buf) * 2 * SHM_V + vst0) = sa0; *(bf16x8*)(V_lds + (buf) * 2 * SHM_V + vst1) = sa1; \
        *(bf16x8*)(V_lds + (buf) * 2 * SHM_V + SHM_V + vst0) = sb0; *(bf16x8*)(V_lds + (buf) * 2 * SHM_V + SHM_V + vst1) = sb1; } while (0)
#define A6_LOADK(kb) do { sk0 = A4_G(c.K, kb, 0); sk1 = A4_G(c.K, kb, 32); } while (0)
#define A6_LOADV(kb) do { sa0 = A4_G(c.V0, kb, 0); sa1 = A4_G(c.V0, kb, 32); sb0 = A4_G(c.V1, kb, 0); sb1 = A4_G(c.V1, kb, 32); } while (0)
#define A6_WRITEK(buf) do { *(bf16x8*)(K_lds + (buf) * SHM_K + kws) = sk0; *(bf16x8*)(K_lds + (buf) * SHM_K + kws + 32 * 256) = sk1; } while (0)
#define A6_WRITEV(buf) do { *(bf16x8*)(V_lds + (buf) * 2 * SHM_V + vst0) = sa0; *(bf16x8*)(V_lds + (buf) * 2 * SHM_V + vst1) = sa1; \
        *(bf16x8*)(V_lds + (buf) * 2 * SHM_V + SHM_V + vst0) = sb0; *(bf16x8*)(V_lds + (buf) * 2 * SHM_V + SHM_V + vst1) = sb1; } while (0)
#define A4_VMW() asm volatile("s_waitcnt vmcnt(0)" ::: "memory")
#define A4_PK(P, B_, OUT) do { unsigned a0_ = cvtpk(P[B_+0], P[B_+1]), a1_ = cvtpk(P[B_+2], P[B_+3]), b0_ = cvtpk(P[B_+4], P[B_+5]), b1_ = cvtpk(P[B_+6], P[B_+7]); \
        auto r0_ = __builtin_amdgcn_permlane32_swap(a0_, b0_, false, false); auto r1_ = __builtin_amdgcn_permlane32_swap(a1_, b1_, false, false); \
        u32x4 w_ = {r0_[0], r1_[0], r0_[1], r1_[1]}; OUT = *reinterpret_cast<bf16x8*>(&w_); } while (0)
#define A5_QK(T, KB) do { p = f32x16{}; \
        { const char* kb_[4]; \
          _Pragma("unroll") for (int dd = 0; dd < 4; ++dd) kb_[dd] = K_lds + (KB) * SHM_K + vh * (32 * 256) + KSWZ(r32, (dd * 16 + hi * 8) * 2); \
          _Pragma("unroll") for (int d0 = 0; d0 < 8; ++d0) { const bf16x8 b_ = *reinterpret_cast<const bf16x8*>(kb_[d0 & 3] + (d0 >> 2) * 128); p = __builtin_amdgcn_mfma_f32_32x32x16_bf16(b_, qr[d0], p, 0, 0, 0); } } } while (0)
#define A5_MAX(T) do { \
        if (64 * (T) + 32 * vh + 31 > qlo) { const int dq_ = qm - 64 * (T) - 32 * vh; \
            _Pragma("unroll") for (int r = 0; r < 16; ++r) { const int cc_ = (r & 3) + 8 * (r >> 2); if ((unsigned)(dq_ - cc_) >= 16384u) p[r] = -__builtin_inff(); } } \
        pmax_ = p[0]; \
        _Pragma("unroll") for (int r = 1; r < 16; ++r) pmax_ = fmaxf(pmax_, p[r]); \
        { auto rr_ = __builtin_amdgcn_permlane32_swap(__float_as_uint(pmax_), __float_as_uint(pmax_), false, false); pmax_ = fmaxf(__uint_as_float(rr_[0]), __uint_as_float(rr_[1])); } \
        if (hi == 0) XM[vh * 32 + r32] = pmax_; } while (0)
#define A5_SOFTMAX() do { \
        pmax_ = fmaxf(pmax_, XM[(vh ^ 1) * 32 + r32]); \
        float mn_; \
        if (__builtin_expect(__all((pmax_ - m_reg) * SCALE <= THR), 1)) { mn_ = m_reg; alpha_ = 1.f; } \
        else { mn_ = fmaxf(m_reg, pmax_); alpha_ = __builtin_amdgcn_exp2f((m_reg - mn_) * C2); m_reg = mn_; } \
        { const float mnL_ = -mn_ * C2; float ps_ = 0.f; \
          _Pragma("unroll") for (int r = 0; r < 16; ++r) { p[r] = __builtin_amdgcn_exp2f(fmaf(p[r], C2, mnL_)); ps_ += p[r]; } \
          auto rr_ = __builtin_amdgcn_permlane32_swap(__float_as_uint(ps_), __float_as_uint(ps_), false, false); ps_ = __uint_as_float(rr_[0]) + __uint_as_float(rr_[1]); \
          l_reg = l_reg * alpha_ + ps_; } \
        A4_PK(p, 0, pm0_); A4_PK(p, 8, pm1_); \
        *(bf16x8*)(X + vh * 2048 + lane * 16) = pm0_; *(bf16x8*)(X + vh * 2048 + 1024 + lane * 16) = pm1_; \
        if (hi == 0) AL[r32] = alpha_; } while (0)
    f32x16 p; float pmax_, alpha_ = 1.f; bf16x8 pm0_, pm1_;
    A4_LOAD(0); A4_VMW(); A4_WRITE(0); A6_LOADK(64); A4_VMW(); A6_WRITEK(1); A6_LOADV(64); if (2 < NT) A6_LOADK(128);
    __syncthreads();
    A5_QK(0, 0); A5_MAX(0);
    __syncthreads();
    A5_SOFTMAX();
    __syncthreads();
#define A6_STEP(t, B) do { \
        bf16x8 pa0, pa1, pa2, pa3; \
        { const bf16x8 po0_ = *(const bf16x8*)(X + (B) * 4096 + (vh ^ 1) * 2048 + lane * 16), po1_ = *(const bf16x8*)(X + (B) * 4096 + (vh ^ 1) * 2048 + 1024 + lane * 16); \
          if (vh == 0) { pa0 = pm0_; pa1 = pm1_; pa2 = po0_; pa3 = po1_; } else { pa0 = po0_; pa1 = po1_; pa2 = pm0_; pa3 = pm1_; } } \
        const float cand_ = fmaxf(pmax_, XM[(B) * 64 + (vh ^ 1) * 32 + r32]);                         \
        const bool more1_ = (t) + 1 < NT; \
        if (more1_) { A4_VMW(); A6_WRITEV((B) ^ 1); if ((t) + 2 < NT) A6_LOADV(((t) + 2) * 64); }     \
        if (more1_) A5_QK((t) + 1, (B) ^ 1); \
        pv_tile<2 * (B), false>(o, vb0, pa0, pa1, pa2, pa3, true); \
        if (!__all((cand_ - m_reg) * SCALE <= THR)) {                                      \
            const float mn_ = fmaxf(m_reg, cand_), al_ = __builtin_amdgcn_exp2f((m_reg - mn_) * C2); m_reg = mn_; l_reg *= al_; \
            if (hi == 0) AL[r32] = al_; asm volatile("s_waitcnt lgkmcnt(0)" ::: "memory"); \
            _Pragma("unroll") for (int d_ = 0; d_ < 4; ++d_) _Pragma("unroll") for (int r = 0; r < 16; ++r) o[d_][r] *= AL[crow(r, hi)]; } \
        if (more1_) { \
            if (64 * ((t) + 1) + 32 * vh + 31 > qlo) { const int dq_ = qm - 64 * ((t) + 1) - 32 * vh; \
                _Pragma("unroll") for (int r = 0; r < 16; ++r) { const int cc_ = (r & 3) + 8 * (r >> 2); if ((unsigned)(dq_ - cc_) >= 16384u) p[r] = -__builtin_inff(); } } \
            pmax_ = p[0]; \
            _Pragma("unroll") for (int r = 1; r < 16; ++r) pmax_ = fmaxf(pmax_, p[r]); \
            { auto rr_ = __builtin_amdgcn_permlane32_swap(__float_as_uint(pmax_), __float_as_uint(pmax_), false, false); pmax_ = fmaxf(__uint_as_float(rr_[0]), __uint_as_float(rr_[1])); } \
            { const float mnL_ = -m_reg * C2; float ps_ = 0.f; \
              _Pragma("unroll") for (int r = 0; r < 16; ++r) { p[r] = __builtin_amdgcn_exp2f(fmaf(p[r], C2, mnL_)); ps_ += p[r]; } \
              auto rr_ = __builtin_amdgcn_permlane32_swap(__float_as_uint(ps_), __float_as_uint(ps_), false, false); ps_ = __uint_as_float(rr_[0]) + __uint_as_float(rr_[1]); \
              l_reg += ps_; } \
            A4_PK(p, 0, pm0_); A4_PK(p, 8, pm1_); \
            *(bf16x8*)(X + ((B) ^ 1) * 4096 + vh * 2048 + lane * 16) = pm0_; *(bf16x8*)(X + ((B) ^ 1) * 4096 + vh * 2048 + 1024 + lane * 16) = pm1_; \
            if (hi == 0) XM[((B) ^ 1) * 64 + vh * 32 + r32] = pmax_; \
            if ((t) + 2 < NT) { A6_WRITEK(B); if ((t) + 3 < NT) A6_LOADK(((t) + 3) * 64); }     \
            __syncthreads(); } \
    } while (0)
    for (int t = 0; t < NT; t += 2) { A6_STEP(t, 0); A6_STEP(t + 1, 1); }
    __syncthreads();
    if (hi == 0) XL[vh * 32 + r32] = l_reg;
    __syncthreads();
    float rli[16];
#pragma unroll
    for (int r = 0; r < 16; ++r) rli[r] = __builtin_amdgcn_rcpf(XL[crow(r, hi)] + XL[32 + crow(r, hi)]);
    bf16* Ow = c.O + (size_t)(rg * 32) * LDO + vh * 128;
#pragma unroll
    for (int r = 0; r < 16; ++r) { const int orow = crow(r, hi);
#pragma unroll
        for (int d0 = 0; d0 < 4; ++d0) { const float v = o[d0][r] * rli[r]; const float vn = __shfl_xor(v, 1);
            if ((r32 & 1) == 0) *(unsigned*)(Ow + (size_t)orow * LDO + d0 * 32 + r32) = cvtpk(v, vn); } }
    __syncthreads();
#undef A4_G
#undef A4_LOAD
#undef A4_WRITE
#undef A4_VMW
#undef A4_PK
#undef A5_QK
#undef A5_MAX
#undef A5_SOFTMAX
#undef A6_STEP
#undef A6_WRITEK
#undef A6_LOADK
#undef A6_LOADV
#undef A6_WRITEV
}

__device__ __forceinline__ void attn9_block(const A2Ref& c, char* lds, __attribute__((address_space(3))) unsigned char* ldsl, const int mk_wave) {
    int lane_ = (int)(__builtin_amdgcn_mbcnt_hi(~0u, __builtin_amdgcn_mbcnt_lo(~0u, 0u)) & 63u); asm volatile("" : "+v"(lane_));
    const int lane = lane_ & 63, wid = mk_wave & 7, tid = wid * 64 + lane, r32 = lane & 31, hi = lane >> 5, rg = wid & 3, vh = wid >> 2;
    char* V_lds = lds + A2_V; char* K_lds = lds + A2_K; char* X = lds + A2_X + rg * A6_XS;
    float* XM = (float*)(X + 8192); float* XL = XM + 128; float* AL = (float*)(lds + A2_X + 4 * A6_XS + wid * 128);
    const int NT = (c.P0 + 127) / 64 + 1;
    const int qlo = c.P0 + rg * 32, qm = qlo + r32 - 4 * hi;
    const int oL = wid * 1024 + lane * 16;
    const int rowK = oL >> 8; const unsigned gK = (unsigned)(rowK * 256 + ((oL & 255) ^ ((rowK & 7) << 4)));
    const int stV = oL >> 9, eV = (oL & 511) >> 1, kkV = (stV >> 2) * 8 + (eV >> 5), kV = (kkV & ~0xC) | ((kkV & 4) << 1) | ((kkV & 8) >> 1);
    const unsigned gV = (unsigned)(kV * 256 + ((stV & 3) * 32 + (eV & 31)) * 2);
    const int vb0 = (int)(uintptr_t)V_lds + vh * SHM_V + v_rd_base(lane);
    bf16x8 qr[8];
#pragma unroll
    for (int d0 = 0; d0 < 8; ++d0) qr[d0] = load8<bf16>(c.Q + (size_t)(rg * 32 + r32) * 128 + d0 * 16 + hi * 8);
    float m_reg = -1e30f, l_reg = 0.f; f32x16 o[4] = {};
    constexpr float C2 = 1.4426950408889634f * SCALE;
#define A9_DMA(gbase, kb, goff, loff) do { \
        __builtin_amdgcn_global_load_lds((const unsigned*)((const char*)((gbase) + (size_t)(kb) * 128) + (goff)), (__attribute__((address_space(3))) unsigned*)(ldsl + (loff) + wid * 1024), 16, 0, 0); \
        __builtin_amdgcn_global_load_lds((const unsigned*)((const char*)((gbase) + (size_t)((kb) + 32) * 128) + (goff)), (__attribute__((address_space(3))) unsigned*)(ldsl + (loff) + 8192 + wid * 1024), 16, 0, 0); } while (0)
#define A9_DMAK(kb, buf) A9_DMA(c.K, kb, gK, A2_K + (buf) * SHM_K)
#define A9_DMAV(kb, buf) do { A9_DMA(c.V0, kb, gV, A2_V + (buf) * 2 * SHM_V); A9_DMA(c.V1, kb, gV, A2_V + (buf) * 2 * SHM_V + SHM_V); } while (0)
#define A4_VMW() asm volatile("s_waitcnt vmcnt(0)" ::: "memory")
#define A4_PK(P, B_, OUT) do { unsigned a0_ = cvtpk(P[B_+0], P[B_+1]), a1_ = cvtpk(P[B_+2], P[B_+3]), b0_ = cvtpk(P[B_+4], P[B_+5]), b1_ = cvtpk(P[B_+6], P[B_+7]); \
        auto r0_ = __builtin_amdgcn_permlane32_swap(a0_, b0_, false, false); auto r1_ = __builtin_amdgcn_permlane32_swap(a1_, b1_, false, false); \
        u32x4 w_ = {r0_[0], r1_[0], r0_[1], r1_[1]}; OUT = *reinterpret_cast<bf16x8*>(&w_); } while (0)
#define A5_QK(T, KB) do { p = f32x16{}; \
        { const char* kb_[4]; \
          _Pragma("unroll") for (int dd = 0; dd < 4; ++dd) kb_[dd] = K_lds + (KB) * SHM_K + vh * (32 * 256) + KSWZ(r32, (dd * 16 + hi * 8) * 2); \
          _Pragma("unroll") for (int d0 = 0; d0 < 8; ++d0) { const bf16x8 b_ = *reinterpret_cast<const bf16x8*>(kb_[d0 & 3] + (d0 >> 2) * 128); p = __builtin_amdgcn_mfma_f32_32x32x16_bf16(b_, qr[d0], p, 0, 0, 0); } } } while (0)
#define A5_MAX(T) do { \
        if (64 * (T) + 32 * vh + 31 > qlo) { const int dq_ = qm - 64 * (T) - 32 * vh; \
            _Pragma("unroll") for (int r = 0; r < 16; ++r) { const int cc_ = (r & 3) + 8 * (r >> 2); if ((unsigned)(dq_ - cc_) >= 16384u) p[r] = -__builtin_inff(); } } \
        pmax_ = p[0]; \
        _Pragma("unroll") for (int r = 1; r < 16; ++r) pmax_ = fmaxf(pmax_, p[r]); \
        { auto rr_ = __builtin_amdgcn_permlane32_swap(__float_as_uint(pmax_), __float_as_uint(pmax_), false, false); pmax_ = fmaxf(__uint_as_float(rr_[0]), __uint_as_float(rr_[1])); } \
        if (hi == 0) XM[vh * 32 + r32] = pmax_; } while (0)
#define A5_SOFTMAX() do { \
        pmax_ = fmaxf(pmax_, XM[(vh ^ 1) * 32 + r32]); \
        float mn_; \
        if (__builtin_expect(__all((pmax_ - m_reg) * SCALE <= THR), 1)) { mn_ = m_reg; alpha_ = 1.f; } \
        else { mn_ = fmaxf(m_reg, pmax_); alpha_ = __builtin_amdgcn_exp2f((m_reg - mn_) * C2); m_reg = mn_; } \
        { const float mnL_ = -mn_ * C2; float ps_ = 0.f; \
          _Pragma("unroll") for (int r = 0; r < 16; ++r) { p[r] = __builtin_amdgcn_exp2f(fmaf(p[r], C2, mnL_)); ps_ += p[r]; } \
          auto rr_ = __builtin_amdgcn_permlane32_swap(__float_as_uint(ps_), __float_as_uint(ps_), false, false); ps_ = __uint_as_float(rr_[0]) + __uint_as_float(rr_[1]); \
          l_reg = l_reg * alpha_ + ps_; } \
        A4_PK(p, 0, pm0_); A4_PK(p, 8, pm1_); \
        *(bf16x8*)(X + vh * 2048 + lane * 16) = pm0_; *(bf16x8*)(X + vh * 2048 + 1024 + lane * 16) = pm1_; \
        if (hi == 0) AL[r32] = alpha_; } while (0)
    f32x16 p; float pmax_, alpha_ = 1.f; bf16x8 pm0_, pm1_;
    A9_DMAK(0, 0); A9_DMAK(64, 1); A9_DMAV(0, 0); A4_VMW();
    __syncthreads();
    A5_QK(0, 0); A5_MAX(0);
    __syncthreads();
    A5_SOFTMAX();
    __syncthreads();
#define A6_STEP(t, B) do { \
        bf16x8 pa0, pa1, pa2, pa3; \
        { const bf16x8 po0_ = *(const bf16x8*)(X + (B) * 4096 + (vh ^ 1) * 2048 + lane * 16), po1_ = *(const bf16x8*)(X + (B) * 4096 + (vh ^ 1) * 2048 + 1024 + lane * 16); \
          if (vh == 0) { pa0 = pm0_; pa1 = pm1_; pa2 = po0_; pa3 = po1_; } else { pa0 = po0_; pa1 = po1_; pa2 = pm0_; pa3 = pm1_; } } \
        const float cand_ = fmaxf(pmax_, XM[(B) * 64 + (vh ^ 1) * 32 + r32]);                         \
        const bool more1_ = (t) + 1 < NT; \
        if (more1_) { A9_DMAV(((t) + 1) * 64, (B) ^ 1); if ((t) + 2 < NT) A9_DMAK(((t) + 2) * 64, B); }     \
        if (more1_) A5_QK((t) + 1, (B) ^ 1); \
        pv_tile<2 * (B), false>(o, vb0, pa0, pa1, pa2, pa3, true); \
        if (!__all((cand_ - m_reg) * SCALE <= THR)) {                                      \
            const float mn_ = fmaxf(m_reg, cand_), al_ = __builtin_amdgcn_exp2f((m_reg - mn_) * C2); m_reg = mn_; l_reg *= al_; \
            if (hi == 0) AL[r32] = al_; asm volatile("s_waitcnt lgkmcnt(0)" ::: "memory"); \
            _Pragma("unroll") for (int d_ = 0; d_ < 4; ++d_) _Pragma("unroll") for (int r = 0; r < 16; ++r) o[d_][r] *= AL[crow(r, hi)]; } \
        if (more1_) { \
            if (64 * ((t) + 1) + 32 * vh + 31 > qlo) { const int dq_ = qm - 64 * ((t) + 1) - 32 * vh; \
                _Pragma("unroll") for (int r = 0; r < 16; ++r) { const int cc_ = (r & 3) + 8 * (r >> 2); if ((unsigned)(dq_ - cc_) >= 16384u) p[r] = -__builtin_inff(); } } \
            pmax_ = p[0]; \
            _Pragma("unroll") for (int r = 1; r < 16; ++r) pmax_ = fmaxf(pmax_, p[r]); \
            { auto rr_ = __builtin_amdgcn_permlane32_swap(__float_as_uint(pmax_), __float_as_uint(pmax_), false, false); pmax_ = fmaxf(__uint_as_float(rr_[0]), __uint_as_float(rr_[1])); } \
            { const float mnL_ = -m_reg * C2; float ps_ = 0.f; \
              _Pragma("unroll") for (int r = 0; r < 16; ++r) { p[r] = __builtin_amdgcn_exp2f(fmaf(p[r], C2, mnL_)); ps_ += p[r]; } \
              auto rr_ = __builtin_amdgcn_permlane32_swap(__float_as_uint(ps_), __float_as_uint(ps_), false, false); ps_ = __uint_as_float(rr_[0]) + __uint_as_float(rr_[1]); \
              l_reg += ps_; } \
            A4_PK(p, 0, pm0_); A4_PK(p, 8, pm1_); \
            *(bf16x8*)(X + ((B) ^ 1) * 4096 + vh * 2048 + lane * 16) = pm0_; *(bf16x8*)(X + ((B) ^ 1) * 4096 + vh * 2048 + 1024 + lane * 16) = pm1_; \
            if (hi == 0) XM[((B) ^ 1) * 64 + vh * 32 + r32] = pmax_; \
            A4_VMW(); __syncthreads(); }     \
    } while (0)
    for (int t = 0; t < NT; t += 2) { A6_STEP(t, 0); A6_STEP(t + 1, 1); }
    __syncthreads();
    if (hi == 0) XL[vh * 32 + r32] = l_reg;
    __syncthreads();
    float rli[16];
#pragma unroll
    for (int r = 0; r < 16; ++r) rli[r] = __builtin_amdgcn_rcpf(XL[crow(r, hi)] + XL[32 + crow(r, hi)]);
    bf16* Ow = c.O + (size_t)(rg * 32) * LDO + vh * 128;
#pragma unroll
    for (int r = 0; r < 16; ++r) { const int orow = crow(r, hi);
#pragma unroll
        for (int d0 = 0; d0 < 4; ++d0) { const float v = o[d0][r] * rli[r]; const float vn = __shfl_xor(v, 1);
            if ((r32 & 1) == 0) *(unsigned*)(Ow + (size_t)orow * LDO + d0 * 32 + r32) = cvtpk(v, vn); } }
    __syncthreads();
#undef A4_VMW
#undef A9_DMA
#undef A9_DMAK
#undef A9_DMAV
#undef A4_PK
#undef A5_QK
#undef A5_MAX
#undef A5_SOFTMAX
#undef A6_STEP
}

}

constexpr int S_ = 16384, DM = 2048, FF = 5632, NIN = 6152, NINP = 6144, PLD = 3072;
constexpr int NWAVES = 8, NTHR = 512;
constexpr int C_MQ = 0, C_MK = 512, C_MV = 1024, C_MO = 2048;
constexpr size_t MiB = 1u << 20, KiB = 1u << 10;
constexpr size_t WS_ROWSS1 = 0, WS_ROWSS2 = 64 * KiB, WS_SC = 192 * KiB  , WS_DN = 256 * KiB, WS_GATES = 512 * KiB;
constexpr size_t WS_BAR = 128 * KiB;
constexpr size_t WS_WGU = 1 * MiB, WS_WD = 45 * MiB, WS_WIN = 67 * MiB, WS_WOUT = 92 * MiB;
constexpr size_t WS_XN = 100 * MiB;
constexpr size_t WS_BIG = 164 * MiB;
constexpr size_t WS_Y = 356 * MiB;
constexpr size_t WS_CT = 420 * MiB;
constexpr size_t WS_QC = 452 * MiB, WS_KC = 468 * MiB;
constexpr size_t WS_NST = 484 * MiB;
constexpr size_t WS_GW = 484 * MiB + 512 * KiB;
constexpr size_t WS_END = 485 * MiB;
constexpr int LDS_BYTES = 147456;

#define LAS __attribute__((address_space(3)))
typedef unsigned short bfu;
typedef unsigned v4u __attribute__((ext_vector_type(4)));
typedef unsigned v2u __attribute__((ext_vector_type(2)));
typedef float f32x4 __attribute__((ext_vector_type(4)));
typedef short bf16x8 __attribute__((ext_vector_type(8)));
#define MFMA16(a, b, c) __builtin_amdgcn_mfma_f32_16x16x32_bf16(a, b, c, 0, 0, 0)
#define LDS_WAIT() asm volatile("s_waitcnt lgkmcnt(0)" ::: "memory")
__device__ __forceinline__ unsigned f2bf(float f) { unsigned u = __builtin_bit_cast(unsigned, f); return (u + 0x7fffu + ((u >> 16) & 1u)) >> 16; }
__device__ __forceinline__ unsigned pk2(float lo, float hi) { return f2bf(lo) | (f2bf(hi) << 16); }
__device__ __forceinline__ float bf2f(unsigned b) { return __builtin_bit_cast(float, b << 16); }
__device__ __forceinline__ int mk_lane() { return (int)(__builtin_amdgcn_mbcnt_hi(~0u, __builtin_amdgcn_mbcnt_lo(~0u, 0u)) & 63u); }
__device__ __forceinline__ float wave_sum(float v) {
#pragma unroll
    for (int o = 1; o < 64; o <<= 1) v += __shfl_xor(v, o);
    return v;
}
__device__ __forceinline__ float silu(float x) { return x / (1.0f + __expf(-x)); }

__device__ __forceinline__ void cvt_item(const float* __restrict__ W, int ldw, int ncols, const float* __restrict__ gain, bfu* WT, int K, int dst_row0, int k0, int n0, LAS float* scr, int lane) {
    const int nq = (lane & 15) * 4, kr = lane >> 4, n = n0 + nq;
#pragma unroll 8
    for (int i = 0; i < 16; ++i) { const int kk = 4 * i + kr; f32x4 v = (f32x4){0.f, 0.f, 0.f, 0.f};
        if (n < ncols) v = *(const f32x4*)(W + (size_t)(k0 + kk) * ldw + n);
        if (gain) v = v * gain[k0 + kk];
        LAS float* d = scr + kk * 65 + nq; d[0] = v[0]; d[1] = v[1]; d[2] = v[2]; d[3] = v[3]; }
    LDS_WAIT(); asm volatile("" ::: "memory");
    const int c = lane & 7;
#pragma unroll
    for (int j = 0; j < 8; ++j) { const int nn = (lane >> 3) + 8 * j; const LAS float* s = scr + (8 * c) * 65 + nn;
        v4u o; o.x = pk2(s[0 * 65], s[1 * 65]); o.y = pk2(s[2 * 65], s[3 * 65]); o.z = pk2(s[4 * 65], s[5 * 65]); o.w = pk2(s[6 * 65], s[7 * 65]);
        *(v4u*)(WT + (size_t)(dst_row0 + nn) * K + k0 + 8 * c) = o; }
    LDS_WAIT(); asm volatile("" ::: "memory");
}
__device__ __forceinline__ void cvt_ffn_item(int it, const float* wg, const float* wu, const float* wd, const float* gain, bfu* Wgu, bfu* Wd, LAS float* scr, int lane) {
    if (it < 2 * 2816) { const int up = it >= 2816; const int r = up ? it - 2816 : it; const int kb = r / 88, nb = r % 88, n0 = nb * 64;
        cvt_item(up ? wu : wg, FF, FF, gain, Wgu, DM, 256 * (n0 >> 7) + (n0 & 127) + (up ? 128 : 0), kb * 64, n0, scr, lane); }
    else { const int r = it - 2 * 2816; const int kb = r / 32, nb = r % 32; cvt_item(wd, DM, DM, nullptr, Wd, FF, nb * 64, kb * 64, nb * 64, scr, lane); }
}

constexpr int GWP = 4112;
__device__ __forceinline__ void gates_rows(LAS unsigned char* lds, const bfu* __restrict__ XB, const float* __restrict__ rowss, const float* __restrict__ b_i, const float* __restrict__ b_f, float* GATES, int rb, int wave, int lane) {
    const int fr = lane & 15, fq = lane >> 4, rg = wave & 3, kh = wave >> 2;
    const LAS unsigned char* wl = lds + 16384;
    const bfu* xp = XB + (size_t)(rb * 64 + rg * 16 + fr) * DM + kh * 1024 + 8 * fq;
    f32x4 acc = (f32x4){0.f, 0.f, 0.f, 0.f};
    for (int k0 = 0; k0 < 32; k0 += 16) {
        bf16x8 xa[16];
#pragma unroll
        for (int ks = 0; ks < 16; ++ks) xa[ks] = *(const bf16x8*)(xp + (k0 + ks) * 32);
#pragma unroll
        for (int ks = 0; ks < 16; ++ks) { const bf16x8 wb = *(const LAS bf16x8*)(wl + fr * GWP + (kh * 1024 + (k0 + ks) * 32 + 8 * fq) * 2); acc = MFMA16(xa[ks], wb, acc); }
    }
    LAS f32x4* red = (LAS f32x4*)lds;
    if (kh == 1) red[rg * 64 + lane] = acc;
    __syncthreads();
    if (kh == 0 && fr < 8) {
        const f32x4 o = red[rg * 64 + lane]; const float bias = fr < 4 ? b_i[fr] : b_f[fr - 4];
#pragma unroll
        for (int j = 0; j < 4; ++j) { const int row = rb * 64 + rg * 16 + 4 * fq + j;
            const float pre = (acc[j] + o[j]) / sqrtf(rowss[row] * (1.0f / DM) + 1e-6f) + bias; const float capped = 15.0f * tanhf(pre * (1.0f / 15.0f));
            GATES[(size_t)row * 8 + fr] = fr < 4 ? capped : -log1pf(expf(-capped)); }
    }
    __syncthreads();
}

#define XB_TMO      128
#define XB_XCNT(j)  (256  + 64 * (j))
#define XB_XSUB(j)  (1280 + 64 * (j))
#define XB_XGEN(j)  (2304 + 64 * (j))
#define XB_TOP      3328
#define XB_TOPGEN   3392
#define XCD_BAR_WORDS 3456
#define XB_SPIN_CAP (1u << 18)
__device__ __forceinline__ unsigned xb_ld(unsigned* p)              { return __hip_atomic_load(p, __ATOMIC_RELAXED, __HIP_MEMORY_SCOPE_AGENT); }
__device__ __forceinline__ unsigned xb_add(unsigned* p, unsigned v) { return __hip_atomic_fetch_add(p, v, __ATOMIC_RELAXED, __HIP_MEMORY_SCOPE_AGENT); }
__device__ __forceinline__ unsigned xb_xcc_id() { return (unsigned)__builtin_amdgcn_s_getreg((3 << 11) | 20) & 0xFu; }
#define XB_SPIN(cond, bar) do { unsigned _sp = 0; while (cond) { __builtin_amdgcn_s_sleep(1); \
    if ((++_sp & 255u) == 0u) { if (xb_ld(&(bar)[XB_TMO])) break; if (_sp > XB_SPIN_CAP) { atomicAdd(&(bar)[XB_TMO], 1u); break; } } } } while (0)
__device__ __forceinline__ void xcd_barrier_complete(unsigned* bar, unsigned x, unsigned& nloc, unsigned& nx) {
    const unsigned G = gridDim.x * gridDim.y * gridDim.z;
    unsigned sum, cnt, mine, sp = 0u;
    for (;;) {
        sum = 0u; cnt = 0u; mine = 0u;
#pragma unroll
        for (unsigned j = 0; j < 16; ++j) { const unsigned c = xb_ld(&bar[XB_XCNT(j)]); sum += c; cnt += (c > 0u) ? 1u : 0u; mine = (j == x) ? c : mine; }
        if (sum == G) break;
        __builtin_amdgcn_s_sleep(1);
        if ((++sp & 255u) == 0u) { if (xb_ld(&bar[XB_TMO])) break; if (sp > XB_SPIN_CAP) { atomicAdd(&bar[XB_TMO], 1u); break; } }
    }
    nloc = mine > 0u ? mine : 1u; nx = cnt > 0u ? cnt : 1u;
}
__device__ __forceinline__ void xcd_barrier(unsigned* bar, volatile LAS unsigned* st, const bool first) {
    asm volatile("s_waitcnt vmcnt(0)" ::: "memory");
    __syncthreads();
    if (first) {
        const unsigned x = xb_xcc_id();
        __builtin_amdgcn_s_waitcnt(0);
        unsigned nloc = st[0], nx = st[1];
        if (nloc == 0u) { xcd_barrier_complete(bar, x, nloc, nx); st[0] = nloc; st[1] = nx; }
        const unsigned old = xb_add(&bar[XB_XSUB(x)], 1u);
        const unsigned gen = old / nloc;
        if (old + 1u == (gen + 1u) * nloc) {
            __builtin_amdgcn_fence(__ATOMIC_RELEASE, "agent");
            asm volatile("s_waitcnt vmcnt(0)" ::: "memory");
            const unsigned og = xb_add(&bar[XB_TOP], 1u);
            const unsigned tg = og / nx;
            if (og + 1u == (tg + 1u) * nx) xb_add(&bar[XB_TOPGEN], 1u);
            else XB_SPIN(xb_ld(&bar[XB_TOPGEN]) == tg, bar);
            __builtin_amdgcn_fence(__ATOMIC_ACQUIRE, "agent");
            xb_add(&bar[XB_XGEN(x)], 1u);
            asm volatile("s_waitcnt vmcnt(0)" ::: "memory");
        } else {
            XB_SPIN(xb_ld(&bar[XB_XGEN(x)]) == gen, bar);
            __builtin_amdgcn_fence(__ATOMIC_ACQUIRE, "agent");
            asm volatile("s_waitcnt vmcnt(0)" ::: "memory");
        }
    }
    __syncthreads();
}

struct Args { const float* in[23]; float* out; unsigned char* ws; int ph_lo, ph_hi; };
constexpr int NPH = 12;

constexpr int MP = 272;

__device__ __forceinline__ void mlstm_stage_a(LAS unsigned char* lds, const bfu* __restrict__ PROJ, const float* __restrict__ GATES, const float* __restrict__ conv_w, const float* __restrict__ conv_b,
                                              bfu* QC, bfu* KC, float* DELTA, float* DN, float* SC, int item, const int mk_wave) {
    int lane = mk_lane(); asm volatile("" : "+v"(lane));
    const int wid = mk_wave & 7, tid = wid * 64 + lane, fr = lane & 15, fq = lane >> 4;
    const int h = item & 3, row0 = (item >> 2) * 128;
    LAS float* fa = (LAS float*)lds; LAS unsigned char* KT = lds + 4096; LAS unsigned char* VT = KT + 128 * MP;
    if (tid < 128) { fa[tid] = GATES[(size_t)(row0 + tid) * 8 + 4 + h]; fa[128 + tid] = GATES[(size_t)(row0 + tid) * 8 + h]; }
    __syncthreads();
    if (tid < 128) { float b = 0.f; for (int s = 0; s <= tid; ++s) b += fa[s]; fa[256 + tid] = fa[128 + tid] - b; if (tid == 127) fa[385] = b; }
    __syncthreads();
    if (wid == 0) { float a = fmaxf(fa[256 + lane], fa[320 + lane]);
#pragma unroll
        for (int o = 1; o < 64; o <<= 1) a = fmaxf(a, __shfl_xor(a, o));
        if (lane == 0) fa[384] = a; }
    __syncthreads();
    const float amax = fa[384], blast = fa[385];
    if (tid < 128) fa[tid] = __expf(fa[256 + tid] - amax);
    if (tid == 0) { SC[item] = blast + amax; SC[512 + item] = blast; }
    __syncthreads();
    for (int task = tid; task < 4096; task += NTHR) {
        const int isk = task >> 11, t2 = task & 2047, d = t2 & 127, s0 = (t2 >> 7) * 8, ch = isk * 512 + h * 128 + d;
        const float w0 = conv_w[ch], w1 = conv_w[1024 + ch], w2 = conv_w[2048 + ch], w3 = conv_w[3072 + ch], bias = conv_b[ch];
        float x[11];
#pragma unroll
        for (int i = 0; i < 11; ++i) { const int r = row0 + s0 - 3 + i; x[i] = r >= 0 ? bf2f(PROJ[(size_t)r * PLD + C_MQ + ch]) : 0.f; }
        float y[8];
#pragma unroll
        for (int i = 0; i < 8; ++i) y[i] = silu(bias + w0 * x[i] + w1 * x[i + 1] + w2 * x[i + 2] + w3 * x[i + 3]);
        if (!isk) {
#pragma unroll
            for (int i = 0; i < 8; ++i) QC[(size_t)(row0 + s0 + i) * 512 + h * 128 + d] = (bfu)f2bf(y[i] * 0.08838834764831845f);
        } else {
#pragma unroll
            for (int i = 0; i < 8; ++i) { KC[(size_t)(row0 + s0 + i) * 512 + h * 128 + d] = (bfu)f2bf(y[i]); y[i] *= fa[s0 + i]; }
            v4u o; o.x = pk2(y[0], y[1]); o.y = pk2(y[2], y[3]); o.z = pk2(y[4], y[5]); o.w = pk2(y[6], y[7]);
            *(LAS v4u*)(KT + d * MP + s0 * 2) = o;
        }
    }
    for (int task = tid; task < 4096; task += NTHR) {
        const int sidx = task & 127, e0 = (task >> 7) * 8;
        const v4u v = *(const v4u*)(PROJ + (size_t)(row0 + sidx) * PLD + C_MV + h * 256 + e0);
        LAS unsigned short* d = (LAS unsigned short*)(VT + e0 * MP + sidx * 2);
        d[0 * (MP / 2)] = (unsigned short)(v.x & 0xffffu); d[1 * (MP / 2)] = (unsigned short)(v.x >> 16); d[2 * (MP / 2)] = (unsigned short)(v.y & 0xffffu); d[3 * (MP / 2)] = (unsigned short)(v.y >> 16);
        d[4 * (MP / 2)] = (unsigned short)(v.z & 0xffffu); d[5 * (MP / 2)] = (unsigned short)(v.z >> 16); d[6 * (MP / 2)] = (unsigned short)(v.w & 0xffffu); d[7 * (MP / 2)] = (unsigned short)(v.w >> 16);
    }
    __syncthreads();
    f32x4 acc[2][8];
#pragma unroll
    for (int mt = 0; mt < 2; ++mt)
#pragma unroll
        for (int nt = 0; nt < 8; ++nt) acc[mt][nt] = (f32x4){0.f, 0.f, 0.f, 0.f};
#pragma unroll
    for (int ks = 0; ks < 4; ++ks) {
        bf16x8 a[2];
#pragma unroll
        for (int mt = 0; mt < 2; ++mt) a[mt] = *(const LAS bf16x8*)(VT + (32 * wid + 16 * mt + fr) * MP + (32 * ks + 8 * fq) * 2);
#pragma unroll
        for (int nt = 0; nt < 8; ++nt) { const bf16x8 b = *(const LAS bf16x8*)(KT + (16 * nt + fr) * MP + (32 * ks + 8 * fq) * 2);
            acc[0][nt] = MFMA16(a[0], b, acc[0][nt]); acc[1][nt] = MFMA16(a[1], b, acc[1][nt]); }
    }
    float* dst = DELTA + (size_t)item * 32768;
#pragma unroll
    for (int mt = 0; mt < 2; ++mt)
#pragma unroll
        for (int nt = 0; nt < 8; ++nt)
#pragma unroll
            for (int j = 0; j < 4; ++j) dst[(32 * wid + 16 * mt + 4 * fq + j) * 128 + 16 * nt + fr] = acc[mt][nt][j];
    if (tid < 128) { float s = 0.f; for (int i = 0; i < 128; ++i) s += bf2f(*(const LAS unsigned short*)(KT + tid * MP + i * 2)); DN[(size_t)item * 128 + tid] = s; }
    __syncthreads();
}

__device__ __forceinline__ void mlstm_scan(LAS unsigned char* lds, const float* __restrict__ DELTA, const float* __restrict__ DN, const float* __restrict__ SC, float* MPREV, bfu* __restrict__ CT, float* __restrict__ NST,
                                           int tid, int gtid, int nthreads) {
    LAS float* fdec = (LAS float*)lds; LAS float* fin = fdec + 512; LAS float* mpv = fdec + 1024;
    if (tid < 4) { float m = 0.f;
        for (int c = 0; c < 128; ++c) { const int item = c * 4 + tid; const float mloc = SC[item], bl = SC[512 + item], mn = fmaxf(bl + m, mloc);
            mpv[tid * 128 + c] = m; fdec[tid * 128 + c] = __expf(bl + m - mn); fin[tid * 128 + c] = __expf(mloc - mn); m = mn; } }
    __syncthreads();
    for (int idx = gtid; idx < 4 * 32768 + 512; idx += nthreads) {
        const bool main_ = idx < 4 * 32768;
        const int h = main_ ? (idx >> 15) : ((idx - 4 * 32768) >> 7), rem = main_ ? (idx & 32767) : ((idx - 4 * 32768) & 127);
        const float* src = main_ ? DELTA + (size_t)h * 32768 + rem : DN + h * 128 + rem; const size_t sstride = main_ ? 4 * 32768 : 512;
        float C = 0.f; float d8[8], e8[8];
#pragma unroll
        for (int i = 0; i < 8; ++i) d8[i] = src[(size_t)i * sstride];
        for (int c0 = 0; c0 < 128; c0 += 8) {
            if (c0 + 8 < 128) {
#pragma unroll
                for (int i = 0; i < 8; ++i) e8[i] = src[(size_t)(c0 + 8 + i) * sstride];
            }
#pragma unroll
            for (int i = 0; i < 8; ++i) { const int c = c0 + i, item = c * 4 + h;
                if (main_) { CT[(size_t)item * 32768 + rem] = (bfu)f2bf(C); if (rem == 0) MPREV[item] = mpv[h * 128 + c]; } else NST[(size_t)item * 128 + rem] = C;
                C = fdec[h * 128 + c] * C + fin[h * 128 + c] * d8[i]; }
#pragma unroll
            for (int i = 0; i < 8; ++i) d8[i] = e8[i];
        }
    }
    __syncthreads();
}

__device__ __forceinline__ void mlstm_stage_c(LAS unsigned char* lds, const bfu* __restrict__ PROJ, const float* __restrict__ GATES, const bfu* __restrict__ QC, const bfu* __restrict__ KC,
                                              const bfu* __restrict__ CT, const float* __restrict__ NST, const float* __restrict__ MPREV, const float* __restrict__ hgain, bfu* Y, int item, const int mk_wave) {
    int lane = mk_lane(); asm volatile("" : "+v"(lane));
    const int wid = mk_wave & 7, tid = wid * 64 + lane, fr = lane & 15, fq = lane >> 4;
    const int h = item & 3, row0 = (item >> 2) * 128;
    LAS float* fa = (LAS float*)lds;
    LAS unsigned char* Qs = lds + 4096; LAS unsigned char* Ks = Qs + 128 * MP; LAS unsigned char* BUF = Ks + 128 * MP;
    if (tid < 128) { fa[768 + tid] = GATES[(size_t)(row0 + tid) * 8 + 4 + h]; fa[896 + tid] = GATES[(size_t)(row0 + tid) * 8 + h]; fa[640 + tid] = NST[(size_t)item * 128 + tid]; }
    __syncthreads();
    float bt_ = 0.f;
    if (tid < 128) { for (int s = 0; s <= tid; ++s) bt_ += fa[768 + s]; fa[tid] = fa[896 + tid] - bt_; }
    __syncthreads();
    if (tid < 128) { const float mp = MPREV[item]; float pm = -3.0e38f; for (int s = 0; s <= tid; ++s) pm = fmaxf(pm, fa[s]);
        const float M = fmaxf(mp, pm); fa[128 + tid] = M; fa[256 + tid] = __expf(mp - M); fa[384 + tid] = __expf(-(bt_ + M)); }
    for (int t = tid; t < 2048; t += NTHR) { const int r = t >> 4, c = t & 15;
        *(LAS v4u*)(Qs + r * MP + c * 16) = *(const v4u*)(QC + (size_t)(row0 + r) * 512 + h * 128 + c * 8);
        *(LAS v4u*)(Ks + r * MP + c * 16) = *(const v4u*)(KC + (size_t)(row0 + r) * 512 + h * 128 + c * 8); }
    for (int t = tid; t < 4096; t += NTHR) { const int r = t >> 4, c = t & 15; *(LAS v4u*)(BUF + r * MP + c * 16) = *(const v4u*)(CT + (size_t)item * 32768 + r * 128 + c * 8); }
    __syncthreads();
    {
        const int t = 16 * wid + fr; float s = 0.f;
#pragma unroll
        for (int i = 0; i < 32; ++i) s += bf2f(*(const LAS unsigned short*)(Qs + t * MP + (32 * fq + i) * 2)) * fa[640 + 32 * fq + i];
        s += __shfl_xor(s, 16); s += __shfl_xor(s, 32); if (fq == 0) fa[512 + t] = s;
    }
    f32x4 sa[8];
#pragma unroll
    for (int nt = 0; nt < 8; ++nt) sa[nt] = (f32x4){0.f, 0.f, 0.f, 0.f};
    bf16x8 qa[4];
#pragma unroll
    for (int ks = 0; ks < 4; ++ks) qa[ks] = *(const LAS bf16x8*)(Qs + (16 * wid + fr) * MP + (32 * ks + 8 * fq) * 2);
#pragma unroll
    for (int nt = 0; nt < 8; ++nt) if (nt <= wid) {
#pragma unroll
        for (int ks = 0; ks < 4; ++ks) { const bf16x8 b = *(const LAS bf16x8*)(Ks + (16 * nt + fr) * MP + (32 * ks + 8 * fq) * 2); sa[nt] = MFMA16(qa[ks], b, sa[nt]); } }
    float Mt[4], rsum[4];
#pragma unroll
    for (int j = 0; j < 4; ++j) { Mt[j] = fa[128 + 16 * wid + 4 * fq + j]; rsum[j] = 0.f; }
#pragma unroll
    for (int nt = 0; nt < 8; ++nt) { const int s = 16 * nt + fr; const float as = fa[s];
#pragma unroll
        for (int j = 0; j < 4; ++j) { const int t = 16 * wid + 4 * fq + j; const float p = (s <= t) ? sa[nt][j] * __expf(as - Mt[j]) : 0.f; sa[nt][j] = p; rsum[j] += p; } }
#pragma unroll
    for (int j = 0; j < 4; ++j) { float v = rsum[j]; v += __shfl_xor(v, 1); v += __shfl_xor(v, 2); v += __shfl_xor(v, 4); v += __shfl_xor(v, 8); rsum[j] = v; }
    f32x4 num[16];
#pragma unroll
    for (int nt = 0; nt < 16; ++nt) num[nt] = (f32x4){0.f, 0.f, 0.f, 0.f};
#pragma unroll
    for (int ks = 0; ks < 4; ++ks)
#pragma unroll
        for (int nt = 0; nt < 16; ++nt) { const bf16x8 b = *(const LAS bf16x8*)(BUF + (16 * nt + fr) * MP + (32 * ks + 8 * fq) * 2); num[nt] = MFMA16(qa[ks], b, num[nt]); if ((nt & 3) == 3) __builtin_amdgcn_sched_barrier(0); }
    float g4[4], den[4];
#pragma unroll
    for (int j = 0; j < 4; ++j) { const int t = 16 * wid + 4 * fq + j; g4[j] = fa[256 + t]; den[j] = fmaxf(fabsf(g4[j] * fa[512 + t] + rsum[j]), fa[384 + t]); }
#pragma unroll
    for (int nt = 0; nt < 16; ++nt)
#pragma unroll
        for (int j = 0; j < 4; ++j) num[nt][j] *= g4[j];
    __syncthreads();
#pragma unroll
    for (int nt = 0; nt < 8; ++nt)
#pragma unroll
        for (int j = 0; j < 4; ++j) *(LAS unsigned short*)(Ks + (16 * wid + 4 * fq + j) * MP + (16 * nt + fr) * 2) = (unsigned short)f2bf(sa[nt][j]);
    for (int task = tid; task < 4096; task += NTHR) {
        const int sidx = task & 127, e0 = (task >> 7) * 8;
        const v4u v = *(const v4u*)(PROJ + (size_t)(row0 + sidx) * PLD + C_MV + h * 256 + e0);
        LAS unsigned short* d = (LAS unsigned short*)(BUF + e0 * MP + sidx * 2);
        d[0 * (MP / 2)] = (unsigned short)(v.x & 0xffffu); d[1 * (MP / 2)] = (unsigned short)(v.x >> 16); d[2 * (MP / 2)] = (unsigned short)(v.y & 0xffffu); d[3 * (MP / 2)] = (unsigned short)(v.y >> 16);
        d[4 * (MP / 2)] = (unsigned short)(v.z & 0xffffu); d[5 * (MP / 2)] = (unsigned short)(v.z >> 16); d[6 * (MP / 2)] = (unsigned short)(v.w & 0xffffu); d[7 * (MP / 2)] = (unsigned short)(v.w >> 16);
    }
    __syncthreads();
#pragma unroll
    for (int ks = 0; ks < 4; ++ks) { const bf16x8 pa = *(const LAS bf16x8*)(Ks + (16 * wid + fr) * MP + (32 * ks + 8 * fq) * 2);
#pragma unroll
        for (int nt = 0; nt < 16; ++nt) { const bf16x8 b = *(const LAS bf16x8*)(BUF + (16 * nt + fr) * MP + (32 * ks + 8 * fq) * 2); num[nt] = MFMA16(pa, b, num[nt]); if ((nt & 3) == 3) __builtin_amdgcn_sched_barrier(0); } }
    float ssq[4];
#pragma unroll
    for (int j = 0; j < 4; ++j) { const float rd = 1.0f / den[j]; float s = 0.f;
#pragma unroll
        for (int nt = 0; nt < 16; ++nt) { const float v = num[nt][j] * rd; num[nt][j] = v; s += v * v; }
        s += __shfl_xor(s, 1); s += __shfl_xor(s, 2); s += __shfl_xor(s, 4); s += __shfl_xor(s, 8); ssq[j] = 1.0f / sqrtf(s * (1.0f / 256.0f) + 1e-6f); }
    __syncthreads();
    LAS float* HS = (LAS float*)(lds + 4096);
#pragma unroll
    for (int nt = 0; nt < 16; ++nt)
#pragma unroll
        for (int j = 0; j < 4; ++j) HS[(16 * wid + 4 * fq + j) * 260 + 16 * nt + fr] = num[nt][j] * ssq[j];
    __syncthreads();
    for (int task = tid; task < 4096; task += NTHR) {
        const int r = task >> 5, c8 = (task & 31) * 8; const size_t row = (size_t)(row0 + r);
        const f32x4 h0 = *(const LAS f32x4*)(HS + r * 260 + c8), h1 = *(const LAS f32x4*)(HS + r * 260 + c8 + 4);
        const f32x4 g0 = *(const f32x4*)(hgain + h * 256 + c8), g1 = *(const f32x4*)(hgain + h * 256 + c8 + 4);
        const v4u mo = *(const v4u*)(PROJ + row * PLD + C_MO + h * 256 + c8);
        v4u o;
        o.x = pk2(h0[0] * g0[0] / (1.0f + __expf(-bf2f(mo.x & 0xffffu))), h0[1] * g0[1] / (1.0f + __expf(-bf2f(mo.x >> 16))));
        o.y = pk2(h0[2] * g0[2] / (1.0f + __expf(-bf2f(mo.y & 0xffffu))), h0[3] * g0[3] / (1.0f + __expf(-bf2f(mo.y >> 16))));
        o.z = pk2(h1[0] * g1[0] / (1.0f + __expf(-bf2f(mo.z & 0xffffu))), h1[1] * g1[1] / (1.0f + __expf(-bf2f(mo.z >> 16))));
        o.w = pk2(h1[2] * g1[2] / (1.0f + __expf(-bf2f(mo.w & 0xffffu))), h1[3] * g1[3] / (1.0f + __expf(-bf2f(mo.w >> 16))));
        *(v4u*)(Y + row * DM + 1024 + h * 256 + c8) = o;
    }
    __syncthreads();
}

__device__ __forceinline__ att::BlockRef<att::bf16, att::bf16> att_ref(int i, int pass, const bfu* PROJ, bfu* OATT) {
    int ph, x;
    if (gridDim.x == 256) { ph = ((i >> 8) & 1) * 8 + (blockIdx.x & 7); x = blockIdx.x >> 3; }
    else { ph = (i >> 5) & 15; x = i & 31; }
    const int qb = pass ? 63 - x : x, h = ph >> 2, c = (ph >> 1) & 1, vh = ph & 1;
    att::BlockRef<att::bf16, att::bf16> r;
    constexpr size_t MSZ = (size_t)16384 * 128;
    r.Q = (const att::bf16*)(PROJ + (size_t)(2 * h + c) * MSZ + (size_t)qb * 256 * 128);
    r.K = (const att::bf16*)(PROJ + (size_t)(8 + 2 * h + c) * MSZ);
    r.V = (const att::bf16*)(PROJ + (size_t)(16 + 2 * h + vh) * MSZ);
    r.O = (att::bf16*)(OATT + (size_t)qb * 256 * 2048 + h * 512 + c * 256 + vh * 128);
    r.P0 = qb * 256;
    return r;
}
__device__ __forceinline__ void attn_phase(char* lds, const bfu* PROJ, bfu* OATT, const int TOTAL, const int mk_wave) {
    using namespace att;
    int i = blockIdx.x; if (i >= TOTAL) return;
    int pass = 0;
    BlockRef<bf16, bf16> cur = att_ref(i, 0, PROJ, OATT);
    Seam<bf16> S;
    causal_swa_prime<bf16, bf16>(cur, S_, lds, S, mk_wave);
    for (;;) {
        const bool more_pass = pass == 0, more_item = i + (int)gridDim.x < TOTAL, last = !more_pass && !more_item;
        int in_ = i, passn = pass + 1;
        if (!more_pass) { passn = 0; in_ = more_item ? i + (int)gridDim.x : i; }
        const BlockRef<bf16, bf16> nxt = last ? cur : att_ref(in_, passn, PROJ, OATT);
        causal_swa_block<bf16, bf16>(cur, nxt, S_, S_, lds, S, mk_wave);
        if (last) break;
        cur = nxt; i = in_; pass = passn;
    }
}

#ifndef ATTN2
#define ATTN2 5
#endif
__device__ __forceinline__ att::A2Ref att2_ref(int i, int pass, const bfu* PROJ, bfu* OATT) {
    int hc, x;
    if (gridDim.x == 256) { hc = blockIdx.x & 7; x = ((i >> 8) & 1) * 32 + (blockIdx.x >> 3); }
    else { hc = (i >> 6) & 7; x = i & 63; }
    const int qb = pass ? 127 - x : x, h = hc >> 1, c = hc & 1;
    constexpr size_t MSZ = (size_t)16384 * 128;
    att::A2Ref r;
    r.Q = (const att::bf16*)(PROJ + (size_t)(2 * h + c) * MSZ + (size_t)qb * 128 * 128);
    r.K = (const att::bf16*)(PROJ + (size_t)(8 + 2 * h + c) * MSZ);
    r.V0 = (const att::bf16*)(PROJ + (size_t)(16 + 2 * h) * MSZ); r.V1 = (const att::bf16*)(PROJ + (size_t)(16 + 2 * h + 1) * MSZ);
    r.O = (att::bf16*)(OATT + (size_t)qb * 128 * 2048 + h * 512 + c * 256);
    r.P0 = qb * 128;
    return r;
}
__device__ __forceinline__ void attn2_phase(char* lds, const bfu* PROJ, bfu* OATT, const int TOTAL, const int mk_wave) {
    for (int i = blockIdx.x; i < TOTAL; i += gridDim.x)
        for (int pass = 0; pass < 2; ++pass) { const att::A2Ref r = att2_ref(i, pass, PROJ, OATT); att::attn9_block(r, lds, (__attribute__((address_space(3))) unsigned char*)lds, mk_wave); }
}

__global__ void __launch_bounds__(NTHR, 2) mega_fwd(Args args) {
    extern __shared__ __attribute__((aligned(16))) unsigned char lds_raw[];
    LAS unsigned char* lds = (LAS unsigned char*)lds_raw;
    const int wave = __builtin_amdgcn_readfirstlane((int)threadIdx.x >> 6);
    const int G = gridDim.x, gw = blockIdx.x * NWAVES + wave, NGW = G * NWAVES;
#define AS4 __attribute__((address_space(4)))
#define PH_BEGIN int koff_ = 0; asm volatile("" : "+s"(koff_)); const AS4 char* kp_ = (const AS4 char*)__builtin_amdgcn_kernarg_segment_ptr() + koff_; \
    unsigned char* ws = *(unsigned char* const AS4*)(kp_ + 192); float* out = *(float* const AS4*)(kp_ + 184); (void)out; (void)ws; const int lane = mk_lane(), tid = wave * 64 + lane; (void)tid; (void)lane;
#define KIN(i) (*(const float* const AS4*)(kp_ + 8 * (i)))
#define Wgu ((bfu*)(ws + WS_WGU))
#define Wd ((bfu*)(ws + WS_WD))
#define Win ((bfu*)(ws + WS_WIN))
#define Wout ((bfu*)(ws + WS_WOUT))
#define XN ((bfu*)(ws + WS_XN))
#define BIG ((bfu*)(ws + WS_BIG))
#define Y ((bfu*)(ws + WS_Y))
#define CT ((bfu*)(ws + WS_CT))
#define QC ((bfu*)(ws + WS_QC))
#define KC ((bfu*)(ws + WS_KC))
#define NST ((float*)(ws + WS_NST))
#define rowss1 ((float*)(ws + WS_ROWSS1))
#define rowss2 ((float*)(ws + WS_ROWSS2))
#define SC ((float*)(ws + WS_SC))
#define DN ((float*)(ws + WS_DN))
#define GATES ((float*)(ws + WS_GATES))
#define DELTA ((float*)(ws + WS_XN))
#define OATT ((bfu*)(ws + WS_XN))
#define PROJM (BIG + (size_t)24 * 16384 * 128)
    const int lo = args.ph_lo, hi = args.ph_hi;
    if (hi - lo > 1) {
        if (wave == 0 && mk_lane() == 0) { volatile LAS unsigned* st = (volatile LAS unsigned*)(lds + LDS_BYTES - 64); st[0] = 0u; st[1] = 0u;
            (void)xb_add(&((unsigned*)(args.ws + WS_BAR))[XB_XCNT(xb_xcc_id())], 1u); }
        __syncthreads();
    }
#ifndef PHMASK
#define PHMASK 0xfff
#endif
#define IN(k) (((PHMASK >> (k)) & 1) && lo <= (k) && (k) < hi)
#ifndef PROBE_MASK
#define PROBE_MASK 0
#endif
#define NREP(k) (((PROBE_MASK >> (k)) & 1) ? 2 : 1)
#define STAGGER_DELAY(N) do { const int sn_ = (int)((blockIdx.x >> 3) & 3) * (N); for (int sd_ = 0; sd_ < sn_; ++sd_) __builtin_amdgcn_s_sleep(85); } while (0)
#define SYNC(k) do { if (IN(k) && IN((k) + 1)) { if (lo < 0) cg::this_grid().sync();     \
        { int kb_ = 0; asm volatile("" : "+s"(kb_)); unsigned char* wsb_ = *(unsigned char* const AS4*)((const AS4 char*)__builtin_amdgcn_kernarg_segment_ptr() + kb_ + 192); \
               xcd_barrier((unsigned*)(wsb_ + WS_BAR), (volatile LAS unsigned*)(lds + LDS_BYTES - 64), wave == 0 && mk_lane() == 0); \
               if ((PROBE_MASK >> 14) & 1) xcd_barrier((unsigned*)(wsb_ + WS_BAR), (volatile LAS unsigned*)(lds + LDS_BYTES - 64), wave == 0 && mk_lane() == 0); } } } while (0)

    if (IN(0)) for (int rep_ = 0; rep_ < NREP(0); ++rep_) { PH_BEGIN
        const float* x = KIN(0);
        LAS float* scr = (LAS float*)(lds + wave * 16640);
        constexpr int I_FFN = 3 * 2816, I_IN = 32 * 96, I_OUT = 32 * 32;
        for (int it = gw; it < I_FFN + I_IN + I_OUT; it += NGW) {
            if (it < I_FFN) cvt_ffn_item(it, KIN(2), KIN(3), KIN(4), KIN(1), Wgu, Wd, scr, lane);
            else if (it < I_FFN + I_IN) { const int r = it - I_FFN, kb = r / 96, nb = r % 96; cvt_item(KIN(6), NIN, NIN, KIN(5), Win, DM, nb * 64, kb * 64, nb * 64, scr, lane); }
            else { const int r = it - I_FFN - I_IN, kb = r / 32, nb = r % 32; cvt_item(KIN(17), DM, DM, nullptr, Wout, DM, nb * 64, kb * 64, nb * 64, scr, lane); }
        }
        for (int m = gw; m < S_; m += NGW) {
            const f32x4* xr = (const f32x4*)(x + (size_t)m * DM) + lane; f32x4 v[8]; float s = 0.f;
#pragma unroll
            for (int j = 0; j < 8; ++j) { v[j] = xr[64 * j]; s += (v[j][0] * v[j][0] + v[j][1] * v[j][1]) + (v[j][2] * v[j][2] + v[j][3] * v[j][3]); }
            const float rs = 1.0f / sqrtf(wave_sum(s) * (1.0f / DM) + 1e-6f);
            v2u* o8 = (v2u*)(XN + (size_t)m * DM) + lane;
#pragma unroll
            for (int j = 0; j < 8; ++j) { v2u w; w.x = pk2(v[j][0] * rs, v[j][1] * rs); w.y = pk2(v[j][2] * rs, v[j][3] * rs); o8[64 * j] = w; }
        }
        for (int i = blockIdx.x * NTHR + tid; i < 2 * S_; i += G * NTHR) rowss1[i] = 0.f;
        for (int k = blockIdx.x * NTHR + tid; k < DM + 8; k += G * NTHR) {
            unsigned char* gwp = ws + WS_GW; f32x4 w0 = (f32x4){0.f, 0.f, 0.f, 0.f}, w1 = w0;
            if (k < DM) { const float gk = KIN(5)[k]; w0 = *(const f32x4*)(KIN(6) + (size_t)k * NIN + 6144) * gk; w1 = *(const f32x4*)(KIN(6) + (size_t)k * NIN + 6148) * gk; }
#pragma unroll
            for (int j = 0; j < 4; ++j) { *(unsigned short*)(gwp + j * GWP + k * 2) = (unsigned short)f2bf(w0[j]); *(unsigned short*)(gwp + (4 + j) * GWP + k * 2) = (unsigned short)f2bf(w1[j]);
                *(unsigned short*)(gwp + (8 + j) * GWP + k * 2) = 0; *(unsigned short*)(gwp + (12 + j) * GWP + k * 2) = 0; }
        }
    }
    SYNC(0);
    if (IN(1)) { PH_BEGIN
        pg8::Gemm g{XN, Wgu, S_, 2 * FF, DM}; pg8::StaticOrder So; So.init(S_, 2 * FF, G, (int)blockIdx.x);
        pg8::EpiSwiGLU E{BIG, FF, nullptr, 0.f};
        STAGGER_DELAY(1); for (int rep_ = 0; rep_ < NREP(1); ++rep_) pg8::gemm_phase<pg8::EpiSwiGLU, pg8::StaticOrder, true, true>(lds, g, So, E, wave);
    }
    SYNC(1);
    if (IN(2)) { PH_BEGIN
        pg8::Gemm g{BIG, Wd, S_, DM, FF}; pg8::StaticOrder So; So.init(S_, DM, G, (int)blockIdx.x);
        pg8::EpiResid E{KIN(0), out, XN, rowss1, 0.5f, DM};
        STAGGER_DELAY(3); pg8::gemm_phase<pg8::EpiResid, pg8::StaticOrder, true, true>(lds, g, So, E, wave);
    }
    SYNC(2);
    if (IN(3)) { PH_BEGIN
        pg8::Gemm g{XN, Win, S_, NINP, DM}; pg8::StaticOrder So; So.init(S_, NINP, G, (int)blockIdx.x);
        pg8::EpiProj E{BIG, rowss1, 1.0f / DM};
        STAGGER_DELAY(1); for (int rep_ = 0; rep_ < NREP(3); ++rep_) pg8::gemm_phase<pg8::EpiProj, pg8::StaticOrder, true, true>(lds, g, So, E, wave);
        {
            const v4u* src = (const v4u*)(ws + WS_GW);
            for (int i = tid; i < 16 * GWP / 16; i += NTHR) *(LAS v4u*)(lds + 16384 + i * 16) = src[i];
            __syncthreads();
        }
        for (int rep_ = 0; rep_ < NREP(13); ++rep_) for (int rb = blockIdx.x; rb < S_ / 64; rb += G) gates_rows(lds, XN, rowss1, KIN(14), KIN(15), GATES, rb, wave, lane);
    }
    SYNC(3);
    if (IN(4)) { PH_BEGIN for (int item = blockIdx.x; item < 512 * NREP(4); item += G) mlstm_stage_a(lds, PROJM, GATES, KIN(12), KIN(13), QC, KC, DELTA, DN, SC, item & 511, wave); }
    SYNC(4);
    if (IN(5)) { PH_BEGIN for (int rep_ = 0; rep_ < NREP(5); ++rep_) mlstm_scan(lds, DELTA, DN, SC, SC + 1024, CT, NST, tid, blockIdx.x * NTHR + tid, G * NTHR); }
    SYNC(5);
    if (IN(6)) { PH_BEGIN
#ifndef NO_ATTN
#if ATTN2
        attn2_phase((char*)lds_raw, BIG, OATT, 512 * NREP(6), wave);
#else
        attn_phase((char*)lds_raw, BIG, OATT, 512 * NREP(6), wave);
#endif
#endif
        __syncthreads();
#ifndef NO_STAGEC
        for (int rep_ = 0; rep_ < NREP(12); ++rep_) for (int item = blockIdx.x; item < 512; item += G) mlstm_stage_c(lds, PROJM, GATES, QC, KC, CT, NST, SC + 1024, KIN(16), Y, item, wave);
#endif
    }
    SYNC(6);
    if (IN(7)) for (int rep_ = 0; rep_ < NREP(7); ++rep_) { PH_BEGIN
        const float l1 = wave_sum(KIN(7)[lane] * KIN(8)[lane] + KIN(7)[lane + 64] * KIN(8)[lane + 64]);
        const float l2 = wave_sum(KIN(9)[lane] * KIN(10)[lane] + KIN(9)[lane + 64] * KIN(10)[lane + 64]);
        const float lam = expf(l1) - expf(l2) + 0.2f;
        const float* hg = KIN(11);
        for (int m = gw; m < S_; m += NGW) {
#pragma unroll
            for (int h = 0; h < 4; ++h) {
                const v2u a = *((const v2u*)(OATT + (size_t)m * 2048 + h * 512) + lane), b = *((const v2u*)(OATT + (size_t)m * 2048 + h * 512 + 256) + lane);
                float y0 = bf2f(a.x & 0xffffu) - lam * bf2f(b.x & 0xffffu), y1 = bf2f(a.x >> 16) - lam * bf2f(b.x >> 16), y2 = bf2f(a.y & 0xffffu) - lam * bf2f(b.y & 0xffffu), y3 = bf2f(a.y >> 16) - lam * bf2f(b.y >> 16);
                const float rs = 0.8f / sqrtf(wave_sum((y0 * y0 + y1 * y1) + (y2 * y2 + y3 * y3)) * (1.0f / 256.0f) + 1e-6f);
                const f32x4 gn = *((const f32x4*)(hg + h * 256) + lane);
                v2u w; w.x = pk2(y0 * rs * gn[0], y1 * rs * gn[1]); w.y = pk2(y2 * rs * gn[2], y3 * rs * gn[3]);
                *((v2u*)(Y + (size_t)m * DM + h * 256) + lane) = w;
            }
        }
        LAS float* scr = (LAS float*)(lds + wave * 16640);
        for (int it = gw; it < 3 * 2816; it += NGW) cvt_ffn_item(it, KIN(19), KIN(20), KIN(21), KIN(18), Wgu, Wd, scr, lane);
    }
    SYNC(7);
    if (IN(8)) { PH_BEGIN
        pg8::Gemm g{Y, Wout, S_, DM, DM}; pg8::StaticOrder So; So.init(S_, DM, G, (int)blockIdx.x);
        pg8::EpiResid E{out, out, XN, rowss2, 1.0f, DM};
        STAGGER_DELAY(3); pg8::gemm_phase<pg8::EpiResid, pg8::StaticOrder, true, true>(lds, g, So, E, wave);
    }
    SYNC(8);
    if (IN(9)) { PH_BEGIN
        pg8::Gemm g{XN, Wgu, S_, 2 * FF, DM}; pg8::StaticOrder So; So.init(S_, 2 * FF, G, (int)blockIdx.x);
        pg8::EpiSwiGLU E{BIG, FF, rowss2, 1.0f / DM};
        STAGGER_DELAY(1); pg8::gemm_phase<pg8::EpiSwiGLU, pg8::StaticOrder, true, true>(lds, g, So, E, wave);
    }
    SYNC(9);
    if (IN(10)) { PH_BEGIN
        pg8::Gemm g{BIG, Wd, S_, DM, FF}; pg8::StaticOrder So; So.init(S_, DM, G, (int)blockIdx.x);
        pg8::EpiResid E{out, out, nullptr, nullptr, 0.5f, DM};
        STAGGER_DELAY(3); pg8::gemm_phase<pg8::EpiResid, pg8::StaticOrder, true, true>(lds, g, So, E, wave);
    }
    SYNC(10);
    if (IN(11)) { PH_BEGIN
        const float* fg = KIN(22);
        for (int m = gw; m < S_; m += NGW) {
            f32x4* xr = (f32x4*)(out + (size_t)m * DM) + lane; f32x4 v[8]; float s = 0.f;
#pragma unroll
            for (int j = 0; j < 8; ++j) { v[j] = xr[64 * j]; s += (v[j][0] * v[j][0] + v[j][1] * v[j][1]) + (v[j][2] * v[j][2] + v[j][3] * v[j][3]); }
            const float rs = 1.0f / sqrtf(wave_sum(s) * (1.0f / DM) + 1e-6f);
#pragma unroll
            for (int j = 0; j < 8; ++j) { const f32x4 gn = *((const f32x4*)fg + 64 * j + lane); xr[64 * j] = v[j] * rs * gn; }
        }
    }
#undef IN
#undef SYNC
}

extern "C" void kernel_launch(void* const* d_in, const int* in_sizes, int n_in, void* d_out, int out_size, void* d_ws, size_t ws_size, hipStream_t stream) {
    static int grid = 0;
    if (grid == 0) {
        if (n_in != 23 || in_sizes[0] != S_ * DM || out_size != S_ * DM || ws_size < WS_END) { fprintf(stderr, "kernel_launch: unexpected shapes (n_in %d, in0 %d, out %d, ws %zu)\n", n_in, n_in > 0 ? in_sizes[0] : -1, out_size, ws_size); grid = -1; return; }
        int dev = 0, cus = 0, per_cu = 0;
        (void)hipGetDevice(&dev); (void)hipDeviceGetAttribute(&cus, hipDeviceAttributeMultiprocessorCount, dev);
        if (hipFuncSetAttribute((const void*)mega_fwd, hipFuncAttributeMaxDynamicSharedMemorySize, LDS_BYTES) != hipSuccess) { fprintf(stderr, "kernel_launch: hipFuncSetAttribute failed\n"); grid = -1; return; }
        if (hipOccupancyMaxActiveBlocksPerMultiprocessor(&per_cu, (const void*)mega_fwd, NTHR, LDS_BYTES) != hipSuccess || per_cu < 1) per_cu = 1;
        grid = cus * per_cu;
        fprintf(stderr, "kernel_launch: grid %d (%d CUs x %d)\n", grid, cus, per_cu);
    }
    if (grid < 0) return;
    Args a{};
    for (int i = 0; i < 23; ++i) a.in[i] = (const float*)d_in[i];
    a.out = (float*)d_out; a.ws = (unsigned char*)d_ws;
#if MK_SPLIT
    for (int p = 0; p < NPH; ++p) { a.ph_lo = p; a.ph_hi = p + 1; hipLaunchKernelGGL(mega_fwd, dim3(grid), dim3(NTHR), LDS_BYTES, stream, a); }
#else
    a.ph_lo = 0; a.ph_hi = NPH;
    (void)hipMemsetAsync((char*)d_ws + WS_BAR, 0, XCD_BAR_WORDS * 4, stream);
    void* kargs[] = {&a};
    hipError_t e = hipLaunchCooperativeKernel((const void*)mega_fwd, dim3(grid), dim3(NTHR), kargs, LDS_BYTES, stream);
    if (e != hipSuccess) fprintf(stderr, "kernel_launch: cooperative launch failed: %s (grid %d)\n", hipGetErrorString(e), grid);
#endif
}
```

```cpp
#include <hip/hip_runtime.h>
#include <hip/hip_bf16.h>
#include <hip/hip_cooperative_groups.h>
#include <cstdio>
#include <cstdint>
namespace cg = cooperative_groups;

#ifndef MK_SPLIT
#define MK_SPLIT 0
#endif

namespace pg8 {
#define PG8_LAS __attribute__((address_space(3)))
typedef unsigned short bf16_t;
typedef short bf16x8 __attribute__((ext_vector_type(8)));
typedef float f32x4 __attribute__((ext_vector_type(4)));
typedef unsigned u32x4 __attribute__((ext_vector_type(4)));
constexpr int BM = 256, BK = 64, HALF = 128, HTB = HALF * BK * 2  , STAGE_BYTES = 8 * HTB, NXCD = 8, WGM = 8;

__host__ __device__ __forceinline__ int lds_byte(int r, int c) { const int st = (r >> 4) * 2 + (c >> 5), rr = r & 15, cc = c & 31, ob = rr * 64 + cc * 2; return st * 1024 + (ob ^ (((ob >> 9) & 1) << 5)); }
__host__ __device__ __forceinline__ void stage_rc(int b, int& R, int& C) { const int st = b / 1024, sb = b % 1024, swz = sb ^ (((sb >> 9) & 1) << 5); R = (st >> 1) * 16 + swz / 64; C = (st & 1) * 32 + (swz % 64) / 2; }
__host__ __device__ __forceinline__ int perm32(int rho) { const int n = rho >> 4, i = rho & 15; return 8 * (i >> 2) + 4 * n + (i & 3); }

struct Unit { int pm, pn; };
struct Gemm { const bf16_t* A; const bf16_t* Bt; int M, N, K; };

struct StaticOrder {
    int nM, nN, nwg, G, c;
    __host__ __device__ void init(int M, int N, int G_, int c_) { nM = M / BM; nN = N / BM; nwg = nM * nN; G = G_; c = c_; }
    __host__ __device__ bool next(int i, Unit& u) const {
        const long L = (long)i * G + c; if (L >= nwg) return false;
        int wgid = (int)L; { const int q = nwg / NXCD, r = nwg % NXCD, xcd = wgid % NXCD, off = wgid / NXCD; wgid = (xcd < r ? xcd * (q + 1) : r * (q + 1) + (xcd - r) * q) + off; }
        const int nig = WGM * nN, gid = wgid / nig, fm = gid * WGM, gsz = (nM - fm) < WGM ? (nM - fm) : WGM;
        u.pm = fm + ((wgid % nig) % gsz); u.pn = (wgid % nig) / gsz; return true;
    }
    __device__ __forceinline__ void a_ready(const Unit&) const {}
    __device__ __forceinline__ void done(const Unit&) const {}
};

__device__ __forceinline__ unsigned cvt_pk_bf16(float lo, float hi) { unsigned r; asm volatile("v_cvt_pk_bf16_f32 %0, %1, %2" : "=v"(r) : "v"(lo), "v"(hi)); return r; }

constexpr float RMS_EPS = 1e-6f;
__device__ __forceinline__ float silu_f(float x) { return x * __builtin_amdgcn_rcpf(1.0f + __builtin_amdgcn_exp2f(-1.4426950408889634f * x)); }
struct EpiSwiGLU {
    static constexpr bool PERM = true, AFTER_DRAIN = false;
    bf16_t* O; int ldo; const float* rowss; float inv_n;
    __device__ __forceinline__ void operator()(const f32x4 (&acc)[2][2][4][2], const Unit& u, int wr, int wc, int fr, int fq) const {
        const int row0 = u.pm * BM + wr * 64 + fr, col0 = u.pn * HALF + wc * 32 + 8 * fq;
#pragma unroll
        for (int ai = 0; ai < 2; ++ai)
#pragma unroll
            for (int m = 0; m < 4; ++m) {
                const int r = row0 + ai * HALF + m * 16;
                const float rs = rowss ? __builtin_amdgcn_rsqf(rowss[r] * inv_n + RMS_EPS) : 1.0f;
                const f32x4 g0 = acc[ai][0][m][0] * rs, g1 = acc[ai][0][m][1] * rs, u0 = acc[ai][1][m][0] * rs, u1 = acc[ai][1][m][1] * rs;
                u32x4 w;
                w.x = cvt_pk_bf16(silu_f(g0[0]) * u0[0], silu_f(g0[1]) * u0[1]); w.y = cvt_pk_bf16(silu_f(g0[2]) * u0[2], silu_f(g0[3]) * u0[3]);
                w.z = cvt_pk_bf16(silu_f(g1[0]) * u1[0], silu_f(g1[1]) * u1[1]); w.w = cvt_pk_bf16(silu_f(g1[2]) * u1[2], silu_f(g1[3]) * u1[3]);
                *(u32x4*)(O + (size_t)r * ldo + col0) = w;
            }
    }
};
struct EpiResid {
    static constexpr bool PERM = false, AFTER_DRAIN = false;
    const float* resid; float* out; bf16_t* xb; float* rowss; float alpha; int ld;
    __device__ __forceinline__ void operator()(const f32x4 (&acc)[2][2][4][2], const Unit& u, int wr, int wc, int fr, int fq) const {
        typedef unsigned u32x2v __attribute__((ext_vector_type(2)));
        const int row0 = u.pm * BM + wr * 64 + fr, col0 = u.pn * BM + wc * 32 + 4 * fq;
#pragma unroll
        for (int ai = 0; ai < 2; ++ai)
#pragma unroll
            for (int m = 0; m < 4; ++m) {
                const int r = row0 + ai * HALF + m * 16; float ss = 0.f;
#pragma unroll
                for (int bj = 0; bj < 2; ++bj)
#pragma unroll
                    for (int n = 0; n < 2; ++n) {
                        const size_t off = (size_t)r * ld + col0 + bj * HALF + n * 16;
                        const f32x4 b = *(const f32x4*)(resid + off); const f32x4 o = b + acc[ai][bj][m][n] * alpha;
                        *(f32x4*)(out + off) = o; ss += (o[0] * o[0] + o[1] * o[1]) + (o[2] * o[2] + o[3] * o[3]);
                        if (xb) { u32x2v w; w.x = cvt_pk_bf16(o[0], o[1]); w.y = cvt_pk_bf16(o[2], o[3]); *(u32x2v*)(xb + off) = w; }
                    }
                if (rowss) { ss += __shfl_xor(ss, 16); ss += __shfl_xor(ss, 32); if (fq == 0) atomicAdd(rowss + r, ss); }
            }
    }
};
struct EpiProj {
    static constexpr bool PERM = true, AFTER_DRAIN = false;
    bf16_t* O; const float* rowss; float inv_n;
    __device__ __forceinline__ void operator()(const f32x4 (&acc)[2][2][4][2], const Unit& u, int wr, int wc, int fr, int fq) const {
        const int row0 = u.pm * BM + wr * 64 + fr;
        {
            const bool dense = u.pn < 12;
            const size_t rstride = dense ? 128 : 3072;
            bf16_t* base = dense ? O + (size_t)(2 * u.pn) * ((size_t)16384 * 128) + wc * 32 + 8 * fq : O + (size_t)24 * 16384 * 128 + (u.pn - 12) * BM + wc * 32 + 8 * fq;
            const size_t bjstep = dense ? (size_t)16384 * 128 : 128;
#pragma unroll
            for (int ai = 0; ai < 2; ++ai)
#pragma unroll
                for (int m = 0; m < 4; ++m) {
                    const int r = row0 + ai * HALF + m * 16; const float rs = __builtin_amdgcn_rsqf(rowss[r] * inv_n + RMS_EPS);
#pragma unroll
                    for (int bj = 0; bj < 2; ++bj) { const f32x4 v0 = acc[ai][bj][m][0] * rs, v1 = acc[ai][bj][m][1] * rs; u32x4 w;
                        w.x = cvt_pk_bf16(v0[0], v0[1]); w.y = cvt_pk_bf16(v0[2], v0[3]); w.z = cvt_pk_bf16(v1[0], v1[1]); w.w = cvt_pk_bf16(v1[2], v1[3]);
                        *(u32x4*)(base + (size_t)r * rstride + bj * bjstep) = w; }
                }
        }
    }
};
template <class Epi, class Sched, bool ALIGN_EPI = false, bool SP2 = false>
__device__ __forceinline__ void gemm_phase(PG8_LAS unsigned char* lds, const Gemm g, const Sched& S, const Epi& E, const int mk_wave) {
    const int lane = (int)(__builtin_amdgcn_mbcnt_hi(~0u, __builtin_amdgcn_mbcnt_lo(~0u, 0u)) & 63u), wid = mk_wave & 7, tid = wid * 64 + lane, wr = wid >> 2, wc = wid & 3, fr = lane & 15, fq = lane >> 4;
    const int K = g.K, nt = K / BK;
    unsigned voffA[2], voffB[2];
#pragma unroll
    for (int i = 0; i < 2; ++i) { int R, C; stage_rc(tid * 16 + i * 8192, R, C); const int Rb = Epi::PERM ? ((R & ~31) + perm32(R & 31)) : R;
        voffA[i] = (unsigned)(R * K + C) * 2u; voffB[i] = (unsigned)(Rb * K + C) * 2u; }
    const size_t kstep = (size_t)(BK * 2);
    const size_t hstep = (size_t)HALF * K * 2;
    const size_t tstep = 2 * hstep;
    const unsigned ldsw = (unsigned)wid * 1024u;
    const int aoff = lds_byte(wr * 64 + fr, fq * 8), boff = lds_byte(wc * 32 + fr, fq * 8);
#define PG8_SA(b, h) (((b) * 2 + (h)) * HTB)
#define PG8_SB(b, h) ((4 + (b) * 2 + (h)) * HTB)
#define PG8_STAGE(bufoff, gbase, voff) do { _Pragma("unroll") for (int _i = 0; _i < 2; ++_i) \
        __builtin_amdgcn_global_load_lds((const unsigned*)((const char*)(gbase) + (voff)[_i]), (PG8_LAS unsigned*)(lds + (bufoff) + ldsw + _i * 8192), 16, 0, 0); } while (0)
#define PG8_LDA(dst, b, h) do { _Pragma("unroll") for (int m = 0; m < 4; ++m) _Pragma("unroll") for (int k = 0; k < 2; ++k) dst[m][k] = *(const PG8_LAS bf16x8*)(lds + PG8_SA(b, h) + aoff + m * 2048 + k * 1024); } while (0)
#define PG8_LDB(dst, b, h) do { _Pragma("unroll") for (int n = 0; n < 2; ++n) _Pragma("unroll") for (int k = 0; k < 2; ++k) dst[n][k] = *(const PG8_LAS bf16x8*)(lds + PG8_SB(b, h) + boff + n * 2048 + k * 1024); } while (0)
#define PG8_MMA(ai, bj, At, Bt) do { __builtin_amdgcn_s_setprio(1); _Pragma("unroll") for (int m = 0; m < 4; ++m) _Pragma("unroll") for (int n = 0; n < 2; ++n) _Pragma("unroll") for (int k = 0; k < 2; ++k) \
        acc[ai][bj][m][n] = __builtin_amdgcn_mfma_f32_16x16x32_bf16(Bt[n][k], At[m][k], acc[ai][bj][m][n], 0, 0, 0); __builtin_amdgcn_s_setprio(0); } while (0)
#define PG8_WAIT_V(n) asm volatile("s_waitcnt vmcnt(" #n ")" ::: "memory")
#define PG8_WAIT_L(n) asm volatile("s_waitcnt lgkmcnt(" #n ")" ::: "memory")
#define PG8_BAR __builtin_amdgcn_s_barrier()
#define PG8_SCHED __builtin_amdgcn_sched_barrier(0)
    Unit cur, nxt; int ui = 0;
    if (!S.next(0, cur)) return;
    f32x4 acc[2][2][4][2];
#pragma unroll
    for (int a = 0; a < 2; ++a)
#pragma unroll
        for (int b = 0; b < 2; ++b)
#pragma unroll
            for (int m = 0; m < 4; ++m)
#pragma unroll
                for (int n = 0; n < 2; ++n) acc[a][b][m][n] = (f32x4){0.f, 0.f, 0.f, 0.f};
    bf16x8 At[4][2], B0[2][2], B1[2][2];
    const char* cA = (const char*)g.A + (size_t)cur.pm * tstep; const char* cB = (const char*)g.Bt + (size_t)cur.pn * tstep;
    S.a_ready(cur);
    if constexpr (SP2) {
        PG8_STAGE(PG8_SB(0, 0), cB, voffB); PG8_STAGE(PG8_SB(0, 1), cB + hstep, voffB); PG8_STAGE(PG8_SA(0, 0), cA, voffA); PG8_STAGE(PG8_SA(0, 1), cA + hstep, voffA);
        if (wr == 1) PG8_BAR;
        PG8_WAIT_V(2); PG8_BAR;
        PG8_STAGE(PG8_SB(1, 0), cB + kstep, voffB); PG8_STAGE(PG8_SA(1, 0), cA + kstep, voffA); PG8_STAGE(PG8_SB(1, 1), cB + hstep + kstep, voffB);
        PG8_WAIT_V(6); PG8_BAR;
    } else {
        PG8_STAGE(PG8_SB(0, 0), cB, voffB); PG8_STAGE(PG8_SA(0, 0), cA, voffA); PG8_STAGE(PG8_SB(0, 1), cB + hstep, voffB); PG8_STAGE(PG8_SA(0, 1), cA + hstep, voffA);
        if (wr == 1) PG8_BAR;
        PG8_WAIT_V(4); PG8_BAR;
        PG8_STAGE(PG8_SB(1, 0), cB + kstep, voffB); PG8_STAGE(PG8_SA(1, 0), cA + kstep, voffA); PG8_STAGE(PG8_SB(1, 1), cB + hstep + kstep, voffB);
        PG8_WAIT_V(6); PG8_BAR;
    }
    for (;;) {
        const bool has_next = S.next(ui + 1, nxt);
        const char* nA = has_next ? (const char*)g.A + (size_t)nxt.pm * tstep : cA; const char* nB = has_next ? (const char*)g.Bt + (size_t)nxt.pn * tstep : cB;
        for (int t = 0; t < nt; t += 2) {
            const bool last = (t == nt - 2);
            const char* a1 = cA + (size_t)(t + 1) * kstep;
            const char* a2 = last ? nA : cA + (size_t)(t + 2) * kstep; const char* b2 = last ? nB : cB + (size_t)(t + 2) * kstep;
            const char* a3 = a2 + kstep; const char* b3 = b2 + kstep;
            if (last && has_next) S.a_ready(nxt);
            if constexpr (SP2) {
            PG8_LDB(B0, 0, 0); PG8_LDB(B1, 0, 1); PG8_SCHED; PG8_LDA(At, 0, 0); PG8_STAGE(PG8_SA(1, 1), a1 + hstep, voffA);
            PG8_WAIT_V(8); PG8_WAIT_L(0); PG8_BAR; PG8_MMA(0, 0, At, B0); PG8_MMA(0, 1, At, B1); PG8_BAR; PG8_SCHED;
            PG8_LDA(At, 0, 1); PG8_STAGE(PG8_SB(0, 0), b2, voffB); PG8_STAGE(PG8_SB(0, 1), b2 + hstep, voffB); PG8_STAGE(PG8_SA(0, 0), a2, voffA);
            PG8_WAIT_V(8); PG8_WAIT_L(0); PG8_BAR; PG8_MMA(1, 0, At, B0); PG8_MMA(1, 1, At, B1); PG8_BAR; PG8_SCHED;
            PG8_LDB(B0, 1, 0); PG8_LDB(B1, 1, 1); PG8_SCHED; PG8_LDA(At, 1, 0); PG8_STAGE(PG8_SA(0, 1), a2 + hstep, voffA);
            PG8_WAIT_V(8); PG8_WAIT_L(0); PG8_BAR; PG8_MMA(0, 0, At, B0); PG8_MMA(0, 1, At, B1); PG8_BAR; PG8_SCHED;
            PG8_LDA(At, 1, 1); PG8_STAGE(PG8_SB(1, 0), b3, voffB); PG8_STAGE(PG8_SB(1, 1), b3 + hstep, voffB); PG8_STAGE(PG8_SA(1, 0), a3, voffA);
            PG8_WAIT_V(8); PG8_WAIT_L(0); PG8_BAR; PG8_MMA(1, 0, At, B0); PG8_MMA(1, 1, At, B1); PG8_BAR; PG8_SCHED;
            } else {
            PG8_LDB(B0, 0, 0); PG8_SCHED; PG8_LDA(At, 0, 0); PG8_STAGE(PG8_SA(1, 1), a1 + hstep, voffA);
            PG8_WAIT_L(8); PG8_BAR; PG8_WAIT_L(0); PG8_MMA(0, 0, At, B0); PG8_BAR; PG8_SCHED;
            PG8_LDB(B1, 0, 1); PG8_STAGE(PG8_SB(0, 0), b2, voffB);
            PG8_BAR; PG8_WAIT_L(0); PG8_MMA(0, 1, At, B1); PG8_BAR;
            PG8_LDA(At, 0, 1); PG8_STAGE(PG8_SA(0, 0), a2, voffA);
            PG8_BAR; PG8_WAIT_L(0); PG8_MMA(1, 0, At, B0); PG8_BAR; PG8_SCHED;
            PG8_STAGE(PG8_SB(0, 1), b2 + hstep, voffB);
            PG8_WAIT_V(6); PG8_BAR; PG8_MMA(1, 1, At, B1); PG8_BAR;
            PG8_LDB(B0, 1, 0); PG8_SCHED; PG8_LDA(At, 1, 0); PG8_STAGE(PG8_SA(0, 1), a2 + hstep, voffA);
            PG8_WAIT_L(8); PG8_BAR; PG8_WAIT_L(0); PG8_MMA(0, 0, At, B0); PG8_BAR; PG8_SCHED;
            PG8_LDB(B1, 1, 1); PG8_STAGE(PG8_SB(1, 0), b3, voffB);
            PG8_BAR; PG8_WAIT_L(0); PG8_MMA(0, 1, At, B1); PG8_BAR;
            PG8_LDA(At, 1, 1); PG8_STAGE(PG8_SA(1, 0), a3, voffA);
            PG8_BAR; PG8_WAIT_L(0); PG8_MMA(1, 0, At, B0); PG8_BAR; PG8_SCHED;
            PG8_STAGE(PG8_SB(1, 1), b3 + hstep, voffB);
            PG8_WAIT_V(6); PG8_BAR; PG8_MMA(1, 1, At, B1); PG8_BAR;
            }
        }
        if constexpr (ALIGN_EPI) { if (wr == 0) PG8_BAR; }
        if constexpr (!Epi::AFTER_DRAIN) { E(acc, cur, wr, wc, fr, fq); S.done(cur); }
        if (!has_next) break;
#pragma unroll
        for (int a = 0; a < 2; ++a)
#pragma unroll
            for (int b = 0; b < 2; ++b)
#pragma unroll
                for (int m = 0; m < 4; ++m)
#pragma unroll
                    for (int n = 0; n < 2; ++n) acc[a][b][m][n] = (f32x4){0.f, 0.f, 0.f, 0.f};
        cur = nxt; cA = nA; cB = nB; ++ui;
        if constexpr (ALIGN_EPI) { if (wr == 1) PG8_BAR; }
    }
    PG8_WAIT_V(0);
    if constexpr (!ALIGN_EPI) { if (wr == 0) PG8_BAR; }
    PG8_BAR;
    if constexpr (Epi::AFTER_DRAIN) { E.fused(acc, cur, wr, wc, fr, fq, lds, wid, lane); S.done(cur); }
#undef PG8_SA
#undef PG8_SB
#undef PG8_STAGE
#undef PG8_LDA
#undef PG8_LDB
#undef PG8_MMA
#undef PG8_WAIT_V
#undef PG8_WAIT_L
#undef PG8_BAR
#undef PG8_SCHED
}
}

namespace att {
constexpr int D = 128; constexpr float THR = 8.f; constexpr bool WSKIP = false; constexpr int LDP = 128, LDO = 2048;
constexpr float SCALE = 0.08838834764831845f;
constexpr int NW = 8, QBLK = 32, KVBLK = 64, QB = NW * QBLK;
constexpr int SHM_V = KVBLK * D * 2, SHM_K = KVBLK * D * 2;
constexpr int LDS_BYTES = 2 * SHM_V + 2 * SHM_K + NW * 64 * 4;

using bf16 = __hip_bfloat16;
typedef short bf16x8 __attribute__((ext_vector_type(8)));
typedef short s16x4 __attribute__((ext_vector_type(4)));
typedef float f32x16 __attribute__((ext_vector_type(16)));
typedef float f32x4 __attribute__((ext_vector_type(4)));
typedef unsigned u32x4 __attribute__((ext_vector_type(4)));
template <class A, class Bt> struct same_t { static constexpr bool v = false; };
template <class A> struct same_t<A, A> { static constexpr bool v = true; };

#define KSWZ(row, colB) ((row) * 256 + ((colB) ^ (((row) & 7) << 4)))
#define SBAR() __builtin_amdgcn_sched_barrier(0)
__device__ __forceinline__ int v_st(int k, int c) { const int kk = (k & ~0xC) | ((k & 4) << 1) | ((k & 8) >> 1); return ((kk >> 3) * 4 + (c >> 5)) * 512 + ((kk & 7) * 32 + (c & 31)) * 2; }
__device__ __forceinline__ int v_rd_base(int lane) { return ((lane & 3) << 3) | (((lane >> 2) & 3) << 6) | (((lane >> 4) & 1) << 5) | (((lane >> 5) & 1) << 8); }
constexpr int v_rd_off(int d0, int ks, int half) { return d0 * 512 + ks * 4096 + half * 2048; }
__device__ __forceinline__ int crow(int r, int hi) { return (r & 3) + 8 * (r >> 2) + 4 * hi; }
__device__ __forceinline__ unsigned cvtpk(float lo, float hi) {
    unsigned r; asm volatile("v_cvt_pk_bf16_f32 %0, %1, %2" : "=v"(r) : "v"(lo), "v"(hi)); return r;
}
__device__ __forceinline__ bf16x8 pack8(f32x4 a, f32x4 b) {
    u32x4 w = {cvtpk(a[0], a[1]), cvtpk(a[2], a[3]), cvtpk(b[0], b[1]), cvtpk(b[2], b[3])};
    return *reinterpret_cast<bf16x8*>(&w);
}
template <class T> __device__ __forceinline__ bf16x8 load8(const T* p) {
    if constexpr (same_t<T, float>::v) { return pack8(*(const f32x4*)p, *(const f32x4*)(p + 4)); }
    else { return *reinterpret_cast<const bf16x8*>(p); }
}
__device__ __forceinline__ void mask_tile(f32x16& p0, f32x16& p1, int dq, unsigned W) {
    const float NEG = -__builtin_inff();
#pragma unroll
    for (int r = 0; r < 16; ++r) {
        const int c = (r & 3) + 8 * (r >> 2);
        if ((unsigned)(dq - c) >= W) p0[r] = NEG;
        if ((unsigned)(dq - c - 32) >= W) p1[r] = NEG;
    }
}
__device__ __forceinline__ void partialSM(f32x16& p0, f32x16& p1, float& m_reg, float& mn, float& alpha) {
    float pmax = p0[0]; for (int r = 1; r < 16; ++r) pmax = fmaxf(pmax, p0[r]); for (int r = 0; r < 16; ++r) pmax = fmaxf(pmax, p1[r]);
    { auto rr = __builtin_amdgcn_permlane32_swap(__float_as_uint(pmax), __float_as_uint(pmax), false, false);
      pmax = fmaxf(__uint_as_float(rr[0]), __uint_as_float(rr[1])); }
    constexpr float C2 = 1.4426950408889634f * SCALE;
    if (__builtin_expect(__all((pmax - m_reg) * SCALE <= THR), 1)) { mn = m_reg; alpha = 1.f; }
    else { mn = fmaxf(m_reg, pmax); alpha = __builtin_amdgcn_exp2f((m_reg - mn) * C2); m_reg = mn; }
    const float mnL = -mn * C2;
    for (int r = 0; r < 16; ++r) p0[r] = fmaf(p0[r], C2, mnL); for (int r = 0; r < 16; ++r) p1[r] = fmaf(p1[r], C2, mnL);
    for (int r = 0; r < 16; ++r) p0[r] = __builtin_amdgcn_exp2f(p0[r]);
}
__device__ __forceinline__ void finishSM(f32x16& p0, f32x16& p1, float alpha, float& l_reg, bf16x8& pa0, bf16x8& pa1, bf16x8& pa2, bf16x8& pa3) {
    for (int r = 0; r < 16; ++r) p1[r] = __builtin_amdgcn_exp2f(p1[r]);
    float ps = 0; for (int r = 0; r < 16; ++r) ps += p0[r]; for (int r = 0; r < 16; ++r) ps += p1[r];
    { auto rr = __builtin_amdgcn_permlane32_swap(__float_as_uint(ps), __float_as_uint(ps), false, false);
      ps = __uint_as_float(rr[0]) + __uint_as_float(rr[1]); }
    l_reg = l_reg * alpha + ps;
#define PK4(P, B_, OUT) do { unsigned a0 = cvtpk(P[B_+0], P[B_+1]), a1 = cvtpk(P[B_+2], P[B_+3]);                          \
        unsigned b0 = cvtpk(P[B_+4], P[B_+5]), b1 = cvtpk(P[B_+6], P[B_+7]);                                             \
        auto r0 = __builtin_amdgcn_permlane32_swap(a0, b0, false, false); auto r1 = __builtin_amdgcn_permlane32_swap(a1, b1, false, false); \
        u32x4 w = {r0[0], r1[0], r0[1], r1[1]}; OUT = *reinterpret_cast<bf16x8*>(&w); } while (0)
    PK4(p0, 0, pa0); PK4(p0, 8, pa1); PK4(p1, 0, pa2); PK4(p1, 8, pa3);
#undef PK4
}
template <int KB, bool SK>
__device__ __forceinline__ void qkt(f32x16& p0, f32x16& p1, const char* K_lds, int r32, int hi, const bf16x8* qr, bool act) {
    if (SK && !act) { const float NEG = -__builtin_inff();
#pragma unroll
        for (int r = 0; r < 16; ++r) { p0[r] = NEG; p1[r] = NEG; } return; }
    p0 = f32x16{}; p1 = f32x16{};
    const char* kb[4];
#pragma unroll
    for (int dd = 0; dd < 4; ++dd) kb[dd] = K_lds + KB * SHM_K + KSWZ(r32, (dd * 16 + hi * 8) * 2);
#pragma unroll
    for (int d0 = 0; d0 < 8; ++d0) { const char* a = kb[d0 & 3] + (d0 >> 2) * 128;
        bf16x8 b0 = *reinterpret_cast<const bf16x8*>(a);
        bf16x8 b1 = *reinterpret_cast<const bf16x8*>(a + 32 * 256);
        p0 = __builtin_amdgcn_mfma_f32_32x32x16_bf16(b0, qr[d0], p0, 0, 0, 0);
        p1 = __builtin_amdgcn_mfma_f32_32x32x16_bf16(b1, qr[d0], p1, 0, 0, 0); }
}
template <int VB, bool SK>
__device__ __forceinline__ void pv_tile(f32x16* o, int vb0, bf16x8 pa0, bf16x8 pa1, bf16x8 pa2, bf16x8 pa3, bool act) {
    if (SK && !act) return;
#define TRRD(dst, off) asm volatile("ds_read_b64_tr_b16 %0, %1 offset:%2" : "=&v"(dst) : "v"(vb0), "i"(off) : "memory")
#define PV_D0(d0) do { s16x4 l0, l1, l2, l3, h0, h1, h2, h3; constexpr int b_ = VB * SHM_V + v_rd_off(d0, 0, 0);     \
        TRRD(l0, b_); TRRD(h0, b_ + 2048); TRRD(l1, b_ + 4096); TRRD(h1, b_ + 6144); TRRD(l2, b_ + 8192); TRRD(h2, b_ + 10240); TRRD(l3, b_ + 12288); TRRD(h3, b_ + 14336); \
        asm volatile("s_waitcnt lgkmcnt(0)" ::: "memory"); SBAR();                 \
        o[d0] = __builtin_amdgcn_mfma_f32_32x32x16_bf16(pa0, (bf16x8){l0[0], l0[1], l0[2], l0[3], h0[0], h0[1], h0[2], h0[3]}, o[d0], 0, 0, 0);   \
        o[d0] = __builtin_amdgcn_mfma_f32_32x32x16_bf16(pa1, (bf16x8){l1[0], l1[1], l1[2], l1[3], h1[0], h1[1], h1[2], h1[3]}, o[d0], 0, 0, 0);   \
        o[d0] = __builtin_amdgcn_mfma_f32_32x32x16_bf16(pa2, (bf16x8){l2[0], l2[1], l2[2], l2[3], h2[0], h2[1], h2[2], h2[3]}, o[d0], 0, 0, 0);   \
        o[d0] = __builtin_amdgcn_mfma_f32_32x32x16_bf16(pa3, (bf16x8){l3[0], l3[1], l3[2], l3[3], h3[0], h3[1], h3[2], h3[3]}, o[d0], 0, 0, 0); } while (0)
    PV_D0(0); PV_D0(1); PV_D0(2); PV_D0(3);
#undef PV_D0
#undef TRRD
}

template <class TIn, class TOut> struct BlockRef { const TIn* Q; const TIn* K; const TIn* V; TOut* O; int P0; };
template <class TIn> struct Seam {
    bf16x8 qr[8];
    bf16x8 st_v0, st_v1, st_k0, st_k1; f32x4 sf0, sf1, sf2, sf3;
    f32x4 tq[16];
};
__device__ __forceinline__ int swa_jlo(int P0, int W) { const int lowk = P0 - W + 1; return lowk > 0 ? lowk / KVBLK : 0; }
#define ROW(p, k0, rr) ((p) + (size_t)((k0) + (rr)) * LDP + sc)
#define VMW() asm volatile("s_waitcnt vmcnt(0)" ::: "memory")
#define VMWN(n) asm volatile("s_waitcnt vmcnt(%0)" :: "i"(n) : "memory")
#define SLOAD_H(Kp, Vp, k0) do { S.st_v0 = load8<TIn>(ROW(Vp, k0, sr)); S.st_v1 = load8<TIn>(ROW(Vp, k0, 32 + sr));              \
                         S.st_k0 = load8<TIn>(ROW(Kp, k0, sr)); S.st_k1 = load8<TIn>(ROW(Kp, k0, 32 + sr)); } while (0)
#define SWRITE_HK(bf) do { *(bf16x8*)(K_lds + (bf) * SHM_K + kws) = S.st_k0; *(bf16x8*)(K_lds + (bf) * SHM_K + kws + 32 * 256) = S.st_k1; } while (0)
#define SWRITE_HV(bf) do { *(bf16x8*)(V_lds + (bf) * SHM_V + vst0) = S.st_v0; *(bf16x8*)(V_lds + (bf) * SHM_V + vst1) = S.st_v1; } while (0)
#define SWRITE_H(bf) do { SWRITE_HV(bf); SWRITE_HK(bf); } while (0)
#define SLOAD_F(p, k0) do { S.sf0 = *(const f32x4*)ROW(p, k0, sr); S.sf1 = *(const f32x4*)(ROW(p, k0, sr) + 4);                \
                            S.sf2 = *(const f32x4*)ROW(p, k0, 32 + sr); S.sf3 = *(const f32x4*)(ROW(p, k0, 32 + sr) + 4); } while (0)
#define SWRITE_KF(bf) do { *(bf16x8*)(K_lds + (bf) * SHM_K + kws) = pack8(S.sf0, S.sf1); *(bf16x8*)(K_lds + (bf) * SHM_K + kws + 32 * 256) = pack8(S.sf2, S.sf3); } while (0)
#define SWRITE_VF(bf) do { *(bf16x8*)(V_lds + (bf) * SHM_V + vst0) = pack8(S.sf0, S.sf1); *(bf16x8*)(V_lds + (bf) * SHM_V + vst1) = pack8(S.sf2, S.sf3); } while (0)
template <class TIn, class TOut>
__device__ __forceinline__ void causal_swa_prime(const BlockRef<TIn, TOut>& cur, int W, char* lds, Seam<TIn>& S, const int mk_wave) {
    constexpr bool F32 = same_t<TIn, float>::v;
    const int lane = (int)(__builtin_amdgcn_mbcnt_hi(~0u, __builtin_amdgcn_mbcnt_lo(~0u, 0u)) & 63u), wid = mk_wave & 7, tid = wid * 64 + lane, r32 = lane & 31, hi = lane >> 5;
    const int sr = tid >> 4, sc = (tid & 15) * 8, kws = KSWZ(sr, sc * 2); char* K_lds = lds + 2 * SHM_V;
    const int kb0 = swa_jlo(cur.P0, W) * KVBLK;
    for (int d0 = 0; d0 < 8; ++d0) S.qr[d0] = load8<TIn>(cur.Q + (size_t)(wid * QBLK + r32) * LDP + d0 * 16 + hi * 8);
    if constexpr (F32) { SLOAD_F((const float*)cur.K, kb0); VMW(); SWRITE_KF(0); SBAR(); SLOAD_F((const float*)cur.V, kb0); }
    else { SLOAD_H(cur.K, cur.V, kb0); VMW(); SWRITE_HK(0); }
    __syncthreads();
}
template <class TIn, class TOut>
__device__ __forceinline__ void causal_swa_block(const BlockRef<TIn, TOut>& cur, const BlockRef<TIn, TOut>& nxt, int skv, int W, char* lds, Seam<TIn>& S, const int mk_wave) {
    constexpr bool F32 = same_t<TIn, float>::v;
    const int lane = (int)(__builtin_amdgcn_mbcnt_hi(~0u, __builtin_amdgcn_mbcnt_lo(~0u, 0u)) & 63u), wid = mk_wave & 7, tid = wid * 64 + lane, r32 = lane & 31, hi = lane >> 5;
    const int j_lo = swa_jlo(cur.P0, W);
    int j_hi = (cur.P0 + QB - 1) / KVBLK + 1; if (j_hi > skv / KVBLK) j_hi = skv / KVBLK;
    const int NT = j_hi - j_lo;
    const int kbn = swa_jlo(nxt.P0, W) * KVBLK;
    const int qlo = cur.P0 + wid * QBLK, qm = qlo + r32 - 4 * hi;
    char* V_lds = lds; char* K_lds = lds + 2 * SHM_V;
    float* ws = (float*)(lds + 2 * SHM_V + 2 * SHM_K) + wid * 64; float* li_l = ws, * al_l = ws + 32;
    float m_reg = -1e30f, l_reg = 0; f32x16 o[4] = {};
    const int sr = tid >> 4, sc = (tid & 15) * 8, vst0 = v_st(sr, sc), vst1 = v_st(32 + sr, sc), kws = KSWZ(sr, sc * 2);
    const int vb0 = (int)(uintptr_t)V_lds + v_rd_base(lane);
    const TIn* Kh = cur.K; const TIn* Vh = cur.V;
#define RESC(a) do { if (__any((a) < 1.f)) { if (hi == 0) al_l[r32] = (a); asm volatile("s_waitcnt lgkmcnt(0)" ::: "memory");              \
                     for (int d_ = 0; d_ < 4; ++d_) for (int r = 0; r < 16; ++r) o[d_][r] *= al_l[crow(r, hi)]; } } while (0)
#define KBASE(t) ((j_lo + (t)) * KVBLK)
#define ACT(t) (KBASE(t) <= qlo + QBLK - 1 && KBASE(t) + KVBLK - 1 >= qlo - W + 1)
#define MASKT(P0_, P1_, t) do { const int kb_ = KBASE(t); if ((!SK || ACT(t)) && (kb_ + KVBLK - 1 > qlo || kb_ <= qlo + QBLK - 1 - W)) mask_tile(P0_, P1_, qm - kb_, (unsigned)W); } while (0)
    constexpr int NQL = F32 ? 16 : 8;
    constexpr bool SK = WSKIP && !F32;
#define SEAM_K0() do { VMWN(NQL); if constexpr (F32) { SWRITE_KF(0); SBAR(); SLOAD_F((const float*)nxt.V, kbn); } else { SWRITE_HK(0); } SBAR(); } while (0)
    f32x16 pA0, pA1, pB0, pB1; float mnA, mnB, alA, alB; bf16x8 pa0, pa1, pa2, pa3;
    if constexpr (F32) { VMW(); SWRITE_VF(0); SBAR(); } else { SWRITE_HV(0); SBAR(); }
    if (NT > 1) { if constexpr (F32) SLOAD_F((const float*)Kh, KBASE(1)); else SLOAD_H(Kh, Vh, KBASE(1)); }
    SBAR(); qkt<0, SK>(pA0, pA1, K_lds, r32, hi, S.qr, ACT(0));
    if constexpr (F32) { if (NT > 1) { VMW(); SWRITE_KF(1); SBAR(); SLOAD_F((const float*)Vh, KBASE(1)); } }
    MASKT(pA0, pA1, 0); partialSM(pA0, pA1, m_reg, mnA, alA);
    if (NT > 1) { VMW(); if constexpr (F32) { SWRITE_VF(1); SBAR(); if (NT > 2) SLOAD_F((const float*)Kh, KBASE(2)); } else SWRITE_H(1); }
    __syncthreads();
#define HALF_STEP(PX0, PX1, mnX, alX, PY0, PY1, alY, t, KB, VB, SB) do {                                                      \
        SBAR(); qkt<KB, SK>(PX0, PX1, K_lds, r32, hi, S.qr, ACT(t));                                             \
        finishSM(PY0, PY1, alY, l_reg, pa0, pa1, pa2, pa3); SBAR();                                                           \
        if ((t) + 1 < NT) { if constexpr (F32) { VMW(); SWRITE_KF(SB); SBAR(); SLOAD_F((const float*)Vh, KBASE((t) + 1)); }  \
                            else { SLOAD_H(Kh, Vh, KBASE((t) + 1)); } SBAR(); }                                               \
        pv_tile<VB, SK>(o, vb0, pa0, pa1, pa2, pa3, ACT((t) - 1)); MASKT(PX0, PX1, (t)); partialSM(PX0, PX1, m_reg, mnX, alX);                                        \
        __syncthreads();                                                                                                      \
        if ((t) + 1 < NT) { VMW(); if constexpr (F32) { SWRITE_VF(SB); SBAR(); if ((t) + 2 < NT) SLOAD_F((const float*)Kh, KBASE((t) + 2)); } \
                            else { SWRITE_H(SB); } }                                                                          \
        RESC(alX); __syncthreads(); } while (0)
    for (int t = 1; t + 1 < NT; t += 2) {
        HALF_STEP(pB0, pB1, mnB, alB, pA0, pA1, alA, t, 1, 0, 0);
        HALF_STEP(pA0, pA1, mnA, alA, pB0, pB1, alB, t + 1, 0, 1, 1);
    }
    const bool even = (NT & 1) == 0;
    if (even) { SBAR(); qkt<1, SK>(pB0, pB1, K_lds, r32, hi, S.qr, ACT(NT - 1)); SBAR(); }
#define QROW(e) (nxt.Q + (size_t)(wid * QBLK + r32) * LDP + ((e) >> 1) * 16 + hi * 8 + ((e) & 1) * 4)
    if constexpr (F32) { SLOAD_F((const float*)nxt.K, kbn); SBAR();
#pragma unroll
        for (int e = 0; e < 8; ++e) S.tq[e] = *(const f32x4*)QROW(e); }
    else { SLOAD_H(nxt.K, nxt.V, kbn); SBAR();
#pragma unroll
        for (int d0 = 0; d0 < 8; ++d0) S.qr[d0] = load8<TIn>(nxt.Q + (size_t)(wid * QBLK + r32) * LDP + d0 * 16 + hi * 8); }
    SBAR();
    finishSM(pA0, pA1, alA, l_reg, pa0, pa1, pa2, pa3); SBAR();
    if constexpr (F32) {
#pragma unroll
        for (int e = 8; e < 16; ++e) S.tq[e] = *(const f32x4*)QROW(e); SBAR(); }
#undef QROW
    pv_tile<0, SK>(o, vb0, pa0, pa1, pa2, pa3, ACT(even ? NT - 2 : NT - 1));
    if (even) { MASKT(pB0, pB1, NT - 1); partialSM(pB0, pB1, m_reg, mnB, alB); __syncthreads(); RESC(alB);
        finishSM(pB0, pB1, alB, l_reg, pa0, pa1, pa2, pa3); SBAR(); pv_tile<1, SK>(o, vb0, pa0, pa1, pa2, pa3, ACT(NT - 1)); }
    SBAR(); SEAM_K0();
    if (hi == 0) li_l[r32] = l_reg; asm volatile("s_waitcnt lgkmcnt(0)" ::: "memory");
    float rli[16];
#pragma unroll
    for (int r = 0; r < 16; ++r) rli[r] = __builtin_amdgcn_rcpf(li_l[crow(r, hi)]);
    TOut* Ow = cur.O + (size_t)(wid * QBLK) * LDO;
#pragma unroll
    for (int r = 0; r < 16; ++r) { const int orow = crow(r, hi);
#pragma unroll
        for (int d0 = 0; d0 < 4; ++d0) { const float v = o[d0][r] * rli[r];
            if constexpr (same_t<TOut, float>::v) { Ow[(size_t)orow * LDO + d0 * 32 + r32] = v; }
            else { const float vn = __shfl_xor(v, 1);
                   if ((r32 & 1) == 0) *(unsigned*)(Ow + (size_t)orow * LDO + d0 * 32 + r32) = cvtpk(v, vn); } } }
    if constexpr (F32) {
#pragma unroll
        for (int d0 = 0; d0 < 8; ++d0) S.qr[d0] = pack8(S.tq[2 * d0], S.tq[2 * d0 + 1]); }
    __syncthreads();
#undef RESC
#undef KBASE
#undef ACT
#undef MASKT
#undef SEAM_K0
#undef HALF_STEP
}
#undef ROW
#undef VMW
#undef VMWN
#undef SLOAD_H
#undef SWRITE_HK
#undef SWRITE_HV
#undef SWRITE_H
#undef SLOAD_F
#undef SWRITE_KF
#undef SWRITE_VF

constexpr int A2_V = 0;
constexpr int A2_K = 4 * SHM_V;
constexpr int A2_X = A2_K + 2 * SHM_K;
constexpr int A2_XS = 4096 + 512;
constexpr int A2_LDS = A2_X + 4 * A2_XS;
struct A2Ref { const bf16* Q; const bf16* K; const bf16* V0; const bf16* V1; bf16* O; int P0; };

__device__ __forceinline__ void attn2_block(const A2Ref& c, char* lds, const int mk_wave) {
    const int lane = (int)(__builtin_amdgcn_mbcnt_hi(~0u, __builtin_amdgcn_mbcnt_lo(~0u, 0u)) & 63u), wid = mk_wave & 7, tid = wid * 64 + lane, r32 = lane & 31, hi = lane >> 5, rg = wid & 3, vh = wid >> 2;
    char* V_lds = lds + A2_V; char* K_lds = lds + A2_K; char* X = lds + A2_X + rg * A2_XS;
    float* XA = (float*)(X + 4096); float* XM = XA + 32; float* XL = XA + 64;
    const int NT = (c.P0 + 127) / 64 + 1;
    const int qlo = c.P0 + rg * 32, qm = qlo + r32 - 4 * hi;
    const int sr = tid >> 4, sc = (tid & 15) * 8, vst0 = v_st(sr, sc), vst1 = v_st(32 + sr, sc), kws = KSWZ(sr, sc * 2);
    const int vb0 = (int)(uintptr_t)V_lds + vh * SHM_V + v_rd_base(lane);
    bf16x8 qr[8];
#pragma unroll
    for (int d0 = 0; d0 < 8; ++d0) qr[d0] = load8<bf16>(c.Q + (size_t)(rg * 32 + r32) * 128 + d0 * 16 + hi * 8);
    float m_reg = -1e30f, l_reg = 0.f; f32x16 o[4] = {};
    bf16x8 sk0, sk1, sa0, sa1, sb0, sb1;
#define A2_LOAD(kb) do { const size_t ro_ = (size_t)((kb) + sr) * 128 + sc; sk0 = load8<bf16>(c.K + ro_); sk1 = load8<bf16>(c.K + ro_ + 32 * 128); \
        sa0 = load8<bf16>(c.V0 + ro_); sa1 = load8<bf16>(c.V0 + ro_ + 32 * 128); sb0 = load8<bf16>(c.V1 + ro_); sb1 = load8<bf16>(c.V1 + ro_ + 32 * 128); } while (0)
#define A2_WRITE(buf) do { *(bf16x8*)(K_lds + (buf) * SHM_K + kws) = sk0; *(bf16x8*)(K_lds + (buf) * SHM_K + kws + 32 * 256) = sk1; \
        *(bf16x8*)(V_lds + (buf) * 2 * SHM_V + vst0) = sa0; *(bf16x8*)(V_lds + (buf) * 2 * SHM_V + vst1) = sa1; \
        *(bf16x8*)(V_lds + (buf) * 2 * SHM_V + SHM_V + vst0) = sb0; *(bf16x8*)(V_lds + (buf) * 2 * SHM_V + SHM_V + vst1) = sb1; } while (0)
#define A2_VMW() asm volatile("s_waitcnt vmcnt(0)" ::: "memory")
#define A2_STEP(t, B) do { const bool more_ = (t) + 1 < NT; if (more_) A2_LOAD(((t) + 1) * 64); \
        bf16x8 pa0, pa1, pa2, pa3; \
        if (vh == (B)) { f32x16 p0, p1; float mn, alpha; \
            qkt<(B), false>(p0, p1, K_lds, r32, hi, qr, true); \
            if (64 * (t) + 63 > qlo) mask_tile(p0, p1, qm - 64 * (t), 16384u); \
            partialSM(p0, p1, m_reg, mn, alpha); finishSM(p0, p1, alpha, l_reg, pa0, pa1, pa2, pa3); \
            *(bf16x8*)(X + lane * 16) = pa0; *(bf16x8*)(X + 1024 + lane * 16) = pa1; *(bf16x8*)(X + 2048 + lane * 16) = pa2; *(bf16x8*)(X + 3072 + lane * 16) = pa3; \
            if (hi == 0) { XA[r32] = alpha; XM[r32] = m_reg; XL[r32] = l_reg; } } \
        __syncthreads(); \
        if (vh != (B)) { pa0 = *(const bf16x8*)(X + lane * 16); pa1 = *(const bf16x8*)(X + 1024 + lane * 16); pa2 = *(const bf16x8*)(X + 2048 + lane * 16); pa3 = *(const bf16x8*)(X + 3072 + lane * 16); \
            m_reg = XM[r32]; l_reg = XL[r32]; } \
        { const float a_ = XA[r32]; if (__any(a_ < 1.f)) { \
            _Pragma("unroll") for (int d_ = 0; d_ < 4; ++d_) _Pragma("unroll") for (int r = 0; r < 16; ++r) o[d_][r] *= XA[crow(r, hi)]; } } \
        pv_tile<2 * (B), false>(o, vb0, pa0, pa1, pa2, pa3, true); \
        if (more_) { A2_VMW(); A2_WRITE((B) ^ 1); } \
        __syncthreads(); } while (0)
    A2_LOAD(0); A2_VMW(); A2_WRITE(0); __syncthreads();
    for (int t = 0; t < NT; t += 2) { A2_STEP(t, 0); A2_STEP(t + 1, 1); }
    float rli[16];
#pragma unroll
    for (int r = 0; r < 16; ++r) rli[r] = __builtin_amdgcn_rcpf(XL[crow(r, hi)]);
    bf16* Ow = c.O + (size_t)(rg * 32) * LDO + vh * 128;
#pragma unroll
    for (int r = 0; r < 16; ++r) { const int orow = crow(r, hi);
#pragma unroll
        for (int d0 = 0; d0 < 4; ++d0) { const float v = o[d0][r] * rli[r]; const float vn = __shfl_xor(v, 1);
            if ((r32 & 1) == 0) *(unsigned*)(Ow + (size_t)orow * LDO + d0 * 32 + r32) = cvtpk(v, vn); } }
    __syncthreads();
#undef A2_LOAD
#undef A2_WRITE
#undef A2_VMW
#undef A2_STEP
}

constexpr int A6_XS = 8192 + 1024;
constexpr int A6_LDS = A2_X + 4 * A6_XS + 8 * 128;
__device__ __forceinline__ void attn6_block(const A2Ref& c, char* lds, const int mk_wave) {
    int lane_ = (int)(__builtin_amdgcn_mbcnt_hi(~0u, __builtin_amdgcn_mbcnt_lo(~0u, 0u)) & 63u); asm volatile("" : "+v"(lane_));
    const int lane = lane_ & 63, wid = mk_wave & 7, tid = wid * 64 + lane, r32 = lane & 31, hi = lane >> 5, rg = wid & 3, vh = wid >> 2;
    char* V_lds = lds + A2_V; char* K_lds = lds + A2_K; char* X = lds + A2_X + rg * A6_XS;
    float* XM = (float*)(X + 8192); float* XL = XM + 128; float* AL = (float*)(lds + A2_X + 4 * A6_XS + wid * 128);
    const int NT = (c.P0 + 127) / 64 + 1;
    const int qlo = c.P0 + rg * 32, qm = qlo + r32 - 4 * hi;
    const int sr = tid >> 4, sc = (tid & 15) * 8, vst0 = v_st(sr, sc), vst1 = v_st(32 + sr, sc), kws = KSWZ(sr, sc * 2);
    const unsigned so = (unsigned)(sr * 128 + sc) * 2u;
    const int vb0 = (int)(uintptr_t)V_lds + vh * SHM_V + v_rd_base(lane);
    bf16x8 qr[8];
#pragma unroll
    for (int d0 = 0; d0 < 8; ++d0) qr[d0] = load8<bf16>(c.Q + (size_t)(rg * 32 + r32) * 128 + d0 * 16 + hi * 8);
    float m_reg = -1e30f, l_reg = 0.f; f32x16 o[4] = {};
    bf16x8 sk0, sk1, sa0, sa1, sb0, sb1;
    constexpr float C2 = 1.4426950408889634f * SCALE;
#define A4_G(base, kb, rows) (*(const bf16x8*)((const char*)((base) + (size_t)((kb) + (rows)) * 128) + so))
#define A4_LOAD(kb) do { sk0 = A4_G(c.K, kb, 0); sk1 = A4_G(c.K, kb, 32); sa0 = A4_G(c.V0, kb, 0); sa1 = A4_G(c.V0, kb, 32); sb0 = A4_G(c.V1, kb, 0); sb1 = A4_G(c.V1, kb, 32); } while (0)
#define A4_WRITE(buf) do { *(bf16x8*)(K_lds + (buf) * SHM_K + kws) = sk0; *(bf16x8*)(K_lds + (buf) * SHM_K + kws + 32 * 256) = sk1; \
        *(bf16x8*)(V_lds + (buf) * 2 * SHM_V + vst0) = sa0; *(bf16x8*)(V_lds + (buf) * 2 * SHM_V + vst1) = sa1; \
        *(bf16x8*)(V_lds + (buf) * 2 * SHM_V + SHM_V + vst0) = sb0; *(bf16x8*)(V_lds + (buf) * 2 * SHM_V + SHM_V + vst1) = sb1; } while (0)
#define A6_LOADK(kb) do { sk0 = A4_G(c.K, kb, 0); sk1 = A4_G(c.K, kb, 32); } while (0)
#define A6_LOADV(kb) do { sa0 = A4_G(c.V0, kb, 0); sa1 = A4_G(c.V0, kb, 32); sb0 = A4_G(c.V1, kb, 0); sb1 = A4_G(c.V1, kb, 32); } while (0)
#define A6_WRITEK(buf) do { *(bf16x8*)(K_lds + (buf) * SHM_K + kws) = sk0; *(bf16x8*)(K_lds + (buf) * SHM_K + kws + 32 * 256) = sk1; } while (0)
#define A6_WRITEV(buf) do { *(bf16x8*)(V_lds + (buf) * 2 * SHM_V + vst0) = sa0; *(bf16x8*)(V_lds + (buf) * 2 * SHM_V + vst1) = sa1; \
        *(bf16x8*)(V_lds + (buf) * 2 * SHM_V + SHM_V + vst0) = sb0; *(bf16x8*)(V_lds + (buf) * 2 * SHM_V + SHM_V + vst1) = sb1; } while (0)
#define A4_VMW() asm volatile("s_waitcnt vmcnt(0)" ::: "memory")
#define A4_PK(P, B_, OUT) do { unsigned a0_ = cvtpk(P[B_+0], P[B_+1]), a1_ = cvtpk(P[B_+2], P[B_+3]), b0_ = cvtpk(P[B_+4], P[B_+5]), b1_ = cvtpk(P[B_+6], P[B_+7]); \
        auto r0_ = __builtin_amdgcn_permlane32_swap(a0_, b0_, false, false); auto r1_ = __builtin_amdgcn_permlane32_swap(a1_, b1_, false, false); \
        u32x4 w_ = {r0_[0], r1_[0], r0_[1], r1_[1]}; OUT = *reinterpret_cast<bf16x8*>(&w_); } while (0)
#define A5_QK(T, KB) do { p = f32x16{}; \
        { const char* kb_[4]; \
          _Pragma("unroll") for (int dd = 0; dd < 4; ++dd) kb_[dd] = K_lds + (KB) * SHM_K + vh * (32 * 256) + KSWZ(r32, (dd * 16 + hi * 8) * 2); \
          _Pragma("unroll") for (int d0 = 0; d0 < 8; ++d0) { const bf16x8 b_ = *reinterpret_cast<const bf16x8*>(kb_[d0 & 3] + (d0 >> 2) * 128); p = __builtin_amdgcn_mfma_f32_32x32x16_bf16(b_, qr[d0], p, 0, 0, 0); } } } while (0)
#define A5_MAX(T) do { \
        if (64 * (T) + 32 * vh + 31 > qlo) { const int dq_ = qm - 64 * (T) - 32 * vh; \
            _Pragma("unroll") for (int r = 0; r < 16; ++r) { const int cc_ = (r & 3) + 8 * (r >> 2); if ((unsigned)(dq_ - cc_) >= 16384u) p[r] = -__builtin_inff(); } } \
        pmax_ = p[0]; \
        _Pragma("unroll") for (int r = 1; r < 16; ++r) pmax_ = fmaxf(pmax_, p[r]); \
        { auto rr_ = __builtin_amdgcn_permlane32_swap(__float_as_uint(pmax_), __float_as_uint(pmax_), false, false); pmax_ = fmaxf(__uint_as_float(rr_[0]), __uint_as_float(rr_[1])); } \
        if (hi == 0) XM[vh * 32 + r32] = pmax_; } while (0)
#define A5_SOFTMAX() do { \
        pmax_ = fmaxf(pmax_, XM[(vh ^ 1) * 32 + r32]); \
        float mn_; \
        if (__builtin_expect(__all((pmax_ - m_reg) * SCALE <= THR), 1)) { mn_ = m_reg; alpha_ = 1.f; } \
        else { mn_ = fmaxf(m_reg, pmax_); alpha_ = __builtin_amdgcn_exp2f((m_reg - mn_) * C2); m_reg = mn_; } \
        { const float mnL_ = -mn_ * C2; float ps_ = 0.f; \
          _Pragma("unroll") for (int r = 0; r < 16; ++r) { p[r] = __builtin_amdgcn_exp2f(fmaf(p[r], C2, mnL_)); ps_ += p[r]; } \
          auto rr_ = __builtin_amdgcn_permlane32_swap(__float_as_uint(ps_), __float_as_uint(ps_), false, false); ps_ = __uint_as_float(rr_[0]) + __uint_as_float(rr_[1]); \
          l_reg = l_reg * alpha_ + ps_; } \
        A4_PK(p, 0, pm0_); A4_PK(p, 8, pm1_); \
        *(bf16x8*)(X + vh * 2048 + lane * 16) = pm0_; *(bf16x8*)(X + vh * 2048 + 1024 + lane * 16) = pm1_; \
        if (hi == 0) AL[r32] = alpha_; } while (0)
    f32x16 p; float pmax_, alpha_ = 1.f; bf16x8 pm0_, pm1_;
    A4_LOAD(0); A4_VMW(); A4_WRITE(0); A6_LOADK(64); A4_VMW(); A6_WRITEK(1); A6_LOADV(64); if (2 < NT) A6_LOADK(128);
    __syncthreads();
    A5_QK(0, 0); A5_MAX(0);
    __syncthreads();
    A5_SOFTMAX();
    __syncthreads();
#define A6_STEP(t, B) do { \
        bf16x8 pa0, pa1, pa2, pa3; \
        { const bf16x8 po0_ = *(const bf16x8*)(X + (B) * 4096 + (vh ^ 1) * 2048 + lane * 16), po1_ = *(const bf16x8*)(X + (B) * 4096 + (vh ^ 1) * 2048 + 1024 + lane * 16); \
          if (vh == 0) { pa0 = pm0_; pa1 = pm1_; pa2 = po0_; pa3 = po1_; } else { pa0 = po0_; pa1 = po1_; pa2 = pm0_; pa3 = pm1_; } } \
        const float cand_ = fmaxf(pmax_, XM[(B) * 64 + (vh ^ 1) * 32 + r32]);                         \
        const bool more1_ = (t) + 1 < NT; \
        if (more1_) { A4_VMW(); A6_WRITEV((B) ^ 1); if ((t) + 2 < NT) A6_LOADV(((t) + 2) * 64); }     \
        if (more1_) A5_QK((t) + 1, (B) ^ 1); \
        pv_tile<2 * (B), false>(o, vb0, pa0, pa1, pa2, pa3, true); \
        if (!__all((cand_ - m_reg) * SCALE <= THR)) {                                      \
            const float mn_ = fmaxf(m_reg, cand_), al_ = __builtin_amdgcn_exp2f((m_reg - mn_) * C2); m_reg = mn_; l_reg *= al_; \
            if (hi == 0) AL[r32] = al_; asm volatile("s_waitcnt lgkmcnt(0)" ::: "memory"); \
            _Pragma("unroll") for (int d_ = 0; d_ < 4; ++d_) _Pragma("unroll") for (int r = 0; r < 16; ++r) o[d_][r] *= AL[crow(r, hi)]; } \
        if (more1_) { \
            if (64 * ((t) + 1) + 32 * vh + 31 > qlo) { const int dq_ = qm - 64 * ((t) + 1) - 32 * vh; \
                _Pragma("unroll") for (int r = 0; r < 16; ++r) { const int cc_ = (r & 3) + 8 * (r >> 2); if ((unsigned)(dq_ - cc_) >= 16384u) p[r] = -__builtin_inff(); } } \
            pmax_ = p[0]; \
            _Pragma("unroll") for (int r = 1; r < 16; ++r) pmax_ = fmaxf(pmax_, p[r]); \
            { auto rr_ = __builtin_amdgcn_permlane32_swap(__float_as_uint(pmax_), __float_as_uint(pmax_), false, false); pmax_ = fmaxf(__uint_as_float(rr_[0]), __uint_as_float(rr_[1])); } \
            { const float mnL_ = -m_reg * C2; float ps_ = 0.f; \
              _Pragma("unroll") for (int r = 0; r < 16; ++r) { p[r] = __builtin_amdgcn_exp2f(fmaf(p[r], C2, mnL_)); ps_ += p[r]; } \
              auto rr_ = __builtin_amdgcn_permlane32_swap(__float_as_uint(ps_), __float_as_uint(ps_), false, false); ps_ = __uint_as_float(rr_[0]) + __uint_as_float(rr_[1]); \
              l_reg += ps_; } \
            A4_PK(p, 0, pm0_); A4_PK(p, 8, pm1_); \
            *(bf16x8*)(X + ((B) ^ 1) * 4096 + vh * 2048 + lane * 16) = pm0_; *(bf16x8*)(X + ((B) ^ 1) * 4096 + vh * 2048 + 1024 + lane * 16) = pm1_; \
            if (hi == 0) XM[((B) ^ 1) * 64 + vh * 32 + r32] = pmax_; \
            if ((t) + 2 < NT) { A6_WRITEK(B); if ((t) + 3 < NT) A6_LOADK(((t) + 3) * 64); }     \
            __syncthreads(); } \
    } while (0)
    for (int t = 0; t < NT; t += 2) { A6_STEP(t, 0); A6_STEP(t + 1, 1); }
    __syncthreads();
    if (hi == 0) XL[vh * 32 + r32] = l_reg;
    __syncthreads();
    float rli[16];
#pragma unroll
    for (int r = 0; r < 16; ++r) rli[r] = __builtin_amdgcn_rcpf(XL[crow(r, hi)] + XL[32 + crow(r, hi)]);
    bf16* Ow = c.O + (size_t)(rg * 32) * LDO + vh * 128;
#pragma unroll
    for (int r = 0; r < 16; ++r) { const int orow = crow(r, hi);
#pragma unroll
        for (int d0 = 0; d0 < 4; ++d0) { const float v = o[d0][r] * rli[r]; const float vn = __shfl_xor(v, 1);
            if ((r32 & 1) == 0) *(unsigned*)(Ow + (size_t)orow * LDO + d0 * 32 + r32) = cvtpk(v, vn); } }
    __syncthreads();
#undef A4_G
#undef A4_LOAD
#undef A4_WRITE
#undef A4_VMW
#undef A4_PK
#undef A5_QK
#undef A5_MAX
#undef A5_SOFTMAX
#undef A6_STEP
#undef A6_WRITEK
#undef A6_LOADK
#undef A6_LOADV
#undef A6_WRITEV
}

__device__ __forceinline__ void attn9_block(const A2Ref& c, char* lds, __attribute__((address_space(3))) unsigned char* ldsl, const int mk_wave) {
    int lane_ = (int)(__builtin_amdgcn_mbcnt_hi(~0u, __builtin_amdgcn_mbcnt_lo(~0u, 0u)) & 63u); asm volatile("" : "+v"(lane_));
    const int lane = lane_ & 63, wid = mk_wave & 7, tid = wid * 64 + lane, r32 = lane & 31, hi = lane >> 5, rg = wid & 3, vh = wid >> 2;
    char* V_lds = lds + A2_V; char* K_lds = lds + A2_K; char* X = lds + A2_X + rg * A6_XS;
    float* XM = (float*)(X + 8192); float* XL = XM + 128; float* AL = (float*)(lds + A2_X + 4 * A6_XS + wid * 128);
    const int NT = (c.P0 + 127) / 64 + 1;
    const int qlo = c.P0 + rg * 32, qm = qlo + r32 - 4 * hi;
    const int oL = wid * 1024 + lane * 16;
    const int rowK = oL >> 8; const unsigned gK = (unsigned)(rowK * 256 + ((oL & 255) ^ ((rowK & 7) << 4)));
    const int stV = oL >> 9, eV = (oL & 511) >> 1, kkV = (stV >> 2) * 8 + (eV >> 5), kV = (kkV & ~0xC) | ((kkV & 4) << 1) | ((kkV & 8) >> 1);
    const unsigned gV = (unsigned)(kV * 256 + ((stV & 3) * 32 + (eV & 31)) * 2);
    const int vb0 = (int)(uintptr_t)V_lds + vh * SHM_V + v_rd_base(lane);
    bf16x8 qr[8];
#pragma unroll
    for (int d0 = 0; d0 < 8; ++d0) qr[d0] = load8<bf16>(c.Q + (size_t)(rg * 32 + r32) * 128 + d0 * 16 + hi * 8);
    float m_reg = -1e30f, l_reg = 0.f; f32x16 o[4] = {};
    constexpr float C2 = 1.4426950408889634f * SCALE;
#define A9_DMA(gbase, kb, goff, loff) do { \
        __builtin_amdgcn_global_load_lds((const unsigned*)((const char*)((gbase) + (size_t)(kb) * 128) + (goff)), (__attribute__((address_space(3))) unsigned*)(ldsl + (loff) + wid * 1024), 16, 0, 0); \
        __builtin_amdgcn_global_load_lds((const unsigned*)((const char*)((gbase) + (size_t)((kb) + 32) * 128) + (goff)), (__attribute__((address_space(3))) unsigned*)(ldsl + (loff) + 8192 + wid * 1024), 16, 0, 0); } while (0)
#define A9_DMAK(kb, buf) A9_DMA(c.K, kb, gK, A2_K + (buf) * SHM_K)
#define A9_DMAV(kb, buf) do { A9_DMA(c.V0, kb, gV, A2_V + (buf) * 2 * SHM_V); A9_DMA(c.V1, kb, gV, A2_V + (buf) * 2 * SHM_V + SHM_V); } while (0)
#define A4_VMW() asm volatile("s_waitcnt vmcnt(0)" ::: "memory")
#define A4_PK(P, B_, OUT) do { unsigned a0_ = cvtpk(P[B_+0], P[B_+1]), a1_ = cvtpk(P[B_+2], P[B_+3]), b0_ = cvtpk(P[B_+4], P[B_+5]), b1_ = cvtpk(P[B_+6], P[B_+7]); \
        auto r0_ = __builtin_amdgcn_permlane32_swap(a0_, b0_, false, false); auto r1_ = __builtin_amdgcn_permlane32_swap(a1_, b1_, false, false); \
        u32x4 w_ = {r0_[0], r1_[0], r0_[1], r1_[1]}; OUT = *reinterpret_cast<bf16x8*>(&w_); } while (0)
#define A5_QK(T, KB) do { p = f32x16{}; \
        { const char* kb_[4]; \
          _Pragma("unroll") for (int dd = 0; dd < 4; ++dd) kb_[dd] = K_lds + (KB) * SHM_K + vh * (32 * 256) + KSWZ(r32, (dd * 16 + hi * 8) * 2); \
          _Pragma("unroll") for (int d0 = 0; d0 < 8; ++d0) { const bf16x8 b_ = *reinterpret_cast<const bf16x8*>(kb_[d0 & 3] + (d0 >> 2) * 128); p = __builtin_amdgcn_mfma_f32_32x32x16_bf16(b_, qr[d0], p, 0, 0, 0); } } } while (0)
#define A5_MAX(T) do { \
        if (64 * (T) + 32 * vh + 31 > qlo) { const int dq_ = qm - 64 * (T) - 32 * vh; \
            _Pragma("unroll") for (int r = 0; r < 16; ++r) { const int cc_ = (r & 3) + 8 * (r >> 2); if ((unsigned)(dq_ - cc_) >= 16384u) p[r] = -__builtin_inff(); } } \
        pmax_ = p[0]; \
        _Pragma("unroll") for (int r = 1; r < 16; ++r) pmax_ = fmaxf(pmax_, p[r]); \
        { auto rr_ = __builtin_amdgcn_permlane32_swap(__float_as_uint(pmax_), __float_as_uint(pmax_), false, false); pmax_ = fmaxf(__uint_as_float(rr_[0]), __uint_as_float(rr_[1])); } \
        if (hi == 0) XM[vh * 32 + r32] = pmax_; } while (0)
#define A5_SOFTMAX() do { \
        pmax_ = fmaxf(pmax_, XM[(vh ^ 1) * 32 + r32]); \
        float mn_; \
        if (__builtin_expect(__all((pmax_ - m_reg) * SCALE <= THR), 1)) { mn_ = m_reg; alpha_ = 1.f; } \
        else { mn_ = fmaxf(m_reg, pmax_); alpha_ = __builtin_amdgcn_exp2f((m_reg - mn_) * C2); m_reg = mn_; } \
        { const float mnL_ = -mn_ * C2; float ps_ = 0.f; \
          _Pragma("unroll") for (int r = 0; r < 16; ++r) { p[r] = __builtin_amdgcn_exp2f(fmaf(p[r], C2, mnL_)); ps_ += p[r]; } \
          auto rr_ = __builtin_amdgcn_permlane32_swap(__float_as_uint(ps_), __float_as_uint(ps_), false, false); ps_ = __uint_as_float(rr_[0]) + __uint_as_float(rr_[1]); \
          l_reg = l_reg * alpha_ + ps_; } \
        A4_PK(p, 0, pm0_); A4_PK(p, 8, pm1_); \
        *(bf16x8*)(X + vh * 2048 + lane * 16) = pm0_; *(bf16x8*)(X + vh * 2048 + 1024 + lane * 16) = pm1_; \
        if (hi == 0) AL[r32] = alpha_; } while (0)
    f32x16 p; float pmax_, alpha_ = 1.f; bf16x8 pm0_, pm1_;
    A9_DMAK(0, 0); A9_DMAK(64, 1); A9_DMAV(0, 0); A4_VMW();
    __syncthreads();
    A5_QK(0, 0); A5_MAX(0);
    __syncthreads();
    A5_SOFTMAX();
    __syncthreads();
#define A6_STEP(t, B) do { \
        bf16x8 pa0, pa1, pa2, pa3; \
        { const bf16x8 po0_ = *(const bf16x8*)(X + (B) * 4096 + (vh ^ 1) * 2048 + lane * 16), po1_ = *(const bf16x8*)(X + (B) * 4096 + (vh ^ 1) * 2048 + 1024 + lane * 16); \
          if (vh == 0) { pa0 = pm0_; pa1 = pm1_; pa2 = po0_; pa3 = po1_; } else { pa0 = po0_; pa1 = po1_; pa2 = pm0_; pa3 = pm1_; } } \
        const float cand_ = fmaxf(pmax_, XM[(B) * 64 + (vh ^ 1) * 32 + r32]);                         \
        const bool more1_ = (t) + 1 < NT; \
        if (more1_) { A9_DMAV(((t) + 1) * 64, (B) ^ 1); if ((t) + 2 < NT) A9_DMAK(((t) + 2) * 64, B); }     \
        if (more1_) A5_QK((t) + 1, (B) ^ 1); \
        pv_tile<2 * (B), false>(o, vb0, pa0, pa1, pa2, pa3, true); \
        if (!__all((cand_ - m_reg) * SCALE <= THR)) {                                      \
            const float mn_ = fmaxf(m_reg, cand_), al_ = __builtin_amdgcn_exp2f((m_reg - mn_) * C2); m_reg = mn_; l_reg *= al_; \
            if (hi == 0) AL[r32] = al_; asm volatile("s_waitcnt lgkmcnt(0)" ::: "memory"); \
            _Pragma("unroll") for (int d_ = 0; d_ < 4; ++d_) _Pragma("unroll") for (int r = 0; r < 16; ++r) o[d_][r] *= AL[crow(r, hi)]; } \
        if (more1_) { \
            if (64 * ((t) + 1) + 32 * vh + 31 > qlo) { const int dq_ = qm - 64 * ((t) + 1) - 32 * vh; \
                _Pragma("unroll") for (int r = 0; r < 16; ++r) { const int cc_ = (r & 3) + 8 * (r >> 2); if ((unsigned)(dq_ - cc_) >= 16384u) p[r] = -__builtin_inff(); } } \
            pmax_ = p[0]; \
            _Pragma("unroll") for (int r = 1; r < 16; ++r) pmax_ = fmaxf(pmax_, p[r]); \
            { auto rr_ = __builtin_amdgcn_permlane32_swap(__float_as_uint(pmax_), __float_as_uint(pmax_), false, false); pmax_ = fmaxf(__uint_as_float(rr_[0]), __uint_as_float(rr_[1])); } \
            { const float mnL_ = -m_reg * C2; float ps_ = 0.f; \
              _Pragma("unroll") for (int r = 0; r < 16; ++r) { p[r] = __builtin_amdgcn_exp2f(fmaf(p[r], C2, mnL_)); ps_ += p[r]; } \
              auto rr_ = __builtin_amdgcn_permlane32_swap(__float_as_uint(ps_), __float_as_uint(ps_), false, false); ps_ = __uint_as_float(rr_[0]) + __uint_as_float(rr_[1]); \
              l_reg += ps_; } \
            A4_PK(p, 0, pm0_); A4_PK(p, 8, pm1_); \
            *(bf16x8*)(X + ((B) ^ 1) * 4096 + vh * 2048 + lane * 16) = pm0_; *(bf16x8*)(X + ((B) ^ 1) * 4096 + vh * 2048 + 1024 + lane * 16) = pm1_; \
            if (hi == 0) XM[((B) ^ 1) * 64 + vh * 32 + r32] = pmax_; \
            A4_VMW(); __syncthreads(); }     \
    } while (0)
    for (int t = 0; t < NT; t += 2) { A6_STEP(t, 0); A6_STEP(t + 1, 1); }
    __syncthreads();
    if (hi == 0) XL[vh * 32 + r32] = l_reg;
    __syncthreads();
    float rli[16];
#pragma unroll
    for (int r = 0; r < 16; ++r) rli[r] = __builtin_amdgcn_rcpf(XL[crow(r, hi)] + XL[32 + crow(r, hi)]);
    bf16* Ow = c.O + (size_t)(rg * 32) * LDO + vh * 128;
#pragma unroll
    for (int r = 0; r < 16; ++r) { const int orow = crow(r, hi);
#pragma unroll
        for (int d0 = 0; d0 < 4; ++d0) { const float v = o[d0][r] * rli[r]; const float vn = __shfl_xor(v, 1);
            if ((r32 & 1) == 0) *(unsigned*)(Ow + (size_t)orow * LDO + d0 * 32 + r32) = cvtpk(v, vn); } }
    __syncthreads();
#undef A4_VMW
#undef A9_DMA
#undef A9_DMAK
#undef A9_DMAV
#undef A4_PK
#undef A5_QK
#undef A5_MAX
#undef A5_SOFTMAX
#undef A6_STEP
}

}

constexpr int S_ = 16384, DM = 2048, FF = 5632, NIN = 6152, NINP = 6144, PLD = 3072;
constexpr int NWAVES = 8, NTHR = 512;
constexpr int C_MQ = 0, C_MK = 512, C_MV = 1024, C_MO = 2048;
constexpr size_t MiB = 1u << 20, KiB = 1u << 10;
constexpr size_t WS_ROWSS1 = 0, WS_ROWSS2 = 64 * KiB, WS_SC = 192 * KiB  , WS_DN = 256 * KiB, WS_GATES = 512 * KiB;
constexpr size_t WS_BAR = 128 * KiB;
constexpr size_t WS_WGU = 1 * MiB, WS_WD = 45 * MiB, WS_WIN = 67 * MiB, WS_WOUT = 92 * MiB;
constexpr size_t WS_XN = 100 * MiB;
constexpr size_t WS_BIG = 164 * MiB;
constexpr size_t WS_Y = 356 * MiB;
constexpr size_t WS_CT = 420 * MiB;
constexpr size_t WS_QC = 452 * MiB, WS_KC = 468 * MiB;
constexpr size_t WS_NST = 484 * MiB;
constexpr size_t WS_GW = 484 * MiB + 512 * KiB;
constexpr size_t WS_END = 485 * MiB;
constexpr int LDS_BYTES = 147456;

#define LAS __attribute__((address_space(3)))
typedef unsigned short bfu;
typedef unsigned v4u __attribute__((ext_vector_type(4)));
typedef unsigned v2u __attribute__((ext_vector_type(2)));
typedef float f32x4 __attribute__((ext_vector_type(4)));
typedef short bf16x8 __attribute__((ext_vector_type(8)));
#define MFMA16(a, b, c) __builtin_amdgcn_mfma_f32_16x16x32_bf16(a, b, c, 0, 0, 0)
#define LDS_WAIT() asm volatile("s_waitcnt lgkmcnt(0)" ::: "memory")
__device__ __forceinline__ unsigned f2bf(float f) { unsigned u = __builtin_bit_cast(unsigned, f); return (u + 0x7fffu + ((u >> 16) & 1u)) >> 16; }
__device__ __forceinline__ unsigned pk2(float lo, float hi) { return f2bf(lo) | (f2bf(hi) << 16); }
__device__ __forceinline__ float bf2f(unsigned b) { return __builtin_bit_cast(float, b << 16); }
__device__ __forceinline__ int mk_lane() { return (int)(__builtin_amdgcn_mbcnt_hi(~0u, __builtin_amdgcn_mbcnt_lo(~0u, 0u)) & 63u); }
__device__ __forceinline__ float wave_sum(float v) {
#pragma unroll
    for (int o = 1; o < 64; o <<= 1) v += __shfl_xor(v, o);
    return v;
}
__device__ __forceinline__ float silu(float x) { return x / (1.0f + __expf(-x)); }

__device__ __forceinline__ void cvt_item(const float* __restrict__ W, int ldw, int ncols, const float* __restrict__ gain, bfu* WT, int K, int dst_row0, int k0, int n0, LAS float* scr, int lane) {
    const int nq = (lane & 15) * 4, kr = lane >> 4, n = n0 + nq;
#pragma unroll 8
    for (int i = 0; i < 16; ++i) { const int kk = 4 * i + kr; f32x4 v = (f32x4){0.f, 0.f, 0.f, 0.f};
        if (n < ncols) v = *(const f32x4*)(W + (size_t)(k0 + kk) * ldw + n);
        if (gain) v = v * gain[k0 + kk];
        LAS float* d = scr + kk * 65 + nq; d[0] = v[0]; d[1] = v[1]; d[2] = v[2]; d[3] = v[3]; }
    LDS_WAIT(); asm volatile("" ::: "memory");
    const int c = lane & 7;
#pragma unroll
    for (int j = 0; j < 8; ++j) { const int nn = (lane >> 3) + 8 * j; const LAS float* s = scr + (8 * c) * 65 + nn;
        v4u o; o.x = pk2(s[0 * 65], s[1 * 65]); o.y = pk2(s[2 * 65], s[3 * 65]); o.z = pk2(s[4 * 65], s[5 * 65]); o.w = pk2(s[6 * 65], s[7 * 65]);
        *(v4u*)(WT + (size_t)(dst_row0 + nn) * K + k0 + 8 * c) = o; }
    LDS_WAIT(); asm volatile("" ::: "memory");
}
__device__ __forceinline__ void cvt_ffn_item(int it, const float* wg, const float* wu, const float* wd, const float* gain, bfu* Wgu, bfu* Wd, LAS float* scr, int lane) {
    if (it < 2 * 2816) { const int up = it >= 2816; const int r = up ? it - 2816 : it; const int kb = r / 88, nb = r % 88, n0 = nb * 64;
        cvt_item(up ? wu : wg, FF, FF, gain, Wgu, DM, 256 * (n0 >> 7) + (n0 & 127) + (up ? 128 : 0), kb * 64, n0, scr, lane); }
    else { const int r = it - 2 * 2816; const int kb = r / 32, nb = r % 32; cvt_item(wd, DM, DM, nullptr, Wd, FF, nb * 64, kb * 64, nb * 64, scr, lane); }
}

constexpr int GWP = 4112;
__device__ __forceinline__ void gates_rows(LAS unsigned char* lds, const bfu* __restrict__ XB, const float* __restrict__ rowss, const float* __restrict__ b_i, const float* __restrict__ b_f, float* GATES, int rb, int wave, int lane) {
    const int fr = lane & 15, fq = lane >> 4, rg = wave & 3, kh = wave >> 2;
    const LAS unsigned char* wl = lds + 16384;
    const bfu* xp = XB + (size_t)(rb * 64 + rg * 16 + fr) * DM + kh * 1024 + 8 * fq;
    f32x4 acc = (f32x4){0.f, 0.f, 0.f, 0.f};
    for (int k0 = 0; k0 < 32; k0 += 16) {
        bf16x8 xa[16];
#pragma unroll
        for (int ks = 0; ks < 16; ++ks) xa[ks] = *(const bf16x8*)(xp + (k0 + ks) * 32);
#pragma unroll
        for (int ks = 0; ks < 16; ++ks) { const bf16x8 wb = *(const LAS bf16x8*)(wl + fr * GWP + (kh * 1024 + (k0 + ks) * 32 + 8 * fq) * 2); acc = MFMA16(xa[ks], wb, acc); }
    }
    LAS f32x4* red = (LAS f32x4*)lds;
    if (kh == 1) red[rg * 64 + lane] = acc;
    __syncthreads();
    if (kh == 0 && fr < 8) {
        const f32x4 o = red[rg * 64 + lane]; const float bias = fr < 4 ? b_i[fr] : b_f[fr - 4];
#pragma unroll
        for (int j = 0; j < 4; ++j) { const int row = rb * 64 + rg * 16 + 4 * fq + j;
            const float pre = (acc[j] + o[j]) / sqrtf(rowss[row] * (1.0f / DM) + 1e-6f) + bias; const float capped = 15.0f * tanhf(pre * (1.0f / 15.0f));
            GATES[(size_t)row * 8 + fr] = fr < 4 ? capped : -log1pf(expf(-capped)); }
    }
    __syncthreads();
}

#define XB_TMO      128
#define XB_XCNT(j)  (256  + 64 * (j))
#define XB_XSUB(j)  (1280 + 64 * (j))
#define XB_XGEN(j)  (2304 + 64 * (j))
#define XB_TOP      3328
#define XB_TOPGEN   3392
#define XCD_BAR_WORDS 3456
#define XB_SPIN_CAP (1u << 18)
__device__ __forceinline__ unsigned xb_ld(unsigned* p)              { return __hip_atomic_load(p, __ATOMIC_RELAXED, __HIP_MEMORY_SCOPE_AGENT); }
__device__ __forceinline__ unsigned xb_add(unsigned* p, unsigned v) { return __hip_atomic_fetch_add(p, v, __ATOMIC_RELAXED, __HIP_MEMORY_SCOPE_AGENT); }
__device__ __forceinline__ unsigned xb_xcc_id() { return (unsigned)__builtin_amdgcn_s_getreg((3 << 11) | 20) & 0xFu; }
#define XB_SPIN(cond, bar) do { unsigned _sp = 0; while (cond) { __builtin_amdgcn_s_sleep(1); \
    if ((++_sp & 255u) == 0u) { if (xb_ld(&(bar)[XB_TMO])) break; if (_sp > XB_SPIN_CAP) { atomicAdd(&(bar)[XB_TMO], 1u); break; } } } } while (0)
__device__ __forceinline__ void xcd_barrier_complete(unsigned* bar, unsigned x, unsigned& nloc, unsigned& nx) {
    const unsigned G = gridDim.x * gridDim.y * gridDim.z;
    unsigned sum, cnt, mine, sp = 0u;
    for (;;) {
        sum = 0u; cnt = 0u; mine = 0u;
#pragma unroll
        for (unsigned j = 0; j < 16; ++j) { const unsigned c = xb_ld(&bar[XB_XCNT(j)]); sum += c; cnt += (c > 0u) ? 1u : 0u; mine = (j == x) ? c : mine; }
        if (sum == G) break;
        __builtin_amdgcn_s_sleep(1);
        if ((++sp & 255u) == 0u) { if (xb_ld(&bar[XB_TMO])) break; if (sp > XB_SPIN_CAP) { atomicAdd(&bar[XB_TMO], 1u); break; } }
    }
    nloc = mine > 0u ? mine : 1u; nx = cnt > 0u ? cnt : 1u;
}
__device__ __forceinline__ void xcd_barrier(unsigned* bar, volatile LAS unsigned* st, const bool first) {
    asm volatile("s_waitcnt vmcnt(0)" ::: "memory");
    __syncthreads();
    if (first) {
        const unsigned x = xb_xcc_id();
        __builtin_amdgcn_s_waitcnt(0);
        unsigned nloc = st[0], nx = st[1];
        if (nloc == 0u) { xcd_barrier_complete(bar, x, nloc, nx); st[0] = nloc; st[1] = nx; }
        const unsigned old = xb_add(&bar[XB_XSUB(x)], 1u);
        const unsigned gen = old / nloc;
        if (old + 1u == (gen + 1u) * nloc) {
            __builtin_amdgcn_fence(__ATOMIC_RELEASE, "agent");
            asm volatile("s_waitcnt vmcnt(0)" ::: "memory");
            const unsigned og = xb_add(&bar[XB_TOP], 1u);
            const unsigned tg = og / nx;
            if (og + 1u == (tg + 1u) * nx) xb_add(&bar[XB_TOPGEN], 1u);
            else XB_SPIN(xb_ld(&bar[XB_TOPGEN]) == tg, bar);
            __builtin_amdgcn_fence(__ATOMIC_ACQUIRE, "agent");
            xb_add(&bar[XB_XGEN(x)], 1u);
            asm volatile("s_waitcnt vmcnt(0)" ::: "memory");
        } else {
            XB_SPIN(xb_ld(&bar[XB_XGEN(x)]) == gen, bar);
            __builtin_amdgcn_fence(__ATOMIC_ACQUIRE, "agent");
            asm volatile("s_waitcnt vmcnt(0)" ::: "memory");
        }
    }
    __syncthreads();
}

struct Args { const float* in[23]; float* out; unsigned char* ws; int ph_lo, ph_hi; };
constexpr int NPH = 12;

constexpr int MP = 272;

__device__ __forceinline__ void mlstm_stage_a(LAS unsigned char* lds, const bfu* __restrict__ PROJ, const float* __restrict__ GATES, const float* __restrict__ conv_w, const float* __restrict__ conv_b,
                                              bfu* QC, bfu* KC, float* DELTA, float* DN, float* SC, int item, const int mk_wave) {
    int lane = mk_lane(); asm volatile("" : "+v"(lane));
    const int wid = mk_wave & 7, tid = wid * 64 + lane, fr = lane & 15, fq = lane >> 4;
    const int h = item & 3, row0 = (item >> 2) * 128;
    LAS float* fa = (LAS float*)lds; LAS unsigned char* KT = lds + 4096; LAS unsigned char* VT = KT + 128 * MP;
    if (tid < 128) { fa[tid] = GATES[(size_t)(row0 + tid) * 8 + 4 + h]; fa[128 + tid] = GATES[(size_t)(row0 + tid) * 8 + h]; }
    __syncthreads();
    if (tid < 128) { float b = 0.f; for (int s = 0; s <= tid; ++s) b += fa[s]; fa[256 + tid] = fa[128 + tid] - b; if (tid == 127) fa[385] = b; }
    __syncthreads();
    if (wid == 0) { float a = fmaxf(fa[256 + lane], fa[320 + lane]);
#pragma unroll
        for (int o = 1; o < 64; o <<= 1) a = fmaxf(a, __shfl_xor(a, o));
        if (lane == 0) fa[384] = a; }
    __syncthreads();
    const float amax = fa[384], blast = fa[385];
    if (tid < 128) fa[tid] = __expf(fa[256 + tid] - amax);
    if (tid == 0) { SC[item] = blast + amax; SC[512 + item] = blast; }
    __syncthreads();
    for (int task = tid; task < 4096; task += NTHR) {
        const int isk = task >> 11, t2 = task & 2047, d = t2 & 127, s0 = (t2 >> 7) * 8, ch = isk * 512 + h * 128 + d;
        const float w0 = conv_w[ch], w1 = conv_w[1024 + ch], w2 = conv_w[2048 + ch], w3 = conv_w[3072 + ch], bias = conv_b[ch];
        float x[11];
#pragma unroll
        for (int i = 0; i < 11; ++i) { const int r = row0 + s0 - 3 + i; x[i] = r >= 0 ? bf2f(PROJ[(size_t)r * PLD + C_MQ + ch]) : 0.f; }
        float y[8];
#pragma unroll
        for (int i = 0; i < 8; ++i) y[i] = silu(bias + w0 * x[i] + w1 * x[i + 1] + w2 * x[i + 2] + w3 * x[i + 3]);
        if (!isk) {
#pragma unroll
            for (int i = 0; i < 8; ++i) QC[(size_t)(row0 + s0 + i) * 512 + h * 128 + d] = (bfu)f2bf(y[i] * 0.08838834764831845f);
        } else {
#pragma unroll
            for (int i = 0; i < 8; ++i) { KC[(size_t)(row0 + s0 + i) * 512 + h * 128 + d] = (bfu)f2bf(y[i]); y[i] *= fa[s0 + i]; }
            v4u o; o.x = pk2(y[0], y[1]); o.y = pk2(y[2], y[3]); o.z = pk2(y[4], y[5]); o.w = pk2(y[6], y[7]);
            *(LAS v4u*)(KT + d * MP + s0 * 2) = o;
        }
    }
    for (int task = tid; task < 4096; task += NTHR) {
        const int sidx = task & 127, e0 = (task >> 7) * 8;
        const v4u v = *(const v4u*)(PROJ + (size_t)(row0 + sidx) * PLD + C_MV + h * 256 + e0);
        LAS unsigned short* d = (LAS unsigned short*)(VT + e0 * MP + sidx * 2);
        d[0 * (MP / 2)] = (unsigned short)(v.x & 0xffffu); d[1 * (MP / 2)] = (unsigned short)(v.x >> 16); d[2 * (MP / 2)] = (unsigned short)(v.y & 0xffffu); d[3 * (MP / 2)] = (unsigned short)(v.y >> 16);
        d[4 * (MP / 2)] = (unsigned short)(v.z & 0xffffu); d[5 * (MP / 2)] = (unsigned short)(v.z >> 16); d[6 * (MP / 2)] = (unsigned short)(v.w & 0xffffu); d[7 * (MP / 2)] = (unsigned short)(v.w >> 16);
    }
    __syncthreads();
    f32x4 acc[2][8];
#pragma unroll
    for (int mt = 0; mt < 2; ++mt)
#pragma unroll
        for (int nt = 0; nt < 8; ++nt) acc[mt][nt] = (f32x4){0.f, 0.f, 0.f, 0.f};
#pragma unroll
    for (int ks = 0; ks < 4; ++ks) {
        bf16x8 a[2];
#pragma unroll
        for (int mt = 0; mt < 2; ++mt) a[mt] = *(const LAS bf16x8*)(VT + (32 * wid + 16 * mt + fr) * MP + (32 * ks + 8 * fq) * 2);
#pragma unroll
        for (int nt = 0; nt < 8; ++nt) { const bf16x8 b = *(const LAS bf16x8*)(KT + (16 * nt + fr) * MP + (32 * ks + 8 * fq) * 2);
            acc[0][nt] = MFMA16(a[0], b, acc[0][nt]); acc[1][nt] = MFMA16(a[1], b, acc[1][nt]); }
    }
    float* dst = DELTA + (size_t)item * 32768;
#pragma unroll
    for (int mt = 0; mt < 2; ++mt)
#pragma unroll
        for (int nt = 0; nt < 8; ++nt)
#pragma unroll
            for (int j = 0; j < 4; ++j) dst[(32 * wid + 16 * mt + 4 * fq + j) * 128 + 16 * nt + fr] = acc[mt][nt][j];
    if (tid < 128) { float s = 0.f; for (int i = 0; i < 128; ++i) s += bf2f(*(const LAS unsigned short*)(KT + tid * MP + i * 2)); DN[(size_t)item * 128 + tid] = s; }
    __syncthreads();
}

__device__ __forceinline__ void mlstm_scan(LAS unsigned char* lds, const float* __restrict__ DELTA, const float* __restrict__ DN, const float* __restrict__ SC, float* MPREV, bfu* __restrict__ CT, float* __restrict__ NST,
                                           int tid, int gtid, int nthreads) {
    LAS float* fdec = (LAS float*)lds; LAS float* fin = fdec + 512; LAS float* mpv = fdec + 1024;
    if (tid < 4) { float m = 0.f;
        for (int c = 0; c < 128; ++c) { const int item = c * 4 + tid; const float mloc = SC[item], bl = SC[512 + item], mn = fmaxf(bl + m, mloc);
            mpv[tid * 128 + c] = m; fdec[tid * 128 + c] = __expf(bl + m - mn); fin[tid * 128 + c] = __expf(mloc - mn); m = mn; } }
    __syncthreads();
    for (int idx = gtid; idx < 4 * 32768 + 512; idx += nthreads) {
        const bool main_ = idx < 4 * 32768;
        const int h = main_ ? (idx >> 15) : ((idx - 4 * 32768) >> 7), rem = main_ ? (idx & 32767) : ((idx - 4 * 32768) & 127);
        const float* src = main_ ? DELTA + (size_t)h * 32768 + rem : DN + h * 128 + rem; const size_t sstride = main_ ? 4 * 32768 : 512;
        float C = 0.f; float d8[8], e8[8];
#pragma unroll
        for (int i = 0; i < 8; ++i) d8[i] = src[(size_t)i * sstride];
        for (int c0 = 0; c0 < 128; c0 += 8) {
            if (c0 + 8 < 128) {
#pragma unroll
                for (int i = 0; i < 8; ++i) e8[i] = src[(size_t)(c0 + 8 + i) * sstride];
            }
#pragma unroll
            for (int i = 0; i < 8; ++i) { const int c = c0 + i, item = c * 4 + h;
                if (main_) { CT[(size_t)item * 32768 + rem] = (bfu)f2bf(C); if (rem == 0) MPREV[item] = mpv[h * 128 + c]; } else NST[(size_t)item * 128 + rem] = C;
                C = fdec[h * 128 + c] * C + fin[h * 128 + c] * d8[i]; }
#pragma unroll
            for (int i = 0; i < 8; ++i) d8[i] = e8[i];
        }
    }
    __syncthreads();
}

__device__ __forceinline__ void mlstm_stage_c(LAS unsigned char* lds, const bfu* __restrict__ PROJ, const float* __restrict__ GATES, const bfu* __restrict__ QC, const bfu* __restrict__ KC,
                                              const bfu* __restrict__ CT, const float* __restrict__ NST, const float* __restrict__ MPREV, const float* __restrict__ hgain, bfu* Y, int item, const int mk_wave) {
    int lane = mk_lane(); asm volatile("" : "+v"(lane));
    const int wid = mk_wave & 7, tid = wid * 64 + lane, fr = lane & 15, fq = lane >> 4;
    const int h = item & 3, row0 = (item >> 2) * 128;
    LAS float* fa = (LAS float*)lds;
    LAS unsigned char* Qs = lds + 4096; LAS unsigned char* Ks = Qs + 128 * MP; LAS unsigned char* BUF = Ks + 128 * MP;
    if (tid < 128) { fa[768 + tid] = GATES[(size_t)(row0 + tid) * 8 + 4 + h]; fa[896 + tid] = GATES[(size_t)(row0 + tid) * 8 + h]; fa[640 + tid] = NST[(size_t)item * 128 + tid]; }
    __syncthreads();
    float bt_ = 0.f;
    if (tid < 128) { for (int s = 0; s <= tid; ++s) bt_ += fa[768 + s]; fa[tid] = fa[896 + tid] - bt_; }
    __syncthreads();
    if (tid < 128) { const float mp = MPREV[item]; float pm = -3.0e38f; for (int s = 0; s <= tid; ++s) pm = fmaxf(pm, fa[s]);
        const float M = fmaxf(mp, pm); fa[128 + tid] = M; fa[256 + tid] = __expf(mp - M); fa[384 + tid] = __expf(-(bt_ + M)); }
    for (int t = tid; t < 2048; t += NTHR) { const int r = t >> 4, c = t & 15;
        *(LAS v4u*)(Qs + r * MP + c * 16) = *(const v4u*)(QC + (size_t)(row0 + r) * 512 + h * 128 + c * 8);
        *(LAS v4u*)(Ks + r * MP + c * 16) = *(const v4u*)(KC + (size_t)(row0 + r) * 512 + h * 128 + c * 8); }
    for (int t = tid; t < 4096; t += NTHR) { const int r = t >> 4, c = t & 15; *(LAS v4u*)(BUF + r * MP + c * 16) = *(const v4u*)(CT + (size_t)item * 32768 + r * 128 + c * 8); }
    __syncthreads();
    {
        const int t = 16 * wid + fr; float s = 0.f;
#pragma unroll
        for (int i = 0; i < 32; ++i) s += bf2f(*(const LAS unsigned short*)(Qs + t * MP + (32 * fq + i) * 2)) * fa[640 + 32 * fq + i];
        s += __shfl_xor(s, 16); s += __shfl_xor(s, 32); if (fq == 0) fa[512 + t] = s;
    }
    f32x4 sa[8];
#pragma unroll
    for (int nt = 0; nt < 8; ++nt) sa[nt] = (f32x4){0.f, 0.f, 0.f, 0.f};
    bf16x8 qa[4];
#pragma unroll
    for (int ks = 0; ks < 4; ++ks) qa[ks] = *(const LAS bf16x8*)(Qs + (16 * wid + fr) * MP + (32 * ks + 8 * fq) * 2);
#pragma unroll
    for (int nt = 0; nt < 8; ++nt) if (nt <= wid) {
#pragma unroll
        for (int ks = 0; ks < 4; ++ks) { const bf16x8 b = *(const LAS bf16x8*)(Ks + (16 * nt + fr) * MP + (32 * ks + 8 * fq) * 2); sa[nt] = MFMA16(qa[ks], b, sa[nt]); } }
    float Mt[4], rsum[4];
#pragma unroll
    for (int j = 0; j < 4; ++j) { Mt[j] = fa[128 + 16 * wid + 4 * fq + j]; rsum[j] = 0.f; }
#pragma unroll
    for (int nt = 0; nt < 8; ++nt) { const int s = 16 * nt + fr; const float as = fa[s];
#pragma unroll
        for (int j = 0; j < 4; ++j) { const int t = 16 * wid + 4 * fq + j; const float p = (s <= t) ? sa[nt][j] * __expf(as - Mt[j]) : 0.f; sa[nt][j] = p; rsum[j] += p; } }
#pragma unroll
    for (int j = 0; j < 4; ++j) { float v = rsum[j]; v += __shfl_xor(v, 1); v += __shfl_xor(v, 2); v += __shfl_xor(v, 4); v += __shfl_xor(v, 8); rsum[j] = v; }
    f32x4 num[16];
#pragma unroll
    for (int nt = 0; nt < 16; ++nt) num[nt] = (f32x4){0.f, 0.f, 0.f, 0.f};
#pragma unroll
    for (int ks = 0; ks < 4; ++ks)
#pragma unroll
        for (int nt = 0; nt < 16; ++nt) { const bf16x8 b = *(const LAS bf16x8*)(BUF + (16 * nt + fr) * MP + (32 * ks + 8 * fq) * 2); num[nt] = MFMA16(qa[ks], b, num[nt]); if ((nt & 3) == 3) __builtin_amdgcn_sched_barrier(0); }
    float g4[4], den[4];
#pragma unroll
    for (int j = 0; j < 4; ++j) { const int t = 16 * wid + 4 * fq + j; g4[j] = fa[256 + t]; den[j] = fmaxf(fabsf(g4[j] * fa[512 + t] + rsum[j]), fa[384 + t]); }
#pragma unroll
    for (int nt = 0; nt < 16; ++nt)
#pragma unroll
        for (int j = 0; j < 4; ++j) num[nt][j] *= g4[j];
    __syncthreads();
#pragma unroll
    for (int nt = 0; nt < 8; ++nt)
#pragma unroll
        for (int j = 0; j < 4; ++j) *(LAS unsigned short*)(Ks + (16 * wid + 4 * fq + j) * MP + (16 * nt + fr) * 2) = (unsigned short)f2bf(sa[nt][j]);
    for (int task = tid; task < 4096; task += NTHR) {
        const int sidx = task & 127, e0 = (task >> 7) * 8;
        const v4u v = *(const v4u*)(PROJ + (size_t)(row0 + sidx) * PLD + C_MV + h * 256 + e0);
        LAS unsigned short* d = (LAS unsigned short*)(BUF + e0 * MP + sidx * 2);
        d[0 * (MP / 2)] = (unsigned short)(v.x & 0xffffu); d[1 * (MP / 2)] = (unsigned short)(v.x >> 16); d[2 * (MP / 2)] = (unsigned short)(v.y & 0xffffu); d[3 * (MP / 2)] = (unsigned short)(v.y >> 16);
        d[4 * (MP / 2)] = (unsigned short)(v.z & 0xffffu); d[5 * (MP / 2)] = (unsigned short)(v.z >> 16); d[6 * (MP / 2)] = (unsigned short)(v.w & 0xffffu); d[7 * (MP / 2)] = (unsigned short)(v.w >> 16);
    }
    __syncthreads();
#pragma unroll
    for (int ks = 0; ks < 4; ++ks) { const bf16x8 pa = *(const LAS bf16x8*)(Ks + (16 * wid + fr) * MP + (32 * ks + 8 * fq) * 2);
#pragma unroll
        for (int nt = 0; nt < 16; ++nt) { const bf16x8 b = *(const LAS bf16x8*)(BUF + (16 * nt + fr) * MP + (32 * ks + 8 * fq) * 2); num[nt] = MFMA16(pa, b, num[nt]); if ((nt & 3) == 3) __builtin_amdgcn_sched_barrier(0); } }
    float ssq[4];
#pragma unroll
    for (int j = 0; j < 4; ++j) { const float rd = 1.0f / den[j]; float s = 0.f;
#pragma unroll
        for (int nt = 0; nt < 16; ++nt) { const float v = num[nt][j] * rd; num[nt][j] = v; s += v * v; }
        s += __shfl_xor(s, 1); s += __shfl_xor(s, 2); s += __shfl_xor(s, 4); s += __shfl_xor(s, 8); ssq[j] = 1.0f / sqrtf(s * (1.0f / 256.0f) + 1e-6f); }
    __syncthreads();
    LAS float* HS = (LAS float*)(lds + 4096);
#pragma unroll
    for (int nt = 0; nt < 16; ++nt)
#pragma unroll
        for (int j = 0; j < 4; ++j) HS[(16 * wid + 4 * fq + j) * 260 + 16 * nt + fr] = num[nt][j] * ssq[j];
    __syncthreads();
    for (int task = tid; task < 4096; task += NTHR) {
        const int r = task >> 5, c8 = (task & 31) * 8; const size_t row = (size_t)(row0 + r);
        const f32x4 h0 = *(const LAS f32x4*)(HS + r * 260 + c8), h1 = *(const LAS f32x4*)(HS + r * 260 + c8 + 4);
        const f32x4 g0 = *(const f32x4*)(hgain + h * 256 + c8), g1 = *(const f32x4*)(hgain + h * 256 + c8 + 4);
        const v4u mo = *(const v4u*)(PROJ + row * PLD + C_MO + h * 256 + c8);
        v4u o;
        o.x = pk2(h0[0] * g0[0] / (1.0f + __expf(-bf2f(mo.x & 0xffffu))), h0[1] * g0[1] / (1.0f + __expf(-bf2f(mo.x >> 16))));
        o.y = pk2(h0[2] * g0[2] / (1.0f + __expf(-bf2f(mo.y & 0xffffu))), h0[3] * g0[3] / (1.0f + __expf(-bf2f(mo.y >> 16))));
        o.z = pk2(h1[0] * g1[0] / (1.0f + __expf(-bf2f(mo.z & 0xffffu))), h1[1] * g1[1] / (1.0f + __expf(-bf2f(mo.z >> 16))));
        o.w = pk2(h1[2] * g1[2] / (1.0f + __expf(-bf2f(mo.w & 0xffffu))), h1[3] * g1[3] / (1.0f + __expf(-bf2f(mo.w >> 16))));
        *(v4u*)(Y + row * DM + 1024 + h * 256 + c8) = o;
    }
    __syncthreads();
}

__device__ __forceinline__ att::BlockRef<att::bf16, att::bf16> att_ref(int i, int pass, const bfu* PROJ, bfu* OATT) {
    int ph, x;
    if (gridDim.x == 256) { ph = ((i >> 8) & 1) * 8 + (blockIdx.x & 7); x = blockIdx.x >> 3; }
    else { ph = (i >> 5) & 15; x = i & 31; }
    const int qb = pass ? 63 - x : x, h = ph >> 2, c = (ph >> 1) & 1, vh = ph & 1;
    att::BlockRef<att::bf16, att::bf16> r;
    constexpr size_t MSZ = (size_t)16384 * 128;
    r.Q = (const att::bf16*)(PROJ + (size_t)(2 * h + c) * MSZ + (size_t)qb * 256 * 128);
    r.K = (const att::bf16*)(PROJ + (size_t)(8 + 2 * h + c) * MSZ);
    r.V = (const att::bf16*)(PROJ + (size_t)(16 + 2 * h + vh) * MSZ);
    r.O = (att::bf16*)(OATT + (size_t)qb * 256 * 2048 + h * 512 + c * 256 + vh * 128);
    r.P0 = qb * 256;
    return r;
}
__device__ __forceinline__ void attn_phase(char* lds, const bfu* PROJ, bfu* OATT, const int TOTAL, const int mk_wave) {
    using namespace att;
    int i = blockIdx.x; if (i >= TOTAL) return;
    int pass = 0;
    BlockRef<bf16, bf16> cur = att_ref(i, 0, PROJ, OATT);
    Seam<bf16> S;
    causal_swa_prime<bf16, bf16>(cur, S_, lds, S, mk_wave);
    for (;;) {
        const bool more_pass = pass == 0, more_item = i + (int)gridDim.x < TOTAL, last = !more_pass && !more_item;
        int in_ = i, passn = pass + 1;
        if (!more_pass) { passn = 0; in_ = more_item ? i + (int)gridDim.x : i; }
        const BlockRef<bf16, bf16> nxt = last ? cur : att_ref(in_, passn, PROJ, OATT);
        causal_swa_block<bf16, bf16>(cur, nxt, S_, S_, lds, S, mk_wave);
        if (last) break;
        cur = nxt; i = in_; pass = passn;
    }
}

#ifndef ATTN2
#define ATTN2 5
#endif
__device__ __forceinline__ att::A2Ref att2_ref(int i, int pass, const bfu* PROJ, bfu* OATT) {
    int hc, x;
    if (gridDim.x == 256) { hc = blockIdx.x & 7; x = ((i >> 8) & 1) * 32 + (blockIdx.x >> 3); }
    else { hc = (i >> 6) & 7; x = i & 63; }
    const int qb = pass ? 127 - x : x, h = hc >> 1, c = hc & 1;
    constexpr size_t MSZ = (size_t)16384 * 128;
    att::A2Ref r;
    r.Q = (const att::bf16*)(PROJ + (size_t)(2 * h + c) * MSZ + (size_t)qb * 128 * 128);
    r.K = (const att::bf16*)(PROJ + (size_t)(8 + 2 * h + c) * MSZ);
    r.V0 = (const att::bf16*)(PROJ + (size_t)(16 + 2 * h) * MSZ); r.V1 = (const att::bf16*)(PROJ + (size_t)(16 + 2 * h + 1) * MSZ);
    r.O = (att::bf16*)(OATT + (size_t)qb * 128 * 2048 + h * 512 + c * 256);
    r.P0 = qb * 128;
    return r;
}
__device__ __forceinline__ void attn2_phase(char* lds, const bfu* PROJ, bfu* OATT, const int TOTAL, const int mk_wave) {
    for (int i = blockIdx.x; i < TOTAL; i += gridDim.x)
        for (int pass = 0; pass < 2; ++pass) { const att::A2Ref r = att2_ref(i, pass, PROJ, OATT); att::attn9_block(r, lds, (__attribute__((address_space(3))) unsigned char*)lds, mk_wave); }
}

__global__ void __launch_bounds__(NTHR, 2) mega_fwd(Args args) {
    extern __shared__ __attribute__((aligned(16))) unsigned char lds_raw[];
    LAS unsigned char* lds = (LAS unsigned char*)lds_raw;
    const int wave = __builtin_amdgcn_readfirstlane((int)threadIdx.x >> 6);
    const int G = gridDim.x, gw = blockIdx.x * NWAVES + wave, NGW = G * NWAVES;
#define AS4 __attribute__((address_space(4)))
#define PH_BEGIN int koff_ = 0; asm volatile("" : "+s"(koff_)); const AS4 char* kp_ = (const AS4 char*)__builtin_amdgcn_kernarg_segment_ptr() + koff_; \
    unsigned char* ws = *(unsigned char* const AS4*)(kp_ + 192); float* out = *(float* const AS4*)(kp_ + 184); (void)out; (void)ws; const int lane = mk_lane(), tid = wave * 64 + lane; (void)tid; (void)lane;
#define KIN(i) (*(const float* const AS4*)(kp_ + 8 * (i)))
#define Wgu ((bfu*)(ws + WS_WGU))
#define Wd ((bfu*)(ws + WS_WD))
#define Win ((bfu*)(ws + WS_WIN))
#define Wout ((bfu*)(ws + WS_WOUT))
#define XN ((bfu*)(ws + WS_XN))
#define BIG ((bfu*)(ws + WS_BIG))
#define Y ((bfu*)(ws + WS_Y))
#define CT ((bfu*)(ws + WS_CT))
#define QC ((bfu*)(ws + WS_QC))
#define KC ((bfu*)(ws + WS_KC))
#define NST ((float*)(ws + WS_NST))
#define rowss1 ((float*)(ws + WS_ROWSS1))
#define rowss2 ((float*)(ws + WS_ROWSS2))
#define SC ((float*)(ws + WS_SC))
#define DN ((float*)(ws + WS_DN))
#define GATES ((float*)(ws + WS_GATES))
#define DELTA ((float*)(ws + WS_XN))
#define OATT ((bfu*)(ws + WS_XN))
#define PROJM (BIG + (size_t)24 * 16384 * 128)
    const int lo = args.ph_lo, hi = args.ph_hi;
    if (hi - lo > 1) {
        if (wave == 0 && mk_lane() == 0) { volatile LAS unsigned* st = (volatile LAS unsigned*)(lds + LDS_BYTES - 64); st[0] = 0u; st[1] = 0u;
            (void)xb_add(&((unsigned*)(args.ws + WS_BAR))[XB_XCNT(xb_xcc_id())], 1u); }
        __syncthreads();
    }
#ifndef PHMASK
#define PHMASK 0xfff
#endif
#define IN(k) (((PHMASK >> (k)) & 1) && lo <= (k) && (k) < hi)
#ifndef PROBE_MASK
#define PROBE_MASK 0
#endif
#define NREP(k) (((PROBE_MASK >> (k)) & 1) ? 2 : 1)
#define STAGGER_DELAY(N) do { const int sn_ = (int)((blockIdx.x >> 3) & 3) * (N); for (int sd_ = 0; sd_ < sn_; ++sd_) __builtin_amdgcn_s_sleep(85); } while (0)
#define SYNC(k) do { if (IN(k) && IN((k) + 1)) { if (lo < 0) cg::this_grid().sync();     \
        { int kb_ = 0; asm volatile("" : "+s"(kb_)); unsigned char* wsb_ = *(unsigned char* const AS4*)((const AS4 char*)__builtin_amdgcn_kernarg_segment_ptr() + kb_ + 192); \
               xcd_barrier((unsigned*)(wsb_ + WS_BAR), (volatile LAS unsigned*)(lds + LDS_BYTES - 64), wave == 0 && mk_lane() == 0); \
               if ((PROBE_MASK >> 14) & 1) xcd_barrier((unsigned*)(wsb_ + WS_BAR), (volatile LAS unsigned*)(lds + LDS_BYTES - 64), wave == 0 && mk_lane() == 0); } } } while (0)

    if (IN(0)) for (int rep_ = 0; rep_ < NREP(0); ++rep_) { PH_BEGIN
        const float* x = KIN(0);
        LAS float* scr = (LAS float*)(lds + wave * 16640);
        constexpr int I_FFN = 3 * 2816, I_IN = 32 * 96, I_OUT = 32 * 32;
        for (int it = gw; it < I_FFN + I_IN + I_OUT; it += NGW) {
            if (it < I_FFN) cvt_ffn_item(it, KIN(2), KIN(3), KIN(4), KIN(1), Wgu, Wd, scr, lane);
            else if (it < I_FFN + I_IN) { const int r = it - I_FFN, kb = r / 96, nb = r % 96; cvt_item(KIN(6), NIN, NIN, KIN(5), Win, DM, nb * 64, kb * 64, nb * 64, scr, lane); }
            else { const int r = it - I_FFN - I_IN, kb = r / 32, nb = r % 32; cvt_item(KIN(17), DM, DM, nullptr, Wout, DM, nb * 64, kb * 64, nb * 64, scr, lane); }
        }
        for (int m = gw; m < S_; m += NGW) {
            const f32x4* xr = (const f32x4*)(x + (size_t)m * DM) + lane; f32x4 v[8]; float s = 0.f;
#pragma unroll
            for (int j = 0; j < 8; ++j) { v[j] = xr[64 * j]; s += (v[j][0] * v[j][0] + v[j][1] * v[j][1]) + (v[j][2] * v[j][2] + v[j][3] * v[j][3]); }
            const float rs = 1.0f / sqrtf(wave_sum(s) * (1.0f / DM) + 1e-6f);
            v2u* o8 = (v2u*)(XN + (size_t)m * DM) + lane;
#pragma unroll
            for (int j = 0; j < 8; ++j) { v2u w; w.x = pk2(v[j][0] * rs, v[j][1] * rs); w.y = pk2(v[j][2] * rs, v[j][3] * rs); o8[64 * j] = w; }
        }
        for (int i = blockIdx.x * NTHR + tid; i < 2 * S_; i += G * NTHR) rowss1[i] = 0.f;
        for (int k = blockIdx.x * NTHR + tid; k < DM + 8; k += G * NTHR) {
            unsigned char* gwp = ws + WS_GW; f32x4 w0 = (f32x4){0.f, 0.f, 0.f, 0.f}, w1 = w0;
            if (k < DM) { const float gk = KIN(5)[k]; w0 = *(const f32x4*)(KIN(6) + (size_t)k * NIN + 6144) * gk; w1 = *(const f32x4*)(KIN(6) + (size_t)k * NIN + 6148) * gk; }
#pragma unroll
            for (int j = 0; j < 4; ++j) { *(unsigned short*)(gwp + j * GWP + k * 2) = (unsigned short)f2bf(w0[j]); *(unsigned short*)(gwp + (4 + j) * GWP + k * 2) = (unsigned short)f2bf(w1[j]);
                *(unsigned short*)(gwp + (8 + j) * GWP + k * 2) = 0; *(unsigned short*)(gwp + (12 + j) * GWP + k * 2) = 0; }
        }
    }
    SYNC(0);
    if (IN(1)) { PH_BEGIN
        pg8::Gemm g{XN, Wgu, S_, 2 * FF, DM}; pg8::StaticOrder So; So.init(S_, 2 * FF, G, (int)blockIdx.x);
        pg8::EpiSwiGLU E{BIG, FF, nullptr, 0.f};
        STAGGER_DELAY(1); for (int rep_ = 0; rep_ < NREP(1); ++rep_) pg8::gemm_phase<pg8::EpiSwiGLU, pg8::StaticOrder, true, true>(lds, g, So, E, wave);
    }
    SYNC(1);
    if (IN(2)) { PH_BEGIN
        pg8::Gemm g{BIG, Wd, S_, DM, FF}; pg8::StaticOrder So; So.init(S_, DM, G, (int)blockIdx.x);
        pg8::EpiResid E{KIN(0), out, XN, rowss1, 0.5f, DM};
        STAGGER_DELAY(3); pg8::gemm_phase<pg8::EpiResid, pg8::StaticOrder, true, true>(lds, g, So, E, wave);
    }
    SYNC(2);
    if (IN(3)) { PH_BEGIN
        pg8::Gemm g{XN, Win, S_, NINP, DM}; pg8::StaticOrder So; So.init(S_, NINP, G, (int)blockIdx.x);
        pg8::EpiProj E{BIG, rowss1, 1.0f / DM};
        STAGGER_DELAY(1); for (int rep_ = 0; rep_ < NREP(3); ++rep_) pg8::gemm_phase<pg8::EpiProj, pg8::StaticOrder, true, true>(lds, g, So, E, wave);
        {
            const v4u* src = (const v4u*)(ws + WS_GW);
            for (int i = tid; i < 16 * GWP / 16; i += NTHR) *(LAS v4u*)(lds + 16384 + i * 16) = src[i];
            __syncthreads();
        }
        for (int rep_ = 0; rep_ < NREP(13); ++rep_) for (int rb = blockIdx.x; rb < S_ / 64; rb += G) gates_rows(lds, XN, rowss1, KIN(14), KIN(15), GATES, rb, wave, lane);
    }
    SYNC(3);
    if (IN(4)) { PH_BEGIN for (int item = blockIdx.x; item < 512 * NREP(4); item += G) mlstm_stage_a(lds, PROJM, GATES, KIN(12), KIN(13), QC, KC, DELTA, DN, SC, item & 511, wave); }
    SYNC(4);
    if (IN(5)) { PH_BEGIN for (int rep_ = 0; rep_ < NREP(5); ++rep_) mlstm_scan(lds, DELTA, DN, SC, SC + 1024, CT, NST, tid, blockIdx.x * NTHR + tid, G * NTHR); }
    SYNC(5);
    if (IN(6)) { PH_BEGIN
#ifndef NO_ATTN
#if ATTN2
        attn2_phase((char*)lds_raw, BIG, OATT, 512 * NREP(6), wave);
#else
        attn_phase((char*)lds_raw, BIG, OATT, 512 * NREP(6), wave);
#endif
#endif
        __syncthreads();
#ifndef NO_STAGEC
        for (int rep_ = 0; rep_ < NREP(12); ++rep_) for (int item = blockIdx.x; item < 512; item += G) mlstm_stage_c(lds, PROJM, GATES, QC, KC, CT, NST, SC + 1024, KIN(16), Y, item, wave);
#endif
        {
            LAS float* scr = (LAS float*)(lds + wave * 16640);
            for (int it = gw; it < 3 * 2816; it += NGW) cvt_ffn_item(it, KIN(19), KIN(20), KIN(21), KIN(18), Wgu, Wd, scr, lane);
        }
    }
    SYNC(6);
    if (IN(7)) for (int rep_ = 0; rep_ < NREP(7); ++rep_) { PH_BEGIN
        const float l1 = wave_sum(KIN(7)[lane] * KIN(8)[lane] + KIN(7)[lane + 64] * KIN(8)[lane + 64]);
        const float l2 = wave_sum(KIN(9)[lane] * KIN(10)[lane] + KIN(9)[lane + 64] * KIN(10)[lane + 64]);
        const float lam = expf(l1) - expf(l2) + 0.2f;
        const float* hg = KIN(11);
        for (int m = gw; m < S_; m += NGW) {
#pragma unroll
            for (int h = 0; h < 4; ++h) {
                const v2u a = *((const v2u*)(OATT + (size_t)m * 2048 + h * 512) + lane), b = *((const v2u*)(OATT + (size_t)m * 2048 + h * 512 + 256) + lane);
                float y0 = bf2f(a.x & 0xffffu) - lam * bf2f(b.x & 0xffffu), y1 = bf2f(a.x >> 16) - lam * bf2f(b.x >> 16), y2 = bf2f(a.y & 0xffffu) - lam * bf2f(b.y & 0xffffu), y3 = bf2f(a.y >> 16) - lam * bf2f(b.y >> 16);
                const float rs = 0.8f / sqrtf(wave_sum((y0 * y0 + y1 * y1) + (y2 * y2 + y3 * y3)) * (1.0f / 256.0f) + 1e-6f);
                const f32x4 gn = *((const f32x4*)(hg + h * 256) + lane);
                v2u w; w.x = pk2(y0 * rs * gn[0], y1 * rs * gn[1]); w.y = pk2(y2 * rs * gn[2], y3 * rs * gn[3]);
                *((v2u*)(Y + (size_t)m * DM + h * 256) + lane) = w;
            }
        }
    }
    SYNC(7);
    if (IN(8)) { PH_BEGIN
        pg8::Gemm g{Y, Wout, S_, DM, DM}; pg8::StaticOrder So; So.init(S_, DM, G, (int)blockIdx.x);
        pg8::EpiResid E{out, out, XN, rowss2, 1.0f, DM};
        STAGGER_DELAY(3); pg8::gemm_phase<pg8::EpiResid, pg8::StaticOrder, true, true>(lds, g, So, E, wave);
    }
    SYNC(8);
    if (IN(9)) { PH_BEGIN
        pg8::Gemm g{XN, Wgu, S_, 2 * FF, DM}; pg8::StaticOrder So; So.init(S_, 2 * FF, G, (int)blockIdx.x);
        pg8::EpiSwiGLU E{BIG, FF, rowss2, 1.0f / DM};
        STAGGER_DELAY(1); pg8::gemm_phase<pg8::EpiSwiGLU, pg8::StaticOrder, true, true>(lds, g, So, E, wave);
    }
    SYNC(9);
    if (IN(10)) { PH_BEGIN
        pg8::Gemm g{BIG, Wd, S_, DM, FF}; pg8::StaticOrder So; So.init(S_, DM, G, (int)blockIdx.x);
        pg8::EpiResid E{out, out, nullptr, nullptr, 0.5f, DM};
        STAGGER_DELAY(3); pg8::gemm_phase<pg8::EpiResid, pg8::StaticOrder, true, true>(lds, g, So, E, wave);
    }
    SYNC(10);
    if (IN(11)) { PH_BEGIN
        const float* fg = KIN(22);
        for (int m = gw; m < S_; m += NGW) {
            f32x4* xr = (f32x4*)(out + (size_t)m * DM) + lane; f32x4 v[8]; float s = 0.f;
#pragma unroll
            for (int j = 0; j < 8; ++j) { v[j] = xr[64 * j]; s += (v[j][0] * v[j][0] + v[j][1] * v[j][1]) + (v[j][2] * v[j][2] + v[j][3] * v[j][3]); }
            const float rs = 1.0f / sqrtf(wave_sum(s) * (1.0f / DM) + 1e-6f);
#pragma unroll
            for (int j = 0; j < 8; ++j) { const f32x4 gn = *((const f32x4*)fg + 64 * j + lane); xr[64 * j] = v[j] * rs * gn; }
        }
    }
#undef IN
#undef SYNC
}

extern "C" void kernel_launch(void* const* d_in, const int* in_sizes, int n_in, void* d_out, int out_size, void* d_ws, size_t ws_size, hipStream_t stream) {
    static int grid = 0;
    if (grid == 0) {
        if (n_in != 23 || in_sizes[0] != S_ * DM || out_size != S_ * DM || ws_size < WS_END) { fprintf(stderr, "kernel_launch: unexpected shapes (n_in %d, in0 %d, out %d, ws %zu)\n", n_in, n_in > 0 ? in_sizes[0] : -1, out_size, ws_size); grid = -1; return; }
        int dev = 0, cus = 0, per_cu = 0;
        (void)hipGetDevice(&dev); (void)hipDeviceGetAttribute(&cus, hipDeviceAttributeMultiprocessorCount, dev);
        if (hipFuncSetAttribute((const void*)mega_fwd, hipFuncAttributeMaxDynamicSharedMemorySize, LDS_BYTES) != hipSuccess) { fprintf(stderr, "kernel_launch: hipFuncSetAttribute failed\n"); grid = -1; return; }
        if (hipOccupancyMaxActiveBlocksPerMultiprocessor(&per_cu, (const void*)mega_fwd, NTHR, LDS_BYTES) != hipSuccess || per_cu < 1) per_cu = 1;
        grid = cus * per_cu;
        fprintf(stderr, "kernel_launch: grid %d (%d CUs x %d)\n", grid, cus, per_cu);
    }
    if (grid < 0) return;
    Args a{};
    for (int i = 0; i < 23; ++i) a.in[i] = (const float*)d_in[i];
    a.out = (float*)d_out; a.ws = (unsigned char*)d_ws;
#if MK_SPLIT
    for (int p = 0; p < NPH; ++p) { a.ph_lo = p; a.ph_hi = p + 1; hipLaunchKernelGGL(mega_fwd, dim3(grid), dim3(NTHR), LDS_BYTES, stream, a); }
#else
    a.ph_lo = 0; a.ph_hi = NPH;
    (void)hipMemsetAsync((char*)d_ws + WS_BAR, 0, XCD_BAR_WORDS * 4, stream);
    void* kargs[] = {&a};
    hipError_t e = hipLaunchCooperativeKernel((const void*)mega_fwd, dim3(grid), dim3(NTHR), kargs, LDS_BYTES, stream);
    if (e != hipSuccess) fprintf(stderr, "kernel_launch: cooperative launch failed: %s (grid %d)\n", hipGetErrorString(e), grid);
#endif
}
```

```cpp
#include <hip/hip_runtime.h>
#include <hip/hip_bf16.h>
#include <hip/hip_cooperative_groups.h>
#include <cstdio>
#include <cstdint>
namespace cg = cooperative_groups;

#ifndef MK_SPLIT
#define MK_SPLIT 0
#endif

namespace pg8 {
#define PG8_LAS __attribute__((address_space(3)))
typedef unsigned short bf16_t;
typedef short bf16x8 __attribute__((ext_vector_type(8)));
typedef float f32x4 __attribute__((ext_vector_type(4)));
typedef unsigned u32x4 __attribute__((ext_vector_type(4)));
constexpr int BM = 256, BK = 64, HALF = 128, HTB = HALF * BK * 2  , STAGE_BYTES = 8 * HTB, NXCD = 8, WGM = 8;

__host__ __device__ __forceinline__ int lds_byte(int r, int c) { const int st = (r >> 4) * 2 + (c >> 5), rr = r & 15, cc = c & 31, ob = rr * 64 + cc * 2; return st * 1024 + (ob ^ (((ob >> 9) & 1) << 5)); }
__host__ __device__ __forceinline__ void stage_rc(int b, int& R, int& C) { const int st = b / 1024, sb = b % 1024, swz = sb ^ (((sb >> 9) & 1) << 5); R = (st >> 1) * 16 + swz / 64; C = (st & 1) * 32 + (swz % 64) / 2; }
__host__ __device__ __forceinline__ int perm32(int rho) { const int n = rho >> 4, i = rho & 15; return 8 * (i >> 2) + 4 * n + (i & 3); }

struct Unit { int pm, pn; };
struct Gemm { const bf16_t* A; const bf16_t* Bt; int M, N, K; };

struct StaticOrder {
    int nM, nN, nwg, G, c;
    __host__ __device__ void init(int M, int N, int G_, int c_) { nM = M / BM; nN = N / BM; nwg = nM * nN; G = G_; c = c_; }
    __host__ __device__ bool next(int i, Unit& u) const {
        const long L = (long)i * G + c; if (L >= nwg) return false;
        int wgid = (int)L; { const int q = nwg / NXCD, r = nwg % NXCD, xcd = wgid % NXCD, off = wgid / NXCD; wgid = (xcd < r ? xcd * (q + 1) : r * (q + 1) + (xcd - r) * q) + off; }
        const int nig = WGM * nN, gid = wgid / nig, fm = gid * WGM, gsz = (nM - fm) < WGM ? (nM - fm) : WGM;
        u.pm = fm + ((wgid % nig) % gsz); u.pn = (wgid % nig) / gsz; return true;
    }
    __device__ __forceinline__ void a_ready(const Unit&) const {}
    __device__ __forceinline__ void done(const Unit&) const {}
};

__device__ __forceinline__ unsigned cvt_pk_bf16(float lo, float hi) { unsigned r; asm volatile("v_cvt_pk_bf16_f32 %0, %1, %2" : "=v"(r) : "v"(lo), "v"(hi)); return r; }

constexpr float RMS_EPS = 1e-6f;
__device__ __forceinline__ float silu_f(float x) { return x * __builtin_amdgcn_rcpf(1.0f + __builtin_amdgcn_exp2f(-1.4426950408889634f * x)); }
struct EpiSwiGLU {
    static constexpr bool PERM = true, AFTER_DRAIN = false;
    bf16_t* O; int ldo; const float* rowss; float inv_n;
    __device__ __forceinline__ void operator()(const f32x4 (&acc)[2][2][4][2], const Unit& u, int wr, int wc, int fr, int fq) const {
        const int row0 = u.pm * BM + wr * 64 + fr, col0 = u.pn * HALF + wc * 32 + 8 * fq;
#pragma unroll
        for (int ai = 0; ai < 2; ++ai)
#pragma unroll
            for (int m = 0; m < 4; ++m) {
                const int r = row0 + ai * HALF + m * 16;
                const float rs = rowss ? __builtin_amdgcn_rsqf(rowss[r] * inv_n + RMS_EPS) : 1.0f;
                const f32x4 g0 = acc[ai][0][m][0] * rs, g1 = acc[ai][0][m][1] * rs, u0 = acc[ai][1][m][0] * rs, u1 = acc[ai][1][m][1] * rs;
                u32x4 w;
                w.x = cvt_pk_bf16(silu_f(g0[0]) * u0[0], silu_f(g0[1]) * u0[1]); w.y = cvt_pk_bf16(silu_f(g0[2]) * u0[2], silu_f(g0[3]) * u0[3]);
                w.z = cvt_pk_bf16(silu_f(g1[0]) * u1[0], silu_f(g1[1]) * u1[1]); w.w = cvt_pk_bf16(silu_f(g1[2]) * u1[2], silu_f(g1[3]) * u1[3]);
                *(u32x4*)(O + (size_t)r * ldo + col0) = w;
            }
    }
};
struct EpiResid {
    static constexpr bool PERM = true, AFTER_DRAIN = false;
    const float* resid; float* out; bf16_t* xb; float* rowss; float alpha; int ld;
    __device__ __forceinline__ void operator()(const f32x4 (&acc)[2][2][4][2], const Unit& u, int wr, int wc, int fr, int fq) const {
        const int row0 = u.pm * BM + wr * 64 + fr, col0 = u.pn * BM + wc * 32 + 8 * fq;
#pragma unroll
        for (int ai = 0; ai < 2; ++ai)
#pragma unroll
            for (int m = 0; m < 4; ++m) {
                const int r = row0 + ai * HALF + m * 16; float ss = 0.f;
#pragma unroll
                for (int bj = 0; bj < 2; ++bj) {
                    const size_t off = (size_t)r * ld + col0 + bj * HALF;
                    const f32x4 b0 = *(const f32x4*)(resid + off), b1 = *(const f32x4*)(resid + off + 4);
                    const f32x4 o0 = b0 + acc[ai][bj][m][0] * alpha, o1 = b1 + acc[ai][bj][m][1] * alpha;
                    if (out) { *(f32x4*)(out + off) = o0; *(f32x4*)(out + off + 4) = o1; }
                    ss += ((o0[0] * o0[0] + o0[1] * o0[1]) + (o0[2] * o0[2] + o0[3] * o0[3])) + ((o1[0] * o1[0] + o1[1] * o1[1]) + (o1[2] * o1[2] + o1[3] * o1[3]));
                    if (xb) { u32x4 w; w.x = cvt_pk_bf16(o0[0], o0[1]); w.y = cvt_pk_bf16(o0[2], o0[3]); w.z = cvt_pk_bf16(o1[0], o1[1]); w.w = cvt_pk_bf16(o1[2], o1[3]); *(u32x4*)(xb + off) = w; }
                }
                if (rowss) { ss += __shfl_xor(ss, 16); ss += __shfl_xor(ss, 32); if (fq == 0) atomicAdd(rowss + r, ss); }
            }
    }
};
struct EpiProj {
    static constexpr bool PERM = true, AFTER_DRAIN = false;
    bf16_t* O; const float* rowss; float inv_n;
    __device__ __forceinline__ void operator()(const f32x4 (&acc)[2][2][4][2], const Unit& u, int wr, int wc, int fr, int fq) const {
        const int row0 = u.pm * BM + wr * 64 + fr;
        {
            const bool dense = u.pn < 12;
            const size_t rstride = dense ? 128 : 3072;
            bf16_t* base = dense ? O + (size_t)(2 * u.pn) * ((size_t)16384 * 128) + wc * 32 + 8 * fq : O + (size_t)24 * 16384 * 128 + (u.pn - 12) * BM + wc * 32 + 8 * fq;
            const size_t bjstep = dense ? (size_t)16384 * 128 : 128;
#pragma unroll
            for (int ai = 0; ai < 2; ++ai)
#pragma unroll
                for (int m = 0; m < 4; ++m) {
                    const int r = row0 + ai * HALF + m * 16; const float rs = __builtin_amdgcn_rsqf(rowss[r] * inv_n + RMS_EPS);
#pragma unroll
                    for (int bj = 0; bj < 2; ++bj) { const f32x4 v0 = acc[ai][bj][m][0] * rs, v1 = acc[ai][bj][m][1] * rs; u32x4 w;
                        w.x = cvt_pk_bf16(v0[0], v0[1]); w.y = cvt_pk_bf16(v0[2], v0[3]); w.z = cvt_pk_bf16(v1[0], v1[1]); w.w = cvt_pk_bf16(v1[2], v1[3]);
                        *(u32x4*)(base + (size_t)r * rstride + bj * bjstep) = w; }
                }
        }
    }
};
template <class Epi, class Sched, bool ALIGN_EPI = false, bool SP2 = false>
__device__ __forceinline__ void gemm_phase(PG8_LAS unsigned char* lds, const Gemm g, const Sched& S, const Epi& E, const int mk_wave) {
    const int lane = (int)(__builtin_amdgcn_mbcnt_hi(~0u, __builtin_amdgcn_mbcnt_lo(~0u, 0u)) & 63u), wid = mk_wave & 7, tid = wid * 64 + lane, wr = wid >> 2, wc = wid & 3, fr = lane & 15, fq = lane >> 4;
    const int K = g.K, nt = K / BK;
    unsigned voffA[2], voffB[2];
#pragma unroll
    for (int i = 0; i < 2; ++i) { int R, C; stage_rc(tid * 16 + i * 8192, R, C); const int Rb = Epi::PERM ? ((R & ~31) + perm32(R & 31)) : R;
        voffA[i] = (unsigned)(R * K + C) * 2u; voffB[i] = (unsigned)(Rb * K + C) * 2u; }
    const size_t kstep = (size_t)(BK * 2);
    const size_t hstep = (size_t)HALF * K * 2;
    const size_t tstep = 2 * hstep;
    const unsigned ldsw = (unsigned)wid * 1024u;
    const int aoff = lds_byte(wr * 64 + fr, fq * 8), boff = lds_byte(wc * 32 + fr, fq * 8);
#define PG8_SA(b, h) (((b) * 2 + (h)) * HTB)
#define PG8_SB(b, h) ((4 + (b) * 2 + (h)) * HTB)
#define PG8_STAGE(bufoff, gbase, voff) do { _Pragma("unroll") for (int _i = 0; _i < 2; ++_i) \
        __builtin_amdgcn_global_load_lds((const unsigned*)((const char*)(gbase) + (voff)[_i]), (PG8_LAS unsigned*)(lds + (bufoff) + ldsw + _i * 8192), 16, 0, 0); } while (0)
#define PG8_LDA(dst, b, h) do { _Pragma("unroll") for (int m = 0; m < 4; ++m) _Pragma("unroll") for (int k = 0; k < 2; ++k) dst[m][k] = *(const PG8_LAS bf16x8*)(lds + PG8_SA(b, h) + aoff + m * 2048 + k * 1024); } while (0)
#define PG8_LDB(dst, b, h) do { _Pragma("unroll") for (int n = 0; n < 2; ++n) _Pragma("unroll") for (int k = 0; k < 2; ++k) dst[n][k] = *(const PG8_LAS bf16x8*)(lds + PG8_SB(b, h) + boff + n * 2048 + k * 1024); } while (0)
#define PG8_MMA(ai, bj, At, Bt) do { __builtin_amdgcn_s_setprio(1); _Pragma("unroll") for (int m = 0; m < 4; ++m) _Pragma("unroll") for (int n = 0; n < 2; ++n) _Pragma("unroll") for (int k = 0; k < 2; ++k) \
        acc[ai][bj][m][n] = __builtin_amdgcn_mfma_f32_16x16x32_bf16(Bt[n][k], At[m][k], acc[ai][bj][m][n], 0, 0, 0); __builtin_amdgcn_s_setprio(0); } while (0)
#define PG8_WAIT_V(n) asm volatile("s_waitcnt vmcnt(" #n ")" ::: "memory")
#define PG8_WAIT_L(n) asm volatile("s_waitcnt lgkmcnt(" #n ")" ::: "memory")
#define PG8_BAR __builtin_amdgcn_s_barrier()
#define PG8_SCHED __builtin_amdgcn_sched_barrier(0)
    Unit cur, nxt; int ui = 0;
    if (!S.next(0, cur)) return;
    f32x4 acc[2][2][4][2];
#pragma unroll
    for (int a = 0; a < 2; ++a)
#pragma unroll
        for (int b = 0; b < 2; ++b)
#pragma unroll
            for (int m = 0; m < 4; ++m)
#pragma unroll
                for (int n = 0; n < 2; ++n) acc[a][b][m][n] = (f32x4){0.f, 0.f, 0.f, 0.f};
    bf16x8 At[4][2], B0[2][2], B1[2][2];
    const char* cA = (const char*)g.A + (size_t)cur.pm * tstep; const char* cB = (const char*)g.Bt + (size_t)cur.pn * tstep;
    S.a_ready(cur);
    if constexpr (SP2) {
        PG8_STAGE(PG8_SB(0, 0), cB, voffB); PG8_STAGE(PG8_SB(0, 1), cB + hstep, voffB); PG8_STAGE(PG8_SA(0, 0), cA, voffA); PG8_STAGE(PG8_SA(0, 1), cA + hstep, voffA);
        if (wr == 1) PG8_BAR;
        PG8_WAIT_V(2); PG8_BAR;
        PG8_STAGE(PG8_SB(1, 0), cB + kstep, voffB); PG8_STAGE(PG8_SA(1, 0), cA + kstep, voffA); PG8_STAGE(PG8_SB(1, 1), cB + hstep + kstep, voffB);
        PG8_WAIT_V(6); PG8_BAR;
    } else {
        PG8_STAGE(PG8_SB(0, 0), cB, voffB); PG8_STAGE(PG8_SA(0, 0), cA, voffA); PG8_STAGE(PG8_SB(0, 1), cB + hstep, voffB); PG8_STAGE(PG8_SA(0, 1), cA + hstep, voffA);
        if (wr == 1) PG8_BAR;
        PG8_WAIT_V(4); PG8_BAR;
        PG8_STAGE(PG8_SB(1, 0), cB + kstep, voffB); PG8_STAGE(PG8_SA(1, 0), cA + kstep, voffA); PG8_STAGE(PG8_SB(1, 1), cB + hstep + kstep, voffB);
        PG8_WAIT_V(6); PG8_BAR;
    }
    for (;;) {
        const bool has_next = S.next(ui + 1, nxt);
        const char* nA = has_next ? (const char*)g.A + (size_t)nxt.pm * tstep : cA; const char* nB = has_next ? (const char*)g.Bt + (size_t)nxt.pn * tstep : cB;
        for (int t = 0; t < nt; t += 2) {
            const bool last = (t == nt - 2);
            const char* a1 = cA + (size_t)(t + 1) * kstep;
            const char* a2 = last ? nA : cA + (size_t)(t + 2) * kstep; const char* b2 = last ? nB : cB + (size_t)(t + 2) * kstep;
            const char* a3 = a2 + kstep; const char* b3 = b2 + kstep;
            if (last && has_next) S.a_ready(nxt);
            if constexpr (SP2) {
            PG8_LDB(B0, 0, 0); PG8_LDB(B1, 0, 1); PG8_SCHED; PG8_LDA(At, 0, 0); PG8_STAGE(PG8_SA(1, 1), a1 + hstep, voffA);
            PG8_WAIT_V(8); PG8_WAIT_L(0); PG8_BAR; PG8_MMA(0, 0, At, B0); PG8_MMA(0, 1, At, B1); PG8_BAR; PG8_SCHED;
            PG8_LDA(At, 0, 1); PG8_STAGE(PG8_SB(0, 0), b2, voffB); PG8_STAGE(PG8_SB(0, 1), b2 + hstep, voffB); PG8_STAGE(PG8_SA(0, 0), a2, voffA);
            PG8_WAIT_V(8); PG8_WAIT_L(0); PG8_BAR; PG8_MMA(1, 0, At, B0); PG8_MMA(1, 1, At, B1); PG8_BAR; PG8_SCHED;
            PG8_LDB(B0, 1, 0); PG8_LDB(B1, 1, 1); PG8_SCHED; PG8_LDA(At, 1, 0); PG8_STAGE(PG8_SA(0, 1), a2 + hstep, voffA);
            PG8_WAIT_V(8); PG8_WAIT_L(0); PG8_BAR; PG8_MMA(0, 0, At, B0); PG8_MMA(0, 1, At, B1); PG8_BAR; PG8_SCHED;
            PG8_LDA(At, 1, 1); PG8_STAGE(PG8_SB(1, 0), b3, voffB); PG8_STAGE(PG8_SB(1, 1), b3 + hstep, voffB); PG8_STAGE(PG8_SA(1, 0), a3, voffA);
            PG8_WAIT_V(8); PG8_WAIT_L(0); PG8_BAR; PG8_MMA(1, 0, At, B0); PG8_MMA(1, 1, At, B1); PG8_BAR; PG8_SCHED;
            } else {
            PG8_LDB(B0, 0, 0); PG8_SCHED; PG8_LDA(At, 0, 0); PG8_STAGE(PG8_SA(1, 1), a1 + hstep, voffA);
            PG8_WAIT_L(8); PG8_BAR; PG8_WAIT_L(0); PG8_MMA(0, 0, At, B0); PG8_BAR; PG8_SCHED;
            PG8_LDB(B1, 0, 1); PG8_STAGE(PG8_SB(0, 0), b2, voffB);
            PG8_BAR; PG8_WAIT_L(0); PG8_MMA(0, 1, At, B1); PG8_BAR;
            PG8_LDA(At, 0, 1); PG8_STAGE(PG8_SA(0, 0), a2, voffA);
            PG8_BAR; PG8_WAIT_L(0); PG8_MMA(1, 0, At, B0); PG8_BAR; PG8_SCHED;
            PG8_STAGE(PG8_SB(0, 1), b2 + hstep, voffB);
            PG8_WAIT_V(6); PG8_BAR; PG8_MMA(1, 1, At, B1); PG8_BAR;
            PG8_LDB(B0, 1, 0); PG8_SCHED; PG8_LDA(At, 1, 0); PG8_STAGE(PG8_SA(0, 1), a2 + hstep, voffA);
            PG8_WAIT_L(8); PG8_BAR; PG8_WAIT_L(0); PG8_MMA(0, 0, At, B0); PG8_BAR; PG8_SCHED;
            PG8_LDB(B1, 1, 1); PG8_STAGE(PG8_SB(1, 0), b3, voffB);
            PG8_BAR; PG8_WAIT_L(0); PG8_MMA(0, 1, At, B1); PG8_BAR;
            PG8_LDA(At, 1, 1); PG8_STAGE(PG8_SA(1, 0), a3, voffA);
            PG8_BAR; PG8_WAIT_L(0); PG8_MMA(1, 0, At, B0); PG8_BAR; PG8_SCHED;
            PG8_STAGE(PG8_SB(1, 1), b3 + hstep, voffB);
            PG8_WAIT_V(6); PG8_BAR; PG8_MMA(1, 1, At, B1); PG8_BAR;
            }
        }
        if constexpr (ALIGN_EPI) { if (wr == 0) PG8_BAR; }
        if constexpr (!Epi::AFTER_DRAIN) { E(acc, cur, wr, wc, fr, fq); S.done(cur); }
        if (!has_next) break;
#pragma unroll
        for (int a = 0; a < 2; ++a)
#pragma unroll
            for (int b = 0; b < 2; ++b)
#pragma unroll
                for (int m = 0; m < 4; ++m)
#pragma unroll
                    for (int n = 0; n < 2; ++n) acc[a][b][m][n] = (f32x4){0.f, 0.f, 0.f, 0.f};
        cur = nxt; cA = nA; cB = nB; ++ui;
        if constexpr (ALIGN_EPI) { if (wr == 1) PG8_BAR; }
    }
    PG8_WAIT_V(0);
    if constexpr (!ALIGN_EPI) { if (wr == 0) PG8_BAR; }
    PG8_BAR;
    if constexpr (Epi::AFTER_DRAIN) { E.fused(acc, cur, wr, wc, fr, fq, lds, wid, lane); S.done(cur); }
#undef PG8_SA
#undef PG8_SB
#undef PG8_STAGE
#undef PG8_LDA
#undef PG8_LDB
#undef PG8_MMA
#undef PG8_WAIT_V
#undef PG8_WAIT_L
#undef PG8_BAR
#undef PG8_SCHED
}
}

namespace att {
constexpr int D = 128; constexpr float THR = 8.f; constexpr bool WSKIP = false; constexpr int LDP = 128, LDO = 2048;
constexpr float SCALE = 0.08838834764831845f;
constexpr int NW = 8, QBLK = 32, KVBLK = 64, QB = NW * QBLK;
constexpr int SHM_V = KVBLK * D * 2, SHM_K = KVBLK * D * 2;
constexpr int LDS_BYTES = 2 * SHM_V + 2 * SHM_K + NW * 64 * 4;

using bf16 = __hip_bfloat16;
typedef short bf16x8 __attribute__((ext_vector_type(8)));
typedef short s16x4 __attribute__((ext_vector_type(4)));
typedef float f32x16 __attribute__((ext_vector_type(16)));
typedef float f32x4 __attribute__((ext_vector_type(4)));
typedef unsigned u32x4 __attribute__((ext_vector_type(4)));
template <class A, class Bt> struct same_t { static constexpr bool v = false; };
template <class A> struct same_t<A, A> { static constexpr bool v = true; };

#define KSWZ(row, colB) ((row) * 256 + ((colB) ^ (((row) & 7) << 4)))
#define SBAR() __builtin_amdgcn_sched_barrier(0)
__device__ __forceinline__ int v_st(int k, int c) { const int kk = (k & ~0xC) | ((k & 4) << 1) | ((k & 8) >> 1); return ((kk >> 3) * 4 + (c >> 5)) * 512 + ((kk & 7) * 32 + (c & 31)) * 2; }
__device__ __forceinline__ int v_rd_base(int lane) { return ((lane & 3) << 3) | (((lane >> 2) & 3) << 6) | (((lane >> 4) & 1) << 5) | (((lane >> 5) & 1) << 8); }
constexpr int v_rd_off(int d0, int ks, int half) { return d0 * 512 + ks * 4096 + half * 2048; }
__device__ __forceinline__ int crow(int r, int hi) { return (r & 3) + 8 * (r >> 2) + 4 * hi; }
__device__ __forceinline__ unsigned cvtpk(float lo, float hi) {
    unsigned r; asm volatile("v_cvt_pk_bf16_f32 %0, %1, %2" : "=v"(r) : "v"(lo), "v"(hi)); return r;
}
__device__ __forceinline__ bf16x8 pack8(f32x4 a, f32x4 b) {
    u32x4 w = {cvtpk(a[0], a[1]), cvtpk(a[2], a[3]), cvtpk(b[0], b[1]), cvtpk(b[2], b[3])};
    return *reinterpret_cast<bf16x8*>(&w);
}
template <class T> __device__ __forceinline__ bf16x8 load8(const T* p) {
    if constexpr (same_t<T, float>::v) { return pack8(*(const f32x4*)p, *(const f32x4*)(p + 4)); }
    else { return *reinterpret_cast<const bf16x8*>(p); }
}
__device__ __forceinline__ void mask_tile(f32x16& p0, f32x16& p1, int dq, unsigned W) {
    const float NEG = -__builtin_inff();
#pragma unroll
    for (int r = 0; r < 16; ++r) {
        const int c = (r & 3) + 8 * (r >> 2);
        if ((unsigned)(dq - c) >= W) p0[r] = NEG;
        if ((unsigned)(dq - c - 32) >= W) p1[r] = NEG;
    }
}
__device__ __forceinline__ void partialSM(f32x16& p0, f32x16& p1, float& m_reg, float& mn, float& alpha) {
    float pmax = p0[0]; for (int r = 1; r < 16; ++r) pmax = fmaxf(pmax, p0[r]); for (int r = 0; r < 16; ++r) pmax = fmaxf(pmax, p1[r]);
    { auto rr = __builtin_amdgcn_permlane32_swap(__float_as_uint(pmax), __float_as_uint(pmax), false, false);
      pmax = fmaxf(__uint_as_float(rr[0]), __uint_as_float(rr[1])); }
    constexpr float C2 = 1.4426950408889634f * SCALE;
    if (__builtin_expect(__all((pmax - m_reg) * SCALE <= THR), 1)) { mn = m_reg; alpha = 1.f; }
    else { mn = fmaxf(m_reg, pmax); alpha = __builtin_amdgcn_exp2f((m_reg - mn) * C2); m_reg = mn; }
    const float mnL = -mn * C2;
    for (int r = 0; r < 16; ++r) p0[r] = fmaf(p0[r], C2, mnL); for (int r = 0; r < 16; ++r) p1[r] = fmaf(p1[r], C2, mnL);
    for (int r = 0; r < 16; ++r) p0[r] = __builtin_amdgcn_exp2f(p0[r]);
}
__device__ __forceinline__ void finishSM(f32x16& p0, f32x16& p1, float alpha, float& l_reg, bf16x8& pa0, bf16x8& pa1, bf16x8& pa2, bf16x8& pa3) {
    for (int r = 0; r < 16; ++r) p1[r] = __builtin_amdgcn_exp2f(p1[r]);
    float ps = 0; for (int r = 0; r < 16; ++r) ps += p0[r]; for (int r = 0; r < 16; ++r) ps += p1[r];
    { auto rr = __builtin_amdgcn_permlane32_swap(__float_as_uint(ps), __float_as_uint(ps), false, false);
      ps = __uint_as_float(rr[0]) + __uint_as_float(rr[1]); }
    l_reg = l_reg * alpha + ps;
#define PK4(P, B_, OUT) do { unsigned a0 = cvtpk(P[B_+0], P[B_+1]), a1 = cvtpk(P[B_+2], P[B_+3]);                          \
        unsigned b0 = cvtpk(P[B_+4], P[B_+5]), b1 = cvtpk(P[B_+6], P[B_+7]);                                             \
        auto r0 = __builtin_amdgcn_permlane32_swap(a0, b0, false, false); auto r1 = __builtin_amdgcn_permlane32_swap(a1, b1, false, false); \
        u32x4 w = {r0[0], r1[0], r0[1], r1[1]}; OUT = *reinterpret_cast<bf16x8*>(&w); } while (0)
    PK4(p0, 0, pa0); PK4(p0, 8, pa1); PK4(p1, 0, pa2); PK4(p1, 8, pa3);
#undef PK4
}
template <int KB, bool SK>
__device__ __forceinline__ void qkt(f32x16& p0, f32x16& p1, const char* K_lds, int r32, int hi, const bf16x8* qr, bool act) {
    if (SK && !act) { const float NEG = -__builtin_inff();
#pragma unroll
        for (int r = 0; r < 16; ++r) { p0[r] = NEG; p1[r] = NEG; } return; }
    p0 = f32x16{}; p1 = f32x16{};
    const char* kb[4];
#pragma unroll
    for (int dd = 0; dd < 4; ++dd) kb[dd] = K_lds + KB * SHM_K + KSWZ(r32, (dd * 16 + hi * 8) * 2);
#pragma unroll
    for (int d0 = 0; d0 < 8; ++d0) { const char* a = kb[d0 & 3] + (d0 >> 2) * 128;
        bf16x8 b0 = *reinterpret_cast<const bf16x8*>(a);
        bf16x8 b1 = *reinterpret_cast<const bf16x8*>(a + 32 * 256);
        p0 = __builtin_amdgcn_mfma_f32_32x32x16_bf16(b0, qr[d0], p0, 0, 0, 0);
        p1 = __builtin_amdgcn_mfma_f32_32x32x16_bf16(b1, qr[d0], p1, 0, 0, 0); }
}
template <int VB, bool SK>
__device__ __forceinline__ void pv_tile(f32x16* o, int vb0, bf16x8 pa0, bf16x8 pa1, bf16x8 pa2, bf16x8 pa3, bool act) {
    if (SK && !act) return;
#define TRRD(dst, off) asm volatile("ds_read_b64_tr_b16 %0, %1 offset:%2" : "=&v"(dst) : "v"(vb0), "i"(off) : "memory")
#define PV_D0(d0) do { s16x4 l0, l1, l2, l3, h0, h1, h2, h3; constexpr int b_ = VB * SHM_V + v_rd_off(d0, 0, 0);     \
        TRRD(l0, b_); TRRD(h0, b_ + 2048); TRRD(l1, b_ + 4096); TRRD(h1, b_ + 6144); TRRD(l2, b_ + 8192); TRRD(h2, b_ + 10240); TRRD(l3, b_ + 12288); TRRD(h3, b_ + 14336); \
        asm volatile("s_waitcnt lgkmcnt(0)" ::: "memory"); SBAR();                 \
        o[d0] = __builtin_amdgcn_mfma_f32_32x32x16_bf16(pa0, (bf16x8){l0[0], l0[1], l0[2], l0[3], h0[0], h0[1], h0[2], h0[3]}, o[d0], 0, 0, 0);   \
        o[d0] = __builtin_amdgcn_mfma_f32_32x32x16_bf16(pa1, (bf16x8){l1[0], l1[1], l1[2], l1[3], h1[0], h1[1], h1[2], h1[3]}, o[d0], 0, 0, 0);   \
        o[d0] = __builtin_amdgcn_mfma_f32_32x32x16_bf16(pa2, (bf16x8){l2[0], l2[1], l2[2], l2[3], h2[0], h2[1], h2[2], h2[3]}, o[d0], 0, 0, 0);   \
        o[d0] = __builtin_amdgcn_mfma_f32_32x32x16_bf16(pa3, (bf16x8){l3[0], l3[1], l3[2], l3[3], h3[0], h3[1], h3[2], h3[3]}, o[d0], 0, 0, 0); } while (0)
    PV_D0(0); PV_D0(1); PV_D0(2); PV_D0(3);
#undef PV_D0
#undef TRRD
}

template <class TIn, class TOut> struct BlockRef { const TIn* Q; const TIn* K; const TIn* V; TOut* O; int P0; };
template <class TIn> struct Seam {
    bf16x8 qr[8];
    bf16x8 st_v0, st_v1, st_k0, st_k1; f32x4 sf0, sf1, sf2, sf3;
    f32x4 tq[16];
};
__device__ __forceinline__ int swa_jlo(int P0, int W) { const int lowk = P0 - W + 1; return lowk > 0 ? lowk / KVBLK : 0; }
#define ROW(p, k0, rr) ((p) + (size_t)((k0) + (rr)) * LDP + sc)
#define VMW() asm volatile("s_waitcnt vmcnt(0)" ::: "memory")
#define VMWN(n) asm volatile("s_waitcnt vmcnt(%0)" :: "i"(n) : "memory")
#define SLOAD_H(Kp, Vp, k0) do { S.st_v0 = load8<TIn>(ROW(Vp, k0, sr)); S.st_v1 = load8<TIn>(ROW(Vp, k0, 32 + sr));              \
                         S.st_k0 = load8<TIn>(ROW(Kp, k0, sr)); S.st_k1 = load8<TIn>(ROW(Kp, k0, 32 + sr)); } while (0)
#define SWRITE_HK(bf) do { *(bf16x8*)(K_lds + (bf) * SHM_K + kws) = S.st_k0; *(bf16x8*)(K_lds + (bf) * SHM_K + kws + 32 * 256) = S.st_k1; } while (0)
#define SWRITE_HV(bf) do { *(bf16x8*)(V_lds + (bf) * SHM_V + vst0) = S.st_v0; *(bf16x8*)(V_lds + (bf) * SHM_V + vst1) = S.st_v1; } while (0)
#define SWRITE_H(bf) do { SWRITE_HV(bf); SWRITE_HK(bf); } while (0)
#define SLOAD_F(p, k0) do { S.sf0 = *(const f32x4*)ROW(p, k0, sr); S.sf1 = *(const f32x4*)(ROW(p, k0, sr) + 4);                \
                            S.sf2 = *(const f32x4*)ROW(p, k0, 32 + sr); S.sf3 = *(const f32x4*)(ROW(p, k0, 32 + sr) + 4); } while (0)
#define SWRITE_KF(bf) do { *(bf16x8*)(K_lds + (bf) * SHM_K + kws) = pack8(S.sf0, S.sf1); *(bf16x8*)(K_lds + (bf) * SHM_K + kws + 32 * 256) = pack8(S.sf2, S.sf3); } while (0)
#define SWRITE_VF(bf) do { *(bf16x8*)(V_lds + (bf) * SHM_V + vst0) = pack8(S.sf0, S.sf1); *(bf16x8*)(V_lds + (bf) * SHM_V + vst1) = pack8(S.sf2, S.sf3); } while (0)
template <class TIn, class TOut>
__device__ __forceinline__ void causal_swa_prime(const BlockRef<TIn, TOut>& cur, int W, char* lds, Seam<TIn>& S, const int mk_wave) {
    constexpr bool F32 = same_t<TIn, float>::v;
    const int lane = (int)(__builtin_amdgcn_mbcnt_hi(~0u, __builtin_amdgcn_mbcnt_lo(~0u, 0u)) & 63u), wid = mk_wave & 7, tid = wid * 64 + lane, r32 = lane & 31, hi = lane >> 5;
    const int sr = tid >> 4, sc = (tid & 15) * 8, kws = KSWZ(sr, sc * 2); char* K_lds = lds + 2 * SHM_V;
    const int kb0 = swa_jlo(cur.P0, W) * KVBLK;
    for (int d0 = 0; d0 < 8; ++d0) S.qr[d0] = load8<TIn>(cur.Q + (size_t)(wid * QBLK + r32) * LDP + d0 * 16 + hi * 8);
    if constexpr (F32) { SLOAD_F((const float*)cur.K, kb0); VMW(); SWRITE_KF(0); SBAR(); SLOAD_F((const float*)cur.V, kb0); }
    else { SLOAD_H(cur.K, cur.V, kb0); VMW(); SWRITE_HK(0); }
    __syncthreads();
}
template <class TIn, class TOut>
__device__ __forceinline__ void causal_swa_block(const BlockRef<TIn, TOut>& cur, const BlockRef<TIn, TOut>& nxt, int skv, int W, char* lds, Seam<TIn>& S, const int mk_wave) {
    constexpr bool F32 = same_t<TIn, float>::v;
    const int lane = (int)(__builtin_amdgcn_mbcnt_hi(~0u, __builtin_amdgcn_mbcnt_lo(~0u, 0u)) & 63u), wid = mk_wave & 7, tid = wid * 64 + lane, r32 = lane & 31, hi = lane >> 5;
    const int j_lo = swa_jlo(cur.P0, W);
    int j_hi = (cur.P0 + QB - 1) / KVBLK + 1; if (j_hi > skv / KVBLK) j_hi = skv / KVBLK;
    const int NT = j_hi - j_lo;
    const int kbn = swa_jlo(nxt.P0, W) * KVBLK;
    const int qlo = cur.P0 + wid * QBLK, qm = qlo + r32 - 4 * hi;
    char* V_lds = lds; char* K_lds = lds + 2 * SHM_V;
    float* ws = (float*)(lds + 2 * SHM_V + 2 * SHM_K) + wid * 64; float* li_l = ws, * al_l = ws + 32;
    float m_reg = -1e30f, l_reg = 0; f32x16 o[4] = {};
    const int sr = tid >> 4, sc = (tid & 15) * 8, vst0 = v_st(sr, sc), vst1 = v_st(32 + sr, sc), kws = KSWZ(sr, sc * 2);
    const int vb0 = (int)(uintptr_t)V_lds + v_rd_base(lane);
    const TIn* Kh = cur.K; const TIn* Vh = cur.V;
#define RESC(a) do { if (__any((a) < 1.f)) { if (hi == 0) al_l[r32] = (a); asm volatile("s_waitcnt lgkmcnt(0)" ::: "memory");              \
                     for (int d_ = 0; d_ < 4; ++d_) for (int r = 0; r < 16; ++r) o[d_][r] *= al_l[crow(r, hi)]; } } while (0)
#define KBASE(t) ((j_lo + (t)) * KVBLK)
#define ACT(t) (KBASE(t) <= qlo + QBLK - 1 && KBASE(t) + KVBLK - 1 >= qlo - W + 1)
#define MASKT(P0_, P1_, t) do { const int kb_ = KBASE(t); if ((!SK || ACT(t)) && (kb_ + KVBLK - 1 > qlo || kb_ <= qlo + QBLK - 1 - W)) mask_tile(P0_, P1_, qm - kb_, (unsigned)W); } while (0)
    constexpr int NQL = F32 ? 16 : 8;
    constexpr bool SK = WSKIP && !F32;
#define SEAM_K0() do { VMWN(NQL); if constexpr (F32) { SWRITE_KF(0); SBAR(); SLOAD_F((const float*)nxt.V, kbn); } else { SWRITE_HK(0); } SBAR(); } while (0)
    f32x16 pA0, pA1, pB0, pB1; float mnA, mnB, alA, alB; bf16x8 pa0, pa1, pa2, pa3;
    if constexpr (F32) { VMW(); SWRITE_VF(0); SBAR(); } else { SWRITE_HV(0); SBAR(); }
    if (NT > 1) { if constexpr (F32) SLOAD_F((const float*)Kh, KBASE(1)); else SLOAD_H(Kh, Vh, KBASE(1)); }
    SBAR(); qkt<0, SK>(pA0, pA1, K_lds, r32, hi, S.qr, ACT(0));
    if constexpr (F32) { if (NT > 1) { VMW(); SWRITE_KF(1); SBAR(); SLOAD_F((const float*)Vh, KBASE(1)); } }
    MASKT(pA0, pA1, 0); partialSM(pA0, pA1, m_reg, mnA, alA);
    if (NT > 1) { VMW(); if constexpr (F32) { SWRITE_VF(1); SBAR(); if (NT > 2) SLOAD_F((const float*)Kh, KBASE(2)); } else SWRITE_H(1); }
    __syncthreads();
#define HALF_STEP(PX0, PX1, mnX, alX, PY0, PY1, alY, t, KB, VB, SB) do {                                                      \
        SBAR(); qkt<KB, SK>(PX0, PX1, K_lds, r32, hi, S.qr, ACT(t));                                             \
        finishSM(PY0, PY1, alY, l_reg, pa0, pa1, pa2, pa3); SBAR();                                                           \
        if ((t) + 1 < NT) { if constexpr (F32) { VMW(); SWRITE_KF(SB); SBAR(); SLOAD_F((const float*)Vh, KBASE((t) + 1)); }  \
                            else { SLOAD_H(Kh, Vh, KBASE((t) + 1)); } SBAR(); }                                               \
        pv_tile<VB, SK>(o, vb0, pa0, pa1, pa2, pa3, ACT((t) - 1)); MASKT(PX0, PX1, (t)); partialSM(PX0, PX1, m_reg, mnX, alX);                                        \
        __syncthreads();                                                                                                      \
        if ((t) + 1 < NT) { VMW(); if constexpr (F32) { SWRITE_VF(SB); SBAR(); if ((t) + 2 < NT) SLOAD_F((const float*)Kh, KBASE((t) + 2)); } \
                            else { SWRITE_H(SB); } }                                                                          \
        RESC(alX); __syncthreads(); } while (0)
    for (int t = 1; t + 1 < NT; t += 2) {
        HALF_STEP(pB0, pB1, mnB, alB, pA0, pA1, alA, t, 1, 0, 0);
        HALF_STEP(pA0, pA1, mnA, alA, pB0, pB1, alB, t + 1, 0, 1, 1);
    }
    const bool even = (NT & 1) == 0;
    if (even) { SBAR(); qkt<1, SK>(pB0, pB1, K_lds, r32, hi, S.qr, ACT(NT - 1)); SBAR(); }
#define QROW(e) (nxt.Q + (size_t)(wid * QBLK + r32) * LDP + ((e) >> 1) * 16 + hi * 8 + ((e) & 1) * 4)
    if constexpr (F32) { SLOAD_F((const float*)nxt.K, kbn); SBAR();
#pragma unroll
        for (int e = 0; e < 8; ++e) S.tq[e] = *(const f32x4*)QROW(e); }
    else { SLOAD_H(nxt.K, nxt.V, kbn); SBAR();
#pragma unroll
        for (int d0 = 0; d0 < 8; ++d0) S.qr[d0] = load8<TIn>(nxt.Q + (size_t)(wid * QBLK + r32) * LDP + d0 * 16 + hi * 8); }
    SBAR();
    finishSM(pA0, pA1, alA, l_reg, pa0, pa1, pa2, pa3); SBAR();
    if constexpr (F32) {
#pragma unroll
        for (int e = 8; e < 16; ++e) S.tq[e] = *(const f32x4*)QROW(e); SBAR(); }
#undef QROW
    pv_tile<0, SK>(o, vb0, pa0, pa1, pa2, pa3, ACT(even ? NT - 2 : NT - 1));
    if (even) { MASKT(pB0, pB1, NT - 1); partialSM(pB0, pB1, m_reg, mnB, alB); __syncthreads(); RESC(alB);
        finishSM(pB0, pB1, alB, l_reg, pa0, pa1, pa2, pa3); SBAR(); pv_tile<1, SK>(o, vb0, pa0, pa1, pa2, pa3, ACT(NT - 1)); }
    SBAR(); SEAM_K0();
    if (hi == 0) li_l[r32] = l_reg; asm volatile("s_waitcnt lgkmcnt(0)" ::: "memory");
    float rli[16];
#pragma unroll
    for (int r = 0; r < 16; ++r) rli[r] = __builtin_amdgcn_rcpf(li_l[crow(r, hi)]);
    TOut* Ow = cur.O + (size_t)(wid * QBLK) * LDO;
#pragma unroll
    for (int r = 0; r < 16; ++r) { const int orow = crow(r, hi);
#pragma unroll
        for (int d0 = 0; d0 < 4; ++d0) { const float v = o[d0][r] * rli[r];
            if constexpr (same_t<TOut, float>::v) { Ow[(size_t)orow * LDO + d0 * 32 + r32] = v; }
            else { const float vn = __shfl_xor(v, 1);
                   if ((r32 & 1) == 0) *(unsigned*)(Ow + (size_t)orow * LDO + d0 * 32 + r32) = cvtpk(v, vn); } } }
    if constexpr (F32) {
#pragma unroll
        for (int d0 = 0; d0 < 8; ++d0) S.qr[d0] = pack8(S.tq[2 * d0], S.tq[2 * d0 + 1]); }
    __syncthreads();
#undef RESC
#undef KBASE
#undef ACT
#undef MASKT
#undef SEAM_K0
#undef HALF_STEP
}
#undef ROW
#undef VMW
#undef VMWN
#undef SLOAD_H
#undef SWRITE_HK
#undef SWRITE_HV
#undef SWRITE_H
#undef SLOAD_F
#undef SWRITE_KF
#undef SWRITE_VF

constexpr int A2_V = 0;
constexpr int A2_K = 4 * SHM_V;
constexpr int A2_X = A2_K + 2 * SHM_K;
constexpr int A2_XS = 4096 + 512;
constexpr int A2_LDS = A2_X + 4 * A2_XS;
struct A2Ref { const bf16* Q; const bf16* K; const bf16* V0; const bf16* V1; bf16* O; int P0; };

__device__ __forceinline__ void attn2_block(const A2Ref& c, char* lds, const int mk_wave) {
    const int lane = (int)(__builtin_amdgcn_mbcnt_hi(~0u, __builtin_amdgcn_mbcnt_lo(~0u, 0u)) & 63u), wid = mk_wave & 7, tid = wid * 64 + lane, r32 = lane & 31, hi = lane >> 5, rg = wid & 3, vh = wid >> 2;
    char* V_lds = lds + A2_V; char* K_lds = lds + A2_K; char* X = lds + A2_X + rg * A2_XS;
    float* XA = (float*)(X + 4096); float* XM = XA + 32; float* XL = XA + 64;
    const int NT = (c.P0 + 127) / 64 + 1;
    const int qlo = c.P0 + rg * 32, qm = qlo + r32 - 4 * hi;
    const int sr = tid >> 4, sc = (tid & 15) * 8, vst0 = v_st(sr, sc), vst1 = v_st(32 + sr, sc), kws = KSWZ(sr, sc * 2);
    const int vb0 = (int)(uintptr_t)V_lds + vh * SHM_V + v_rd_base(lane);
    bf16x8 qr[8];
#pragma unroll
    for (int d0 = 0; d0 < 8; ++d0) qr[d0] = load8<bf16>(c.Q + (size_t)(rg * 32 + r32) * 128 + d0 * 16 + hi * 8);
    float m_reg = -1e30f, l_reg = 0.f; f32x16 o[4] = {};
    bf16x8 sk0, sk1, sa0, sa1, sb0, sb1;
#define A2_LOAD(kb) do { const size_t ro_ = (size_t)((kb) + sr) * 128 + sc; sk0 = load8<bf16>(c.K + ro_); sk1 = load8<bf16>(c.K + ro_ + 32 * 128); \
        sa0 = load8<bf16>(c.V0 + ro_); sa1 = load8<bf16>(c.V0 + ro_ + 32 * 128); sb0 = load8<bf16>(c.V1 + ro_); sb1 = load8<bf16>(c.V1 + ro_ + 32 * 128); } while (0)
#define A2_WRITE(buf) do { *(bf16x8*)(K_lds + (buf) * SHM_K + kws) = sk0; *(bf16x8*)(K_lds + (buf) * SHM_K + kws + 32 * 256) = sk1; \
        *(bf16x8*)(V_lds + (buf) * 2 * SHM_V + vst0) = sa0; *(bf16x8*)(V_lds + (buf) * 2 * SHM_V + vst1) = sa1; \
        *(bf16x8*)(V_lds + (buf) * 2 * SHM_V + SHM_V + vst0) = sb0; *(bf16x8*)(V_lds + (buf) * 2 * SHM_V + SHM_V + vst1) = sb1; } while (0)
#define A2_VMW() asm volatile("s_waitcnt vmcnt(0)" ::: "memory")
#define A2_STEP(t, B) do { const bool more_ = (t) + 1 < NT; if (more_) A2_LOAD(((t) + 1) * 64); \
        bf16x8 pa0, pa1, pa2, pa3; \
        if (vh == (B)) { f32x16 p0, p1; float mn, alpha; \
            qkt<(B), false>(p0, p1, K_lds, r32, hi, qr, true); \
            if (64 * (t) + 63 > qlo) mask_tile(p0, p1, qm - 64 * (t), 16384u); \
            partialSM(p0, p1, m_reg, mn, alpha); finishSM(p0, p1, alpha, l_reg, pa0, pa1, pa2, pa3); \
            *(bf16x8*)(X + lane * 16) = pa0; *(bf16x8*)(X + 1024 + lane * 16) = pa1; *(bf16x8*)(X + 2048 + lane * 16) = pa2; *(bf16x8*)(X + 3072 + lane * 16) = pa3; \
            if (hi == 0) { XA[r32] = alpha; XM[r32] = m_reg; XL[r32] = l_reg; } } \
        __syncthreads(); \
        if (vh != (B)) { pa0 = *(const bf16x8*)(X + lane * 16); pa1 = *(const bf16x8*)(X + 1024 + lane * 16); pa2 = *(const bf16x8*)(X + 2048 + lane * 16); pa3 = *(const bf16x8*)(X + 3072 + lane * 16); \
            m_reg = XM[r32]; l_reg = XL[r32]; } \
        { const float a_ = XA[r32]; if (__any(a_ < 1.f)) { \
            _Pragma("unroll") for (int d_ = 0; d_ < 4; ++d_) _Pragma("unroll") for (int r = 0; r < 16; ++r) o[d_][r] *= XA[crow(r, hi)]; } } \
        pv_tile<2 * (B), false>(o, vb0, pa0, pa1, pa2, pa3, true); \
        if (more_) { A2_VMW(); A2_WRITE((B) ^ 1); } \
        __syncthreads(); } while (0)
    A2_LOAD(0); A2_VMW(); A2_WRITE(0); __syncthreads();
    for (int t = 0; t < NT; t += 2) { A2_STEP(t, 0); A2_STEP(t + 1, 1); }
    float rli[16];
#pragma unroll
    for (int r = 0; r < 16; ++r) rli[r] = __builtin_amdgcn_rcpf(XL[crow(r, hi)]);
    bf16* Ow = c.O + (size_t)(rg * 32) * LDO + vh * 128;
#pragma unroll
    for (int r = 0; r < 16; ++r) { const int orow = crow(r, hi);
#pragma unroll
        for (int d0 = 0; d0 < 4; ++d0) { const float v = o[d0][r] * rli[r]; const float vn = __shfl_xor(v, 1);
            if ((r32 & 1) == 0) *(unsigned*)(Ow + (size_t)orow * LDO + d0 * 32 + r32) = cvtpk(v, vn); } }
    __syncthreads();
#undef A2_LOAD
#undef A2_WRITE
#undef A2_VMW
#undef A2_STEP
}

constexpr int A6_XS = 8192 + 1024;
constexpr int A6_LDS = A2_X + 4 * A6_XS + 8 * 128;
__device__ __forceinline__ void attn6_block(const A2Ref& c, char* lds, const int mk_wave) {
    int lane_ = (int)(__builtin_amdgcn_mbcnt_hi(~0u, __builtin_amdgcn_mbcnt_lo(~0u, 0u)) & 63u); asm volatile("" : "+v"(lane_));
    const int lane = lane_ & 63, wid = mk_wave & 7, tid = wid * 64 + lane, r32 = lane & 31, hi = lane >> 5, rg = wid & 3, vh = wid >> 2;
    char* V_lds = lds + A2_V; char* K_lds = lds + A2_K; char* X = lds + A2_X + rg * A6_XS;
    float* XM = (float*)(X + 8192); float* XL = XM + 128; float* AL = (float*)(lds + A2_X + 4 * A6_XS + wid * 128);
    const int NT = (c.P0 + 127) / 64 + 1;
    const int qlo = c.P0 + rg * 32, qm = qlo + r32 - 4 * hi;
    const int sr = tid >> 4, sc = (tid & 15) * 8, vst0 = v_st(sr, sc), vst1 = v_st(32 + sr, sc), kws = KSWZ(sr, sc * 2);
    const unsigned so = (unsigned)(sr * 128 + sc) * 2u;
    const int vb0 = (int)(uintptr_t)V_lds + vh * SHM_V + v_rd_base(lane);
    bf16x8 qr[8];
#pragma unroll
    for (int d0 = 0; d0 < 8; ++d0) qr[d0] = load8<bf16>(c.Q + (size_t)(rg * 32 + r32) * 128 + d0 * 16 + hi * 8);
    float m_reg = -1e30f, l_reg = 0.f; f32x16 o[4] = {};
    bf16x8 sk0, sk1, sa0, sa1, sb0, sb1;
    constexpr float C2 = 1.4426950408889634f * SCALE;
#define A4_G(base, kb, rows) (*(const bf16x8*)((const char*)((base) + (size_t)((kb) + (rows)) * 128) + so))
#define A4_LOAD(kb) do { sk0 = A4_G(c.K, kb, 0); sk1 = A4_G(c.K, kb, 32); sa0 = A4_G(c.V0, kb, 0); sa1 = A4_G(c.V0, kb, 32); sb0 = A4_G(c.V1, kb, 0); sb1 = A4_G(c.V1, kb, 32); } while (0)
#define A4_WRITE(buf) do { *(bf16x8*)(K_lds + (buf) * SHM_K + kws) = sk0; *(bf16x8*)(K_lds + (buf) * SHM_K + kws + 32 * 256) = sk1; \
        *(bf16x8*)(V_lds + (buf) * 2 * SHM_V + vst0) = sa0; *(bf16x8*)(V_lds + (buf) * 2 * SHM_V + vst1) = sa1; \
        *(bf16x8*)(V_lds + (buf) * 2 * SHM_V + SHM_V + vst0) = sb0; *(bf16x8*)(V_lds + (buf) * 2 * SHM_V + SHM_V + vst1) = sb1; } while (0)
#define A6_LOADK(kb) do { sk0 = A4_G(c.K, kb, 0); sk1 = A4_G(c.K, kb, 32); } while (0)
#define A6_LOADV(kb) do { sa0 = A4_G(c.V0, kb, 0); sa1 = A4_G(c.V0, kb, 32); sb0 = A4_G(c.V1, kb, 0); sb1 = A4_G(c.V1, kb, 32); } while (0)
#define A6_WRITEK(buf) do { *(bf16x8*)(K_lds + (buf) * SHM_K + kws) = sk0; *(bf16x8*)(K_lds + (buf) * SHM_K + kws + 32 * 256) = sk1; } while (0)
#define A6_WRITEV(buf) do { *(bf16x8*)(V_lds + (buf) * 2 * SHM_V + vst0) = sa0; *(bf16x8*)(V_lds + (buf) * 2 * SHM_V + vst1) = sa1; \
        *(bf16x8*)(V_lds + (buf) * 2 * SHM_V + SHM_V + vst0) = sb0; *(bf16x8*)(V_lds + (buf) * 2 * SHM_V + SHM_V + vst1) = sb1; } while (0)
#define A4_VMW() asm volatile("s_waitcnt vmcnt(0)" ::: "memory")
#define A4_PK(P, B_, OUT) do { unsigned a0_ = cvtpk(P[B_+0], P[B_+1]), a1_ = cvtpk(P[B_+2], P[B_+3]), b0_ = cvtpk(P[B_+4], P[B_+5]), b1_ = cvtpk(P[B_+6], P[B_+7]); \
        auto r0_ = __builtin_amdgcn_permlane32_swap(a0_, b0_, false, false); auto r1_ = __builtin_amdgcn_permlane32_swap(a1_, b1_, false, false); \
        u32x4 w_ = {r0_[0], r1_[0], r0_[1], r1_[1]}; OUT = *reinterpret_cast<bf16x8*>(&w_); } while (0)
#define A5_QK(T, KB) do { p = f32x16{}; \
        { const char* kb_[4]; \
          _Pragma("unroll") for (int dd = 0; dd < 4; ++dd) kb_[dd] = K_lds + (KB) * SHM_K + vh * (32 * 256) + KSWZ(r32, (dd * 16 + hi * 8) * 2); \
          _Pragma("unroll") for (int d0 = 0; d0 < 8; ++d0) { const bf16x8 b_ = *reinterpret_cast<const bf16x8*>(kb_[d0 & 3] + (d0 >> 2) * 128); p = __builtin_amdgcn_mfma_f32_32x32x16_bf16(b_, qr[d0], p, 0, 0, 0); } } } while (0)
#define A5_MAX(T) do { \
        if (64 * (T) + 32 * vh + 31 > qlo) { const int dq_ = qm - 64 * (T) - 32 * vh; \
            _Pragma("unroll") for (int r = 0; r < 16; ++r) { const int cc_ = (r & 3) + 8 * (r >> 2); if ((unsigned)(dq_ - cc_) >= 16384u) p[r] = -__builtin_inff(); } } \
        pmax_ = p[0]; \
        _Pragma("unroll") for (int r = 1; r < 16; ++r) pmax_ = fmaxf(pmax_, p[r]); \
        { auto rr_ = __builtin_amdgcn_permlane32_swap(__float_as_uint(pmax_), __float_as_uint(pmax_), false, false); pmax_ = fmaxf(__uint_as_float(rr_[0]), __uint_as_float(rr_[1])); } \
        if (hi == 0) XM[vh * 32 + r32] = pmax_; } while (0)
#define A5_SOFTMAX() do { \
        pmax_ = fmaxf(pmax_, XM[(vh ^ 1) * 32 + r32]); \
        float mn_; \
        if (__builtin_expect(__all((pmax_ - m_reg) * SCALE <= THR), 1)) { mn_ = m_reg; alpha_ = 1.f; } \
        else { mn_ = fmaxf(m_reg, pmax_); alpha_ = __builtin_amdgcn_exp2f((m_reg - mn_) * C2); m_reg = mn_; } \
        { const float mnL_ = -mn_ * C2; float ps_ = 0.f; \
          _Pragma("unroll") for (int r = 0; r < 16; ++r) { p[r] = __builtin_amdgcn_exp2f(fmaf(p[r], C2, mnL_)); ps_ += p[r]; } \
          auto rr_ = __builtin_amdgcn_permlane32_swap(__float_as_uint(ps_), __float_as_uint(ps_), false, false); ps_ = __uint_as_float(rr_[0]) + __uint_as_float(rr_[1]); \
          l_reg = l_reg * alpha_ + ps_; } \
        A4_PK(p, 0, pm0_); A4_PK(p, 8, pm1_); \
        *(bf16x8*)(X + vh * 2048 + lane * 16) = pm0_; *(bf16x8*)(X + vh * 2048 + 1024 + lane * 16) = pm1_; \
        if (hi == 0) AL[r32] = alpha_; } while (0)
    f32x16 p; float pmax_, alpha_ = 1.f; bf16x8 pm0_, pm1_;
    A4_LOAD(0); A4_VMW(); A4_WRITE(0); A6_LOADK(64); A4_VMW(); A6_WRITEK(1); A6_LOADV(64); if (2 < NT) A6_LOADK(128);
    __syncthreads();
    A5_QK(0, 0); A5_MAX(0);
    __syncthreads();
    A5_SOFTMAX();
    __syncthreads();
#define A6_STEP(t, B) do { \
        bf16x8 pa0, pa1, pa2, pa3; \
        { const bf16x8 po0_ = *(const bf16x8*)(X + (B) * 4096 + (vh ^ 1) * 2048 + lane * 16), po1_ = *(const bf16x8*)(X + (B) * 4096 + (vh ^ 1) * 2048 + 1024 + lane * 16); \
          if (vh == 0) { pa0 = pm0_; pa1 = pm1_; pa2 = po0_; pa3 = po1_; } else { pa0 = po0_; pa1 = po1_; pa2 = pm0_; pa3 = pm1_; } } \
        const float cand_ = fmaxf(pmax_, XM[(B) * 64 + (vh ^ 1) * 32 + r32]);                         \
        const bool more1_ = (t) + 1 < NT; \
        if (more1_) { A4_VMW(); A6_WRITEV((B) ^ 1); if ((t) + 2 < NT) A6_LOADV(((t) + 2) * 64); }     \
        if (more1_) A5_QK((t) + 1, (B) ^ 1); \
        pv_tile<2 * (B), false>(o, vb0, pa0, pa1, pa2, pa3, true); \
        if (!__all((cand_ - m_reg) * SCALE <= THR)) {                                      \
            const float mn_ = fmaxf(m_reg, cand_), al_ = __builtin_amdgcn_exp2f((m_reg - mn_) * C2); m_reg = mn_; l_reg *= al_; \
            if (hi == 0) AL[r32] = al_; asm volatile("s_waitcnt lgkmcnt(0)" ::: "memory"); \
            _Pragma("unroll") for (int d_ = 0; d_ < 4; ++d_) _Pragma("unroll") for (int r = 0; r < 16; ++r) o[d_][r] *= AL[crow(r, hi)]; } \
        if (more1_) { \
            if (64 * ((t) + 1) + 32 * vh + 31 > qlo) { const int dq_ = qm - 64 * ((t) + 1) - 32 * vh; \
                _Pragma("unroll") for (int r = 0; r < 16; ++r) { const int cc_ = (r & 3) + 8 * (r >> 2); if ((unsigned)(dq_ - cc_) >= 16384u) p[r] = -__builtin_inff(); } } \
            pmax_ = p[0]; \
            _Pragma("unroll") for (int r = 1; r < 16; ++r) pmax_ = fmaxf(pmax_, p[r]); \
            { auto rr_ = __builtin_amdgcn_permlane32_swap(__float_as_uint(pmax_), __float_as_uint(pmax_), false, false); pmax_ = fmaxf(__uint_as_float(rr_[0]), __uint_as_float(rr_[1])); } \
            { const float mnL_ = -m_reg * C2; float ps_ = 0.f; \
              _Pragma("unroll") for (int r = 0; r < 16; ++r) { p[r] = __builtin_amdgcn_exp2f(fmaf(p[r], C2, mnL_)); ps_ += p[r]; } \
              auto rr_ = __builtin_amdgcn_permlane32_swap(__float_as_uint(ps_), __float_as_uint(ps_), false, false); ps_ = __uint_as_float(rr_[0]) + __uint_as_float(rr_[1]); \
              l_reg += ps_; } \
            A4_PK(p, 0, pm0_); A4_PK(p, 8, pm1_); \
            *(bf16x8*)(X + ((B) ^ 1) * 4096 + vh * 2048 + lane * 16) = pm0_; *(bf16x8*)(X + ((B) ^ 1) * 4096 + vh * 2048 + 1024 + lane * 16) = pm1_; \
            if (hi == 0) XM[((B) ^ 1) * 64 + vh * 32 + r32] = pmax_; \
            if ((t) + 2 < NT) { A6_WRITEK(B); if ((t) + 3 < NT) A6_LOADK(((t) + 3) * 64); }     \
            __syncthreads(); } \
    } while (0)
    for (int t = 0; t < NT; t += 2) { A6_STEP(t, 0); A6_STEP(t + 1, 1); }
    __syncthreads();
    if (hi == 0) XL[vh * 32 + r32] = l_reg;
    __syncthreads();
    float rli[16];
#pragma unroll
    for (int r = 0; r < 16; ++r) rli[r] = __builtin_amdgcn_rcpf(XL[crow(r, hi)] + XL[32 + crow(r, hi)]);
    bf16* Ow = c.O + (size_t)(rg * 32) * LDO + vh * 128;
#pragma unroll
    for (int r = 0; r < 16; ++r) { const int orow = crow(r, hi);
#pragma unroll
        for (int d0 = 0; d0 < 4; ++d0) { const float v = o[d0][r] * rli[r]; const float vn = __shfl_xor(v, 1);
            if ((r32 & 1) == 0) *(unsigned*)(Ow + (size_t)orow * LDO + d0 * 32 + r32) = cvtpk(v, vn); } }
    __syncthreads();
#undef A4_G
#undef A4_LOAD
#undef A4_WRITE
#undef A4_VMW
#undef A4_PK
#undef A5_QK
#undef A5_MAX
#undef A5_SOFTMAX
#undef A6_STEP
#undef A6_WRITEK
#undef A6_LOADK
#undef A6_LOADV
#undef A6_WRITEV
}

__device__ __forceinline__ void attn9_block(const A2Ref& c, char* lds, __attribute__((address_space(3))) unsigned char* ldsl, const int mk_wave) {
    int lane_ = (int)(__builtin_amdgcn_mbcnt_hi(~0u, __builtin_amdgcn_mbcnt_lo(~0u, 0u)) & 63u); asm volatile("" : "+v"(lane_));
    const int lane = lane_ & 63, wid = mk_wave & 7, tid = wid * 64 + lane, r32 = lane & 31, hi = lane >> 5, rg = wid & 3, vh = wid >> 2;
    char* V_lds = lds + A2_V; char* K_lds = lds + A2_K; char* X = lds + A2_X + rg * A6_XS;
    float* XM = (float*)(X + 8192); float* XL = XM + 128; float* AL = (float*)(lds + A2_X + 4 * A6_XS + wid * 128);
    const int NT = (c.P0 + 127) / 64 + 1;
    const int qlo = c.P0 + rg * 32, qm = qlo + r32 - 4 * hi;
    const int oL = wid * 1024 + lane * 16;
    const int rowK = oL >> 8; const unsigned gK = (unsigned)(rowK * 256 + ((oL & 255) ^ ((rowK & 7) << 4)));
    const int stV = oL >> 9, eV = (oL & 511) >> 1, kkV = (stV >> 2) * 8 + (eV >> 5), kV = (kkV & ~0xC) | ((kkV & 4) << 1) | ((kkV & 8) >> 1);
    const unsigned gV = (unsigned)(kV * 256 + ((stV & 3) * 32 + (eV & 31)) * 2);
    const int vb0 = (int)(uintptr_t)V_lds + vh * SHM_V + v_rd_base(lane);
    bf16x8 qr[8];
#pragma unroll
    for (int d0 = 0; d0 < 8; ++d0) qr[d0] = load8<bf16>(c.Q + (size_t)(rg * 32 + r32) * 128 + d0 * 16 + hi * 8);
    float m_reg = -1e30f, l_reg = 0.f; f32x16 o[4] = {};
    constexpr float C2 = 1.4426950408889634f * SCALE;
#define A9_DMA(gbase, kb, goff, loff) do { \
        __builtin_amdgcn_global_load_lds((const unsigned*)((const char*)((gbase) + (size_t)(kb) * 128) + (goff)), (__attribute__((address_space(3))) unsigned*)(ldsl + (loff) + wid * 1024), 16, 0, 0); \
        __builtin_amdgcn_global_load_lds((const unsigned*)((const char*)((gbase) + (size_t)((kb) + 32) * 128) + (goff)), (__attribute__((address_space(3))) unsigned*)(ldsl + (loff) + 8192 + wid * 1024), 16, 0, 0); } while (0)
#define A9_DMAK(kb, buf) A9_DMA(c.K, kb, gK, A2_K + (buf) * SHM_K)
#define A9_DMAV(kb, buf) do { A9_DMA(c.V0, kb, gV, A2_V + (buf) * 2 * SHM_V); A9_DMA(c.V1, kb, gV, A2_V + (buf) * 2 * SHM_V + SHM_V); } while (0)
#define A4_VMW() asm volatile("s_waitcnt vmcnt(0)" ::: "memory")
#define A4_PK(P, B_, OUT) do { unsigned a0_ = cvtpk(P[B_+0], P[B_+1]), a1_ = cvtpk(P[B_+2], P[B_+3]), b0_ = cvtpk(P[B_+4], P[B_+5]), b1_ = cvtpk(P[B_+6], P[B_+7]); \
        auto r0_ = __builtin_amdgcn_permlane32_swap(a0_, b0_, false, false); auto r1_ = __builtin_amdgcn_permlane32_swap(a1_, b1_, false, false); \
        u32x4 w_ = {r0_[0], r1_[0], r0_[1], r1_[1]}; OUT = *reinterpret_cast<bf16x8*>(&w_); } while (0)
#define A5_QK(T, KB) do { p = f32x16{}; \
        { const char* kb_[4]; \
          _Pragma("unroll") for (int dd = 0; dd < 4; ++dd) kb_[dd] = K_lds + (KB) * SHM_K + vh * (32 * 256) + KSWZ(r32, (dd * 16 + hi * 8) * 2); \
          _Pragma("unroll") for (int d0 = 0; d0 < 8; ++d0) { const bf16x8 b_ = *reinterpret_cast<const bf16x8*>(kb_[d0 & 3] + (d0 >> 2) * 128); p = __builtin_amdgcn_mfma_f32_32x32x16_bf16(b_, qr[d0], p, 0, 0, 0); } } } while (0)
#define A5_MAX(T) do { \
        if (64 * (T) + 32 * vh + 31 > qlo) { const int dq_ = qm - 64 * (T) - 32 * vh; \
            _Pragma("unroll") for (int r = 0; r < 16; ++r) { const int cc_ = (r & 3) + 8 * (r >> 2); if ((unsigned)(dq_ - cc_) >= 16384u) p[r] = -__builtin_inff(); } } \
        pmax_ = p[0]; \
        _Pragma("unroll") for (int r = 1; r < 16; ++r) pmax_ = fmaxf(pmax_, p[r]); \
        { auto rr_ = __builtin_amdgcn_permlane32_swap(__float_as_uint(pmax_), __float_as_uint(pmax_), false, false); pmax_ = fmaxf(__uint_as_float(rr_[0]), __uint_as_float(rr_[1])); } \
        if (hi == 0) XM[vh * 32 + r32] = pmax_; } while (0)
#define A5_SOFTMAX() do { \
        pmax_ = fmaxf(pmax_, XM[(vh ^ 1) * 32 + r32]); \
        float mn_; \
        if (__builtin_expect(__all((pmax_ - m_reg) * SCALE <= THR), 1)) { mn_ = m_reg; alpha_ = 1.f; } \
        else { mn_ = fmaxf(m_reg, pmax_); alpha_ = __builtin_amdgcn_exp2f((m_reg - mn_) * C2); m_reg = mn_; } \
        { const float mnL_ = -mn_ * C2; float ps_ = 0.f; \
          _Pragma("unroll") for (int r = 0; r < 16; ++r) { p[r] = __builtin_amdgcn_exp2f(fmaf(p[r], C2, mnL_)); ps_ += p[r]; } \
          auto rr_ = __builtin_amdgcn_permlane32_swap(__float_as_uint(ps_), __float_as_uint(ps_), false, false); ps_ = __uint_as_float(rr_[0]) + __uint_as_float(rr_[1]); \
          l_reg = l_reg * alpha_ + ps_; } \
        A4_PK(p, 0, pm0_); A4_PK(p, 8, pm1_); \
        *(bf16x8*)(X + vh * 2048 + lane * 16) = pm0_; *(bf16x8*)(X + vh * 2048 + 1024 + lane * 16) = pm1_; \
        if (hi == 0) AL[r32] = alpha_; } while (0)
    f32x16 p; float pmax_, alpha_ = 1.f; bf16x8 pm0_, pm1_;
    A9_DMAK(0, 0); A9_DMAK(64, 1); A9_DMAV(0, 0); A4_VMW();
    __syncthreads();
    A5_QK(0, 0); A5_MAX(0);
    __syncthreads();
    A5_SOFTMAX();
    __syncthreads();
#define A6_STEP(t, B) do { \
        bf16x8 pa0, pa1, pa2, pa3; \
        { const bf16x8 po0_ = *(const bf16x8*)(X + (B) * 4096 + (vh ^ 1) * 2048 + lane * 16), po1_ = *(const bf16x8*)(X + (B) * 4096 + (vh ^ 1) * 2048 + 1024 + lane * 16); \
          if (vh == 0) { pa0 = pm0_; pa1 = pm1_; pa2 = po0_; pa3 = po1_; } else { pa0 = po0_; pa1 = po1_; pa2 = pm0_; pa3 = pm1_; } } \
        const float cand_ = fmaxf(pmax_, XM[(B) * 64 + (vh ^ 1) * 32 + r32]);                         \
        const bool more1_ = (t) + 1 < NT; \
        if (more1_) { A9_DMAV(((t) + 1) * 64, (B) ^ 1); if ((t) + 2 < NT) A9_DMAK(((t) + 2) * 64, B); }     \
        if (more1_) A5_QK((t) + 1, (B) ^ 1); \
        pv_tile<2 * (B), false>(o, vb0, pa0, pa1, pa2, pa3, true); \
        if (!__all((cand_ - m_reg) * SCALE <= THR)) {                                      \
            const float mn_ = fmaxf(m_reg, cand_), al_ = __builtin_amdgcn_exp2f((m_reg - mn_) * C2); m_reg = mn_; l_reg *= al_; \
            if (hi == 0) AL[r32] = al_; asm volatile("s_waitcnt lgkmcnt(0)" ::: "memory"); \
            _Pragma("unroll") for (int d_ = 0; d_ < 4; ++d_) _Pragma("unroll") for (int r = 0; r < 16; ++r) o[d_][r] *= AL[crow(r, hi)]; } \
        if (more1_) { \
            if (64 * ((t) + 1) + 32 * vh + 31 > qlo) { const int dq_ = qm - 64 * ((t) + 1) - 32 * vh; \
                _Pragma("unroll") for (int r = 0; r < 16; ++r) { const int cc_ = (r & 3) + 8 * (r >> 2); if ((unsigned)(dq_ - cc_) >= 16384u) p[r] = -__builtin_inff(); } } \
            pmax_ = p[0]; \
            _Pragma("unroll") for (int r = 1; r < 16; ++r) pmax_ = fmaxf(pmax_, p[r]); \
            { auto rr_ = __builtin_amdgcn_permlane32_swap(__float_as_uint(pmax_), __float_as_uint(pmax_), false, false); pmax_ = fmaxf(__uint_as_float(rr_[0]), __uint_as_float(rr_[1])); } \
            { const float mnL_ = -m_reg * C2; float ps_ = 0.f; \
              _Pragma("unroll") for (int r = 0; r < 16; ++r) { p[r] = __builtin_amdgcn_exp2f(fmaf(p[r], C2, mnL_)); ps_ += p[r]; } \
              auto rr_ = __builtin_amdgcn_permlane32_swap(__float_as_uint(ps_), __float_as_uint(ps_), false, false); ps_ = __uint_as_float(rr_[0]) + __uint_as_float(rr_[1]); \
              l_reg += ps_; } \
            A4_PK(p, 0, pm0_); A4_PK(p, 8, pm1_); \
            *(bf16x8*)(X + ((B) ^ 1) * 4096 + vh * 2048 + lane * 16) = pm0_; *(bf16x8*)(X + ((B) ^ 1) * 4096 + vh * 2048 + 1024 + lane * 16) = pm1_; \
            if (hi == 0) XM[((B) ^ 1) * 64 + vh * 32 + r32] = pmax_; \
            A4_VMW(); __syncthreads(); }     \
    } while (0)
    for (int t = 0; t < NT; t += 2) { A6_STEP(t, 0); A6_STEP(t + 1, 1); }
    __syncthreads();
    if (hi == 0) XL[vh * 32 + r32] = l_reg;
    __syncthreads();
    float rli[16];
#pragma unroll
    for (int r = 0; r < 16; ++r) rli[r] = __builtin_amdgcn_rcpf(XL[crow(r, hi)] + XL[32 + crow(r, hi)]);
    bf16* Ow = c.O + (size_t)(rg * 32) * LDO + vh * 128;
#pragma unroll
    for (int r = 0; r < 16; ++r) { const int orow = crow(r, hi);
#pragma unroll
        for (int d0 = 0; d0 < 4; ++d0) { const float v = o[d0][r] * rli[r]; const float vn = __shfl_xor(v, 1);
            if ((r32 & 1) == 0) *(unsigned*)(Ow + (size_t)orow * LDO + d0 * 32 + r32) = cvtpk(v, vn); } }
    __syncthreads();
#undef A4_VMW
#undef A9_DMA
#undef A9_DMAK
#undef A9_DMAV
#undef A4_PK
#undef A5_QK
#undef A5_MAX
#undef A5_SOFTMAX
#undef A6_STEP
}

}

constexpr int S_ = 16384, DM = 2048, FF = 5632, NIN = 6152, NINP = 6144, PLD = 3072;
constexpr int NWAVES = 8, NTHR = 512;
constexpr int C_MQ = 0, C_MK = 512, C_MV = 1024, C_MO = 2048;
constexpr size_t MiB = 1u << 20, KiB = 1u << 10;
constexpr size_t WS_ROWSS1 = 0, WS_ROWSS2 = 64 * KiB, WS_SC = 192 * KiB  , WS_DN = 256 * KiB, WS_GATES = 512 * KiB;
constexpr size_t WS_BAR = 128 * KiB;
constexpr size_t WS_WGU = 1 * MiB, WS_WD = 45 * MiB, WS_WIN = 67 * MiB, WS_WOUT = 92 * MiB;
constexpr size_t WS_XN = 100 * MiB;
constexpr size_t WS_BIG = 164 * MiB;
constexpr size_t WS_Y = 356 * MiB;
constexpr size_t WS_CT = 420 * MiB;
constexpr size_t WS_QC = 452 * MiB, WS_KC = 468 * MiB;
constexpr size_t WS_NST = 484 * MiB;
constexpr size_t WS_GW = 484 * MiB + 512 * KiB;
constexpr size_t WS_END = 485 * MiB;
constexpr int LDS_BYTES = 147456;

#define LAS __attribute__((address_space(3)))
typedef unsigned short bfu;
typedef unsigned v4u __attribute__((ext_vector_type(4)));
typedef unsigned v2u __attribute__((ext_vector_type(2)));
typedef float f32x4 __attribute__((ext_vector_type(4)));
typedef short bf16x8 __attribute__((ext_vector_type(8)));
#define MFMA16(a, b, c) __builtin_amdgcn_mfma_f32_16x16x32_bf16(a, b, c, 0, 0, 0)
#define LDS_WAIT() asm volatile("s_waitcnt lgkmcnt(0)" ::: "memory")
__device__ __forceinline__ unsigned f2bf(float f) { unsigned u = __builtin_bit_cast(unsigned, f); return (u + 0x7fffu + ((u >> 16) & 1u)) >> 16; }
__device__ __forceinline__ unsigned pk2(float lo, float hi) { return f2bf(lo) | (f2bf(hi) << 16); }
__device__ __forceinline__ float bf2f(unsigned b) { return __builtin_bit_cast(float, b << 16); }
__device__ __forceinline__ int mk_lane() { return (int)(__builtin_amdgcn_mbcnt_hi(~0u, __builtin_amdgcn_mbcnt_lo(~0u, 0u)) & 63u); }
__device__ __forceinline__ float wave_sum(float v) {
#pragma unroll
    for (int o = 1; o < 64; o <<= 1) v += __shfl_xor(v, o);
    return v;
}
__device__ __forceinline__ float silu(float x) { return x / (1.0f + __expf(-x)); }

__device__ __forceinline__ void cvt_item(const float* __restrict__ W, int ldw, int ncols, const float* __restrict__ gain, bfu* WT, int K, int dst_row0, int k0, int n0, LAS float* scr, int lane) {
    const int nq = (lane & 15) * 4, kr = lane >> 4, n = n0 + nq;
#pragma unroll 8
    for (int i = 0; i < 16; ++i) { const int kk = 4 * i + kr; f32x4 v = (f32x4){0.f, 0.f, 0.f, 0.f};
        if (n < ncols) v = *(const f32x4*)(W + (size_t)(k0 + kk) * ldw + n);
        if (gain) v = v * gain[k0 + kk];
        LAS float* d = scr + kk * 65 + nq; d[0] = v[0]; d[1] = v[1]; d[2] = v[2]; d[3] = v[3]; }
    LDS_WAIT(); asm volatile("" ::: "memory");
    const int c = lane & 7;
#pragma unroll
    for (int j = 0; j < 8; ++j) { const int nn = (lane >> 3) + 8 * j; const LAS float* s = scr + (8 * c) * 65 + nn;
        v4u o; o.x = pk2(s[0 * 65], s[1 * 65]); o.y = pk2(s[2 * 65], s[3 * 65]); o.z = pk2(s[4 * 65], s[5 * 65]); o.w = pk2(s[6 * 65], s[7 * 65]);
        *(v4u*)(WT + (size_t)(dst_row0 + nn) * K + k0 + 8 * c) = o; }
    LDS_WAIT(); asm volatile("" ::: "memory");
}
__device__ __forceinline__ void cvt_ffn_item(int it, const float* wg, const float* wu, const float* wd, const float* gain, bfu* Wgu, bfu* Wd, LAS float* scr, int lane) {
    if (it < 2 * 2816) { const int up = it >= 2816; const int r = up ? it - 2816 : it; const int kb = r / 88, nb = r % 88, n0 = nb * 64;
        cvt_item(up ? wu : wg, FF, FF, gain, Wgu, DM, 256 * (n0 >> 7) + (n0 & 127) + (up ? 128 : 0), kb * 64, n0, scr, lane); }
    else { const int r = it - 2 * 2816; const int kb = r / 32, nb = r % 32; cvt_item(wd, DM, DM, nullptr, Wd, FF, nb * 64, kb * 64, nb * 64, scr, lane); }
}

constexpr int GWP = 4112;
__device__ __forceinline__ void gates_rows(LAS unsigned char* lds, const bfu* __restrict__ XB, const float* __restrict__ rowss, const float* __restrict__ b_i, const float* __restrict__ b_f, float* GATES, int rb, int wave, int lane) {
    const int fr = lane & 15, fq = lane >> 4, rg = wave & 3, kh = wave >> 2;
    const LAS unsigned char* wl = lds + 16384;
    const bfu* xp = XB + (size_t)(rb * 64 + rg * 16 + fr) * DM + kh * 1024 + 8 * fq;
    f32x4 acc = (f32x4){0.f, 0.f, 0.f, 0.f};
    for (int k0 = 0; k0 < 32; k0 += 16) {
        bf16x8 xa[16];
#pragma unroll
        for (int ks = 0; ks < 16; ++ks) xa[ks] = *(const bf16x8*)(xp + (k0 + ks) * 32);
#pragma unroll
        for (int ks = 0; ks < 16; ++ks) { const bf16x8 wb = *(const LAS bf16x8*)(wl + fr * GWP + (kh * 1024 + (k0 + ks) * 32 + 8 * fq) * 2); acc = MFMA16(xa[ks], wb, acc); }
    }
    LAS f32x4* red = (LAS f32x4*)lds;
    if (kh == 1) red[rg * 64 + lane] = acc;
    __syncthreads();
    if (kh == 0 && fr < 8) {
        const f32x4 o = red[rg * 64 + lane]; const float bias = fr < 4 ? b_i[fr] : b_f[fr - 4];
#pragma unroll
        for (int j = 0; j < 4; ++j) { const int row = rb * 64 + rg * 16 + 4 * fq + j;
            const float pre = (acc[j] + o[j]) / sqrtf(rowss[row] * (1.0f / DM) + 1e-6f) + bias; const float capped = 15.0f * tanhf(pre * (1.0f / 15.0f));
            GATES[(size_t)row * 8 + fr] = fr < 4 ? capped : -log1pf(expf(-capped)); }
    }
    __syncthreads();
}

#define XB_TMO      128
#define XB_XCNT(j)  (256  + 64 * (j))
#define XB_XSUB(j)  (1280 + 64 * (j))
#define XB_XGEN(j)  (2304 + 64 * (j))
#define XB_TOP      3328
#define XB_TOPGEN   3392
#define XCD_BAR_WORDS 3456
#define XB_SPIN_CAP (1u << 18)
__device__ __forceinline__ unsigned xb_ld(unsigned* p)              { return __hip_atomic_load(p, __ATOMIC_RELAXED, __HIP_MEMORY_SCOPE_AGENT); }
__device__ __forceinline__ unsigned xb_add(unsigned* p, unsigned v) { return __hip_atomic_fetch_add(p, v, __ATOMIC_RELAXED, __HIP_MEMORY_SCOPE_AGENT); }
__device__ __forceinline__ unsigned xb_xcc_id() { return (unsigned)__builtin_amdgcn_s_getreg((3 << 11) | 20) & 0xFu; }
#define XB_SPIN(cond, bar) do { unsigned _sp = 0; while (cond) { __builtin_amdgcn_s_sleep(1); \
    if ((++_sp & 255u) == 0u) { if (xb_ld(&(bar)[XB_TMO])) break; if (_sp > XB_SPIN_CAP) { atomicAdd(&(bar)[XB_TMO], 1u); break; } } } } while (0)
__device__ __forceinline__ void xcd_barrier_complete(unsigned* bar, unsigned x, unsigned& nloc, unsigned& nx) {
    const unsigned G = gridDim.x * gridDim.y * gridDim.z;
    unsigned sum, cnt, mine, sp = 0u;
    for (;;) {
        sum = 0u; cnt = 0u; mine = 0u;
#pragma unroll
        for (unsigned j = 0; j < 16; ++j) { const unsigned c = xb_ld(&bar[XB_XCNT(j)]); sum += c; cnt += (c > 0u) ? 1u : 0u; mine = (j == x) ? c : mine; }
        if (sum == G) break;
        __builtin_amdgcn_s_sleep(1);
        if ((++sp & 255u) == 0u) { if (xb_ld(&bar[XB_TMO])) break; if (sp > XB_SPIN_CAP) { atomicAdd(&bar[XB_TMO], 1u); break; } }
    }
    nloc = mine > 0u ? mine : 1u; nx = cnt > 0u ? cnt : 1u;
}
__device__ __forceinline__ void xcd_barrier(unsigned* bar, volatile LAS unsigned* st, const bool first) {
    asm volatile("s_waitcnt vmcnt(0)" ::: "memory");
    __syncthreads();
    if (first) {
        const unsigned x = xb_xcc_id();
        __builtin_amdgcn_s_waitcnt(0);
        unsigned nloc = st[0], nx = st[1];
        if (nloc == 0u) { xcd_barrier_complete(bar, x, nloc, nx); st[0] = nloc; st[1] = nx; }
        const unsigned old = xb_add(&bar[XB_XSUB(x)], 1u);
        const unsigned gen = old / nloc;
        if (old + 1u == (gen + 1u) * nloc) {
            __builtin_amdgcn_fence(__ATOMIC_RELEASE, "agent");
            asm volatile("s_waitcnt vmcnt(0)" ::: "memory");
            const unsigned og = xb_add(&bar[XB_TOP], 1u);
            const unsigned tg = og / nx;
            if (og + 1u == (tg + 1u) * nx) xb_add(&bar[XB_TOPGEN], 1u);
            else XB_SPIN(xb_ld(&bar[XB_TOPGEN]) == tg, bar);
            __builtin_amdgcn_fence(__ATOMIC_ACQUIRE, "agent");
            xb_add(&bar[XB_XGEN(x)], 1u);
            asm volatile("s_waitcnt vmcnt(0)" ::: "memory");
        } else {
            XB_SPIN(xb_ld(&bar[XB_XGEN(x)]) == gen, bar);
            __builtin_amdgcn_fence(__ATOMIC_ACQUIRE, "agent");
            asm volatile("s_waitcnt vmcnt(0)" ::: "memory");
        }
    }
    __syncthreads();
}

struct Args { const float* in[23]; float* out; unsigned char* ws; int ph_lo, ph_hi; };
constexpr int NPH = 12;

constexpr int MP = 272;

__device__ __forceinline__ void mlstm_stage_a(LAS unsigned char* lds, const bfu* __restrict__ PROJ, const float* __restrict__ GATES, const float* __restrict__ conv_w, const float* __restrict__ conv_b,
                                              bfu* QC, bfu* KC, float* DELTA, float* DN, float* SC, int item, const int mk_wave) {
    int lane = mk_lane(); asm volatile("" : "+v"(lane));
    const int wid = mk_wave & 7, tid = wid * 64 + lane, fr = lane & 15, fq = lane >> 4;
    const int h = item & 3, row0 = (item >> 2) * 128;
    LAS float* fa = (LAS float*)lds; LAS unsigned char* KT = lds + 4096; LAS unsigned char* VT = KT + 128 * MP;
    if (tid < 128) { fa[tid] = GATES[(size_t)(row0 + tid) * 8 + 4 + h]; fa[128 + tid] = GATES[(size_t)(row0 + tid) * 8 + h]; }
    __syncthreads();
    if (tid < 128) { float b = 0.f; for (int s = 0; s <= tid; ++s) b += fa[s]; fa[256 + tid] = fa[128 + tid] - b; if (tid == 127) fa[385] = b; }
    __syncthreads();
    if (wid == 0) { float a = fmaxf(fa[256 + lane], fa[320 + lane]);
#pragma unroll
        for (int o = 1; o < 64; o <<= 1) a = fmaxf(a, __shfl_xor(a, o));
        if (lane == 0) fa[384] = a; }
    __syncthreads();
    const float amax = fa[384], blast = fa[385];
    if (tid < 128) fa[tid] = __expf(fa[256 + tid] - amax);
    if (tid == 0) { SC[item] = blast + amax; SC[512 + item] = blast; }
    __syncthreads();
    for (int task = tid; task < 4096; task += NTHR) {
        const int isk = task >> 11, t2 = task & 2047, d = t2 & 127, s0 = (t2 >> 7) * 8, ch = isk * 512 + h * 128 + d;
        const float w0 = conv_w[ch], w1 = conv_w[1024 + ch], w2 = conv_w[2048 + ch], w3 = conv_w[3072 + ch], bias = conv_b[ch];
        float x[11];
#pragma unroll
        for (int i = 0; i < 11; ++i) { const int r = row0 + s0 - 3 + i; x[i] = r >= 0 ? bf2f(PROJ[(size_t)r * PLD + C_MQ + ch]) : 0.f; }
        float y[8];
#pragma unroll
        for (int i = 0; i < 8; ++i) y[i] = silu(bias + w0 * x[i] + w1 * x[i + 1] + w2 * x[i + 2] + w3 * x[i + 3]);
        if (!isk) {
#pragma unroll
            for (int i = 0; i < 8; ++i) QC[(size_t)(row0 + s0 + i) * 512 + h * 128 + d] = (bfu)f2bf(y[i] * 0.08838834764831845f);
        } else {
#pragma unroll
            for (int i = 0; i < 8; ++i) { KC[(size_t)(row0 + s0 + i) * 512 + h * 128 + d] = (bfu)f2bf(y[i]); y[i] *= fa[s0 + i]; }
            v4u o; o.x = pk2(y[0], y[1]); o.y = pk2(y[2], y[3]); o.z = pk2(y[4], y[5]); o.w = pk2(y[6], y[7]);
            *(LAS v4u*)(KT + d * MP + s0 * 2) = o;
        }
    }
    for (int task = tid; task < 4096; task += NTHR) {
        const int sidx = task & 127, e0 = (task >> 7) * 8;
        const v4u v = *(const v4u*)(PROJ + (size_t)(row0 + sidx) * PLD + C_MV + h * 256 + e0);
        LAS unsigned short* d = (LAS unsigned short*)(VT + e0 * MP + sidx * 2);
        d[0 * (MP / 2)] = (unsigned short)(v.x & 0xffffu); d[1 * (MP / 2)] = (unsigned short)(v.x >> 16); d[2 * (MP / 2)] = (unsigned short)(v.y & 0xffffu); d[3 * (MP / 2)] = (unsigned short)(v.y >> 16);
        d[4 * (MP / 2)] = (unsigned short)(v.z & 0xffffu); d[5 * (MP / 2)] = (unsigned short)(v.z >> 16); d[6 * (MP / 2)] = (unsigned short)(v.w & 0xffffu); d[7 * (MP / 2)] = (unsigned short)(v.w >> 16);
    }
    __syncthreads();
    f32x4 acc[2][8];
#pragma unroll
    for (int mt = 0; mt < 2; ++mt)
#pragma unroll
        for (int nt = 0; nt < 8; ++nt) acc[mt][nt] = (f32x4){0.f, 0.f, 0.f, 0.f};
#pragma unroll
    for (int ks = 0; ks < 4; ++ks) {
        bf16x8 a[2];
#pragma unroll
        for (int mt = 0; mt < 2; ++mt) a[mt] = *(const LAS bf16x8*)(VT + (32 * wid + 16 * mt + fr) * MP + (32 * ks + 8 * fq) * 2);
#pragma unroll
        for (int nt = 0; nt < 8; ++nt) { const bf16x8 b = *(const LAS bf16x8*)(KT + (16 * nt + fr) * MP + (32 * ks + 8 * fq) * 2);
            acc[0][nt] = MFMA16(a[0], b, acc[0][nt]); acc[1][nt] = MFMA16(a[1], b, acc[1][nt]); }
    }
    float* dst = DELTA + (size_t)item * 32768;
#pragma unroll
    for (int mt = 0; mt < 2; ++mt)
#pragma unroll
        for (int nt = 0; nt < 8; ++nt)
#pragma unroll
            for (int j = 0; j < 4; ++j) dst[(32 * wid + 16 * mt + 4 * fq + j) * 128 + 16 * nt + fr] = acc[mt][nt][j];
    if (tid < 128) { float s = 0.f; for (int i = 0; i < 128; ++i) s += bf2f(*(const LAS unsigned short*)(KT + tid * MP + i * 2)); DN[(size_t)item * 128 + tid] = s; }
    __syncthreads();
}

__device__ __forceinline__ void mlstm_scan(LAS unsigned char* lds, const float* __restrict__ DELTA, const float* __restrict__ DN, const float* __restrict__ SC, float* MPREV, bfu* __restrict__ CT, float* __restrict__ NST,
                                           int tid, int gtid, int nthreads) {
    LAS float* fdec = (LAS float*)lds; LAS float* fin = fdec + 512; LAS float* mpv = fdec + 1024;
    if (tid < 4) { float m = 0.f;
        for (int c = 0; c < 128; ++c) { const int item = c * 4 + tid; const float mloc = SC[item], bl = SC[512 + item], mn = fmaxf(bl + m, mloc);
            mpv[tid * 128 + c] = m; fdec[tid * 128 + c] = __expf(bl + m - mn); fin[tid * 128 + c] = __expf(mloc - mn); m = mn; } }
    __syncthreads();
    for (int idx = gtid; idx < 4 * 32768 + 512; idx += nthreads) {
        const bool main_ = idx < 4 * 32768;
        const int h = main_ ? (idx >> 15) : ((idx - 4 * 32768) >> 7), rem = main_ ? (idx & 32767) : ((idx - 4 * 32768) & 127);
        const float* src = main_ ? DELTA + (size_t)h * 32768 + rem : DN + h * 128 + rem; const size_t sstride = main_ ? 4 * 32768 : 512;
        float C = 0.f; float d8[8], e8[8];
#pragma unroll
        for (int i = 0; i < 8; ++i) d8[i] = src[(size_t)i * sstride];
        for (int c0 = 0; c0 < 128; c0 += 8) {
            if (c0 + 8 < 128) {
#pragma unroll
                for (int i = 0; i < 8; ++i) e8[i] = src[(size_t)(c0 + 8 + i) * sstride];
            }
#pragma unroll
            for (int i = 0; i < 8; ++i) { const int c = c0 + i, item = c * 4 + h;
                if (main_) { CT[(size_t)item * 32768 + rem] = (bfu)f2bf(C); if (rem == 0) MPREV[item] = mpv[h * 128 + c]; } else NST[(size_t)item * 128 + rem] = C;
                C = fdec[h * 128 + c] * C + fin[h * 128 + c] * d8[i]; }
#pragma unroll
            for (int i = 0; i < 8; ++i) d8[i] = e8[i];
        }
    }
    __syncthreads();
}

__device__ __forceinline__ void mlstm_stage_c(LAS unsigned char* lds, const bfu* __restrict__ PROJ, const float* __restrict__ GATES, const bfu* __restrict__ QC, const bfu* __restrict__ KC,
                                              const bfu* __restrict__ CT, const float* __restrict__ NST, const float* __restrict__ MPREV, const float* __restrict__ hgain, bfu* Y, int item, const int mk_wave) {
    int lane = mk_lane(); asm volatile("" : "+v"(lane));
    const int wid = mk_wave & 7, tid = wid * 64 + lane, fr = lane & 15, fq = lane >> 4;
    const int h = item & 3, row0 = (item >> 2) * 128;
    LAS float* fa = (LAS float*)lds;
    LAS unsigned char* Qs = lds + 4096; LAS unsigned char* Ks = Qs + 128 * MP; LAS unsigned char* BUF = Ks + 128 * MP;
    if (tid < 128) { fa[768 + tid] = GATES[(size_t)(row0 + tid) * 8 + 4 + h]; fa[896 + tid] = GATES[(size_t)(row0 + tid) * 8 + h]; fa[640 + tid] = NST[(size_t)item * 128 + tid]; }
    __syncthreads();
    float bt_ = 0.f;
    if (tid < 128) { for (int s = 0; s <= tid; ++s) bt_ += fa[768 + s]; fa[tid] = fa[896 + tid] - bt_; }
    __syncthreads();
    if (tid < 128) { const float mp = MPREV[item]; float pm = -3.0e38f; for (int s = 0; s <= tid; ++s) pm = fmaxf(pm, fa[s]);
        const float M = fmaxf(mp, pm); fa[128 + tid] = M; fa[256 + tid] = __expf(mp - M); fa[384 + tid] = __expf(-(bt_ + M)); }
    for (int t = tid; t < 2048; t += NTHR) { const int r = t >> 4, c = t & 15;
        *(LAS v4u*)(Qs + r * MP + c * 16) = *(const v4u*)(QC + (size_t)(row0 + r) * 512 + h * 128 + c * 8);
        *(LAS v4u*)(Ks + r * MP + c * 16) = *(const v4u*)(KC + (size_t)(row0 + r) * 512 + h * 128 + c * 8); }
    for (int t = tid; t < 4096; t += NTHR) { const int r = t >> 4, c = t & 15; *(LAS v4u*)(BUF + r * MP + c * 16) = *(const v4u*)(CT + (size_t)item * 32768 + r * 128 + c * 8); }
    __syncthreads();
    {
        const int t = 16 * wid + fr; float s = 0.f;
#pragma unroll
        for (int i = 0; i < 32; ++i) s += bf2f(*(const LAS unsigned short*)(Qs + t * MP + (32 * fq + i) * 2)) * fa[640 + 32 * fq + i];
        s += __shfl_xor(s, 16); s += __shfl_xor(s, 32); if (fq == 0) fa[512 + t] = s;
    }
    f32x4 sa[8];
#pragma unroll
    for (int nt = 0; nt < 8; ++nt) sa[nt] = (f32x4){0.f, 0.f, 0.f, 0.f};
    bf16x8 qa[4];
#pragma unroll
    for (int ks = 0; ks < 4; ++ks) qa[ks] = *(const LAS bf16x8*)(Qs + (16 * wid + fr) * MP + (32 * ks + 8 * fq) * 2);
#pragma unroll
    for (int nt = 0; nt < 8; ++nt) if (nt <= wid) {
#pragma unroll
        for (int ks = 0; ks < 4; ++ks) { const bf16x8 b = *(const LAS bf16x8*)(Ks + (16 * nt + fr) * MP + (32 * ks + 8 * fq) * 2); sa[nt] = MFMA16(qa[ks], b, sa[nt]); } }
    float Mt[4], rsum[4];
#pragma unroll
    for (int j = 0; j < 4; ++j) { Mt[j] = fa[128 + 16 * wid + 4 * fq + j]; rsum[j] = 0.f; }
#pragma unroll
    for (int nt = 0; nt < 8; ++nt) { const int s = 16 * nt + fr; const float as = fa[s];
#pragma unroll
        for (int j = 0; j < 4; ++j) { const int t = 16 * wid + 4 * fq + j; const float p = (s <= t) ? sa[nt][j] * __expf(as - Mt[j]) : 0.f; sa[nt][j] = p; rsum[j] += p; } }
#pragma unroll
    for (int j = 0; j < 4; ++j) { float v = rsum[j]; v += __shfl_xor(v, 1); v += __shfl_xor(v, 2); v += __shfl_xor(v, 4); v += __shfl_xor(v, 8); rsum[j] = v; }
    f32x4 num[16];
#pragma unroll
    for (int nt = 0; nt < 16; ++nt) num[nt] = (f32x4){0.f, 0.f, 0.f, 0.f};
#pragma unroll
    for (int ks = 0; ks < 4; ++ks)
#pragma unroll
        for (int nt = 0; nt < 16; ++nt) { const bf16x8 b = *(const LAS bf16x8*)(BUF + (16 * nt + fr) * MP + (32 * ks + 8 * fq) * 2); num[nt] = MFMA16(qa[ks], b, num[nt]); if ((nt & 3) == 3) __builtin_amdgcn_sched_barrier(0); }
    float g4[4], den[4];
#pragma unroll
    for (int j = 0; j < 4; ++j) { const int t = 16 * wid + 4 * fq + j; g4[j] = fa[256 + t]; den[j] = fmaxf(fabsf(g4[j] * fa[512 + t] + rsum[j]), fa[384 + t]); }
#pragma unroll
    for (int nt = 0; nt < 16; ++nt)
#pragma unroll
        for (int j = 0; j < 4; ++j) num[nt][j] *= g4[j];
    __syncthreads();
#pragma unroll
    for (int nt = 0; nt < 8; ++nt)
#pragma unroll
        for (int j = 0; j < 4; ++j) *(LAS unsigned short*)(Ks + (16 * wid + 4 * fq + j) * MP + (16 * nt + fr) * 2) = (unsigned short)f2bf(sa[nt][j]);
    for (int task = tid; task < 4096; task += NTHR) {
        const int sidx = task & 127, e0 = (task >> 7) * 8;
        const v4u v = *(const v4u*)(PROJ + (size_t)(row0 + sidx) * PLD + C_MV + h * 256 + e0);
        LAS unsigned short* d = (LAS unsigned short*)(BUF + e0 * MP + sidx * 2);
        d[0 * (MP / 2)] = (unsigned short)(v.x & 0xffffu); d[1 * (MP / 2)] = (unsigned short)(v.x >> 16); d[2 * (MP / 2)] = (unsigned short)(v.y & 0xffffu); d[3 * (MP / 2)] = (unsigned short)(v.y >> 16);
        d[4 * (MP / 2)] = (unsigned short)(v.z & 0xffffu); d[5 * (MP / 2)] = (unsigned short)(v.z >> 16); d[6 * (MP / 2)] = (unsigned short)(v.w & 0xffffu); d[7 * (MP / 2)] = (unsigned short)(v.w >> 16);
    }
    __syncthreads();
#pragma unroll
    for (int ks = 0; ks < 4; ++ks) { const bf16x8 pa = *(const LAS bf16x8*)(Ks + (16 * wid + fr) * MP + (32 * ks + 8 * fq) * 2);
#pragma unroll
        for (int nt = 0; nt < 16; ++nt) { const bf16x8 b = *(const LAS bf16x8*)(BUF + (16 * nt + fr) * MP + (32 * ks + 8 * fq) * 2); num[nt] = MFMA16(pa, b, num[nt]); if ((nt & 3) == 3) __builtin_amdgcn_sched_barrier(0); } }
    float ssq[4];
#pragma unroll
    for (int j = 0; j < 4; ++j) { const float rd = 1.0f / den[j]; float s = 0.f;
#pragma unroll
        for (int nt = 0; nt < 16; ++nt) { const float v = num[nt][j] * rd; num[nt][j] = v; s += v * v; }
        s += __shfl_xor(s, 1); s += __shfl_xor(s, 2); s += __shfl_xor(s, 4); s += __shfl_xor(s, 8); ssq[j] = 1.0f / sqrtf(s * (1.0f / 256.0f) + 1e-6f); }
    __syncthreads();
    LAS float* HS = (LAS float*)(lds + 4096);
#pragma unroll
    for (int nt = 0; nt < 16; ++nt)
#pragma unroll
        for (int j = 0; j < 4; ++j) HS[(16 * wid + 4 * fq + j) * 260 + 16 * nt + fr] = num[nt][j] * ssq[j];
    __syncthreads();
    for (int task = tid; task < 4096; task += NTHR) {
        const int r = task >> 5, c8 = (task & 31) * 8; const size_t row = (size_t)(row0 + r);
        const f32x4 h0 = *(const LAS f32x4*)(HS + r * 260 + c8), h1 = *(const LAS f32x4*)(HS + r * 260 + c8 + 4);
        const f32x4 g0 = *(const f32x4*)(hgain + h * 256 + c8), g1 = *(const f32x4*)(hgain + h * 256 + c8 + 4);
        const v4u mo = *(const v4u*)(PROJ + row * PLD + C_MO + h * 256 + c8);
        v4u o;
        o.x = pk2(h0[0] * g0[0] / (1.0f + __expf(-bf2f(mo.x & 0xffffu))), h0[1] * g0[1] / (1.0f + __expf(-bf2f(mo.x >> 16))));
        o.y = pk2(h0[2] * g0[2] / (1.0f + __expf(-bf2f(mo.y & 0xffffu))), h0[3] * g0[3] / (1.0f + __expf(-bf2f(mo.y >> 16))));
        o.z = pk2(h1[0] * g1[0] / (1.0f + __expf(-bf2f(mo.z & 0xffffu))), h1[1] * g1[1] / (1.0f + __expf(-bf2f(mo.z >> 16))));
        o.w = pk2(h1[2] * g1[2] / (1.0f + __expf(-bf2f(mo.w & 0xffffu))), h1[3] * g1[3] / (1.0f + __expf(-bf2f(mo.w >> 16))));
        *(v4u*)(Y + row * DM + 1024 + h * 256 + c8) = o;
    }
    __syncthreads();
}

__device__ __forceinline__ att::BlockRef<att::bf16, att::bf16> att_ref(int i, int pass, const bfu* PROJ, bfu* OATT) {
    int ph, x;
    if (gridDim.x == 256) { ph = ((i >> 8) & 1) * 8 + (blockIdx.x & 7); x = blockIdx.x >> 3; }
    else { ph = (i >> 5) & 15; x = i & 31; }
    const int qb = pass ? 63 - x : x, h = ph >> 2, c = (ph >> 1) & 1, vh = ph & 1;
    att::BlockRef<att::bf16, att::bf16> r;
    constexpr size_t MSZ = (size_t)16384 * 128;
    r.Q = (const att::bf16*)(PROJ + (size_t)(2 * h + c) * MSZ + (size_t)qb * 256 * 128);
    r.K = (const att::bf16*)(PROJ + (size_t)(8 + 2 * h + c) * MSZ);
    r.V = (const att::bf16*)(PROJ + (size_t)(16 + 2 * h + vh) * MSZ);
    r.O = (att::bf16*)(OATT + (size_t)qb * 256 * 2048 + h * 512 + c * 256 + vh * 128);
    r.P0 = qb * 256;
    return r;
}
__device__ __forceinline__ void attn_phase(char* lds, const bfu* PROJ, bfu* OATT, const int TOTAL, const int mk_wave) {
    using namespace att;
    int i = blockIdx.x; if (i >= TOTAL) return;
    int pass = 0;
    BlockRef<bf16, bf16> cur = att_ref(i, 0, PROJ, OATT);
    Seam<bf16> S;
    causal_swa_prime<bf16, bf16>(cur, S_, lds, S, mk_wave);
    for (;;) {
        const bool more_pass = pass == 0, more_item = i + (int)gridDim.x < TOTAL, last = !more_pass && !more_item;
        int in_ = i, passn = pass + 1;
        if (!more_pass) { passn = 0; in_ = more_item ? i + (int)gridDim.x : i; }
        const BlockRef<bf16, bf16> nxt = last ? cur : att_ref(in_, passn, PROJ, OATT);
        causal_swa_block<bf16, bf16>(cur, nxt, S_, S_, lds, S, mk_wave);
        if (last) break;
        cur = nxt; i = in_; pass = passn;
    }
}

#ifndef ATTN2
#define ATTN2 5
#endif
__device__ __forceinline__ att::A2Ref att2_ref(int i, int pass, const bfu* PROJ, bfu* OATT) {
    int hc, x;
    if (gridDim.x == 256) { hc = blockIdx.x & 7; x = ((i >> 8) & 1) * 32 + (blockIdx.x >> 3); }
    else { hc = (i >> 6) & 7; x = i & 63; }
    const int qb = pass ? 127 - x : x, h = hc >> 1, c = hc & 1;
    constexpr size_t MSZ = (size_t)16384 * 128;
    att::A2Ref r;
    r.Q = (const att::bf16*)(PROJ + (size_t)(2 * h + c) * MSZ + (size_t)qb * 128 * 128);
    r.K = (const att::bf16*)(PROJ + (size_t)(8 + 2 * h + c) * MSZ);
    r.V0 = (const att::bf16*)(PROJ + (size_t)(16 + 2 * h) * MSZ); r.V1 = (const att::bf16*)(PROJ + (size_t)(16 + 2 * h + 1) * MSZ);
    r.O = (att::bf16*)(OATT + (size_t)qb * 128 * 2048 + h * 512 + c * 256);
    r.P0 = qb * 128;
    return r;
}
__device__ __forceinline__ void attn2_phase(char* lds, const bfu* PROJ, bfu* OATT, const int TOTAL, const int mk_wave) {
    for (int i = blockIdx.x; i < TOTAL; i += gridDim.x)
        for (int pass = 0; pass < 2; ++pass) { const att::A2Ref r = att2_ref(i, pass, PROJ, OATT); att::attn9_block(r, lds, (__attribute__((address_space(3))) unsigned char*)lds, mk_wave); }
}

__global__ void __launch_bounds__(NTHR, 2) mega_fwd(Args args) {
    extern __shared__ __attribute__((aligned(16))) unsigned char lds_raw[];
    LAS unsigned char* lds = (LAS unsigned char*)lds_raw;
    const int wave = __builtin_amdgcn_readfirstlane((int)threadIdx.x >> 6);
    const int G = gridDim.x, gw = blockIdx.x * NWAVES + wave, NGW = G * NWAVES;
#define AS4 __attribute__((address_space(4)))
#define PH_BEGIN int koff_ = 0; asm volatile("" : "+s"(koff_)); const AS4 char* kp_ = (const AS4 char*)__builtin_amdgcn_kernarg_segment_ptr() + koff_; \
    unsigned char* ws = *(unsigned char* const AS4*)(kp_ + 192); float* out = *(float* const AS4*)(kp_ + 184); (void)out; (void)ws; const int lane = mk_lane(), tid = wave * 64 + lane; (void)tid; (void)lane;
#define KIN(i) (*(const float* const AS4*)(kp_ + 8 * (i)))
#define Wgu ((bfu*)(ws + WS_WGU))
#define Wd ((bfu*)(ws + WS_WD))
#define Win ((bfu*)(ws + WS_WIN))
#define Wout ((bfu*)(ws + WS_WOUT))
#define XN ((bfu*)(ws + WS_XN))
#define BIG ((bfu*)(ws + WS_BIG))
#define Y ((bfu*)(ws + WS_Y))
#define CT ((bfu*)(ws + WS_CT))
#define QC ((bfu*)(ws + WS_QC))
#define KC ((bfu*)(ws + WS_KC))
#define NST ((float*)(ws + WS_NST))
#define rowss1 ((float*)(ws + WS_ROWSS1))
#define rowss2 ((float*)(ws + WS_ROWSS2))
#define SC ((float*)(ws + WS_SC))
#define DN ((float*)(ws + WS_DN))
#define GATES ((float*)(ws + WS_GATES))
#define DELTA ((float*)(ws + WS_XN))
#define OATT ((bfu*)(ws + WS_XN))
#define PROJM (BIG + (size_t)24 * 16384 * 128)
    const int lo = args.ph_lo, hi = args.ph_hi;
    if (lo < 0) cg::this_grid().sync();
    if (hi - lo > 1) {
        if (wave == 0 && mk_lane() == 0) { volatile LAS unsigned* st = (volatile LAS unsigned*)(lds + LDS_BYTES - 64); st[0] = 0u; st[1] = 0u;
            (void)xb_add(&((unsigned*)(args.ws + WS_BAR))[XB_XCNT(xb_xcc_id())], 1u); }
        __syncthreads();
    }
#ifndef PHMASK
#define PHMASK 0xfff
#endif
#define IN(k) (((PHMASK >> (k)) & 1) && lo <= (k) && (k) < hi)
#ifndef PROBE_MASK
#define PROBE_MASK 0
#endif
#define NREP(k) (((PROBE_MASK >> (k)) & 1) ? 2 : 1)
#define STAGGER_DELAY(N) do { const int sn_ = (int)((blockIdx.x >> 3) & 3) * (N); for (int sd_ = 0; sd_ < sn_; ++sd_) __builtin_amdgcn_s_sleep(85); } while (0)
#define SYNC(k) do { if (IN(k) && IN((k) + 1)) { \
        { int kb_ = 0; asm volatile("" : "+s"(kb_)); unsigned char* wsb_ = *(unsigned char* const AS4*)((const AS4 char*)__builtin_amdgcn_kernarg_segment_ptr() + kb_ + 192); \
               xcd_barrier((unsigned*)(wsb_ + WS_BAR), (volatile LAS unsigned*)(lds + LDS_BYTES - 64), wave == 0 && mk_lane() == 0); \
               if ((PROBE_MASK >> 14) & 1) xcd_barrier((unsigned*)(wsb_ + WS_BAR), (volatile LAS unsigned*)(lds + LDS_BYTES - 64), wave == 0 && mk_lane() == 0); } } } while (0)

    if (IN(0)) for (int rep_ = 0; rep_ < NREP(0); ++rep_) { PH_BEGIN
        const float* x = KIN(0);
        LAS float* scr = (LAS float*)(lds + wave * 16640);
        constexpr int I_FFN = 3 * 2816, I_IN = 32 * 96, I_OUT = 32 * 32;
        for (int it = gw; it < I_FFN + I_IN + I_OUT; it += NGW) {
            if (it < I_FFN) cvt_ffn_item(it, KIN(2), KIN(3), KIN(4), KIN(1), Wgu, Wd, scr, lane);
            else if (it < I_FFN + I_IN) { const int r = it - I_FFN, kb = r / 96, nb = r % 96; cvt_item(KIN(6), NIN, NIN, KIN(5), Win, DM, nb * 64, kb * 64, nb * 64, scr, lane); }
            else { const int r = it - I_FFN - I_IN, kb = r / 32, nb = r % 32; cvt_item(KIN(17), DM, DM, nullptr, Wout, DM, nb * 64, kb * 64, nb * 64, scr, lane); }
        }
        for (int m = gw; m < S_; m += NGW) {
            const f32x4* xr = (const f32x4*)(x + (size_t)m * DM) + lane; f32x4 v[8]; float s = 0.f;
#pragma unroll
            for (int j = 0; j < 8; ++j) { v[j] = xr[64 * j]; s += (v[j][0] * v[j][0] + v[j][1] * v[j][1]) + (v[j][2] * v[j][2] + v[j][3] * v[j][3]); }
            const float rs = 1.0f / sqrtf(wave_sum(s) * (1.0f / DM) + 1e-6f);
            v2u* o8 = (v2u*)(XN + (size_t)m * DM) + lane;
#pragma unroll
            for (int j = 0; j < 8; ++j) { v2u w; w.x = pk2(v[j][0] * rs, v[j][1] * rs); w.y = pk2(v[j][2] * rs, v[j][3] * rs); o8[64 * j] = w; }
        }
        for (int i = blockIdx.x * NTHR + tid; i < 2 * S_; i += G * NTHR) rowss1[i] = 0.f;
        for (int k = blockIdx.x * NTHR + tid; k < DM + 8; k += G * NTHR) {
            unsigned char* gwp = ws + WS_GW; f32x4 w0 = (f32x4){0.f, 0.f, 0.f, 0.f}, w1 = w0;
            if (k < DM) { const float gk = KIN(5)[k]; w0 = *(const f32x4*)(KIN(6) + (size_t)k * NIN + 6144) * gk; w1 = *(const f32x4*)(KIN(6) + (size_t)k * NIN + 6148) * gk; }
#pragma unroll
            for (int j = 0; j < 4; ++j) { *(unsigned short*)(gwp + j * GWP + k * 2) = (unsigned short)f2bf(w0[j]); *(unsigned short*)(gwp + (4 + j) * GWP + k * 2) = (unsigned short)f2bf(w1[j]);
                *(unsigned short*)(gwp + (8 + j) * GWP + k * 2) = 0; *(unsigned short*)(gwp + (12 + j) * GWP + k * 2) = 0; }
        }
    }
    SYNC(0);
    if (IN(1)) { PH_BEGIN
        pg8::Gemm g{XN, Wgu, S_, 2 * FF, DM}; pg8::StaticOrder So; So.init(S_, 2 * FF, G, (int)blockIdx.x);
        pg8::EpiSwiGLU E{BIG, FF, nullptr, 0.f};
        STAGGER_DELAY(1); for (int rep_ = 0; rep_ < NREP(1); ++rep_) pg8::gemm_phase<pg8::EpiSwiGLU, pg8::StaticOrder, true, true>(lds, g, So, E, wave);
    }
    SYNC(1);
    if (IN(2)) { PH_BEGIN
        pg8::Gemm g{BIG, Wd, S_, DM, FF}; pg8::StaticOrder So; So.init(S_, DM, G, (int)blockIdx.x);
        pg8::EpiResid E{KIN(0), out, XN, rowss1, 0.5f, DM};
        STAGGER_DELAY(3); pg8::gemm_phase<pg8::EpiResid, pg8::StaticOrder, true, true>(lds, g, So, E, wave);
    }
    SYNC(2);
    if (IN(3)) { PH_BEGIN
        pg8::Gemm g{XN, Win, S_, NINP, DM}; pg8::StaticOrder So; So.init(S_, NINP, G, (int)blockIdx.x);
        pg8::EpiProj E{BIG, rowss1, 1.0f / DM};
        STAGGER_DELAY(1); for (int rep_ = 0; rep_ < NREP(3); ++rep_) pg8::gemm_phase<pg8::EpiProj, pg8::StaticOrder, true, true>(lds, g, So, E, wave);
        {
            const v4u* src = (const v4u*)(ws + WS_GW);
            for (int i = tid; i < 16 * GWP / 16; i += NTHR) *(LAS v4u*)(lds + 16384 + i * 16) = src[i];
            __syncthreads();
        }
        for (int rep_ = 0; rep_ < NREP(13); ++rep_) for (int rb = blockIdx.x; rb < S_ / 64; rb += G) gates_rows(lds, XN, rowss1, KIN(14), KIN(15), GATES, rb, wave, lane);
    }
    SYNC(3);
    if (IN(4)) { PH_BEGIN for (int item = blockIdx.x; item < 512 * NREP(4); item += G) mlstm_stage_a(lds, PROJM, GATES, KIN(12), KIN(13), QC, KC, DELTA, DN, SC, item & 511, wave); }
    SYNC(4);
    if (IN(5)) { PH_BEGIN for (int rep_ = 0; rep_ < NREP(5); ++rep_) mlstm_scan(lds, DELTA, DN, SC, SC + 1024, CT, NST, tid, blockIdx.x * NTHR + tid, G * NTHR); }
    SYNC(5);
    if (IN(6)) { PH_BEGIN
#ifndef NO_ATTN
#if ATTN2
        attn2_phase((char*)lds_raw, BIG, OATT, 512 * NREP(6), wave);
#else
        attn_phase((char*)lds_raw, BIG, OATT, 512 * NREP(6), wave);
#endif
#endif
        __syncthreads();
#ifndef NO_STAGEC
        for (int rep_ = 0; rep_ < NREP(12); ++rep_) for (int item = blockIdx.x; item < 512; item += G) mlstm_stage_c(lds, PROJM, GATES, QC, KC, CT, NST, SC + 1024, KIN(16), Y, item, wave);
#endif
        {
            LAS float* scr = (LAS float*)(lds + wave * 16640);
            for (int it = gw; it < 3 * 2816; it += NGW) cvt_ffn_item(it, KIN(19), KIN(20), KIN(21), KIN(18), Wgu, Wd, scr, lane);
        }
    }
    SYNC(6);
    if (IN(7)) for (int rep_ = 0; rep_ < NREP(7); ++rep_) { PH_BEGIN
        const float l1 = wave_sum(KIN(7)[lane] * KIN(8)[lane] + KIN(7)[lane + 64] * KIN(8)[lane + 64]);
        const float l2 = wave_sum(KIN(9)[lane] * KIN(10)[lane] + KIN(9)[lane + 64] * KIN(10)[lane + 64]);
        const float lam = expf(l1) - expf(l2) + 0.2f;
        const float* hg = KIN(11);
        for (int m = gw; m < S_; m += NGW) {
#pragma unroll
            for (int h = 0; h < 4; ++h) {
                const v2u a = *((const v2u*)(OATT + (size_t)m * 2048 + h * 512) + lane), b = *((const v2u*)(OATT + (size_t)m * 2048 + h * 512 + 256) + lane);
                float y0 = bf2f(a.x & 0xffffu) - lam * bf2f(b.x & 0xffffu), y1 = bf2f(a.x >> 16) - lam * bf2f(b.x >> 16), y2 = bf2f(a.y & 0xffffu) - lam * bf2f(b.y & 0xffffu), y3 = bf2f(a.y >> 16) - lam * bf2f(b.y >> 16);
                const float rs = 0.8f / sqrtf(wave_sum((y0 * y0 + y1 * y1) + (y2 * y2 + y3 * y3)) * (1.0f / 256.0f) + 1e-6f);
                const f32x4 gn = *((const f32x4*)(hg + h * 256) + lane);
                v2u w; w.x = pk2(y0 * rs * gn[0], y1 * rs * gn[1]); w.y = pk2(y2 * rs * gn[2], y3 * rs * gn[3]);
                *((v2u*)(Y + (size_t)m * DM + h * 256) + lane) = w;
            }
        }
    }
    SYNC(7);
    if (IN(8)) { PH_BEGIN
        pg8::Gemm g{Y, Wout, S_, DM, DM}; pg8::StaticOrder So; So.init(S_, DM, G, (int)blockIdx.x);
        pg8::EpiResid E{out, out, XN, rowss2, 1.0f, DM};
        STAGGER_DELAY(3); pg8::gemm_phase<pg8::EpiResid, pg8::StaticOrder, true, true>(lds, g, So, E, wave);
    }
    SYNC(8);
    if (IN(9)) { PH_BEGIN
        pg8::Gemm g{XN, Wgu, S_, 2 * FF, DM}; pg8::StaticOrder So; So.init(S_, 2 * FF, G, (int)blockIdx.x);
        pg8::EpiSwiGLU E{BIG, FF, rowss2, 1.0f / DM};
        STAGGER_DELAY(1); pg8::gemm_phase<pg8::EpiSwiGLU, pg8::StaticOrder, true, true>(lds, g, So, E, wave);
    }
    SYNC(9);
    if (IN(10)) { PH_BEGIN
        pg8::Gemm g{BIG, Wd, S_, DM, FF}; pg8::StaticOrder So; So.init(S_, DM, G, (int)blockIdx.x);
        pg8::EpiResid E{out, out, nullptr, nullptr, 0.5f, DM};
        STAGGER_DELAY(3); pg8::gemm_phase<pg8::EpiResid, pg8::StaticOrder, true, true>(lds, g, So, E, wave);
    }
    SYNC(10);
    if (IN(11)) { PH_BEGIN
        const float* fg = KIN(22);
        for (int m = gw; m < S_; m += NGW) {
            f32x4* xr = (f32x4*)(out + (size_t)m * DM) + lane; f32x4 v[8]; float s = 0.f;
#pragma unroll
            for (int j = 0; j < 8; ++j) { v[j] = xr[64 * j]; s += (v[j][0] * v[j][0] + v[j][1] * v[j][1]) + (v[j][2] * v[j][2] + v[j][3] * v[j][3]); }
            const float rs = 1.0f / sqrtf(wave_sum(s) * (1.0f / DM) + 1e-6f);
#pragma unroll
            for (int j = 0; j < 8; ++j) { const f32x4 gn = *((const f32x4*)fg + 64 * j + lane); xr[64 * j] = v[j] * rs * gn; }
        }
    }
#undef IN
#undef SYNC
}

extern "C" void kernel_launch(void* const* d_in, const int* in_sizes, int n_in, void* d_out, int out_size, void* d_ws, size_t ws_size, hipStream_t stream) {
    static int grid = 0;
    if (grid == 0) {
        if (n_in != 23 || in_sizes[0] != S_ * DM || out_size != S_ * DM || ws_size < WS_END) { fprintf(stderr, "kernel_launch: unexpected shapes (n_in %d, in0 %d, out %d, ws %zu)\n", n_in, n_in > 0 ? in_sizes[0] : -1, out_size, ws_size); grid = -1; return; }
        int dev = 0, cus = 0, per_cu = 0;
        (void)hipGetDevice(&dev); (void)hipDeviceGetAttribute(&cus, hipDeviceAttributeMultiprocessorCount, dev);
        if (hipFuncSetAttribute((const void*)mega_fwd, hipFuncAttributeMaxDynamicSharedMemorySize, LDS_BYTES) != hipSuccess) { fprintf(stderr, "kernel_launch: hipFuncSetAttribute failed\n"); grid = -1; return; }
        if (hipOccupancyMaxActiveBlocksPerMultiprocessor(&per_cu, (const void*)mega_fwd, NTHR, LDS_BYTES) != hipSuccess || per_cu < 1) per_cu = 1;
        grid = cus * per_cu;
        fprintf(stderr, "kernel_launch: grid %d (%d CUs x %d)\n", grid, cus, per_cu);
    }
    if (grid < 0) return;
    Args a{};
    for (int i = 0; i < 23; ++i) a.in[i] = (const float*)d_in[i];
    a.out = (float*)d_out; a.ws = (unsigned char*)d_ws;
#if MK_SPLIT
    for (int p = 0; p < NPH; ++p) { a.ph_lo = p; a.ph_hi = p + 1; hipLaunchKernelGGL(mega_fwd, dim3(grid), dim3(NTHR), LDS_BYTES, stream, a); }
#else
    a.ph_lo = 0; a.ph_hi = NPH;
    (void)hipMemsetAsync((char*)d_ws + WS_BAR, 0, XCD_BAR_WORDS * 4, stream);
    void* kargs[] = {&a};
    hipError_t e = hipLaunchCooperativeKernel((const void*)mega_fwd, dim3(grid), dim3(NTHR), kargs, LDS_BYTES, stream);
    if (e != hipSuccess) fprintf(stderr, "kernel_launch: cooperative launch failed: %s (grid %d)\n", hipGetErrorString(e), grid);
#endif
}
```

```cpp
#include <hip/hip_runtime.h>
#include <hip/hip_bf16.h>
#include <hip/hip_cooperative_groups.h>
#include <cstdio>
#include <cstdint>
namespace cg = cooperative_groups;

#ifndef MK_SPLIT
#define MK_SPLIT 0
#endif

namespace pg8 {
#define PG8_LAS __attribute__((address_space(3)))
typedef unsigned short bf16_t;
typedef short bf16x8 __attribute__((ext_vector_type(8)));
typedef float f32x4 __attribute__((ext_vector_type(4)));
typedef unsigned u32x4 __attribute__((ext_vector_type(4)));
constexpr int BM = 256, BK = 64, HALF = 128, HTB = HALF * BK * 2  , STAGE_BYTES = 8 * HTB, NXCD = 8, WGM = 8;

__host__ __device__ __forceinline__ int lds_byte(int r, int c) { const int st = (r >> 4) * 2 + (c >> 5), rr = r & 15, cc = c & 31, ob = rr * 64 + cc * 2; return st * 1024 + (ob ^ (((ob >> 9) & 1) << 5)); }
__host__ __device__ __forceinline__ void stage_rc(int b, int& R, int& C) { const int st = b / 1024, sb = b % 1024, swz = sb ^ (((sb >> 9) & 1) << 5); R = (st >> 1) * 16 + swz / 64; C = (st & 1) * 32 + (swz % 64) / 2; }
__host__ __device__ __forceinline__ int perm32(int rho) { const int n = rho >> 4, i = rho & 15; return 8 * (i >> 2) + 4 * n + (i & 3); }

struct Unit { int pm, pn; };
struct Gemm { const bf16_t* A; const bf16_t* Bt; int M, N, K; };

struct StaticOrder {
    int nM, nN, nwg, G, c;
    __host__ __device__ void init(int M, int N, int G_, int c_) { nM = M / BM; nN = N / BM; nwg = nM * nN; G = G_; c = c_; }
    __host__ __device__ bool next(int i, Unit& u) const {
        const long L = (long)i * G + c; if (L >= nwg) return false;
        int wgid = (int)L; { const int q = nwg / NXCD, r = nwg % NXCD, xcd = wgid % NXCD, off = wgid / NXCD; wgid = (xcd < r ? xcd * (q + 1) : r * (q + 1) + (xcd - r) * q) + off; }
        const int nig = WGM * nN, gid = wgid / nig, fm = gid * WGM, gsz = (nM - fm) < WGM ? (nM - fm) : WGM;
        u.pm = fm + ((wgid % nig) % gsz); u.pn = (wgid % nig) / gsz; return true;
    }
    __device__ __forceinline__ void a_ready(const Unit&) const {}
    __device__ __forceinline__ void done(const Unit&) const {}
};

__device__ __forceinline__ unsigned cvt_pk_bf16(float lo, float hi) { unsigned r; asm volatile("v_cvt_pk_bf16_f32 %0, %1, %2" : "=v"(r) : "v"(lo), "v"(hi)); return r; }

constexpr float RMS_EPS = 1e-6f;
__device__ __forceinline__ float silu_f(float x) { return x * __builtin_amdgcn_rcpf(1.0f + __builtin_amdgcn_exp2f(-1.4426950408889634f * x)); }
struct EpiSwiGLU {
    static constexpr bool PERM = true, AFTER_DRAIN = false;
    bf16_t* O; int ldo; const float* rowss; float inv_n;
    __device__ __forceinline__ void operator()(const f32x4 (&acc)[2][2][4][2], const Unit& u, int wr, int wc, int fr, int fq) const {
        const int row0 = u.pm * BM + wr * 64 + fr, col0 = u.pn * HALF + wc * 32 + 8 * fq;
#pragma unroll
        for (int ai = 0; ai < 2; ++ai)
#pragma unroll
            for (int m = 0; m < 4; ++m) {
                const int r = row0 + ai * HALF + m * 16;
                const float rs = rowss ? __builtin_amdgcn_rsqf(rowss[r] * inv_n + RMS_EPS) : 1.0f;
                const f32x4 g0 = acc[ai][0][m][0] * rs, g1 = acc[ai][0][m][1] * rs, u0 = acc[ai][1][m][0] * rs, u1 = acc[ai][1][m][1] * rs;
                u32x4 w;
                w.x = cvt_pk_bf16(silu_f(g0[0]) * u0[0], silu_f(g0[1]) * u0[1]); w.y = cvt_pk_bf16(silu_f(g0[2]) * u0[2], silu_f(g0[3]) * u0[3]);
                w.z = cvt_pk_bf16(silu_f(g1[0]) * u1[0], silu_f(g1[1]) * u1[1]); w.w = cvt_pk_bf16(silu_f(g1[2]) * u1[2], silu_f(g1[3]) * u1[3]);
                *(u32x4*)(O + (size_t)r * ldo + col0) = w;
            }
    }
};
struct EpiResid {
    static constexpr bool PERM = true, AFTER_DRAIN = false;
    const float* resid; float* out; bf16_t* xb; float* rowss; float alpha; int ld;
    __device__ __forceinline__ void operator()(const f32x4 (&acc)[2][2][4][2], const Unit& u, int wr, int wc, int fr, int fq) const {
        const int row0 = u.pm * BM + wr * 64 + fr, col0 = u.pn * BM + wc * 32 + 8 * fq;
#pragma unroll
        for (int ai = 0; ai < 2; ++ai)
#pragma unroll
            for (int m = 0; m < 4; ++m) {
                const int r = row0 + ai * HALF + m * 16; float ss = 0.f;
#pragma unroll
                for (int bj = 0; bj < 2; ++bj) {
                    const size_t off = (size_t)r * ld + col0 + bj * HALF;
                    const f32x4 b0 = *(const f32x4*)(resid + off), b1 = *(const f32x4*)(resid + off + 4);
                    const f32x4 o0 = b0 + acc[ai][bj][m][0] * alpha, o1 = b1 + acc[ai][bj][m][1] * alpha;
                    if (out) { *(f32x4*)(out + off) = o0; *(f32x4*)(out + off + 4) = o1; }
                    ss += ((o0[0] * o0[0] + o0[1] * o0[1]) + (o0[2] * o0[2] + o0[3] * o0[3])) + ((o1[0] * o1[0] + o1[1] * o1[1]) + (o1[2] * o1[2] + o1[3] * o1[3]));
                    if (xb) { u32x4 w; w.x = cvt_pk_bf16(o0[0], o0[1]); w.y = cvt_pk_bf16(o0[2], o0[3]); w.z = cvt_pk_bf16(o1[0], o1[1]); w.w = cvt_pk_bf16(o1[2], o1[3]); *(u32x4*)(xb + off) = w; }
                }
                if (rowss) { ss += __shfl_xor(ss, 16); ss += __shfl_xor(ss, 32); if (fq == 0) atomicAdd(rowss + r, ss); }
            }
    }
};
struct EpiProj {
    static constexpr bool PERM = true, AFTER_DRAIN = false;
    bf16_t* O; const float* rowss; float inv_n;
    __device__ __forceinline__ void operator()(const f32x4 (&acc)[2][2][4][2], const Unit& u, int wr, int wc, int fr, int fq) const {
        const int row0 = u.pm * BM + wr * 64 + fr;
        {
            const bool dense = u.pn < 12;
            const size_t rstride = dense ? 128 : 3072;
            bf16_t* base = dense ? O + (size_t)(2 * u.pn) * ((size_t)16384 * 128) + wc * 32 + 8 * fq : O + (size_t)24 * 16384 * 128 + (u.pn - 12) * BM + wc * 32 + 8 * fq;
            const size_t bjstep = dense ? (size_t)16384 * 128 : 128;
#pragma unroll
            for (int ai = 0; ai < 2; ++ai)
#pragma unroll
                for (int m = 0; m < 4; ++m) {
                    const int r = row0 + ai * HALF + m * 16; const float rs = __builtin_amdgcn_rsqf(rowss[r] * inv_n + RMS_EPS);
#pragma unroll
                    for (int bj = 0; bj < 2; ++bj) { const f32x4 v0 = acc[ai][bj][m][0] * rs, v1 = acc[ai][bj][m][1] * rs; u32x4 w;
                        w.x = cvt_pk_bf16(v0[0], v0[1]); w.y = cvt_pk_bf16(v0[2], v0[3]); w.z = cvt_pk_bf16(v1[0], v1[1]); w.w = cvt_pk_bf16(v1[2], v1[3]);
                        *(u32x4*)(base + (size_t)r * rstride + bj * bjstep) = w; }
                }
        }
    }
};
template <class Epi, class Sched, bool ALIGN_EPI = false, bool SP2 = false>
__device__ __forceinline__ void gemm_phase(PG8_LAS unsigned char* lds, const Gemm g, const Sched& S, const Epi& E, const int mk_wave) {
    const int lane = (int)(__builtin_amdgcn_mbcnt_hi(~0u, __builtin_amdgcn_mbcnt_lo(~0u, 0u)) & 63u), wid = mk_wave & 7, tid = wid * 64 + lane, wr = wid >> 2, wc = wid & 3, fr = lane & 15, fq = lane >> 4;
    const int K = g.K, nt = K / BK;
    unsigned voffA[2], voffB[2];
#pragma unroll
    for (int i = 0; i < 2; ++i) { int R, C; stage_rc(tid * 16 + i * 8192, R, C); const int Rb = Epi::PERM ? ((R & ~31) + perm32(R & 31)) : R;
        voffA[i] = (unsigned)(R * K + C) * 2u; voffB[i] = (unsigned)(Rb * K + C) * 2u; }
    const size_t kstep = (size_t)(BK * 2);
    const size_t hstep = (size_t)HALF * K * 2;
    const size_t tstep = 2 * hstep;
    const unsigned ldsw = (unsigned)wid * 1024u;
    const int aoff = lds_byte(wr * 64 + fr, fq * 8), boff = lds_byte(wc * 32 + fr, fq * 8);
#define PG8_SA(b, h) (((b) * 2 + (h)) * HTB)
#define PG8_SB(b, h) ((4 + (b) * 2 + (h)) * HTB)
#define PG8_STAGE(bufoff, gbase, voff) do { _Pragma("unroll") for (int _i = 0; _i < 2; ++_i) \
        __builtin_amdgcn_global_load_lds((const unsigned*)((const char*)(gbase) + (voff)[_i]), (PG8_LAS unsigned*)(lds + (bufoff) + ldsw + _i * 8192), 16, 0, 0); } while (0)
#define PG8_LDA(dst, b, h) do { _Pragma("unroll") for (int m = 0; m < 4; ++m) _Pragma("unroll") for (int k = 0; k < 2; ++k) dst[m][k] = *(const PG8_LAS bf16x8*)(lds + PG8_SA(b, h) + aoff + m * 2048 + k * 1024); } while (0)
#define PG8_LDB(dst, b, h) do { _Pragma("unroll") for (int n = 0; n < 2; ++n) _Pragma("unroll") for (int k = 0; k < 2; ++k) dst[n][k] = *(const PG8_LAS bf16x8*)(lds + PG8_SB(b, h) + boff + n * 2048 + k * 1024); } while (0)
#define PG8_MMA(ai, bj, At, Bt) do { __builtin_amdgcn_s_setprio(1); _Pragma("unroll") for (int m = 0; m < 4; ++m) _Pragma("unroll") for (int n = 0; n < 2; ++n) _Pragma("unroll") for (int k = 0; k < 2; ++k) \
        acc[ai][bj][m][n] = __builtin_amdgcn_mfma_f32_16x16x32_bf16(Bt[n][k], At[m][k], acc[ai][bj][m][n], 0, 0, 0); __builtin_amdgcn_s_setprio(0); } while (0)
#define PG8_WAIT_V(n) asm volatile("s_waitcnt vmcnt(" #n ")" ::: "memory")
#define PG8_WAIT_L(n) asm volatile("s_waitcnt lgkmcnt(" #n ")" ::: "memory")
#define PG8_BAR __builtin_amdgcn_s_barrier()
#define PG8_SCHED __builtin_amdgcn_sched_barrier(0)
    Unit cur, nxt; int ui = 0;
    if (!S.next(0, cur)) return;
    f32x4 acc[2][2][4][2];
#pragma unroll
    for (int a = 0; a < 2; ++a)
#pragma unroll
        for (int b = 0; b < 2; ++b)
#pragma unroll
            for (int m = 0; m < 4; ++m)
#pragma unroll
                for (int n = 0; n < 2; ++n) acc[a][b][m][n] = (f32x4){0.f, 0.f, 0.f, 0.f};
    bf16x8 At[4][2], B0[2][2], B1[2][2];
    const char* cA = (const char*)g.A + (size_t)cur.pm * tstep; const char* cB = (const char*)g.Bt + (size_t)cur.pn * tstep;
    S.a_ready(cur);
    if constexpr (SP2) {
        PG8_STAGE(PG8_SB(0, 0), cB, voffB); PG8_STAGE(PG8_SB(0, 1), cB + hstep, voffB); PG8_STAGE(PG8_SA(0, 0), cA, voffA); PG8_STAGE(PG8_SA(0, 1), cA + hstep, voffA);
        if (wr == 1) PG8_BAR;
        PG8_WAIT_V(2); PG8_BAR;
        PG8_STAGE(PG8_SB(1, 0), cB + kstep, voffB); PG8_STAGE(PG8_SA(1, 0), cA + kstep, voffA); PG8_STAGE(PG8_SB(1, 1), cB + hstep + kstep, voffB);
        PG8_WAIT_V(6); PG8_BAR;
    } else {
        PG8_STAGE(PG8_SB(0, 0), cB, voffB); PG8_STAGE(PG8_SA(0, 0), cA, voffA); PG8_STAGE(PG8_SB(0, 1), cB + hstep, voffB); PG8_STAGE(PG8_SA(0, 1), cA + hstep, voffA);
        if (wr == 1) PG8_BAR;
        PG8_WAIT_V(4); PG8_BAR;
        PG8_STAGE(PG8_SB(1, 0), cB + kstep, voffB); PG8_STAGE(PG8_SA(1, 0), cA + kstep, voffA); PG8_STAGE(PG8_SB(1, 1), cB + hstep + kstep, voffB);
        PG8_WAIT_V(6); PG8_BAR;
    }
    for (;;) {
        const bool has_next = S.next(ui + 1, nxt);
        const char* nA = has_next ? (const char*)g.A + (size_t)nxt.pm * tstep : cA; const char* nB = has_next ? (const char*)g.Bt + (size_t)nxt.pn * tstep : cB;
        for (int t = 0; t < nt; t += 2) {
            const bool last = (t == nt - 2);
            const char* a1 = cA + (size_t)(t + 1) * kstep;
            const char* a2 = last ? nA : cA + (size_t)(t + 2) * kstep; const char* b2 = last ? nB : cB + (size_t)(t + 2) * kstep;
            const char* a3 = a2 + kstep; const char* b3 = b2 + kstep;
            if (last && has_next) S.a_ready(nxt);
            if constexpr (SP2) {
            PG8_LDB(B0, 0, 0); PG8_LDB(B1, 0, 1); PG8_SCHED; PG8_LDA(At, 0, 0); PG8_STAGE(PG8_SA(1, 1), a1 + hstep, voffA);
            PG8_WAIT_V(8); PG8_WAIT_L(0); PG8_BAR; PG8_MMA(0, 0, At, B0); PG8_MMA(0, 1, At, B1); PG8_BAR; PG8_SCHED;
            PG8_LDA(At, 0, 1); PG8_STAGE(PG8_SB(0, 0), b2, voffB); PG8_STAGE(PG8_SB(0, 1), b2 + hstep, voffB); PG8_STAGE(PG8_SA(0, 0), a2, voffA);
            PG8_WAIT_V(8); PG8_WAIT_L(0); PG8_BAR; PG8_MMA(1, 0, At, B0); PG8_MMA(1, 1, At, B1); PG8_BAR; PG8_SCHED;
            PG8_LDB(B0, 1, 0); PG8_LDB(B1, 1, 1); PG8_SCHED; PG8_LDA(At, 1, 0); PG8_STAGE(PG8_SA(0, 1), a2 + hstep, voffA);
            PG8_WAIT_V(8); PG8_WAIT_L(0); PG8_BAR; PG8_MMA(0, 0, At, B0); PG8_MMA(0, 1, At, B1); PG8_BAR; PG8_SCHED;
            PG8_LDA(At, 1, 1); PG8_STAGE(PG8_SB(1, 0), b3, voffB); PG8_STAGE(PG8_SB(1, 1), b3 + hstep, voffB); PG8_STAGE(PG8_SA(1, 0), a3, voffA);
            PG8_WAIT_V(8); PG8_WAIT_L(0); PG8_BAR; PG8_MMA(1, 0, At, B0); PG8_MMA(1, 1, At, B1); PG8_BAR; PG8_SCHED;
            } else {
            PG8_LDB(B0, 0, 0); PG8_SCHED; PG8_LDA(At, 0, 0); PG8_STAGE(PG8_SA(1, 1), a1 + hstep, voffA);
            PG8_WAIT_L(8); PG8_BAR; PG8_WAIT_L(0); PG8_MMA(0, 0, At, B0); PG8_BAR; PG8_SCHED;
            PG8_LDB(B1, 0, 1); PG8_STAGE(PG8_SB(0, 0), b2, voffB);
            PG8_BAR; PG8_WAIT_L(0); PG8_MMA(0, 1, At, B1); PG8_BAR;
            PG8_LDA(At, 0, 1); PG8_STAGE(PG8_SA(0, 0), a2, voffA);
            PG8_BAR; PG8_WAIT_L(0); PG8_MMA(1, 0, At, B0); PG8_BAR; PG8_SCHED;
            PG8_STAGE(PG8_SB(0, 1), b2 + hstep, voffB);
            PG8_WAIT_V(6); PG8_BAR; PG8_MMA(1, 1, At, B1); PG8_BAR;
            PG8_LDB(B0, 1, 0); PG8_SCHED; PG8_LDA(At, 1, 0); PG8_STAGE(PG8_SA(0, 1), a2 + hstep, voffA);
            PG8_WAIT_L(8); PG8_BAR; PG8_WAIT_L(0); PG8_MMA(0, 0, At, B0); PG8_BAR; PG8_SCHED;
            PG8_LDB(B1, 1, 1); PG8_STAGE(PG8_SB(1, 0), b3, voffB);
            PG8_BAR; PG8_WAIT_L(0); PG8_MMA(0, 1, At, B1); PG8_BAR;
            PG8_LDA(At, 1, 1); PG8_STAGE(PG8_SA(1, 0), a3, voffA);
            PG8_BAR; PG8_WAIT_L(0); PG8_MMA(1, 0, At, B0); PG8_BAR; PG8_SCHED;
            PG8_STAGE(PG8_SB(1, 1), b3 + hstep, voffB);
            PG8_WAIT_V(6); PG8_BAR; PG8_MMA(1, 1, At, B1); PG8_BAR;
            }
        }
        if constexpr (ALIGN_EPI) { if (wr == 0) PG8_BAR; }
        if constexpr (!Epi::AFTER_DRAIN) { E(acc, cur, wr, wc, fr, fq); S.done(cur); }
        if (!has_next) break;
#pragma unroll
        for (int a = 0; a < 2; ++a)
#pragma unroll
            for (int b = 0; b < 2; ++b)
#pragma unroll
                for (int m = 0; m < 4; ++m)
#pragma unroll
                    for (int n = 0; n < 2; ++n) acc[a][b][m][n] = (f32x4){0.f, 0.f, 0.f, 0.f};
        cur = nxt; cA = nA; cB = nB; ++ui;
        if constexpr (ALIGN_EPI) { if (wr == 1) PG8_BAR; }
    }
    PG8_WAIT_V(0);
    if constexpr (!ALIGN_EPI) { if (wr == 0) PG8_BAR; }
    PG8_BAR;
    if constexpr (Epi::AFTER_DRAIN) { E.fused(acc, cur, wr, wc, fr, fq, lds, wid, lane); S.done(cur); }
#undef PG8_SA
#undef PG8_SB
#undef PG8_STAGE
#undef PG8_LDA
#undef PG8_LDB
#undef PG8_MMA
#undef PG8_WAIT_V
#undef PG8_WAIT_L
#undef PG8_BAR
#undef PG8_SCHED
}
}

namespace att {
constexpr int D = 128; constexpr float THR = 8.f; constexpr bool WSKIP = false; constexpr int LDP = 128, LDO = 2048;
constexpr float SCALE = 0.08838834764831845f;
constexpr int NW = 8, QBLK = 32, KVBLK = 64, QB = NW * QBLK;
constexpr int SHM_V = KVBLK * D * 2, SHM_K = KVBLK * D * 2;
constexpr int LDS_BYTES = 2 * SHM_V + 2 * SHM_K + NW * 64 * 4;

using bf16 = __hip_bfloat16;
typedef short bf16x8 __attribute__((ext_vector_type(8)));
typedef short s16x4 __attribute__((ext_vector_type(4)));
typedef float f32x16 __attribute__((ext_vector_type(16)));
typedef float f32x4 __attribute__((ext_vector_type(4)));
typedef unsigned u32x4 __attribute__((ext_vector_type(4)));
template <class A, class Bt> struct same_t { static constexpr bool v = false; };
template <class A> struct same_t<A, A> { static constexpr bool v = true; };

#define KSWZ(row, colB) ((row) * 256 + ((colB) ^ (((row) & 7) << 4)))
#define SBAR() __builtin_amdgcn_sched_barrier(0)
__device__ __forceinline__ int v_st(int k, int c) { const int kk = (k & ~0xC) | ((k & 4) << 1) | ((k & 8) >> 1); return ((kk >> 3) * 4 + (c >> 5)) * 512 + ((kk & 7) * 32 + (c & 31)) * 2; }
__device__ __forceinline__ int v_rd_base(int lane) { return ((lane & 3) << 3) | (((lane >> 2) & 3) << 6) | (((lane >> 4) & 1) << 5) | (((lane >> 5) & 1) << 8); }
constexpr int v_rd_off(int d0, int ks, int half) { return d0 * 512 + ks * 4096 + half * 2048; }
__device__ __forceinline__ int crow(int r, int hi) { return (r & 3) + 8 * (r >> 2) + 4 * hi; }
__device__ __forceinline__ unsigned cvtpk(float lo, float hi) {
    unsigned r; asm volatile("v_cvt_pk_bf16_f32 %0, %1, %2" : "=v"(r) : "v"(lo), "v"(hi)); return r;
}
__device__ __forceinline__ bf16x8 pack8(f32x4 a, f32x4 b) {
    u32x4 w = {cvtpk(a[0], a[1]), cvtpk(a[2], a[3]), cvtpk(b[0], b[1]), cvtpk(b[2], b[3])};
    return *reinterpret_cast<bf16x8*>(&w);
}
template <class T> __device__ __forceinline__ bf16x8 load8(const T* p) {
    if constexpr (same_t<T, float>::v) { return pack8(*(const f32x4*)p, *(const f32x4*)(p + 4)); }
    else { return *reinterpret_cast<const bf16x8*>(p); }
}
__device__ __forceinline__ void mask_tile(f32x16& p0, f32x16& p1, int dq, unsigned W) {
    const float NEG = -__builtin_inff();
#pragma unroll
    for (int r = 0; r < 16; ++r) {
        const int c = (r & 3) + 8 * (r >> 2);
        if ((unsigned)(dq - c) >= W) p0[r] = NEG;
        if ((unsigned)(dq - c - 32) >= W) p1[r] = NEG;
    }
}
__device__ __forceinline__ void partialSM(f32x16& p0, f32x16& p1, float& m_reg, float& mn, float& alpha) {
    float pmax = p0[0]; for (int r = 1; r < 16; ++r) pmax = fmaxf(pmax, p0[r]); for (int r = 0; r < 16; ++r) pmax = fmaxf(pmax, p1[r]);
    { auto rr = __builtin_amdgcn_permlane32_swap(__float_as_uint(pmax), __float_as_uint(pmax), false, false);
      pmax = fmaxf(__uint_as_float(rr[0]), __uint_as_float(rr[1])); }
    constexpr float C2 = 1.4426950408889634f * SCALE;
    if (__builtin_expect(__all((pmax - m_reg) * SCALE <= THR), 1)) { mn = m_reg; alpha = 1.f; }
    else { mn = fmaxf(m_reg, pmax); alpha = __builtin_amdgcn_exp2f((m_reg - mn) * C2); m_reg = mn; }
    const float mnL = -mn * C2;
    for (int r = 0; r < 16; ++r) p0[r] = fmaf(p0[r], C2, mnL); for (int r = 0; r < 16; ++r) p1[r] = fmaf(p1[r], C2, mnL);
    for (int r = 0; r < 16; ++r) p0[r] = __builtin_amdgcn_exp2f(p0[r]);
}
__device__ __forceinline__ void finishSM(f32x16& p0, f32x16& p1, float alpha, float& l_reg, bf16x8& pa0, bf16x8& pa1, bf16x8& pa2, bf16x8& pa3) {
    for (int r = 0; r < 16; ++r) p1[r] = __builtin_amdgcn_exp2f(p1[r]);
    float ps = 0; for (int r = 0; r < 16; ++r) ps += p0[r]; for (int r = 0; r < 16; ++r) ps += p1[r];
    { auto rr = __builtin_amdgcn_permlane32_swap(__float_as_uint(ps), __float_as_uint(ps), false, false);
      ps = __uint_as_float(rr[0]) + __uint_as_float(rr[1]); }
    l_reg = l_reg * alpha + ps;
#define PK4(P, B_, OUT) do { unsigned a0 = cvtpk(P[B_+0], P[B_+1]), a1 = cvtpk(P[B_+2], P[B_+3]);                          \
        unsigned b0 = cvtpk(P[B_+4], P[B_+5]), b1 = cvtpk(P[B_+6], P[B_+7]);                                             \
        auto r0 = __builtin_amdgcn_permlane32_swap(a0, b0, false, false); auto r1 = __builtin_amdgcn_permlane32_swap(a1, b1, false, false); \
        u32x4 w = {r0[0], r1[0], r0[1], r1[1]}; OUT = *reinterpret_cast<bf16x8*>(&w); } while (0)
    PK4(p0, 0, pa0); PK4(p0, 8, pa1); PK4(p1, 0, pa2); PK4(p1, 8, pa3);
#undef PK4
}
template <int KB, bool SK>
__device__ __forceinline__ void qkt(f32x16& p0, f32x16& p1, const char* K_lds, int r32, int hi, const bf16x8* qr, bool act) {
    if (SK && !act) { const float NEG = -__builtin_inff();
#pragma unroll
        for (int r = 0; r < 16; ++r) { p0[r] = NEG; p1[r] = NEG; } return; }
    p0 = f32x16{}; p1 = f32x16{};
    const char* kb[4];
#pragma unroll
    for (int dd = 0; dd < 4; ++dd) kb[dd] = K_lds + KB * SHM_K + KSWZ(r32, (dd * 16 + hi * 8) * 2);
#pragma unroll
    for (int d0 = 0; d0 < 8; ++d0) { const char* a = kb[d0 & 3] + (d0 >> 2) * 128;
        bf16x8 b0 = *reinterpret_cast<const bf16x8*>(a);
        bf16x8 b1 = *reinterpret_cast<const bf16x8*>(a + 32 * 256);
        p0 = __builtin_amdgcn_mfma_f32_32x32x16_bf16(b0, qr[d0], p0, 0, 0, 0);
        p1 = __builtin_amdgcn_mfma_f32_32x32x16_bf16(b1, qr[d0], p1, 0, 0, 0); }
}
template <int VB, bool SK>
__device__ __forceinline__ void pv_tile(f32x16* o, int vb0, bf16x8 pa0, bf16x8 pa1, bf16x8 pa2, bf16x8 pa3, bool act) {
    if (SK && !act) return;
#define TRRD(dst, off) asm volatile("ds_read_b64_tr_b16 %0, %1 offset:%2" : "=&v"(dst) : "v"(vb0), "i"(off) : "memory")
#define PV_D0(d0) do { s16x4 l0, l1, l2, l3, h0, h1, h2, h3; constexpr int b_ = VB * SHM_V + v_rd_off(d0, 0, 0);     \
        TRRD(l0, b_); TRRD(h0, b_ + 2048); TRRD(l1, b_ + 4096); TRRD(h1, b_ + 6144); TRRD(l2, b_ + 8192); TRRD(h2, b_ + 10240); TRRD(l3, b_ + 12288); TRRD(h3, b_ + 14336); \
        asm volatile("s_waitcnt lgkmcnt(0)" ::: "memory"); SBAR();                 \
        o[d0] = __builtin_amdgcn_mfma_f32_32x32x16_bf16(pa0, (bf16x8){l0[0], l0[1], l0[2], l0[3], h0[0], h0[1], h0[2], h0[3]}, o[d0], 0, 0, 0);   \
        o[d0] = __builtin_amdgcn_mfma_f32_32x32x16_bf16(pa1, (bf16x8){l1[0], l1[1], l1[2], l1[3], h1[0], h1[1], h1[2], h1[3]}, o[d0], 0, 0, 0);   \
        o[d0] = __builtin_amdgcn_mfma_f32_32x32x16_bf16(pa2, (bf16x8){l2[0], l2[1], l2[2], l2[3], h2[0], h2[1], h2[2], h2[3]}, o[d0], 0, 0, 0);   \
        o[d0] = __builtin_amdgcn_mfma_f32_32x32x16_bf16(pa3, (bf16x8){l3[0], l3[1], l3[2], l3[3], h3[0], h3[1], h3[2], h3[3]}, o[d0], 0, 0, 0); } while (0)
    PV_D0(0); PV_D0(1); PV_D0(2); PV_D0(3);
#undef PV_D0
#undef TRRD
}

template <class TIn, class TOut> struct BlockRef { const TIn* Q; const TIn* K; const TIn* V; TOut* O; int P0; };
template <class TIn> struct Seam {
    bf16x8 qr[8];
    bf16x8 st_v0, st_v1, st_k0, st_k1; f32x4 sf0, sf1, sf2, sf3;
    f32x4 tq[16];
};
__device__ __forceinline__ int swa_jlo(int P0, int W) { const int lowk = P0 - W + 1; return lowk > 0 ? lowk / KVBLK : 0; }
#define ROW(p, k0, rr) ((p) + (size_t)((k0) + (rr)) * LDP + sc)
#define VMW() asm volatile("s_waitcnt vmcnt(0)" ::: "memory")
#define VMWN(n) asm volatile("s_waitcnt vmcnt(%0)" :: "i"(n) : "memory")
#define SLOAD_H(Kp, Vp, k0) do { S.st_v0 = load8<TIn>(ROW(Vp, k0, sr)); S.st_v1 = load8<TIn>(ROW(Vp, k0, 32 + sr));              \
                         S.st_k0 = load8<TIn>(ROW(Kp, k0, sr)); S.st_k1 = load8<TIn>(ROW(Kp, k0, 32 + sr)); } while (0)
#define SWRITE_HK(bf) do { *(bf16x8*)(K_lds + (bf) * SHM_K + kws) = S.st_k0; *(bf16x8*)(K_lds + (bf) * SHM_K + kws + 32 * 256) = S.st_k1; } while (0)
#define SWRITE_HV(bf) do { *(bf16x8*)(V_lds + (bf) * SHM_V + vst0) = S.st_v0; *(bf16x8*)(V_lds + (bf) * SHM_V + vst1) = S.st_v1; } while (0)
#define SWRITE_H(bf) do { SWRITE_HV(bf); SWRITE_HK(bf); } while (0)
#define SLOAD_F(p, k0) do { S.sf0 = *(const f32x4*)ROW(p, k0, sr); S.sf1 = *(const f32x4*)(ROW(p, k0, sr) + 4);                \
                            S.sf2 = *(const f32x4*)ROW(p, k0, 32 + sr); S.sf3 = *(const f32x4*)(ROW(p, k0, 32 + sr) + 4); } while (0)
#define SWRITE_KF(bf) do { *(bf16x8*)(K_lds + (bf) * SHM_K + kws) = pack8(S.sf0, S.sf1); *(bf16x8*)(K_lds + (bf) * SHM_K + kws + 32 * 256) = pack8(S.sf2, S.sf3); } while (0)
#define SWRITE_VF(bf) do { *(bf16x8*)(V_lds + (bf) * SHM_V + vst0) = pack8(S.sf0, S.sf1); *(bf16x8*)(V_lds + (bf) * SHM_V + vst1) = pack8(S.sf2, S.sf3); } while (0)
template <class TIn, class TOut>
__device__ __forceinline__ void causal_swa_prime(const BlockRef<TIn, TOut>& cur, int W, char* lds, Seam<TIn>& S, const int mk_wave) {
    constexpr bool F32 = same_t<TIn, float>::v;
    const int lane = (int)(__builtin_amdgcn_mbcnt_hi(~0u, __builtin_amdgcn_mbcnt_lo(~0u, 0u)) & 63u), wid = mk_wave & 7, tid = wid * 64 + lane, r32 = lane & 31, hi = lane >> 5;
    const int sr = tid >> 4, sc = (tid & 15) * 8, kws = KSWZ(sr, sc * 2); char* K_lds = lds + 2 * SHM_V;
    const int kb0 = swa_jlo(cur.P0, W) * KVBLK;
    for (int d0 = 0; d0 < 8; ++d0) S.qr[d0] = load8<TIn>(cur.Q + (size_t)(wid * QBLK + r32) * LDP + d0 * 16 + hi * 8);
    if constexpr (F32) { SLOAD_F((const float*)cur.K, kb0); VMW(); SWRITE_KF(0); SBAR(); SLOAD_F((const float*)cur.V, kb0); }
    else { SLOAD_H(cur.K, cur.V, kb0); VMW(); SWRITE_HK(0); }
    __syncthreads();
}
template <class TIn, class TOut>
__device__ __forceinline__ void causal_swa_block(const BlockRef<TIn, TOut>& cur, const BlockRef<TIn, TOut>& nxt, int skv, int W, char* lds, Seam<TIn>& S, const int mk_wave) {
    constexpr bool F32 = same_t<TIn, float>::v;
    const int lane = (int)(__builtin_amdgcn_mbcnt_hi(~0u, __builtin_amdgcn_mbcnt_lo(~0u, 0u)) & 63u), wid = mk_wave & 7, tid = wid * 64 + lane, r32 = lane & 31, hi = lane >> 5;
    const int j_lo = swa_jlo(cur.P0, W);
    int j_hi = (cur.P0 + QB - 1) / KVBLK + 1; if (j_hi > skv / KVBLK) j_hi = skv / KVBLK;
    const int NT = j_hi - j_lo;
    const int kbn = swa_jlo(nxt.P0, W) * KVBLK;
    const int qlo = cur.P0 + wid * QBLK, qm = qlo + r32 - 4 * hi;
    char* V_lds = lds; char* K_lds = lds + 2 * SHM_V;
    float* ws = (float*)(lds + 2 * SHM_V + 2 * SHM_K) + wid * 64; float* li_l = ws, * al_l = ws + 32;
    float m_reg = -1e30f, l_reg = 0; f32x16 o[4] = {};
    const int sr = tid >> 4, sc = (tid & 15) * 8, vst0 = v_st(sr, sc), vst1 = v_st(32 + sr, sc), kws = KSWZ(sr, sc * 2);
    const int vb0 = (int)(uintptr_t)V_lds + v_rd_base(lane);
    const TIn* Kh = cur.K; const TIn* Vh = cur.V;
#define RESC(a) do { if (__any((a) < 1.f)) { if (hi == 0) al_l[r32] = (a); asm volatile("s_waitcnt lgkmcnt(0)" ::: "memory");              \
                     for (int d_ = 0; d_ < 4; ++d_) for (int r = 0; r < 16; ++r) o[d_][r] *= al_l[crow(r, hi)]; } } while (0)
#define KBASE(t) ((j_lo + (t)) * KVBLK)
#define ACT(t) (KBASE(t) <= qlo + QBLK - 1 && KBASE(t) + KVBLK - 1 >= qlo - W + 1)
#define MASKT(P0_, P1_, t) do { const int kb_ = KBASE(t); if ((!SK || ACT(t)) && (kb_ + KVBLK - 1 > qlo || kb_ <= qlo + QBLK - 1 - W)) mask_tile(P0_, P1_, qm - kb_, (unsigned)W); } while (0)
    constexpr int NQL = F32 ? 16 : 8;
    constexpr bool SK = WSKIP && !F32;
#define SEAM_K0() do { VMWN(NQL); if constexpr (F32) { SWRITE_KF(0); SBAR(); SLOAD_F((const float*)nxt.V, kbn); } else { SWRITE_HK(0); } SBAR(); } while (0)
    f32x16 pA0, pA1, pB0, pB1; float mnA, mnB, alA, alB; bf16x8 pa0, pa1, pa2, pa3;
    if constexpr (F32) { VMW(); SWRITE_VF(0); SBAR(); } else { SWRITE_HV(0); SBAR(); }
    if (NT > 1) { if constexpr (F32) SLOAD_F((const float*)Kh, KBASE(1)); else SLOAD_H(Kh, Vh, KBASE(1)); }
    SBAR(); qkt<0, SK>(pA0, pA1, K_lds, r32, hi, S.qr, ACT(0));
    if constexpr (F32) { if (NT > 1) { VMW(); SWRITE_KF(1); SBAR(); SLOAD_F((const float*)Vh, KBASE(1)); } }
    MASKT(pA0, pA1, 0); partialSM(pA0, pA1, m_reg, mnA, alA);
    if (NT > 1) { VMW(); if constexpr (F32) { SWRITE_VF(1); SBAR(); if (NT > 2) SLOAD_F((const float*)Kh, KBASE(2)); } else SWRITE_H(1); }
    __syncthreads();
#define HALF_STEP(PX0, PX1, mnX, alX, PY0, PY1, alY, t, KB, VB, SB) do {                                                      \
        SBAR(); qkt<KB, SK>(PX0, PX1, K_lds, r32, hi, S.qr, ACT(t));                                             \
        finishSM(PY0, PY1, alY, l_reg, pa0, pa1, pa2, pa3); SBAR();                                                           \
        if ((t) + 1 < NT) { if constexpr (F32) { VMW(); SWRITE_KF(SB); SBAR(); SLOAD_F((const float*)Vh, KBASE((t) + 1)); }  \
                            else { SLOAD_H(Kh, Vh, KBASE((t) + 1)); } SBAR(); }                                               \
        pv_tile<VB, SK>(o, vb0, pa0, pa1, pa2, pa3, ACT((t) - 1)); MASKT(PX0, PX1, (t)); partialSM(PX0, PX1, m_reg, mnX, alX);                                        \
        __syncthreads();                                                                                                      \
        if ((t) + 1 < NT) { VMW(); if constexpr (F32) { SWRITE_VF(SB); SBAR(); if ((t) + 2 < NT) SLOAD_F((const float*)Kh, KBASE((t) + 2)); } \
                            else { SWRITE_H(SB); } }                                                                          \
        RESC(alX); __syncthreads(); } while (0)
    for (int t = 1; t + 1 < NT; t += 2) {
        HALF_STEP(pB0, pB1, mnB, alB, pA0, pA1, alA, t, 1, 0, 0);
        HALF_STEP(pA0, pA1, mnA, alA, pB0, pB1, alB, t + 1, 0, 1, 1);
    }
    const bool even = (NT & 1) == 0;
    if (even) { SBAR(); qkt<1, SK>(pB0, pB1, K_lds, r32, hi, S.qr, ACT(NT - 1)); SBAR(); }
#define QROW(e) (nxt.Q + (size_t)(wid * QBLK + r32) * LDP + ((e) >> 1) * 16 + hi * 8 + ((e) & 1) * 4)
    if constexpr (F32) { SLOAD_F((const float*)nxt.K, kbn); SBAR();
#pragma unroll
        for (int e = 0; e < 8; ++e) S.tq[e] = *(const f32x4*)QROW(e); }
    else { SLOAD_H(nxt.K, nxt.V, kbn); SBAR();
#pragma unroll
        for (int d0 = 0; d0 < 8; ++d0) S.qr[d0] = load8<TIn>(nxt.Q + (size_t)(wid * QBLK + r32) * LDP + d0 * 16 + hi * 8); }
    SBAR();
    finishSM(pA0, pA1, alA, l_reg, pa0, pa1, pa2, pa3); SBAR();
    if constexpr (F32) {
#pragma unroll
        for (int e = 8; e < 16; ++e) S.tq[e] = *(const f32x4*)QROW(e); SBAR(); }
#undef QROW
    pv_tile<0, SK>(o, vb0, pa0, pa1, pa2, pa3, ACT(even ? NT - 2 : NT - 1));
    if (even) { MASKT(pB0, pB1, NT - 1); partialSM(pB0, pB1, m_reg, mnB, alB); __syncthreads(); RESC(alB);
        finishSM(pB0, pB1, alB, l_reg, pa0, pa1, pa2, pa3); SBAR(); pv_tile<1, SK>(o, vb0, pa0, pa1, pa2, pa3, ACT(NT - 1)); }
    SBAR(); SEAM_K0();
    if (hi == 0) li_l[r32] = l_reg; asm volatile("s_waitcnt lgkmcnt(0)" ::: "memory");
    float rli[16];
#pragma unroll
    for (int r = 0; r < 16; ++r) rli[r] = __builtin_amdgcn_rcpf(li_l[crow(r, hi)]);
    TOut* Ow = cur.O + (size_t)(wid * QBLK) * LDO;
#pragma unroll
    for (int r = 0; r < 16; ++r) { const int orow = crow(r, hi);
#pragma unroll
        for (int d0 = 0; d0 < 4; ++d0) { const float v = o[d0][r] * rli[r];
            if constexpr (same_t<TOut, float>::v) { Ow[(size_t)orow * LDO + d0 * 32 + r32] = v; }
            else { const float vn = __shfl_xor(v, 1);
                   if ((r32 & 1) == 0) *(unsigned*)(Ow + (size_t)orow * LDO + d0 * 32 + r32) = cvtpk(v, vn); } } }
    if constexpr (F32) {
#pragma unroll
        for (int d0 = 0; d0 < 8; ++d0) S.qr[d0] = pack8(S.tq[2 * d0], S.tq[2 * d0 + 1]); }
    __syncthreads();
#undef RESC
#undef KBASE
#undef ACT
#undef MASKT
#undef SEAM_K0
#undef HALF_STEP
}
#undef ROW
#undef VMW
#undef VMWN
#undef SLOAD_H
#undef SWRITE_HK
#undef SWRITE_HV
#undef SWRITE_H
#undef SLOAD_F
#undef SWRITE_KF
#undef SWRITE_VF

constexpr int A2_V = 0;
constexpr int A2_K = 4 * SHM_V;
constexpr int A2_X = A2_K + 2 * SHM_K;
constexpr int A2_XS = 4096 + 512;
constexpr int A2_LDS = A2_X + 4 * A2_XS;
struct A2Ref { const bf16* Q; const bf16* K; const bf16* V0; const bf16* V1; bf16* O; int P0; };

__device__ __forceinline__ void attn2_block(const A2Ref& c, char* lds, const int mk_wave) {
    const int lane = (int)(__builtin_amdgcn_mbcnt_hi(~0u, __builtin_amdgcn_mbcnt_lo(~0u, 0u)) & 63u), wid = mk_wave & 7, tid = wid * 64 + lane, r32 = lane & 31, hi = lane >> 5, rg = wid & 3, vh = wid >> 2;
    char* V_lds = lds + A2_V; char* K_lds = lds + A2_K; char* X = lds + A2_X + rg * A2_XS;
    float* XA = (float*)(X + 4096); float* XM = XA + 32; float* XL = XA + 64;
    const int NT = (c.P0 + 127) / 64 + 1;
    const int qlo = c.P0 + rg * 32, qm = qlo + r32 - 4 * hi;
    const int sr = tid >> 4, sc = (tid & 15) * 8, vst0 = v_st(sr, sc), vst1 = v_st(32 + sr, sc), kws = KSWZ(sr, sc * 2);
    const int vb0 = (int)(uintptr_t)V_lds + vh * SHM_V + v_rd_base(lane);
    bf16x8 qr[8];
#pragma unroll
    for (int d0 = 0; d0 < 8; ++d0) qr[d0] = load8<bf16>(c.Q + (size_t)(rg * 32 + r32) * 128 + d0 * 16 + hi * 8);
    float m_reg = -1e30f, l_reg = 0.f; f32x16 o[4] = {};
    bf16x8 sk0, sk1, sa0, sa1, sb0, sb1;
#define A2_LOAD(kb) do { const size_t ro_ = (size_t)((kb) + sr) * 128 + sc; sk0 = load8<bf16>(c.K + ro_); sk1 = load8<bf16>(c.K + ro_ + 32 * 128); \
        sa0 = load8<bf16>(c.V0 + ro_); sa1 = load8<bf16>(c.V0 + ro_ + 32 * 128); sb0 = load8<bf16>(c.V1 + ro_); sb1 = load8<bf16>(c.V1 + ro_ + 32 * 128); } while (0)
#define A2_WRITE(buf) do { *(bf16x8*)(K_lds + (buf) * SHM_K + kws) = sk0; *(bf16x8*)(K_lds + (buf) * SHM_K + kws + 32 * 256) = sk1; \
        *(bf16x8*)(V_lds + (buf) * 2 * SHM_V + vst0) = sa0; *(bf16x8*)(V_lds + (buf) * 2 * SHM_V + vst1) = sa1; \
        *(bf16x8*)(V_lds + (buf) * 2 * SHM_V + SHM_V + vst0) = sb0; *(bf16x8*)(V_lds + (buf) * 2 * SHM_V + SHM_V + vst1) = sb1; } while (0)
#define A2_VMW() asm volatile("s_waitcnt vmcnt(0)" ::: "memory")
#define A2_STEP(t, B) do { const bool more_ = (t) + 1 < NT; if (more_) A2_LOAD(((t) + 1) * 64); \
        bf16x8 pa0, pa1, pa2, pa3; \
        if (vh == (B)) { f32x16 p0, p1; float mn, alpha; \
            qkt<(B), false>(p0, p1, K_lds, r32, hi, qr, true); \
            if (64 * (t) + 63 > qlo) mask_tile(p0, p1, qm - 64 * (t), 16384u); \
            partialSM(p0, p1, m_reg, mn, alpha); finishSM(p0, p1, alpha, l_reg, pa0, pa1, pa2, pa3); \
            *(bf16x8*)(X + lane * 16) = pa0; *(bf16x8*)(X + 1024 + lane * 16) = pa1; *(bf16x8*)(X + 2048 + lane * 16) = pa2; *(bf16x8*)(X + 3072 + lane * 16) = pa3; \
            if (hi == 0) { XA[r32] = alpha; XM[r32] = m_reg; XL[r32] = l_reg; } } \
        __syncthreads(); \
        if (vh != (B)) { pa0 = *(const bf16x8*)(X + lane * 16); pa1 = *(const bf16x8*)(X + 1024 + lane * 16); pa2 = *(const bf16x8*)(X + 2048 + lane * 16); pa3 = *(const bf16x8*)(X + 3072 + lane * 16); \
            m_reg = XM[r32]; l_reg = XL[r32]; } \
        { const float a_ = XA[r32]; if (__any(a_ < 1.f)) { \
            _Pragma("unroll") for (int d_ = 0; d_ < 4; ++d_) _Pragma("unroll") for (int r = 0; r < 16; ++r) o[d_][r] *= XA[crow(r, hi)]; } } \
        pv_tile<2 * (B), false>(o, vb0, pa0, pa1, pa2, pa3, true); \
        if (more_) { A2_VMW(); A2_WRITE((B) ^ 1); } \
        __syncthreads(); } while (0)
    A2_LOAD(0); A2_VMW(); A2_WRITE(0); __syncthreads();
    for (int t = 0; t < NT; t += 2) { A2_STEP(t, 0); A2_STEP(t + 1, 1); }
    float rli[16];
#pragma unroll
    for (int r = 0; r < 16; ++r) rli[r] = __builtin_amdgcn_rcpf(XL[crow(r, hi)]);
    bf16* Ow = c.O + (size_t)(rg * 32) * LDO + vh * 128;
#pragma unroll
    for (int r = 0; r < 16; ++r) { const int orow = crow(r, hi);
#pragma unroll
        for (int d0 = 0; d0 < 4; ++d0) { const float v = o[d0][r] * rli[r]; const float vn = __shfl_xor(v, 1);
            if ((r32 & 1) == 0) *(unsigned*)(Ow + (size_t)orow * LDO + d0 * 32 + r32) = cvtpk(v, vn); } }
    __syncthreads();
#undef A2_LOAD
#undef A2_WRITE
#undef A2_VMW
#undef A2_STEP
}

constexpr int A6_XS = 8192 + 1024;
constexpr int A6_LDS = A2_X + 4 * A6_XS + 8 * 128;
__device__ __forceinline__ void attn6_block(const A2Ref& c, char* lds, const int mk_wave) {
    int lane_ = (int)(__builtin_amdgcn_mbcnt_hi(~0u, __builtin_amdgcn_mbcnt_lo(~0u, 0u)) & 63u); asm volatile("" : "+v"(lane_));
    const int lane = lane_ & 63, wid = mk_wave & 7, tid = wid * 64 + lane, r32 = lane & 31, hi = lane >> 5, rg = wid & 3, vh = wid >> 2;
    char* V_lds = lds + A2_V; char* K_lds = lds + A2_K; char* X = lds + A2_X + rg * A6_XS;
    float* XM = (float*)(X + 8192); float* XL = XM + 128; float* AL = (float*)(lds + A2_X + 4 * A6_XS + wid * 128);
    const int NT = (c.P0 + 127) / 64 + 1;
    const int qlo = c.P0 + rg * 32, qm = qlo + r32 - 4 * hi;
    const int sr = tid >> 4, sc = (tid & 15) * 8, vst0 = v_st(sr, sc), vst1 = v_st(32 + sr, sc), kws = KSWZ(sr, sc * 2);
    const unsigned so = (unsigned)(sr * 128 + sc) * 2u;
    const int vb0 = (int)(uintptr_t)V_lds + vh * SHM_V + v_rd_base(lane);
    bf16x8 qr[8];
#pragma unroll
    for (int d0 = 0; d0 < 8; ++d0) qr[d0] = load8<bf16>(c.Q + (size_t)(rg * 32 + r32) * 128 + d0 * 16 + hi * 8);
    float m_reg = -1e30f, l_reg = 0.f; f32x16 o[4] = {};
    bf16x8 sk0, sk1, sa0, sa1, sb0, sb1;
    constexpr float C2 = 1.4426950408889634f * SCALE;
#define A4_G(base, kb, rows) (*(const bf16x8*)((const char*)((base) + (size_t)((kb) + (rows)) * 128) + so))
#define A4_LOAD(kb) do { sk0 = A4_G(c.K, kb, 0); sk1 = A4_G(c.K, kb, 32); sa0 = A4_G(c.V0, kb, 0); sa1 = A4_G(c.V0, kb, 32); sb0 = A4_G(c.V1, kb, 0); sb1 = A4_G(c.V1, kb, 32); } while (0)
#define A4_WRITE(buf) do { *(bf16x8*)(K_lds + (buf) * SHM_K + kws) = sk0; *(bf16x8*)(K_lds + (buf) * SHM_K + kws + 32 * 256) = sk1; \
        *(bf16x8*)(V_lds + (buf) * 2 * SHM_V + vst0) = sa0; *(bf16x8*)(V_lds + (buf) * 2 * SHM_V + vst1) = sa1; \
        *(bf16x8*)(V_lds + (buf) * 2 * SHM_V + SHM_V + vst0) = sb0; *(bf16x8*)(V_lds + (buf) * 2 * SHM_V + SHM_V + vst1) = sb1; } while (0)
#define A6_LOADK(kb) do { sk0 = A4_G(c.K, kb, 0); sk1 = A4_G(c.K, kb, 32); } while (0)
#define A6_LOADV(kb) do { sa0 = A4_G(c.V0, kb, 0); sa1 = A4_G(c.V0, kb, 32); sb0 = A4_G(c.V1, kb, 0); sb1 = A4_G(c.V1, kb, 32); } while (0)
#define A6_WRITEK(buf) do { *(bf16x8*)(K_lds + (buf) * SHM_K + kws) = sk0; *(bf16x8*)(K_lds + (buf) * SHM_K + kws + 32 * 256) = sk1; } while (0)
#define A6_WRITEV(buf) do { *(bf16x8*)(V_lds + (buf) * 2 * SHM_V + vst0) = sa0; *(bf16x8*)(V_lds + (buf) * 2 * SHM_V + vst1) = sa1; \
        *(bf16x8*)(V_lds + (buf) * 2 * SHM_V + SHM_V + vst0) = sb0; *(bf16x8*)(V_lds + (buf) * 2 * SHM_V + SHM_V + vst1) = sb1; } while (0)
#define A4_VMW() asm volatile("s_waitcnt vmcnt(0)" ::: "memory")
#define A4_PK(P, B_, OUT) do { unsigned a0_ = cvtpk(P[B_+0], P[B_+1]), a1_ = cvtpk(P[B_+2], P[B_+3]), b0_ = cvtpk(P[B_+4], P[B_+5]), b1_ = cvtpk(P[B_+6], P[B_+7]); \
        auto r0_ = __builtin_amdgcn_permlane32_swap(a0_, b0_, false, false); auto r1_ = __builtin_amdgcn_permlane32_swap(a1_, b1_, false, false); \
        u32x4 w_ = {r0_[0], r1_[0], r0_[1], r1_[1]}; OUT = *reinterpret_cast<bf16x8*>(&w_); } while (0)
#define A5_QK(T, KB) do { p = f32x16{}; \
        { const char* kb_[4]; \
          _Pragma("unroll") for (int dd = 0; dd < 4; ++dd) kb_[dd] = K_lds + (KB) * SHM_K + vh * (32 * 256) + KSWZ(r32, (dd * 16 + hi * 8) * 2); \
          _Pragma("unroll") for (int d0 = 0; d0 < 8; ++d0) { const bf16x8 b_ = *reinterpret_cast<const bf16x8*>(kb_[d0 & 3] + (d0 >> 2) * 128); p = __builtin_amdgcn_mfma_f32_32x32x16_bf16(b_, qr[d0], p, 0, 0, 0); } } } while (0)
#define A5_MAX(T) do { \
        if (64 * (T) + 32 * vh + 31 > qlo) { const int dq_ = qm - 64 * (T) - 32 * vh; \
            _Pragma("unroll") for (int r = 0; r < 16; ++r) { const int cc_ = (r & 3) + 8 * (r >> 2); if ((unsigned)(dq_ - cc_) >= 16384u) p[r] = -__builtin_inff(); } } \
        pmax_ = p[0]; \
        _Pragma("unroll") for (int r = 1; r < 16; ++r) pmax_ = fmaxf(pmax_, p[r]); \
        { auto rr_ = __builtin_amdgcn_permlane32_swap(__float_as_uint(pmax_), __float_as_uint(pmax_), false, false); pmax_ = fmaxf(__uint_as_float(rr_[0]), __uint_as_float(rr_[1])); } \
        if (hi == 0) XM[vh * 32 + r32] = pmax_; } while (0)
#define A5_SOFTMAX() do { \
        pmax_ = fmaxf(pmax_, XM[(vh ^ 1) * 32 + r32]); \
        float mn_; \
        if (__builtin_expect(__all((pmax_ - m_reg) * SCALE <= THR), 1)) { mn_ = m_reg; alpha_ = 1.f; } \
        else { mn_ = fmaxf(m_reg, pmax_); alpha_ = __builtin_amdgcn_exp2f((m_reg - mn_) * C2); m_reg = mn_; } \
        { const float mnL_ = -mn_ * C2; float ps_ = 0.f; \
          _Pragma("unroll") for (int r = 0; r < 16; ++r) { p[r] = __builtin_amdgcn_exp2f(fmaf(p[r], C2, mnL_)); ps_ += p[r]; } \
          auto rr_ = __builtin_amdgcn_permlane32_swap(__float_as_uint(ps_), __float_as_uint(ps_), false, false); ps_ = __uint_as_float(rr_[0]) + __uint_as_float(rr_[1]); \
          l_reg = l_reg * alpha_ + ps_; } \
        A4_PK(p, 0, pm0_); A4_PK(p, 8, pm1_); \
        *(bf16x8*)(X + vh * 2048 + lane * 16) = pm0_; *(bf16x8*)(X + vh * 2048 + 1024 + lane * 16) = pm1_; \
        if (hi == 0) AL[r32] = alpha_; } while (0)
    f32x16 p; float pmax_, alpha_ = 1.f; bf16x8 pm0_, pm1_;
    A4_LOAD(0); A4_VMW(); A4_WRITE(0); A6_LOADK(64); A4_VMW(); A6_WRITEK(1); A6_LOADV(64); if (2 < NT) A6_LOADK(128);
    __syncthreads();
    A5_QK(0, 0); A5_MAX(0);
    __syncthreads();
    A5_SOFTMAX();
    __syncthreads();
#define A6_STEP(t, B) do { \
        bf16x8 pa0, pa1, pa2, pa3; \
        { const bf16x8 po0_ = *(const bf16x8*)(X + (B) * 4096 + (vh ^ 1) * 2048 + lane * 16), po1_ = *(const bf16x8*)(X + (B) * 4096 + (vh ^ 1) * 2048 + 1024 + lane * 16); \
          if (vh == 0) { pa0 = pm0_; pa1 = pm1_; pa2 = po0_; pa3 = po1_; } else { pa0 = po0_; pa1 = po1_; pa2 = pm0_; pa3 = pm1_; } } \
        const float cand_ = fmaxf(pmax_, XM[(B) * 64 + (vh ^ 1) * 32 + r32]);                         \
        const bool more1_ = (t) + 1 < NT; \
        if (more1_) { A4_VMW(); A6_WRITEV((B) ^ 1); if ((t) + 2 < NT) A6_LOADV(((t) + 2) * 64); }     \
        if (more1_) A5_QK((t) + 1, (B) ^ 1); \
        pv_tile<2 * (B), false>(o, vb0, pa0, pa1, pa2, pa3, true); \
        if (!__all((cand_ - m_reg) * SCALE <= THR)) {                                      \
            const float mn_ = fmaxf(m_reg, cand_), al_ = __builtin_amdgcn_exp2f((m_reg - mn_) * C2); m_reg = mn_; l_reg *= al_; \
            if (hi == 0) AL[r32] = al_; asm volatile("s_waitcnt lgkmcnt(0)" ::: "memory"); \
            _Pragma("unroll") for (int d_ = 0; d_ < 4; ++d_) _Pragma("unroll") for (int r = 0; r < 16; ++r) o[d_][r] *= AL[crow(r, hi)]; } \
        if (more1_) { \
            if (64 * ((t) + 1) + 32 * vh + 31 > qlo) { const int dq_ = qm - 64 * ((t) + 1) - 32 * vh; \
                _Pragma("unroll") for (int r = 0; r < 16; ++r) { const int cc_ = (r & 3) + 8 * (r >> 2); if ((unsigned)(dq_ - cc_) >= 16384u) p[r] = -__builtin_inff(); } } \
            pmax_ = p[0]; \
            _Pragma("unroll") for (int r = 1; r < 16; ++r) pmax_ = fmaxf(pmax_, p[r]); \
            { auto rr_ = __builtin_amdgcn_permlane32_swap(__float_as_uint(pmax_), __float_as_uint(pmax_), false, false); pmax_ = fmaxf(__uint_as_float(rr_[0]), __uint_as_float(rr_[1])); } \
            { const float mnL_ = -m_reg * C2; float ps_ = 0.f; \
              _Pragma("unroll") for (int r = 0; r < 16; ++r) { p[r] = __builtin_amdgcn_exp2f(fmaf(p[r], C2, mnL_)); ps_ += p[r]; } \
              auto rr_ = __builtin_amdgcn_permlane32_swap(__float_as_uint(ps_), __float_as_uint(ps_), false, false); ps_ = __uint_as_float(rr_[0]) + __uint_as_float(rr_[1]); \
              l_reg += ps_; } \
            A4_PK(p, 0, pm0_); A4_PK(p, 8, pm1_); \
            *(bf16x8*)(X + ((B) ^ 1) * 4096 + vh * 2048 + lane * 16) = pm0_; *(bf16x8*)(X + ((B) ^ 1) * 4096 + vh * 2048 + 1024 + lane * 16) = pm1_; \
            if (hi == 0) XM[((B) ^ 1) * 64 + vh * 32 + r32] = pmax_; \
            if ((t) + 2 < NT) { A6_WRITEK(B); if ((t) + 3 < NT) A6_LOADK(((t) + 3) * 64); }     \
            __syncthreads(); } \
    } while (0)
    for (int t = 0; t < NT; t += 2) { A6_STEP(t, 0); A6_STEP(t + 1, 1); }
    __syncthreads();
    if (hi == 0) XL[vh * 32 + r32] = l_reg;
    __syncthreads();
    float rli[16];
#pragma unroll
    for (int r = 0; r < 16; ++r) rli[r] = __builtin_amdgcn_rcpf(XL[crow(r, hi)] + XL[32 + crow(r, hi)]);
    bf16* Ow = c.O + (size_t)(rg * 32) * LDO + vh * 128;
#pragma unroll
    for (int r = 0; r < 16; ++r) { const int orow = crow(r, hi);
#pragma unroll
        for (int d0 = 0; d0 < 4; ++d0) { const float v = o[d0][r] * rli[r]; const float vn = __shfl_xor(v, 1);
            if ((r32 & 1) == 0) *(unsigned*)(Ow + (size_t)orow * LDO + d0 * 32 + r32) = cvtpk(v, vn); } }
    __syncthreads();
#undef A4_G
#undef A4_LOAD
#undef A4_WRITE
#undef A4_VMW
#undef A4_PK
#undef A5_QK
#undef A5_MAX
#undef A5_SOFTMAX
#undef A6_STEP
#undef A6_WRITEK
#undef A6_LOADK
#undef A6_LOADV
#undef A6_WRITEV
}

__device__ __forceinline__ void attn9_block(const A2Ref& c, char* lds, __attribute__((address_space(3))) unsigned char* ldsl, const int mk_wave) {
    int lane_ = (int)(__builtin_amdgcn_mbcnt_hi(~0u, __builtin_amdgcn_mbcnt_lo(~0u, 0u)) & 63u); asm volatile("" : "+v"(lane_));
    const int lane = lane_ & 63, wid = mk_wave & 7, tid = wid * 64 + lane, r32 = lane & 31, hi = lane >> 5, rg = wid & 3, vh = wid >> 2;
    char* V_lds = lds + A2_V; char* K_lds = lds + A2_K; char* X = lds + A2_X + rg * A6_XS;
    float* XM = (float*)(X + 8192); float* XL = XM + 128; float* AL = (float*)(lds + A2_X + 4 * A6_XS + wid * 128);
    const int NT = (c.P0 + 127) / 64 + 1;
    const int qlo = c.P0 + rg * 32, qm = qlo + r32 - 4 * hi;
    const int oL = wid * 1024 + lane * 16;
    const int rowK = oL >> 8; const unsigned gK = (unsigned)(rowK * 256 + ((oL & 255) ^ ((rowK & 7) << 4)));
    const int stV = oL >> 9, eV = (oL & 511) >> 1, kkV = (stV >> 2) * 8 + (eV >> 5), kV = (kkV & ~0xC) | ((kkV & 4) << 1) | ((kkV & 8) >> 1);
    const unsigned gV = (unsigned)(kV * 256 + ((stV & 3) * 32 + (eV & 31)) * 2);
    const int vb0 = (int)(uintptr_t)V_lds + vh * SHM_V + v_rd_base(lane);
    bf16x8 qr[8];
#pragma unroll
    for (int d0 = 0; d0 < 8; ++d0) qr[d0] = load8<bf16>(c.Q + (size_t)(rg * 32 + r32) * 128 + d0 * 16 + hi * 8);
    float m_reg = -1e30f, l_reg = 0.f; f32x16 o[4] = {};
    constexpr float C2 = 1.4426950408889634f * SCALE;
#define A9_DMA(gbase, kb, goff, loff) do { \
        __builtin_amdgcn_global_load_lds((const unsigned*)((const char*)((gbase) + (size_t)(kb) * 128) + (goff)), (__attribute__((address_space(3))) unsigned*)(ldsl + (loff) + wid * 1024), 16, 0, 0); \
        __builtin_amdgcn_global_load_lds((const unsigned*)((const char*)((gbase) + (size_t)((kb) + 32) * 128) + (goff)), (__attribute__((address_space(3))) unsigned*)(ldsl + (loff) + 8192 + wid * 1024), 16, 0, 0); } while (0)
#define A9_DMAK(kb, buf) A9_DMA(c.K, kb, gK, A2_K + (buf) * SHM_K)
#define A9_DMAV(kb, buf) do { A9_DMA(c.V0, kb, gV, A2_V + (buf) * 2 * SHM_V); A9_DMA(c.V1, kb, gV, A2_V + (buf) * 2 * SHM_V + SHM_V); } while (0)
#define A4_VMW() asm volatile("s_waitcnt vmcnt(0)" ::: "memory")
#define A4_PK(P, B_, OUT) do { unsigned a0_ = cvtpk(P[B_+0], P[B_+1]), a1_ = cvtpk(P[B_+2], P[B_+3]), b0_ = cvtpk(P[B_+4], P[B_+5]), b1_ = cvtpk(P[B_+6], P[B_+7]); \
        auto r0_ = __builtin_amdgcn_permlane32_swap(a0_, b0_, false, false); auto r1_ = __builtin_amdgcn_permlane32_swap(a1_, b1_, false, false); \
        u32x4 w_ = {r0_[0], r1_[0], r0_[1], r1_[1]}; OUT = *reinterpret_cast<bf16x8*>(&w_); } while (0)
#define A5_QK(T, KB) do { p = f32x16{}; \
        { const char* kb_[4]; \
          _Pragma("unroll") for (int dd = 0; dd < 4; ++dd) kb_[dd] = K_lds + (KB) * SHM_K + vh * (32 * 256) + KSWZ(r32, (dd * 16 + hi * 8) * 2); \
          _Pragma("unroll") for (int d0 = 0; d0 < 8; ++d0) { const bf16x8 b_ = *reinterpret_cast<const bf16x8*>(kb_[d0 & 3] + (d0 >> 2) * 128); p = __builtin_amdgcn_mfma_f32_32x32x16_bf16(b_, qr[d0], p, 0, 0, 0); } } } while (0)
#define A5_MAX(T) do { \
        if (64 * (T) + 32 * vh + 31 > qlo) { const int dq_ = qm - 64 * (T) - 32 * vh; \
            _Pragma("unroll") for (int r = 0; r < 16; ++r) { const int cc_ = (r & 3) + 8 * (r >> 2); if ((unsigned)(dq_ - cc_) >= 16384u) p[r] = -__builtin_inff(); } } \
        pmax_ = p[0]; \
        _Pragma("unroll") for (int r = 1; r < 16; ++r) pmax_ = fmaxf(pmax_, p[r]); \
        { auto rr_ = __builtin_amdgcn_permlane32_swap(__float_as_uint(pmax_), __float_as_uint(pmax_), false, false); pmax_ = fmaxf(__uint_as_float(rr_[0]), __uint_as_float(rr_[1])); } \
        if (hi == 0) XM[vh * 32 + r32] = pmax_; } while (0)
#define A5_SOFTMAX() do { \
        pmax_ = fmaxf(pmax_, XM[(vh ^ 1) * 32 + r32]); \
        float mn_; \
        if (__builtin_expect(__all((pmax_ - m_reg) * SCALE <= THR), 1)) { mn_ = m_reg; alpha_ = 1.f; } \
        else { mn_ = fmaxf(m_reg, pmax_); alpha_ = __builtin_amdgcn_exp2f((m_reg - mn_) * C2); m_reg = mn_; } \
        { const float mnL_ = -mn_ * C2; float ps_ = 0.f; \
          _Pragma("unroll") for (int r = 0; r < 16; ++r) { p[r] = __builtin_amdgcn_exp2f(fmaf(p[r], C2, mnL_)); ps_ += p[r]; } \
          auto rr_ = __builtin_amdgcn_permlane32_swap(__float_as_uint(ps_), __float_as_uint(ps_), false, false); ps_ = __uint_as_float(rr_[0]) + __uint_as_float(rr_[1]); \
          l_reg = l_reg * alpha_ + ps_; } \
        A4_PK(p, 0, pm0_); A4_PK(p, 8, pm1_); \
        *(bf16x8*)(X + vh * 2048 + lane * 16) = pm0_; *(bf16x8*)(X + vh * 2048 + 1024 + lane * 16) = pm1_; \
        if (hi == 0) AL[r32] = alpha_; } while (0)
    f32x16 p; float pmax_, alpha_ = 1.f; bf16x8 pm0_, pm1_;
    A9_DMAK(0, 0); A9_DMAK(64, 1); A9_DMAV(0, 0); A4_VMW();
    __syncthreads();
    A5_QK(0, 0); A5_MAX(0);
    __syncthreads();
    A5_SOFTMAX();
    __syncthreads();
#define A6_STEP(t, B) do { \
        bf16x8 pa0, pa1, pa2, pa3; \
        { const bf16x8 po0_ = *(const bf16x8*)(X + (B) * 4096 + (vh ^ 1) * 2048 + lane * 16), po1_ = *(const bf16x8*)(X + (B) * 4096 + (vh ^ 1) * 2048 + 1024 + lane * 16); \
          if (vh == 0) { pa0 = pm0_; pa1 = pm1_; pa2 = po0_; pa3 = po1_; } else { pa0 = po0_; pa1 = po1_; pa2 = pm0_; pa3 = pm1_; } } \
        const float cand_ = fmaxf(pmax_, XM[(B) * 64 + (vh ^ 1) * 32 + r32]);                         \
        const bool more1_ = (t) + 1 < NT; \
        if (more1_) { A9_DMAV(((t) + 1) * 64, (B) ^ 1); if ((t) + 2 < NT) A9_DMAK(((t) + 2) * 64, B); }     \
        if (more1_) A5_QK((t) + 1, (B) ^ 1); \
        pv_tile<2 * (B), false>(o, vb0, pa0, pa1, pa2, pa3, true); \
        if (!__all((cand_ - m_reg) * SCALE <= THR)) {                                      \
            const float mn_ = fmaxf(m_reg, cand_), al_ = __builtin_amdgcn_exp2f((m_reg - mn_) * C2); m_reg = mn_; l_reg *= al_; \
            if (hi == 0) AL[r32] = al_; asm volatile("s_waitcnt lgkmcnt(0)" ::: "memory"); \
            _Pragma("unroll") for (int d_ = 0; d_ < 4; ++d_) _Pragma("unroll") for (int r = 0; r < 16; ++r) o[d_][r] *= AL[crow(r, hi)]; } \
        if (more1_) { \
            if (64 * ((t) + 1) + 32 * vh + 31 > qlo) { const int dq_ = qm - 64 * ((t) + 1) - 32 * vh; \
                _Pragma("unroll") for (int r = 0; r < 16; ++r) { const int cc_ = (r & 3) + 8 * (r >> 2); if ((unsigned)(dq_ - cc_) >= 16384u) p[r] = -__builtin_inff(); } } \
            pmax_ = p[0]; \
            _Pragma("unroll") for (int r = 1; r < 16; ++r) pmax_ = fmaxf(pmax_, p[r]); \
            { auto rr_ = __builtin_amdgcn_permlane32_swap(__float_as_uint(pmax_), __float_as_uint(pmax_), false, false); pmax_ = fmaxf(__uint_as_float(rr_[0]), __uint_as_float(rr_[1])); } \
            { const float mnL_ = -m_reg * C2; float ps_ = 0.f; \
              _Pragma("unroll") for (int r = 0; r < 16; ++r) { p[r] = __builtin_amdgcn_exp2f(fmaf(p[r], C2, mnL_)); ps_ += p[r]; } \
              auto rr_ = __builtin_amdgcn_permlane32_swap(__float_as_uint(ps_), __float_as_uint(ps_), false, false); ps_ = __uint_as_float(rr_[0]) + __uint_as_float(rr_[1]); \
              l_reg += ps_; } \
            A4_PK(p, 0, pm0_); A4_PK(p, 8, pm1_); \
            *(bf16x8*)(X + ((B) ^ 1) * 4096 + vh * 2048 + lane * 16) = pm0_; *(bf16x8*)(X + ((B) ^ 1) * 4096 + vh * 2048 + 1024 + lane * 16) = pm1_; \
            if (hi == 0) XM[((B) ^ 1) * 64 + vh * 32 + r32] = pmax_; \
            A4_VMW(); __syncthreads(); }     \
    } while (0)
    for (int t = 0; t < NT; t += 2) { A6_STEP(t, 0); A6_STEP(t + 1, 1); }
    __syncthreads();
    if (hi == 0) XL[vh * 32 + r32] = l_reg;
    __syncthreads();
    float rli[16];
#pragma unroll
    for (int r = 0; r < 16; ++r) rli[r] = __builtin_amdgcn_rcpf(XL[crow(r, hi)] + XL[32 + crow(r, hi)]);
    bf16* Ow = c.O + (size_t)(rg * 32) * LDO + vh * 128;
#pragma unroll
    for (int r = 0; r < 16; ++r) { const int orow = crow(r, hi);
#pragma unroll
        for (int d0 = 0; d0 < 4; ++d0) { const float v = o[d0][r] * rli[r]; const float vn = __shfl_xor(v, 1);
            if ((r32 & 1) == 0) *(unsigned*)(Ow + (size_t)orow * LDO + d0 * 32 + r32) = cvtpk(v, vn); } }
    __syncthreads();
#undef A4_VMW
#undef A9_DMA
#undef A9_DMAK
#undef A9_DMAV
#undef A4_PK
#undef A5_QK
#undef A5_MAX
#undef A5_SOFTMAX
#undef A6_STEP
}

}

constexpr int S_ = 16384, DM = 2048, FF = 5632, NIN = 6152, NINP = 6144, PLD = 3072;
constexpr int NWAVES = 8, NTHR = 512;
constexpr int C_MQ = 0, C_MK = 512, C_MV = 1024, C_MO = 2048;
constexpr size_t MiB = 1u << 20, KiB = 1u << 10;
constexpr size_t WS_ROWSS1 = 0, WS_ROWSS2 = 64 * KiB, WS_SC = 192 * KiB  , WS_DN = 256 * KiB, WS_GATES = 512 * KiB;
constexpr size_t WS_BAR = 128 * KiB;
constexpr size_t WS_WGU = 1 * MiB, WS_WD = 45 * MiB, WS_WIN = 67 * MiB, WS_WOUT = 92 * MiB;
constexpr size_t WS_XN = 100 * MiB;
constexpr size_t WS_BIG = 164 * MiB;
constexpr size_t WS_Y = 356 * MiB;
constexpr size_t WS_CT = 420 * MiB;
constexpr size_t WS_QC = 452 * MiB, WS_KC = 468 * MiB;
constexpr size_t WS_NST = 484 * MiB;
constexpr size_t WS_GW = 484 * MiB + 512 * KiB;
constexpr size_t WS_END = 485 * MiB;
constexpr int LDS_BYTES = 147456;

#define LAS __attribute__((address_space(3)))
typedef unsigned short bfu;
typedef unsigned v4u __attribute__((ext_vector_type(4)));
typedef unsigned v2u __attribute__((ext_vector_type(2)));
typedef float f32x4 __attribute__((ext_vector_type(4)));
typedef short bf16x8 __attribute__((ext_vector_type(8)));
#define MFMA16(a, b, c) __builtin_amdgcn_mfma_f32_16x16x32_bf16(a, b, c, 0, 0, 0)
#define LDS_WAIT() asm volatile("s_waitcnt lgkmcnt(0)" ::: "memory")
__device__ __forceinline__ unsigned f2bf(float f) { unsigned u = __builtin_bit_cast(unsigned, f); return (u + 0x7fffu + ((u >> 16) & 1u)) >> 16; }
__device__ __forceinline__ unsigned pk2(float lo, float hi) { return f2bf(lo) | (f2bf(hi) << 16); }
__device__ __forceinline__ float bf2f(unsigned b) { return __builtin_bit_cast(float, b << 16); }
__device__ __forceinline__ int mk_lane() { return (int)(__builtin_amdgcn_mbcnt_hi(~0u, __builtin_amdgcn_mbcnt_lo(~0u, 0u)) & 63u); }
__device__ __forceinline__ float wave_sum(float v) {
#pragma unroll
    for (int o = 1; o < 64; o <<= 1) v += __shfl_xor(v, o);
    return v;
}
__device__ __forceinline__ float silu(float x) { return x / (1.0f + __expf(-x)); }

__device__ __forceinline__ void cvt_item(const float* __restrict__ W, int ldw, int ncols, const float* __restrict__ gain, bfu* WT, int K, int dst_row0, int k0, int n0, LAS float* scr, int lane) {
    const int nq = (lane & 15) * 4, kr = lane >> 4, n = n0 + nq;
#pragma unroll 8
    for (int i = 0; i < 16; ++i) { const int kk = 4 * i + kr; f32x4 v = (f32x4){0.f, 0.f, 0.f, 0.f};
        if (n < ncols) v = *(const f32x4*)(W + (size_t)(k0 + kk) * ldw + n);
        if (gain) v = v * gain[k0 + kk];
        LAS float* d = scr + kk * 65 + nq; d[0] = v[0]; d[1] = v[1]; d[2] = v[2]; d[3] = v[3]; }
    LDS_WAIT(); asm volatile("" ::: "memory");
    const int c = lane & 7;
#pragma unroll
    for (int j = 0; j < 8; ++j) { const int nn = (lane >> 3) + 8 * j; const LAS float* s = scr + (8 * c) * 65 + nn;
        v4u o; o.x = pk2(s[0 * 65], s[1 * 65]); o.y = pk2(s[2 * 65], s[3 * 65]); o.z = pk2(s[4 * 65], s[5 * 65]); o.w = pk2(s[6 * 65], s[7 * 65]);
        *(v4u*)(WT + (size_t)(dst_row0 + nn) * K + k0 + 8 * c) = o; }
    LDS_WAIT(); asm volatile("" ::: "memory");
}
__device__ __forceinline__ void cvt_ffn_item(int it, const float* wg, const float* wu, const float* wd, const float* gain, bfu* Wgu, bfu* Wd, LAS float* scr, int lane) {
    if (it < 2 * 2816) { const int up = it >= 2816; const int r = up ? it - 2816 : it; const int kb = r / 88, nb = r % 88, n0 = nb * 64;
        cvt_item(up ? wu : wg, FF, FF, gain, Wgu, DM, 256 * (n0 >> 7) + (n0 & 127) + (up ? 128 : 0), kb * 64, n0, scr, lane); }
    else { const int r = it - 2 * 2816; const int kb = r / 32, nb = r % 32; cvt_item(wd, DM, DM, nullptr, Wd, FF, nb * 64, kb * 64, nb * 64, scr, lane); }
}

constexpr int GWP = 4112;
__device__ __forceinline__ void gates_rows(LAS unsigned char* lds, const bfu* __restrict__ XB, const float* __restrict__ rowss, const float* __restrict__ b_i, const float* __restrict__ b_f, float* GATES, int rb, int wave, int lane) {
    const int fr = lane & 15, fq = lane >> 4, rg = wave & 3, kh = wave >> 2;
    const LAS unsigned char* wl = lds + 16384;
    const bfu* xp = XB + (size_t)(rb * 64 + rg * 16 + fr) * DM + kh * 1024 + 8 * fq;
    f32x4 acc = (f32x4){0.f, 0.f, 0.f, 0.f};
    for (int k0 = 0; k0 < 32; k0 += 16) {
        bf16x8 xa[16];
#pragma unroll
        for (int ks = 0; ks < 16; ++ks) xa[ks] = *(const bf16x8*)(xp + (k0 + ks) * 32);
#pragma unroll
        for (int ks = 0; ks < 16; ++ks) { const bf16x8 wb = *(const LAS bf16x8*)(wl + fr * GWP + (kh * 1024 + (k0 + ks) * 32 + 8 * fq) * 2); acc = MFMA16(xa[ks], wb, acc); }
    }
    LAS f32x4* red = (LAS f32x4*)lds;
    if (kh == 1) red[rg * 64 + lane] = acc;
    __syncthreads();
    if (kh == 0 && fr < 8) {
        const f32x4 o = red[rg * 64 + lane]; const float bias = fr < 4 ? b_i[fr] : b_f[fr - 4];
#pragma unroll
        for (int j = 0; j < 4; ++j) { const int row = rb * 64 + rg * 16 + 4 * fq + j;
            const float pre = (acc[j] + o[j]) / sqrtf(rowss[row] * (1.0f / DM) + 1e-6f) + bias; const float capped = 15.0f * tanhf(pre * (1.0f / 15.0f));
            GATES[(size_t)row * 8 + fr] = fr < 4 ? capped : -log1pf(expf(-capped)); }
    }
    __syncthreads();
}

#define XB_TMO      128
#define XB_XCNT(j)  (256  + 64 * (j))
#define XB_XSUB(j)  (1280 + 64 * (j))
#define XB_XGEN(j)  (2304 + 64 * (j))
#define XB_TOP      3328
#define XB_TOPGEN   3392
#define XCD_BAR_WORDS 3456
#define XB_SPIN_CAP (1u << 18)
__device__ __forceinline__ unsigned xb_ld(unsigned* p)              { return __hip_atomic_load(p, __ATOMIC_RELAXED, __HIP_MEMORY_SCOPE_AGENT); }
__device__ __forceinline__ unsigned xb_add(unsigned* p, unsigned v) { return __hip_atomic_fetch_add(p, v, __ATOMIC_RELAXED, __HIP_MEMORY_SCOPE_AGENT); }
__device__ __forceinline__ unsigned xb_xcc_id() { return (unsigned)__builtin_amdgcn_s_getreg((3 << 11) | 20) & 0xFu; }
#define XB_SPIN(cond, bar) do { unsigned _sp = 0; while (cond) { __builtin_amdgcn_s_sleep(1); \
    if ((++_sp & 255u) == 0u) { if (xb_ld(&(bar)[XB_TMO])) break; if (_sp > XB_SPIN_CAP) { atomicAdd(&(bar)[XB_TMO], 1u); break; } } } } while (0)
__device__ __forceinline__ void xcd_barrier_complete(unsigned* bar, unsigned x, unsigned& nloc, unsigned& nx) {
    const unsigned G = gridDim.x * gridDim.y * gridDim.z;
    unsigned sum, cnt, mine, sp = 0u;
    for (;;) {
        sum = 0u; cnt = 0u; mine = 0u;
#pragma unroll
        for (unsigned j = 0; j < 16; ++j) { const unsigned c = xb_ld(&bar[XB_XCNT(j)]); sum += c; cnt += (c > 0u) ? 1u : 0u; mine = (j == x) ? c : mine; }
        if (sum == G) break;
        __builtin_amdgcn_s_sleep(1);
        if ((++sp & 255u) == 0u) { if (xb_ld(&bar[XB_TMO])) break; if (sp > XB_SPIN_CAP) { atomicAdd(&bar[XB_TMO], 1u); break; } }
    }
    nloc = mine > 0u ? mine : 1u; nx = cnt > 0u ? cnt : 1u;
}
__device__ __forceinline__ void xcd_barrier(unsigned* bar, volatile LAS unsigned* st, const bool first) {
    asm volatile("s_waitcnt vmcnt(0)" ::: "memory");
    __syncthreads();
    if (first) {
        const unsigned x = xb_xcc_id();
        __builtin_amdgcn_s_waitcnt(0);
        unsigned nloc = st[0], nx = st[1];
        if (nloc == 0u) { xcd_barrier_complete(bar, x, nloc, nx); st[0] = nloc; st[1] = nx; }
        const unsigned old = xb_add(&bar[XB_XSUB(x)], 1u);
        const unsigned gen = old / nloc;
        if (old + 1u == (gen + 1u) * nloc) {
            __builtin_amdgcn_fence(__ATOMIC_RELEASE, "agent");
            asm volatile("s_waitcnt vmcnt(0)" ::: "memory");
            const unsigned og = xb_add(&bar[XB_TOP], 1u);
            const unsigned tg = og / nx;
            if (og + 1u == (tg + 1u) * nx) xb_add(&bar[XB_TOPGEN], 1u);
            else XB_SPIN(xb_ld(&bar[XB_TOPGEN]) == tg, bar);
            __builtin_amdgcn_fence(__ATOMIC_ACQUIRE, "agent");
            xb_add(&bar[XB_XGEN(x)], 1u);
            asm volatile("s_waitcnt vmcnt(0)" ::: "memory");
        } else {
            XB_SPIN(xb_ld(&bar[XB_XGEN(x)]) == gen, bar);
            __builtin_amdgcn_fence(__ATOMIC_ACQUIRE, "agent");
            asm volatile("s_waitcnt vmcnt(0)" ::: "memory");
        }
    }
    __syncthreads();
}

struct Args { const float* in[23]; float* out; unsigned char* ws; int ph_lo, ph_hi; };
constexpr int NPH = 12;

constexpr int MP = 272;

__device__ __forceinline__ void mlstm_stage_a(LAS unsigned char* lds, const bfu* __restrict__ PROJ, const float* __restrict__ GATES, const float* __restrict__ conv_w, const float* __restrict__ conv_b,
                                              bfu* QC, bfu* KC, float* DELTA, float* DN, float* SC, int item, const int mk_wave) {
    int lane = mk_lane(); asm volatile("" : "+v"(lane));
    const int wid = mk_wave & 7, tid = wid * 64 + lane, fr = lane & 15, fq = lane >> 4;
    const int h = item & 3, row0 = (item >> 2) * 128;
    LAS float* fa = (LAS float*)lds; LAS unsigned char* KT = lds + 4096; LAS unsigned char* VT = KT + 128 * MP;
    if (tid < 128) { fa[tid] = GATES[(size_t)(row0 + tid) * 8 + 4 + h]; fa[128 + tid] = GATES[(size_t)(row0 + tid) * 8 + h]; }
    __syncthreads();
    if (tid < 128) { float b = 0.f; for (int s = 0; s <= tid; ++s) b += fa[s]; fa[256 + tid] = fa[128 + tid] - b; if (tid == 127) fa[385] = b; }
    __syncthreads();
    if (wid == 0) { float a = fmaxf(fa[256 + lane], fa[320 + lane]);
#pragma unroll
        for (int o = 1; o < 64; o <<= 1) a = fmaxf(a, __shfl_xor(a, o));
        if (lane == 0) fa[384] = a; }
    __syncthreads();
    const float amax = fa[384], blast = fa[385];
    if (tid < 128) fa[tid] = __expf(fa[256 + tid] - amax);
    if (tid == 0) { SC[item] = blast + amax; SC[512 + item] = blast; }
    __syncthreads();
    for (int task = tid; task < 4096; task += NTHR) {
        const int isk = task >> 11, t2 = task & 2047, d = t2 & 127, s0 = (t2 >> 7) * 8, ch = isk * 512 + h * 128 + d;
        const float w0 = conv_w[ch], w1 = conv_w[1024 + ch], w2 = conv_w[2048 + ch], w3 = conv_w[3072 + ch], bias = conv_b[ch];
        float x[11];
#pragma unroll
        for (int i = 0; i < 11; ++i) { const int r = row0 + s0 - 3 + i; x[i] = r >= 0 ? bf2f(PROJ[(size_t)r * PLD + C_MQ + ch]) : 0.f; }
        float y[8];
#pragma unroll
        for (int i = 0; i < 8; ++i) y[i] = silu(bias + w0 * x[i] + w1 * x[i + 1] + w2 * x[i + 2] + w3 * x[i + 3]);
        if (!isk) {
#pragma unroll
            for (int i = 0; i < 8; ++i) QC[(size_t)(row0 + s0 + i) * 512 + h * 128 + d] = (bfu)f2bf(y[i] * 0.08838834764831845f);
        } else {
#pragma unroll
            for (int i = 0; i < 8; ++i) { KC[(size_t)(row0 + s0 + i) * 512 + h * 128 + d] = (bfu)f2bf(y[i]); y[i] *= fa[s0 + i]; }
            v4u o; o.x = pk2(y[0], y[1]); o.y = pk2(y[2], y[3]); o.z = pk2(y[4], y[5]); o.w = pk2(y[6], y[7]);
            *(LAS v4u*)(KT + d * MP + s0 * 2) = o;
        }
    }
    for (int task = tid; task < 4096; task += NTHR) {
        const int sidx = task & 127, e0 = (task >> 7) * 8;
        const v4u v = *(const v4u*)(PROJ + (size_t)(row0 + sidx) * PLD + C_MV + h * 256 + e0);
        LAS unsigned short* d = (LAS unsigned short*)(VT + e0 * MP + sidx * 2);
        d[0 * (MP / 2)] = (unsigned short)(v.x & 0xffffu); d[1 * (MP / 2)] = (unsigned short)(v.x >> 16); d[2 * (MP / 2)] = (unsigned short)(v.y & 0xffffu); d[3 * (MP / 2)] = (unsigned short)(v.y >> 16);
        d[4 * (MP / 2)] = (unsigned short)(v.z & 0xffffu); d[5 * (MP / 2)] = (unsigned short)(v.z >> 16); d[6 * (MP / 2)] = (unsigned short)(v.w & 0xffffu); d[7 * (MP / 2)] = (unsigned short)(v.w >> 16);
    }
    __syncthreads();
    f32x4 acc[2][8];
#pragma unroll
    for (int mt = 0; mt < 2; ++mt)
#pragma unroll
        for (int nt = 0; nt < 8; ++nt) acc[mt][nt] = (f32x4){0.f, 0.f, 0.f, 0.f};
#pragma unroll
    for (int ks = 0; ks < 4; ++ks) {
        bf16x8 a[2];
#pragma unroll
        for (int mt = 0; mt < 2; ++mt) a[mt] = *(const LAS bf16x8*)(VT + (32 * wid + 16 * mt + fr) * MP + (32 * ks + 8 * fq) * 2);
#pragma unroll
        for (int nt = 0; nt < 8; ++nt) { const bf16x8 b = *(const LAS bf16x8*)(KT + (16 * nt + fr) * MP + (32 * ks + 8 * fq) * 2);
            acc[0][nt] = MFMA16(a[0], b, acc[0][nt]); acc[1][nt] = MFMA16(a[1], b, acc[1][nt]); }
    }
    float* dst = DELTA + (size_t)item * 32768;
#pragma unroll
    for (int mt = 0; mt < 2; ++mt)
#pragma unroll
        for (int nt = 0; nt < 8; ++nt)
#pragma unroll
            for (int j = 0; j < 4; ++j) dst[(32 * wid + 16 * mt + 4 * fq + j) * 128 + 16 * nt + fr] = acc[mt][nt][j];
    if (tid < 128) { float s = 0.f; for (int i = 0; i < 128; ++i) s += bf2f(*(const LAS unsigned short*)(KT + tid * MP + i * 2)); DN[(size_t)item * 128 + tid] = s; }
    __syncthreads();
}

__device__ __forceinline__ void mlstm_scan(LAS unsigned char* lds, const float* __restrict__ DELTA, const float* __restrict__ DN, const float* __restrict__ SC, float* MPREV, bfu* __restrict__ CT, float* __restrict__ NST,
                                           int tid, int gtid, int nthreads) {
    LAS float* fdec = (LAS float*)lds; LAS float* fin = fdec + 512; LAS float* mpv = fdec + 1024;
    if (tid < 4) { float m = 0.f;
        for (int c = 0; c < 128; ++c) { const int item = c * 4 + tid; const float mloc = SC[item], bl = SC[512 + item], mn = fmaxf(bl + m, mloc);
            mpv[tid * 128 + c] = m; fdec[tid * 128 + c] = __expf(bl + m - mn); fin[tid * 128 + c] = __expf(mloc - mn); m = mn; } }
    __syncthreads();
    for (int idx = gtid; idx < 4 * 32768 + 512; idx += nthreads) {
        const bool main_ = idx < 4 * 32768;
        const int h = main_ ? (idx >> 15) : ((idx - 4 * 32768) >> 7), rem = main_ ? (idx & 32767) : ((idx - 4 * 32768) & 127);
        const float* src = main_ ? DELTA + (size_t)h * 32768 + rem : DN + h * 128 + rem; const size_t sstride = main_ ? 4 * 32768 : 512;
        float C = 0.f; float d8[8], e8[8];
#pragma unroll
        for (int i = 0; i < 8; ++i) d8[i] = src[(size_t)i * sstride];
        for (int c0 = 0; c0 < 128; c0 += 8) {
            if (c0 + 8 < 128) {
#pragma unroll
                for (int i = 0; i < 8; ++i) e8[i] = src[(size_t)(c0 + 8 + i) * sstride];
            }
#pragma unroll
            for (int i = 0; i < 8; ++i) { const int c = c0 + i, item = c * 4 + h;
                if (main_) { CT[(size_t)item * 32768 + rem] = (bfu)f2bf(C); if (rem == 0) MPREV[item] = mpv[h * 128 + c]; } else NST[(size_t)item * 128 + rem] = C;
                C = fdec[h * 128 + c] * C + fin[h * 128 + c] * d8[i]; }
#pragma unroll
            for (int i = 0; i < 8; ++i) d8[i] = e8[i];
        }
    }
    __syncthreads();
}

__device__ __forceinline__ void mlstm_stage_c(LAS unsigned char* lds, const bfu* __restrict__ PROJ, const float* __restrict__ GATES, const bfu* __restrict__ QC, const bfu* __restrict__ KC,
                                              const bfu* __restrict__ CT, const float* __restrict__ NST, const float* __restrict__ MPREV, const float* __restrict__ hgain, bfu* Y, int item, const int mk_wave) {
    int lane = mk_lane(); asm volatile("" : "+v"(lane));
    const int wid = mk_wave & 7, tid = wid * 64 + lane, fr = lane & 15, fq = lane >> 4;
    const int h = item & 3, row0 = (item >> 2) * 128;
    LAS float* fa = (LAS float*)lds;
    LAS unsigned char* Qs = lds + 4096; LAS unsigned char* Ks = Qs + 128 * MP; LAS unsigned char* BUF = Ks + 128 * MP;
    if (tid < 128) { fa[768 + tid] = GATES[(size_t)(row0 + tid) * 8 + 4 + h]; fa[896 + tid] = GATES[(size_t)(row0 + tid) * 8 + h]; fa[640 + tid] = NST[(size_t)item * 128 + tid]; }
    __syncthreads();
    float bt_ = 0.f;
    if (tid < 128) { for (int s = 0; s <= tid; ++s) bt_ += fa[768 + s]; fa[tid] = fa[896 + tid] - bt_; }
    __syncthreads();
    if (tid < 128) { const float mp = MPREV[item]; float pm = -3.0e38f; for (int s = 0; s <= tid; ++s) pm = fmaxf(pm, fa[s]);
        const float M = fmaxf(mp, pm); fa[128 + tid] = M; fa[256 + tid] = __expf(mp - M); fa[384 + tid] = __expf(-(bt_ + M)); }
    for (int t = tid; t < 2048; t += NTHR) { const int r = t >> 4, c = t & 15;
        *(LAS v4u*)(Qs + r * MP + c * 16) = *(const v4u*)(QC + (size_t)(row0 + r) * 512 + h * 128 + c * 8);
        *(LAS v4u*)(Ks + r * MP + c * 16) = *(const v4u*)(KC + (size_t)(row0 + r) * 512 + h * 128 + c * 8); }
    for (int t = tid; t < 4096; t += NTHR) { const int r = t >> 4, c = t & 15; *(LAS v4u*)(BUF + r * MP + c * 16) = *(const v4u*)(CT + (size_t)item * 32768 + r * 128 + c * 8); }
    __syncthreads();
    {
        const int t = 16 * wid + fr; float s = 0.f;
#pragma unroll
        for (int i = 0; i < 32; ++i) s += bf2f(*(const LAS unsigned short*)(Qs + t * MP + (32 * fq + i) * 2)) * fa[640 + 32 * fq + i];
        s += __shfl_xor(s, 16); s += __shfl_xor(s, 32); if (fq == 0) fa[512 + t] = s;
    }
    f32x4 sa[8];
#pragma unroll
    for (int nt = 0; nt < 8; ++nt) sa[nt] = (f32x4){0.f, 0.f, 0.f, 0.f};
    bf16x8 qa[4];
#pragma unroll
    for (int ks = 0; ks < 4; ++ks) qa[ks] = *(const LAS bf16x8*)(Qs + (16 * wid + fr) * MP + (32 * ks + 8 * fq) * 2);
#pragma unroll
    for (int nt = 0; nt < 8; ++nt) if (nt <= wid) {
#pragma unroll
        for (int ks = 0; ks < 4; ++ks) { const bf16x8 b = *(const LAS bf16x8*)(Ks + (16 * nt + fr) * MP + (32 * ks + 8 * fq) * 2); sa[nt] = MFMA16(qa[ks], b, sa[nt]); } }
    float Mt[4], rsum[4];
#pragma unroll
    for (int j = 0; j < 4; ++j) { Mt[j] = fa[128 + 16 * wid + 4 * fq + j]; rsum[j] = 0.f; }
#pragma unroll
    for (int nt = 0; nt < 8; ++nt) { const int s = 16 * nt + fr; const float as = fa[s];
#pragma unroll
        for (int j = 0; j < 4; ++j) { const int t = 16 * wid + 4 * fq + j; const float p = (s <= t) ? sa[nt][j] * __expf(as - Mt[j]) : 0.f; sa[nt][j] = p; rsum[j] += p; } }
#pragma unroll
    for (int j = 0; j < 4; ++j) { float v = rsum[j]; v += __shfl_xor(v, 1); v += __shfl_xor(v, 2); v += __shfl_xor(v, 4); v += __shfl_xor(v, 8); rsum[j] = v; }
    f32x4 num[16];
#pragma unroll
    for (int nt = 0; nt < 16; ++nt) num[nt] = (f32x4){0.f, 0.f, 0.f, 0.f};
#pragma unroll
    for (int ks = 0; ks < 4; ++ks)
#pragma unroll
        for (int nt = 0; nt < 16; ++nt) { const bf16x8 b = *(const LAS bf16x8*)(BUF + (16 * nt + fr) * MP + (32 * ks + 8 * fq) * 2); num[nt] = MFMA16(qa[ks], b, num[nt]); if ((nt & 3) == 3) __builtin_amdgcn_sched_barrier(0); }
    float g4[4], den[4];
#pragma unroll
    for (int j = 0; j < 4; ++j) { const int t = 16 * wid + 4 * fq + j; g4[j] = fa[256 + t]; den[j] = fmaxf(fabsf(g4[j] * fa[512 + t] + rsum[j]), fa[384 + t]); }
#pragma unroll
    for (int nt = 0; nt < 16; ++nt)
#pragma unroll
        for (int j = 0; j < 4; ++j) num[nt][j] *= g4[j];
    __syncthreads();
#pragma unroll
    for (int nt = 0; nt < 8; ++nt)
#pragma unroll
        for (int j = 0; j < 4; ++j) *(LAS unsigned short*)(Ks + (16 * wid + 4 * fq + j) * MP + (16 * nt + fr) * 2) = (unsigned short)f2bf(sa[nt][j]);
    for (int task = tid; task < 4096; task += NTHR) {
        const int sidx = task & 127, e0 = (task >> 7) * 8;
        const v4u v = *(const v4u*)(PROJ + (size_t)(row0 + sidx) * PLD + C_MV + h * 256 + e0);
        LAS unsigned short* d = (LAS unsigned short*)(BUF + e0 * MP + sidx * 2);
        d[0 * (MP / 2)] = (unsigned short)(v.x & 0xffffu); d[1 * (MP / 2)] = (unsigned short)(v.x >> 16); d[2 * (MP / 2)] = (unsigned short)(v.y & 0xffffu); d[3 * (MP / 2)] = (unsigned short)(v.y >> 16);
        d[4 * (MP / 2)] = (unsigned short)(v.z & 0xffffu); d[5 * (MP / 2)] = (unsigned short)(v.z >> 16); d[6 * (MP / 2)] = (unsigned short)(v.w & 0xffffu); d[7 * (MP / 2)] = (unsigned short)(v.w >> 16);
    }
    __syncthreads();
#pragma unroll
    for (int ks = 0; ks < 4; ++ks) { const bf16x8 pa = *(const LAS bf16x8*)(Ks + (16 * wid + fr) * MP + (32 * ks + 8 * fq) * 2);
#pragma unroll
        for (int nt = 0; nt < 16; ++nt) { const bf16x8 b = *(const LAS bf16x8*)(BUF + (16 * nt + fr) * MP + (32 * ks + 8 * fq) * 2); num[nt] = MFMA16(pa, b, num[nt]); if ((nt & 3) == 3) __builtin_amdgcn_sched_barrier(0); } }
    float ssq[4];
#pragma unroll
    for (int j = 0; j < 4; ++j) { const float rd = 1.0f / den[j]; float s = 0.f;
#pragma unroll
        for (int nt = 0; nt < 16; ++nt) { const float v = num[nt][j] * rd; num[nt][j] = v; s += v * v; }
        s += __shfl_xor(s, 1); s += __shfl_xor(s, 2); s += __shfl_xor(s, 4); s += __shfl_xor(s, 8); ssq[j] = 1.0f / sqrtf(s * (1.0f / 256.0f) + 1e-6f); }
    __syncthreads();
    LAS float* HS = (LAS float*)(lds + 4096);
#pragma unroll
    for (int nt = 0; nt < 16; ++nt)
#pragma unroll
        for (int j = 0; j < 4; ++j) HS[(16 * wid + 4 * fq + j) * 260 + 16 * nt + fr] = num[nt][j] * ssq[j];
    __syncthreads();
    for (int task = tid; task < 4096; task += NTHR) {
        const int r = task >> 5, c8 = (task & 31) * 8; const size_t row = (size_t)(row0 + r);
        const f32x4 h0 = *(const LAS f32x4*)(HS + r * 260 + c8), h1 = *(const LAS f32x4*)(HS + r * 260 + c8 + 4);
        const f32x4 g0 = *(const f32x4*)(hgain + h * 256 + c8), g1 = *(const f32x4*)(hgain + h * 256 + c8 + 4);
        const v4u mo = *(const v4u*)(PROJ + row * PLD + C_MO + h * 256 + c8);
        v4u o;
        o.x = pk2(h0[0] * g0[0] / (1.0f + __expf(-bf2f(mo.x & 0xffffu))), h0[1] * g0[1] / (1.0f + __expf(-bf2f(mo.x >> 16))));
        o.y = pk2(h0[2] * g0[2] / (1.0f + __expf(-bf2f(mo.y & 0xffffu))), h0[3] * g0[3] / (1.0f + __expf(-bf2f(mo.y >> 16))));
        o.z = pk2(h1[0] * g1[0] / (1.0f + __expf(-bf2f(mo.z & 0xffffu))), h1[1] * g1[1] / (1.0f + __expf(-bf2f(mo.z >> 16))));
        o.w = pk2(h1[2] * g1[2] / (1.0f + __expf(-bf2f(mo.w & 0xffffu))), h1[3] * g1[3] / (1.0f + __expf(-bf2f(mo.w >> 16))));
        *(v4u*)(Y + row * DM + 1024 + h * 256 + c8) = o;
    }
    __syncthreads();
}

__device__ __forceinline__ att::BlockRef<att::bf16, att::bf16> att_ref(int i, int pass, const bfu* PROJ, bfu* OATT) {
    int ph, x;
    if (gridDim.x == 256) { ph = ((i >> 8) & 1) * 8 + (blockIdx.x & 7); x = blockIdx.x >> 3; }
    else { ph = (i >> 5) & 15; x = i & 31; }
    const int qb = pass ? 63 - x : x, h = ph >> 2, c = (ph >> 1) & 1, vh = ph & 1;
    att::BlockRef<att::bf16, att::bf16> r;
    constexpr size_t MSZ = (size_t)16384 * 128;
    r.Q = (const att::bf16*)(PROJ + (size_t)(2 * h + c) * MSZ + (size_t)qb * 256 * 128);
    r.K = (const att::bf16*)(PROJ + (size_t)(8 + 2 * h + c) * MSZ);
    r.V = (const att::bf16*)(PROJ + (size_t)(16 + 2 * h + vh) * MSZ);
    r.O = (att::bf16*)(OATT + (size_t)qb * 256 * 2048 + h * 512 + c * 256 + vh * 128);
    r.P0 = qb * 256;
    return r;
}
__device__ __forceinline__ void attn_phase(char* lds, const bfu* PROJ, bfu* OATT, const int TOTAL, const int mk_wave) {
    using namespace att;
    int i = blockIdx.x; if (i >= TOTAL) return;
    int pass = 0;
    BlockRef<bf16, bf16> cur = att_ref(i, 0, PROJ, OATT);
    Seam<bf16> S;
    causal_swa_prime<bf16, bf16>(cur, S_, lds, S, mk_wave);
    for (;;) {
        const bool more_pass = pass == 0, more_item = i + (int)gridDim.x < TOTAL, last = !more_pass && !more_item;
        int in_ = i, passn = pass + 1;
        if (!more_pass) { passn = 0; in_ = more_item ? i + (int)gridDim.x : i; }
        const BlockRef<bf16, bf16> nxt = last ? cur : att_ref(in_, passn, PROJ, OATT);
        causal_swa_block<bf16, bf16>(cur, nxt, S_, S_, lds, S, mk_wave);
        if (last) break;
        cur = nxt; i = in_; pass = passn;
    }
}

#ifndef ATTN2
#define ATTN2 5
#endif
__device__ __forceinline__ att::A2Ref att2_ref(int i, int pass, const bfu* PROJ, bfu* OATT) {
    int hc, x;
    if (gridDim.x == 256) { hc = blockIdx.x & 7; x = ((i >> 8) & 1) * 32 + (blockIdx.x >> 3); }
    else { hc = (i >> 6) & 7; x = i & 63; }
    const int qb = pass ? x : 127 - x, h = hc >> 1, c = hc & 1;
    constexpr size_t MSZ = (size_t)16384 * 128;
    att::A2Ref r;
    r.Q = (const att::bf16*)(PROJ + (size_t)(2 * h + c) * MSZ + (size_t)qb * 128 * 128);
    r.K = (const att::bf16*)(PROJ + (size_t)(8 + 2 * h + c) * MSZ);
    r.V0 = (const att::bf16*)(PROJ + (size_t)(16 + 2 * h) * MSZ); r.V1 = (const att::bf16*)(PROJ + (size_t)(16 + 2 * h + 1) * MSZ);
    r.O = (att::bf16*)(OATT + (size_t)qb * 128 * 2048 + h * 512 + c * 256);
    r.P0 = qb * 128;
    return r;
}
__device__ __forceinline__ void attn2_phase(char* lds, const bfu* PROJ, bfu* OATT, const int TOTAL, const int mk_wave) {
    for (int i = blockIdx.x; i < TOTAL; i += gridDim.x)
        for (int pass = 0; pass < 2; ++pass) { const att::A2Ref r = att2_ref(i, pass, PROJ, OATT); att::attn9_block(r, lds, (__attribute__((address_space(3))) unsigned char*)lds, mk_wave); }
}

__global__ void __launch_bounds__(NTHR, 2) mega_fwd(Args args) {
    extern __shared__ __attribute__((aligned(16))) unsigned char lds_raw[];
    LAS unsigned char* lds = (LAS unsigned char*)lds_raw;
    const int wave = __builtin_amdgcn_readfirstlane((int)threadIdx.x >> 6);
    const int G = gridDim.x, gw = blockIdx.x * NWAVES + wave, NGW = G * NWAVES;
#define AS4 __attribute__((address_space(4)))
#define PH_BEGIN int koff_ = 0; asm volatile("" : "+s"(koff_)); const AS4 char* kp_ = (const AS4 char*)__builtin_amdgcn_kernarg_segment_ptr() + koff_; \
    unsigned char* ws = *(unsigned char* const AS4*)(kp_ + 192); float* out = *(float* const AS4*)(kp_ + 184); (void)out; (void)ws; const int lane = mk_lane(), tid = wave * 64 + lane; (void)tid; (void)lane;
#define KIN(i) (*(const float* const AS4*)(kp_ + 8 * (i)))
#define Wgu ((bfu*)(ws + WS_WGU))
#define Wd ((bfu*)(ws + WS_WD))
#define Win ((bfu*)(ws + WS_WIN))
#define Wout ((bfu*)(ws + WS_WOUT))
#define XN ((bfu*)(ws + WS_XN))
#define BIG ((bfu*)(ws + WS_BIG))
#define Y ((bfu*)(ws + WS_Y))
#define CT ((bfu*)(ws + WS_CT))
#define QC ((bfu*)(ws + WS_QC))
#define KC ((bfu*)(ws + WS_KC))
#define NST ((float*)(ws + WS_NST))
#define rowss1 ((float*)(ws + WS_ROWSS1))
#define rowss2 ((float*)(ws + WS_ROWSS2))
#define SC ((float*)(ws + WS_SC))
#define DN ((float*)(ws + WS_DN))
#define GATES ((float*)(ws + WS_GATES))
#define DELTA ((float*)(ws + WS_XN))
#define OATT ((bfu*)(ws + WS_XN))
#define PROJM (BIG + (size_t)24 * 16384 * 128)
    const int lo = args.ph_lo, hi = args.ph_hi;
    if (lo < 0) cg::this_grid().sync();
    if (hi - lo > 1) {
        if (wave == 0 && mk_lane() == 0) { volatile LAS unsigned* st = (volatile LAS unsigned*)(lds + LDS_BYTES - 64); st[0] = 0u; st[1] = 0u;
            (void)xb_add(&((unsigned*)(args.ws + WS_BAR))[XB_XCNT(xb_xcc_id())], 1u); }
        __syncthreads();
    }
#ifndef PHMASK
#define PHMASK 0xfff
#endif
#define IN(k) (((PHMASK >> (k)) & 1) && lo <= (k) && (k) < hi)
#ifndef PROBE_MASK
#define PROBE_MASK 0
#endif
#define NREP(k) (((PROBE_MASK >> (k)) & 1) ? 2 : 1)
#define STAGGER_DELAY(N) do { const int sn_ = (int)((blockIdx.x >> 3) & 3) * (N); for (int sd_ = 0; sd_ < sn_; ++sd_) __builtin_amdgcn_s_sleep(85); } while (0)
#define SYNC(k) do { if (IN(k) && IN((k) + 1)) { \
        { int kb_ = 0; asm volatile("" : "+s"(kb_)); unsigned char* wsb_ = *(unsigned char* const AS4*)((const AS4 char*)__builtin_amdgcn_kernarg_segment_ptr() + kb_ + 192); \
               xcd_barrier((unsigned*)(wsb_ + WS_BAR), (volatile LAS unsigned*)(lds + LDS_BYTES - 64), wave == 0 && mk_lane() == 0); \
               if ((PROBE_MASK >> 14) & 1) xcd_barrier((unsigned*)(wsb_ + WS_BAR), (volatile LAS unsigned*)(lds + LDS_BYTES - 64), wave == 0 && mk_lane() == 0); } } } while (0)

    if (IN(0)) for (int rep_ = 0; rep_ < NREP(0); ++rep_) { PH_BEGIN
        const float* x = KIN(0);
        LAS float* scr = (LAS float*)(lds + wave * 16640);
        constexpr int I_FFN = 3 * 2816, I_IN = 32 * 96, I_OUT = 32 * 32;
        for (int it = gw; it < I_FFN + I_IN + I_OUT; it += NGW) {
            if (it < I_FFN) cvt_ffn_item(it, KIN(2), KIN(3), KIN(4), KIN(1), Wgu, Wd, scr, lane);
            else if (it < I_FFN + I_IN) { const int r = it - I_FFN, kb = r / 96, nb = r % 96; cvt_item(KIN(6), NIN, NIN, KIN(5), Win, DM, nb * 64, kb * 64, nb * 64, scr, lane); }
            else { const int r = it - I_FFN - I_IN, kb = r / 32, nb = r % 32; cvt_item(KIN(17), DM, DM, nullptr, Wout, DM, nb * 64, kb * 64, nb * 64, scr, lane); }
        }
        for (int m = gw; m < S_; m += NGW) {
            const f32x4* xr = (const f32x4*)(x + (size_t)m * DM) + lane; f32x4 v[8]; float s = 0.f;
#pragma unroll
            for (int j = 0; j < 8; ++j) { v[j] = xr[64 * j]; s += (v[j][0] * v[j][0] + v[j][1] * v[j][1]) + (v[j][2] * v[j][2] + v[j][3] * v[j][3]); }
            const float rs = 1.0f / sqrtf(wave_sum(s) * (1.0f / DM) + 1e-6f);
            v2u* o8 = (v2u*)(XN + (size_t)m * DM) + lane;
#pragma unroll
            for (int j = 0; j < 8; ++j) { v2u w; w.x = pk2(v[j][0] * rs, v[j][1] * rs); w.y = pk2(v[j][2] * rs, v[j][3] * rs); o8[64 * j] = w; }
        }
        for (int i = blockIdx.x * NTHR + tid; i < 2 * S_; i += G * NTHR) rowss1[i] = 0.f;
        for (int k = blockIdx.x * NTHR + tid; k < DM + 8; k += G * NTHR) {
            unsigned char* gwp = ws + WS_GW; f32x4 w0 = (f32x4){0.f, 0.f, 0.f, 0.f}, w1 = w0;
            if (k < DM) { const float gk = KIN(5)[k]; w0 = *(const f32x4*)(KIN(6) + (size_t)k * NIN + 6144) * gk; w1 = *(const f32x4*)(KIN(6) + (size_t)k * NIN + 6148) * gk; }
#pragma unroll
            for (int j = 0; j < 4; ++j) { *(unsigned short*)(gwp + j * GWP + k * 2) = (unsigned short)f2bf(w0[j]); *(unsigned short*)(gwp + (4 + j) * GWP + k * 2) = (unsigned short)f2bf(w1[j]);
                *(unsigned short*)(gwp + (8 + j) * GWP + k * 2) = 0; *(unsigned short*)(gwp + (12 + j) * GWP + k * 2) = 0; }
        }
    }
    SYNC(0);
    if (IN(1)) { PH_BEGIN
        pg8::Gemm g{XN, Wgu, S_, 2 * FF, DM}; pg8::StaticOrder So; So.init(S_, 2 * FF, G, (int)blockIdx.x);
        pg8::EpiSwiGLU E{BIG, FF, nullptr, 0.f};
        STAGGER_DELAY(1); for (int rep_ = 0; rep_ < NREP(1); ++rep_) pg8::gemm_phase<pg8::EpiSwiGLU, pg8::StaticOrder, true, true>(lds, g, So, E, wave);
    }
    SYNC(1);
    if (IN(2)) { PH_BEGIN
        pg8::Gemm g{BIG, Wd, S_, DM, FF}; pg8::StaticOrder So; So.init(S_, DM, G, (int)blockIdx.x);
        pg8::EpiResid E{KIN(0), out, XN, rowss1, 0.5f, DM};
        STAGGER_DELAY(3); pg8::gemm_phase<pg8::EpiResid, pg8::StaticOrder, true, true>(lds, g, So, E, wave);
    }
    SYNC(2);
    if (IN(3)) { PH_BEGIN
        pg8::Gemm g{XN, Win, S_, NINP, DM}; pg8::StaticOrder So; So.init(S_, NINP, G, (int)blockIdx.x);
        pg8::EpiProj E{BIG, rowss1, 1.0f / DM};
        STAGGER_DELAY(1); for (int rep_ = 0; rep_ < NREP(3); ++rep_) pg8::gemm_phase<pg8::EpiProj, pg8::StaticOrder, true, true>(lds, g, So, E, wave);
        {
            const v4u* src = (const v4u*)(ws + WS_GW);
            for (int i = tid; i < 16 * GWP / 16; i += NTHR) *(LAS v4u*)(lds + 16384 + i * 16) = src[i];
            __syncthreads();
        }
        for (int rep_ = 0; rep_ < NREP(13); ++rep_) for (int rb = blockIdx.x; rb < S_ / 64; rb += G) gates_rows(lds, XN, rowss1, KIN(14), KIN(15), GATES, rb, wave, lane);
    }
    SYNC(3);
    if (IN(4)) { PH_BEGIN for (int item = blockIdx.x; item < 512 * NREP(4); item += G) mlstm_stage_a(lds, PROJM, GATES, KIN(12), KIN(13), QC, KC, DELTA, DN, SC, item & 511, wave); }
    SYNC(4);
    if (IN(5)) { PH_BEGIN for (int rep_ = 0; rep_ < NREP(5); ++rep_) mlstm_scan(lds, DELTA, DN, SC, SC + 1024, CT, NST, tid, blockIdx.x * NTHR + tid, G * NTHR); }
    SYNC(5);
    if (IN(6)) { PH_BEGIN
#ifndef NO_ATTN
#if ATTN2
        attn2_phase((char*)lds_raw, BIG, OATT, 512 * NREP(6), wave);
#else
        attn_phase((char*)lds_raw, BIG, OATT, 512 * NREP(6), wave);
#endif
#endif
        __syncthreads();
#ifndef NO_STAGEC
        for (int rep_ = 0; rep_ < NREP(12); ++rep_) for (int item = blockIdx.x; item < 512; item += G) mlstm_stage_c(lds, PROJM, GATES, QC, KC, CT, NST, SC + 1024, KIN(16), Y, item, wave);
#endif
        {
            LAS float* scr = (LAS float*)(lds + wave * 16640);
            for (int it = gw; it < 3 * 2816; it += NGW) cvt_ffn_item(it, KIN(19), KIN(20), KIN(21), KIN(18), Wgu, Wd, scr, lane);
        }
    }
    SYNC(6);
    if (IN(7)) for (int rep_ = 0; rep_ < NREP(7); ++rep_) { PH_BEGIN
        const float l1 = wave_sum(KIN(7)[lane] * KIN(8)[lane] + KIN(7)[lane + 64] * KIN(8)[lane + 64]);
        const float l2 = wave_sum(KIN(9)[lane] * KIN(10)[lane] + KIN(9)[lane + 64] * KIN(10)[lane + 64]);
        const float lam = expf(l1) - expf(l2) + 0.2f;
        const float* hg = KIN(11);
        for (int m = gw; m < S_; m += NGW) {
#pragma unroll
            for (int h = 0; h < 4; ++h) {
                const v2u a = *((const v2u*)(OATT + (size_t)m * 2048 + h * 512) + lane), b = *((const v2u*)(OATT + (size_t)m * 2048 + h * 512 + 256) + lane);
                float y0 = bf2f(a.x & 0xffffu) - lam * bf2f(b.x & 0xffffu), y1 = bf2f(a.x >> 16) - lam * bf2f(b.x >> 16), y2 = bf2f(a.y & 0xffffu) - lam * bf2f(b.y & 0xffffu), y3 = bf2f(a.y >> 16) - lam * bf2f(b.y >> 16);
                const float rs = 0.8f / sqrtf(wave_sum((y0 * y0 + y1 * y1) + (y2 * y2 + y3 * y3)) * (1.0f / 256.0f) + 1e-6f);
                const f32x4 gn = *((const f32x4*)(hg + h * 256) + lane);
                v2u w; w.x = pk2(y0 * rs * gn[0], y1 * rs * gn[1]); w.y = pk2(y2 * rs * gn[2], y3 * rs * gn[3]);
                *((v2u*)(Y + (size_t)m * DM + h * 256) + lane) = w;
            }
        }
    }
    SYNC(7);
    if (IN(8)) { PH_BEGIN
        pg8::Gemm g{Y, Wout, S_, DM, DM}; pg8::StaticOrder So; So.init(S_, DM, G, (int)blockIdx.x);
        pg8::EpiResid E{out, out, XN, rowss2, 1.0f, DM};
        STAGGER_DELAY(3); pg8::gemm_phase<pg8::EpiResid, pg8::StaticOrder, true, true>(lds, g, So, E, wave);
    }
    SYNC(8);
    if (IN(9)) { PH_BEGIN
        pg8::Gemm g{XN, Wgu, S_, 2 * FF, DM}; pg8::StaticOrder So; So.init(S_, 2 * FF, G, (int)blockIdx.x);
        pg8::EpiSwiGLU E{BIG, FF, rowss2, 1.0f / DM};
        STAGGER_DELAY(1); pg8::gemm_phase<pg8::EpiSwiGLU, pg8::StaticOrder, true, true>(lds, g, So, E, wave);
    }
    SYNC(9);
    if (IN(10)) { PH_BEGIN
        pg8::Gemm g{BIG, Wd, S_, DM, FF}; pg8::StaticOrder So; So.init(S_, DM, G, (int)blockIdx.x);
        pg8::EpiResid E{out, out, nullptr, nullptr, 0.5f, DM};
        STAGGER_DELAY(3); pg8::gemm_phase<pg8::EpiResid, pg8::StaticOrder, true, true>(lds, g, So, E, wave);
    }
    SYNC(10);
    if (IN(11)) { PH_BEGIN
        const float* fg = KIN(22);
        for (int m = gw; m < S_; m += NGW) {
            f32x4* xr = (f32x4*)(out + (size_t)m * DM) + lane; f32x4 v[8]; float s = 0.f;
#pragma unroll
            for (int j = 0; j < 8; ++j) { v[j] = xr[64 * j]; s += (v[j][0] * v[j][0] + v[j][1] * v[j][1]) + (v[j][2] * v[j][2] + v[j][3] * v[j][3]); }
            const float rs = 1.0f / sqrtf(wave_sum(s) * (1.0f / DM) + 1e-6f);
#pragma unroll
            for (int j = 0; j < 8; ++j) { const f32x4 gn = *((const f32x4*)fg + 64 * j + lane); xr[64 * j] = v[j] * rs * gn; }
        }
    }
#undef IN
#undef SYNC
}

extern "C" void kernel_launch(void* const* d_in, const int* in_sizes, int n_in, void* d_out, int out_size, void* d_ws, size_t ws_size, hipStream_t stream) {
    static int grid = 0;
    if (grid == 0) {
        if (n_in != 23 || in_sizes[0] != S_ * DM || out_size != S_ * DM || ws_size < WS_END) { fprintf(stderr, "kernel_launch: unexpected shapes (n_in %d, in0 %d, out %d, ws %zu)\n", n_in, n_in > 0 ? in_sizes[0] : -1, out_size, ws_size); grid = -1; return; }
        int dev = 0, cus = 0, per_cu = 0;
        (void)hipGetDevice(&dev); (void)hipDeviceGetAttribute(&cus, hipDeviceAttributeMultiprocessorCount, dev);
        if (hipFuncSetAttribute((const void*)mega_fwd, hipFuncAttributeMaxDynamicSharedMemorySize, LDS_BYTES) != hipSuccess) { fprintf(stderr, "kernel_launch: hipFuncSetAttribute failed\n"); grid = -1; return; }
        if (hipOccupancyMaxActiveBlocksPerMultiprocessor(&per_cu, (const void*)mega_fwd, NTHR, LDS_BYTES) != hipSuccess || per_cu < 1) per_cu = 1;
        grid = cus * per_cu;
        fprintf(stderr, "kernel_launch: grid %d (%d CUs x %d)\n", grid, cus, per_cu);
    }
    if (grid < 0) return;
    Args a{};
    for (int i = 0; i < 23; ++i) a.in[i] = (const float*)d_in[i];
    a.out = (float*)d_out; a.ws = (unsigned char*)d_ws;
#if MK_SPLIT
    for (int p = 0; p < NPH; ++p) { a.ph_lo = p; a.ph_hi = p + 1; hipLaunchKernelGGL(mega_fwd, dim3(grid), dim3(NTHR), LDS_BYTES, stream, a); }
#else
    a.ph_lo = 0; a.ph_hi = NPH;
    (void)hipMemsetAsync((char*)d_ws + WS_BAR, 0, XCD_BAR_WORDS * 4, stream);
    void* kargs[] = {&a};
    hipError_t e = hipLaunchCooperativeKernel((const void*)mega_fwd, dim3(grid), dim3(NTHR), kargs, LDS_BYTES, stream);
    if (e != hipSuccess) fprintf(stderr, "kernel_launch: cooperative launch failed: %s (grid %d)\n", hipGetErrorString(e), grid);
#endif
}
```
